# Optimizing an MI355X kernel written in HIP

```python
import jax
import jax.numpy as jnp
from jax import lax
import numpy as np

D_MODEL = 1024
BATCH = 4
SEQ = 4096
DEPTH = 4

GRID_W = 64
CTX_LEN = 256
HEAD_DIM = 128
ROPE_THETA = 10000.0
EPS = 1e-6
NEG_INF = -1e30

RET_HEADS = 4
RET_DK = HEAD_DIM
RET_DV = HEAD_DIM
RET_WIDTH = RET_HEADS * RET_DV
RET_CHUNK = 128

ATT_Q_HEADS = 4
ATT_KV_HEADS = 2
ATT_GROUP = ATT_Q_HEADS // ATT_KV_HEADS
ATT_WIDTH = ATT_Q_HEADS * HEAD_DIM
ATT_KV_WIDTH = ATT_KV_HEADS * HEAD_DIM
WINDOW = 128
ATT_BLOCK = 128

EVEN_SPLITS = (RET_WIDTH, 2 * RET_WIDTH, 3 * RET_WIDTH, 4 * RET_WIDTH, 4 * RET_WIDTH + ATT_WIDTH, 4 * RET_WIDTH + ATT_WIDTH + ATT_KV_WIDTH)
EVEN_IN = 4 * RET_WIDTH + ATT_WIDTH + 2 * ATT_KV_WIDTH
EVEN_OUT = RET_WIDTH + ATT_WIDTH

HG_DK = 128
HG_HEADS = D_MODEL // HG_DK
HG_DV = D_MODEL // HG_HEADS
HG_FWIDTH = HG_HEADS * HG_DK
HG_VWIDTH = HG_HEADS * HG_DV
HG_CHUNK = 16
ODD_SPLITS = (HG_FWIDTH, 2 * HG_FWIDTH, 3 * HG_FWIDTH, 3 * HG_FWIDTH + HG_VWIDTH)
ODD_IN = 3 * HG_FWIDTH + 2 * HG_VWIDTH

MOE_GROUPS = 4
MOE_EXPERTS_PER_GROUP = 8
MOE_EXPERTS = MOE_GROUPS * MOE_EXPERTS_PER_GROUP
MOE_TOP_K = 2
MOE_FF = D_MODEL // 2
MOE_BLOCK = 128

kernel_name = 'hybrid_retention_swa_hgrn2_hmoe_dit'


def rms_norm(x, w):
    xf = x.astype(jnp.float32)
    y = xf * lax.rsqrt(jnp.mean(xf * xf, axis=-1, keepdims=True) + EPS)
    return (y * w.astype(jnp.float32)).astype(x.dtype)


def head_rms(o):
    return o * lax.rsqrt(jnp.mean(o * o, axis=-1, keepdims=True) + EPS)


def flip_seq(t):
    return jnp.flip(t, axis=1)


def axial_rope_tables(n_rows):
    row = jnp.repeat(jnp.arange(n_rows, dtype=jnp.float32), GRID_W)
    col = jnp.tile(jnp.arange(GRID_W, dtype=jnp.float32), n_rows)
    axis_dim = HEAD_DIM // 2
    inv_freq = ROPE_THETA ** (-jnp.arange(0, axis_dim, 2, dtype=jnp.float32) / axis_dim)
    ang_r = row[:, None] * inv_freq[None, :]
    ang_c = col[:, None] * inv_freq[None, :]
    return (jnp.cos(ang_r), jnp.sin(ang_r), jnp.cos(ang_c), jnp.sin(ang_c))


def _rotate(x, cos, sin):
    m = cos.shape[-1]
    x1, x2 = x[..., :m], x[..., m:]
    cs = cos[None, :, None, :]
    sn = sin[None, :, None, :]
    return jnp.concatenate([x1 * cs - x2 * sn, x2 * cs + x1 * sn], axis=-1)


def apply_axial_rope(x, tables):
    cos_r, sin_r, cos_c, sin_c = tables
    xf = x.astype(jnp.float32)
    half = HEAD_DIM // 2
    out = jnp.concatenate([_rotate(xf[..., :half], cos_r, sin_r), _rotate(xf[..., half:], cos_c, sin_c)], axis=-1)
    return out.astype(x.dtype)


def retention_scan(q, k, v, log_gamma, s0):
    B, T, H, dk = q.shape
    dv = v.shape[-1]
    C = RET_CHUNK
    N = T // C
    qc = q.astype(jnp.float32).reshape(B, N, C, H, dk)
    kc = k.astype(jnp.float32).reshape(B, N, C, H, dk)
    vc = v.astype(jnp.float32).reshape(B, N, C, H, dv)
    pos = jnp.arange(C, dtype=jnp.float32)
    rel = pos[:, None] - pos[None, :]
    decay = jnp.where(rel[None] >= 0, jnp.exp(jnp.maximum(rel, 0.0)[None] * log_gamma[:, None, None]), 0.0)
    scores = jnp.einsum('bnihd,bnjhd->bnhij', qc, kc) * decay
    intra = jnp.einsum('bnhij,bnjhe->bnihe', scores, vc)
    k_decay = jnp.exp((C - 1 - pos)[:, None] * log_gamma[None, :])
    u = jnp.einsum('bnjhd,jh,bnjhe->bnhde', kc, k_decay, vc)
    chunk_decay = jnp.exp(C * log_gamma)[None, :, None, None]

    def step(s, u_n):
        return chunk_decay * s + u_n, s

    s_fin, s_prev = lax.scan(step, s0.astype(jnp.float32), jnp.moveaxis(u, 1, 0))
    q_decay = jnp.exp((pos + 1.0)[:, None] * log_gamma[None, :])
    cross = jnp.einsum('bnihd,ih,nbhde->bnihe', qc, q_decay, s_prev)
    return (intra + cross).reshape(B, T, H, dv), s_fin


def bidirectional_retention(c_qkv, l_qkv, log_gamma):
    qc, kc, vc = c_qkv
    ql, kl, vl = l_qkv
    B, _, H, dk = qc.shape
    zero = jnp.zeros((B, H, dk, vc.shape[-1]), jnp.float32)
    o_cf, s_cf = retention_scan(qc, kc, vc, log_gamma[0], zero)
    o_cb, s_cb = retention_scan(flip_seq(qc), flip_seq(kc), flip_seq(vc), log_gamma[1], zero)
    o_lf, _ = retention_scan(ql, kl, vl, log_gamma[0], s_cf)
    o_lb, _ = retention_scan(flip_seq(ql), flip_seq(kl), flip_seq(vl), log_gamma[1], s_cb)
    return o_cf + flip_seq(o_cb), o_lf + flip_seq(o_lb)


def windowed_gqa_with_sink(c_qkv, l_qkv, sink, ctx_out):
    qc, kc, vc = c_qkv
    ql, kl, vl = l_qkv
    B, L = ql.shape[:2]
    Bs = ATT_BLOCK
    nb = L // Bs
    scale = HEAD_DIM ** -0.5
    sink = sink.astype(jnp.float32).reshape(ATT_KV_HEADS, ATT_GROUP)
    kc32 = kc.astype(jnp.float32)
    vc32 = vc.astype(jnp.float32)
    n_ctx = kc.shape[1]
    qg = ql.astype(jnp.float32).reshape(B, nb, Bs, ATT_KV_HEADS, ATT_GROUP, HEAD_DIM) * scale
    pad = ((0, 0), (Bs, Bs), (0, 0), (0, 0))
    kp = jnp.pad(kl.astype(jnp.float32), pad).reshape(B, nb + 2, Bs, ATT_KV_HEADS, HEAD_DIM)
    vp = jnp.pad(vl.astype(jnp.float32), pad).reshape(B, nb + 2, Bs, ATT_KV_HEADS, HEAD_DIM)
    kw = jnp.concatenate([kp[:, :-2], kp[:, 1:-1], kp[:, 2:]], axis=2)
    vw = jnp.concatenate([vp[:, :-2], vp[:, 1:-1], vp[:, 2:]], axis=2)
    s_loc = jnp.einsum('bnqhgd,bnkhd->bnhgqk', qg, kw)
    q_pos = jnp.arange(L).reshape(nb, Bs)
    k_pos = (jnp.arange(nb)[:, None] - 1) * Bs + jnp.arange(3 * Bs)[None, :]
    valid = (k_pos[:, None, :] >= 0) & (k_pos[:, None, :] < L) & (jnp.abs(q_pos[:, :, None] - k_pos[:, None, :]) <= WINDOW)
    s_loc = jnp.where(valid[None, :, None, None], s_loc, NEG_INF)
    s_ctx = jnp.einsum('bnqhgd,bkhd->bnhgqk', qg, kc32)
    s_sink = jnp.broadcast_to(sink[None, None, :, :, None, None], s_loc.shape[:-1] + (1,))
    p = jax.nn.softmax(jnp.concatenate([s_loc, s_ctx, s_sink], axis=-1), axis=-1)
    n_loc = 3 * Bs
    o_l = (jnp.einsum('bnhgqk,bnkhd->bnqhgd', p[..., :n_loc], vw)
           + jnp.einsum('bnhgqk,bkhd->bnqhgd', p[..., n_loc:n_loc + n_ctx], vc32))
    o_l = o_l.reshape(B, L, ATT_WIDTH)
    if not ctx_out:
        return None, o_l
    qgc = qc.astype(jnp.float32).reshape(B, n_ctx, ATT_KV_HEADS, ATT_GROUP, HEAD_DIM) * scale
    s_cc = jnp.einsum('bqhgd,bkhd->bhgqk', qgc, kc32)
    s_sink_c = jnp.broadcast_to(sink[None, :, :, None, None], s_cc.shape[:-1] + (1,))
    pc = jax.nn.softmax(jnp.concatenate([s_cc, s_sink_c], axis=-1), axis=-1)
    o_c = jnp.einsum('bhgqk,bkhd->bqhgd', pc[..., :n_ctx], vc32).reshape(B, n_ctx, ATT_WIDTH)
    return o_c, o_l


def even_mixer(h_c, h_l, w_in, w_out, ret_decay_raw, att_sink, rope, ctx_out):
    B = h_l.shape[0]

    def project(h, rotate):
        T = h.shape[1]
        rq, rk, rv, rg, aq, ak, av = jnp.split(h @ w_in, EVEN_SPLITS, axis=-1)
        rq = rq.reshape(B, T, RET_HEADS, RET_DK)
        rk = rk.reshape(B, T, RET_HEADS, RET_DK) * (RET_DK ** -0.5)
        rv = rv.reshape(B, T, RET_HEADS, RET_DV)
        aq = aq.reshape(B, T, ATT_Q_HEADS, HEAD_DIM)
        ak = ak.reshape(B, T, ATT_KV_HEADS, HEAD_DIM)
        av = av.reshape(B, T, ATT_KV_HEADS, HEAD_DIM)
        if rotate:
            rq, rk, aq, ak = (apply_axial_rope(t, rope) for t in (rq, rk, aq, ak))
        return (rq, rk, rv), rg, (aq, ak, av)

    c_ret, c_gate, c_att = project(h_c, False)
    l_ret, l_gate, l_att = project(h_l, True)
    log_gamma = -jnp.exp(ret_decay_raw.astype(jnp.float32))
    o_ret_c, o_ret_l = bidirectional_retention(c_ret, l_ret, log_gamma)
    o_att_c, o_att_l = windowed_gqa_with_sink(c_att, l_att, att_sink, ctx_out)

    def merge(o_ret, gate, o_att):
        T = o_ret.shape[1]
        ret = jax.nn.silu(gate.astype(jnp.float32)) * head_rms(o_ret).reshape(B, T, RET_WIDTH)
        y = jnp.concatenate([ret, o_att], axis=-1).astype(h_l.dtype) @ w_out
        return y.astype(h_l.dtype)

    y_l = merge(o_ret_l, l_gate, o_att_l)
    y_c = merge(o_ret_c, c_gate, o_att_c) if ctx_out else None
    return y_c, y_l


def hgrn2_scan(q, k, v, log_f, s0):
    B, T, H, dk = q.shape
    dv = v.shape[-1]
    C = HG_CHUNK
    N = T // C

    def chunks(t):
        return t.reshape(B, N, C, H, t.shape[-1]).transpose(1, 0, 3, 2, 4)

    lower = jnp.tril(jnp.ones((C, C), dtype=bool))[:, :, None]

    def step(s, inp):
        qn, kn, vn, fn = inp
        a = jnp.cumsum(fn, axis=2)
        o_inter = jnp.einsum('bhcd,bhde->bhce', qn * jnp.exp(a), s)
        diff = a[:, :, :, None, :] - a[:, :, None, :, :]
        dec = jnp.exp(jnp.where(lower, diff, NEG_INF))
        scores = jnp.einsum('bhid,bhjd,bhijd->bhij', qn, kn, dec)
        o_intra = jnp.einsum('bhij,bhje->bhie', scores, vn)
        a_last = a[:, :, -1:, :]
        s_new = jnp.exp(a_last[:, :, 0, :])[..., None] * s + jnp.einsum('bhjd,bhje->bhde', kn * jnp.exp(a_last - a), vn)
        return s_new, o_inter + o_intra

    s_fin, o = lax.scan(step, s0.astype(jnp.float32), (chunks(q), chunks(k), chunks(v), chunks(log_f)))
    return o.transpose(1, 0, 3, 2, 4).reshape(B, T, H, dv), s_fin


def odd_mixer(h_c, h_l, w_in, w_out, lower_bound, norm_w, ctx_out):
    B = h_l.shape[0]
    lb = lower_bound.astype(jnp.float32).reshape(HG_HEADS, HG_DK)

    def project(h):
        T = h.shape[1]
        q, zf, zb, i, g = jnp.split(h @ w_in, ODD_SPLITS, axis=-1)
        heads = lambda t, d: t.astype(jnp.float32).reshape(B, T, HG_HEADS, d)
        f_fwd = lb + (1.0 - lb) * jax.nn.sigmoid(heads(zf, HG_DK))
        f_bwd = lb + (1.0 - lb) * jax.nn.sigmoid(heads(zb, HG_DK))
        return heads(q, HG_DK), f_fwd, f_bwd, heads(i, HG_DV), g

    def scan_dir(q, f, i, s0, reverse):
        if reverse:
            q, f, i = flip_seq(q), flip_seq(f), flip_seq(i)
        o, s = hgrn2_scan(q, 1.0 - f, i, jnp.log(f), s0)
        return (flip_seq(o) if reverse else o), s

    qc, ffc, fbc, ic, gc = project(h_c)
    ql, ffl, fbl, il, gl = project(h_l)
    zero = jnp.zeros((B, HG_HEADS, HG_DK, HG_DV), jnp.float32)
    o_cf, s_cf = scan_dir(qc, ffc, ic, zero, False)
    o_cb, s_cb = scan_dir(qc, fbc, ic, zero, True)
    o_lf, _ = scan_dir(ql, ffl, il, s_cf, False)
    o_lb, _ = scan_dir(ql, fbl, il, s_cb, True)

    def readout(o, g):
        T = o.shape[1]
        y = rms_norm(o, norm_w) * jax.nn.silu(g.astype(jnp.float32).reshape(B, T, HG_HEADS, HG_DV))
        return (y.reshape(B, T, HG_VWIDTH).astype(h_l.dtype) @ w_out).astype(h_l.dtype)

    y_l = readout(o_lf + o_lb, gl)
    y_c = readout(o_cf + o_cb, gc) if ctx_out else None
    return y_c, y_l


def hierarchical_moe(h, wg, bg, we, be, w1, w3, w2):
    N, D = h.shape
    g_prob = jax.nn.softmax((h @ wg).astype(jnp.float32) + bg.astype(jnp.float32), axis=-1)
    g_p, g_idx = lax.top_k(g_prob, 1)
    e_all = jnp.einsum('nd,gde->nge', h, we).astype(jnp.float32) + be.astype(jnp.float32)
    sel = jnp.broadcast_to(g_idx[:, :, None], (N, 1, MOE_EXPERTS_PER_GROUP))
    e_logits = jnp.take_along_axis(e_all, sel, axis=1)[:, 0]
    e_top, e_idx = lax.top_k(e_logits, MOE_TOP_K)
    gate = g_p * jax.nn.softmax(e_top, axis=-1)
    expert = g_idx * MOE_EXPERTS_PER_GROUP + e_idx
    NK = N * MOE_TOP_K
    flat_e = expert.reshape(-1)
    flat_tok = jnp.arange(NK) // MOE_TOP_K
    flat_w = gate.reshape(-1)
    order = jnp.argsort(flat_e)
    s_e = flat_e[order]
    s_tok = flat_tok[order]
    s_w = flat_w[order]
    counts = jnp.bincount(flat_e, length=MOE_EXPERTS)
    padded = (counts + MOE_BLOCK - 1) // MOE_BLOCK * MOE_BLOCK
    pad_end = jnp.cumsum(padded)
    pad_start = pad_end - padded
    seg_start = jnp.cumsum(counts) - counts
    dest = pad_start[s_e] + jnp.arange(NK) - seg_start[s_e]
    n_blocks = -(-NK // MOE_BLOCK) + MOE_EXPERTS
    cap = n_blocks * MOE_BLOCK
    slot_tok = jnp.full((cap,), N, dtype=jnp.int32).at[dest].set(s_tok.astype(jnp.int32))
    block_expert = jnp.minimum(jnp.searchsorted(pad_end, jnp.arange(n_blocks) * MOE_BLOCK, side='right'), MOE_EXPERTS - 1)
    h_pad = jnp.concatenate([h, jnp.zeros((1, D), h.dtype)], axis=0)
    xb = h_pad[slot_tok].reshape(n_blocks, MOE_BLOCK, D)

    def expert_block(args):
        xblk, e = args
        return (jax.nn.silu(xblk @ w1[e]) * (xblk @ w3[e])) @ w2[e]

    yb = lax.map(expert_block, (xb, block_expert))
    y_sorted = yb.reshape(cap, D)[dest]
    return jnp.zeros((N, D), h.dtype).at[s_tok].add((y_sorted * s_w[:, None]).astype(h.dtype))


def setup_inputs(seed: int = 0) -> dict:
    key = jax.random.key(seed)
    ks = jax.random.split(key, 24)
    f32 = jnp.float32
    n_even = (DEPTH + 1) // 2
    n_odd = DEPTH // 2

    def nrm(k, shape, scale):
        return jax.random.normal(k, shape, f32) * scale

    base_decay = jnp.log(-jnp.log1p(-(2.0 ** (-5.0 - jnp.arange(RET_HEADS, dtype=f32)))))
    return {
        'x': nrm(ks[0], (BATCH, SEQ, D_MODEL), 1.0),
        'c': nrm(ks[1], (BATCH, D_MODEL), 1.0),
        'ctx': nrm(ks[2], (BATCH, CTX_LEN, D_MODEL), 1.0),
        'c_ctx': nrm(ks[3], (D_MODEL,), 1.0),
        'ada_w': nrm(ks[4], (DEPTH, D_MODEL, 6 * D_MODEL), 0.5 * D_MODEL ** -0.5),
        'ada_b': nrm(ks[5], (DEPTH, 6 * D_MODEL), 0.02),
        'norm_w': 1.0 + nrm(ks[6], (DEPTH, 2, D_MODEL), 0.02),
        'final_norm_w': 1.0 + nrm(ks[7], (D_MODEL,), 0.02),
        'ev_w_in': nrm(ks[8], (n_even, D_MODEL, EVEN_IN), D_MODEL ** -0.5),
        'ev_w_out': nrm(ks[9], (n_even, EVEN_OUT, D_MODEL), EVEN_OUT ** -0.5),
        'ret_decay_raw': base_decay[None, None, :] + nrm(ks[10], (n_even, 2, RET_HEADS), 0.05),
        'att_sink': nrm(ks[11], (n_even, ATT_Q_HEADS), 0.5),
        'od_w_in': nrm(ks[12], (n_odd, D_MODEL, ODD_IN), D_MODEL ** -0.5),
        'od_w_out': nrm(ks[13], (n_odd, HG_VWIDTH, D_MODEL), HG_VWIDTH ** -0.5),
        'hg_lb_logits': nrm(ks[14], (DEPTH, HG_FWIDTH), 0.1),
        'hg_norm_w': 1.0 + nrm(ks[15], (n_odd, HG_DV), 0.02),
        'moe_wg': nrm(ks[16], (DEPTH, D_MODEL, MOE_GROUPS), D_MODEL ** -0.5),
        'moe_bg': nrm(ks[17], (DEPTH, MOE_GROUPS), 0.01),
        'moe_we': nrm(ks[18], (DEPTH, MOE_GROUPS, D_MODEL, MOE_EXPERTS_PER_GROUP), D_MODEL ** -0.5),
        'moe_be': nrm(ks[19], (DEPTH, MOE_GROUPS, MOE_EXPERTS_PER_GROUP), 0.01),
        'moe_w1': nrm(ks[20], (DEPTH, MOE_EXPERTS, D_MODEL, MOE_FF), D_MODEL ** -0.5),
        'moe_w3': nrm(ks[21], (DEPTH, MOE_EXPERTS, D_MODEL, MOE_FF), D_MODEL ** -0.5),
        'moe_w2': nrm(ks[22], (DEPTH, MOE_EXPERTS, MOE_FF, D_MODEL), MOE_FF ** -0.5),
    }


def reference(x, c, ctx, c_ctx, ada_w, ada_b, norm_w, final_norm_w, ev_w_in, ev_w_out, ret_decay_raw, att_sink,
              od_w_in, od_w_out, hg_lb_logits, hg_norm_w, moe_wg, moe_bg, moe_we, moe_be, moe_w1, moe_w3, moe_w2):
    B, L, D = x.shape
    n_ctx = ctx.shape[1]
    n_rows = L // GRID_W
    rope = axial_rope_tables(n_rows)
    lb_cum = jnp.cumsum(jax.nn.softmax(hg_lb_logits.astype(jnp.float32), axis=0), axis=0)
    lower_bounds = lb_cum - lb_cum[:1]
    for l in range(DEPTH):
        last = l == DEPTH - 1
        mod_l = jnp.split(jax.nn.silu(c) @ ada_w[l] + ada_b[l], 6, axis=-1)
        mod_c = jnp.split(jax.nn.silu(c_ctx) @ ada_w[l] + ada_b[l], 6, axis=-1)
        h_l = rms_norm(x, norm_w[l, 0]) * (1.0 + mod_l[1][:, None]) + mod_l[0][:, None]
        h_c = rms_norm(ctx, norm_w[l, 0]) * (1.0 + mod_c[1]) + mod_c[0]
        p = l // 2
        if l % 2 == 0:
            y_c, y_l = even_mixer(h_c, h_l, ev_w_in[p], ev_w_out[p], ret_decay_raw[p], att_sink[p], rope, not last)
        else:
            y_c, y_l = odd_mixer(h_c, h_l, od_w_in[p], od_w_out[p], lower_bounds[l], hg_norm_w[p], not last)
        x = x + mod_l[2][:, None] * y_l
        h2_l = rms_norm(x, norm_w[l, 1]) * (1.0 + mod_l[4][:, None]) + mod_l[3][:, None]
        moe_params = (moe_wg[l], moe_bg[l], moe_we[l], moe_be[l], moe_w1[l], moe_w3[l], moe_w2[l])
        if last:
            y2 = hierarchical_moe(h2_l.reshape(B * L, D), *moe_params)
            x = x + mod_l[5][:, None] * y2.reshape(B, L, D)
        else:
            ctx = ctx + mod_c[2] * y_c
            h2_c = rms_norm(ctx, norm_w[l, 1]) * (1.0 + mod_c[4]) + mod_c[3]
            tokens = jnp.concatenate([h2_c.reshape(B * n_ctx, D), h2_l.reshape(B * L, D)], axis=0)
            y2 = hierarchical_moe(tokens, *moe_params)
            ctx = ctx + mod_c[5] * y2[:B * n_ctx].reshape(B, n_ctx, D)
            x = x + mod_l[5][:, None] * y2[B * n_ctx:].reshape(B, L, D)
    return rms_norm(x, final_norm_w)
```

```cpp
#include <hip/hip_runtime.h>
#include <cstdio>
#include <cstdint>

#ifndef MK_PER_PHASE
#define MK_PER_PHASE 0
#endif

#ifndef CONTRIB_EVEN
#define CONTRIB_EVEN 1
#endif
#ifndef CONTRIB_ODD
#define CONTRIB_ODD 1
#endif
#ifndef CONTRIB_MOE
#define CONTRIB_MOE 1
#endif
#ifndef ABL_ATT0
#define ABL_ATT0 0
#endif
#ifndef ABL_RET0
#define ABL_RET0 0
#endif
#ifndef ABL_HGB0
#define ABL_HGB0 0
#endif
#ifndef RET_DIRECT
#define RET_DIRECT 0
#endif
#ifndef NAIVE_G1
#define NAIVE_G1 0
#endif
#ifndef NAIVE_G2
#define NAIVE_G2 0
#endif
#ifndef NAIVE_MOD
#define NAIVE_MOD 0
#endif
#ifndef NAIVE_MOE
#define NAIVE_MOE 0
#endif
#ifndef NAIVE_ATT
#define NAIVE_ATT 0
#endif
#ifndef NAIVE_HG
#define NAIVE_HG 0
#endif
#ifndef NAIVE_N2R
#define NAIVE_N2R 0
#endif
#ifndef NAIVE_COPY
#define NAIVE_COPY 0
#endif
#ifndef NAIVE_N1
#define NAIVE_N1 0
#endif
#ifndef NAIVE_FINAL
#define NAIVE_FINAL 0
#endif
#ifndef MUT_A
#define MUT_A 0
#endif
#ifndef MUT_B
#define MUT_B 0
#endif
#ifndef MUT_D
#define MUT_D 0
#endif
#ifndef REP_CONV
#define REP_CONV 0
#endif
#ifndef REP_HG
#define REP_HG 0
#endif
#ifndef REP_MIXE
#define REP_MIXE 0
#endif
#define LAS __attribute__((address_space(3)))
#define GAS __attribute__((address_space(1)))
typedef unsigned short bf16_t;
typedef short bf16x8 __attribute__((ext_vector_type(8)));
typedef float f32x4 __attribute__((ext_vector_type(4)));
typedef float f32x2 __attribute__((ext_vector_type(2)));
typedef unsigned u32x4 __attribute__((ext_vector_type(4)));
typedef unsigned u32x2 __attribute__((ext_vector_type(2)));

constexpr int NB = 4, LSEQ = 4096, DM = 1024, NCTX = 256, SU = NCTX + LSEQ  , MTOK = NB * SU  , DEPTH = 4;
constexpr int EV_N = 3072, OD_N = 5120, NEXP = 32, FF = 512;
constexpr int NCHUNK = SU / 128;
constexpr float EPS = 1e-6f;
constexpr int LIST_CAP = MTOK;
constexpr int MOE_MAXROWS = 43008;

constexpr size_t MiB = 1u << 20;
constexpr size_t WS_CTL = 0, CTL_ZERO_BYTES = 1 * MiB;
constexpr size_t WS_MOD = 1 * MiB;
constexpr size_t WS_LB = 1 * MiB + 512 * 1024;
constexpr size_t WS_ROPEC = WS_LB + 16384;
constexpr size_t WS_ROPES = WS_ROPEC + 8192;
constexpr size_t WS_W = 2 * MiB;
constexpr size_t WS_W_EVIN = WS_W;
constexpr size_t WS_W_EVOUT = WS_W + 12 * MiB;
constexpr size_t WS_W_ODIN = WS_W + 16 * MiB;
constexpr size_t WS_W_ODOUT = WS_W + 36 * MiB;
constexpr size_t WS_W_MOE = WS_W + 40 * MiB;
constexpr size_t WS_XRES = 426 * MiB;
constexpr size_t WS_HB = 494 * MiB;
constexpr size_t WS_YB16 = 528 * MiB;
constexpr size_t WS_R = 562 * MiB;
constexpr size_t WS_PE = WS_R;
constexpr size_t WS_ST = WS_R + 102 * MiB;
constexpr size_t WS_PQ = WS_R, WS_PI = WS_R + 34 * MiB, WS_PG = WS_R + 68 * MiB;
constexpr size_t WS_FF = WS_R + 102 * MiB, WS_FB = WS_R + 170 * MiB, WS_OF = WS_R + 238 * MiB, WS_OB = WS_R + 306 * MiB;
constexpr size_t WS_LIST = WS_R;
constexpr size_t WS_TOKINFO = WS_R + 5 * MiB;
constexpr size_t WS_ACT = WS_R + 6 * MiB;
constexpr size_t WS_YB = WS_R + 50 * MiB;
constexpr size_t WS_YN = WS_R + 140 * MiB;
constexpr size_t WS_END = 936 * MiB;
constexpr size_t WS_SP = 256 * 1024;
constexpr int SP_NORMW = 0, SP_FNORMW = 8192, SP_WG = 9216, SP_BG = 25600, SP_WE = 25616, SP_BE = 156688, SP_DECAY = 156816, SP_SINK = 156832, SP_HGNW = 156840, SP_END = 157096;
static_assert(WS_SP + (size_t)SP_END * 4 <= CTL_ZERO_BYTES, "small parameters fit in the control MiB");
constexpr int CW_BAR = 4096;
constexpr int CW_CNT = 8192;

constexpr int RING_BYTES = 150528;
constexpr int LDSCTL_OFF = RING_BYTES, MISC_OFF = LDSCTL_OFF + 320;
constexpr int LDS_BYTES = RING_BYTES + 4096;
constexpr int NWAVES = 8;

#ifndef BF_TRUNC
#define BF_TRUNC 0
#endif
__device__ __forceinline__ unsigned f2bf(float f) { unsigned u = __builtin_bit_cast(unsigned, f); return BF_TRUNC ? (u >> 16) : ((u + 0x7fffu + ((u >> 16) & 1u)) >> 16); }
__device__ __forceinline__ unsigned pk2(float lo, float hi) { return f2bf(lo) | (f2bf(hi) << 16); }
__device__ __forceinline__ float bf2f(unsigned h) { return __builtin_bit_cast(float, h << 16); }
__device__ __forceinline__ float bflo(unsigned w) { return __builtin_bit_cast(float, w << 16); }
__device__ __forceinline__ float bfhi(unsigned w) { return __builtin_bit_cast(float, w & 0xffff0000u); }
__device__ __forceinline__ float shx(float v, int o, int lane) { return __builtin_bit_cast(float, __builtin_amdgcn_ds_bpermute((lane ^ o) << 2, __builtin_bit_cast(int, v))); }
__device__ __forceinline__ int shup_i(int v, int o, int lane) { return __builtin_amdgcn_ds_bpermute((lane - o) << 2, v); }
__device__ __forceinline__ int shidx_i(int v, int src) { return __builtin_amdgcn_ds_bpermute(src << 2, v); }
__device__ __forceinline__ float wave_sum(float v, int lane) {
#pragma unroll
    for (int o = 1; o < 64; o <<= 1) v += shx(v, o, lane);
    return v;
}
__device__ __forceinline__ float siluf(float x) { return x / (1.0f + __expf(-x)); }
#define LDS_WAIT() asm volatile("s_waitcnt lgkmcnt(0)" ::: "memory")
#define VM_WAIT() asm volatile("s_waitcnt vmcnt(0)" ::: "memory")

namespace pg8 {
constexpr int BM = 256, BK = 64, HALF = 128, HTB = HALF * BK * 2, STAGE_BYTES = 8 * HTB, NXCD = 8, WGM = 8;
__host__ __device__ __forceinline__ int lds_byte(int r, int c) { const int st = (r >> 4) * 2 + (c >> 5), rr = r & 15, cc = c & 31, ob = rr * 64 + cc * 2; return st * 1024 + (ob ^ (((ob >> 9) & 1) << 5)); }
__host__ __device__ __forceinline__ void stage_rc(int b, int& R, int& C) { const int st = b / 1024, sb = b % 1024, swz = sb ^ (((sb >> 9) & 1) << 5); R = (st >> 1) * 16 + swz / 64; C = (st & 1) * 32 + (swz % 64) / 2; }
__host__ __device__ __forceinline__ int perm32(int rho) { const int n = rho >> 4, i = rho & 15; return 8 * (i >> 2) + 4 * n + (i & 3); }

struct Unit { int pm, pn, e, cnt, tile; };

__device__ __forceinline__ int xcd_remap(int L, int nwg) { const int q = nwg / NXCD, r = nwg % NXCD, xcd = L % NXCD, off = L / NXCD; return (xcd < r ? xcd * (q + 1) : r * (q + 1) + (xcd - r) * q) + off; }

struct StaticOrder {
    int nM, nN, nwg, G, c, skipctx;
    __device__ void init(int M, int N, int G_, int c_, int skip_ = 0) { skipctx = skip_; nM = skip_ ? 64 : M / BM; nN = N / BM; nwg = nM * nN; G = G_; c = c_; }
    __device__ bool next(int i, Unit& u) const {
        const long L = (long)i * G + c; if (L >= nwg) return false;
        const int wgid = xcd_remap((int)L, nwg);
        const int nig = WGM * nN, gid = wgid / nig, fm = gid * WGM, gsz = (nM - fm) < WGM ? (nM - fm) : WGM;
        u.pm = fm + ((wgid % nig) % gsz); u.pn = (wgid % nig) / gsz; u.e = 0; u.cnt = 0; u.tile = 0;
        if (skipctx) u.pm = u.pm + u.pm / 16 + 1;
        return true;
    }
};
struct MoeOrder {
    const LAS int* tstart; const LAS int* cnts; int ntiles, G, c;
    __device__ bool next(int i, Unit& u) const {
        const int nwg = ntiles * 4; const long L = (long)i * G + c; if (L >= nwg) return false;
        const int wgid = xcd_remap((int)L, nwg);
        const int tile = wgid >> 2; u.pn = wgid & 3; u.tile = tile;
        int e = 0;
        for (int k = 1; k < NEXP; ++k) e += (tstart[k] <= tile) ? 1 : 0;
        u.e = e; u.pm = tile - tstart[e]; u.cnt = cnts[e]; return true;
    }
};

struct PlainAddr {
    static constexpr bool GATHER = false;
    const bf16_t* A; const bf16_t* Bt; int K;
    __device__ __forceinline__ void base(const Unit& u, const char*& cA, const char*& cB) const { cA = (const char*)(A + (size_t)u.pm * BM * K); cB = (const char*)(Bt + (size_t)u.pn * BM * K); }
    __device__ __forceinline__ void rows(const Unit&, const int (&)[2], const int (&)[2], unsigned (&)[2], unsigned (&)[2]) const {}
};
struct MoeGatherAddr {
    static constexpr bool GATHER = true;
    const bf16_t* HB; const bf16_t* Wbase; const unsigned* list; int K;
    __device__ __forceinline__ void base(const Unit& u, const char*& cA, const char*& cB) const { cA = (const char*)HB; cB = (const char*)Wbase + (size_t)u.e * (3u << 20) + (size_t)u.pn * BM * K * 2; }
    __device__ __forceinline__ void rows(const Unit& u, const int (&R)[2], const int (&C)[2], unsigned (&v0)[2], unsigned (&v1)[2]) const {
        const unsigned* lp = list + (size_t)u.e * LIST_CAP;
#pragma unroll
        for (int i = 0; i < 2; ++i) {
            int i0 = u.pm * BM + R[i], i1 = i0 + HALF; const int mx = u.cnt - 1; i0 = i0 < mx ? i0 : mx; i1 = i1 < mx ? i1 : mx;
            const unsigned t0 = __hip_atomic_load(lp + i0, __ATOMIC_RELAXED, __HIP_MEMORY_SCOPE_AGENT), t1 = __hip_atomic_load(lp + i1, __ATOMIC_RELAXED, __HIP_MEMORY_SCOPE_AGENT);
            v0[i] = (t0 * (unsigned)K + (unsigned)C[i]) * 2u; v1[i] = (t1 * (unsigned)K + (unsigned)C[i]) * 2u;
        }
    }
};
struct MoeActAddr {
    static constexpr bool GATHER = false;
    const bf16_t* Act; const bf16_t* Wbase; int K;
    __device__ __forceinline__ void base(const Unit& u, const char*& cA, const char*& cB) const { cA = (const char*)(Act + (size_t)u.tile * BM * K); cB = (const char*)Wbase + (size_t)u.e * (3u << 20) + (size_t)u.pn * BM * K * 2; }
    __device__ __forceinline__ void rows(const Unit&, const int (&)[2], const int (&)[2], unsigned (&)[2], unsigned (&)[2]) const {}
};

__device__ __forceinline__ unsigned cvt_pk_bf16(float lo, float hi) { unsigned r; asm volatile("v_cvt_pk_bf16_f32 %0, %1, %2" : "=v"(r) : "v"(lo), "v"(hi)); return r; }

template <class Epi, class Sched, class Addr>
__device__ __forceinline__ void gemm_phase(LAS unsigned char* lds, const Addr& AD, const Sched& S, const Epi& E, const int K) {
    int tid = threadIdx.x; asm volatile("" : "+v"(tid));
    const int wid = __builtin_amdgcn_readfirstlane(tid >> 6), lane = tid & 63, wr = wid >> 2, wc = wid & 3, fr = lane & 15, fq = lane >> 4;
    const int nt = K / BK;
    int sR[2], sC[2]; unsigned voffA[2], voffB[2];
#pragma unroll
    for (int i = 0; i < 2; ++i) { int R, C; stage_rc(tid * 16 + i * 8192, R, C); sR[i] = R; sC[i] = C; const int Rb = Epi::PERM ? ((R & ~31) + perm32(R & 31)) : R; voffA[i] = (unsigned)(R * K + C) * 2u; voffB[i] = (unsigned)(Rb * K + C) * 2u; }
    const size_t kstep = (size_t)(BK * 2);
    const size_t hstep = (size_t)HALF * K * 2;
    const unsigned ldsw = (unsigned)wid * 1024u;
    const int aoff = lds_byte(wr * 64 + fr, fq * 8), boff = lds_byte(wc * 32 + fr, fq * 8);
#define PG8_SA(b, h) (((b) * 2 + (h)) * HTB)
#define PG8_SB(b, h) ((4 + (b) * 2 + (h)) * HTB)
#define PG8_STAGE(bufoff, gbase, voff) do { _Pragma("unroll") for (int _i = 0; _i < 2; ++_i) \
        __builtin_amdgcn_global_load_lds((const unsigned*)((const char*)(gbase) + (voff)[_i]), (LAS unsigned*)(lds + (bufoff) + ldsw + _i * 8192), 16, 0, 0); } while (0)
#define PG8_LDA(dst, b, h) do { _Pragma("unroll") for (int m = 0; m < 4; ++m) _Pragma("unroll") for (int k = 0; k < 2; ++k) dst[m][k] = *(const LAS bf16x8*)(lds + PG8_SA(b, h) + aoff + m * 2048 + k * 1024); } while (0)
#define PG8_LDB(dst, b, h) do { _Pragma("unroll") for (int n = 0; n < 2; ++n) _Pragma("unroll") for (int k = 0; k < 2; ++k) dst[n][k] = *(const LAS bf16x8*)(lds + PG8_SB(b, h) + boff + n * 2048 + k * 1024); } while (0)
#define PG8_MMA(ai, bj, At, Bt) do { __builtin_amdgcn_s_setprio(1); _Pragma("unroll") for (int m = 0; m < 4; ++m) _Pragma("unroll") for (int n = 0; n < 2; ++n) _Pragma("unroll") for (int k = 0; k < 2; ++k) \
        acc[ai][bj][m][n] = __builtin_amdgcn_mfma_f32_16x16x32_bf16(Bt[n][k], At[m][k], acc[ai][bj][m][n], 0, 0, 0); __builtin_amdgcn_s_setprio(0); } while (0)
#define PG8_WAIT_V(n) asm volatile("s_waitcnt vmcnt(" #n ")" ::: "memory")
#define PG8_WAIT_L(n) asm volatile("s_waitcnt lgkmcnt(" #n ")" ::: "memory")
#define PG8_BAR __builtin_amdgcn_s_barrier()
#define PG8_SCHED __builtin_amdgcn_sched_barrier(0)
    Unit cur, nxt; int ui = 0;
    if (!S.next(0, cur)) return;
    f32x4 acc[2][2][4][2];
#pragma unroll
    for (int a = 0; a < 2; ++a)
#pragma unroll
        for (int b = 0; b < 2; ++b)
#pragma unroll
            for (int m = 0; m < 4; ++m)
#pragma unroll
                for (int n = 0; n < 2; ++n) acc[a][b][m][n] = (f32x4){0.f, 0.f, 0.f, 0.f};
    bf16x8 At[4][2], B0[2][2], B1[2][2];
    const char* cA; const char* cB; unsigned cv0[2] = {voffA[0], voffA[1]}, cv1[2] = {voffA[0], voffA[1]};
    AD.base(cur, cA, cB); AD.rows(cur, sR, sC, cv0, cv1);
    const size_t ah = Addr::GATHER ? (size_t)0 : hstep;
    PG8_STAGE(PG8_SB(0, 0), cB, voffB); PG8_STAGE(PG8_SB(0, 1), cB + hstep, voffB); PG8_STAGE(PG8_SA(0, 0), cA, cv0); PG8_STAGE(PG8_SA(0, 1), cA + ah, cv1);
    if (wr == 1) PG8_BAR;
    PG8_WAIT_V(2); PG8_BAR;
    PG8_STAGE(PG8_SB(1, 0), cB + kstep, voffB); PG8_STAGE(PG8_SA(1, 0), cA + kstep, cv0); PG8_STAGE(PG8_SB(1, 1), cB + hstep + kstep, voffB);
    PG8_WAIT_V(6); PG8_BAR;
    for (;;) {
        const bool has_next = S.next(ui + 1, nxt);
        const char* nA = cA; const char* nB = cB; unsigned nv0[2] = {cv0[0], cv0[1]}, nv1[2] = {cv1[0], cv1[1]};
        if (has_next) { AD.base(nxt, nA, nB); AD.rows(nxt, sR, sC, nv0, nv1); }
        for (int t = 0; t < nt; t += 2) {
            const bool last = (t == nt - 2);
            const char* a1 = cA + (size_t)(t + 1) * kstep;
            const char* a2 = last ? nA : cA + (size_t)(t + 2) * kstep; const char* b2 = last ? nB : cB + (size_t)(t + 2) * kstep;
            const char* a3 = a2 + kstep; const char* b3 = b2 + kstep;
            unsigned x0[2] = {cv0[0], cv0[1]}, x1[2] = {cv1[0], cv1[1]};
            if constexpr (Addr::GATHER) { if (last) { x0[0] = nv0[0]; x0[1] = nv0[1]; x1[0] = nv1[0]; x1[1] = nv1[1]; } }
            PG8_LDB(B0, 0, 0); PG8_LDB(B1, 0, 1); PG8_SCHED; PG8_LDA(At, 0, 0); PG8_STAGE(PG8_SA(1, 1), a1 + ah, cv1);
            PG8_WAIT_V(8); PG8_WAIT_L(0); PG8_BAR; PG8_MMA(0, 0, At, B0); PG8_MMA(0, 1, At, B1); PG8_BAR; PG8_SCHED;
            PG8_LDA(At, 0, 1); PG8_STAGE(PG8_SB(0, 0), b2, voffB); PG8_STAGE(PG8_SB(0, 1), b2 + hstep, voffB); PG8_STAGE(PG8_SA(0, 0), a2, x0);
            PG8_WAIT_V(8); PG8_WAIT_L(0); PG8_BAR; PG8_MMA(1, 0, At, B0); PG8_MMA(1, 1, At, B1); PG8_BAR; PG8_SCHED;
            PG8_LDB(B0, 1, 0); PG8_LDB(B1, 1, 1); PG8_SCHED; PG8_LDA(At, 1, 0); PG8_STAGE(PG8_SA(0, 1), a2 + ah, x1);
            PG8_WAIT_V(8); PG8_WAIT_L(0); PG8_BAR; PG8_MMA(0, 0, At, B0); PG8_MMA(0, 1, At, B1); PG8_BAR; PG8_SCHED;
            PG8_LDA(At, 1, 1); PG8_STAGE(PG8_SB(1, 0), b3, voffB); PG8_STAGE(PG8_SB(1, 1), b3 + hstep, voffB); PG8_STAGE(PG8_SA(1, 0), a3, x0);
            PG8_WAIT_V(8); PG8_WAIT_L(0); PG8_BAR; PG8_MMA(1, 0, At, B0); PG8_MMA(1, 1, At, B1); PG8_BAR; PG8_SCHED;
        }
        if (wr == 0) PG8_BAR;
        E(acc, cur, wr, wc, fr, fq);
        if (!has_next) break;
#pragma unroll
        for (int a = 0; a < 2; ++a)
#pragma unroll
            for (int b = 0; b < 2; ++b)
#pragma unroll
                for (int m = 0; m < 4; ++m)
#pragma unroll
                    for (int n = 0; n < 2; ++n) acc[a][b][m][n] = (f32x4){0.f, 0.f, 0.f, 0.f};
        cur = nxt; cA = nA; cB = nB; cv0[0] = nv0[0]; cv0[1] = nv0[1]; cv1[0] = nv1[0]; cv1[1] = nv1[1]; ++ui;
        if (wr == 1) PG8_BAR;
    }
    PG8_WAIT_V(0);
    PG8_BAR;
#undef PG8_SA
#undef PG8_SB
#undef PG8_STAGE
#undef PG8_LDA
#undef PG8_LDB
#undef PG8_MMA
#undef PG8_WAIT_V
#undef PG8_WAIT_L
#undef PG8_BAR
#undef PG8_SCHED
}
}

#define XB_TMO      128
#define XB_XCNT(j)  (256  + 64 * (j))
#define XB_XSUB(j)  (1280 + 64 * (j))
#define XB_XGEN(j)  (2304 + 64 * (j))
#define XB_TOP      3328
#define XB_TOPGEN   3392
#define XCD_BAR_WORDS 3456
#define XB_SPIN_CAP (1u << 20)
__device__ __forceinline__ unsigned xb_ld(unsigned* p)              { return __hip_atomic_load((GAS unsigned*)p, __ATOMIC_RELAXED, __HIP_MEMORY_SCOPE_AGENT); }
__device__ __forceinline__ unsigned xb_add(unsigned* p, unsigned v) { return __hip_atomic_fetch_add((GAS unsigned*)p, v, __ATOMIC_RELAXED, __HIP_MEMORY_SCOPE_AGENT); }
__device__ __forceinline__ unsigned xb_xcc_id() { return (unsigned)__builtin_amdgcn_s_getreg((3 << 11) | 20) & 0xFu; }
#define XB_SPIN(cond, bar) do { unsigned _sp = 0; while (cond) { __builtin_amdgcn_s_sleep(1); \
    if ((++_sp & 255u) == 0u) { if (xb_ld(&(bar)[XB_TMO])) break; if (_sp > XB_SPIN_CAP) { xb_add(&(bar)[XB_TMO], 1u); break; } } } } while (0)
struct XcdBarrier { unsigned* bar; unsigned x; volatile LAS unsigned* st; };
__device__ __forceinline__ XcdBarrier xcd_barrier_post(unsigned* bar, volatile LAS unsigned* st) {
    XcdBarrier b; b.bar = bar; b.x = xb_xcc_id(); b.st = st;
    if (threadIdx.x == 0) (void)xb_add(&bar[XB_XCNT(b.x)], 1u);
    return b;
}
__device__ __forceinline__ void xcd_barrier_complete(unsigned* bar, unsigned x, unsigned& nloc, unsigned& nx) {
    const unsigned G = gridDim.x * gridDim.y * gridDim.z;
    unsigned sum, cnt, mine, sp = 0u;
    for (;;) {
        sum = 0u; cnt = 0u; mine = 0u;
#pragma unroll
        for (unsigned j = 0; j < 16; ++j) { const unsigned c = xb_ld(&bar[XB_XCNT(j)]); sum += c; cnt += (c > 0u) ? 1u : 0u; }
        mine = xb_ld(&bar[XB_XCNT(x)]);
        if (sum == G) break;
        __builtin_amdgcn_s_sleep(1);
        if ((++sp & 255u) == 0u) { if (xb_ld(&bar[XB_TMO])) break; if (sp > XB_SPIN_CAP) { xb_add(&bar[XB_TMO], 1u); break; } }
    }
    nloc = mine > 0u ? mine : 1u; nx = cnt > 0u ? cnt : 1u;
}
__device__ __forceinline__ void xcd_barrier(const XcdBarrier& b) {
    asm volatile("s_waitcnt vmcnt(0)" ::: "memory");
    __syncthreads();
    if (threadIdx.x == 0) {
        unsigned* bar = b.bar; asm volatile("" : "+s"(bar));
        __builtin_amdgcn_s_waitcnt(0);
        unsigned nloc = b.st[0], nx = b.st[1];
        if (nloc == 0u) { xcd_barrier_complete(bar, b.x, nloc, nx); b.st[0] = nloc; b.st[1] = nx; }
        const unsigned old = xb_add(&bar[XB_XSUB(b.x)], 1u);
        const unsigned gen = old / nloc;
        if (old + 1u == (gen + 1u) * nloc) {
            __builtin_amdgcn_fence(__ATOMIC_RELEASE, "agent");
            asm volatile("s_waitcnt vmcnt(0)" ::: "memory");
            const unsigned og = xb_add(&bar[XB_TOP], 1u);
            const unsigned tg = og / nx;
            if (og + 1u == (tg + 1u) * nx) xb_add(&bar[XB_TOPGEN], 1u);
            else XB_SPIN(xb_ld(&bar[XB_TOPGEN]) == tg, bar);
            __builtin_amdgcn_fence(__ATOMIC_ACQUIRE, "agent");
            xb_add(&bar[XB_XGEN(b.x)], 1u);
            asm volatile("s_waitcnt vmcnt(0)" ::: "memory");
        } else {
            XB_SPIN(xb_ld(&bar[XB_XGEN(b.x)]) == gen, bar);
            __builtin_amdgcn_fence(__ATOMIC_ACQUIRE, "agent");
            asm volatile("s_waitcnt vmcnt(0)" ::: "memory");
        }
    }
    __syncthreads();
}

__device__ __forceinline__ int ftid() { int t = (int)threadIdx.x; asm volatile("" : "+v"(t)); return t; }
__device__ __forceinline__ int flane() { return ftid() & 63; }
__device__ __forceinline__ int fbid() { int b = (int)blockIdx.x; asm volatile("" : "+s"(b)); return b; }
struct Args { const float* in[23]; float* out; unsigned char* ws; int ph_lo, ph_hi; };
struct Frame {
    LAS unsigned char* lds;
    volatile LAS unsigned* MISC;
    unsigned* ctl;
    unsigned char* ws;
    int wave, vcu, G;
};
enum { I_X = 0, I_C, I_CTX, I_CCTX, I_ADAW, I_ADAB, I_NORMW, I_FNORMW, I_EVWIN, I_EVWOUT, I_RETDECAY, I_SINK, I_ODWIN, I_ODWOUT, I_LBLOG, I_HGNW,
       I_WG, I_BG, I_WE, I_BE, I_W1, I_W3, I_W2 };

__device__ __forceinline__ void conv_item(const float* srcp, int src_ld, bf16_t* WT, int K, int n0, int k0, LAS float* scr, int lane) {
#pragma unroll 8
    for (int i = 0; i < 32; ++i) { const int kk = 2 * i + (lane >> 5); scr[kk * 33 + (lane & 31)] = srcp[(size_t)(k0 + kk) * src_ld]; }
    LDS_WAIT(); asm volatile("" ::: "memory");
    const int c = lane & 7;
#pragma unroll
    for (int j = 0; j < 4; ++j) { const int n = (lane >> 3) + 8 * j; const LAS float* s = scr + (8 * c) * 33 + n;
        u32x4 o; o.x = pk2(s[0 * 33], s[1 * 33]); o.y = pk2(s[2 * 33], s[3 * 33]); o.z = pk2(s[4 * 33], s[5 * 33]); o.w = pk2(s[6 * 33], s[7 * 33]);
        *(u32x4*)(WT + (size_t)(n0 + n) * K + k0 + 8 * c) = o; }
    LDS_WAIT(); asm volatile("" ::: "memory");
}
__device__ __forceinline__ int head_perm(int n) { const int hh = n >> 7, phi = n & 127, g = phi >> 3, u = phi & 7; return hh * 128 + 64 * (g >> 3) + 4 * (g & 7) + (u & 3) + 32 * (u >> 2); }

__device__ __forceinline__ void p0_prologue(Frame& F, const Args& args) {
    LAS float* scr = (LAS float*)(F.lds + F.wave * 16384);
    const int gw = F.vcu * NWAVES + F.wave, NGW = F.G * NWAVES, lane = flane();
    constexpr int NI_EVIN = 16 * (EV_N / 32), NI_ODIN = 16 * (OD_N / 32), NI_OUT = 16 * 32, NI_W13 = 16 * 32, NI_W2 = 8 * 32;
    constexpr int NI_MOE1 = NI_W13 + NI_W2;
    constexpr int NITEMS = 2 * NI_EVIN + 2 * NI_ODIN + 4 * NI_OUT + DEPTH * NEXP * NI_MOE1;
    for (int rep_ = 0; rep_ <= REP_CONV; ++rep_)
    for (int it = gw; it < NITEMS; it += NGW) {
        int r = it;
        if (r < 2 * NI_EVIN) { const int p = r / NI_EVIN; r %= NI_EVIN; const int nblk = EV_N / 32, kb = r / nblk, nb = r % nblk; const int n = nb * 32 + (lane & 31);
            conv_item(args.in[I_EVWIN] + (size_t)p * DM * EV_N + head_perm(n), EV_N, (bf16_t*)(F.ws + WS_W_EVIN + (size_t)p * 6 * MiB), DM, nb * 32, kb * 64, scr, lane); continue; }
        r -= 2 * NI_EVIN;
        if (r < 2 * NI_ODIN) { const int p = r / NI_ODIN; r %= NI_ODIN; const int nblk = OD_N / 32, kb = r / nblk, nb = r % nblk; const int n = nb * 32 + (lane & 31);
            conv_item(args.in[I_ODWIN] + (size_t)p * DM * OD_N + head_perm(n), OD_N, (bf16_t*)(F.ws + WS_W_ODIN + (size_t)p * 10 * MiB), DM, nb * 32, kb * 64, scr, lane); continue; }
        r -= 2 * NI_ODIN;
        if (r < 4 * NI_OUT) { const int q = r / NI_OUT; r %= NI_OUT; const int kb = r / 32, nb = r % 32; const int n = nb * 32 + (lane & 31);
            const float* src = (q < 2 ? args.in[I_EVWOUT] + (size_t)q * DM * DM : args.in[I_ODWOUT] + (size_t)(q - 2) * DM * DM);
            bf16_t* dst = (bf16_t*)(F.ws + (q < 2 ? WS_W_EVOUT + (size_t)q * 2 * MiB : WS_W_ODOUT + (size_t)(q - 2) * 2 * MiB));
            conv_item(src + n, DM, dst, DM, nb * 32, kb * 64, scr, lane); continue; }
        r -= 4 * NI_OUT;
        { const int le = r / NI_MOE1; r %= NI_MOE1;
            bf16_t* dst = (bf16_t*)(F.ws + WS_W_MOE + (size_t)le * 3 * MiB);
            if (r < NI_W13) { const int kb = r / 32, nb = r % 32; const int n = nb * 32 + (lane & 31);
                const int Gq = n >> 3, u = n & 7; const float* src = (u < 4 ? args.in[I_W1] : args.in[I_W3]) + (size_t)le * DM * FF + 4 * Gq + (u & 3);
                conv_item(src, FF, dst, DM, nb * 32, kb * 64, scr, lane); }
            else { r -= NI_W13; const int kb = r / 32, nb = r % 32; const int n = nb * 32 + (lane & 31);
                conv_item(args.in[I_W2] + (size_t)le * FF * DM + n, DM, dst + (size_t)DM * DM, FF, nb * 32, kb * 64, scr, lane); }
        }
    }
    {
        f32x4* xr = (f32x4*)(F.ws + WS_XRES);
        const f32x4* xs = (const f32x4*)args.in[I_X]; const f32x4* cs = (const f32x4*)args.in[I_CTX];
        const size_t total = (size_t)MTOK * 256;
        for (size_t i = (size_t)fbid() * 512 + ftid(); i < total; i += (size_t)F.G * 512) {
            const int row = (int)(i >> 8), c4 = (int)(i & 255); const int b = row / SU, p = row % SU;
            xr[i] = (p < NCTX) ? cs[((size_t)(b * NCTX + p) << 8) + c4] : xs[((size_t)(b * LSEQ + p - NCTX) << 8) + c4];
        }
    }
    if (NAIVE_COPY) { float* xr2 = (float*)(F.ws + WS_XRES);
        for (size_t i = (size_t)fbid() * 512 + ftid(); i < (size_t)MTOK * DM; i += (size_t)F.G * 512) { const size_t row = i / DM; const int k = (int)(i % DM); const int b = (int)(row / SU), p = (int)(row % SU);
            xr2[i] = p < NCTX ? args.in[I_CTX][((size_t)b * NCTX + p) * DM + k] : args.in[I_X][((size_t)b * LSEQ + (p - NCTX)) * DM + k]; } }
    {
        float* sp = (float*)(F.ws + WS_SP);
        for (int i = fbid() * 512 + ftid(); i < SP_END; i += F.G * 512) {
            float v;
            if (i < SP_FNORMW) v = args.in[I_NORMW][i]; else if (i < SP_WG) v = args.in[I_FNORMW][i - SP_FNORMW]; else if (i < SP_BG) v = args.in[I_WG][i - SP_WG]; else if (i < SP_WE) v = args.in[I_BG][i - SP_BG];
            else if (i < SP_BE) v = args.in[I_WE][i - SP_WE]; else if (i < SP_DECAY) v = args.in[I_BE][i - SP_BE]; else if (i < SP_SINK) v = args.in[I_RETDECAY][i - SP_DECAY]; else if (i < SP_HGNW) v = args.in[I_SINK][i - SP_SINK]; else v = args.in[I_HGNW][i - SP_HGNW];
            sp[i] = v;
        }
    }
    if (blockIdx.x == 0) {
        float* lb = (float*)(F.ws + WS_LB); const float* lg = args.in[I_LBLOG];
        for (int c = ftid(); c < DM; c += 512) {
            const float a0 = lg[c], a1 = lg[DM + c], a2 = lg[2 * DM + c], a3 = lg[3 * DM + c];
            const float mx = fmaxf(fmaxf(a0, a1), fmaxf(a2, a3));
            const float e0 = expf(a0 - mx), e1 = expf(a1 - mx), e2 = expf(a2 - mx), e3 = expf(a3 - mx); const float inv = 1.0f / (e0 + e1 + e2 + e3);
            lb[c] = 0.f; lb[DM + c] = e1 * inv; lb[2 * DM + c] = (e1 + e2) * inv; lb[3 * DM + c] = (e1 + e2 + e3) * inv;
        }
    }
    if (blockIdx.x == 1) {
        float* rc = (float*)(F.ws + WS_ROPEC); float* rs = (float*)(F.ws + WS_ROPES);
        for (int i = ftid(); i < 64 * 32; i += 512) { const int pos = i >> 5, fi = i & 31;
            const float invf = powf(10000.0f, -(float)(2 * fi) / 64.0f); const float ang = (float)pos * invf;
            rc[i] = cosf(ang); rs[i] = sinf(ang); }
    }
    {
        __syncthreads();
        LAS float* sv = (LAS float*)F.lds;
        LAS float* part = (LAS float*)(F.lds + 20480);
        for (int i = ftid(); i < 5 * DM; i += 512) { const int r = i >> 10, k = i & 1023; const float v = (r < 4) ? args.in[I_C][r * DM + k] : args.in[I_CCTX][k]; sv[i] = siluf(v); }
        __syncthreads();
        float* mod = (float*)(F.ws + WS_MOD);
        for (int it = fbid(); it < DEPTH * 96; it += F.G) {
            const int l = it / 96, cg = it % 96; const int col = cg * 64 + lane;
            const float* w = args.in[I_ADAW] + (size_t)l * DM * 6144 + col;
            float a[5] = {0.f, 0.f, 0.f, 0.f, 0.f};
            const int k0 = F.wave * 128;
#pragma unroll 8
            for (int k = 0; k < 128; ++k) { const float wv = w[(size_t)(k0 + k) * 6144];
#pragma unroll
                for (int r = 0; r < 5; ++r) a[r] += sv[r * DM + k0 + k] * wv; }
#pragma unroll
            for (int r = 0; r < 5; ++r) part[(F.wave * 5 + r) * 64 + lane] = a[r];
            __syncthreads();
            if (ftid() < 320) { const int r = ftid() >> 6, c = ftid() & 63; float s = 0.f;
#pragma unroll
                for (int w8 = 0; w8 < 8; ++w8) s += part[(w8 * 5 + r) * 64 + c];
                mod[((size_t)l * 5 + r) * 6144 + cg * 64 + c] = s + args.in[I_ADAB][l * 6144 + cg * 64 + c]; }
            __syncthreads();
        }
    }
}

__device__ __forceinline__ int moe_tile_prefix(const unsigned* cnt, int lane, int& mycnt) {
    const int c = (lane < NEXP) ? (int)__hip_atomic_load(cnt + lane, __ATOMIC_RELAXED, __HIP_MEMORY_SCOPE_AGENT) : 0; mycnt = c;
    const int nt = (c + 255) >> 8; int incl = nt;
#pragma unroll
    for (int o = 1; o < 64; o <<= 1) { const int v = shup_i(incl, o, lane); if (lane >= o) incl += v; }
    return incl - nt;
}

template <bool FINAL>
__device__ __forceinline__ void n1_phase(Frame& F, const Args& args, int l) {
    const int gw = (MUT_A ? fbid() : F.vcu) * NWAVES + F.wave, NGW = F.G * NWAVES, lane = flane();
    float* xres = (float*)(F.ws + WS_XRES);
    const float* mod = (const float*)(F.ws + WS_MOD);
    int tprefix = 0, dummy;
    if (l > 0) tprefix = moe_tile_prefix(F.ctl + CW_CNT + (l - 1) * NEXP, lane, dummy);
    for (int rr_ = 0; rr_ < (MUT_D ? 64 : 9); ++rr_) {
        const int row = MUT_D ? (fbid() * 512 + F.wave * 64 + rr_) : (gw + rr_ * NGW); if (row >= MTOK) continue;
        const int b = row / SU, p = row % SU; const int mrow = (p < NCTX) ? 4 : b;
        if (FINAL && p < NCTX) continue;
        f32x4* xr = (f32x4*)(xres + (size_t)row * DM) + lane;
        f32x4 v[4];
#pragma unroll
        for (int j = 0; j < 4; ++j) v[j] = xr[64 * j];
        if (l > 0 && CONTRIB_MOE) {
            {
                unsigned* tiw = (unsigned*)(F.ws + WS_TOKINFO) + (size_t)row * 8;
                u32x4 t0, t1;
                t0.x = __hip_atomic_load(tiw + 0, __ATOMIC_RELAXED, __HIP_MEMORY_SCOPE_AGENT); t0.y = __hip_atomic_load(tiw + 1, __ATOMIC_RELAXED, __HIP_MEMORY_SCOPE_AGENT);
                t0.z = __hip_atomic_load(tiw + 2, __ATOMIC_RELAXED, __HIP_MEMORY_SCOPE_AGENT); t0.w = __hip_atomic_load(tiw + 3, __ATOMIC_RELAXED, __HIP_MEMORY_SCOPE_AGENT);
                t1.x = __hip_atomic_load(tiw + 4, __ATOMIC_RELAXED, __HIP_MEMORY_SCOPE_AGENT); t1.y = __hip_atomic_load(tiw + 5, __ATOMIC_RELAXED, __HIP_MEMORY_SCOPE_AGENT); t1.z = 0u; t1.w = 0u;
                const int ts0 = shidx_i(tprefix, (int)t0.x), ts1 = shidx_i(tprefix, (int)t0.z);
                const size_t s0 = (size_t)ts0 * 256 + t0.y, s1 = (size_t)ts1 * 256 + t0.w;
                const unsigned gb0 = t1.x, gb1 = t1.y;
                const float g0 = __builtin_bit_cast(float, gb0), g1 = __builtin_bit_cast(float, gb1);
                const u32x2* y0 = (const u32x2*)(F.ws + WS_YB + s0 * (DM * 2)) + lane; const u32x2* y1 = (const u32x2*)(F.ws + WS_YB + s1 * (DM * 2)) + lane;
                const f32x4* gp = (const f32x4*)(mod + ((size_t)(l - 1) * 5 + mrow) * 6144 + 5 * DM) + lane;
                if (NAIVE_MOE) {
                    const f32x4* n0 = (const f32x4*)(F.ws + WS_YN + (size_t)row * 2 * DM * 4) + lane; const f32x4* n1 = n0 + 256;
#pragma unroll
                    for (int j = 0; j < 4; ++j) { const f32x4 g = gp[64 * j]; v[j] = v[j] + g * (n0[64 * j] * g0 + n1[64 * j] * g1); }
                } else {
                if (MUT_B) {
                    const bf16_t* yy0 = (const bf16_t*)(F.ws + WS_YB) + s0 * DM; const bf16_t* yy1 = (const bf16_t*)(F.ws + WS_YB) + s1 * DM;
                    const float* gate = mod + ((size_t)(l - 1) * 5 + mrow) * 6144 + 5 * DM;
#pragma unroll
                    for (int j = 0; j < 4; ++j) { const int k = 4 * lane + 256 * j;
                        v[j].x += gate[k] * (g0 * bf2f(yy0[k]) + g1 * bf2f(yy1[k])); v[j].y += gate[k + 1] * (g0 * bf2f(yy0[k + 1]) + g1 * bf2f(yy1[k + 1]));
                        v[j].z += gate[k + 2] * (g0 * bf2f(yy0[k + 2]) + g1 * bf2f(yy1[k + 2])); v[j].w += gate[k + 3] * (g0 * bf2f(yy0[k + 3]) + g1 * bf2f(yy1[k + 3])); }
                } else {
#pragma unroll
                for (int j = 0; j < 4; ++j) { const u32x2 a = y0[64 * j], c = y1[64 * j]; const f32x4 g = gp[64 * j];
                    v[j].x += g.x * (g0 * bflo(a.x) + g1 * bflo(c.x)); v[j].y += g.y * (g0 * bfhi(a.x) + g1 * bfhi(c.x));
                    v[j].z += g.z * (g0 * bflo(a.y) + g1 * bflo(c.y)); v[j].w += g.w * (g0 * bfhi(a.y) + g1 * bfhi(c.y)); }
                }
                }
                if (!FINAL) {
#pragma unroll
                    for (int j = 0; j < 4; ++j) xr[64 * j] = v[j];
                }
            }
        }
        float s = 0.f;
#pragma unroll
        for (int j = 0; j < 4; ++j) s += (v[j].x * v[j].x + v[j].y * v[j].y) + (v[j].z * v[j].z + v[j].w * v[j].w);
        const float rstd = 1.0f / sqrtf(wave_sum(s, lane) * (1.0f / DM) + EPS);
        if (FINAL) {
            const f32x4* nw = (const f32x4*)((const float*)(F.ws + WS_SP) + SP_FNORMW) + lane;
            f32x4* o = (f32x4*)(args.out + ((size_t)b * LSEQ + (p - NCTX)) * DM) + lane;
#pragma unroll
            for (int j = 0; j < 4; ++j) { const f32x4 w = nw[64 * j]; o[64 * j] = v[j] * rstd * w; }
        } else {
            const f32x4* nw = (const f32x4*)(((const float*)(F.ws + WS_SP) + SP_NORMW) + (size_t)(l * 2 + 0) * DM) + lane;
            const f32x4* sh = (const f32x4*)(mod + ((size_t)l * 5 + mrow) * 6144 + 0 * DM) + lane;
            const f32x4* sc = (const f32x4*)(mod + ((size_t)l * 5 + mrow) * 6144 + 1 * DM) + lane;
            u32x2* o = (u32x2*)(F.ws + WS_HB + (size_t)row * (DM * 2)) + lane;
#pragma unroll
            for (int j = 0; j < 4; ++j) { const f32x4 w = nw[64 * j], a = sh[64 * j], c = sc[64 * j]; const f32x4 h = v[j] * rstd * w * (c + 1.0f) + a;
                u32x2 q; q.x = pk2(h.x, h.y); q.y = pk2(h.z, h.w); o[64 * j] = q; }
        }
    }
}

__device__ __forceinline__ void naive_n1(Frame& F, const Args& args, int l, bool final_) {
    float* xres = (float*)(F.ws + WS_XRES);
    const float* mod = (const float*)(F.ws + WS_MOD);
    for (int row = fbid() * 512 + ftid(); row < MTOK; row += F.G * 512) {
        const int b = row / SU, p = row % SU; const int mrow = (p < NCTX) ? 4 : b;
        if (final_ && p < NCTX) continue;
        float* xr = xres + (size_t)row * DM;
        if (l > 0) {
            const unsigned* cnt = F.ctl + CW_CNT + (l - 1) * NEXP;
            const unsigned* ti = (const unsigned*)(F.ws + WS_TOKINFO) + (size_t)row * 8;
            const unsigned e0 = ti[0], p0 = ti[1], e1 = ti[2], p1 = ti[3]; const float g0 = __builtin_bit_cast(float, ti[4]), g1 = __builtin_bit_cast(float, ti[5]);
            int ts0 = 0, ts1 = 0; for (unsigned e = 0; e < e0; ++e) ts0 += ((int)cnt[e] + 255) / 256; for (unsigned e = 0; e < e1; ++e) ts1 += ((int)cnt[e] + 255) / 256;
            const bf16_t* y0 = (const bf16_t*)(F.ws + WS_YB) + ((size_t)ts0 * 256 + p0) * DM; const bf16_t* y1 = (const bf16_t*)(F.ws + WS_YB) + ((size_t)ts1 * 256 + p1) * DM;
            const float* gate = mod + ((size_t)(l - 1) * 5 + mrow) * 6144 + 5 * DM;
            for (int k = 0; k < DM; ++k) xr[k] = xr[k] + gate[k] * (g0 * bf2f(y0[k]) + g1 * bf2f(y1[k]));
        }
        double ss = 0.0; for (int k = 0; k < DM; ++k) ss += (double)xr[k] * xr[k];
        const float rstd = 1.0f / sqrtf((float)(ss / DM) + EPS);
        if (final_) { float* o = args.out + ((size_t)b * LSEQ + (p - NCTX)) * DM; for (int k = 0; k < DM; ++k) o[k] = xr[k] * rstd * args.in[I_FNORMW][k]; }
        else { bf16_t* hb = (bf16_t*)(F.ws + WS_HB) + (size_t)row * DM; const float* nw = args.in[I_NORMW] + (size_t)(l * 2) * DM; const float* mr = mod + ((size_t)l * 5 + mrow) * 6144;
            for (int k = 0; k < DM; ++k) hb[k] = (bf16_t)f2bf(xr[k] * rstd * nw[k] * (1.0f + mr[DM + k]) + mr[k]); }
    }
}
__device__ __forceinline__ void wave_n1(Frame& F, const Args& args, int l, bool final_) {
    float* xres = (float*)(F.ws + WS_XRES);
    const float* mod = (const float*)(F.ws + WS_MOD);
    const int gw = F.vcu * NWAVES + F.wave, NGW = F.G * NWAVES, lane = flane();
    for (int row = gw; row < MTOK; row += NGW) {
        const int b = row / SU, p = row % SU; const int mrow = (p < NCTX) ? 4 : b;
        if (final_ && p < NCTX) continue;
        float* xr = xres + (size_t)row * DM;
        float xv[16];
#pragma unroll
        for (int i = 0; i < 16; ++i) xv[i] = xr[lane + 64 * i];
        if (l > 0) {
            const unsigned* cnt = F.ctl + CW_CNT + (l - 1) * NEXP;
            const unsigned* ti = (const unsigned*)(F.ws + WS_TOKINFO) + (size_t)row * 8;
            const unsigned e0 = ti[0], p0 = ti[1], e1 = ti[2], p1 = ti[3]; const float g0 = __builtin_bit_cast(float, ti[4]), g1 = __builtin_bit_cast(float, ti[5]);
            int ts0 = 0, ts1 = 0; for (unsigned e = 0; e < e0; ++e) ts0 += ((int)cnt[e] + 255) / 256; for (unsigned e = 0; e < e1; ++e) ts1 += ((int)cnt[e] + 255) / 256;
            const bf16_t* y0 = (const bf16_t*)(F.ws + WS_YB) + ((size_t)ts0 * 256 + p0) * DM; const bf16_t* y1 = (const bf16_t*)(F.ws + WS_YB) + ((size_t)ts1 * 256 + p1) * DM;
            const float* gate = mod + ((size_t)(l - 1) * 5 + mrow) * 6144 + 5 * DM;
#pragma unroll
            for (int i = 0; i < 16; ++i) { const int k = lane + 64 * i; xv[i] = xv[i] + gate[k] * (g0 * bf2f(y0[k]) + g1 * bf2f(y1[k])); if (!final_) xr[k] = xv[i]; }
        }
        float ss = 0.f;
#pragma unroll
        for (int i = 0; i < 16; ++i) ss += xv[i] * xv[i];
        const float rstd = 1.0f / sqrtf(wave_sum(ss, lane) * (1.0f / DM) + EPS);
        if (final_) { float* o = args.out + ((size_t)b * LSEQ + (p - NCTX)) * DM;
#pragma unroll
            for (int i = 0; i < 16; ++i) { const int k = lane + 64 * i; o[k] = xv[i] * rstd * args.in[I_FNORMW][k]; } }
        else { bf16_t* hb = (bf16_t*)(F.ws + WS_HB) + (size_t)row * DM; const float* nw = args.in[I_NORMW] + (size_t)(l * 2) * DM; const float* mr = mod + ((size_t)l * 5 + mrow) * 6144;
#pragma unroll
            for (int i = 0; i < 16; ++i) { const int k = lane + 64 * i; hb[k] = (bf16_t)f2bf(xv[i] * rstd * nw[k] * (1.0f + mr[DM + k]) + mr[k]); } }
    }
}
__device__ __forceinline__ void n2r_phase(Frame& F, const Args& args, int l) {
    const int gw = F.vcu * NWAVES + F.wave, NGW = F.G * NWAVES, lane = flane();
    const float* xres = (const float*)(F.ws + WS_XRES);
    const float* mod = (const float*)(F.ws + WS_MOD);
    unsigned* cnt = F.ctl + CW_CNT + l * NEXP;
    unsigned* list = (unsigned*)(F.ws + WS_LIST);
    const float* wg = ((const float*)(F.ws + WS_SP) + SP_WG) + (size_t)l * DM * 4; const float* bg = ((const float*)(F.ws + WS_SP) + SP_BG) + l * 4;
    const float* we = ((const float*)(F.ws + WS_SP) + SP_WE) + (size_t)l * 4 * DM * 8; const float* be = ((const float*)(F.ws + WS_SP) + SP_BE) + l * 32;
    LAS float* wgT = (LAS float*)F.lds; LAS float* weT = wgT + 4 * DM;
    LAS unsigned* hist = (LAS unsigned*)(F.lds + LDSCTL_OFF + 1024); LAS unsigned* baseL = hist + 32; LAS unsigned* rec = hist + 64 + F.wave * 36;
    __syncthreads();
    if (ftid() < 32) hist[ftid()] = 0u;
    {   const int t = ftid();
        for (int r = t; r < DM; r += 512) { const f32x4 a = *(const f32x4*)(wg + (size_t)r * 4); wgT[r] = a.x; wgT[DM + r] = a.y; wgT[2 * DM + r] = a.z; wgT[3 * DM + r] = a.w; }
        for (int r = t; r < 4 * DM; r += 512) { const int g = r >> 10, c = r & 1023; const f32x4 a = *(const f32x4*)(we + (size_t)r * 8), b2 = *(const f32x4*)(we + (size_t)r * 8 + 4);
            LAS float* d = weT + g * 8 * DM + c; d[0] = a.x; d[DM] = a.y; d[2 * DM] = a.z; d[3 * DM] = a.w; d[4 * DM] = b2.x; d[5 * DM] = b2.y; d[6 * DM] = b2.z; d[7 * DM] = b2.w; }
    }
    __syncthreads();
    for (int k_ = 0; k_ < 9; ++k_) {
        const int row = gw + k_ * NGW; if (row >= MTOK) break;
        const int b = row / SU, p = row % SU; const int mrow = (p < NCTX) ? 4 : b;
        if (l == DEPTH - 1 && p < NCTX) continue;
        const f32x4* xr = (const f32x4*)(xres + (size_t)row * DM) + lane;
        f32x4 v[4]; float s = 0.f;
#pragma unroll
        for (int j = 0; j < 4; ++j) { v[j] = xr[64 * j]; s += (v[j].x * v[j].x + v[j].y * v[j].y) + (v[j].z * v[j].z + v[j].w * v[j].w); }
        const float rstd = 1.0f / sqrtf(wave_sum(s, lane) * (1.0f / DM) + EPS);
        const f32x4* nw = (const f32x4*)(((const float*)(F.ws + WS_SP) + SP_NORMW) + (size_t)(l * 2 + 1) * DM) + lane;
        const f32x4* sh = (const f32x4*)(mod + ((size_t)l * 5 + mrow) * 6144 + 3 * DM) + lane;
        const f32x4* sc = (const f32x4*)(mod + ((size_t)l * 5 + mrow) * 6144 + 4 * DM) + lane;
        u32x2* o = (u32x2*)(F.ws + WS_HB + (size_t)row * (DM * 2)) + lane;
        float gl[4] = {0.f, 0.f, 0.f, 0.f};
#pragma unroll
        for (int j = 0; j < 4; ++j) { const f32x4 w = nw[64 * j], a = sh[64 * j], c = sc[64 * j]; const f32x4 h = v[j] * rstd * w * (c + 1.0f) + a; v[j] = h;
            u32x2 q; q.x = pk2(h.x, h.y); q.y = pk2(h.z, h.w); o[64 * j] = q;
#pragma unroll
            for (int g = 0; g < 4; ++g) { const f32x4 wv = *(const LAS f32x4*)(wgT + g * DM + 4 * lane + 256 * j); gl[g] += (h.x * wv.x + h.y * wv.y) + (h.z * wv.z + h.w * wv.w); } }
#pragma unroll
        for (int g = 0; g < 4; ++g) gl[g] = wave_sum(gl[g], lane) + bg[g];
        int gi = 0; float gm = gl[0];
#pragma unroll
        for (int g = 1; g < 4; ++g) if (gl[g] > gm) { gm = gl[g]; gi = g; }
        const float gp = 1.0f / (expf(gl[0] - gm) + expf(gl[1] - gm) + expf(gl[2] - gm) + expf(gl[3] - gm));
        const LAS float* weg = weT + gi * 8 * DM;
        float el[8] = {0.f, 0.f, 0.f, 0.f, 0.f, 0.f, 0.f, 0.f};
#pragma unroll
        for (int j = 0; j < 4; ++j) {
#pragma unroll
            for (int e = 0; e < 8; ++e) { const f32x4 wv = *(const LAS f32x4*)(weg + e * DM + 4 * lane + 256 * j); el[e] += (v[j].x * wv.x + v[j].y * wv.y) + (v[j].z * wv.z + v[j].w * wv.w); }
        }
#pragma unroll
        for (int e = 0; e < 8; ++e) el[e] = wave_sum(el[e], lane) + be[gi * 8 + e];
        int i0 = 0; float v0 = el[0];
#pragma unroll
        for (int e = 1; e < 8; ++e) if (el[e] > v0) { v0 = el[e]; i0 = e; }
        int i1 = -1; float v1 = -3.0e38f;
#pragma unroll
        for (int e = 0; e < 8; ++e) if (e != i0 && el[e] > v1) { v1 = el[e]; i1 = e; }
        const float w0 = 1.0f / (1.0f + expf(v1 - v0)), w1 = 1.0f - w0;
        if (lane == 0) {
            const unsigned e0 = (unsigned)(gi * 8 + i0), e1 = (unsigned)(gi * 8 + i1);
            const unsigned lp0 = __hip_atomic_fetch_add(hist + e0, 1u, __ATOMIC_RELAXED, __HIP_MEMORY_SCOPE_WORKGROUP), lp1 = __hip_atomic_fetch_add(hist + e1, 1u, __ATOMIC_RELAXED, __HIP_MEMORY_SCOPE_WORKGROUP);
            rec[k_ * 4 + 0] = e0; rec[k_ * 4 + 1] = lp0; rec[k_ * 4 + 2] = e1; rec[k_ * 4 + 3] = lp1;
            u32x4* ti = (u32x4*)(F.ws + WS_TOKINFO) + (size_t)row * 2;
            ti[1] = (u32x4){__builtin_bit_cast(unsigned, gp * w0), __builtin_bit_cast(unsigned, gp * w1), 0u, 0u};
        }
    }
    __syncthreads();
    if (ftid() < 32) { const unsigned hc = hist[ftid()]; baseL[ftid()] = hc ? atomicAdd(cnt + ftid(), hc) : 0u; }
    __syncthreads();
    if (lane == 0) {
        for (int k_ = 0; k_ < 9; ++k_) {
            const int row = gw + k_ * NGW; if (row >= MTOK) break;
            if (l == DEPTH - 1 && (row % SU) < NCTX) continue;
            const unsigned e0 = rec[k_ * 4 + 0], e1 = rec[k_ * 4 + 2]; const unsigned p0 = baseL[e0] + rec[k_ * 4 + 1], p1 = baseL[e1] + rec[k_ * 4 + 3];
            list[(size_t)e0 * LIST_CAP + p0] = (unsigned)row; list[(size_t)e1 * LIST_CAP + p1] = (unsigned)row;
            u32x4* ti = (u32x4*)(F.ws + WS_TOKINFO) + (size_t)row * 2;
            ti[0] = (u32x4){e0, p0, e1, p1};
        }
    }
    __syncthreads();
}

__device__ __forceinline__ void naive_n2r(Frame& F, const Args& args, int l) {
    const float* xres = (const float*)(F.ws + WS_XRES);
    const float* mod = (const float*)(F.ws + WS_MOD);
    unsigned* cnt = F.ctl + CW_CNT + l * NEXP;
    unsigned* list = (unsigned*)(F.ws + WS_LIST);
    const float* wg = args.in[I_WG] + (size_t)l * DM * 4; const float* bg = args.in[I_BG] + l * 4;
    const float* we = args.in[I_WE] + (size_t)l * 4 * DM * 8; const float* be = args.in[I_BE] + l * 32;
    for (int row = fbid() * 512 + ftid(); row < MTOK; row += F.G * 512) {
        const int b = row / SU, p = row % SU; const int mrow = (p < NCTX) ? 4 : b;
        if (l == DEPTH - 1 && p < NCTX) continue;
        const float* xr = xres + (size_t)row * DM; double ss = 0.0;
        for (int k = 0; k < DM; ++k) ss += (double)xr[k] * xr[k];
        const float rstd = 1.0f / sqrtf((float)(ss / DM) + EPS);
        const float* nw = args.in[I_NORMW] + (size_t)(l * 2 + 1) * DM; const float* mr = mod + ((size_t)l * 5 + mrow) * 6144;
        bf16_t* hb = (bf16_t*)(F.ws + WS_HB) + (size_t)row * DM;
        float gl[4] = {bg[0], bg[1], bg[2], bg[3]};
        for (int k = 0; k < DM; ++k) { const float h = xr[k] * rstd * nw[k] * (1.0f + mr[4 * DM + k]) + mr[3 * DM + k]; hb[k] = (bf16_t)f2bf(h);
            gl[0] += h * wg[k * 4 + 0]; gl[1] += h * wg[k * 4 + 1]; gl[2] += h * wg[k * 4 + 2]; gl[3] += h * wg[k * 4 + 3]; }
        int gi = 0; for (int g = 1; g < 4; ++g) if (gl[g] > gl[gi]) gi = g;
        float den = 0.f; for (int g = 0; g < 4; ++g) den += expf(gl[g] - gl[gi]);
        const float gp = 1.0f / den;
        float el[8]; for (int e = 0; e < 8; ++e) el[e] = be[gi * 8 + e];
        for (int k = 0; k < DM; ++k) { const float h = xr[k] * rstd * nw[k] * (1.0f + mr[4 * DM + k]) + mr[3 * DM + k]; const float* wr = we + ((size_t)gi * DM + k) * 8;
#pragma unroll
            for (int e = 0; e < 8; ++e) el[e] += h * wr[e]; }
        int i0 = 0; for (int e = 1; e < 8; ++e) if (el[e] > el[i0]) i0 = e;
        int i1 = (i0 == 0) ? 1 : 0; for (int e = 0; e < 8; ++e) if (e != i0 && el[e] > el[i1]) i1 = e;
        const float m2 = el[i0]; const float a0 = 1.0f, a1 = expf(el[i1] - m2); const float w0 = a0 / (a0 + a1), w1 = a1 / (a0 + a1);
        const unsigned e0 = (unsigned)(gi * 8 + i0), e1 = (unsigned)(gi * 8 + i1);
        const unsigned p0 = atomicAdd(cnt + e0, 1u), p1 = atomicAdd(cnt + e1, 1u);
        list[(size_t)e0 * LIST_CAP + p0] = (unsigned)row; list[(size_t)e1 * LIST_CAP + p1] = (unsigned)row;
        u32x4* ti = (u32x4*)(F.ws + WS_TOKINFO) + (size_t)row * 2;
        ti[0] = (u32x4){e0, p0, e1, p1}; ti[1] = (u32x4){__builtin_bit_cast(unsigned, gp * w0), __builtin_bit_cast(unsigned, gp * w1), 0u, 0u};
    }
}

struct EpiProj {
    static constexpr bool PERM = true;
    unsigned char* ws; const float* lb; int odd;
    __device__ __forceinline__ void operator()(const f32x4 (&acc)[2][2][4][2], const pg8::Unit& u, int wr, int wc, int fr, int fq) const {
        const int pmb = u.pm % 17; const bool isctx = (pmb == 0); const int tbase = (pmb - 1) * 256;
        const int g = 4 * wc + fq, half = g >> 3, f0 = 4 * (g & 7);
        const float* ropec = (const float*)(ws + WS_ROPEC); const float* ropes = (const float*)(ws + WS_ROPES);
#pragma unroll
        for (int bj = 0; bj < 2; ++bj) {
            const int hcol = 256 * u.pn + 128 * bj; const int lc0 = hcol + 64 * half + f0;
            if (!odd) {
                const bool rope = !isctx && (hcol < 1024 || (hcol >= 2048 && hcol < 2816));
                const float scale = (hcol >= 512 && hcol < 1024) ? 0.08838834764831845f : 1.0f;
                bf16_t* dst = (bf16_t*)(ws + WS_PE);
#pragma unroll
                for (int ai = 0; ai < 2; ++ai)
#pragma unroll
                    for (int m = 0; m < 4; ++m) {
                        const int rr = 128 * ai + 64 * wr + 16 * m + fr; const size_t row = (size_t)u.pm * 256 + rr;
                        f32x4 x1 = acc[ai][bj][m][0] * scale, x2 = acc[ai][bj][m][1] * scale;
                        if (rope) { const int t = tbase + rr; const int pos = half ? (t & 63) : (t >> 6);
                            const f32x4 c = *(const f32x4*)(ropec + pos * 32 + f0), s = *(const f32x4*)(ropes + pos * 32 + f0);
                            const f32x4 o1 = x1 * c - x2 * s, o2 = x2 * c + x1 * s; x1 = o1; x2 = o2; }
                        u32x2 q1, q2; q1.x = pk2(x1.x, x1.y); q1.y = pk2(x1.z, x1.w); q2.x = pk2(x2.x, x2.y); q2.y = pk2(x2.z, x2.w);
                        *(u32x2*)(dst + row * EV_N + lc0) = q1; *(u32x2*)(dst + row * EV_N + lc0 + 32) = q2;
                    }
            } else {
                const int seg = hcol >> 10, c0 = lc0 & 1023;
                if (seg == 1 || seg == 2) {
                    float* dst = (float*)(ws + (seg == 1 ? WS_FF : WS_FB));
                    const f32x4 l1 = *(const f32x4*)(lb + c0), l2 = *(const f32x4*)(lb + c0 + 32);
#pragma unroll
                    for (int ai = 0; ai < 2; ++ai)
#pragma unroll
                        for (int m = 0; m < 4; ++m) {
                            const size_t row = (size_t)u.pm * 256 + 128 * ai + 64 * wr + 16 * m + fr;
                            const f32x4 z1 = acc[ai][bj][m][0], z2 = acc[ai][bj][m][1]; f32x4 f1, f2;
                            f1.x = l1.x + (1.f - l1.x) / (1.f + __expf(-z1.x)); f1.y = l1.y + (1.f - l1.y) / (1.f + __expf(-z1.y)); f1.z = l1.z + (1.f - l1.z) / (1.f + __expf(-z1.z)); f1.w = l1.w + (1.f - l1.w) / (1.f + __expf(-z1.w));
                            f2.x = l2.x + (1.f - l2.x) / (1.f + __expf(-z2.x)); f2.y = l2.y + (1.f - l2.y) / (1.f + __expf(-z2.y)); f2.z = l2.z + (1.f - l2.z) / (1.f + __expf(-z2.z)); f2.w = l2.w + (1.f - l2.w) / (1.f + __expf(-z2.w));
                            *(f32x4*)(dst + row * DM + c0) = f1; *(f32x4*)(dst + row * DM + c0 + 32) = f2;
                        }
                } else {
                    bf16_t* dst = (bf16_t*)(ws + (seg == 0 ? WS_PQ : (seg == 3 ? WS_PI : WS_PG)));
#pragma unroll
                    for (int ai = 0; ai < 2; ++ai)
#pragma unroll
                        for (int m = 0; m < 4; ++m) {
                            const size_t row = (size_t)u.pm * 256 + 128 * ai + 64 * wr + 16 * m + fr;
                            const f32x4 x1 = acc[ai][bj][m][0], x2 = acc[ai][bj][m][1];
                            u32x2 q1, q2; q1.x = pk2(x1.x, x1.y); q1.y = pk2(x1.z, x1.w); q2.x = pk2(x2.x, x2.y); q2.y = pk2(x2.z, x2.w);
                            *(u32x2*)(dst + row * DM + c0) = q1; *(u32x2*)(dst + row * DM + c0 + 32) = q2;
                        }
                }
            }
        }
    }
};
struct EpiOut {
    static constexpr bool PERM = false;
    float* xres; const float* modl; int enable;
    __device__ __forceinline__ void operator()(const f32x4 (&acc)[2][2][4][2], const pg8::Unit& u, int wr, int wc, int fr, int fq) const {
        if (!enable) return;
        const int pmb = u.pm % 17; const int mrow = (pmb == 0) ? 4 : (u.pm / 17);
        const float* gate = modl + (size_t)mrow * 6144 + 2 * DM;
#pragma unroll
        for (int bj = 0; bj < 2; ++bj)
#pragma unroll
            for (int n = 0; n < 2; ++n) {
                const int c = 256 * u.pn + 128 * bj + 32 * wc + 16 * n + 4 * fq; const f32x4 gv = *(const f32x4*)(gate + c);
#pragma unroll
                for (int ai = 0; ai < 2; ++ai)
#pragma unroll
                    for (int m = 0; m < 4; ++m) { f32x4* p = (f32x4*)(xres + ((size_t)u.pm * 256 + 128 * ai + 64 * wr + 16 * m + fr) * DM + c); *p = *p + gv * acc[ai][bj][m][n]; }
            }
    }
};
struct EpiAct {
    static constexpr bool PERM = true;
    bf16_t* Act;
    __device__ __forceinline__ void operator()(const f32x4 (&acc)[2][2][4][2], const pg8::Unit& u, int wr, int wc, int fr, int fq) const {
#pragma unroll
        for (int bj = 0; bj < 2; ++bj) { const int Gq = 32 * u.pn + 16 * bj + 4 * wc + fq;
#pragma unroll
            for (int ai = 0; ai < 2; ++ai)
#pragma unroll
                for (int m = 0; m < 4; ++m) { const size_t row = (size_t)u.tile * 256 + 128 * ai + 64 * wr + 16 * m + fr;
                    const f32x4 a = acc[ai][bj][m][0], b = acc[ai][bj][m][1];
                    u32x2 q; q.x = pk2(siluf(a.x) * b.x, siluf(a.y) * b.y); q.y = pk2(siluf(a.z) * b.z, siluf(a.w) * b.w);
                    *(u32x2*)(Act + row * FF + 4 * Gq) = q; } }
    }
};
struct EpiY {
    static constexpr bool PERM = true;
    bf16_t* YB;
    __device__ __forceinline__ void operator()(const f32x4 (&acc)[2][2][4][2], const pg8::Unit& u, int wr, int wc, int fr, int fq) const {
#pragma unroll
        for (int bj = 0; bj < 2; ++bj) { const int c = 256 * u.pn + 128 * bj + 32 * wc + 8 * fq;
#pragma unroll
            for (int ai = 0; ai < 2; ++ai)
#pragma unroll
                for (int m = 0; m < 4; ++m) { const size_t row = (size_t)u.tile * 256 + 128 * ai + 64 * wr + 16 * m + fr;
                    const f32x4 a = acc[ai][bj][m][0], b = acc[ai][bj][m][1];
                    u32x4 q; q.x = pk2(a.x, a.y); q.y = pk2(a.z, a.w); q.z = pk2(b.x, b.y); q.w = pk2(b.z, b.w);
                    *(u32x4*)(YB + row * DM + c) = q; } }
    }
};

__device__ __forceinline__ void naive_g1(Frame& F, const Args& args, int l) {
    const int odd = l & 1, p = l >> 1; const int N = odd ? OD_N : EV_N;
    const float* W = (odd ? args.in[I_ODWIN] : args.in[I_EVWIN]) + (size_t)p * DM * N;
    LAS float* sh = (LAS float*)F.lds;
    const float* lb = (const float*)(F.ws + WS_LB) + l * DM;
    const float* ropec = (const float*)(F.ws + WS_ROPEC); const float* ropes = (const float*)(F.ws + WS_ROPES);
    for (int rg = fbid(); rg < MTOK / 8; rg += F.G) {
        __syncthreads();
        if (NAIVE_G1 == 2) {
            const int row = rg * 8 + F.wave; const int bb = row / SU, pp = row % SU; const int mrow = pp < NCTX ? 4 : bb;
            const float* xr = (const float*)(F.ws + WS_XRES) + (size_t)row * DM; float ssq = 0.f;
            for (int k = flane(); k < DM; k += 64) ssq += xr[k] * xr[k];
            ssq = wave_sum(ssq, flane()); const float rs = 1.0f / sqrtf(ssq / (float)DM + EPS);
            const float* modr = (const float*)(F.ws + WS_MOD) + ((size_t)l * 5 + mrow) * 6144;
            for (int k = flane(); k < DM; k += 64) sh[F.wave * DM + k] = xr[k] * rs * args.in[I_NORMW][(size_t)(l * 2) * DM + k] * (1.0f + modr[DM + k]) + modr[k];
        } else
        for (int i = ftid(); i < 8 * DM; i += 512) sh[i] = bf2f(((const bf16_t*)(F.ws + WS_HB))[(size_t)rg * 8 * DM + i]);
        __syncthreads();
        for (int pi = ftid(); pi < N / 2; pi += 512) {
            const int hh = pi >> 6, rem = pi & 63, half = rem >> 5, d = rem & 31; const int cA = 128 * hh + 64 * half + d, cB = cA + 32;
            float a[8], bq[8];
#pragma unroll
            for (int r = 0; r < 8; ++r) { a[r] = 0.f; bq[r] = 0.f; }
            for (int k = 0; k < DM; ++k) { const float wa = W[(size_t)k * N + cA], wb = W[(size_t)k * N + cB];
#pragma unroll
                for (int r = 0; r < 8; ++r) { const float hv = sh[r * DM + k]; a[r] += hv * wa; bq[r] += hv * wb; } }
            const int hcol = 128 * hh;
#pragma unroll
            for (int r = 0; r < 8; ++r) {
                const int row = rg * 8 + r; const int pp = row % SU; const bool isctx = pp < NCTX; const int t = pp - NCTX;
                float x1 = a[r], x2 = bq[r];
                if (!odd) {
                    const bool rope = !isctx && (hcol < 1024 || (hcol >= 2048 && hcol < 2816));
                    if (hcol >= 512 && hcol < 1024) { x1 *= 0.08838834764831845f; x2 *= 0.08838834764831845f; }
                    if (rope) { const int pos = half ? (t & 63) : (t >> 6); float cc = ropec[pos * 32 + d], sn = ropes[pos * 32 + d];
                        if (NAIVE_G1 == 3) { const double ang = (double)((float)pos * powf(10000.0f, -(float)d / 32.0f)); cc = (float)cos(ang); sn = (float)sin(ang); }
                        const float o1 = x1 * cc - x2 * sn, o2 = x2 * cc + x1 * sn; x1 = o1; x2 = o2; }
                    bf16_t* dst = (bf16_t*)(F.ws + WS_PE) + (size_t)row * EV_N; dst[cA] = (bf16_t)f2bf(x1); dst[cB] = (bf16_t)f2bf(x2);
                } else {
                    const int seg = hcol >> 10, c0 = cA & 1023;
                    if (seg == 1 || seg == 2) { float* dst = (float*)(F.ws + (seg == 1 ? WS_FF : WS_FB)) + (size_t)row * DM;
                        float lba = lb[c0], lbb = lb[c0 + 32];
                        if (NAIVE_G1 == 3) { const float* lg = args.in[I_LBLOG]; float ea[4], eb[4], sa = 0.f, sb2 = 0.f; for (int q = 0; q < 4; ++q) { ea[q] = expf(lg[q * DM + c0]); eb[q] = expf(lg[q * DM + c0 + 32]); sa += ea[q]; sb2 += eb[q]; }
                            lba = 0.f; lbb = 0.f; for (int q = 1; q <= l; ++q) { lba += ea[q] / sa; lbb += eb[q] / sb2; } }
                        dst[c0] = lba + (1.f - lba) / (1.f + expf(-x1)); dst[c0 + 32] = lbb + (1.f - lbb) / (1.f + expf(-x2)); }
                    else { bf16_t* dst = (bf16_t*)(F.ws + (seg == 0 ? WS_PQ : (seg == 3 ? WS_PI : WS_PG))) + (size_t)row * DM; dst[c0] = (bf16_t)f2bf(x1); dst[c0 + 32] = (bf16_t)f2bf(x2); }
                }
            }
        }
    }
    __syncthreads();
}

__device__ __forceinline__ void naive_g2(Frame& F, const Args& args, int l) {
    const int odd = l & 1, p = l >> 1;
    const float* W = (odd ? args.in[I_ODWOUT] : args.in[I_EVWOUT]) + (size_t)p * DM * DM;
    LAS float* sh = (LAS float*)F.lds;
    const float* modl = (const float*)(F.ws + WS_MOD) + (size_t)l * 5 * 6144;
    float* xres = (float*)(F.ws + WS_XRES);
    for (int rg = fbid(); rg < MTOK / 8; rg += F.G) {
        __syncthreads();
        for (int i = ftid(); i < 8 * DM; i += 512) sh[i] = bf2f(((const bf16_t*)(F.ws + WS_YB16))[(size_t)rg * 8 * DM + i]);
        __syncthreads();
        for (int col = ftid(); col < DM; col += 512) {
            float a[8];
#pragma unroll
            for (int r = 0; r < 8; ++r) a[r] = 0.f;
            for (int k = 0; k < DM; ++k) { const float wa = W[(size_t)k * DM + col];
#pragma unroll
                for (int r = 0; r < 8; ++r) a[r] += sh[r * DM + k] * wa; }
#pragma unroll
            for (int r = 0; r < 8; ++r) { const int row = rg * 8 + r; const int b = row / SU, pp = row % SU; const int mrow = pp < NCTX ? 4 : b;
                xres[(size_t)row * DM + col] += modl[(size_t)mrow * 6144 + 2 * DM + col] * a[r]; }
        }
    }
    __syncthreads();
}
__device__ __forceinline__ void naive_mod(Frame& F, const Args& args) {
    float* mod = (float*)(F.ws + WS_MOD);
    for (int i = fbid() * 512 + ftid(); i < DEPTH * 5 * 6144; i += F.G * 512) {
        const int col = i % 6144, r = (i / 6144) % 5, l = i / (5 * 6144);
        const float* cv = r < 4 ? args.in[I_C] + r * DM : args.in[I_CCTX];
        const float* w = args.in[I_ADAW] + (size_t)l * DM * 6144 + col;
        float a = 0.f;
        for (int k = 0; k < DM; ++k) { const float v = cv[k]; a += (v / (1.0f + expf(-v))) * w[(size_t)k * 6144]; }
        mod[i] = a + args.in[I_ADAB][l * 6144 + col];
    }
}

__device__ __forceinline__ void naive_moe(Frame& F, const Args& args, int l) {
    LAS float* sh = (LAS float*)F.lds;
    LAS float* sa = sh + 8 * DM;
    LAS int* gstart = (LAS int*)(sa + 8 * FF);
    LAS int* stok = gstart + 40;
    const unsigned* cnt = F.ctl + CW_CNT + l * NEXP;
    const unsigned* list = (const unsigned*)(F.ws + WS_LIST);
    __syncthreads();
    if (ftid() == 0) { int acc = 0; for (int e = 0; e < NEXP; ++e) { gstart[e] = acc; acc += ((int)cnt[e] + 7) / 8; } gstart[NEXP] = acc; }
    __syncthreads();
    const int total = gstart[NEXP];
    float* YN = (float*)(F.ws + WS_YN);
    for (int gi = fbid(); gi < total; gi += F.G) {
        int e = 0; for (int k = 1; k < NEXP; ++k) e += (gstart[k] <= gi) ? 1 : 0;
        const int g = gi - gstart[e]; const int ce = (int)cnt[e];
        __syncthreads();
        if (ftid() < 8) { const int idx = 8 * g + ftid(); stok[ftid()] = idx < ce ? (int)list[(size_t)e * LIST_CAP + idx] : -1; }
        __syncthreads();
        for (int i = ftid(); i < 8 * DM; i += 512) { const int r = i >> 10, k = i & 1023; const int tk = stok[r]; sh[i] = tk >= 0 ? bf2f(((const bf16_t*)(F.ws + WS_HB))[(size_t)tk * DM + k]) : 0.f; }
        __syncthreads();
        const float* w1 = args.in[I_W1] + ((size_t)l * NEXP + e) * DM * FF; const float* w3 = args.in[I_W3] + ((size_t)l * NEXP + e) * DM * FF; const float* w2 = args.in[I_W2] + ((size_t)l * NEXP + e) * FF * DM;
        { const int col = ftid(); float a[8], b[8];
#pragma unroll
            for (int r = 0; r < 8; ++r) { a[r] = 0.f; b[r] = 0.f; }
            for (int k = 0; k < DM; ++k) { const float wa = w1[(size_t)k * FF + col], wb = w3[(size_t)k * FF + col];
#pragma unroll
                for (int r = 0; r < 8; ++r) { const float hv = sh[r * DM + k]; a[r] += hv * wa; b[r] += hv * wb; } }
#pragma unroll
            for (int r = 0; r < 8; ++r) sa[r * FF + col] = (a[r] / (1.0f + expf(-a[r]))) * b[r]; }
        __syncthreads();
        for (int col = ftid(); col < DM; col += 512) { float y[8];
#pragma unroll
            for (int r = 0; r < 8; ++r) y[r] = 0.f;
            for (int k = 0; k < FF; ++k) { const float wv = w2[(size_t)k * DM + col];
#pragma unroll
                for (int r = 0; r < 8; ++r) y[r] += sa[r * FF + k] * wv; }
#pragma unroll
            for (int r = 0; r < 8; ++r) { const int tk = stok[r]; if (tk >= 0) { const unsigned e0 = ((const unsigned*)(F.ws + WS_TOKINFO))[(size_t)tk * 8]; const int kk = (e0 == (unsigned)e) ? 0 : 1;
                YN[((size_t)tk * 2 + kk) * DM + col] = y[r]; } } }
    }
    __syncthreads();
}

constexpr int TLD = 136;
constexpr int TILE_BYTES = 128 * TLD * 2;
template <int NT, int KS>
__device__ __forceinline__ void wave_mma(f32x4 (&acc)[NT], const bf16x8 (&afr)[KS], const LAS bf16_t* Bt, int ldb, int lane) {
    const LAS bf16_t* bp = Bt + (lane & 15) * ldb + 8 * (lane >> 4);
#pragma unroll
    for (int nt = 0; nt < NT; ++nt)
#pragma unroll
        for (int ks = 0; ks < KS; ++ks) { const bf16x8 b = *(const LAS bf16x8*)(bp + nt * 16 * ldb + 32 * ks); acc[nt] = __builtin_amdgcn_mfma_f32_16x16x32_bf16(afr[ks], b, acc[nt], 0, 0, 0);
            if ((ks & 3) == 3 && (nt & 1) == 1) asm volatile("" ::: "memory"); }
}
__device__ __forceinline__ void stage_rowmajor(LAS bf16_t* T, const bf16_t* src, size_t ld, int tid) {
#pragma unroll
    for (int i = 0; i < 4; ++i) { const int q = tid + 512 * i, r = q >> 4, cc = q & 15; const u32x4 v = *(const u32x4*)(src + (size_t)r * ld + 8 * cc); *(LAS u32x4*)(T + r * TLD + 8 * cc) = v; }
}
__device__ __forceinline__ void stage_transposed(LAS bf16_t* T, const bf16_t* src, size_t ld, int tid, bool scaled, float sa, float sb) {
#pragma unroll
    for (int i = 0; i < 4; ++i) { const int q = tid + 512 * i, r = q >> 4, cc = q & 15; const u32x4 v = *(const u32x4*)(src + (size_t)r * ld + 8 * cc);
        const unsigned w[4] = {v.x, v.y, v.z, v.w};
        if (scaled) { const float sc = exp2f(sa * (float)r + sb);
#pragma unroll
            for (int k = 0; k < 4; ++k) { T[(8 * cc + 2 * k) * TLD + r] = (bf16_t)f2bf(bflo(w[k]) * sc); T[(8 * cc + 2 * k + 1) * TLD + r] = (bf16_t)f2bf(bfhi(w[k]) * sc); }
        } else {
#pragma unroll
            for (int k = 0; k < 4; ++k) { T[(8 * cc + 2 * k) * TLD + r] = (bf16_t)(w[k] & 0xffffu); T[(8 * cc + 2 * k + 1) * TLD + r] = (bf16_t)(w[k] >> 16); }
        }
    }
}
__device__ __forceinline__ void stage_f32_rowmajor(LAS bf16_t* T, const float* src, int tid) {
#pragma unroll
    for (int i = 0; i < 8; ++i) { const int q = tid + 512 * i, r = q >> 5, cc = q & 31; const f32x4 v = *(const f32x4*)(src + (size_t)r * 128 + 4 * cc);
        u32x2 o; o.x = pk2(v.x, v.y); o.y = pk2(v.z, v.w); *(LAS u32x2*)(T + r * TLD + 4 * cc) = o; }
}
__device__ __forceinline__ float log2_gamma_f(const Frame& F, int p, int dir, int h) { return -expf(((const float*)(F.ws + WS_SP) + SP_DECAY)[(p * 2 + dir) * 4 + h]) * 1.4426950408889634f; }
#define log2_gamma(args, p, dir, h) log2_gamma_f(F, p, dir, h)

__device__ __forceinline__ void ret_state_item(Frame& F, const Args& args, int p, int item) {
    const int c = item % NCHUNK, h = (item / NCHUNK) & 3, b = item / (NCHUNK * 4);
    int tid = ftid(); asm volatile("" : "+v"(tid)); const int lane = tid & 63, w = F.wave;
    LAS bf16_t* T0 = (LAS bf16_t*)F.lds; LAS bf16_t* T1 = (LAS bf16_t*)(F.lds + TILE_BYTES); LAS bf16_t* T2 = (LAS bf16_t*)(F.lds + 2 * TILE_BYTES);
    const bf16_t* pe = (const bf16_t*)(F.ws + WS_PE) + ((size_t)b * SU + 128 * c) * EV_N;
    const float lgf = log2_gamma(args, p, 0, h), lgb = log2_gamma(args, p, 1, h);
    __syncthreads();
    stage_transposed(T0, pe + 512 + h * 128, EV_N, tid, false, 0.f, 0.f);
    stage_transposed(T1, pe + 1024 + h * 128, EV_N, tid, true, -lgf, 127.f * lgf);
    stage_transposed(T2, pe + 1024 + h * 128, EV_N, tid, true, lgb, 0.f);
    __syncthreads();
    float* st = (float*)(F.ws + WS_ST);
#pragma unroll
    for (int dir = 0; dir < 2; ++dir) {
        const LAS bf16_t* VT = dir ? T2 : T1;
        bf16x8 afr[4];
#pragma unroll
        for (int ks = 0; ks < 4; ++ks) afr[ks] = *(const LAS bf16x8*)(VT + (16 * w + (lane & 15)) * TLD + 32 * ks + 8 * (lane >> 4));
        f32x4 acc[8];
#pragma unroll
        for (int nt = 0; nt < 8; ++nt) acc[nt] = (f32x4){0.f, 0.f, 0.f, 0.f};
        wave_mma<8, 4>(acc, afr, T0, TLD, lane);
        float* dst = st + ((((size_t)(b * 4 + h) * 2 + dir) * NCHUNK + c) * 128) * 128;
#pragma unroll
        for (int nt = 0; nt < 8; ++nt)
#pragma unroll
            for (int j = 0; j < 4; ++j) dst[(size_t)(16 * w + 4 * (lane >> 4) + j) * 128 + 16 * nt + (lane & 15)] = acc[nt][j];
    }
}
__device__ __forceinline__ void ret_scan_phase(Frame& F, const Args& args, int p) {
    f32x4* st = (f32x4*)(F.ws + WS_ST);
    for (int i = fbid() * 512 + ftid(); i < 32 * 4096; i += F.G * 512) {
        const int bhd = i >> 12, el = i & 4095; const int dir = bhd & 1, h = (bhd >> 1) & 3;
        const float g128 = exp2f(128.f * log2_gamma(args, p, dir, h));
        f32x4* base = st + (size_t)bhd * NCHUNK * 4096 + el;
        f32x4 s = (f32x4){0.f, 0.f, 0.f, 0.f};
        for (int k = 0; k < NCHUNK; ++k) {
            const int c = dir == 0 ? k : (k < 2 ? 1 - k : NCHUNK + 1 - k);
            const f32x4 u = base[(size_t)c * 4096]; base[(size_t)c * 4096] = s; s = s * g128 + u;
        }
    }
}
__device__ __forceinline__ bf16x8 scale_frag(const bf16x8 a, float sc) {
    bf16x8 r;
#pragma unroll
    for (int k = 0; k < 8; ++k) r[k] = (short)f2bf(bf2f((unsigned)(unsigned short)a[k]) * sc);
    return r;
}
__device__ __forceinline__ void ret_out_item(Frame& F, const Args& args, int p, int item) {
    const int c = item % NCHUNK, h = (item / NCHUNK) & 3, b = item / (NCHUNK * 4);
    int tid = ftid(); asm volatile("" : "+v"(tid)); const int lane = tid & 63, w = F.wave, quad = lane >> 4, l15 = lane & 15;
    LAS bf16_t* T0 = (LAS bf16_t*)F.lds; LAS bf16_t* T1 = (LAS bf16_t*)(F.lds + TILE_BYTES); LAS bf16_t* T2 = (LAS bf16_t*)(F.lds + 2 * TILE_BYTES);
    const size_t row0 = (size_t)b * SU + 128 * c;
    const bf16_t* pe = (const bf16_t*)(F.ws + WS_PE) + row0 * EV_N;
    const float lgf = log2_gamma(args, p, 0, h), lgb = log2_gamma(args, p, 1, h);
    const float* stf = (const float*)(F.ws + WS_ST) + ((((size_t)(b * 4 + h) * 2 + 0) * NCHUNK + c) * 128) * 128;
    const float* stb = (const float*)(F.ws + WS_ST) + ((((size_t)(b * 4 + h) * 2 + 1) * NCHUNK + c) * 128) * 128;
    bf16x8 qf[4];
#pragma unroll
    for (int ks = 0; ks < 4; ++ks) qf[ks] = *(const bf16x8*)(pe + (size_t)(16 * w + l15) * EV_N + h * 128 + 32 * ks + 8 * quad);
    __syncthreads();
    stage_rowmajor(T0, pe + 512 + h * 128, EV_N, tid);
    stage_transposed(T1, pe + 1024 + h * 128, EV_N, tid, false, 0.f, 0.f);
    stage_f32_rowmajor(T2, stf, tid);
    __syncthreads();
    f32x4 ao[8];
#pragma unroll
    for (int nt = 0; nt < 8; ++nt) ao[nt] = (f32x4){0.f, 0.f, 0.f, 0.f};
    {
        const float cf = exp2f(lgf * (float)(16 * w + l15 + 1));
        bf16x8 qs[4];
#pragma unroll
        for (int ks = 0; ks < 4; ++ks) qs[ks] = scale_frag(qf[ks], cf);
        wave_mma<8, 4>(ao, qs, T2, TLD, lane);
    }
    {
        f32x4 aw[8];
#pragma unroll
        for (int nt = 0; nt < 8; ++nt) aw[nt] = (f32x4){0.f, 0.f, 0.f, 0.f};
        wave_mma<8, 4>(aw, qf, T0, TLD, lane);
        __syncthreads();
#pragma unroll
        for (int nt = 0; nt < 8; ++nt)
#pragma unroll
            for (int j = 0; j < 4; ++j) { const int i = 16 * w + 4 * quad + j, jj = 16 * nt + l15; const int d = i - jj;
                const float dec = d > 0 ? exp2f(lgf * (float)d) : (d < 0 ? exp2f(lgb * (float)(-d)) : 2.0f);
                T0[i * TLD + jj] = (bf16_t)f2bf(aw[nt][j] * dec); }
    }
    stage_f32_rowmajor(T2, stb, tid);
    __syncthreads();
    {
        bf16x8 pf[4];
#pragma unroll
        for (int ks = 0; ks < 4; ++ks) pf[ks] = *(const LAS bf16x8*)(T0 + (16 * w + l15) * TLD + 32 * ks + 8 * quad);
        wave_mma<8, 4>(ao, pf, T1, TLD, lane);
        const float cb = exp2f(lgb * (float)(128 - (16 * w + l15)));
#pragma unroll
        for (int ks = 0; ks < 4; ++ks) pf[ks] = scale_frag(qf[ks], cb);
        wave_mma<8, 4>(ao, pf, T2, TLD, lane);
    }
    bf16_t* yb = (bf16_t*)(F.ws + WS_YB16);
#pragma unroll
    for (int j = 0; j < 4; ++j) { const int i = 16 * w + 4 * quad + j;
        float ss = 0.f;
#pragma unroll
        for (int nt = 0; nt < 8; ++nt) ss += ao[nt][j] * ao[nt][j];
        ss += shx(ss, 1, lane); ss += shx(ss, 2, lane); ss += shx(ss, 4, lane); ss += shx(ss, 8, lane);
        const float rstd = 1.0f / sqrtf(ss * (1.0f / 128.f) + EPS);
        const bf16_t* gp = pe + (size_t)i * EV_N + 1536 + h * 128;
#pragma unroll
        for (int nt = 0; nt < 8; ++nt) { const float gt = bf2f(gp[16 * nt + l15]); yb[(row0 + i) * DM + h * 128 + 16 * nt + l15] = ABL_RET0 ? (bf16_t)0 : (bf16_t)f2bf(siluf(gt) * ao[nt][j] * rstd); }
    }
}
__device__ __forceinline__ void ret_direct_item(Frame& F, const Args& args, int p, int item) {
    const int c = item % NCHUNK, h = (item / NCHUNK) & 3, b = item / (NCHUNK * 4);
    int tid = ftid(); asm volatile("" : "+v"(tid)); const int lane = tid & 63, w = F.wave, quad = lane >> 4, l15 = lane & 15;
    LAS bf16_t* T0 = (LAS bf16_t*)F.lds; LAS bf16_t* T1 = (LAS bf16_t*)(F.lds + TILE_BYTES); LAS bf16_t* T2 = (LAS bf16_t*)(F.lds + 2 * TILE_BYTES);
    const size_t row0 = (size_t)b * SU + 128 * c;
    const bf16_t* peb = (const bf16_t*)(F.ws + WS_PE) + (size_t)b * SU * EV_N;
    const bf16_t* pe = peb + (size_t)128 * c * EV_N;
    const float lgf = log2_gamma(args, p, 0, h), lgb = log2_gamma(args, p, 1, h);
    bf16x8 qf[4];
#pragma unroll
    for (int ks = 0; ks < 4; ++ks) qf[ks] = *(const bf16x8*)(pe + (size_t)(16 * w + l15) * EV_N + h * 128 + 32 * ks + 8 * quad);
    f32x4 ao[8];
#pragma unroll
    for (int nt = 0; nt < 8; ++nt) ao[nt] = (f32x4){0.f, 0.f, 0.f, 0.f};
    for (int c2 = 0; c2 < NCHUNK; ++c2) {
        __syncthreads();
        stage_rowmajor(T0, peb + (size_t)128 * c2 * EV_N + 512 + h * 128, EV_N, tid);
        stage_transposed(T1, peb + (size_t)128 * c2 * EV_N + 1024 + h * 128, EV_N, tid, false, 0.f, 0.f);
        __syncthreads();
        f32x4 aw[8];
#pragma unroll
        for (int nt = 0; nt < 8; ++nt) aw[nt] = (f32x4){0.f, 0.f, 0.f, 0.f};
        wave_mma<8, 4>(aw, qf, T0, TLD, lane);
#pragma unroll
        for (int nt = 0; nt < 8; ++nt)
#pragma unroll
            for (int j = 0; j < 4; ++j) { const int i = 16 * w + 4 * quad + j, jj = 16 * nt + l15;
                const int px = 128 * c + i, py = 128 * c2 + jj;
                const int ubx = px < NCTX ? NCTX - 1 - px : SU + NCTX - 1 - px, uby = py < NCTX ? NCTX - 1 - py : SU + NCTX - 1 - py;
                float dec = 0.f;
                if (py <= px && !(px >= NCTX && false)) dec += exp2f(lgf * (float)(px - py));
                if (uby <= ubx) dec += exp2f(lgb * (float)(ubx - uby));
                if (px < NCTX && py >= NCTX) dec = 0.f;
                T2[i * TLD + jj] = (bf16_t)f2bf(aw[nt][j] * dec); }
        LDS_WAIT(); asm volatile("" ::: "memory");
        bf16x8 pf[4];
#pragma unroll
        for (int ks = 0; ks < 4; ++ks) pf[ks] = *(const LAS bf16x8*)(T2 + (16 * w + l15) * TLD + 32 * ks + 8 * quad);
        wave_mma<8, 4>(ao, pf, T1, TLD, lane);
    }
    bf16_t* yb = (bf16_t*)(F.ws + WS_YB16);
#pragma unroll
    for (int j = 0; j < 4; ++j) { const int i = 16 * w + 4 * quad + j;
        float ss = 0.f;
#pragma unroll
        for (int nt = 0; nt < 8; ++nt) ss += ao[nt][j] * ao[nt][j];
        ss += shx(ss, 1, lane); ss += shx(ss, 2, lane); ss += shx(ss, 4, lane); ss += shx(ss, 8, lane);
        const float rstd = 1.0f / sqrtf(ss * (1.0f / 128.f) + EPS);
        const bf16_t* gp = pe + (size_t)i * EV_N + 1536 + h * 128;
#pragma unroll
        for (int nt = 0; nt < 8; ++nt) { const float gt = bf2f(gp[16 * nt + l15]); yb[(row0 + i) * DM + h * 128 + 16 * nt + l15] = (bf16_t)f2bf(siluf(gt) * ao[nt][j] * rstd); }
    }
}
__device__ __forceinline__ void att_item(Frame& F, const Args& args, int p, int item) {
    const int qb = item % NCHUNK, hk = (item / NCHUNK) & 1, b = item / (NCHUNK * 2);
    int tid = ftid(); asm volatile("" : "+v"(tid)); const int lane = tid & 63, w = F.wave, quad = lane >> 4, l15 = lane & 15;
    const int g = w >> 2, hq = 2 * hk + g, qr0 = 32 * (w & 3);
    LAS bf16_t* T0 = (LAS bf16_t*)F.lds; LAS bf16_t* T1 = (LAS bf16_t*)(F.lds + TILE_BYTES);
    LAS bf16_t* Pw = (LAS bf16_t*)(F.lds + 2 * TILE_BYTES) + w * 32 * TLD;
    const bf16_t* peb = (const bf16_t*)(F.ws + WS_PE) + (size_t)b * SU * EV_N;
    const size_t qrow0 = (size_t)128 * qb + qr0;
    bf16x8 qf[2][4];
#pragma unroll
    for (int rt = 0; rt < 2; ++rt)
#pragma unroll
        for (int ks = 0; ks < 4; ++ks) qf[rt][ks] = *(const bf16x8*)(peb + (qrow0 + 16 * rt + l15) * EV_N + 2048 + hq * 128 + 32 * ks + 8 * quad);
    const float sink = ((const float*)(F.ws + WS_SP) + SP_SINK)[p * 4 + hq];
    const float scale = 0.08838834764831845f;
    float mrow[2][4], lrow[2][4]; f32x4 ao[2][8];
#pragma unroll
    for (int rt = 0; rt < 2; ++rt) {
#pragma unroll
        for (int j = 0; j < 4; ++j) { mrow[rt][j] = sink; lrow[rt][j] = 1.0f; }
#pragma unroll
        for (int nt = 0; nt < 8; ++nt) ao[rt][nt] = (f32x4){0.f, 0.f, 0.f, 0.f};
    }
    const int ntile = (qb < 2) ? 2 : 5;
    for (int ti = 0; ti < ntile; ++ti) {
        int kt, mode = 0;
        if (ti < 2) kt = ti; else { kt = qb + (ti - 3); mode = (ti == 2) ? 1 : (ti == 4 ? 2 : 0); }
        if (ti >= 2 && (kt < 2 || kt >= NCHUNK)) continue;
        __syncthreads();
        stage_rowmajor(T0, peb + (size_t)128 * kt * EV_N + 2560 + hk * 128, EV_N, tid);
        stage_transposed(T1, peb + (size_t)128 * kt * EV_N + 2816 + hk * 128, EV_N, tid, false, 0.f, 0.f);
        __syncthreads();
#pragma unroll
        for (int rt = 0; rt < 2; ++rt) {
            f32x4 s[8];
#pragma unroll
            for (int nt = 0; nt < 8; ++nt) s[nt] = (f32x4){0.f, 0.f, 0.f, 0.f};
            wave_mma<8, 4>(s, qf[rt], T0, TLD, lane);
#pragma unroll
            for (int j = 0; j < 4; ++j) {
                const int qq = qr0 + 16 * rt + 4 * quad + j;
                float mx = -3.0e38f;
#pragma unroll
                for (int nt = 0; nt < 8; ++nt) { const int kk = 16 * nt + l15; float v = s[nt][j] * scale;
                    const bool valid = (mode == 0) || (mode == 1 ? (kk >= qq) : (kk <= qq));
                    v = valid ? v : -3.0e38f; s[nt][j] = v; mx = fmaxf(mx, v); }
                mx = fmaxf(mx, shx(mx, 1, lane)); mx = fmaxf(mx, shx(mx, 2, lane)); mx = fmaxf(mx, shx(mx, 4, lane)); mx = fmaxf(mx, shx(mx, 8, lane));
                const float mn = fmaxf(mrow[rt][j], mx); const float alpha = __expf(mrow[rt][j] - mn);
                float rs = 0.f;
#pragma unroll
                for (int nt = 0; nt < 8; ++nt) { const float pv = (s[nt][j] > -1.0e38f) ? __expf(s[nt][j] - mn) : 0.f; rs += pv; Pw[(16 * rt + 4 * quad + j) * TLD + 16 * nt + l15] = (bf16_t)f2bf(pv); }
                rs += shx(rs, 1, lane); rs += shx(rs, 2, lane); rs += shx(rs, 4, lane); rs += shx(rs, 8, lane);
                lrow[rt][j] = lrow[rt][j] * alpha + rs; mrow[rt][j] = mn;
#pragma unroll
                for (int nt = 0; nt < 8; ++nt) ao[rt][nt][j] *= alpha;
            }
        }
        LDS_WAIT(); asm volatile("" ::: "memory");
#pragma unroll
        for (int rt = 0; rt < 2; ++rt) {
            bf16x8 pf[4];
#pragma unroll
            for (int ks = 0; ks < 4; ++ks) pf[ks] = *(const LAS bf16x8*)(Pw + (16 * rt + l15) * TLD + 32 * ks + 8 * quad);
            wave_mma<8, 4>(ao[rt], pf, T1, TLD, lane);
        }
    }
    bf16_t* yb = (bf16_t*)(F.ws + WS_YB16) + ((size_t)b * SU + qrow0) * DM + 512 + hq * 128;
#pragma unroll
    for (int rt = 0; rt < 2; ++rt)
#pragma unroll
        for (int j = 0; j < 4; ++j) { const float inv = 1.0f / lrow[rt][j];
#pragma unroll
            for (int nt = 0; nt < 8; ++nt) yb[(size_t)(16 * rt + 4 * quad + j) * DM + 16 * nt + l15] = ABL_ATT0 ? (bf16_t)0 : (bf16_t)f2bf(ao[rt][nt][j] * inv); }
}
__device__ __forceinline__ void naive_att(Frame& F, const Args& args, int p) {
    const int gw = F.vcu * NWAVES + F.wave, NGW = F.G * NWAVES, lane = flane();
    LAS float* sq = (LAS float*)F.lds + F.wave * 1024;
    LAS float* sc = sq + 128;
    const bf16_t* pe = (const bf16_t*)(F.ws + WS_PE);
    for (int task = gw; task < MTOK * 4; task += NGW) {
        const int row = task >> 2, hq = task & 3, hk = hq >> 1; const int b = row / SU, pq = row % SU;
        const bf16_t* peb = pe + (size_t)b * SU * EV_N;
        sq[lane] = bf2f(peb[(size_t)pq * EV_N + 2048 + hq * 128 + lane]) * 0.08838834764831845f; sq[lane + 64] = bf2f(peb[(size_t)pq * EV_N + 2048 + hq * 128 + lane + 64]) * 0.08838834764831845f;
        LDS_WAIT(); asm volatile("" ::: "memory");
        int lo = 0, nloc = 0;
        if (pq >= NCTX) { const int t = pq - NCTX; lo = t - 128 < 0 ? 0 : t - 128; const int hi = t + 128 > LSEQ - 1 ? LSEQ - 1 : t + 128; nloc = hi - lo + 1; }
        const int nk = NCTX + nloc;
        const float sink = args.in[I_SINK][p * 4 + hq];
        float mx = sink;
        for (int ki = lane; ki < nk; ki += 64) { const int kp = ki < NCTX ? ki : NCTX + lo + (ki - NCTX);
            const bf16_t* kr = peb + (size_t)kp * EV_N + 2560 + hk * 128; float d = 0.f;
            for (int x = 0; x < 128; ++x) d += sq[x] * bf2f(kr[x]);
            sc[ki] = d; mx = fmaxf(mx, d); }
#pragma unroll
        for (int o = 1; o < 64; o <<= 1) mx = fmaxf(mx, shx(mx, o, lane));
        float sum = 0.f;
        for (int ki = lane; ki < nk; ki += 64) { const float e = expf(sc[ki] - mx); sc[ki] = e; sum += e; }
        sum = wave_sum(sum, lane) + expf(sink - mx);
        LDS_WAIT(); asm volatile("" ::: "memory");
        float o0 = 0.f, o1 = 0.f;
        for (int ki = 0; ki < nk; ++ki) { const int kp = ki < NCTX ? ki : NCTX + lo + (ki - NCTX); const bf16_t* vr = peb + (size_t)kp * EV_N + 2816 + hk * 128; const float pv = sc[ki];
            o0 += pv * bf2f(vr[lane]); o1 += pv * bf2f(vr[lane + 64]); }
        bf16_t* yb = (bf16_t*)(F.ws + WS_YB16) + (size_t)row * DM + 512 + hq * 128;
        yb[lane] = (bf16_t)f2bf(o0 / sum); yb[lane + 64] = (bf16_t)f2bf(o1 / sum);
        LDS_WAIT(); asm volatile("" ::: "memory");
    }
}
__device__ __forceinline__ void hg_scan_item_plain(Frame& F, int item) {
    const int es = item & 3, dir = (item >> 2) & 1, h = (item >> 3) & 7, b = item >> 6;
    const int tid = ftid(), e = tid & 31, dg = tid >> 5;
    LAS float* sP = (LAS float*)F.lds;
    LAS float* sIn = sP + 32 * 16 * 32;
    constexpr int INB = 32 * 128 * 2 + 32 * 32;
    const float* fsrc = (const float*)(F.ws + (dir ? WS_FB : WS_FF));
    const bf16_t* qsrc = (const bf16_t*)(F.ws + WS_PQ); const bf16_t* vsrc = (const bf16_t*)(F.ws + WS_PI);
    float* osrc = (float*)(F.ws + (dir ? WS_OB : WS_OF));
    float S[8];
#pragma unroll
    for (int k = 0; k < 8; ++k) S[k] = 0.f;
    const size_t rb = (size_t)b * SU;
    f32x4 rf0, rf1; u32x4 rq, rv;
    auto pos_of = [&](int s) { return dir ? (s < NCTX ? NCTX - 1 - s : SU + NCTX - 1 - s) : s; };
#define HG_ISSUE(s0_) do { const int pA = pos_of((s0_) + (tid >> 5)), pB = pos_of((s0_) + 16 + (tid >> 5)), pQ = pos_of((s0_) + (tid >> 4)); \
        rf0 = *(const f32x4*)(fsrc + (rb + pA) * DM + h * 128 + 4 * (tid & 31)); rf1 = *(const f32x4*)(fsrc + (rb + pB) * DM + h * 128 + 4 * (tid & 31)); \
        rq = *(const u32x4*)(qsrc + (rb + pQ) * DM + h * 128 + 8 * (tid & 15)); \
        if (tid < 128) { const int pV = pos_of((s0_) + (tid >> 2)); rv = *(const u32x4*)(vsrc + (rb + pV) * DM + h * 128 + 32 * es + 8 * (tid & 3)); } } while (0)
#define HG_WRITE(buf_) do { LAS float* bF = sIn + (buf_) * INB; LAS float* bQ = bF + 32 * 128; LAS float* bV = bQ + 32 * 128; \
        *(LAS f32x4*)(bF + (tid >> 5) * 128 + 4 * (tid & 31)) = rf0; *(LAS f32x4*)(bF + (16 + (tid >> 5)) * 128 + 4 * (tid & 31)) = rf1; \
        { LAS float* d = bQ + (tid >> 4) * 128 + 8 * (tid & 15); *(LAS f32x4*)d = (f32x4){bflo(rq.x), bfhi(rq.x), bflo(rq.y), bfhi(rq.y)}; *(LAS f32x4*)(d + 4) = (f32x4){bflo(rq.z), bfhi(rq.z), bflo(rq.w), bfhi(rq.w)}; } \
        if (tid < 128) { LAS float* d = bV + (tid >> 2) * 32 + 8 * (tid & 3); *(LAS f32x4*)d = (f32x4){bflo(rv.x), bfhi(rv.x), bflo(rv.y), bfhi(rv.y)}; *(LAS f32x4*)(d + 4) = (f32x4){bflo(rv.z), bfhi(rv.z), bflo(rv.w), bfhi(rv.w)}; } } while (0)
    __syncthreads();
    HG_ISSUE(0); HG_WRITE(0);
    __syncthreads();
    constexpr int NTB = SU / 32;
    for (int tb = 0; tb < NTB; ++tb) {
        const int s0 = 32 * tb, cur = tb & 1;
        if (tb + 1 < NTB) HG_ISSUE(s0 + 32);
        const LAS float* sF = sIn + cur * INB; const LAS float* sQ = sF + 32 * 128; const LAS float* sV = sQ + 32 * 128;
#pragma unroll 4
        for (int tt = 0; tt < 32; ++tt) {
            const f32x4 f0 = *(const LAS f32x4*)(sF + tt * 128 + 8 * dg), f1 = *(const LAS f32x4*)(sF + tt * 128 + 8 * dg + 4);
            const f32x4 q0 = *(const LAS f32x4*)(sQ + tt * 128 + 8 * dg), q1 = *(const LAS f32x4*)(sQ + tt * 128 + 8 * dg + 4);
            const float v = sV[tt * 32 + e];
            const float ff[8] = {f0.x, f0.y, f0.z, f0.w, f1.x, f1.y, f1.z, f1.w}; const float qq[8] = {q0.x, q0.y, q0.z, q0.w, q1.x, q1.y, q1.z, q1.w};
            float part = 0.f;
#pragma unroll
            for (int k = 0; k < 8; ++k) { S[k] = ff[k] * S[k] + (1.0f - ff[k]) * v; part += qq[k] * S[k]; }
            sP[(tt * 16 + dg) * 32 + e] = part;
        }
        __syncthreads();
#pragma unroll
        for (int i = 0; i < 2; ++i) { const int q = tid + 512 * i, tt = q >> 5, ee = q & 31; float o = 0.f;
#pragma unroll
            for (int k = 0; k < 16; ++k) o += sP[(tt * 16 + k) * 32 + ee];
            osrc[(rb + pos_of(s0 + tt)) * DM + h * 128 + 32 * es + ee] = o; }
        if (tb + 1 < NTB) HG_WRITE(cur ^ 1);
        __syncthreads();
    }
#undef HG_ISSUE
#undef HG_WRITE
}
__device__ __forceinline__ void hg_scan_item_c16(Frame& F, int item) {
    const int es = item & 3, dir = (item >> 2) & 1, h = (item >> 3) & 7, b = item >> 6;
    const int tid = ftid(), lane = tid & 63, w = F.wave, quad = lane >> 4, l15 = lane & 15;
    constexpr int INB = 32 * 128 * 2 + 32 * 32;
    LAS float* sIn = (LAS float*)F.lds;
    LAS bf16_t* QA = (LAS bf16_t*)(sIn + 2 * INB);
    LAS bf16_t* KB = QA + 2 * 16 * 136;
    LAS bf16_t* KC = KB + 2 * 16 * 136;
    LAS bf16_t* VT = KC + 2 * 128 * 40;
    LAS bf16_t* PP = VT + 2 * 32 * 40;
    LAS bf16_t* ST = PP + 2 * 16 * 40;
    LAS float* DEC = (LAS float*)(ST + 32 * 136);
    const float* fsrc = (const float*)(F.ws + (dir ? WS_FB : WS_FF));
    const bf16_t* qsrc = (const bf16_t*)(F.ws + WS_PQ); const bf16_t* vsrc = (const bf16_t*)(F.ws + WS_PI);
    float* osrc = (float*)(F.ws + (dir ? WS_OB : WS_OF));
    const size_t rb = (size_t)b * SU;
    f32x4 S[2] = {(f32x4){0.f, 0.f, 0.f, 0.f}, (f32x4){0.f, 0.f, 0.f, 0.f}};
    f32x4 rf0, rf1; u32x4 rq, rv;
    auto pos_of = [&](int s) { return dir ? (s < NCTX ? NCTX - 1 - s : SU + NCTX - 1 - s) : s; };
#define HG_ISSUE(s0_) do { const int pA = pos_of((s0_) + (tid >> 5)), pB = pos_of((s0_) + 16 + (tid >> 5)), pQ = pos_of((s0_) + (tid >> 4)); \
        rf0 = *(const f32x4*)(fsrc + (rb + pA) * DM + h * 128 + 4 * (tid & 31)); rf1 = *(const f32x4*)(fsrc + (rb + pB) * DM + h * 128 + 4 * (tid & 31)); \
        rq = *(const u32x4*)(qsrc + (rb + pQ) * DM + h * 128 + 8 * (tid & 15)); \
        if (tid < 128) { const int pV = pos_of((s0_) + (tid >> 2)); rv = *(const u32x4*)(vsrc + (rb + pV) * DM + h * 128 + 32 * es + 8 * (tid & 3)); } } while (0)
#define HG_WRITE(buf_) do { LAS float* bF = sIn + (buf_) * INB; LAS float* bQ = bF + 32 * 128; LAS float* bV = bQ + 32 * 128; \
        *(LAS f32x4*)(bF + (tid >> 5) * 128 + 4 * (tid & 31)) = rf0; *(LAS f32x4*)(bF + (16 + (tid >> 5)) * 128 + 4 * (tid & 31)) = rf1; \
        { LAS float* d = bQ + (tid >> 4) * 128 + 8 * (tid & 15); *(LAS f32x4*)d = (f32x4){bflo(rq.x), bfhi(rq.x), bflo(rq.y), bfhi(rq.y)}; *(LAS f32x4*)(d + 4) = (f32x4){bflo(rq.z), bfhi(rq.z), bflo(rq.w), bfhi(rq.w)}; } \
        if (tid < 128) { LAS float* d = bV + (tid >> 2) * 32 + 8 * (tid & 3); *(LAS f32x4*)d = (f32x4){bflo(rv.x), bfhi(rv.x), bflo(rv.y), bfhi(rv.y)}; *(LAS f32x4*)(d + 4) = (f32x4){bflo(rv.z), bfhi(rv.z), bflo(rv.w), bfhi(rv.w)}; } } while (0)
    __syncthreads();
    for (int i = tid; i < 2 * 128 * 40; i += 512) KC[i] = 0;
    for (int i = tid; i < 2 * 32 * 40; i += 512) VT[i] = 0;
    for (int i = tid; i < 2 * 16 * 40; i += 512) PP[i] = 0;
    for (int i = tid; i < 32 * 136; i += 512) ST[i] = 0;
    HG_ISSUE(0); HG_WRITE(0);
    __syncthreads();
    constexpr int NTB = SU / 32;
#define HG_BAR() do { asm volatile("s_waitcnt lgkmcnt(0)" ::: "memory"); __builtin_amdgcn_s_barrier(); asm volatile("" ::: "memory"); } while (0)
    for (int tb = 0; tb < NTB; ++tb) {
        const int s0 = 32 * tb, cur = tb & 1;
        if (tb + 1 < NTB) HG_ISSUE(s0 + 32);
        const LAS float* sF = sIn + cur * INB; const LAS float* sQ = sF + 32 * 128; const LAS float* sV = sQ + 32 * 128;
        if (tid < 256) {
            const int c = tid >> 7, d = tid & 127;
            float a = 0.f, kbv[16], fv[16], qv[16];
#pragma unroll
            for (int i = 0; i < 16; ++i) { fv[i] = sF[(16 * c + i) * 128 + d]; qv[i] = sQ[(16 * c + i) * 128 + d]; }
#pragma unroll
            for (int i = 0; i < 16; ++i) { const float f = fv[i], q = qv[i];
                a += __builtin_amdgcn_logf(f); const float ea = __builtin_amdgcn_exp2f(a);
                QA[(c * 16 + i) * 136 + d] = (bf16_t)f2bf(q * ea); kbv[i] = (1.0f - f) * __builtin_amdgcn_exp2f(-a); }
            const float al = __builtin_amdgcn_exp2f(a); DEC[c * 128 + d] = al;
            unsigned pk[8];
#pragma unroll
            for (int j = 0; j < 16; ++j) { KB[(c * 16 + j) * 136 + d] = (bf16_t)f2bf(kbv[j]); }
#pragma unroll
            for (int j = 0; j < 8; ++j) pk[j] = pk2(kbv[2 * j] * al, kbv[2 * j + 1] * al);
            LAS u32x4* kd = (LAS u32x4*)(KC + (c * 128 + d) * 40); kd[0] = (u32x4){pk[0], pk[1], pk[2], pk[3]}; kd[1] = (u32x4){pk[4], pk[5], pk[6], pk[7]};
        } else {
            const int idx = tid - 256, c = idx >> 7, e = (idx >> 2) & 31, jq = idx & 3;
            const float v0 = sV[(16 * c + 4 * jq + 0) * 32 + e], v1 = sV[(16 * c + 4 * jq + 1) * 32 + e], v2 = sV[(16 * c + 4 * jq + 2) * 32 + e], v3 = sV[(16 * c + 4 * jq + 3) * 32 + e];
            u32x2 o; o.x = pk2(v0, v1); o.y = pk2(v2, v3); *(LAS u32x2*)(VT + (c * 32 + e) * 40 + 4 * jq) = o;
        }
        HG_BAR();
        bf16x8 qa[4]; f32x4 oi[2] = {(f32x4){0.f, 0.f, 0.f, 0.f}, (f32x4){0.f, 0.f, 0.f, 0.f}};
        bf16x8 sb0[2][4];
        if (w < 2) {
            const int c = w;
            bf16x8 kbf[4], vbf[2];
#pragma unroll
            for (int ks = 0; ks < 4; ++ks) { qa[ks] = *(const LAS bf16x8*)(QA + (c * 16 + l15) * 136 + 32 * ks + 8 * quad); kbf[ks] = *(const LAS bf16x8*)(KB + (c * 16 + l15) * 136 + 32 * ks + 8 * quad); }
#pragma unroll
            for (int nt = 0; nt < 2; ++nt) vbf[nt] = *(const LAS bf16x8*)(VT + (c * 32 + 16 * nt + l15) * 40 + 8 * quad);
            if (c == 0) {
#pragma unroll
                for (int nt = 0; nt < 2; ++nt)
#pragma unroll
                    for (int ks = 0; ks < 4; ++ks) sb0[nt][ks] = *(const LAS bf16x8*)(ST + (16 * nt + l15) * 136 + 32 * ks + 8 * quad);
            }
            f32x4 sc = (f32x4){0.f, 0.f, 0.f, 0.f};
#pragma unroll
            for (int ks = 0; ks < 4; ++ks) sc = __builtin_amdgcn_mfma_f32_16x16x32_bf16(qa[ks], kbf[ks], sc, 0, 0, 0);
#pragma unroll
            for (int jj = 0; jj < 4; ++jj) { const int i = 4 * quad + jj; PP[(c * 16 + i) * 40 + l15] = (bf16_t)f2bf(l15 <= i ? sc[jj] : 0.f); }
            LDS_WAIT(); asm volatile("" ::: "memory");
            const bf16x8 pa = *(const LAS bf16x8*)(PP + (c * 16 + l15) * 40 + 8 * quad);
#pragma unroll
            for (int nt = 0; nt < 2; ++nt) oi[nt] = __builtin_amdgcn_mfma_f32_16x16x32_bf16(pa, vbf[nt], oi[nt], 0, 0, 0);
        }
#pragma unroll
        for (int c = 0; c < 2; ++c) {
            if (w == c) {
                if (c == 1) {
#pragma unroll
                    for (int nt = 0; nt < 2; ++nt)
#pragma unroll
                        for (int ks = 0; ks < 4; ++ks) sb0[nt][ks] = *(const LAS bf16x8*)(ST + (16 * nt + l15) * 136 + 32 * ks + 8 * quad);
                }
#pragma unroll
                for (int ks = 0; ks < 4; ++ks)
#pragma unroll
                    for (int nt = 0; nt < 2; ++nt) oi[nt] = __builtin_amdgcn_mfma_f32_16x16x32_bf16(qa[ks], sb0[nt][ks], oi[nt], 0, 0, 0);
#pragma unroll
                for (int jj = 0; jj < 4; ++jj) { const int pp = pos_of(s0 + 16 * c + 4 * quad + jj); float* op = osrc + (rb + pp) * DM + h * 128 + 32 * es + l15; op[0] = oi[0][jj]; op[16] = oi[1][jj]; }
            }
            {
                const f32x4 dc = *(const LAS f32x4*)(DEC + c * 128 + 16 * w + 4 * quad);
                const bf16x8 ka = *(const LAS bf16x8*)(KC + (c * 128 + 16 * w + l15) * 40 + 8 * quad);
#pragma unroll
                for (int nt = 0; nt < 2; ++nt) { const bf16x8 vb = *(const LAS bf16x8*)(VT + (c * 32 + 16 * nt + l15) * 40 + 8 * quad); S[nt] = S[nt] * dc; S[nt] = __builtin_amdgcn_mfma_f32_16x16x32_bf16(ka, vb, S[nt], 0, 0, 0); }
            }
            HG_BAR();
#pragma unroll
            for (int nt = 0; nt < 2; ++nt)
#pragma unroll
                for (int jj = 0; jj < 4; ++jj) ST[(16 * nt + l15) * 136 + 16 * w + 4 * quad + jj] = (bf16_t)f2bf(S[nt][jj]);
            if (c == 1 && tb + 1 < NTB) HG_WRITE(cur ^ 1);
            HG_BAR();
        }
    }
#undef HG_ISSUE
#undef HG_WRITE
#undef HG_BAR
}
__device__ __forceinline__ void hg_scan_item_c32(Frame& F, int item) {
    const int es = item & 3, dir = (item >> 2) & 1, h = (item >> 3) & 7, b = item >> 6;
    const int tid = ftid(), lane = tid & 63, w = F.wave, quad = lane >> 4, l15 = lane & 15;
    constexpr int INB = 32 * 128 * 2 + 32 * 32;
    LAS float* sIn = (LAS float*)F.lds;
    LAS bf16_t* QA = (LAS bf16_t*)(sIn + 2 * INB);
    LAS bf16_t* KB = QA + 32 * 136;
    LAS bf16_t* KC = KB + 32 * 136;
    LAS bf16_t* VT = KC + 128 * 40;
    LAS bf16_t* PP = VT + 32 * 40;
    LAS bf16_t* ST = PP + 32 * 40;
    LAS float* DEC = (LAS float*)(ST + 32 * 136);
    const float* fsrc = (const float*)(F.ws + (dir ? WS_FB : WS_FF));
    const bf16_t* qsrc = (const bf16_t*)(F.ws + WS_PQ); const bf16_t* vsrc = (const bf16_t*)(F.ws + WS_PI);
    float* osrc = (float*)(F.ws + (dir ? WS_OB : WS_OF));
    const size_t rb = (size_t)b * SU;
    f32x4 S[2] = {(f32x4){0.f, 0.f, 0.f, 0.f}, (f32x4){0.f, 0.f, 0.f, 0.f}};
    f32x4 rf0A, rf1A, rf0B, rf1B; u32x4 rqA, rvA, rqB, rvB;
    auto pos_of = [&](int s) { return dir ? (s < NCTX ? NCTX - 1 - s : SU + NCTX - 1 - s) : s; };
#define HG_ISSUE(rf0, rf1, rq, rv, s0_) do { const int pA = pos_of((s0_) + (tid >> 5)), pB = pos_of((s0_) + 16 + (tid >> 5)), pQ = pos_of((s0_) + (tid >> 4)); \
        rf0 = *(const f32x4*)(fsrc + (rb + pA) * DM + h * 128 + 4 * (tid & 31)); rf1 = *(const f32x4*)(fsrc + (rb + pB) * DM + h * 128 + 4 * (tid & 31)); \
        rq = *(const u32x4*)(qsrc + (rb + pQ) * DM + h * 128 + 8 * (tid & 15)); \
        if (tid < 128) { const int pV = pos_of((s0_) + (tid >> 2)); rv = *(const u32x4*)(vsrc + (rb + pV) * DM + h * 128 + 32 * es + 8 * (tid & 3)); } } while (0)
#define HG_WRITE(rf0, rf1, rq, rv, buf_) do { LAS float* bF = sIn + (buf_) * INB; LAS float* bQ = bF + 32 * 128; LAS float* bV = bQ + 32 * 128; \
        *(LAS f32x4*)(bF + (tid >> 5) * 128 + 4 * (tid & 31)) = rf0; *(LAS f32x4*)(bF + (16 + (tid >> 5)) * 128 + 4 * (tid & 31)) = rf1; \
        { LAS float* d = bQ + (tid >> 4) * 128 + 8 * (tid & 15); *(LAS f32x4*)d = (f32x4){bflo(rq.x), bfhi(rq.x), bflo(rq.y), bfhi(rq.y)}; *(LAS f32x4*)(d + 4) = (f32x4){bflo(rq.z), bfhi(rq.z), bflo(rq.w), bfhi(rq.w)}; } \
        if (tid < 128) { LAS float* d = bV + (tid >> 2) * 32 + 8 * (tid & 3); *(LAS f32x4*)d = (f32x4){bflo(rv.x), bfhi(rv.x), bflo(rv.y), bfhi(rv.y)}; *(LAS f32x4*)(d + 4) = (f32x4){bflo(rv.z), bfhi(rv.z), bflo(rv.w), bfhi(rv.w)}; } } while (0)
#define HG_BAR() do { asm volatile("s_waitcnt lgkmcnt(0)" ::: "memory"); __builtin_amdgcn_s_barrier(); asm volatile("" ::: "memory"); } while (0)
    __syncthreads();
    for (int i = tid; i < 32 * 136; i += 512) ST[i] = 0;
    HG_ISSUE(rf0A, rf1A, rqA, rvA, 0); HG_WRITE(rf0A, rf1A, rqA, rvA, 0);
    HG_ISSUE(rf0B, rf1B, rqB, rvB, 32);
    __syncthreads();
    constexpr int NTB = SU / 32;
    auto blk = [&](const int tb, const int cur) __attribute__((always_inline)) {
        const int s0 = 32 * tb;
        const LAS float* sF = sIn + cur * INB; const LAS float* sQ = sF + 32 * 128; const LAS float* sV = sQ + 32 * 128;
        if (tid < 256) {
            const int c = tid & 1, d = tid >> 1;
            float fv[16], qv[16], kbv[16];
#pragma unroll
            for (int i = 0; i < 16; ++i) { fv[i] = sF[(16 * c + i) * 128 + d]; qv[i] = sQ[(16 * c + i) * 128 + d]; }
            float tot = 1.f;
#pragma unroll
            for (int i = 0; i < 16; ++i) tot *= fv[i];
            const float oth = shx(tot, 1, lane);
            float ea = c ? oth : 1.f;
            float eia = __builtin_amdgcn_rcpf(ea);
            const float al = tot * oth;
#pragma unroll
            for (int i = 0; i < 16; ++i) { const float fo = fv[i]; ea *= fo; eia *= __builtin_amdgcn_rcpf(fo);
                QA[(16 * c + i) * 136 + d] = (bf16_t)f2bf(qv[i] * ea); kbv[i] = (1.0f - fo) * eia; }
            if (c == 0) DEC[d] = al;
            unsigned pk[8];
#pragma unroll
            for (int j = 0; j < 16; ++j) KB[(16 * c + j) * 136 + d] = (bf16_t)f2bf(kbv[j]);
#pragma unroll
            for (int j = 0; j < 8; ++j) pk[j] = pk2(kbv[2 * j] * al, kbv[2 * j + 1] * al);
            LAS u32x4* kd = (LAS u32x4*)(KC + d * 40 + 16 * c); kd[0] = (u32x4){pk[0], pk[1], pk[2], pk[3]}; kd[1] = (u32x4){pk[4], pk[5], pk[6], pk[7]};
        } else {
            const int idx = tid - 256, e = idx >> 3, jq = idx & 7;
            const float v0 = sV[(4 * jq + 0) * 32 + e], v1 = sV[(4 * jq + 1) * 32 + e], v2 = sV[(4 * jq + 2) * 32 + e], v3 = sV[(4 * jq + 3) * 32 + e];
            u32x2 o; o.x = pk2(v0, v1); o.y = pk2(v2, v3); *(LAS u32x2*)(VT + e * 40 + 4 * jq) = o;
        }
        HG_BAR();
        if (w < 2) {
            const int it = w;
            bf16x8 qa[4], kbf[2][4], vbf[2], sbf[2][4];
#pragma unroll
            for (int ks = 0; ks < 4; ++ks) { qa[ks] = *(const LAS bf16x8*)(QA + (16 * it + l15) * 136 + 32 * ks + 8 * quad);
                kbf[0][ks] = *(const LAS bf16x8*)(KB + (l15) * 136 + 32 * ks + 8 * quad); kbf[1][ks] = *(const LAS bf16x8*)(KB + (16 + l15) * 136 + 32 * ks + 8 * quad); }
#pragma unroll
            for (int nt = 0; nt < 2; ++nt) { vbf[nt] = *(const LAS bf16x8*)(VT + (16 * nt + l15) * 40 + 8 * quad);
#pragma unroll
                for (int ks = 0; ks < 4; ++ks) sbf[nt][ks] = *(const LAS bf16x8*)(ST + (16 * nt + l15) * 136 + 32 * ks + 8 * quad); }
            f32x4 sc0 = (f32x4){0.f, 0.f, 0.f, 0.f}, sc1 = (f32x4){0.f, 0.f, 0.f, 0.f};
#pragma unroll
            for (int ks = 0; ks < 4; ++ks) { sc0 = __builtin_amdgcn_mfma_f32_16x16x32_bf16(qa[ks], kbf[0][ks], sc0, 0, 0, 0); sc1 = __builtin_amdgcn_mfma_f32_16x16x32_bf16(qa[ks], kbf[1][ks], sc1, 0, 0, 0); }
#pragma unroll
            for (int jj = 0; jj < 4; ++jj) { const int i = 16 * it + 4 * quad + jj;
                PP[i * 40 + l15] = (bf16_t)f2bf(l15 <= i ? sc0[jj] : 0.f); PP[i * 40 + 16 + l15] = (bf16_t)f2bf(16 + l15 <= i ? sc1[jj] : 0.f); }
            LDS_WAIT(); asm volatile("" ::: "memory");
            const bf16x8 pa = *(const LAS bf16x8*)(PP + (16 * it + l15) * 40 + 8 * quad);
            f32x4 oi[2];
#pragma unroll
            for (int nt = 0; nt < 2; ++nt) { oi[nt] = __builtin_amdgcn_mfma_f32_16x16x32_bf16(pa, vbf[nt], (f32x4){0.f, 0.f, 0.f, 0.f}, 0, 0, 0);
#pragma unroll
                for (int ks = 0; ks < 4; ++ks) oi[nt] = __builtin_amdgcn_mfma_f32_16x16x32_bf16(qa[ks], sbf[nt][ks], oi[nt], 0, 0, 0); }
#pragma unroll
            for (int jj = 0; jj < 4; ++jj) { const int pp = pos_of(s0 + 16 * it + 4 * quad + jj); float* op = osrc + (rb + pp) * DM + h * 128 + 32 * es + l15; op[0] = oi[0][jj]; op[16] = oi[1][jj]; }
        }
        {
            const f32x4 dc = *(const LAS f32x4*)(DEC + 16 * w + 4 * quad);
            const bf16x8 ka = *(const LAS bf16x8*)(KC + (16 * w + l15) * 40 + 8 * quad);
#pragma unroll
            for (int nt = 0; nt < 2; ++nt) { const bf16x8 vb = *(const LAS bf16x8*)(VT + (16 * nt + l15) * 40 + 8 * quad); S[nt] = S[nt] * dc; S[nt] = __builtin_amdgcn_mfma_f32_16x16x32_bf16(ka, vb, S[nt], 0, 0, 0); }
        }
        HG_BAR();
#pragma unroll
        for (int nt = 0; nt < 2; ++nt)
#pragma unroll
            for (int jj = 0; jj < 4; ++jj) ST[(16 * nt + l15) * 136 + 16 * w + 4 * quad + jj] = (bf16_t)f2bf(S[nt][jj]);
    };
    for (int tb = 0; tb < NTB; tb += 2) {
        { const int nb = tb + 2 < NTB ? tb + 2 : NTB - 1; HG_ISSUE(rf0A, rf1A, rqA, rvA, 32 * nb); }
        blk(tb, 0);
        HG_WRITE(rf0B, rf1B, rqB, rvB, 1);
        HG_BAR();
        { const int nb = tb + 3 < NTB ? tb + 3 : NTB - 1; HG_ISSUE(rf0B, rf1B, rqB, rvB, 32 * nb); }
        blk(tb + 1, 1);
        HG_WRITE(rf0A, rf1A, rqA, rvA, 0);
        HG_BAR();
    }
#undef HG_ISSUE
#undef HG_WRITE
#undef HG_BAR
}
__device__ __forceinline__ void hg_scan_item(Frame& F, int item) {
    const int es = item & 3, dir = (item >> 2) & 1, h = (item >> 3) & 7, b = item >> 6;
    const int tid = ftid(), lane = tid & 63, w = F.wave, quad = lane >> 4, l15 = lane & 15;
    constexpr int INB = 32 * 128 * 2 + 32 * 32;
    LAS float* sIn = (LAS float*)F.lds;
    LAS bf16_t* QA = (LAS bf16_t*)(sIn + 2 * INB);
    LAS bf16_t* KB = QA + 2 * 32 * 136;
    LAS bf16_t* KC = KB + 32 * 136;
    LAS bf16_t* VT = KC + 2 * 128 * 40;
    LAS bf16_t* PP = VT + 2 * 32 * 40;
    LAS bf16_t* ST = PP + 2 * 32 * 40;
    LAS float* DEC = (LAS float*)(ST + 2 * 32 * 136);
    const float* fsrc = (const float*)(F.ws + (dir ? WS_FB : WS_FF));
    const bf16_t* qsrc = (const bf16_t*)(F.ws + WS_PQ); const bf16_t* vsrc = (const bf16_t*)(F.ws + WS_PI);
    float* osrc = (float*)(F.ws + (dir ? WS_OB : WS_OF));
    const size_t rb = (size_t)b * SU;
    auto pos_of = [&](int s) { return dir ? (s < NCTX ? NCTX - 1 - s : SU + NCTX - 1 - s) : s; };
    constexpr int NTB = SU / 32;
#define HG_BAR() do { asm volatile("s_waitcnt lgkmcnt(0)" ::: "memory"); __builtin_amdgcn_s_barrier(); asm volatile("" ::: "memory"); } while (0)
    f32x4 rf[4]; u32x4 rq[2], rv;
#define HG_ISSUE(s0_) do { \
        _Pragma("unroll") for (int r_ = 0; r_ < 4; ++r_) rf[r_] = *(const f32x4*)(fsrc + (rb + pos_of((s0_) + (tid >> 5) + 8 * r_)) * DM + h * 128 + 4 * (tid & 31)); \
        _Pragma("unroll") for (int r_ = 0; r_ < 2; ++r_) rq[r_] = *(const u32x4*)(qsrc + (rb + pos_of((s0_) + (tid >> 4) + 16 * r_)) * DM + h * 128 + 8 * (tid & 15)); \
        if (tid < 128) rv = *(const u32x4*)(vsrc + (rb + pos_of((s0_) + (tid >> 2))) * DM + h * 128 + 32 * es + 8 * (tid & 3)); } while (0)
#define HG_WRITE(buf_) do { LAS float* bF = sIn + (buf_) * INB; LAS float* bQ = bF + 32 * 128; LAS float* bV = bQ + 32 * 128; \
        _Pragma("unroll") for (int r_ = 0; r_ < 4; ++r_) *(LAS f32x4*)(bF + ((tid >> 5) + 8 * r_) * 128 + 4 * (tid & 31)) = rf[r_]; \
        _Pragma("unroll") for (int r_ = 0; r_ < 2; ++r_) { LAS float* d = bQ + ((tid >> 4) + 16 * r_) * 128 + 8 * (tid & 15); *(LAS f32x4*)d = (f32x4){bflo(rq[r_].x), bfhi(rq[r_].x), bflo(rq[r_].y), bfhi(rq[r_].y)}; *(LAS f32x4*)(d + 4) = (f32x4){bflo(rq[r_].z), bfhi(rq[r_].z), bflo(rq[r_].w), bfhi(rq[r_].w)}; } \
        if (tid < 128) { LAS float* d = bV + (tid >> 2) * 32 + 8 * (tid & 3); *(LAS f32x4*)d = (f32x4){bflo(rv.x), bfhi(rv.x), bflo(rv.y), bfhi(rv.y)}; *(LAS f32x4*)(d + 4) = (f32x4){bflo(rv.z), bfhi(rv.z), bflo(rv.w), bfhi(rv.w)}; } } while (0)
    f32x4 S[2][2];
#pragma unroll
    for (int a = 0; a < 2; ++a)
#pragma unroll
        for (int c2 = 0; c2 < 2; ++c2) S[a][c2] = (f32x4){0.f, 0.f, 0.f, 0.f};
    __syncthreads();
    for (int i = tid; i < 2 * 32 * 136; i += 512) ST[i] = 0;
    if (w < 4) { HG_ISSUE(0); HG_WRITE(0); HG_ISSUE(32); }
    __syncthreads();
    for (int j = 0; j <= NTB; ++j) {
        const int sp = j & 1;
        const int t = j - 1, sc_ = t & 1;
        f32x4 oi = (f32x4){0.f, 0.f, 0.f, 0.f};
        if (w < 4) {
            if (j < NTB) {
                const LAS float* sF = sIn + sp * INB; const LAS float* sQ = sF + 32 * 128; const LAS float* sV = sQ + 32 * 128;
                const int c = tid & 1, d = tid >> 1;
                float fv[16], qv[16], kbv[16];
#pragma unroll
                for (int i = 0; i < 16; ++i) { fv[i] = sF[(16 * c + i) * 128 + d]; qv[i] = sQ[(16 * c + i) * 128 + d]; }
                const int e = tid >> 3, jq = tid & 7;
                const float v0 = sV[(4 * jq + 0) * 32 + e], v1 = sV[(4 * jq + 1) * 32 + e], v2 = sV[(4 * jq + 2) * 32 + e], v3 = sV[(4 * jq + 3) * 32 + e];
                float tot = 1.f;
#pragma unroll
                for (int i = 0; i < 16; ++i) tot *= fv[i];
                const float oth = shx(tot, 1, lane);
                float ea = c ? oth : 1.f; float eia = __builtin_amdgcn_rcpf(ea);
                const float al = tot * oth;
                LAS bf16_t* qa_ = QA + sp * 32 * 136;
#pragma unroll
                for (int i = 0; i < 16; ++i) { const float fo = fv[i]; ea *= fo; eia *= __builtin_amdgcn_rcpf(fo);
                    qa_[(16 * c + i) * 136 + d] = (bf16_t)f2bf(qv[i] * ea); kbv[i] = (1.0f - fo) * eia; }
                if (c == 0) DEC[sp * 128 + d] = al;
                unsigned pk[8];
#pragma unroll
                for (int jx = 0; jx < 16; ++jx) KB[(16 * c + jx) * 136 + d] = (bf16_t)f2bf(kbv[jx]);
#pragma unroll
                for (int jx = 0; jx < 8; ++jx) pk[jx] = pk2(kbv[2 * jx] * al, kbv[2 * jx + 1] * al);
                LAS u32x4* kd = (LAS u32x4*)(KC + (sp * 128 + d) * 40 + 16 * c); kd[0] = (u32x4){pk[0], pk[1], pk[2], pk[3]}; kd[1] = (u32x4){pk[4], pk[5], pk[6], pk[7]};
                u32x2 o; o.x = pk2(v0, v1); o.y = pk2(v2, v3); *(LAS u32x2*)(VT + (sp * 32 + e) * 40 + 4 * jq) = o;
            }
        } else if (t >= 0) {
            const int k = w - 4, it = k >> 1, nt = k & 1;
            const bf16x8 pa = *(const LAS bf16x8*)(PP + (sc_ * 32 + 16 * it + l15) * 40 + 8 * quad);
            const bf16x8 vb = *(const LAS bf16x8*)(VT + (sc_ * 32 + 16 * nt + l15) * 40 + 8 * quad);
            bf16x8 qa[4], sb[4];
#pragma unroll
            for (int ks = 0; ks < 4; ++ks) { qa[ks] = *(const LAS bf16x8*)(QA + (sc_ * 32 + 16 * it + l15) * 136 + 32 * ks + 8 * quad); sb[ks] = *(const LAS bf16x8*)(ST + (sc_ * 32 + 16 * nt + l15) * 136 + 32 * ks + 8 * quad); }
            oi = __builtin_amdgcn_mfma_f32_16x16x32_bf16(pa, vb, oi, 0, 0, 0);
#pragma unroll
            for (int ks = 0; ks < 4; ++ks) oi = __builtin_amdgcn_mfma_f32_16x16x32_bf16(qa[ks], sb[ks], oi, 0, 0, 0);
#pragma unroll
            for (int jj = 0; jj < 4; ++jj) { const int pp = pos_of(32 * t + 16 * it + 4 * quad + jj); osrc[(rb + pp) * DM + h * 128 + 32 * es + 16 * nt + l15] = oi[jj]; }
        }
        HG_BAR();
        if (w < 2) {
            if (j < NTB) {
                const int it = w;
                bf16x8 qa[4], kbf[2][4];
#pragma unroll
                for (int ks = 0; ks < 4; ++ks) { qa[ks] = *(const LAS bf16x8*)(QA + (sp * 32 + 16 * it + l15) * 136 + 32 * ks + 8 * quad);
                    kbf[0][ks] = *(const LAS bf16x8*)(KB + (l15) * 136 + 32 * ks + 8 * quad); kbf[1][ks] = *(const LAS bf16x8*)(KB + (16 + l15) * 136 + 32 * ks + 8 * quad); }
                f32x4 sc0 = (f32x4){0.f, 0.f, 0.f, 0.f}, sc1 = (f32x4){0.f, 0.f, 0.f, 0.f};
#pragma unroll
                for (int ks = 0; ks < 4; ++ks) { sc0 = __builtin_amdgcn_mfma_f32_16x16x32_bf16(qa[ks], kbf[0][ks], sc0, 0, 0, 0); sc1 = __builtin_amdgcn_mfma_f32_16x16x32_bf16(qa[ks], kbf[1][ks], sc1, 0, 0, 0); }
#pragma unroll
                for (int jj = 0; jj < 4; ++jj) { const int i = 16 * it + 4 * quad + jj;
                    PP[(sp * 32 + i) * 40 + l15] = (bf16_t)f2bf(l15 <= i ? sc0[jj] : 0.f); PP[(sp * 32 + i) * 40 + 16 + l15] = (bf16_t)f2bf(16 + l15 <= i ? sc1[jj] : 0.f); }
            }
        } else if (w >= 4 && t >= 0) {
            const int k = w - 4;
#pragma unroll
            for (int mt = 0; mt < 2; ++mt) {
                const f32x4 dc = *(const LAS f32x4*)(DEC + sc_ * 128 + 32 * k + 16 * mt + 4 * quad);
                const bf16x8 ka = *(const LAS bf16x8*)(KC + (sc_ * 128 + 32 * k + 16 * mt + l15) * 40 + 8 * quad);
#pragma unroll
                for (int n2 = 0; n2 < 2; ++n2) { const bf16x8 vb2 = *(const LAS bf16x8*)(VT + (sc_ * 32 + 16 * n2 + l15) * 40 + 8 * quad); S[mt][n2] = S[mt][n2] * dc; S[mt][n2] = __builtin_amdgcn_mfma_f32_16x16x32_bf16(ka, vb2, S[mt][n2], 0, 0, 0); }
            }
            LAS bf16_t* stn = ST + (sc_ ^ 1) * 32 * 136;
#pragma unroll
            for (int mt = 0; mt < 2; ++mt)
#pragma unroll
                for (int n2 = 0; n2 < 2; ++n2)
#pragma unroll
                    for (int jj = 0; jj < 4; ++jj) stn[(16 * n2 + l15) * 136 + 32 * k + 16 * mt + 4 * quad + jj] = (bf16_t)f2bf(S[mt][n2][jj]);
        }
        if (w < 4 && j + 1 < NTB) { HG_WRITE((j + 1) & 1); if (j + 2 < NTB) HG_ISSUE(32 * (j + 2)); }
        HG_BAR();
    }
#undef HG_ISSUE
#undef HG_WRITE
#undef HG_BAR
}
__device__ __forceinline__ void naive_hg_scan(Frame& F) {
    const int gt = fbid() * 512 + ftid();
    if (gt >= NB * 8 * 2 * 128) return;
    const int e = gt & 127, dir = (gt >> 7) & 1, h = (gt >> 8) & 7, b = gt >> 11;
    const float* fsrc = (const float*)(F.ws + (dir ? WS_FB : WS_FF));
    const bf16_t* qsrc = (const bf16_t*)(F.ws + WS_PQ); const bf16_t* vsrc = (const bf16_t*)(F.ws + WS_PI);
    float* osrc = (float*)(F.ws + (dir ? WS_OB : WS_OF));
    float S[128];
#pragma unroll
    for (int d = 0; d < 128; ++d) S[d] = 0.f;
    for (int s_ = 0; s_ < SU; ++s_) {
        const int pp = dir ? (s_ < NCTX ? NCTX - 1 - s_ : SU + NCTX - 1 - s_) : s_;
        const size_t row = (size_t)b * SU + pp;
        const float v = bf2f(vsrc[row * DM + h * 128 + e]);
        const float* fr = fsrc + row * DM + h * 128; const bf16_t* qr = qsrc + row * DM + h * 128;
        float o = 0.f;
#pragma unroll
        for (int d = 0; d < 128; ++d) { const float f = fr[d]; S[d] = f * S[d] + (1.0f - f) * v; o += bf2f(qr[d]) * S[d]; }
        osrc[row * DM + h * 128 + e] = o;
    }
}
__device__ __forceinline__ void naive_hg_readout(Frame& F, const Args& args, int p) {
    for (int i = fbid() * 512 + ftid(); i < MTOK * 8; i += F.G * 512) {
        const int row = i >> 3, h = i & 7;
        const float* a = (const float*)(F.ws + WS_OF) + (size_t)row * DM + h * 128; const float* c = (const float*)(F.ws + WS_OB) + (size_t)row * DM + h * 128;
        float ss = 0.f;
        for (int d = 0; d < 128; ++d) { const float o = a[d] + c[d]; ss += o * o; }
        const float rstd = 1.0f / sqrtf(ss / 128.f + EPS);
        const bf16_t* g = (const bf16_t*)(F.ws + WS_PG) + (size_t)row * DM + h * 128; bf16_t* y = (bf16_t*)(F.ws + WS_YB16) + (size_t)row * DM + h * 128;
        for (int d = 0; d < 128; ++d) { const float o = a[d] + c[d]; const float gv = bf2f(g[d]); y[d] = (bf16_t)f2bf(o * rstd * args.in[I_HGNW][p * 128 + d] * (gv / (1.0f + expf(-gv)))); }
    }
}
__device__ __forceinline__ void hg_readout_phase(Frame& F, const Args& args, int p) {
    const int gw = F.vcu * NWAVES + F.wave, NGW = F.G * NWAVES, lane = flane();
    const float* nw = ((const float*)(F.ws + WS_SP) + SP_HGNW) + p * 128 + 16 * (lane & 7);
    for (int row = gw; row < MTOK; row += NGW) {
        const f32x4* a = (const f32x4*)(F.ws + WS_OF + (size_t)row * DM * 4) + 4 * lane; const f32x4* c = (const f32x4*)(F.ws + WS_OB + (size_t)row * DM * 4) + 4 * lane;
        f32x4 o[4]; float ss = 0.f;
#pragma unroll
        for (int j = 0; j < 4; ++j) { o[j] = ABL_HGB0 ? a[j] : a[j] + c[j]; ss += (o[j].x * o[j].x + o[j].y * o[j].y) + (o[j].z * o[j].z + o[j].w * o[j].w); }
        ss += shx(ss, 1, lane); ss += shx(ss, 2, lane); ss += shx(ss, 4, lane);
        const float rstd = 1.0f / sqrtf(ss * (1.0f / 128.f) + EPS);
        const u32x4* gp = (const u32x4*)(F.ws + WS_PG + (size_t)row * DM * 2) + 2 * lane;
        const u32x4 g0 = gp[0], g1 = gp[1]; const unsigned gwv[8] = {g0.x, g0.y, g0.z, g0.w, g1.x, g1.y, g1.z, g1.w};
        unsigned outw[8];
#pragma unroll
        for (int j = 0; j < 4; ++j) { const f32x4 wv = *(const f32x4*)(nw + 4 * j);
            const float y0 = o[j].x * rstd * wv.x * siluf(bflo(gwv[2 * j])), y1 = o[j].y * rstd * wv.y * siluf(bfhi(gwv[2 * j]));
            const float y2 = o[j].z * rstd * wv.z * siluf(bflo(gwv[2 * j + 1])), y3 = o[j].w * rstd * wv.w * siluf(bfhi(gwv[2 * j + 1]));
            outw[2 * j] = pk2(y0, y1); outw[2 * j + 1] = pk2(y2, y3); }
        u32x4* op = (u32x4*)(F.ws + WS_YB16 + (size_t)row * DM * 2) + 2 * lane;
        op[0] = (u32x4){outw[0], outw[1], outw[2], outw[3]}; op[1] = (u32x4){outw[4], outw[5], outw[6], outw[7]};
    }
}

constexpr int NPHASE = 2 + 9 * DEPTH;
constexpr unsigned KM_ALL = 0x7ffu | (3u << 16);
template <unsigned KM>
__device__ __forceinline__ void mk_body(const Args& args, unsigned char* lds_raw) {
    Frame F;
    F.lds = (LAS unsigned char*)lds_raw;
    F.MISC = (volatile LAS unsigned*)(F.lds + MISC_OFF);
    F.wave = __builtin_amdgcn_readfirstlane(ftid() >> 6);
    F.G = gridDim.x; { const int bx = blockIdx.x; F.vcu = (F.G % 8 == 0) ? (bx % 8) * (F.G / 8) + bx / 8 : bx; }
    F.ws = args.ws; F.ctl = (unsigned*)(args.ws + WS_CTL);
    for (int u = ftid(); u < (LDS_BYTES - LDSCTL_OFF) / 4; u += NWAVES * 64) ((LAS unsigned*)(F.lds + LDSCTL_OFF))[u] = 0u;
    __syncthreads();
    XcdBarrier bar; bar.bar = F.ctl + CW_BAR; bar.x = 0; bar.st = nullptr;
    const int lo = args.ph_lo, hi = args.ph_hi;
    if (hi - lo > 1) bar = xcd_barrier_post(F.ctl + CW_BAR, F.MISC + 8);
#define HAS(kind) ((KM >> (kind)) & 1u)
    if constexpr (HAS(0)) { if (lo == 0) { p0_prologue(F, args); if (NAIVE_MOD) { __syncthreads(); naive_mod(F, args); } if (hi > 1) xcd_barrier(bar); } }
    float* const outp = args.out;
#pragma nounroll
    for (int ph = (lo == 0 ? 1 : lo); ph < hi; ++ph) {
        const Args* ap = &args;
        { unsigned char* w_ = args.ws; asm volatile("" : "+s"(w_)); F.ws = w_; F.ctl = (unsigned*)(w_ + WS_CTL); }
        { int wv_ = __builtin_amdgcn_readfirstlane(ftid() >> 6); F.wave = wv_; int g_ = (int)gridDim.x; asm volatile("" : "+s"(g_)); F.G = g_; const int bx = fbid(); F.vcu = (g_ % 8 == 0) ? (bx % 8) * (g_ / 8) + bx / 8 : bx; }
        const float* mod = (const float*)(F.ws + WS_MOD);
        const int kind = (ph == 0) ? 0 : (ph == NPHASE - 1 ? 10 : 1 + (ph - 1) % 9);
        const int l = (ph - 1) / 9; const int odd = l & 1, p = l >> 1;
        if (kind == 5 && odd) continue;
        switch (kind) {
        case 1: if constexpr (HAS(1)) { if (NAIVE_N1 == 1) naive_n1(F, *ap, l, false); else if (NAIVE_N1 == 2) wave_n1(F, *ap, l, false); else n1_phase<false>(F, *ap, l); } break;
        case 2: if constexpr (HAS(2)) {
            const int N = odd ? OD_N : EV_N;
            if (NAIVE_G1) { naive_g1(F, *ap, l); } else {
            pg8::PlainAddr AD{(const bf16_t*)(F.ws + WS_HB), (const bf16_t*)(F.ws + (odd ? WS_W_ODIN + (size_t)p * 10 * MiB : WS_W_EVIN + (size_t)p * 6 * MiB)), DM};
            pg8::StaticOrder S; S.init(MTOK, N, F.G, fbid());
            EpiProj E{F.ws, (const float*)(F.ws + WS_LB) + l * DM, odd};
            pg8::gemm_phase(F.lds, AD, S, E, DM);
            } } break;
        case 3: if constexpr (HAS(3)) {
            if (!odd) {
                if constexpr (HAS(16)) {
                    for (int it = fbid(); it < NB * 4 * NCHUNK + (NAIVE_ATT ? 0 : NB * 2 * NCHUNK); it += F.G) {
                        if (it < NB * 4 * NCHUNK) ret_state_item(F, *ap, p, it); else att_item(F, *ap, p, it - NB * 4 * NCHUNK);
                    }
                    if (NAIVE_ATT) { __syncthreads(); naive_att(F, *ap, p); }
                }
            } else {
                if constexpr (HAS(17)) { if (NAIVE_HG) naive_hg_scan(F); else for (int it = fbid(); it < NB * 8 * 2 * 4; it += F.G) hg_scan_item(F, it); }
            }
            __syncthreads(); } break;
        case 4: if constexpr (HAS(4)) {
            if (!odd) { if constexpr (HAS(16)) ret_scan_phase(F, *ap, p); } else { if constexpr (HAS(17)) { if (NAIVE_HG) naive_hg_readout(F, *ap, p); else hg_readout_phase(F, *ap, p); } } } break;
        case 5: if constexpr (HAS(5)) { for (int it = fbid(); it < NB * 4 * NCHUNK; it += F.G) { if (RET_DIRECT) ret_direct_item(F, *ap, p, it); else ret_out_item(F, *ap, p, it); } __syncthreads(); } break;
        case 6: if constexpr (HAS(6)) {
            if (NAIVE_G2) { if (odd ? CONTRIB_ODD : CONTRIB_EVEN) naive_g2(F, *ap, l); } else {
            pg8::PlainAddr AD{(const bf16_t*)(F.ws + WS_YB16), (const bf16_t*)(F.ws + (odd ? WS_W_ODOUT : WS_W_EVOUT) + (size_t)p * 2 * MiB), DM};
            pg8::StaticOrder S; S.init(MTOK, DM, F.G, fbid());
            EpiOut E{(float*)(F.ws + WS_XRES), mod + (size_t)l * 5 * 6144, odd ? CONTRIB_ODD : CONTRIB_EVEN};
            pg8::gemm_phase(F.lds, AD, S, E, DM);
            } } break;
        case 7: if constexpr (HAS(7)) { if (NAIVE_N2R) naive_n2r(F, *ap, l); else n2r_phase(F, *ap, l); } break;
        case 8: case 9: if constexpr (HAS(8) || HAS(9)) {
            LAS int* tstart = (LAS int*)(F.lds + LDSCTL_OFF + 512); LAS int* cnts = (LAS int*)(F.lds + LDSCTL_OFF + 768);
            __syncthreads();
            if (F.wave == 0) { int mycnt; const int pre = moe_tile_prefix(F.ctl + CW_CNT + l * NEXP, flane(), mycnt); if (flane() <= NEXP) tstart[flane()] = pre; if (flane() < NEXP) cnts[flane()] = mycnt; }
            __syncthreads();
            const int ntiles = tstart[NEXP];
            const bf16_t* wmoe = (const bf16_t*)(F.ws + WS_W_MOE + (size_t)l * NEXP * 3 * MiB);
            if (kind == 8) { if constexpr (HAS(8)) {
                if (NAIVE_MOE) naive_moe(F, *ap, l); else {
                pg8::MoeGatherAddr AD{(const bf16_t*)(F.ws + WS_HB), wmoe, (const unsigned*)(F.ws + WS_LIST), DM};
                pg8::MoeOrder S{tstart, cnts, ntiles, F.G, fbid()};
                EpiAct E{(bf16_t*)(F.ws + WS_ACT)};
                pg8::gemm_phase(F.lds, AD, S, E, DM); }
            } } else { if constexpr (HAS(9)) {
                pg8::MoeActAddr AD{(const bf16_t*)(F.ws + WS_ACT), wmoe + (size_t)DM * DM, FF};
                pg8::MoeOrder S{tstart, cnts, ntiles, F.G, fbid()};
                EpiY E{(bf16_t*)(F.ws + WS_YB)};
                pg8::gemm_phase(F.lds, AD, S, E, FF);
            } } } break;
        default: if constexpr (HAS(10)) { if (NAIVE_FINAL == 1) naive_n1(F, *ap, DEPTH, true); else if (NAIVE_FINAL == 2) wave_n1(F, *ap, DEPTH, true); else n1_phase<true>(F, *ap, DEPTH); } break;
        }
        if (ph + 1 < hi) xcd_barrier(bar);
    }
#undef HAS
}
template <int L>
__device__ __forceinline__ void layer_sl(Frame& F, const Args& args, const XcdBarrier& bar) {
    constexpr int l = L; constexpr int odd = L & 1, p = L >> 1;
    const float* mod = (const float*)(F.ws + WS_MOD);
    n1_phase<false>(F, args, l); xcd_barrier(bar);
    { pg8::PlainAddr AD{(const bf16_t*)(F.ws + WS_HB), (const bf16_t*)(F.ws + (odd ? WS_W_ODIN + (size_t)p * 10 * MiB : WS_W_EVIN + (size_t)p * 6 * MiB)), DM};
      pg8::StaticOrder S; S.init(MTOK, odd ? OD_N : EV_N, F.G, fbid());
      EpiProj E{F.ws, (const float*)(F.ws + WS_LB) + l * DM, odd};
      pg8::gemm_phase(F.lds, AD, S, E, DM); }
    xcd_barrier(bar);
    if constexpr (!odd) {
        {
            const int bx = fbid();
            if (F.G == 256) {
                att_item(F, args, p, bx);
                if (bx < 16) att_item(F, args, p, 256 + bx);
                else { const int r0 = 2 * (bx - 16); ret_state_item(F, args, p, r0); ret_state_item(F, args, p, r0 + 1); if (bx - 16 < 64) ret_state_item(F, args, p, 480 + (bx - 16)); }
            } else {
                for (int it = bx; it < NB * 4 * NCHUNK + NB * 2 * NCHUNK; it += F.G) { if (it < NB * 2 * NCHUNK) att_item(F, args, p, it); else ret_state_item(F, args, p, it - NB * 2 * NCHUNK); }
            }
        }
        __syncthreads(); xcd_barrier(bar);
        ret_scan_phase(F, args, p); xcd_barrier(bar);
        for (int rep_ = 0; rep_ <= REP_MIXE; ++rep_) for (int it = fbid(); it < NB * 4 * NCHUNK; it += F.G) ret_out_item(F, args, p, it);
        __syncthreads(); xcd_barrier(bar);
    } else {
        for (int rep_ = 0; rep_ <= REP_HG; ++rep_) for (int it = F.vcu; it < NB * 8 * 2 * 4; it += F.G) hg_scan_item(F, it);
        __syncthreads(); xcd_barrier(bar);
        hg_readout_phase(F, args, p); xcd_barrier(bar);
    }
    { pg8::PlainAddr AD{(const bf16_t*)(F.ws + WS_YB16), (const bf16_t*)(F.ws + (odd ? WS_W_ODOUT : WS_W_EVOUT) + (size_t)p * 2 * MiB), DM};
      pg8::StaticOrder S; S.init(MTOK, DM, F.G, fbid(), l == DEPTH - 1 ? 1 : 0);
      EpiOut E{(float*)(F.ws + WS_XRES), mod + (size_t)l * 5 * 6144, 1};
      pg8::gemm_phase(F.lds, AD, S, E, DM); }
    xcd_barrier(bar);
    n2r_phase(F, args, l); xcd_barrier(bar);
    {   LAS int* tstart = (LAS int*)(F.lds + LDSCTL_OFF + 512); LAS int* cnts = (LAS int*)(F.lds + LDSCTL_OFF + 768);
        __syncthreads();
        if (F.wave == 0) { int mycnt; const int ln = flane(); const int pre = moe_tile_prefix(F.ctl + CW_CNT + l * NEXP, ln, mycnt); if (ln <= NEXP) tstart[ln] = pre; if (ln < NEXP) cnts[ln] = mycnt; }
        __syncthreads();
        const int ntiles = tstart[NEXP];
        const bf16_t* wmoe = (const bf16_t*)(F.ws + WS_W_MOE + (size_t)l * NEXP * 3 * MiB);
        { pg8::MoeGatherAddr AD{(const bf16_t*)(F.ws + WS_HB), wmoe, (const unsigned*)(F.ws + WS_LIST), DM};
          pg8::MoeOrder S{tstart, cnts, ntiles, F.G, fbid()};
          EpiAct E{(bf16_t*)(F.ws + WS_ACT)};
          pg8::gemm_phase(F.lds, AD, S, E, DM); }
        xcd_barrier(bar);
        { pg8::MoeActAddr AD{(const bf16_t*)(F.ws + WS_ACT), wmoe + (size_t)DM * DM, FF};
          pg8::MoeOrder S{tstart, cnts, ntiles, F.G, fbid()};
          EpiY E{(bf16_t*)(F.ws + WS_YB)};
          pg8::gemm_phase(F.lds, AD, S, E, FF); }
        xcd_barrier(bar);
    }
}
__global__ void __launch_bounds__(NWAVES * 64, 2) mk_one(Args args) {
    extern __shared__ __attribute__((aligned(16))) unsigned char lds_raw[];
    Frame F;
    F.lds = (LAS unsigned char*)lds_raw;
    F.MISC = (volatile LAS unsigned*)(F.lds + MISC_OFF);
    F.wave = __builtin_amdgcn_readfirstlane(ftid() >> 6);
    F.G = gridDim.x; { const int bx = blockIdx.x; F.vcu = (F.G % 8 == 0) ? (bx % 8) * (F.G / 8) + bx / 8 : bx; }
    F.ws = args.ws; F.ctl = (unsigned*)(args.ws + WS_CTL);
    for (int u = ftid(); u < (LDS_BYTES - LDSCTL_OFF) / 4; u += NWAVES * 64) ((LAS unsigned*)(F.lds + LDSCTL_OFF))[u] = 0u;
    __syncthreads();
    const XcdBarrier bar = xcd_barrier_post(F.ctl + CW_BAR, F.MISC + 8);
    p0_prologue(F, args); xcd_barrier(bar);
    layer_sl<0>(F, args, bar);
    layer_sl<1>(F, args, bar);
    layer_sl<2>(F, args, bar);
    layer_sl<3>(F, args, bar);
    n1_phase<true>(F, args, DEPTH);
}

template <unsigned KM>
__global__ void __launch_bounds__(NWAVES * 64, 2) mk_fwd(Args args) {
    extern __shared__ __attribute__((aligned(16))) unsigned char lds_raw[];
    mk_body<KM>(args, lds_raw);
}

template <unsigned KM> static bool prep_kernel() { return hipFuncSetAttribute((const void*)mk_fwd<KM>, hipFuncAttributeMaxDynamicSharedMemorySize, LDS_BYTES) == hipSuccess; }
template <unsigned KM> static void launch_kernel(int grid, hipStream_t stream, const Args& a) { hipLaunchKernelGGL(mk_fwd<KM>, dim3(grid), dim3(NWAVES * 64), LDS_BYTES, stream, a); }
#define KEV (1u << 16)
#define KOD (1u << 17)
extern "C" void kernel_launch(void* const* d_in, const int* in_sizes, int n_in, void* d_out, int out_size, void* d_ws, size_t ws_size, hipStream_t stream) {
    static int grid = 0;
    if (grid == 0) {
        const int exp_sizes[23] = {NB * LSEQ * DM, NB * DM, NB * NCTX * DM, DM, DEPTH * DM * 6 * DM, DEPTH * 6 * DM, DEPTH * 2 * DM, DM, 2 * DM * EV_N, 2 * DM * DM, 16, 8,
                                   2 * DM * OD_N, 2 * DM * DM, DEPTH * DM, 2 * 128, DEPTH * DM * 4, DEPTH * 4, DEPTH * 4 * DM * 8, DEPTH * 32, DEPTH * NEXP * DM * FF, DEPTH * NEXP * DM * FF, DEPTH * NEXP * FF * DM};
        bool sz_ok = (n_in == 23) && out_size == NB * LSEQ * DM;
        for (int i = 0; i < 23 && sz_ok; ++i) sz_ok = (in_sizes[i] == exp_sizes[i]);
        if (!sz_ok) { fprintf(stderr, "kernel_launch: unexpected input sizes\n"); grid = -1; return; }
        if (n_in != 23 || ws_size < WS_END) { fprintf(stderr, "kernel_launch: unexpected n_in %d / ws_size %zu\n", n_in, ws_size); grid = -1; return; }
        int dev = 0, cus = 0;
        if (hipGetDevice(&dev) != hipSuccess || hipDeviceGetAttribute(&cus, hipDeviceAttributeMultiprocessorCount, dev) != hipSuccess) { grid = -1; return; }
        bool ok = true;
#if MK_PER_PHASE
        ok = ok && prep_kernel<1u << 0>() && prep_kernel<1u << 1>() && prep_kernel<1u << 2>() && prep_kernel<(1u << 3) | KEV>() && prep_kernel<(1u << 3) | KOD>()
                && prep_kernel<(1u << 4) | KEV>() && prep_kernel<(1u << 4) | KOD>() && prep_kernel<(1u << 5) | KEV>() && prep_kernel<1u << 6>() && prep_kernel<1u << 7>()
                && prep_kernel<1u << 8>() && prep_kernel<1u << 9>() && prep_kernel<1u << 10>();
#else
        ok = ok && (hipFuncSetAttribute((const void*)mk_one, hipFuncAttributeMaxDynamicSharedMemorySize, LDS_BYTES) == hipSuccess);
#ifdef PROBE_MASKS
        ok = ok && prep_kernel<(1u<<3)|(3u<<16)>() && prep_kernel<(1u<<3)|(1u<<5)|(1u<<16)>() && prep_kernel<(1u<<0)|(1u<<1)|(1u<<7)|(1u<<10)>() && prep_kernel<(1u<<3)|(1u<<4)|(1u<<5)|(3u<<16)>() && prep_kernel<(1u<<0)|(1u<<3)|(1u<<16)>() && prep_kernel<(1u<<1)|(1u<<3)|(1u<<16)>();
#endif
#endif
        if (!ok) { fprintf(stderr, "kernel_launch: hipFuncSetAttribute failed\n"); grid = -1; return; }
        (void)hipGetLastError();
        grid = cus > 256 ? 256 : cus;
    }
    if (grid < 0) return;
    (void)hipMemsetAsync((char*)d_ws + WS_CTL, 0, CTL_ZERO_BYTES, stream);
    Args a{};
    for (int i = 0; i < 23; ++i) a.in[i] = (const float*)d_in[i];
    a.out = (float*)d_out; a.ws = (unsigned char*)d_ws;
#if MK_PER_PHASE
    for (int ph = 0; ph < NPHASE; ++ph) {
        { unsigned char* w_ = args.ws; asm volatile("" : "+s"(w_)); F.ws = w_; F.ctl = (unsigned*)(w_ + WS_CTL); }
        { int wv_ = __builtin_amdgcn_readfirstlane(ftid() >> 6); F.wave = wv_; int g_ = (int)gridDim.x; asm volatile("" : "+s"(g_)); F.G = g_; const int bx = fbid(); F.vcu = (g_ % 8 == 0) ? (bx % 8) * (g_ / 8) + bx / 8 : bx; }
        const float* mod = (const float*)(F.ws + WS_MOD);
        const int kind = (ph == 0) ? 0 : (ph == NPHASE - 1 ? 10 : 1 + (ph - 1) % 9); const int l = (ph - 1) / 9; const bool odd = (l & 1) != 0;
        if (kind == 5 && odd) continue;
        a.ph_lo = ph; a.ph_hi = ph + 1;
        switch (kind) {
            case 0: launch_kernel<1u << 0>(grid, stream, a); break;
            case 1: launch_kernel<1u << 1>(grid, stream, a); break;
            case 2: launch_kernel<1u << 2>(grid, stream, a); break;
            case 3: if (odd) launch_kernel<(1u << 3) | KOD>(grid, stream, a); else launch_kernel<(1u << 3) | KEV>(grid, stream, a); break;
            case 4: if (odd) launch_kernel<(1u << 4) | KOD>(grid, stream, a); else launch_kernel<(1u << 4) | KEV>(grid, stream, a); break;
            case 5: launch_kernel<(1u << 5) | KEV>(grid, stream, a); break;
            case 6: launch_kernel<1u << 6>(grid, stream, a); break;
            case 7: launch_kernel<1u << 7>(grid, stream, a); break;
            case 8: launch_kernel<1u << 8>(grid, stream, a); break;
            case 9: launch_kernel<1u << 9>(grid, stream, a); break;
            default: launch_kernel<1u << 10>(grid, stream, a); break;
        }
    }
#else
    a.ph_lo = 0; a.ph_hi = NPHASE;
    hipLaunchKernelGGL(mk_one, dim3(grid), dim3(NWAVES * 64), LDS_BYTES, stream, a);
#endif
}
```

```cpp
#include <hip/hip_runtime.h>
#include <cstdio>
#include <cstdint>

#ifndef MK_PER_PHASE
#define MK_PER_PHASE 0
#endif

#ifndef CONTRIB_EVEN
#define CONTRIB_EVEN 1
#endif
#ifndef CONTRIB_ODD
#define CONTRIB_ODD 1
#endif
#ifndef CONTRIB_MOE
#define CONTRIB_MOE 1
#endif
#ifndef ABL_ATT0
#define ABL_ATT0 0
#endif
#ifndef ABL_RET0
#define ABL_RET0 0
#endif
#ifndef ABL_HGB0
#define ABL_HGB0 0
#endif
#ifndef RET_DIRECT
#define RET_DIRECT 0
#endif
#ifndef NAIVE_G1
#define NAIVE_G1 0
#endif
#ifndef NAIVE_G2
#define NAIVE_G2 0
#endif
#ifndef NAIVE_MOD
#define NAIVE_MOD 0
#endif
#ifndef NAIVE_MOE
#define NAIVE_MOE 0
#endif
#ifndef NAIVE_ATT
#define NAIVE_ATT 0
#endif
#ifndef NAIVE_HG
#define NAIVE_HG 0
#endif
#ifndef NAIVE_N2R
#define NAIVE_N2R 0
#endif
#ifndef NAIVE_COPY
#define NAIVE_COPY 0
#endif
#ifndef NAIVE_N1
#define NAIVE_N1 0
#endif
#ifndef NAIVE_FINAL
#define NAIVE_FINAL 0
#endif
#ifndef MUT_A
#define MUT_A 0
#endif
#ifndef MUT_B
#define MUT_B 0
#endif
#ifndef MUT_D
#define MUT_D 0
#endif
#ifndef REP_CONV
#define REP_CONV 0
#endif
#ifndef REP_HG
#define REP_HG 0
#endif
#ifndef REP_MIXE
#define REP_MIXE 0
#endif
#define LAS __attribute__((address_space(3)))
#define GAS __attribute__((address_space(1)))
typedef unsigned short bf16_t;
typedef short bf16x8 __attribute__((ext_vector_type(8)));
typedef float f32x4 __attribute__((ext_vector_type(4)));
typedef float f32x2 __attribute__((ext_vector_type(2)));
typedef unsigned u32x4 __attribute__((ext_vector_type(4)));
typedef unsigned u32x2 __attribute__((ext_vector_type(2)));

constexpr int NB = 4, LSEQ = 4096, DM = 1024, NCTX = 256, SU = NCTX + LSEQ  , MTOK = NB * SU  , DEPTH = 4;
constexpr int EV_N = 3072, OD_N = 5120, NEXP = 32, FF = 512;
constexpr int NCHUNK = SU / 128;
constexpr float EPS = 1e-6f;
constexpr int LIST_CAP = MTOK;
constexpr int MOE_MAXROWS = 43008;

constexpr size_t MiB = 1u << 20;
constexpr size_t WS_CTL = 0, CTL_ZERO_BYTES = 1 * MiB;
constexpr size_t WS_MOD = 1 * MiB;
constexpr size_t WS_LB = 1 * MiB + 512 * 1024;
constexpr size_t WS_ROPEC = WS_LB + 16384;
constexpr size_t WS_ROPES = WS_ROPEC + 8192;
constexpr size_t WS_W = 2 * MiB;
constexpr size_t WS_W_EVIN = WS_W;
constexpr size_t WS_W_EVOUT = WS_W + 12 * MiB;
constexpr size_t WS_W_ODIN = WS_W + 16 * MiB;
constexpr size_t WS_W_ODOUT = WS_W + 36 * MiB;
constexpr size_t WS_W_MOE = WS_W + 40 * MiB;
constexpr size_t WS_XRES = 426 * MiB;
constexpr size_t WS_HB = 494 * MiB;
constexpr size_t WS_YB16 = 528 * MiB;
constexpr size_t WS_R = 562 * MiB;
constexpr size_t WS_PE = WS_R;
constexpr size_t WS_ST = WS_R + 102 * MiB;
constexpr size_t WS_PQ = WS_R, WS_PI = WS_R + 34 * MiB, WS_PG = WS_R + 68 * MiB;
constexpr size_t WS_FF = WS_R + 102 * MiB, WS_FB = WS_R + 170 * MiB, WS_OF = WS_R + 238 * MiB, WS_OB = WS_R + 306 * MiB;
constexpr size_t WS_LIST = WS_R;
constexpr size_t WS_TOKINFO = WS_R + 5 * MiB;
constexpr size_t WS_ACT = WS_R + 6 * MiB;
constexpr size_t WS_YB = WS_R + 50 * MiB;
constexpr size_t WS_YN = WS_R + 140 * MiB;
constexpr size_t WS_END = 936 * MiB;
constexpr size_t WS_SP = 256 * 1024;
constexpr int SP_NORMW = 0, SP_FNORMW = 8192, SP_WG = 9216, SP_BG = 25600, SP_WE = 25616, SP_BE = 156688, SP_DECAY = 156816, SP_SINK = 156832, SP_HGNW = 156840, SP_END = 157096;
static_assert(WS_SP + (size_t)SP_END * 4 <= CTL_ZERO_BYTES, "small parameters fit in the control MiB");
constexpr int CW_BAR = 4096;
constexpr int CW_CNT = 8192;

constexpr int RING_BYTES = 147456;
constexpr int LDSCTL_OFF = RING_BYTES, MISC_OFF = LDSCTL_OFF + 320;
constexpr int LDS_BYTES = RING_BYTES + 4096;
constexpr int NWAVES = 8;

typedef __bf16 bf16v2_t __attribute__((ext_vector_type(2)));
__device__ __forceinline__ unsigned pk2(float lo, float hi) { const f32x2 v = {lo, hi}; const bf16v2_t r = __builtin_convertvector(v, bf16v2_t); return __builtin_bit_cast(unsigned, r); }
__device__ __forceinline__ unsigned f2bf(float f) { return pk2(f, f) & 0xffffu; }
__device__ __forceinline__ float bf2f(unsigned h) { return __builtin_bit_cast(float, h << 16); }
__device__ __forceinline__ float bflo(unsigned w) { return __builtin_bit_cast(float, w << 16); }
__device__ __forceinline__ float bfhi(unsigned w) { return __builtin_bit_cast(float, w & 0xffff0000u); }
__device__ __forceinline__ float shx(float v, int o, int lane) { return __builtin_bit_cast(float, __builtin_amdgcn_ds_bpermute((lane ^ o) << 2, __builtin_bit_cast(int, v))); }
__device__ __forceinline__ int shup_i(int v, int o, int lane) { return __builtin_amdgcn_ds_bpermute((lane - o) << 2, v); }
__device__ __forceinline__ int shidx_i(int v, int src) { return __builtin_amdgcn_ds_bpermute(src << 2, v); }
__device__ __forceinline__ float wave_sum(float v, int lane) {
#pragma unroll
    for (int o = 1; o < 64; o <<= 1) v += shx(v, o, lane);
    return v;
}
__device__ __forceinline__ float siluf(float x) { return x / (1.0f + __expf(-x)); }
#define LDS_WAIT() asm volatile("s_waitcnt lgkmcnt(0)" ::: "memory")
#define VM_WAIT() asm volatile("s_waitcnt vmcnt(0)" ::: "memory")

namespace pg8 {
constexpr int BM = 256, BK = 64, HALF = 128, HTB = HALF * BK * 2, STAGE_BYTES = 8 * HTB, NXCD = 8, WGM = 8;
__host__ __device__ __forceinline__ int lds_byte(int r, int c) { const int st = (r >> 4) * 2 + (c >> 5), rr = r & 15, cc = c & 31, ob = rr * 64 + cc * 2; return st * 1024 + (ob ^ (((ob >> 9) & 1) << 5)); }
__host__ __device__ __forceinline__ void stage_rc(int b, int& R, int& C) { const int st = b / 1024, sb = b % 1024, swz = sb ^ (((sb >> 9) & 1) << 5); R = (st >> 1) * 16 + swz / 64; C = (st & 1) * 32 + (swz % 64) / 2; }
__host__ __device__ __forceinline__ int perm32(int rho) { const int n = rho >> 4, i = rho & 15; return 8 * (i >> 2) + 4 * n + (i & 3); }

struct Unit { int pm, pn, e, cnt, tile; };

__device__ __forceinline__ int xcd_remap(int L, int nwg) { const int q = nwg / NXCD, r = nwg % NXCD, xcd = L % NXCD, off = L / NXCD; return (xcd < r ? xcd * (q + 1) : r * (q + 1) + (xcd - r) * q) + off; }

struct StaticOrder {
    int nM, nN, nwg, G, c, skipctx;
    __device__ void init(int M, int N, int G_, int c_, int skip_ = 0) { skipctx = skip_; nM = skip_ ? 64 : M / BM; nN = N / BM; nwg = nM * nN; G = G_; c = c_; }
    __device__ bool next(int i, Unit& u) const {
        const long L = (long)i * G + c; if (L >= nwg) return false;
        const int wgid = xcd_remap((int)L, nwg);
        const int nig = WGM * nN, gid = wgid / nig, fm = gid * WGM, gsz = (nM - fm) < WGM ? (nM - fm) : WGM;
        u.pm = fm + ((wgid % nig) % gsz); u.pn = (wgid % nig) / gsz; u.e = 0; u.cnt = 0; u.tile = 0;
        if (skipctx) u.pm = u.pm + u.pm / 16 + 1;
        return true;
    }
};
struct MoeOrder {
    const LAS int* tstart; const LAS int* cnts; int ntiles, G, c;
    __device__ bool next(int i, Unit& u) const {
        const int nwg = ntiles * 4; const long L = (long)i * G + c; if (L >= nwg) return false;
        const int wgid = xcd_remap((int)L, nwg);
        const int tile = wgid >> 2; u.pn = wgid & 3; u.tile = tile;
        int e = 0;
        for (int k = 1; k < NEXP; ++k) e += (tstart[k] <= tile) ? 1 : 0;
        u.e = e; u.pm = tile - tstart[e]; u.cnt = cnts[e]; return true;
    }
};

struct PlainAddr {
    static constexpr bool GATHER = false;
    const bf16_t* A; const bf16_t* Bt; int K;
    __device__ __forceinline__ void base(const Unit& u, const char*& cA, const char*& cB) const { cA = (const char*)(A + (size_t)u.pm * BM * K); cB = (const char*)(Bt + (size_t)u.pn * BM * K); }
    __device__ __forceinline__ void rows(const Unit&, const int (&)[2], const int (&)[2], unsigned (&)[2], unsigned (&)[2]) const {}
};
struct MoeGatherAddr {
    static constexpr bool GATHER = true;
    const bf16_t* HB; const bf16_t* Wbase; const unsigned* list; int K;
    __device__ __forceinline__ void base(const Unit& u, const char*& cA, const char*& cB) const { cA = (const char*)HB; cB = (const char*)Wbase + (size_t)u.e * (3u << 20) + (size_t)u.pn * BM * K * 2; }
    __device__ __forceinline__ void rows(const Unit& u, const int (&R)[2], const int (&C)[2], unsigned (&v0)[2], unsigned (&v1)[2]) const {
        const unsigned* lp = list + (size_t)u.e * LIST_CAP;
#pragma unroll
        for (int i = 0; i < 2; ++i) {
            int i0 = u.pm * BM + R[i], i1 = i0 + HALF; const int mx = u.cnt - 1; i0 = i0 < mx ? i0 : mx; i1 = i1 < mx ? i1 : mx;
            const unsigned t0 = __hip_atomic_load(lp + i0, __ATOMIC_RELAXED, __HIP_MEMORY_SCOPE_AGENT), t1 = __hip_atomic_load(lp + i1, __ATOMIC_RELAXED, __HIP_MEMORY_SCOPE_AGENT);
            v0[i] = (t0 * (unsigned)K + (unsigned)C[i]) * 2u; v1[i] = (t1 * (unsigned)K + (unsigned)C[i]) * 2u;
        }
    }
};
struct MoeActAddr {
    static constexpr bool GATHER = false;
    const bf16_t* Act; const bf16_t* Wbase; int K;
    __device__ __forceinline__ void base(const Unit& u, const char*& cA, const char*& cB) const { cA = (const char*)(Act + (size_t)u.tile * BM * K); cB = (const char*)Wbase + (size_t)u.e * (3u << 20) + (size_t)u.pn * BM * K * 2; }
    __device__ __forceinline__ void rows(const Unit&, const int (&)[2], const int (&)[2], unsigned (&)[2], unsigned (&)[2]) const {}
};

__device__ __forceinline__ unsigned cvt_pk_bf16(float lo, float hi) { unsigned r; asm volatile("v_cvt_pk_bf16_f32 %0, %1, %2" : "=v"(r) : "v"(lo), "v"(hi)); return r; }

template <class Epi, class Sched, class Addr>
__device__ __forceinline__ void gemm_phase(LAS unsigned char* lds, const Addr& AD, const Sched& S, const Epi& E, const int K) {
    int tid = threadIdx.x; asm volatile("" : "+v"(tid));
    const int wid = __builtin_amdgcn_readfirstlane(tid >> 6), lane = tid & 63, wr = wid >> 2, wc = wid & 3, fr = lane & 15, fq = lane >> 4;
    const int nt = K / BK;
    int sR[2], sC[2]; unsigned voffA[2], voffB[2];
#pragma unroll
    for (int i = 0; i < 2; ++i) { int R, C; stage_rc(tid * 16 + i * 8192, R, C); sR[i] = R; sC[i] = C; const int Rb = Epi::PERM ? ((R & ~31) + perm32(R & 31)) : R; voffA[i] = (unsigned)(R * K + C) * 2u; voffB[i] = (unsigned)(Rb * K + C) * 2u; }
    const size_t kstep = (size_t)(BK * 2);
    const size_t hstep = (size_t)HALF * K * 2;
    const unsigned ldsw = (unsigned)wid * 1024u;
    const int aoff = lds_byte(wr * 64 + fr, fq * 8), boff = lds_byte(wc * 32 + fr, fq * 8);
#define PG8_SA(b, h) (((b) * 2 + (h)) * HTB)
#define PG8_SB(b, h) ((4 + (b) * 2 + (h)) * HTB)
#define PG8_STAGE(bufoff, gbase, voff) do { _Pragma("unroll") for (int _i = 0; _i < 2; ++_i) \
        __builtin_amdgcn_global_load_lds((const unsigned*)((const char*)(gbase) + (voff)[_i]), (LAS unsigned*)(lds + (bufoff) + ldsw + _i * 8192), 16, 0, 0); } while (0)
#define PG8_LDA(dst, b, h) do { _Pragma("unroll") for (int m = 0; m < 4; ++m) _Pragma("unroll") for (int k = 0; k < 2; ++k) dst[m][k] = *(const LAS bf16x8*)(lds + PG8_SA(b, h) + aoff + m * 2048 + k * 1024); } while (0)
#define PG8_LDB(dst, b, h) do { _Pragma("unroll") for (int n = 0; n < 2; ++n) _Pragma("unroll") for (int k = 0; k < 2; ++k) dst[n][k] = *(const LAS bf16x8*)(lds + PG8_SB(b, h) + boff + n * 2048 + k * 1024); } while (0)
#define PG8_MMA(ai, bj, At, Bt) do { __builtin_amdgcn_s_setprio(1); _Pragma("unroll") for (int m = 0; m < 4; ++m) _Pragma("unroll") for (int n = 0; n < 2; ++n) _Pragma("unroll") for (int k = 0; k < 2; ++k) \
        acc[ai][bj][m][n] = __builtin_amdgcn_mfma_f32_16x16x32_bf16(Bt[n][k], At[m][k], acc[ai][bj][m][n], 0, 0, 0); __builtin_amdgcn_s_setprio(0); } while (0)
#define PG8_WAIT_V(n) asm volatile("s_waitcnt vmcnt(" #n ")" ::: "memory")
#define PG8_WAIT_L(n) asm volatile("s_waitcnt lgkmcnt(" #n ")" ::: "memory")
#define PG8_BAR __builtin_amdgcn_s_barrier()
#define PG8_SCHED __builtin_amdgcn_sched_barrier(0)
    Unit cur, nxt; int ui = 0;
    if (!S.next(0, cur)) return;
    f32x4 acc[2][2][4][2];
#pragma unroll
    for (int a = 0; a < 2; ++a)
#pragma unroll
        for (int b = 0; b < 2; ++b)
#pragma unroll
            for (int m = 0; m < 4; ++m)
#pragma unroll
                for (int n = 0; n < 2; ++n) acc[a][b][m][n] = (f32x4){0.f, 0.f, 0.f, 0.f};
    bf16x8 At[4][2], B0[2][2], B1[2][2];
    const char* cA; const char* cB; unsigned cv0[2] = {voffA[0], voffA[1]}, cv1[2] = {voffA[0], voffA[1]};
    AD.base(cur, cA, cB); AD.rows(cur, sR, sC, cv0, cv1);
    const size_t ah = Addr::GATHER ? (size_t)0 : hstep;
    PG8_STAGE(PG8_SB(0, 0), cB, voffB); PG8_STAGE(PG8_SB(0, 1), cB + hstep, voffB); PG8_STAGE(PG8_SA(0, 0), cA, cv0); PG8_STAGE(PG8_SA(0, 1), cA + ah, cv1);
    if (wr == 1) PG8_BAR;
    PG8_WAIT_V(2); PG8_BAR;
    PG8_STAGE(PG8_SB(1, 0), cB + kstep, voffB); PG8_STAGE(PG8_SA(1, 0), cA + kstep, cv0); PG8_STAGE(PG8_SB(1, 1), cB + hstep + kstep, voffB);
    PG8_WAIT_V(6); PG8_BAR;
    for (;;) {
        const bool has_next = S.next(ui + 1, nxt);
        const char* nA = cA; const char* nB = cB; unsigned nv0[2] = {cv0[0], cv0[1]}, nv1[2] = {cv1[0], cv1[1]};
        if (has_next) { AD.base(nxt, nA, nB); AD.rows(nxt, sR, sC, nv0, nv1); }
        for (int t = 0; t < nt; t += 2) {
            const bool last = (t == nt - 2);
            const char* a1 = cA + (size_t)(t + 1) * kstep;
            const char* a2 = last ? nA : cA + (size_t)(t + 2) * kstep; const char* b2 = last ? nB : cB + (size_t)(t + 2) * kstep;
            const char* a3 = a2 + kstep; const char* b3 = b2 + kstep;
            unsigned x0[2] = {cv0[0], cv0[1]}, x1[2] = {cv1[0], cv1[1]};
            if constexpr (Addr::GATHER) { if (last) { x0[0] = nv0[0]; x0[1] = nv0[1]; x1[0] = nv1[0]; x1[1] = nv1[1]; } }
            PG8_LDB(B0, 0, 0); PG8_LDB(B1, 0, 1); PG8_SCHED; PG8_LDA(At, 0, 0); PG8_STAGE(PG8_SA(1, 1), a1 + ah, cv1);
            PG8_WAIT_V(8); PG8_WAIT_L(0); PG8_BAR; PG8_MMA(0, 0, At, B0); PG8_MMA(0, 1, At, B1); PG8_BAR; PG8_SCHED;
            PG8_LDA(At, 0, 1); PG8_STAGE(PG8_SB(0, 0), b2, voffB); PG8_STAGE(PG8_SB(0, 1), b2 + hstep, voffB); PG8_STAGE(PG8_SA(0, 0), a2, x0);
            PG8_WAIT_V(8); PG8_WAIT_L(0); PG8_BAR; PG8_MMA(1, 0, At, B0); PG8_MMA(1, 1, At, B1); PG8_BAR; PG8_SCHED;
            PG8_LDB(B0, 1, 0); PG8_LDB(B1, 1, 1); PG8_SCHED; PG8_LDA(At, 1, 0); PG8_STAGE(PG8_SA(0, 1), a2 + ah, x1);
            PG8_WAIT_V(8); PG8_WAIT_L(0); PG8_BAR; PG8_MMA(0, 0, At, B0); PG8_MMA(0, 1, At, B1); PG8_BAR; PG8_SCHED;
            PG8_LDA(At, 1, 1); PG8_STAGE(PG8_SB(1, 0), b3, voffB); PG8_STAGE(PG8_SB(1, 1), b3 + hstep, voffB); PG8_STAGE(PG8_SA(1, 0), a3, x0);
            PG8_WAIT_V(8); PG8_WAIT_L(0); PG8_BAR; PG8_MMA(1, 0, At, B0); PG8_MMA(1, 1, At, B1); PG8_BAR; PG8_SCHED;
        }
        if (wr == 0) PG8_BAR;
        E(acc, cur, wr, wc, fr, fq);
        if (!has_next) break;
#pragma unroll
        for (int a = 0; a < 2; ++a)
#pragma unroll
            for (int b = 0; b < 2; ++b)
#pragma unroll
                for (int m = 0; m < 4; ++m)
#pragma unroll
                    for (int n = 0; n < 2; ++n) acc[a][b][m][n] = (f32x4){0.f, 0.f, 0.f, 0.f};
        cur = nxt; cA = nA; cB = nB; cv0[0] = nv0[0]; cv0[1] = nv0[1]; cv1[0] = nv1[0]; cv1[1] = nv1[1]; ++ui;
        if (wr == 1) PG8_BAR;
    }
    PG8_WAIT_V(0);
    PG8_BAR;
#undef PG8_SA
#undef PG8_SB
#undef PG8_STAGE
#undef PG8_LDA
#undef PG8_LDB
#undef PG8_MMA
#undef PG8_WAIT_V
#undef PG8_WAIT_L
#undef PG8_BAR
#undef PG8_SCHED
}
}

#define XB_TMO      128
#define XB_XCNT(j)  (256  + 64 * (j))
#define XB_XSUB(j)  (1280 + 64 * (j))
#define XB_XGEN(j)  (2304 + 64 * (j))
#define XB_TOP      3328
#define XB_TOPGEN   3392
#define XCD_BAR_WORDS 3456
#define XB_SPIN_CAP (1u << 20)
__device__ __forceinline__ unsigned xb_ld(unsigned* p)              { return __hip_atomic_load((GAS unsigned*)p, __ATOMIC_RELAXED, __HIP_MEMORY_SCOPE_AGENT); }
__device__ __forceinline__ unsigned xb_add(unsigned* p, unsigned v) { return __hip_atomic_fetch_add((GAS unsigned*)p, v, __ATOMIC_RELAXED, __HIP_MEMORY_SCOPE_AGENT); }
__device__ __forceinline__ unsigned xb_xcc_id() { return (unsigned)__builtin_amdgcn_s_getreg((3 << 11) | 20) & 0xFu; }
#define XB_SPIN(cond, bar) do { unsigned _sp = 0; while (cond) { __builtin_amdgcn_s_sleep(1); \
    if ((++_sp & 255u) == 0u) { if (xb_ld(&(bar)[XB_TMO])) break; if (_sp > XB_SPIN_CAP) { xb_add(&(bar)[XB_TMO], 1u); break; } } } } while (0)
struct XcdBarrier { unsigned* bar; unsigned x; volatile LAS unsigned* st; };
__device__ __forceinline__ XcdBarrier xcd_barrier_post(unsigned* bar, volatile LAS unsigned* st) {
    XcdBarrier b; b.bar = bar; b.x = xb_xcc_id(); b.st = st;
    if (threadIdx.x == 0) (void)xb_add(&bar[XB_XCNT(b.x)], 1u);
    return b;
}
__device__ __forceinline__ void xcd_barrier_complete(unsigned* bar, unsigned x, unsigned& nloc, unsigned& nx) {
    const unsigned G = gridDim.x * gridDim.y * gridDim.z;
    unsigned sum, cnt, mine, sp = 0u;
    for (;;) {
        sum = 0u; cnt = 0u; mine = 0u;
#pragma unroll
        for (unsigned j = 0; j < 16; ++j) { const unsigned c = xb_ld(&bar[XB_XCNT(j)]); sum += c; cnt += (c > 0u) ? 1u : 0u; }
        mine = xb_ld(&bar[XB_XCNT(x)]);
        if (sum == G) break;
        __builtin_amdgcn_s_sleep(1);
        if ((++sp & 255u) == 0u) { if (xb_ld(&bar[XB_TMO])) break; if (sp > XB_SPIN_CAP) { xb_add(&bar[XB_TMO], 1u); break; } }
    }
    nloc = mine > 0u ? mine : 1u; nx = cnt > 0u ? cnt : 1u;
}
__device__ __forceinline__ void xcd_barrier(const XcdBarrier& b) {
    asm volatile("s_waitcnt vmcnt(0)" ::: "memory");
    __syncthreads();
    if (threadIdx.x == 0) {
        unsigned* bar = b.bar; asm volatile("" : "+s"(bar));
        __builtin_amdgcn_s_waitcnt(0);
        unsigned nloc = b.st[0], nx = b.st[1];
        if (nloc == 0u) { xcd_barrier_complete(bar, b.x, nloc, nx); b.st[0] = nloc; b.st[1] = nx; }
        const unsigned old = xb_add(&bar[XB_XSUB(b.x)], 1u);
        const unsigned gen = old / nloc;
        if (old + 1u == (gen + 1u) * nloc) {
            __builtin_amdgcn_fence(__ATOMIC_RELEASE, "agent");
            asm volatile("s_waitcnt vmcnt(0)" ::: "memory");
            const unsigned og = xb_add(&bar[XB_TOP], 1u);
            const unsigned tg = og / nx;
            if (og + 1u == (tg + 1u) * nx) xb_add(&bar[XB_TOPGEN], 1u);
            else XB_SPIN(xb_ld(&bar[XB_TOPGEN]) == tg, bar);
            __builtin_amdgcn_fence(__ATOMIC_ACQUIRE, "agent");
            xb_add(&bar[XB_XGEN(b.x)], 1u);
            asm volatile("s_waitcnt vmcnt(0)" ::: "memory");
        } else {
            XB_SPIN(xb_ld(&bar[XB_XGEN(b.x)]) == gen, bar);
            __builtin_amdgcn_fence(__ATOMIC_ACQUIRE, "agent");
            asm volatile("s_waitcnt vmcnt(0)" ::: "memory");
        }
    }
    __syncthreads();
}

__device__ __forceinline__ int ftid() { int t = (int)threadIdx.x; asm volatile("" : "+v"(t)); return t; }
__device__ __forceinline__ int flane() { return ftid() & 63; }
__device__ __forceinline__ int fbid() { int b = (int)blockIdx.x; asm volatile("" : "+s"(b)); return b; }
struct Args { const float* in[23]; float* out; unsigned char* ws; int ph_lo, ph_hi; };
struct Frame {
    LAS unsigned char* lds;
    volatile LAS unsigned* MISC;
    unsigned* ctl;
    unsigned char* ws;
    int wave, vcu, G;
};
enum { I_X = 0, I_C, I_CTX, I_CCTX, I_ADAW, I_ADAB, I_NORMW, I_FNORMW, I_EVWIN, I_EVWOUT, I_RETDECAY, I_SINK, I_ODWIN, I_ODWOUT, I_LBLOG, I_HGNW,
       I_WG, I_BG, I_WE, I_BE, I_W1, I_W3, I_W2 };

__device__ __forceinline__ void conv_item(const float* srcp, int src_ld, bf16_t* WT, int K, int n0, int k0, LAS float* scr, int lane) {
#pragma unroll 8
    for (int i = 0; i < 32; ++i) { const int kk = 2 * i + (lane >> 5); scr[kk * 33 + (lane & 31)] = srcp[(size_t)(k0 + kk) * src_ld]; }
    LDS_WAIT(); asm volatile("" ::: "memory");
    const int c = lane & 7;
#pragma unroll
    for (int j = 0; j < 4; ++j) { const int n = (lane >> 3) + 8 * j; const LAS float* s = scr + (8 * c) * 33 + n;
        u32x4 o; o.x = pk2(s[0 * 33], s[1 * 33]); o.y = pk2(s[2 * 33], s[3 * 33]); o.z = pk2(s[4 * 33], s[5 * 33]); o.w = pk2(s[6 * 33], s[7 * 33]);
        *(u32x4*)(WT + (size_t)(n0 + n) * K + k0 + 8 * c) = o; }
    LDS_WAIT(); asm volatile("" ::: "memory");
}
__device__ __forceinline__ int head_perm(int n) { const int hh = n >> 7, phi = n & 127, g = phi >> 3, u = phi & 7; return hh * 128 + 64 * (g >> 3) + 4 * (g & 7) + (u & 3) + 32 * (u >> 2); }

__device__ __forceinline__ void p0_prologue(Frame& F, const Args& args) {
    LAS float* scr = (LAS float*)(F.lds + F.wave * 16384);
    const int gw = F.vcu * NWAVES + F.wave, NGW = F.G * NWAVES, lane = flane();
    constexpr int NI_EVIN = 16 * (EV_N / 32), NI_ODIN = 16 * (OD_N / 32), NI_OUT = 16 * 32, NI_W13 = 16 * 32, NI_W2 = 8 * 32;
    constexpr int NI_MOE1 = NI_W13 + NI_W2;
    constexpr int NITEMS = 2 * NI_EVIN + 2 * NI_ODIN + 4 * NI_OUT + DEPTH * NEXP * NI_MOE1;
    for (int rep_ = 0; rep_ <= REP_CONV; ++rep_)
    for (int it = gw; it < NITEMS; it += NGW) {
        int r = it;
        if (r < 2 * NI_EVIN) { const int p = r / NI_EVIN; r %= NI_EVIN; const int nblk = EV_N / 32, kb = r / nblk, nb = r % nblk; const int n = nb * 32 + (lane & 31);
            conv_item(args.in[I_EVWIN] + (size_t)p * DM * EV_N + head_perm(n), EV_N, (bf16_t*)(F.ws + WS_W_EVIN + (size_t)p * 6 * MiB), DM, nb * 32, kb * 64, scr, lane); continue; }
        r -= 2 * NI_EVIN;
        if (r < 2 * NI_ODIN) { const int p = r / NI_ODIN; r %= NI_ODIN; const int nblk = OD_N / 32, kb = r / nblk, nb = r % nblk; const int n = nb * 32 + (lane & 31);
            conv_item(args.in[I_ODWIN] + (size_t)p * DM * OD_N + head_perm(n), OD_N, (bf16_t*)(F.ws + WS_W_ODIN + (size_t)p * 10 * MiB), DM, nb * 32, kb * 64, scr, lane); continue; }
        r -= 2 * NI_ODIN;
        if (r < 4 * NI_OUT) { const int q = r / NI_OUT; r %= NI_OUT; const int kb = r / 32, nb = r % 32; const int n = nb * 32 + (lane & 31);
            const float* src = (q < 2 ? args.in[I_EVWOUT] + (size_t)q * DM * DM : args.in[I_ODWOUT] + (size_t)(q - 2) * DM * DM);
            bf16_t* dst = (bf16_t*)(F.ws + (q < 2 ? WS_W_EVOUT + (size_t)q * 2 * MiB : WS_W_ODOUT + (size_t)(q - 2) * 2 * MiB));
            conv_item(src + n, DM, dst, DM, nb * 32, kb * 64, scr, lane); continue; }
        r -= 4 * NI_OUT;
        { const int le = r / NI_MOE1; r %= NI_MOE1;
            bf16_t* dst = (bf16_t*)(F.ws + WS_W_MOE + (size_t)le * 3 * MiB);
            if (r < NI_W13) { const int kb = r / 32, nb = r % 32; const int n = nb * 32 + (lane & 31);
                const int Gq = n >> 3, u = n & 7; const float* src = (u < 4 ? args.in[I_W1] : args.in[I_W3]) + (size_t)le * DM * FF + 4 * Gq + (u & 3);
                conv_item(src, FF, dst, DM, nb * 32, kb * 64, scr, lane); }
            else { r -= NI_W13; const int kb = r / 32, nb = r % 32; const int n = nb * 32 + (lane & 31);
                conv_item(args.in[I_W2] + (size_t)le * FF * DM + n, DM, dst + (size_t)DM * DM, FF, nb * 32, kb * 64, scr, lane); }
        }
    }
    {
        f32x4* xr = (f32x4*)(F.ws + WS_XRES);
        const f32x4* xs = (const f32x4*)args.in[I_X]; const f32x4* cs = (const f32x4*)args.in[I_CTX];
        const size_t total = (size_t)MTOK * 256;
        for (size_t i = (size_t)fbid() * 512 + ftid(); i < total; i += (size_t)F.G * 512) {
            const int row = (int)(i >> 8), c4 = (int)(i & 255); const int b = row / SU, p = row % SU;
            xr[i] = (p < NCTX) ? cs[((size_t)(b * NCTX + p) << 8) + c4] : xs[((size_t)(b * LSEQ + p - NCTX) << 8) + c4];
        }
    }
    if (NAIVE_COPY) { float* xr2 = (float*)(F.ws + WS_XRES);
        for (size_t i = (size_t)fbid() * 512 + ftid(); i < (size_t)MTOK * DM; i += (size_t)F.G * 512) { const size_t row = i / DM; const int k = (int)(i % DM); const int b = (int)(row / SU), p = (int)(row % SU);
            xr2[i] = p < NCTX ? args.in[I_CTX][((size_t)b * NCTX + p) * DM + k] : args.in[I_X][((size_t)b * LSEQ + (p - NCTX)) * DM + k]; } }
    {
        float* sp = (float*)(F.ws + WS_SP);
        for (int i = fbid() * 512 + ftid(); i < SP_END; i += F.G * 512) {
            float v;
            if (i < SP_FNORMW) v = args.in[I_NORMW][i]; else if (i < SP_WG) v = args.in[I_FNORMW][i - SP_FNORMW]; else if (i < SP_BG) v = args.in[I_WG][i - SP_WG]; else if (i < SP_WE) v = args.in[I_BG][i - SP_BG];
            else if (i < SP_BE) v = args.in[I_WE][i - SP_WE]; else if (i < SP_DECAY) v = args.in[I_BE][i - SP_BE]; else if (i < SP_SINK) v = args.in[I_RETDECAY][i - SP_DECAY]; else if (i < SP_HGNW) v = args.in[I_SINK][i - SP_SINK]; else v = args.in[I_HGNW][i - SP_HGNW];
            sp[i] = v;
        }
    }
    if (blockIdx.x == 0) {
        float* lb = (float*)(F.ws + WS_LB); const float* lg = args.in[I_LBLOG];
        for (int c = ftid(); c < DM; c += 512) {
            const float a0 = lg[c], a1 = lg[DM + c], a2 = lg[2 * DM + c], a3 = lg[3 * DM + c];
            const float mx = fmaxf(fmaxf(a0, a1), fmaxf(a2, a3));
            const float e0 = expf(a0 - mx), e1 = expf(a1 - mx), e2 = expf(a2 - mx), e3 = expf(a3 - mx); const float inv = 1.0f / (e0 + e1 + e2 + e3);
            lb[c] = 0.f; lb[DM + c] = e1 * inv; lb[2 * DM + c] = (e1 + e2) * inv; lb[3 * DM + c] = (e1 + e2 + e3) * inv;
        }
    }
    if (blockIdx.x == 1) {
        float* rc = (float*)(F.ws + WS_ROPEC); float* rs = (float*)(F.ws + WS_ROPES);
        for (int i = ftid(); i < 64 * 32; i += 512) { const int pos = i >> 5, fi = i & 31;
            const float invf = powf(10000.0f, -(float)(2 * fi) / 64.0f); const float ang = (float)pos * invf;
            rc[i] = cosf(ang); rs[i] = sinf(ang); }
    }
    {
        __syncthreads();
        LAS float* sv = (LAS float*)F.lds;
        LAS float* part = (LAS float*)(F.lds + 20480);
        for (int i = ftid(); i < 5 * DM; i += 512) { const int r = i >> 10, k = i & 1023; const float v = (r < 4) ? args.in[I_C][r * DM + k] : args.in[I_CCTX][k]; sv[i] = siluf(v); }
        __syncthreads();
        float* mod = (float*)(F.ws + WS_MOD);
        for (int it = fbid(); it < DEPTH * 96; it += F.G) {
            const int l = it / 96, cg = it % 96; const int col = cg * 64 + lane;
            const float* w = args.in[I_ADAW] + (size_t)l * DM * 6144 + col;
            float a[5] = {0.f, 0.f, 0.f, 0.f, 0.f};
            const int k0 = F.wave * 128;
#pragma unroll 8
            for (int k = 0; k < 128; ++k) { const float wv = w[(size_t)(k0 + k) * 6144];
#pragma unroll
                for (int r = 0; r < 5; ++r) a[r] += sv[r * DM + k0 + k] * wv; }
#pragma unroll
            for (int r = 0; r < 5; ++r) part[(F.wave * 5 + r) * 64 + lane] = a[r];
            __syncthreads();
            if (ftid() < 320) { const int r = ftid() >> 6, c = ftid() & 63; float s = 0.f;
#pragma unroll
                for (int w8 = 0; w8 < 8; ++w8) s += part[(w8 * 5 + r) * 64 + c];
                mod[((size_t)l * 5 + r) * 6144 + cg * 64 + c] = s + args.in[I_ADAB][l * 6144 + cg * 64 + c]; }
            __syncthreads();
        }
    }
}

__device__ __forceinline__ int moe_tile_prefix(const unsigned* cnt, int lane, int& mycnt) {
    const int c = (lane < NEXP) ? (int)__hip_atomic_load(cnt + lane, __ATOMIC_RELAXED, __HIP_MEMORY_SCOPE_AGENT) : 0; mycnt = c;
    const int nt = (c + 255) >> 8; int incl = nt;
#pragma unroll
    for (int o = 1; o < 64; o <<= 1) { const int v = shup_i(incl, o, lane); if (lane >= o) incl += v; }
    return incl - nt;
}

template <bool FINAL>
__device__ __forceinline__ void n1_phase(Frame& F, const Args& args, int l) {
    const int gw = (MUT_A ? fbid() : F.vcu) * NWAVES + F.wave, NGW = F.G * NWAVES, lane = flane();
    float* xres = (float*)(F.ws + WS_XRES);
    const float* mod = (const float*)(F.ws + WS_MOD);
    int tprefix = 0, dummy;
    if (l > 0) tprefix = moe_tile_prefix(F.ctl + CW_CNT + (l - 1) * NEXP, lane, dummy);
    for (int rr_ = 0; rr_ < (MUT_D ? 64 : 9); ++rr_) {
        const int row = MUT_D ? (fbid() * 512 + F.wave * 64 + rr_) : (gw + rr_ * NGW); if (row >= MTOK) continue;
        const int b = row / SU, p = row % SU; const int mrow = (p < NCTX) ? 4 : b;
        if (FINAL && p < NCTX) continue;
        f32x4* xr = (f32x4*)(xres + (size_t)row * DM) + lane;
        f32x4 v[4];
#pragma unroll
        for (int j = 0; j < 4; ++j) v[j] = xr[64 * j];
        if (l > 0 && CONTRIB_MOE) {
            {
                unsigned* tiw = (unsigned*)(F.ws + WS_TOKINFO) + (size_t)row * 8;
                u32x4 t0, t1;
                t0.x = __hip_atomic_load(tiw + 0, __ATOMIC_RELAXED, __HIP_MEMORY_SCOPE_AGENT); t0.y = __hip_atomic_load(tiw + 1, __ATOMIC_RELAXED, __HIP_MEMORY_SCOPE_AGENT);
                t0.z = __hip_atomic_load(tiw + 2, __ATOMIC_RELAXED, __HIP_MEMORY_SCOPE_AGENT); t0.w = __hip_atomic_load(tiw + 3, __ATOMIC_RELAXED, __HIP_MEMORY_SCOPE_AGENT);
                t1.x = __hip_atomic_load(tiw + 4, __ATOMIC_RELAXED, __HIP_MEMORY_SCOPE_AGENT); t1.y = __hip_atomic_load(tiw + 5, __ATOMIC_RELAXED, __HIP_MEMORY_SCOPE_AGENT); t1.z = 0u; t1.w = 0u;
                const int ts0 = shidx_i(tprefix, (int)t0.x), ts1 = shidx_i(tprefix, (int)t0.z);
                const size_t s0 = (size_t)ts0 * 256 + t0.y, s1 = (size_t)ts1 * 256 + t0.w;
                const unsigned gb0 = t1.x, gb1 = t1.y;
                const float g0 = __builtin_bit_cast(float, gb0), g1 = __builtin_bit_cast(float, gb1);
                const u32x2* y0 = (const u32x2*)(F.ws + WS_YB + s0 * (DM * 2)) + lane; const u32x2* y1 = (const u32x2*)(F.ws + WS_YB + s1 * (DM * 2)) + lane;
                const f32x4* gp = (const f32x4*)(mod + ((size_t)(l - 1) * 5 + mrow) * 6144 + 5 * DM) + lane;
                if (NAIVE_MOE) {
                    const f32x4* n0 = (const f32x4*)(F.ws + WS_YN + (size_t)row * 2 * DM * 4) + lane; const f32x4* n1 = n0 + 256;
#pragma unroll
                    for (int j = 0; j < 4; ++j) { const f32x4 g = gp[64 * j]; v[j] = v[j] + g * (n0[64 * j] * g0 + n1[64 * j] * g1); }
                } else {
                if (MUT_B) {
                    const bf16_t* yy0 = (const bf16_t*)(F.ws + WS_YB) + s0 * DM; const bf16_t* yy1 = (const bf16_t*)(F.ws + WS_YB) + s1 * DM;
                    const float* gate = mod + ((size_t)(l - 1) * 5 + mrow) * 6144 + 5 * DM;
#pragma unroll
                    for (int j = 0; j < 4; ++j) { const int k = 4 * lane + 256 * j;
                        v[j].x += gate[k] * (g0 * bf2f(yy0[k]) + g1 * bf2f(yy1[k])); v[j].y += gate[k + 1] * (g0 * bf2f(yy0[k + 1]) + g1 * bf2f(yy1[k + 1]));
                        v[j].z += gate[k + 2] * (g0 * bf2f(yy0[k + 2]) + g1 * bf2f(yy1[k + 2])); v[j].w += gate[k + 3] * (g0 * bf2f(yy0[k + 3]) + g1 * bf2f(yy1[k + 3])); }
                } else {
#pragma unroll
                for (int j = 0; j < 4; ++j) { const u32x2 a = y0[64 * j], c = y1[64 * j]; const f32x4 g = gp[64 * j];
                    v[j].x += g.x * (g0 * bflo(a.x) + g1 * bflo(c.x)); v[j].y += g.y * (g0 * bfhi(a.x) + g1 * bfhi(c.x));
                    v[j].z += g.z * (g0 * bflo(a.y) + g1 * bflo(c.y)); v[j].w += g.w * (g0 * bfhi(a.y) + g1 * bfhi(c.y)); }
                }
                }
                if (!FINAL) {
#pragma unroll
                    for (int j = 0; j < 4; ++j) xr[64 * j] = v[j];
                }
            }
        }
        float s = 0.f;
#pragma unroll
        for (int j = 0; j < 4; ++j) s += (v[j].x * v[j].x + v[j].y * v[j].y) + (v[j].z * v[j].z + v[j].w * v[j].w);
        const float rstd = 1.0f / sqrtf(wave_sum(s, lane) * (1.0f / DM) + EPS);
        if (FINAL) {
            const f32x4* nw = (const f32x4*)((const float*)(F.ws + WS_SP) + SP_FNORMW) + lane;
            f32x4* o = (f32x4*)(args.out + ((size_t)b * LSEQ + (p - NCTX)) * DM) + lane;
#pragma unroll
            for (int j = 0; j < 4; ++j) { const f32x4 w = nw[64 * j]; o[64 * j] = v[j] * rstd * w; }
        } else {
            const f32x4* nw = (const f32x4*)(((const float*)(F.ws + WS_SP) + SP_NORMW) + (size_t)(l * 2 + 0) * DM) + lane;
            const f32x4* sh = (const f32x4*)(mod + ((size_t)l * 5 + mrow) * 6144 + 0 * DM) + lane;
            const f32x4* sc = (const f32x4*)(mod + ((size_t)l * 5 + mrow) * 6144 + 1 * DM) + lane;
            u32x2* o = (u32x2*)(F.ws + WS_HB + (size_t)row * (DM * 2)) + lane;
#pragma unroll
            for (int j = 0; j < 4; ++j) { const f32x4 w = nw[64 * j], a = sh[64 * j], c = sc[64 * j]; const f32x4 h = v[j] * rstd * w * (c + 1.0f) + a;
                u32x2 q; q.x = pk2(h.x, h.y); q.y = pk2(h.z, h.w); o[64 * j] = q; }
        }
    }
}

__device__ __forceinline__ void naive_n1(Frame& F, const Args& args, int l, bool final_) {
    float* xres = (float*)(F.ws + WS_XRES);
    const float* mod = (const float*)(F.ws + WS_MOD);
    for (int row = fbid() * 512 + ftid(); row < MTOK; row += F.G * 512) {
        const int b = row / SU, p = row % SU; const int mrow = (p < NCTX) ? 4 : b;
        if (final_ && p < NCTX) continue;
        float* xr = xres + (size_t)row * DM;
        if (l > 0) {
            const unsigned* cnt = F.ctl + CW_CNT + (l - 1) * NEXP;
            const unsigned* ti = (const unsigned*)(F.ws + WS_TOKINFO) + (size_t)row * 8;
            const unsigned e0 = ti[0], p0 = ti[1], e1 = ti[2], p1 = ti[3]; const float g0 = __builtin_bit_cast(float, ti[4]), g1 = __builtin_bit_cast(float, ti[5]);
            int ts0 = 0, ts1 = 0; for (unsigned e = 0; e < e0; ++e) ts0 += ((int)cnt[e] + 255) / 256; for (unsigned e = 0; e < e1; ++e) ts1 += ((int)cnt[e] + 255) / 256;
            const bf16_t* y0 = (const bf16_t*)(F.ws + WS_YB) + ((size_t)ts0 * 256 + p0) * DM; const bf16_t* y1 = (const bf16_t*)(F.ws + WS_YB) + ((size_t)ts1 * 256 + p1) * DM;
            const float* gate = mod + ((size_t)(l - 1) * 5 + mrow) * 6144 + 5 * DM;
            for (int k = 0; k < DM; ++k) xr[k] = xr[k] + gate[k] * (g0 * bf2f(y0[k]) + g1 * bf2f(y1[k]));
        }
        double ss = 0.0; for (int k = 0; k < DM; ++k) ss += (double)xr[k] * xr[k];
        const float rstd = 1.0f / sqrtf((float)(ss / DM) + EPS);
        if (final_) { float* o = args.out + ((size_t)b * LSEQ + (p - NCTX)) * DM; for (int k = 0; k < DM; ++k) o[k] = xr[k] * rstd * args.in[I_FNORMW][k]; }
        else { bf16_t* hb = (bf16_t*)(F.ws + WS_HB) + (size_t)row * DM; const float* nw = args.in[I_NORMW] + (size_t)(l * 2) * DM; const float* mr = mod + ((size_t)l * 5 + mrow) * 6144;
            for (int k = 0; k < DM; ++k) hb[k] = (bf16_t)f2bf(xr[k] * rstd * nw[k] * (1.0f + mr[DM + k]) + mr[k]); }
    }
}
__device__ __forceinline__ void wave_n1(Frame& F, const Args& args, int l, bool final_) {
    float* xres = (float*)(F.ws + WS_XRES);
    const float* mod = (const float*)(F.ws + WS_MOD);
    const int gw = F.vcu * NWAVES + F.wave, NGW = F.G * NWAVES, lane = flane();
    for (int row = gw; row < MTOK; row += NGW) {
        const int b = row / SU, p = row % SU; const int mrow = (p < NCTX) ? 4 : b;
        if (final_ && p < NCTX) continue;
        float* xr = xres + (size_t)row * DM;
        float xv[16];
#pragma unroll
        for (int i = 0; i < 16; ++i) xv[i] = xr[lane + 64 * i];
        if (l > 0) {
            const unsigned* cnt = F.ctl + CW_CNT + (l - 1) * NEXP;
            const unsigned* ti = (const unsigned*)(F.ws + WS_TOKINFO) + (size_t)row * 8;
            const unsigned e0 = ti[0], p0 = ti[1], e1 = ti[2], p1 = ti[3]; const float g0 = __builtin_bit_cast(float, ti[4]), g1 = __builtin_bit_cast(float, ti[5]);
            int ts0 = 0, ts1 = 0; for (unsigned e = 0; e < e0; ++e) ts0 += ((int)cnt[e] + 255) / 256; for (unsigned e = 0; e < e1; ++e) ts1 += ((int)cnt[e] + 255) / 256;
            const bf16_t* y0 = (const bf16_t*)(F.ws + WS_YB) + ((size_t)ts0 * 256 + p0) * DM; const bf16_t* y1 = (const bf16_t*)(F.ws + WS_YB) + ((size_t)ts1 * 256 + p1) * DM;
            const float* gate = mod + ((size_t)(l - 1) * 5 + mrow) * 6144 + 5 * DM;
#pragma unroll
            for (int i = 0; i < 16; ++i) { const int k = lane + 64 * i; xv[i] = xv[i] + gate[k] * (g0 * bf2f(y0[k]) + g1 * bf2f(y1[k])); if (!final_) xr[k] = xv[i]; }
        }
        float ss = 0.f;
#pragma unroll
        for (int i = 0; i < 16; ++i) ss += xv[i] * xv[i];
        const float rstd = 1.0f / sqrtf(wave_sum(ss, lane) * (1.0f / DM) + EPS);
        if (final_) { float* o = args.out + ((size_t)b * LSEQ + (p - NCTX)) * DM;
#pragma unroll
            for (int i = 0; i < 16; ++i) { const int k = lane + 64 * i; o[k] = xv[i] * rstd * args.in[I_FNORMW][k]; } }
        else { bf16_t* hb = (bf16_t*)(F.ws + WS_HB) + (size_t)row * DM; const float* nw = args.in[I_NORMW] + (size_t)(l * 2) * DM; const float* mr = mod + ((size_t)l * 5 + mrow) * 6144;
#pragma unroll
            for (int i = 0; i < 16; ++i) { const int k = lane + 64 * i; hb[k] = (bf16_t)f2bf(xv[i] * rstd * nw[k] * (1.0f + mr[DM + k]) + mr[k]); } }
    }
}
__device__ __forceinline__ void n2r_phase(Frame& F, const Args& args, int l) {
    const int gw = F.vcu * NWAVES + F.wave, NGW = F.G * NWAVES, lane = flane();
    const float* xres = (const float*)(F.ws + WS_XRES);
    const float* mod = (const float*)(F.ws + WS_MOD);
    unsigned* cnt = F.ctl + CW_CNT + l * NEXP;
    unsigned* list = (unsigned*)(F.ws + WS_LIST);
    const float* wg = ((const float*)(F.ws + WS_SP) + SP_WG) + (size_t)l * DM * 4; const float* bg = ((const float*)(F.ws + WS_SP) + SP_BG) + l * 4;
    const float* we = ((const float*)(F.ws + WS_SP) + SP_WE) + (size_t)l * 4 * DM * 8; const float* be = ((const float*)(F.ws + WS_SP) + SP_BE) + l * 32;
    LAS float* wgT = (LAS float*)F.lds; LAS float* weT = wgT + 4 * DM;
    LAS unsigned* hist = (LAS unsigned*)(F.lds + LDSCTL_OFF + 1024); LAS unsigned* baseL = hist + 32; LAS unsigned* rec = hist + 64 + F.wave * 36;
    __syncthreads();
    if (ftid() < 32) hist[ftid()] = 0u;
    {   const int t = ftid();
        for (int r = t; r < DM; r += 512) { const f32x4 a = *(const f32x4*)(wg + (size_t)r * 4); wgT[r] = a.x; wgT[DM + r] = a.y; wgT[2 * DM + r] = a.z; wgT[3 * DM + r] = a.w; }
        for (int r = t; r < 4 * DM; r += 512) { const int g = r >> 10, c = r & 1023; const f32x4 a = *(const f32x4*)(we + (size_t)r * 8), b2 = *(const f32x4*)(we + (size_t)r * 8 + 4);
            LAS float* d = weT + g * 8 * DM + c; d[0] = a.x; d[DM] = a.y; d[2 * DM] = a.z; d[3 * DM] = a.w; d[4 * DM] = b2.x; d[5 * DM] = b2.y; d[6 * DM] = b2.z; d[7 * DM] = b2.w; }
    }
    __syncthreads();
    for (int k_ = 0; k_ < 9; ++k_) {
        const int row = gw + k_ * NGW; if (row >= MTOK) break;
        const int b = row / SU, p = row % SU; const int mrow = (p < NCTX) ? 4 : b;
        if (l == DEPTH - 1 && p < NCTX) continue;
        const f32x4* xr = (const f32x4*)(xres + (size_t)row * DM) + lane;
        f32x4 v[4]; float s = 0.f;
#pragma unroll
        for (int j = 0; j < 4; ++j) { v[j] = xr[64 * j]; s += (v[j].x * v[j].x + v[j].y * v[j].y) + (v[j].z * v[j].z + v[j].w * v[j].w); }
        const float rstd = 1.0f / sqrtf(wave_sum(s, lane) * (1.0f / DM) + EPS);
        const f32x4* nw = (const f32x4*)(((const float*)(F.ws + WS_SP) + SP_NORMW) + (size_t)(l * 2 + 1) * DM) + lane;
        const f32x4* sh = (const f32x4*)(mod + ((size_t)l * 5 + mrow) * 6144 + 3 * DM) + lane;
        const f32x4* sc = (const f32x4*)(mod + ((size_t)l * 5 + mrow) * 6144 + 4 * DM) + lane;
        u32x2* o = (u32x2*)(F.ws + WS_HB + (size_t)row * (DM * 2)) + lane;
        float gl[4] = {0.f, 0.f, 0.f, 0.f};
#pragma unroll
        for (int j = 0; j < 4; ++j) { const f32x4 w = nw[64 * j], a = sh[64 * j], c = sc[64 * j]; const f32x4 h = v[j] * rstd * w * (c + 1.0f) + a; v[j] = h;
            u32x2 q; q.x = pk2(h.x, h.y); q.y = pk2(h.z, h.w); o[64 * j] = q;
#pragma unroll
            for (int g = 0; g < 4; ++g) { const f32x4 wv = *(const LAS f32x4*)(wgT + g * DM + 4 * lane + 256 * j); gl[g] += (h.x * wv.x + h.y * wv.y) + (h.z * wv.z + h.w * wv.w); } }
#pragma unroll
        for (int g = 0; g < 4; ++g) gl[g] = wave_sum(gl[g], lane) + bg[g];
        int gi = 0; float gm = gl[0];
#pragma unroll
        for (int g = 1; g < 4; ++g) if (gl[g] > gm) { gm = gl[g]; gi = g; }
        const float gp = 1.0f / (expf(gl[0] - gm) + expf(gl[1] - gm) + expf(gl[2] - gm) + expf(gl[3] - gm));
        const LAS float* weg = weT + gi * 8 * DM;
        float el[8] = {0.f, 0.f, 0.f, 0.f, 0.f, 0.f, 0.f, 0.f};
#pragma unroll
        for (int j = 0; j < 4; ++j) {
#pragma unroll
            for (int e = 0; e < 8; ++e) { const f32x4 wv = *(const LAS f32x4*)(weg + e * DM + 4 * lane + 256 * j); el[e] += (v[j].x * wv.x + v[j].y * wv.y) + (v[j].z * wv.z + v[j].w * wv.w); }
        }
#pragma unroll
        for (int e = 0; e < 8; ++e) el[e] = wave_sum(el[e], lane) + be[gi * 8 + e];
        int i0 = 0; float v0 = el[0];
#pragma unroll
        for (int e = 1; e < 8; ++e) if (el[e] > v0) { v0 = el[e]; i0 = e; }
        int i1 = -1; float v1 = -3.0e38f;
#pragma unroll
        for (int e = 0; e < 8; ++e) if (e != i0 && el[e] > v1) { v1 = el[e]; i1 = e; }
        const float w0 = 1.0f / (1.0f + expf(v1 - v0)), w1 = 1.0f - w0;
        if (lane == 0) {
            const unsigned e0 = (unsigned)(gi * 8 + i0), e1 = (unsigned)(gi * 8 + i1);
            const unsigned lp0 = __hip_atomic_fetch_add(hist + e0, 1u, __ATOMIC_RELAXED, __HIP_MEMORY_SCOPE_WORKGROUP), lp1 = __hip_atomic_fetch_add(hist + e1, 1u, __ATOMIC_RELAXED, __HIP_MEMORY_SCOPE_WORKGROUP);
            rec[k_ * 4 + 0] = e0; rec[k_ * 4 + 1] = lp0; rec[k_ * 4 + 2] = e1; rec[k_ * 4 + 3] = lp1;
            u32x4* ti = (u32x4*)(F.ws + WS_TOKINFO) + (size_t)row * 2;
            ti[1] = (u32x4){__builtin_bit_cast(unsigned, gp * w0), __builtin_bit_cast(unsigned, gp * w1), 0u, 0u};
        }
    }
    __syncthreads();
    if (ftid() < 32) { const unsigned hc = hist[ftid()]; baseL[ftid()] = hc ? atomicAdd(cnt + ftid(), hc) : 0u; }
    __syncthreads();
    if (lane == 0) {
        for (int k_ = 0; k_ < 9; ++k_) {
            const int row = gw + k_ * NGW; if (row >= MTOK) break;
            if (l == DEPTH - 1 && (row % SU) < NCTX) continue;
            const unsigned e0 = rec[k_ * 4 + 0], e1 = rec[k_ * 4 + 2]; const unsigned p0 = baseL[e0] + rec[k_ * 4 + 1], p1 = baseL[e1] + rec[k_ * 4 + 3];
            list[(size_t)e0 * LIST_CAP + p0] = (unsigned)row; list[(size_t)e1 * LIST_CAP + p1] = (unsigned)row;
            u32x4* ti = (u32x4*)(F.ws + WS_TOKINFO) + (size_t)row * 2;
            ti[0] = (u32x4){e0, p0, e1, p1};
        }
    }
    __syncthreads();
}

__device__ __forceinline__ void naive_n2r(Frame& F, const Args& args, int l) {
    const float* xres = (const float*)(F.ws + WS_XRES);
    const float* mod = (const float*)(F.ws + WS_MOD);
    unsigned* cnt = F.ctl + CW_CNT + l * NEXP;
    unsigned* list = (unsigned*)(F.ws + WS_LIST);
    const float* wg = args.in[I_WG] + (size_t)l * DM * 4; const float* bg = args.in[I_BG] + l * 4;
    const float* we = args.in[I_WE] + (size_t)l * 4 * DM * 8; const float* be = args.in[I_BE] + l * 32;
    for (int row = fbid() * 512 + ftid(); row < MTOK; row += F.G * 512) {
        const int b = row / SU, p = row % SU; const int mrow = (p < NCTX) ? 4 : b;
        if (l == DEPTH - 1 && p < NCTX) continue;
        const float* xr = xres + (size_t)row * DM; double ss = 0.0;
        for (int k = 0; k < DM; ++k) ss += (double)xr[k] * xr[k];
        const float rstd = 1.0f / sqrtf((float)(ss / DM) + EPS);
        const float* nw = args.in[I_NORMW] + (size_t)(l * 2 + 1) * DM; const float* mr = mod + ((size_t)l * 5 + mrow) * 6144;
        bf16_t* hb = (bf16_t*)(F.ws + WS_HB) + (size_t)row * DM;
        float gl[4] = {bg[0], bg[1], bg[2], bg[3]};
        for (int k = 0; k < DM; ++k) { const float h = xr[k] * rstd * nw[k] * (1.0f + mr[4 * DM + k]) + mr[3 * DM + k]; hb[k] = (bf16_t)f2bf(h);
            gl[0] += h * wg[k * 4 + 0]; gl[1] += h * wg[k * 4 + 1]; gl[2] += h * wg[k * 4 + 2]; gl[3] += h * wg[k * 4 + 3]; }
        int gi = 0; for (int g = 1; g < 4; ++g) if (gl[g] > gl[gi]) gi = g;
        float den = 0.f; for (int g = 0; g < 4; ++g) den += expf(gl[g] - gl[gi]);
        const float gp = 1.0f / den;
        float el[8]; for (int e = 0; e < 8; ++e) el[e] = be[gi * 8 + e];
        for (int k = 0; k < DM; ++k) { const float h = xr[k] * rstd * nw[k] * (1.0f + mr[4 * DM + k]) + mr[3 * DM + k]; const float* wr = we + ((size_t)gi * DM + k) * 8;
#pragma unroll
            for (int e = 0; e < 8; ++e) el[e] += h * wr[e]; }
        int i0 = 0; for (int e = 1; e < 8; ++e) if (el[e] > el[i0]) i0 = e;
        int i1 = (i0 == 0) ? 1 : 0; for (int e = 0; e < 8; ++e) if (e != i0 && el[e] > el[i1]) i1 = e;
        const float m2 = el[i0]; const float a0 = 1.0f, a1 = expf(el[i1] - m2); const float w0 = a0 / (a0 + a1), w1 = a1 / (a0 + a1);
        const unsigned e0 = (unsigned)(gi * 8 + i0), e1 = (unsigned)(gi * 8 + i1);
        const unsigned p0 = atomicAdd(cnt + e0, 1u), p1 = atomicAdd(cnt + e1, 1u);
        list[(size_t)e0 * LIST_CAP + p0] = (unsigned)row; list[(size_t)e1 * LIST_CAP + p1] = (unsigned)row;
        u32x4* ti = (u32x4*)(F.ws + WS_TOKINFO) + (size_t)row * 2;
        ti[0] = (u32x4){e0, p0, e1, p1}; ti[1] = (u32x4){__builtin_bit_cast(unsigned, gp * w0), __builtin_bit_cast(unsigned, gp * w1), 0u, 0u};
    }
}

struct EpiProj {
    static constexpr bool PERM = true;
    unsigned char* ws; const float* lb; int odd;
    __device__ __forceinline__ void operator()(const f32x4 (&acc)[2][2][4][2], const pg8::Unit& u, int wr, int wc, int fr, int fq) const {
        const int pmb = u.pm % 17; const bool isctx = (pmb == 0); const int tbase = (pmb - 1) * 256;
        const int g = 4 * wc + fq, half = g >> 3, f0 = 4 * (g & 7);
        const float* ropec = (const float*)(ws + WS_ROPEC); const float* ropes = (const float*)(ws + WS_ROPES);
#pragma unroll
        for (int bj = 0; bj < 2; ++bj) {
            const int hcol = 256 * u.pn + 128 * bj; const int lc0 = hcol + 64 * half + f0;
            if (!odd) {
                const bool rope = !isctx && (hcol < 1024 || (hcol >= 2048 && hcol < 2816));
                const float scale = (hcol >= 512 && hcol < 1024) ? 0.08838834764831845f : 1.0f;
                bf16_t* dst = (bf16_t*)(ws + WS_PE);
#pragma unroll
                for (int ai = 0; ai < 2; ++ai)
#pragma unroll
                    for (int m = 0; m < 4; ++m) {
                        const int rr = 128 * ai + 64 * wr + 16 * m + fr; const size_t row = (size_t)u.pm * 256 + rr;
                        f32x4 x1 = acc[ai][bj][m][0] * scale, x2 = acc[ai][bj][m][1] * scale;
                        if (rope) { const int t = tbase + rr; const int pos = half ? (t & 63) : (t >> 6);
                            const f32x4 c = *(const f32x4*)(ropec + pos * 32 + f0), s = *(const f32x4*)(ropes + pos * 32 + f0);
                            const f32x4 o1 = x1 * c - x2 * s, o2 = x2 * c + x1 * s; x1 = o1; x2 = o2; }
                        u32x2 q1, q2; q1.x = pk2(x1.x, x1.y); q1.y = pk2(x1.z, x1.w); q2.x = pk2(x2.x, x2.y); q2.y = pk2(x2.z, x2.w);
                        *(u32x2*)(dst + row * EV_N + lc0) = q1; *(u32x2*)(dst + row * EV_N + lc0 + 32) = q2;
                    }
            } else {
                const int seg = hcol >> 10, c0 = lc0 & 1023;
                if (seg == 1 || seg == 2) {
                    float* dst = (float*)(ws + (seg == 1 ? WS_FF : WS_FB));
                    const f32x4 l1 = *(const f32x4*)(lb + c0), l2 = *(const f32x4*)(lb + c0 + 32);
#pragma unroll
                    for (int ai = 0; ai < 2; ++ai)
#pragma unroll
                        for (int m = 0; m < 4; ++m) {
                            const size_t row = (size_t)u.pm * 256 + 128 * ai + 64 * wr + 16 * m + fr;
                            const f32x4 z1 = acc[ai][bj][m][0], z2 = acc[ai][bj][m][1]; f32x4 f1, f2;
                            f1.x = l1.x + (1.f - l1.x) / (1.f + __expf(-z1.x)); f1.y = l1.y + (1.f - l1.y) / (1.f + __expf(-z1.y)); f1.z = l1.z + (1.f - l1.z) / (1.f + __expf(-z1.z)); f1.w = l1.w + (1.f - l1.w) / (1.f + __expf(-z1.w));
                            f2.x = l2.x + (1.f - l2.x) / (1.f + __expf(-z2.x)); f2.y = l2.y + (1.f - l2.y) / (1.f + __expf(-z2.y)); f2.z = l2.z + (1.f - l2.z) / (1.f + __expf(-z2.z)); f2.w = l2.w + (1.f - l2.w) / (1.f + __expf(-z2.w));
                            *(f32x4*)(dst + row * DM + c0) = f1; *(f32x4*)(dst + row * DM + c0 + 32) = f2;
                        }
                } else {
                    bf16_t* dst = (bf16_t*)(ws + (seg == 0 ? WS_PQ : (seg == 3 ? WS_PI : WS_PG)));
#pragma unroll
                    for (int ai = 0; ai < 2; ++ai)
#pragma unroll
                        for (int m = 0; m < 4; ++m) {
                            const size_t row = (size_t)u.pm * 256 + 128 * ai + 64 * wr + 16 * m + fr;
                            const f32x4 x1 = acc[ai][bj][m][0], x2 = acc[ai][bj][m][1];
                            u32x2 q1, q2; q1.x = pk2(x1.x, x1.y); q1.y = pk2(x1.z, x1.w); q2.x = pk2(x2.x, x2.y); q2.y = pk2(x2.z, x2.w);
                            *(u32x2*)(dst + row * DM + c0) = q1; *(u32x2*)(dst + row * DM + c0 + 32) = q2;
                        }
                }
            }
        }
    }
};
struct EpiOut {
    static constexpr bool PERM = false;
    float* xres; const float* modl; int enable;
    __device__ __forceinline__ void operator()(const f32x4 (&acc)[2][2][4][2], const pg8::Unit& u, int wr, int wc, int fr, int fq) const {
        if (!enable) return;
        const int pmb = u.pm % 17; const int mrow = (pmb == 0) ? 4 : (u.pm / 17);
        const float* gate = modl + (size_t)mrow * 6144 + 2 * DM;
#pragma unroll
        for (int bj = 0; bj < 2; ++bj)
#pragma unroll
            for (int n = 0; n < 2; ++n) {
                const int c = 256 * u.pn + 128 * bj + 32 * wc + 16 * n + 4 * fq; const f32x4 gv = *(const f32x4*)(gate + c);
#pragma unroll
                for (int ai = 0; ai < 2; ++ai)
#pragma unroll
                    for (int m = 0; m < 4; ++m) { f32x4* p = (f32x4*)(xres + ((size_t)u.pm * 256 + 128 * ai + 64 * wr + 16 * m + fr) * DM + c); *p = *p + gv * acc[ai][bj][m][n]; }
            }
    }
};
struct EpiAct {
    static constexpr bool PERM = true;
    bf16_t* Act;
    __device__ __forceinline__ void operator()(const f32x4 (&acc)[2][2][4][2], const pg8::Unit& u, int wr, int wc, int fr, int fq) const {
#pragma unroll
        for (int bj = 0; bj < 2; ++bj) { const int Gq = 32 * u.pn + 16 * bj + 4 * wc + fq;
#pragma unroll
            for (int ai = 0; ai < 2; ++ai)
#pragma unroll
                for (int m = 0; m < 4; ++m) { const size_t row = (size_t)u.tile * 256 + 128 * ai + 64 * wr + 16 * m + fr;
                    const f32x4 a = acc[ai][bj][m][0], b = acc[ai][bj][m][1];
                    u32x2 q; q.x = pk2(siluf(a.x) * b.x, siluf(a.y) * b.y); q.y = pk2(siluf(a.z) * b.z, siluf(a.w) * b.w);
                    *(u32x2*)(Act + row * FF + 4 * Gq) = q; } }
    }
};
struct EpiY {
    static constexpr bool PERM = true;
    bf16_t* YB;
    __device__ __forceinline__ void operator()(const f32x4 (&acc)[2][2][4][2], const pg8::Unit& u, int wr, int wc, int fr, int fq) const {
#pragma unroll
        for (int bj = 0; bj < 2; ++bj) { const int c = 256 * u.pn + 128 * bj + 32 * wc + 8 * fq;
#pragma unroll
            for (int ai = 0; ai < 2; ++ai)
#pragma unroll
                for (int m = 0; m < 4; ++m) { const size_t row = (size_t)u.tile * 256 + 128 * ai + 64 * wr + 16 * m + fr;
                    const f32x4 a = acc[ai][bj][m][0], b = acc[ai][bj][m][1];
                    u32x4 q; q.x = pk2(a.x, a.y); q.y = pk2(a.z, a.w); q.z = pk2(b.x, b.y); q.w = pk2(b.z, b.w);
                    *(u32x4*)(YB + row * DM + c) = q; } }
    }
};

__device__ __forceinline__ void naive_g1(Frame& F, const Args& args, int l) {
    const int odd = l & 1, p = l >> 1; const int N = odd ? OD_N : EV_N;
    const float* W = (odd ? args.in[I_ODWIN] : args.in[I_EVWIN]) + (size_t)p * DM * N;
    LAS float* sh = (LAS float*)F.lds;
    const float* lb = (const float*)(F.ws + WS_LB) + l * DM;
    const float* ropec = (const float*)(F.ws + WS_ROPEC); const float* ropes = (const float*)(F.ws + WS_ROPES);
    for (int rg = fbid(); rg < MTOK / 8; rg += F.G) {
        __syncthreads();
        if (NAIVE_G1 == 2) {
            const int row = rg * 8 + F.wave; const int bb = row / SU, pp = row % SU; const int mrow = pp < NCTX ? 4 : bb;
            const float* xr = (const float*)(F.ws + WS_XRES) + (size_t)row * DM; float ssq = 0.f;
            for (int k = flane(); k < DM; k += 64) ssq += xr[k] * xr[k];
            ssq = wave_sum(ssq, flane()); const float rs = 1.0f / sqrtf(ssq / (float)DM + EPS);
            const float* modr = (const float*)(F.ws + WS_MOD) + ((size_t)l * 5 + mrow) * 6144;
            for (int k = flane(); k < DM; k += 64) sh[F.wave * DM + k] = xr[k] * rs * args.in[I_NORMW][(size_t)(l * 2) * DM + k] * (1.0f + modr[DM + k]) + modr[k];
        } else
        for (int i = ftid(); i < 8 * DM; i += 512) sh[i] = bf2f(((const bf16_t*)(F.ws + WS_HB))[(size_t)rg * 8 * DM + i]);
        __syncthreads();
        for (int pi = ftid(); pi < N / 2; pi += 512) {
            const int hh = pi >> 6, rem = pi & 63, half = rem >> 5, d = rem & 31; const int cA = 128 * hh + 64 * half + d, cB = cA + 32;
            float a[8], bq[8];
#pragma unroll
            for (int r = 0; r < 8; ++r) { a[r] = 0.f; bq[r] = 0.f; }
            for (int k = 0; k < DM; ++k) { const float wa = W[(size_t)k * N + cA], wb = W[(size_t)k * N + cB];
#pragma unroll
                for (int r = 0; r < 8; ++r) { const float hv = sh[r * DM + k]; a[r] += hv * wa; bq[r] += hv * wb; } }
            const int hcol = 128 * hh;
#pragma unroll
            for (int r = 0; r < 8; ++r) {
                const int row = rg * 8 + r; const int pp = row % SU; const bool isctx = pp < NCTX; const int t = pp - NCTX;
                float x1 = a[r], x2 = bq[r];
                if (!odd) {
                    const bool rope = !isctx && (hcol < 1024 || (hcol >= 2048 && hcol < 2816));
                    if (hcol >= 512 && hcol < 1024) { x1 *= 0.08838834764831845f; x2 *= 0.08838834764831845f; }
                    if (rope) { const int pos = half ? (t & 63) : (t >> 6); float cc = ropec[pos * 32 + d], sn = ropes[pos * 32 + d];
                        if (NAIVE_G1 == 3) { const double ang = (double)((float)pos * powf(10000.0f, -(float)d / 32.0f)); cc = (float)cos(ang); sn = (float)sin(ang); }
                        const float o1 = x1 * cc - x2 * sn, o2 = x2 * cc + x1 * sn; x1 = o1; x2 = o2; }
                    bf16_t* dst = (bf16_t*)(F.ws + WS_PE) + (size_t)row * EV_N; dst[cA] = (bf16_t)f2bf(x1); dst[cB] = (bf16_t)f2bf(x2);
                } else {
                    const int seg = hcol >> 10, c0 = cA & 1023;
                    if (seg == 1 || seg == 2) { float* dst = (float*)(F.ws + (seg == 1 ? WS_FF : WS_FB)) + (size_t)row * DM;
                        float lba = lb[c0], lbb = lb[c0 + 32];
                        if (NAIVE_G1 == 3) { const float* lg = args.in[I_LBLOG]; float ea[4], eb[4], sa = 0.f, sb2 = 0.f; for (int q = 0; q < 4; ++q) { ea[q] = expf(lg[q * DM + c0]); eb[q] = expf(lg[q * DM + c0 + 32]); sa += ea[q]; sb2 += eb[q]; }
                            lba = 0.f; lbb = 0.f; for (int q = 1; q <= l; ++q) { lba += ea[q] / sa; lbb += eb[q] / sb2; } }
                        dst[c0] = lba + (1.f - lba) / (1.f + expf(-x1)); dst[c0 + 32] = lbb + (1.f - lbb) / (1.f + expf(-x2)); }
                    else { bf16_t* dst = (bf16_t*)(F.ws + (seg == 0 ? WS_PQ : (seg == 3 ? WS_PI : WS_PG))) + (size_t)row * DM; dst[c0] = (bf16_t)f2bf(x1); dst[c0 + 32] = (bf16_t)f2bf(x2); }
                }
            }
        }
    }
    __syncthreads();
}

__device__ __forceinline__ void naive_g2(Frame& F, const Args& args, int l) {
    const int odd = l & 1, p = l >> 1;
    const float* W = (odd ? args.in[I_ODWOUT] : args.in[I_EVWOUT]) + (size_t)p * DM * DM;
    LAS float* sh = (LAS float*)F.lds;
    const float* modl = (const float*)(F.ws + WS_MOD) + (size_t)l * 5 * 6144;
    float* xres = (float*)(F.ws + WS_XRES);
    for (int rg = fbid(); rg < MTOK / 8; rg += F.G) {
        __syncthreads();
        for (int i = ftid(); i < 8 * DM; i += 512) sh[i] = bf2f(((const bf16_t*)(F.ws + WS_YB16))[(size_t)rg * 8 * DM + i]);
        __syncthreads();
        for (int col = ftid(); col < DM; col += 512) {
            float a[8];
#pragma unroll
            for (int r = 0; r < 8; ++r) a[r] = 0.f;
            for (int k = 0; k < DM; ++k) { const float wa = W[(size_t)k * DM + col];
#pragma unroll
                for (int r = 0; r < 8; ++r) a[r] += sh[r * DM + k] * wa; }
#pragma unroll
            for (int r = 0; r < 8; ++r) { const int row = rg * 8 + r; const int b = row / SU, pp = row % SU; const int mrow = pp < NCTX ? 4 : b;
                xres[(size_t)row * DM + col] += modl[(size_t)mrow * 6144 + 2 * DM + col] * a[r]; }
        }
    }
    __syncthreads();
}
__device__ __forceinline__ void naive_mod(Frame& F, const Args& args) {
    float* mod = (float*)(F.ws + WS_MOD);
    for (int i = fbid() * 512 + ftid(); i < DEPTH * 5 * 6144; i += F.G * 512) {
        const int col = i % 6144, r = (i / 6144) % 5, l = i / (5 * 6144);
        const float* cv = r < 4 ? args.in[I_C] + r * DM : args.in[I_CCTX];
        const float* w = args.in[I_ADAW] + (size_t)l * DM * 6144 + col;
        float a = 0.f;
        for (int k = 0; k < DM; ++k) { const float v = cv[k]; a += (v / (1.0f + expf(-v))) * w[(size_t)k * 6144]; }
        mod[i] = a + args.in[I_ADAB][l * 6144 + col];
    }
}

__device__ __forceinline__ void naive_moe(Frame& F, const Args& args, int l) {
    LAS float* sh = (LAS float*)F.lds;
    LAS float* sa = sh + 8 * DM;
    LAS int* gstart = (LAS int*)(sa + 8 * FF);
    LAS int* stok = gstart + 40;
    const unsigned* cnt = F.ctl + CW_CNT + l * NEXP;
    const unsigned* list = (const unsigned*)(F.ws + WS_LIST);
    __syncthreads();
    if (ftid() == 0) { int acc = 0; for (int e = 0; e < NEXP; ++e) { gstart[e] = acc; acc += ((int)cnt[e] + 7) / 8; } gstart[NEXP] = acc; }
    __syncthreads();
    const int total = gstart[NEXP];
    float* YN = (float*)(F.ws + WS_YN);
    for (int gi = fbid(); gi < total; gi += F.G) {
        int e = 0; for (int k = 1; k < NEXP; ++k) e += (gstart[k] <= gi) ? 1 : 0;
        const int g = gi - gstart[e]; const int ce = (int)cnt[e];
        __syncthreads();
        if (ftid() < 8) { const int idx = 8 * g + ftid(); stok[ftid()] = idx < ce ? (int)list[(size_t)e * LIST_CAP + idx] : -1; }
        __syncthreads();
        for (int i = ftid(); i < 8 * DM; i += 512) { const int r = i >> 10, k = i & 1023; const int tk = stok[r]; sh[i] = tk >= 0 ? bf2f(((const bf16_t*)(F.ws + WS_HB))[(size_t)tk * DM + k]) : 0.f; }
        __syncthreads();
        const float* w1 = args.in[I_W1] + ((size_t)l * NEXP + e) * DM * FF; const float* w3 = args.in[I_W3] + ((size_t)l * NEXP + e) * DM * FF; const float* w2 = args.in[I_W2] + ((size_t)l * NEXP + e) * FF * DM;
        { const int col = ftid(); float a[8], b[8];
#pragma unroll
            for (int r = 0; r < 8; ++r) { a[r] = 0.f; b[r] = 0.f; }
            for (int k = 0; k < DM; ++k) { const float wa = w1[(size_t)k * FF + col], wb = w3[(size_t)k * FF + col];
#pragma unroll
                for (int r = 0; r < 8; ++r) { const float hv = sh[r * DM + k]; a[r] += hv * wa; b[r] += hv * wb; } }
#pragma unroll
            for (int r = 0; r < 8; ++r) sa[r * FF + col] = (a[r] / (1.0f + expf(-a[r]))) * b[r]; }
        __syncthreads();
        for (int col = ftid(); col < DM; col += 512) { float y[8];
#pragma unroll
            for (int r = 0; r < 8; ++r) y[r] = 0.f;
            for (int k = 0; k < FF; ++k) { const float wv = w2[(size_t)k * DM + col];
#pragma unroll
                for (int r = 0; r < 8; ++r) y[r] += sa[r * FF + k] * wv; }
#pragma unroll
            for (int r = 0; r < 8; ++r) { const int tk = stok[r]; if (tk >= 0) { const unsigned e0 = ((const unsigned*)(F.ws + WS_TOKINFO))[(size_t)tk * 8]; const int kk = (e0 == (unsigned)e) ? 0 : 1;
                YN[((size_t)tk * 2 + kk) * DM + col] = y[r]; } } }
    }
    __syncthreads();
}

constexpr int TLD = 136;
constexpr int TILE_BYTES = 128 * TLD * 2;
template <int NT, int KS>
__device__ __forceinline__ void wave_mma(f32x4 (&acc)[NT], const bf16x8 (&afr)[KS], const LAS bf16_t* Bt, int ldb, int lane) {
    const LAS bf16_t* bp = Bt + (lane & 15) * ldb + 8 * (lane >> 4);
#pragma unroll
    for (int nt = 0; nt < NT; ++nt)
#pragma unroll
        for (int ks = 0; ks < KS; ++ks) { const bf16x8 b = *(const LAS bf16x8*)(bp + nt * 16 * ldb + 32 * ks); acc[nt] = __builtin_amdgcn_mfma_f32_16x16x32_bf16(afr[ks], b, acc[nt], 0, 0, 0);
            if ((ks & 3) == 3 && (nt & 1) == 1) asm volatile("" ::: "memory"); }
}
__device__ __forceinline__ void stage_rowmajor(LAS bf16_t* T, const bf16_t* src, size_t ld, int tid) {
#pragma unroll
    for (int i = 0; i < 4; ++i) { const int q = tid + 512 * i, r = q >> 4, cc = q & 15; const u32x4 v = *(const u32x4*)(src + (size_t)r * ld + 8 * cc); *(LAS u32x4*)(T + r * TLD + 8 * cc) = v; }
}
__device__ __forceinline__ void stage_transposed(LAS bf16_t* T, const bf16_t* src, size_t ld, int tid, bool scaled, float sa, float sb) {
#pragma unroll
    for (int i = 0; i < 4; ++i) { const int q = tid + 512 * i, r = q >> 4, cc = q & 15; const u32x4 v = *(const u32x4*)(src + (size_t)r * ld + 8 * cc);
        const unsigned w[4] = {v.x, v.y, v.z, v.w};
        if (scaled) { const float sc = exp2f(sa * (float)r + sb);
#pragma unroll
            for (int k = 0; k < 4; ++k) { T[(8 * cc + 2 * k) * TLD + r] = (bf16_t)f2bf(bflo(w[k]) * sc); T[(8 * cc + 2 * k + 1) * TLD + r] = (bf16_t)f2bf(bfhi(w[k]) * sc); }
        } else {
#pragma unroll
            for (int k = 0; k < 4; ++k) { T[(8 * cc + 2 * k) * TLD + r] = (bf16_t)(w[k] & 0xffffu); T[(8 * cc + 2 * k + 1) * TLD + r] = (bf16_t)(w[k] >> 16); }
        }
    }
}
__device__ __forceinline__ void stage_f32_rowmajor(LAS bf16_t* T, const float* src, int tid) {
#pragma unroll
    for (int i = 0; i < 8; ++i) { const int q = tid + 512 * i, r = q >> 5, cc = q & 31; const f32x4 v = *(const f32x4*)(src + (size_t)r * 128 + 4 * cc);
        u32x2 o; o.x = pk2(v.x, v.y); o.y = pk2(v.z, v.w); *(LAS u32x2*)(T + r * TLD + 4 * cc) = o; }
}
__device__ __forceinline__ float log2_gamma_f(const Frame& F, int p, int dir, int h) { return -expf(((const float*)(F.ws + WS_SP) + SP_DECAY)[(p * 2 + dir) * 4 + h]) * 1.4426950408889634f; }
#define log2_gamma(args, p, dir, h) log2_gamma_f(F, p, dir, h)

__device__ __forceinline__ void ret_state_item(Frame& F, const Args& args, int p, int item) {
    const int c = item % NCHUNK, h = (item / NCHUNK) & 3, b = item / (NCHUNK * 4);
    int tid = ftid(); asm volatile("" : "+v"(tid)); const int lane = tid & 63, w = F.wave;
    LAS bf16_t* T0 = (LAS bf16_t*)F.lds; LAS bf16_t* T1 = (LAS bf16_t*)(F.lds + TILE_BYTES); LAS bf16_t* T2 = (LAS bf16_t*)(F.lds + 2 * TILE_BYTES);
    const bf16_t* pe = (const bf16_t*)(F.ws + WS_PE) + ((size_t)b * SU + 128 * c) * EV_N;
    const float lgf = log2_gamma(args, p, 0, h), lgb = log2_gamma(args, p, 1, h);
    __syncthreads();
    stage_transposed(T0, pe + 512 + h * 128, EV_N, tid, false, 0.f, 0.f);
    stage_transposed(T1, pe + 1024 + h * 128, EV_N, tid, true, -lgf, 127.f * lgf);
    stage_transposed(T2, pe + 1024 + h * 128, EV_N, tid, true, lgb, 0.f);
    __syncthreads();
    float* st = (float*)(F.ws + WS_ST);
#pragma unroll
    for (int dir = 0; dir < 2; ++dir) {
        const LAS bf16_t* VT = dir ? T2 : T1;
        bf16x8 afr[4];
#pragma unroll
        for (int ks = 0; ks < 4; ++ks) afr[ks] = *(const LAS bf16x8*)(VT + (16 * w + (lane & 15)) * TLD + 32 * ks + 8 * (lane >> 4));
        f32x4 acc[8];
#pragma unroll
        for (int nt = 0; nt < 8; ++nt) acc[nt] = (f32x4){0.f, 0.f, 0.f, 0.f};
        wave_mma<8, 4>(acc, afr, T0, TLD, lane);
        float* dst = st + ((((size_t)(b * 4 + h) * 2 + dir) * NCHUNK + c) * 128) * 128;
#pragma unroll
        for (int nt = 0; nt < 8; ++nt)
#pragma unroll
            for (int j = 0; j < 4; ++j) dst[(size_t)(16 * w + 4 * (lane >> 4) + j) * 128 + 16 * nt + (lane & 15)] = acc[nt][j];
    }
}
__device__ __forceinline__ void ret_scan_phase(Frame& F, const Args& args, int p) {
    f32x4* st = (f32x4*)(F.ws + WS_ST);
    for (int i = fbid() * 512 + ftid(); i < 32 * 4096; i += F.G * 512) {
        const int bhd = i >> 12, el = i & 4095; const int dir = bhd & 1, h = (bhd >> 1) & 3;
        const float g128 = exp2f(128.f * log2_gamma(args, p, dir, h));
        f32x4* base = st + (size_t)bhd * NCHUNK * 4096 + el;
        f32x4 s = (f32x4){0.f, 0.f, 0.f, 0.f};
        for (int k = 0; k < NCHUNK; ++k) {
            const int c = dir == 0 ? k : (k < 2 ? 1 - k : NCHUNK + 1 - k);
            const f32x4 u = base[(size_t)c * 4096]; base[(size_t)c * 4096] = s; s = s * g128 + u;
        }
    }
}
__device__ __forceinline__ bf16x8 scale_frag(const bf16x8 a, float sc) {
    bf16x8 r;
#pragma unroll
    for (int k = 0; k < 8; ++k) r[k] = (short)f2bf(bf2f((unsigned)(unsigned short)a[k]) * sc);
    return r;
}
__device__ __forceinline__ void ret_out_item(Frame& F, const Args& args, int p, int item) {
    const int c = item % NCHUNK, h = (item / NCHUNK) & 3, b = item / (NCHUNK * 4);
    int tid = ftid(); asm volatile("" : "+v"(tid)); const int lane = tid & 63, w = F.wave, quad = lane >> 4, l15 = lane & 15;
    LAS bf16_t* T0 = (LAS bf16_t*)F.lds; LAS bf16_t* T1 = (LAS bf16_t*)(F.lds + TILE_BYTES); LAS bf16_t* T2 = (LAS bf16_t*)(F.lds + 2 * TILE_BYTES);
    const size_t row0 = (size_t)b * SU + 128 * c;
    const bf16_t* pe = (const bf16_t*)(F.ws + WS_PE) + row0 * EV_N;
    const float lgf = log2_gamma(args, p, 0, h), lgb = log2_gamma(args, p, 1, h);
    const float* stf = (const float*)(F.ws + WS_ST) + ((((size_t)(b * 4 + h) * 2 + 0) * NCHUNK + c) * 128) * 128;
    const float* stb = (const float*)(F.ws + WS_ST) + ((((size_t)(b * 4 + h) * 2 + 1) * NCHUNK + c) * 128) * 128;
    bf16x8 qf[4];
#pragma unroll
    for (int ks = 0; ks < 4; ++ks) qf[ks] = *(const bf16x8*)(pe + (size_t)(16 * w + l15) * EV_N + h * 128 + 32 * ks + 8 * quad);
    __syncthreads();
    stage_rowmajor(T0, pe + 512 + h * 128, EV_N, tid);
    stage_transposed(T1, pe + 1024 + h * 128, EV_N, tid, false, 0.f, 0.f);
    stage_f32_rowmajor(T2, stf, tid);
    __syncthreads();
    f32x4 ao[8];
#pragma unroll
    for (int nt = 0; nt < 8; ++nt) ao[nt] = (f32x4){0.f, 0.f, 0.f, 0.f};
    {
        const float cf = exp2f(lgf * (float)(16 * w + l15 + 1));
        bf16x8 qs[4];
#pragma unroll
        for (int ks = 0; ks < 4; ++ks) qs[ks] = scale_frag(qf[ks], cf);
        wave_mma<8, 4>(ao, qs, T2, TLD, lane);
    }
    {
        f32x4 aw[8];
#pragma unroll
        for (int nt = 0; nt < 8; ++nt) aw[nt] = (f32x4){0.f, 0.f, 0.f, 0.f};
        wave_mma<8, 4>(aw, qf, T0, TLD, lane);
        __syncthreads();
#pragma unroll
        for (int nt = 0; nt < 8; ++nt)
#pragma unroll
            for (int j = 0; j < 4; ++j) { const int i = 16 * w + 4 * quad + j, jj = 16 * nt + l15; const int d = i - jj;
                const float dec = d > 0 ? exp2f(lgf * (float)d) : (d < 0 ? exp2f(lgb * (float)(-d)) : 2.0f);
                T0[i * TLD + jj] = (bf16_t)f2bf(aw[nt][j] * dec); }
    }
    stage_f32_rowmajor(T2, stb, tid);
    __syncthreads();
    {
        bf16x8 pf[4];
#pragma unroll
        for (int ks = 0; ks < 4; ++ks) pf[ks] = *(const LAS bf16x8*)(T0 + (16 * w + l15) * TLD + 32 * ks + 8 * quad);
        wave_mma<8, 4>(ao, pf, T1, TLD, lane);
        const float cb = exp2f(lgb * (float)(128 - (16 * w + l15)));
#pragma unroll
        for (int ks = 0; ks < 4; ++ks) pf[ks] = scale_frag(qf[ks], cb);
        wave_mma<8, 4>(ao, pf, T2, TLD, lane);
    }
    bf16_t* yb = (bf16_t*)(F.ws + WS_YB16);
#pragma unroll
    for (int j = 0; j < 4; ++j) { const int i = 16 * w + 4 * quad + j;
        float ss = 0.f;
#pragma unroll
        for (int nt = 0; nt < 8; ++nt) ss += ao[nt][j] * ao[nt][j];
        ss += shx(ss, 1, lane); ss += shx(ss, 2, lane); ss += shx(ss, 4, lane); ss += shx(ss, 8, lane);
        const float rstd = 1.0f / sqrtf(ss * (1.0f / 128.f) + EPS);
        const bf16_t* gp = pe + (size_t)i * EV_N + 1536 + h * 128;
#pragma unroll
        for (int nt = 0; nt < 8; ++nt) { const float gt = bf2f(gp[16 * nt + l15]); yb[(row0 + i) * DM + h * 128 + 16 * nt + l15] = ABL_RET0 ? (bf16_t)0 : (bf16_t)f2bf(siluf(gt) * ao[nt][j] * rstd); }
    }
}
__device__ __forceinline__ void ret_direct_item(Frame& F, const Args& args, int p, int item) {
    const int c = item % NCHUNK, h = (item / NCHUNK) & 3, b = item / (NCHUNK * 4);
    int tid = ftid(); asm volatile("" : "+v"(tid)); const int lane = tid & 63, w = F.wave, quad = lane >> 4, l15 = lane & 15;
    LAS bf16_t* T0 = (LAS bf16_t*)F.lds; LAS bf16_t* T1 = (LAS bf16_t*)(F.lds + TILE_BYTES); LAS bf16_t* T2 = (LAS bf16_t*)(F.lds + 2 * TILE_BYTES);
    const size_t row0 = (size_t)b * SU + 128 * c;
    const bf16_t* peb = (const bf16_t*)(F.ws + WS_PE) + (size_t)b * SU * EV_N;
    const bf16_t* pe = peb + (size_t)128 * c * EV_N;
    const float lgf = log2_gamma(args, p, 0, h), lgb = log2_gamma(args, p, 1, h);
    bf16x8 qf[4];
#pragma unroll
    for (int ks = 0; ks < 4; ++ks) qf[ks] = *(const bf16x8*)(pe + (size_t)(16 * w + l15) * EV_N + h * 128 + 32 * ks + 8 * quad);
    f32x4 ao[8];
#pragma unroll
    for (int nt = 0; nt < 8; ++nt) ao[nt] = (f32x4){0.f, 0.f, 0.f, 0.f};
    for (int c2 = 0; c2 < NCHUNK; ++c2) {
        __syncthreads();
        stage_rowmajor(T0, peb + (size_t)128 * c2 * EV_N + 512 + h * 128, EV_N, tid);
        stage_transposed(T1, peb + (size_t)128 * c2 * EV_N + 1024 + h * 128, EV_N, tid, false, 0.f, 0.f);
        __syncthreads();
        f32x4 aw[8];
#pragma unroll
        for (int nt = 0; nt < 8; ++nt) aw[nt] = (f32x4){0.f, 0.f, 0.f, 0.f};
        wave_mma<8, 4>(aw, qf, T0, TLD, lane);
#pragma unroll
        for (int nt = 0; nt < 8; ++nt)
#pragma unroll
            for (int j = 0; j < 4; ++j) { const int i = 16 * w + 4 * quad + j, jj = 16 * nt + l15;
                const int px = 128 * c + i, py = 128 * c2 + jj;
                const int ubx = px < NCTX ? NCTX - 1 - px : SU + NCTX - 1 - px, uby = py < NCTX ? NCTX - 1 - py : SU + NCTX - 1 - py;
                float dec = 0.f;
                if (py <= px && !(px >= NCTX && false)) dec += exp2f(lgf * (float)(px - py));
                if (uby <= ubx) dec += exp2f(lgb * (float)(ubx - uby));
                if (px < NCTX && py >= NCTX) dec = 0.f;
                T2[i * TLD + jj] = (bf16_t)f2bf(aw[nt][j] * dec); }
        LDS_WAIT(); asm volatile("" ::: "memory");
        bf16x8 pf[4];
#pragma unroll
        for (int ks = 0; ks < 4; ++ks) pf[ks] = *(const LAS bf16x8*)(T2 + (16 * w + l15) * TLD + 32 * ks + 8 * quad);
        wave_mma<8, 4>(ao, pf, T1, TLD, lane);
    }
    bf16_t* yb = (bf16_t*)(F.ws + WS_YB16);
#pragma unroll
    for (int j = 0; j < 4; ++j) { const int i = 16 * w + 4 * quad + j;
        float ss = 0.f;
#pragma unroll
        for (int nt = 0; nt < 8; ++nt) ss += ao[nt][j] * ao[nt][j];
        ss += shx(ss, 1, lane); ss += shx(ss, 2, lane); ss += shx(ss, 4, lane); ss += shx(ss, 8, lane);
        const float rstd = 1.0f / sqrtf(ss * (1.0f / 128.f) + EPS);
        const bf16_t* gp = pe + (size_t)i * EV_N + 1536 + h * 128;
#pragma unroll
        for (int nt = 0; nt < 8; ++nt) { const float gt = bf2f(gp[16 * nt + l15]); yb[(row0 + i) * DM + h * 128 + 16 * nt + l15] = (bf16_t)f2bf(siluf(gt) * ao[nt][j] * rstd); }
    }
}
__device__ __forceinline__ void att_item(Frame& F, const Args& args, int p, int item) {
    const int qb = item % NCHUNK, hk = (item / NCHUNK) & 1, b = item / (NCHUNK * 2);
    int tid = ftid(); asm volatile("" : "+v"(tid)); const int lane = tid & 63, w = F.wave, quad = lane >> 4, l15 = lane & 15;
    const int g = w >> 2, hq = 2 * hk + g, qr0 = 32 * (w & 3);
    LAS bf16_t* T0 = (LAS bf16_t*)F.lds; LAS bf16_t* T1 = (LAS bf16_t*)(F.lds + TILE_BYTES);
    LAS bf16_t* Pw = (LAS bf16_t*)(F.lds + 2 * TILE_BYTES) + w * 32 * TLD;
    const bf16_t* peb = (const bf16_t*)(F.ws + WS_PE) + (size_t)b * SU * EV_N;
    const size_t qrow0 = (size_t)128 * qb + qr0;
    bf16x8 qf[2][4];
#pragma unroll
    for (int rt = 0; rt < 2; ++rt)
#pragma unroll
        for (int ks = 0; ks < 4; ++ks) qf[rt][ks] = *(const bf16x8*)(peb + (qrow0 + 16 * rt + l15) * EV_N + 2048 + hq * 128 + 32 * ks + 8 * quad);
    const float sink = ((const float*)(F.ws + WS_SP) + SP_SINK)[p * 4 + hq];
    const float scale = 0.08838834764831845f;
    float mrow[2][4], lrow[2][4]; f32x4 ao[2][8];
#pragma unroll
    for (int rt = 0; rt < 2; ++rt) {
#pragma unroll
        for (int j = 0; j < 4; ++j) { mrow[rt][j] = sink; lrow[rt][j] = 1.0f; }
#pragma unroll
        for (int nt = 0; nt < 8; ++nt) ao[rt][nt] = (f32x4){0.f, 0.f, 0.f, 0.f};
    }
    const int ntile = (qb < 2) ? 2 : 5;
    for (int ti = 0; ti < ntile; ++ti) {
        int kt, mode = 0;
        if (ti < 2) kt = ti; else { kt = qb + (ti - 3); mode = (ti == 2) ? 1 : (ti == 4 ? 2 : 0); }
        if (ti >= 2 && (kt < 2 || kt >= NCHUNK)) continue;
        __syncthreads();
        stage_rowmajor(T0, peb + (size_t)128 * kt * EV_N + 2560 + hk * 128, EV_N, tid);
        stage_transposed(T1, peb + (size_t)128 * kt * EV_N + 2816 + hk * 128, EV_N, tid, false, 0.f, 0.f);
        __syncthreads();
#pragma unroll
        for (int rt = 0; rt < 2; ++rt) {
            f32x4 s[8];
#pragma unroll
            for (int nt = 0; nt < 8; ++nt) s[nt] = (f32x4){0.f, 0.f, 0.f, 0.f};
            wave_mma<8, 4>(s, qf[rt], T0, TLD, lane);
#pragma unroll
            for (int j = 0; j < 4; ++j) {
                const int qq = qr0 + 16 * rt + 4 * quad + j;
                float mx = -3.0e38f;
#pragma unroll
                for (int nt = 0; nt < 8; ++nt) { const int kk = 16 * nt + l15; float v = s[nt][j] * scale;
                    const bool valid = (mode == 0) || (mode == 1 ? (kk >= qq) : (kk <= qq));
                    v = valid ? v : -3.0e38f; s[nt][j] = v; mx = fmaxf(mx, v); }
                mx = fmaxf(mx, shx(mx, 1, lane)); mx = fmaxf(mx, shx(mx, 2, lane)); mx = fmaxf(mx, shx(mx, 4, lane)); mx = fmaxf(mx, shx(mx, 8, lane));
                const float mn = fmaxf(mrow[rt][j], mx); const float alpha = __expf(mrow[rt][j] - mn);
                float rs = 0.f;
#pragma unroll
                for (int nt = 0; nt < 8; ++nt) { const float pv = (s[nt][j] > -1.0e38f) ? __expf(s[nt][j] - mn) : 0.f; rs += pv; Pw[(16 * rt + 4 * quad + j) * TLD + 16 * nt + l15] = (bf16_t)f2bf(pv); }
                rs += shx(rs, 1, lane); rs += shx(rs, 2, lane); rs += shx(rs, 4, lane); rs += shx(rs, 8, lane);
                lrow[rt][j] = lrow[rt][j] * alpha + rs; mrow[rt][j] = mn;
#pragma unroll
                for (int nt = 0; nt < 8; ++nt) ao[rt][nt][j] *= alpha;
            }
        }
        LDS_WAIT(); asm volatile("" ::: "memory");
#pragma unroll
        for (int rt = 0; rt < 2; ++rt) {
            bf16x8 pf[4];
#pragma unroll
            for (int ks = 0; ks < 4; ++ks) pf[ks] = *(const LAS bf16x8*)(Pw + (16 * rt + l15) * TLD + 32 * ks + 8 * quad);
            wave_mma<8, 4>(ao[rt], pf, T1, TLD, lane);
        }
    }
    bf16_t* yb = (bf16_t*)(F.ws + WS_YB16) + ((size_t)b * SU + qrow0) * DM + 512 + hq * 128;
#pragma unroll
    for (int rt = 0; rt < 2; ++rt)
#pragma unroll
        for (int j = 0; j < 4; ++j) { const float inv = 1.0f / lrow[rt][j];
#pragma unroll
            for (int nt = 0; nt < 8; ++nt) yb[(size_t)(16 * rt + 4 * quad + j) * DM + 16 * nt + l15] = ABL_ATT0 ? (bf16_t)0 : (bf16_t)f2bf(ao[rt][nt][j] * inv); }
}
__device__ __forceinline__ void naive_att(Frame& F, const Args& args, int p) {
    const int gw = F.vcu * NWAVES + F.wave, NGW = F.G * NWAVES, lane = flane();
    LAS float* sq = (LAS float*)F.lds + F.wave * 1024;
    LAS float* sc = sq + 128;
    const bf16_t* pe = (const bf16_t*)(F.ws + WS_PE);
    for (int task = gw; task < MTOK * 4; task += NGW) {
        const int row = task >> 2, hq = task & 3, hk = hq >> 1; const int b = row / SU, pq = row % SU;
        const bf16_t* peb = pe + (size_t)b * SU * EV_N;
        sq[lane] = bf2f(peb[(size_t)pq * EV_N + 2048 + hq * 128 + lane]) * 0.08838834764831845f; sq[lane + 64] = bf2f(peb[(size_t)pq * EV_N + 2048 + hq * 128 + lane + 64]) * 0.08838834764831845f;
        LDS_WAIT(); asm volatile("" ::: "memory");
        int lo = 0, nloc = 0;
        if (pq >= NCTX) { const int t = pq - NCTX; lo = t - 128 < 0 ? 0 : t - 128; const int hi = t + 128 > LSEQ - 1 ? LSEQ - 1 : t + 128; nloc = hi - lo + 1; }
        const int nk = NCTX + nloc;
        const float sink = args.in[I_SINK][p * 4 + hq];
        float mx = sink;
        for (int ki = lane; ki < nk; ki += 64) { const int kp = ki < NCTX ? ki : NCTX + lo + (ki - NCTX);
            const bf16_t* kr = peb + (size_t)kp * EV_N + 2560 + hk * 128; float d = 0.f;
            for (int x = 0; x < 128; ++x) d += sq[x] * bf2f(kr[x]);
            sc[ki] = d; mx = fmaxf(mx, d); }
#pragma unroll
        for (int o = 1; o < 64; o <<= 1) mx = fmaxf(mx, shx(mx, o, lane));
        float sum = 0.f;
        for (int ki = lane; ki < nk; ki += 64) { const float e = expf(sc[ki] - mx); sc[ki] = e; sum += e; }
        sum = wave_sum(sum, lane) + expf(sink - mx);
        LDS_WAIT(); asm volatile("" ::: "memory");
        float o0 = 0.f, o1 = 0.f;
        for (int ki = 0; ki < nk; ++ki) { const int kp = ki < NCTX ? ki : NCTX + lo + (ki - NCTX); const bf16_t* vr = peb + (size_t)kp * EV_N + 2816 + hk * 128; const float pv = sc[ki];
            o0 += pv * bf2f(vr[lane]); o1 += pv * bf2f(vr[lane + 64]); }
        bf16_t* yb = (bf16_t*)(F.ws + WS_YB16) + (size_t)row * DM + 512 + hq * 128;
        yb[lane] = (bf16_t)f2bf(o0 / sum); yb[lane + 64] = (bf16_t)f2bf(o1 / sum);
        LDS_WAIT(); asm volatile("" ::: "memory");
    }
}
__device__ __forceinline__ void hg_scan_item_plain(Frame& F, int item) {
    const int es = item & 3, dir = (item >> 2) & 1, h = (item >> 3) & 7, b = item >> 6;
    const int tid = ftid(), e = tid & 31, dg = tid >> 5;
    LAS float* sP = (LAS float*)F.lds;
    LAS float* sIn = sP + 32 * 16 * 32;
    constexpr int INB = 32 * 128 * 2 + 32 * 32;
    const float* fsrc = (const float*)(F.ws + (dir ? WS_FB : WS_FF));
    const bf16_t* qsrc = (const bf16_t*)(F.ws + WS_PQ); const bf16_t* vsrc = (const bf16_t*)(F.ws + WS_PI);
    float* osrc = (float*)(F.ws + (dir ? WS_OB : WS_OF));
    float S[8];
#pragma unroll
    for (int k = 0; k < 8; ++k) S[k] = 0.f;
    const size_t rb = (size_t)b * SU;
    f32x4 rf0, rf1; u32x4 rq, rv;
    auto pos_of = [&](int s) { return dir ? (s < NCTX ? NCTX - 1 - s : SU + NCTX - 1 - s) : s; };
#define HG_ISSUE(s0_) do { const int pA = pos_of((s0_) + (tid >> 5)), pB = pos_of((s0_) + 16 + (tid >> 5)), pQ = pos_of((s0_) + (tid >> 4)); \
        rf0 = *(const f32x4*)(fsrc + (rb + pA) * DM + h * 128 + 4 * (tid & 31)); rf1 = *(const f32x4*)(fsrc + (rb + pB) * DM + h * 128 + 4 * (tid & 31)); \
        rq = *(const u32x4*)(qsrc + (rb + pQ) * DM + h * 128 + 8 * (tid & 15)); \
        if (tid < 128) { const int pV = pos_of((s0_) + (tid >> 2)); rv = *(const u32x4*)(vsrc + (rb + pV) * DM + h * 128 + 32 * es + 8 * (tid & 3)); } } while (0)
#define HG_WRITE(buf_) do { LAS float* bF = sIn + (buf_) * INB; LAS float* bQ = bF + 32 * 128; LAS float* bV = bQ + 32 * 128; \
        *(LAS f32x4*)(bF + (tid >> 5) * 128 + 4 * (tid & 31)) = rf0; *(LAS f32x4*)(bF + (16 + (tid >> 5)) * 128 + 4 * (tid & 31)) = rf1; \
        { LAS float* d = bQ + (tid >> 4) * 128 + 8 * (tid & 15); *(LAS f32x4*)d = (f32x4){bflo(rq.x), bfhi(rq.x), bflo(rq.y), bfhi(rq.y)}; *(LAS f32x4*)(d + 4) = (f32x4){bflo(rq.z), bfhi(rq.z), bflo(rq.w), bfhi(rq.w)}; } \
        if (tid < 128) { LAS float* d = bV + (tid >> 2) * 32 + 8 * (tid & 3); *(LAS f32x4*)d = (f32x4){bflo(rv.x), bfhi(rv.x), bflo(rv.y), bfhi(rv.y)}; *(LAS f32x4*)(d + 4) = (f32x4){bflo(rv.z), bfhi(rv.z), bflo(rv.w), bfhi(rv.w)}; } } while (0)
    __syncthreads();
    HG_ISSUE(0); HG_WRITE(0);
    __syncthreads();
    constexpr int NTB = SU / 32;
    for (int tb = 0; tb < NTB; ++tb) {
        const int s0 = 32 * tb, cur = tb & 1;
        if (tb + 1 < NTB) HG_ISSUE(s0 + 32);
        const LAS float* sF = sIn + cur * INB; const LAS float* sQ = sF + 32 * 128; const LAS float* sV = sQ + 32 * 128;
#pragma unroll 4
        for (int tt = 0; tt < 32; ++tt) {
            const f32x4 f0 = *(const LAS f32x4*)(sF + tt * 128 + 8 * dg), f1 = *(const LAS f32x4*)(sF + tt * 128 + 8 * dg + 4);
            const f32x4 q0 = *(const LAS f32x4*)(sQ + tt * 128 + 8 * dg), q1 = *(const LAS f32x4*)(sQ + tt * 128 + 8 * dg + 4);
            const float v = sV[tt * 32 + e];
            const float ff[8] = {f0.x, f0.y, f0.z, f0.w, f1.x, f1.y, f1.z, f1.w}; const float qq[8] = {q0.x, q0.y, q0.z, q0.w, q1.x, q1.y, q1.z, q1.w};
            float part = 0.f;
#pragma unroll
            for (int k = 0; k < 8; ++k) { S[k] = ff[k] * S[k] + (1.0f - ff[k]) * v; part += qq[k] * S[k]; }
            sP[(tt * 16 + dg) * 32 + e] = part;
        }
        __syncthreads();
#pragma unroll
        for (int i = 0; i < 2; ++i) { const int q = tid + 512 * i, tt = q >> 5, ee = q & 31; float o = 0.f;
#pragma unroll
            for (int k = 0; k < 16; ++k) o += sP[(tt * 16 + k) * 32 + ee];
            osrc[(rb + pos_of(s0 + tt)) * DM + h * 128 + 32 * es + ee] = o; }
        if (tb + 1 < NTB) HG_WRITE(cur ^ 1);
        __syncthreads();
    }
#undef HG_ISSUE
#undef HG_WRITE
}
__device__ __forceinline__ void hg_scan_item_c16(Frame& F, int item) {
    const int es = item & 3, dir = (item >> 2) & 1, h = (item >> 3) & 7, b = item >> 6;
    const int tid = ftid(), lane = tid & 63, w = F.wave, quad = lane >> 4, l15 = lane & 15;
    constexpr int INB = 32 * 128 * 2 + 32 * 32;
    LAS float* sIn = (LAS float*)F.lds;
    LAS bf16_t* QA = (LAS bf16_t*)(sIn + 2 * INB);
    LAS bf16_t* KB = QA + 2 * 16 * 136;
    LAS bf16_t* KC = KB + 2 * 16 * 136;
    LAS bf16_t* VT = KC + 2 * 128 * 40;
    LAS bf16_t* PP = VT + 2 * 32 * 40;
    LAS bf16_t* ST = PP + 2 * 16 * 40;
    LAS float* DEC = (LAS float*)(ST + 32 * 136);
    const float* fsrc = (const float*)(F.ws + (dir ? WS_FB : WS_FF));
    const bf16_t* qsrc = (const bf16_t*)(F.ws + WS_PQ); const bf16_t* vsrc = (const bf16_t*)(F.ws + WS_PI);
    float* osrc = (float*)(F.ws + (dir ? WS_OB : WS_OF));
    const size_t rb = (size_t)b * SU;
    f32x4 S[2] = {(f32x4){0.f, 0.f, 0.f, 0.f}, (f32x4){0.f, 0.f, 0.f, 0.f}};
    f32x4 rf0, rf1; u32x4 rq, rv;
    auto pos_of = [&](int s) { return dir ? (s < NCTX ? NCTX - 1 - s : SU + NCTX - 1 - s) : s; };
#define HG_ISSUE(s0_) do { const int pA = pos_of((s0_) + (tid >> 5)), pB = pos_of((s0_) + 16 + (tid >> 5)), pQ = pos_of((s0_) + (tid >> 4)); \
        rf0 = *(const f32x4*)(fsrc + (rb + pA) * DM + h * 128 + 4 * (tid & 31)); rf1 = *(const f32x4*)(fsrc + (rb + pB) * DM + h * 128 + 4 * (tid & 31)); \
        rq = *(const u32x4*)(qsrc + (rb + pQ) * DM + h * 128 + 8 * (tid & 15)); \
        if (tid < 128) { const int pV = pos_of((s0_) + (tid >> 2)); rv = *(const u32x4*)(vsrc + (rb + pV) * DM + h * 128 + 32 * es + 8 * (tid & 3)); } } while (0)
#define HG_WRITE(buf_) do { LAS float* bF = sIn + (buf_) * INB; LAS float* bQ = bF + 32 * 128; LAS float* bV = bQ + 32 * 128; \
        *(LAS f32x4*)(bF + (tid >> 5) * 128 + 4 * (tid & 31)) = rf0; *(LAS f32x4*)(bF + (16 + (tid >> 5)) * 128 + 4 * (tid & 31)) = rf1; \
        { LAS float* d = bQ + (tid >> 4) * 128 + 8 * (tid & 15); *(LAS f32x4*)d = (f32x4){bflo(rq.x), bfhi(rq.x), bflo(rq.y), bfhi(rq.y)}; *(LAS f32x4*)(d + 4) = (f32x4){bflo(rq.z), bfhi(rq.z), bflo(rq.w), bfhi(rq.w)}; } \
        if (tid < 128) { LAS float* d = bV + (tid >> 2) * 32 + 8 * (tid & 3); *(LAS f32x4*)d = (f32x4){bflo(rv.x), bfhi(rv.x), bflo(rv.y), bfhi(rv.y)}; *(LAS f32x4*)(d + 4) = (f32x4){bflo(rv.z), bfhi(rv.z), bflo(rv.w), bfhi(rv.w)}; } } while (0)
    __syncthreads();
    for (int i = tid; i < 2 * 128 * 40; i += 512) KC[i] = 0;
    for (int i = tid; i < 2 * 32 * 40; i += 512) VT[i] = 0;
    for (int i = tid; i < 2 * 16 * 40; i += 512) PP[i] = 0;
    for (int i = tid; i < 32 * 136; i += 512) ST[i] = 0;
    HG_ISSUE(0); HG_WRITE(0);
    __syncthreads();
    constexpr int NTB = SU / 32;
#define HG_BAR() do { asm volatile("s_waitcnt lgkmcnt(0)" ::: "memory"); __builtin_amdgcn_s_barrier(); asm volatile("" ::: "memory"); } while (0)
    for (int tb = 0; tb < NTB; ++tb) {
        const int s0 = 32 * tb, cur = tb & 1;
        if (tb + 1 < NTB) HG_ISSUE(s0 + 32);
        const LAS float* sF = sIn + cur * INB; const LAS float* sQ = sF + 32 * 128; const LAS float* sV = sQ + 32 * 128;
        if (tid < 256) {
            const int c = tid >> 7, d = tid & 127;
            float a = 0.f, kbv[16], fv[16], qv[16];
#pragma unroll
            for (int i = 0; i < 16; ++i) { fv[i] = sF[(16 * c + i) * 128 + d]; qv[i] = sQ[(16 * c + i) * 128 + d]; }
#pragma unroll
            for (int i = 0; i < 16; ++i) { const float f = fv[i], q = qv[i];
                a += __builtin_amdgcn_logf(f); const float ea = __builtin_amdgcn_exp2f(a);
                QA[(c * 16 + i) * 136 + d] = (bf16_t)f2bf(q * ea); kbv[i] = (1.0f - f) * __builtin_amdgcn_exp2f(-a); }
            const float al = __builtin_amdgcn_exp2f(a); DEC[c * 128 + d] = al;
            unsigned pk[8];
#pragma unroll
            for (int j = 0; j < 16; ++j) { KB[(c * 16 + j) * 136 + d] = (bf16_t)f2bf(kbv[j]); }
#pragma unroll
            for (int j = 0; j < 8; ++j) pk[j] = pk2(kbv[2 * j] * al, kbv[2 * j + 1] * al);
            LAS u32x4* kd = (LAS u32x4*)(KC + (c * 128 + d) * 40); kd[0] = (u32x4){pk[0], pk[1], pk[2], pk[3]}; kd[1] = (u32x4){pk[4], pk[5], pk[6], pk[7]};
        } else {
            const int idx = tid - 256, c = idx >> 7, e = (idx >> 2) & 31, jq = idx & 3;
            const float v0 = sV[(16 * c + 4 * jq + 0) * 32 + e], v1 = sV[(16 * c + 4 * jq + 1) * 32 + e], v2 = sV[(16 * c + 4 * jq + 2) * 32 + e], v3 = sV[(16 * c + 4 * jq + 3) * 32 + e];
            u32x2 o; o.x = pk2(v0, v1); o.y = pk2(v2, v3); *(LAS u32x2*)(VT + (c * 32 + e) * 40 + 4 * jq) = o;
        }
        HG_BAR();
        bf16x8 qa[4]; f32x4 oi[2] = {(f32x4){0.f, 0.f, 0.f, 0.f}, (f32x4){0.f, 0.f, 0.f, 0.f}};
        bf16x8 sb0[2][4];
        if (w < 2) {
            const int c = w;
            bf16x8 kbf[4], vbf[2];
#pragma unroll
            for (int ks = 0; ks < 4; ++ks) { qa[ks] = *(const LAS bf16x8*)(QA + (c * 16 + l15) * 136 + 32 * ks + 8 * quad); kbf[ks] = *(const LAS bf16x8*)(KB + (c * 16 + l15) * 136 + 32 * ks + 8 * quad); }
#pragma unroll
            for (int nt = 0; nt < 2; ++nt) vbf[nt] = *(const LAS bf16x8*)(VT + (c * 32 + 16 * nt + l15) * 40 + 8 * quad);
            if (c == 0) {
#pragma unroll
                for (int nt = 0; nt < 2; ++nt)
#pragma unroll
                    for (int ks = 0; ks < 4; ++ks) sb0[nt][ks] = *(const LAS bf16x8*)(ST + (16 * nt + l15) * 136 + 32 * ks + 8 * quad);
            }
            f32x4 sc = (f32x4){0.f, 0.f, 0.f, 0.f};
#pragma unroll
            for (int ks = 0; ks < 4; ++ks) sc = __builtin_amdgcn_mfma_f32_16x16x32_bf16(qa[ks], kbf[ks], sc, 0, 0, 0);
#pragma unroll
            for (int jj = 0; jj < 4; ++jj) { const int i = 4 * quad + jj; PP[(c * 16 + i) * 40 + l15] = (bf16_t)f2bf(l15 <= i ? sc[jj] : 0.f); }
            LDS_WAIT(); asm volatile("" ::: "memory");
            const bf16x8 pa = *(const LAS bf16x8*)(PP + (c * 16 + l15) * 40 + 8 * quad);
#pragma unroll
            for (int nt = 0; nt < 2; ++nt) oi[nt] = __builtin_amdgcn_mfma_f32_16x16x32_bf16(pa, vbf[nt], oi[nt], 0, 0, 0);
        }
#pragma unroll
        for (int c = 0; c < 2; ++c) {
            if (w == c) {
                if (c == 1) {
#pragma unroll
                    for (int nt = 0; nt < 2; ++nt)
#pragma unroll
                        for (int ks = 0; ks < 4; ++ks) sb0[nt][ks] = *(const LAS bf16x8*)(ST + (16 * nt + l15) * 136 + 32 * ks + 8 * quad);
                }
#pragma unroll
                for (int ks = 0; ks < 4; ++ks)
#pragma unroll
                    for (int nt = 0; nt < 2; ++nt) oi[nt] = __builtin_amdgcn_mfma_f32_16x16x32_bf16(qa[ks], sb0[nt][ks], oi[nt], 0, 0, 0);
#pragma unroll
                for (int jj = 0; jj < 4; ++jj) { const int pp = pos_of(s0 + 16 * c + 4 * quad + jj); float* op = osrc + (rb + pp) * DM + h * 128 + 32 * es + l15; op[0] = oi[0][jj]; op[16] = oi[1][jj]; }
            }
            {
                const f32x4 dc = *(const LAS f32x4*)(DEC + c * 128 + 16 * w + 4 * quad);
                const bf16x8 ka = *(const LAS bf16x8*)(KC + (c * 128 + 16 * w + l15) * 40 + 8 * quad);
#pragma unroll
                for (int nt = 0; nt < 2; ++nt) { const bf16x8 vb = *(const LAS bf16x8*)(VT + (c * 32 + 16 * nt + l15) * 40 + 8 * quad); S[nt] = S[nt] * dc; S[nt] = __builtin_amdgcn_mfma_f32_16x16x32_bf16(ka, vb, S[nt], 0, 0, 0); }
            }
            HG_BAR();
#pragma unroll
            for (int nt = 0; nt < 2; ++nt)
#pragma unroll
                for (int jj = 0; jj < 4; ++jj) ST[(16 * nt + l15) * 136 + 16 * w + 4 * quad + jj] = (bf16_t)f2bf(S[nt][jj]);
            if (c == 1 && tb + 1 < NTB) HG_WRITE(cur ^ 1);
            HG_BAR();
        }
    }
#undef HG_ISSUE
#undef HG_WRITE
#undef HG_BAR
}
__device__ __forceinline__ void hg_scan_item(Frame& F, int item) {
    const int es = item & 3, dir = (item >> 2) & 1, h = (item >> 3) & 7, b = item >> 6;
    const int tid = ftid(), lane = tid & 63, w = F.wave, quad = lane >> 4, l15 = lane & 15;
    constexpr int INB = 32 * 128 * 2 + 32 * 32;
    LAS float* sIn = (LAS float*)F.lds;
    LAS bf16_t* QA = (LAS bf16_t*)(sIn + 2 * INB);
    LAS bf16_t* KB = QA + 32 * 136;
    LAS bf16_t* KC = KB + 32 * 136;
    LAS bf16_t* VT = KC + 128 * 40;
    LAS bf16_t* PP = VT + 32 * 40;
    LAS bf16_t* ST = PP + 32 * 40;
    LAS float* DEC = (LAS float*)(ST + 32 * 136);
    const float* fsrc = (const float*)(F.ws + (dir ? WS_FB : WS_FF));
    const bf16_t* qsrc = (const bf16_t*)(F.ws + WS_PQ); const bf16_t* vsrc = (const bf16_t*)(F.ws + WS_PI);
    float* osrc = (float*)(F.ws + (dir ? WS_OB : WS_OF));
    const size_t rb = (size_t)b * SU;
    f32x4 S[2] = {(f32x4){0.f, 0.f, 0.f, 0.f}, (f32x4){0.f, 0.f, 0.f, 0.f}};
    f32x4 rf0A, rf1A, rf0B, rf1B; u32x4 rqA, rvA, rqB, rvB;
    auto pos_of = [&](int s) { return dir ? (s < NCTX ? NCTX - 1 - s : SU + NCTX - 1 - s) : s; };
#define HG_ISSUE(rf0, rf1, rq, rv, s0_) do { const int pA = pos_of((s0_) + (tid >> 5)), pB = pos_of((s0_) + 16 + (tid >> 5)), pQ = pos_of((s0_) + (tid >> 4)); \
        rf0 = *(const f32x4*)(fsrc + (rb + pA) * DM + h * 128 + 4 * (tid & 31)); rf1 = *(const f32x4*)(fsrc + (rb + pB) * DM + h * 128 + 4 * (tid & 31)); \
        rq = *(const u32x4*)(qsrc + (rb + pQ) * DM + h * 128 + 8 * (tid & 15)); \
        if (tid < 128) { const int pV = pos_of((s0_) + (tid >> 2)); rv = *(const u32x4*)(vsrc + (rb + pV) * DM + h * 128 + 32 * es + 8 * (tid & 3)); } } while (0)
#define HG_WRITE(rf0, rf1, rq, rv, buf_) do { LAS float* bF = sIn + (buf_) * INB; LAS float* bQ = bF + 32 * 128; LAS float* bV = bQ + 32 * 128; \
        *(LAS f32x4*)(bF + (tid >> 5) * 128 + 4 * (tid & 31)) = rf0; *(LAS f32x4*)(bF + (16 + (tid >> 5)) * 128 + 4 * (tid & 31)) = rf1; \
        { LAS float* d = bQ + (tid >> 4) * 128 + 8 * (tid & 15); *(LAS f32x4*)d = (f32x4){bflo(rq.x), bfhi(rq.x), bflo(rq.y), bfhi(rq.y)}; *(LAS f32x4*)(d + 4) = (f32x4){bflo(rq.z), bfhi(rq.z), bflo(rq.w), bfhi(rq.w)}; } \
        if (tid < 128) { LAS float* d = bV + (tid >> 2) * 32 + 8 * (tid & 3); *(LAS f32x4*)d = (f32x4){bflo(rv.x), bfhi(rv.x), bflo(rv.y), bfhi(rv.y)}; *(LAS f32x4*)(d + 4) = (f32x4){bflo(rv.z), bfhi(rv.z), bflo(rv.w), bfhi(rv.w)}; } } while (0)
#define HG_BAR() do { asm volatile("s_waitcnt lgkmcnt(0)" ::: "memory"); __builtin_amdgcn_s_barrier(); asm volatile("" ::: "memory"); } while (0)
    __syncthreads();
    for (int i = tid; i < 32 * 136; i += 512) ST[i] = 0;
    HG_ISSUE(rf0A, rf1A, rqA, rvA, 0); HG_WRITE(rf0A, rf1A, rqA, rvA, 0);
    HG_ISSUE(rf0B, rf1B, rqB, rvB, 32);
    __syncthreads();
    constexpr int NTB = SU / 32;
    auto blk = [&](const int tb, const int cur) __attribute__((always_inline)) {
        const int s0 = 32 * tb;
        const LAS float* sF = sIn + cur * INB; const LAS float* sQ = sF + 32 * 128; const LAS float* sV = sQ + 32 * 128;
        if (tid < 256) {
            const int c = tid & 1, d = tid >> 1;
            float fv[16], qv[16], kbv[16];
#pragma unroll
            for (int i = 0; i < 16; ++i) { fv[i] = sF[(16 * c + i) * 128 + d]; qv[i] = sQ[(16 * c + i) * 128 + d]; }
            float tot = 1.f;
#pragma unroll
            for (int i = 0; i < 16; ++i) tot *= fv[i];
            const float oth = shx(tot, 1, lane);
            float ea = c ? oth : 1.f;
            float eia = __builtin_amdgcn_rcpf(ea);
            const float al = tot * oth;
#pragma unroll
            for (int i = 0; i < 16; ++i) { const float fo = fv[i]; ea *= fo; eia *= __builtin_amdgcn_rcpf(fo);
                QA[(16 * c + i) * 136 + d] = (bf16_t)f2bf(qv[i] * ea); kbv[i] = (1.0f - fo) * eia; }
            if (c == 0) DEC[d] = al;
            unsigned pk[8];
#pragma unroll
            for (int j = 0; j < 16; ++j) KB[(16 * c + j) * 136 + d] = (bf16_t)f2bf(kbv[j]);
#pragma unroll
            for (int j = 0; j < 8; ++j) pk[j] = pk2(kbv[2 * j] * al, kbv[2 * j + 1] * al);
            LAS u32x4* kd = (LAS u32x4*)(KC + d * 40 + 16 * c); kd[0] = (u32x4){pk[0], pk[1], pk[2], pk[3]}; kd[1] = (u32x4){pk[4], pk[5], pk[6], pk[7]};
        } else {
            const int idx = tid - 256, e = idx >> 3, jq = idx & 7;
            const float v0 = sV[(4 * jq + 0) * 32 + e], v1 = sV[(4 * jq + 1) * 32 + e], v2 = sV[(4 * jq + 2) * 32 + e], v3 = sV[(4 * jq + 3) * 32 + e];
            u32x2 o; o.x = pk2(v0, v1); o.y = pk2(v2, v3); *(LAS u32x2*)(VT + e * 40 + 4 * jq) = o;
        }
        HG_BAR();
        if (w < 2) {
            const int it = w;
            bf16x8 qa[4], kbf[2][4], vbf[2], sbf[2][4];
#pragma unroll
            for (int ks = 0; ks < 4; ++ks) { qa[ks] = *(const LAS bf16x8*)(QA + (16 * it + l15) * 136 + 32 * ks + 8 * quad);
                kbf[0][ks] = *(const LAS bf16x8*)(KB + (l15) * 136 + 32 * ks + 8 * quad); kbf[1][ks] = *(const LAS bf16x8*)(KB + (16 + l15) * 136 + 32 * ks + 8 * quad); }
#pragma unroll
            for (int nt = 0; nt < 2; ++nt) { vbf[nt] = *(const LAS bf16x8*)(VT + (16 * nt + l15) * 40 + 8 * quad);
#pragma unroll
                for (int ks = 0; ks < 4; ++ks) sbf[nt][ks] = *(const LAS bf16x8*)(ST + (16 * nt + l15) * 136 + 32 * ks + 8 * quad); }
            f32x4 sc0 = (f32x4){0.f, 0.f, 0.f, 0.f}, sc1 = (f32x4){0.f, 0.f, 0.f, 0.f};
#pragma unroll
            for (int ks = 0; ks < 4; ++ks) { sc0 = __builtin_amdgcn_mfma_f32_16x16x32_bf16(qa[ks], kbf[0][ks], sc0, 0, 0, 0); sc1 = __builtin_amdgcn_mfma_f32_16x16x32_bf16(qa[ks], kbf[1][ks], sc1, 0, 0, 0); }
#pragma unroll
            for (int jj = 0; jj < 4; ++jj) { const int i = 16 * it + 4 * quad + jj;
                PP[i * 40 + l15] = (bf16_t)f2bf(l15 <= i ? sc0[jj] : 0.f); PP[i * 40 + 16 + l15] = (bf16_t)f2bf(16 + l15 <= i ? sc1[jj] : 0.f); }
            LDS_WAIT(); asm volatile("" ::: "memory");
            const bf16x8 pa = *(const LAS bf16x8*)(PP + (16 * it + l15) * 40 + 8 * quad);
            f32x4 oi[2];
#pragma unroll
            for (int nt = 0; nt < 2; ++nt) { oi[nt] = __builtin_amdgcn_mfma_f32_16x16x32_bf16(pa, vbf[nt], (f32x4){0.f, 0.f, 0.f, 0.f}, 0, 0, 0);
#pragma unroll
                for (int ks = 0; ks < 4; ++ks) oi[nt] = __builtin_amdgcn_mfma_f32_16x16x32_bf16(qa[ks], sbf[nt][ks], oi[nt], 0, 0, 0); }
#pragma unroll
            for (int jj = 0; jj < 4; ++jj) { const int pp = pos_of(s0 + 16 * it + 4 * quad + jj); float* op = osrc + (rb + pp) * DM + h * 128 + 32 * es + l15; op[0] = oi[0][jj]; op[16] = oi[1][jj]; }
        }
        {
            const f32x4 dc = *(const LAS f32x4*)(DEC + 16 * w + 4 * quad);
            const bf16x8 ka = *(const LAS bf16x8*)(KC + (16 * w + l15) * 40 + 8 * quad);
#pragma unroll
            for (int nt = 0; nt < 2; ++nt) { const bf16x8 vb = *(const LAS bf16x8*)(VT + (16 * nt + l15) * 40 + 8 * quad); S[nt] = S[nt] * dc; S[nt] = __builtin_amdgcn_mfma_f32_16x16x32_bf16(ka, vb, S[nt], 0, 0, 0); }
        }
        HG_BAR();
#pragma unroll
        for (int nt = 0; nt < 2; ++nt)
#pragma unroll
            for (int jj = 0; jj < 4; ++jj) ST[(16 * nt + l15) * 136 + 16 * w + 4 * quad + jj] = (bf16_t)f2bf(S[nt][jj]);
    };
    for (int tb = 0; tb < NTB; tb += 2) {
        { const int nb = tb + 2 < NTB ? tb + 2 : NTB - 1; HG_ISSUE(rf0A, rf1A, rqA, rvA, 32 * nb); }
        blk(tb, 0);
        HG_WRITE(rf0B, rf1B, rqB, rvB, 1);
        HG_BAR();
        { const int nb = tb + 3 < NTB ? tb + 3 : NTB - 1; HG_ISSUE(rf0B, rf1B, rqB, rvB, 32 * nb); }
        blk(tb + 1, 1);
        HG_WRITE(rf0A, rf1A, rqA, rvA, 0);
        HG_BAR();
    }
#undef HG_ISSUE
#undef HG_WRITE
#undef HG_BAR
}
__device__ __forceinline__ void naive_hg_scan(Frame& F) {
    const int gt = fbid() * 512 + ftid();
    if (gt >= NB * 8 * 2 * 128) return;
    const int e = gt & 127, dir = (gt >> 7) & 1, h = (gt >> 8) & 7, b = gt >> 11;
    const float* fsrc = (const float*)(F.ws + (dir ? WS_FB : WS_FF));
    const bf16_t* qsrc = (const bf16_t*)(F.ws + WS_PQ); const bf16_t* vsrc = (const bf16_t*)(F.ws + WS_PI);
    float* osrc = (float*)(F.ws + (dir ? WS_OB : WS_OF));
    float S[128];
#pragma unroll
    for (int d = 0; d < 128; ++d) S[d] = 0.f;
    for (int s_ = 0; s_ < SU; ++s_) {
        const int pp = dir ? (s_ < NCTX ? NCTX - 1 - s_ : SU + NCTX - 1 - s_) : s_;
        const size_t row = (size_t)b * SU + pp;
        const float v = bf2f(vsrc[row * DM + h * 128 + e]);
        const float* fr = fsrc + row * DM + h * 128; const bf16_t* qr = qsrc + row * DM + h * 128;
        float o = 0.f;
#pragma unroll
        for (int d = 0; d < 128; ++d) { const float f = fr[d]; S[d] = f * S[d] + (1.0f - f) * v; o += bf2f(qr[d]) * S[d]; }
        osrc[row * DM + h * 128 + e] = o;
    }
}
__device__ __forceinline__ void naive_hg_readout(Frame& F, const Args& args, int p) {
    for (int i = fbid() * 512 + ftid(); i < MTOK * 8; i += F.G * 512) {
        const int row = i >> 3, h = i & 7;
        const float* a = (const float*)(F.ws + WS_OF) + (size_t)row * DM + h * 128; const float* c = (const float*)(F.ws + WS_OB) + (size_t)row * DM + h * 128;
        float ss = 0.f;
        for (int d = 0; d < 128; ++d) { const float o = a[d] + c[d]; ss += o * o; }
        const float rstd = 1.0f / sqrtf(ss / 128.f + EPS);
        const bf16_t* g = (const bf16_t*)(F.ws + WS_PG) + (size_t)row * DM + h * 128; bf16_t* y = (bf16_t*)(F.ws + WS_YB16) + (size_t)row * DM + h * 128;
        for (int d = 0; d < 128; ++d) { const float o = a[d] + c[d]; const float gv = bf2f(g[d]); y[d] = (bf16_t)f2bf(o * rstd * args.in[I_HGNW][p * 128 + d] * (gv / (1.0f + expf(-gv)))); }
    }
}
__device__ __forceinline__ void hg_readout_phase(Frame& F, const Args& args, int p) {
    const int gw = F.vcu * NWAVES + F.wave, NGW = F.G * NWAVES, lane = flane();
    const float* nw = ((const float*)(F.ws + WS_SP) + SP_HGNW) + p * 128 + 16 * (lane & 7);
    for (int row = gw; row < MTOK; row += NGW) {
        const f32x4* a = (const f32x4*)(F.ws + WS_OF + (size_t)row * DM * 4) + 4 * lane; const f32x4* c = (const f32x4*)(F.ws + WS_OB + (size_t)row * DM * 4) + 4 * lane;
        f32x4 o[4]; float ss = 0.f;
#pragma unroll
        for (int j = 0; j < 4; ++j) { o[j] = ABL_HGB0 ? a[j] : a[j] + c[j]; ss += (o[j].x * o[j].x + o[j].y * o[j].y) + (o[j].z * o[j].z + o[j].w * o[j].w); }
        ss += shx(ss, 1, lane); ss += shx(ss, 2, lane); ss += shx(ss, 4, lane);
        const float rstd = 1.0f / sqrtf(ss * (1.0f / 128.f) + EPS);
        const u32x4* gp = (const u32x4*)(F.ws + WS_PG + (size_t)row * DM * 2) + 2 * lane;
        const u32x4 g0 = gp[0], g1 = gp[1]; const unsigned gwv[8] = {g0.x, g0.y, g0.z, g0.w, g1.x, g1.y, g1.z, g1.w};
        unsigned outw[8];
#pragma unroll
        for (int j = 0; j < 4; ++j) { const f32x4 wv = *(const f32x4*)(nw + 4 * j);
            const float y0 = o[j].x * rstd * wv.x * siluf(bflo(gwv[2 * j])), y1 = o[j].y * rstd * wv.y * siluf(bfhi(gwv[2 * j]));
            const float y2 = o[j].z * rstd * wv.z * siluf(bflo(gwv[2 * j + 1])), y3 = o[j].w * rstd * wv.w * siluf(bfhi(gwv[2 * j + 1]));
            outw[2 * j] = pk2(y0, y1); outw[2 * j + 1] = pk2(y2, y3); }
        u32x4* op = (u32x4*)(F.ws + WS_YB16 + (size_t)row * DM * 2) + 2 * lane;
        op[0] = (u32x4){outw[0], outw[1], outw[2], outw[3]}; op[1] = (u32x4){outw[4], outw[5], outw[6], outw[7]};
    }
}

constexpr int NPHASE = 2 + 9 * DEPTH;
constexpr unsigned KM_ALL = 0x7ffu | (3u << 16);
template <unsigned KM>
__device__ __forceinline__ void mk_body(const Args& args, unsigned char* lds_raw) {
    Frame F;
    F.lds = (LAS unsigned char*)lds_raw;
    F.MISC = (volatile LAS unsigned*)(F.lds + MISC_OFF);
    F.wave = __builtin_amdgcn_readfirstlane(ftid() >> 6);
    F.G = gridDim.x; { const int bx = blockIdx.x; F.vcu = (F.G % 8 == 0) ? (bx % 8) * (F.G / 8) + bx / 8 : bx; }
    F.ws = args.ws; F.ctl = (unsigned*)(args.ws + WS_CTL);
    for (int u = ftid(); u < (LDS_BYTES - LDSCTL_OFF) / 4; u += NWAVES * 64) ((LAS unsigned*)(F.lds + LDSCTL_OFF))[u] = 0u;
    __syncthreads();
    XcdBarrier bar; bar.bar = F.ctl + CW_BAR; bar.x = 0; bar.st = nullptr;
    const int lo = args.ph_lo, hi = args.ph_hi;
    if (hi - lo > 1) bar = xcd_barrier_post(F.ctl + CW_BAR, F.MISC + 8);
#define HAS(kind) ((KM >> (kind)) & 1u)
    if constexpr (HAS(0)) { if (lo == 0) { p0_prologue(F, args); if (NAIVE_MOD) { __syncthreads(); naive_mod(F, args); } if (hi > 1) xcd_barrier(bar); } }
    float* const outp = args.out;
#pragma nounroll
    for (int ph = (lo == 0 ? 1 : lo); ph < hi; ++ph) {
        const Args* ap = &args;
        { unsigned char* w_ = args.ws; asm volatile("" : "+s"(w_)); F.ws = w_; F.ctl = (unsigned*)(w_ + WS_CTL); }
        { int wv_ = __builtin_amdgcn_readfirstlane(ftid() >> 6); F.wave = wv_; int g_ = (int)gridDim.x; asm volatile("" : "+s"(g_)); F.G = g_; const int bx = fbid(); F.vcu = (g_ % 8 == 0) ? (bx % 8) * (g_ / 8) + bx / 8 : bx; }
        const float* mod = (const float*)(F.ws + WS_MOD);
        const int kind = (ph == 0) ? 0 : (ph == NPHASE - 1 ? 10 : 1 + (ph - 1) % 9);
        const int l = (ph - 1) / 9; const int odd = l & 1, p = l >> 1;
        if (kind == 5 && odd) continue;
        switch (kind) {
        case 1: if constexpr (HAS(1)) { if (NAIVE_N1 == 1) naive_n1(F, *ap, l, false); else if (NAIVE_N1 == 2) wave_n1(F, *ap, l, false); else n1_phase<false>(F, *ap, l); } break;
        case 2: if constexpr (HAS(2)) {
            const int N = odd ? OD_N : EV_N;
            if (NAIVE_G1) { naive_g1(F, *ap, l); } else {
            pg8::PlainAddr AD{(const bf16_t*)(F.ws + WS_HB), (const bf16_t*)(F.ws + (odd ? WS_W_ODIN + (size_t)p * 10 * MiB : WS_W_EVIN + (size_t)p * 6 * MiB)), DM};
            pg8::StaticOrder S; S.init(MTOK, N, F.G, fbid());
            EpiProj E{F.ws, (const float*)(F.ws + WS_LB) + l * DM, odd};
            pg8::gemm_phase(F.lds, AD, S, E, DM);
            } } break;
        case 3: if constexpr (HAS(3)) {
            if (!odd) {
                if constexpr (HAS(16)) {
                    for (int it = fbid(); it < NB * 4 * NCHUNK + (NAIVE_ATT ? 0 : NB * 2 * NCHUNK); it += F.G) {
                        if (it < NB * 4 * NCHUNK) ret_state_item(F, *ap, p, it); else att_item(F, *ap, p, it - NB * 4 * NCHUNK);
                    }
                    if (NAIVE_ATT) { __syncthreads(); naive_att(F, *ap, p); }
                }
            } else {
                if constexpr (HAS(17)) { if (NAIVE_HG) naive_hg_scan(F); else for (int it = fbid(); it < NB * 8 * 2 * 4; it += F.G) hg_scan_item(F, it); }
            }
            __syncthreads(); } break;
        case 4: if constexpr (HAS(4)) {
            if (!odd) { if constexpr (HAS(16)) ret_scan_phase(F, *ap, p); } else { if constexpr (HAS(17)) { if (NAIVE_HG) naive_hg_readout(F, *ap, p); else hg_readout_phase(F, *ap, p); } } } break;
        case 5: if constexpr (HAS(5)) { for (int it = fbid(); it < NB * 4 * NCHUNK; it += F.G) { if (RET_DIRECT) ret_direct_item(F, *ap, p, it); else ret_out_item(F, *ap, p, it); } __syncthreads(); } break;
        case 6: if constexpr (HAS(6)) {
            if (NAIVE_G2) { if (odd ? CONTRIB_ODD : CONTRIB_EVEN) naive_g2(F, *ap, l); } else {
            pg8::PlainAddr AD{(const bf16_t*)(F.ws + WS_YB16), (const bf16_t*)(F.ws + (odd ? WS_W_ODOUT : WS_W_EVOUT) + (size_t)p * 2 * MiB), DM};
            pg8::StaticOrder S; S.init(MTOK, DM, F.G, fbid());
            EpiOut E{(float*)(F.ws + WS_XRES), mod + (size_t)l * 5 * 6144, odd ? CONTRIB_ODD : CONTRIB_EVEN};
            pg8::gemm_phase(F.lds, AD, S, E, DM);
            } } break;
        case 7: if constexpr (HAS(7)) { if (NAIVE_N2R) naive_n2r(F, *ap, l); else n2r_phase(F, *ap, l); } break;
        case 8: case 9: if constexpr (HAS(8) || HAS(9)) {
            LAS int* tstart = (LAS int*)(F.lds + LDSCTL_OFF + 512); LAS int* cnts = (LAS int*)(F.lds + LDSCTL_OFF + 768);
            __syncthreads();
            if (F.wave == 0) { int mycnt; const int pre = moe_tile_prefix(F.ctl + CW_CNT + l * NEXP, flane(), mycnt); if (flane() <= NEXP) tstart[flane()] = pre; if (flane() < NEXP) cnts[flane()] = mycnt; }
            __syncthreads();
            const int ntiles = tstart[NEXP];
            const bf16_t* wmoe = (const bf16_t*)(F.ws + WS_W_MOE + (size_t)l * NEXP * 3 * MiB);
            if (kind == 8) { if constexpr (HAS(8)) {
                if (NAIVE_MOE) naive_moe(F, *ap, l); else {
                pg8::MoeGatherAddr AD{(const bf16_t*)(F.ws + WS_HB), wmoe, (const unsigned*)(F.ws + WS_LIST), DM};
                pg8::MoeOrder S{tstart, cnts, ntiles, F.G, fbid()};
                EpiAct E{(bf16_t*)(F.ws + WS_ACT)};
                pg8::gemm_phase(F.lds, AD, S, E, DM); }
            } } else { if constexpr (HAS(9)) {
                pg8::MoeActAddr AD{(const bf16_t*)(F.ws + WS_ACT), wmoe + (size_t)DM * DM, FF};
                pg8::MoeOrder S{tstart, cnts, ntiles, F.G, fbid()};
                EpiY E{(bf16_t*)(F.ws + WS_YB)};
                pg8::gemm_phase(F.lds, AD, S, E, FF);
            } } } break;
        default: if constexpr (HAS(10)) { if (NAIVE_FINAL == 1) naive_n1(F, *ap, DEPTH, true); else if (NAIVE_FINAL == 2) wave_n1(F, *ap, DEPTH, true); else n1_phase<true>(F, *ap, DEPTH); } break;
        }
        if (ph + 1 < hi) xcd_barrier(bar);
    }
#undef HAS
}
template <int L>
__device__ __forceinline__ void layer_sl(Frame& F, const Args& args, const XcdBarrier& bar) {
    constexpr int l = L; constexpr int odd = L & 1, p = L >> 1;
    const float* mod = (const float*)(F.ws + WS_MOD);
    n1_phase<false>(F, args, l); xcd_barrier(bar);
    { pg8::PlainAddr AD{(const bf16_t*)(F.ws + WS_HB), (const bf16_t*)(F.ws + (odd ? WS_W_ODIN + (size_t)p * 10 * MiB : WS_W_EVIN + (size_t)p * 6 * MiB)), DM};
      pg8::StaticOrder S; S.init(MTOK, odd ? OD_N : EV_N, F.G, fbid());
      EpiProj E{F.ws, (const float*)(F.ws + WS_LB) + l * DM, odd};
      pg8::gemm_phase(F.lds, AD, S, E, DM); }
    xcd_barrier(bar);
    if constexpr (!odd) {
        {
            const int bx = fbid();
            if (F.G == 256) {
                att_item(F, args, p, bx);
                if (bx < 16) att_item(F, args, p, 256 + bx);
                else { const int r0 = 2 * (bx - 16); ret_state_item(F, args, p, r0); ret_state_item(F, args, p, r0 + 1); if (bx - 16 < 64) ret_state_item(F, args, p, 480 + (bx - 16)); }
            } else {
                for (int it = bx; it < NB * 4 * NCHUNK + NB * 2 * NCHUNK; it += F.G) { if (it < NB * 2 * NCHUNK) att_item(F, args, p, it); else ret_state_item(F, args, p, it - NB * 2 * NCHUNK); }
            }
        }
        __syncthreads(); xcd_barrier(bar);
        ret_scan_phase(F, args, p); xcd_barrier(bar);
        for (int rep_ = 0; rep_ <= REP_MIXE; ++rep_) for (int it = fbid(); it < NB * 4 * NCHUNK; it += F.G) ret_out_item(F, args, p, it);
        __syncthreads(); xcd_barrier(bar);
    } else {
        for (int rep_ = 0; rep_ <= REP_HG; ++rep_) for (int it = fbid(); it < NB * 8 * 2 * 4; it += F.G) hg_scan_item(F, it);
        __syncthreads(); xcd_barrier(bar);
        hg_readout_phase(F, args, p); xcd_barrier(bar);
    }
    { pg8::PlainAddr AD{(const bf16_t*)(F.ws + WS_YB16), (const bf16_t*)(F.ws + (odd ? WS_W_ODOUT : WS_W_EVOUT) + (size_t)p * 2 * MiB), DM};
      pg8::StaticOrder S; S.init(MTOK, DM, F.G, fbid(), l == DEPTH - 1 ? 1 : 0);
      EpiOut E{(float*)(F.ws + WS_XRES), mod + (size_t)l * 5 * 6144, 1};
      pg8::gemm_phase(F.lds, AD, S, E, DM); }
    xcd_barrier(bar);
    n2r_phase(F, args, l); xcd_barrier(bar);
    {   LAS int* tstart = (LAS int*)(F.lds + LDSCTL_OFF + 512); LAS int* cnts = (LAS int*)(F.lds + LDSCTL_OFF + 768);
        __syncthreads();
        if (F.wave == 0) { int mycnt; const int ln = flane(); const int pre = moe_tile_prefix(F.ctl + CW_CNT + l * NEXP, ln, mycnt); if (ln <= NEXP) tstart[ln] = pre; if (ln < NEXP) cnts[ln] = mycnt; }
        __syncthreads();
        const int ntiles = tstart[NEXP];
        const bf16_t* wmoe = (const bf16_t*)(F.ws + WS_W_MOE + (size_t)l * NEXP * 3 * MiB);
        { pg8::MoeGatherAddr AD{(const bf16_t*)(F.ws + WS_HB), wmoe, (const unsigned*)(F.ws + WS_LIST), DM};
          pg8::MoeOrder S{tstart, cnts, ntiles, F.G, fbid()};
          EpiAct E{(bf16_t*)(F.ws + WS_ACT)};
          pg8::gemm_phase(F.lds, AD, S, E, DM); }
        xcd_barrier(bar);
        { pg8::MoeActAddr AD{(const bf16_t*)(F.ws + WS_ACT), wmoe + (size_t)DM * DM, FF};
          pg8::MoeOrder S{tstart, cnts, ntiles, F.G, fbid()};
          EpiY E{(bf16_t*)(F.ws + WS_YB)};
          pg8::gemm_phase(F.lds, AD, S, E, FF); }
        xcd_barrier(bar);
    }
}
__global__ void __launch_bounds__(NWAVES * 64, 2) mk_one(Args args) {
    extern __shared__ __attribute__((aligned(16))) unsigned char lds_raw[];
    Frame F;
    F.lds = (LAS unsigned char*)lds_raw;
    F.MISC = (volatile LAS unsigned*)(F.lds + MISC_OFF);
    F.wave = __builtin_amdgcn_readfirstlane(ftid() >> 6);
    F.G = gridDim.x; { const int bx = blockIdx.x; F.vcu = (F.G % 8 == 0) ? (bx % 8) * (F.G / 8) + bx / 8 : bx; }
    F.ws = args.ws; F.ctl = (unsigned*)(args.ws + WS_CTL);
    for (int u = ftid(); u < (LDS_BYTES - LDSCTL_OFF) / 4; u += NWAVES * 64) ((LAS unsigned*)(F.lds + LDSCTL_OFF))[u] = 0u;
    __syncthreads();
    const XcdBarrier bar = xcd_barrier_post(F.ctl + CW_BAR, F.MISC + 8);
    p0_prologue(F, args); xcd_barrier(bar);
    layer_sl<0>(F, args, bar);
    layer_sl<1>(F, args, bar);
    layer_sl<2>(F, args, bar);
    layer_sl<3>(F, args, bar);
    n1_phase<true>(F, args, DEPTH);
}

template <unsigned KM>
__global__ void __launch_bounds__(NWAVES * 64, 2) mk_fwd(Args args) {
    extern __shared__ __attribute__((aligned(16))) unsigned char lds_raw[];
    mk_body<KM>(args, lds_raw);
}

template <unsigned KM> static bool prep_kernel() { return hipFuncSetAttribute((const void*)mk_fwd<KM>, hipFuncAttributeMaxDynamicSharedMemorySize, LDS_BYTES) == hipSuccess; }
template <unsigned KM> static void launch_kernel(int grid, hipStream_t stream, const Args& a) { hipLaunchKernelGGL(mk_fwd<KM>, dim3(grid), dim3(NWAVES * 64), LDS_BYTES, stream, a); }
#define KEV (1u << 16)
#define KOD (1u << 17)
extern "C" void kernel_launch(void* const* d_in, const int* in_sizes, int n_in, void* d_out, int out_size, void* d_ws, size_t ws_size, hipStream_t stream) {
    static int grid = 0;
    if (grid == 0) {
        const int exp_sizes[23] = {NB * LSEQ * DM, NB * DM, NB * NCTX * DM, DM, DEPTH * DM * 6 * DM, DEPTH * 6 * DM, DEPTH * 2 * DM, DM, 2 * DM * EV_N, 2 * DM * DM, 16, 8,
                                   2 * DM * OD_N, 2 * DM * DM, DEPTH * DM, 2 * 128, DEPTH * DM * 4, DEPTH * 4, DEPTH * 4 * DM * 8, DEPTH * 32, DEPTH * NEXP * DM * FF, DEPTH * NEXP * DM * FF, DEPTH * NEXP * FF * DM};
        bool sz_ok = (n_in == 23) && out_size == NB * LSEQ * DM;
        for (int i = 0; i < 23 && sz_ok; ++i) sz_ok = (in_sizes[i] == exp_sizes[i]);
        if (!sz_ok) { fprintf(stderr, "kernel_launch: unexpected input sizes\n"); grid = -1; return; }
        if (n_in != 23 || ws_size < WS_END) { fprintf(stderr, "kernel_launch: unexpected n_in %d / ws_size %zu\n", n_in, ws_size); grid = -1; return; }
        int dev = 0, cus = 0;
        if (hipGetDevice(&dev) != hipSuccess || hipDeviceGetAttribute(&cus, hipDeviceAttributeMultiprocessorCount, dev) != hipSuccess) { grid = -1; return; }
        bool ok = true;
#if MK_PER_PHASE
        ok = ok && prep_kernel<1u << 0>() && prep_kernel<1u << 1>() && prep_kernel<1u << 2>() && prep_kernel<(1u << 3) | KEV>() && prep_kernel<(1u << 3) | KOD>()
                && prep_kernel<(1u << 4) | KEV>() && prep_kernel<(1u << 4) | KOD>() && prep_kernel<(1u << 5) | KEV>() && prep_kernel<1u << 6>() && prep_kernel<1u << 7>()
                && prep_kernel<1u << 8>() && prep_kernel<1u << 9>() && prep_kernel<1u << 10>();
#else
        ok = ok && (hipFuncSetAttribute((const void*)mk_one, hipFuncAttributeMaxDynamicSharedMemorySize, LDS_BYTES) == hipSuccess);
#ifdef PROBE_MASKS
        ok = ok && prep_kernel<(1u<<3)|(3u<<16)>() && prep_kernel<(1u<<3)|(1u<<5)|(1u<<16)>() && prep_kernel<(1u<<0)|(1u<<1)|(1u<<7)|(1u<<10)>() && prep_kernel<(1u<<3)|(1u<<4)|(1u<<5)|(3u<<16)>() && prep_kernel<(1u<<0)|(1u<<3)|(1u<<16)>() && prep_kernel<(1u<<1)|(1u<<3)|(1u<<16)>();
#endif
#endif
        if (!ok) { fprintf(stderr, "kernel_launch: hipFuncSetAttribute failed\n"); grid = -1; return; }
        (void)hipGetLastError();
        grid = cus > 256 ? 256 : cus;
    }
    if (grid < 0) return;
    (void)hipMemsetAsync((char*)d_ws + WS_CTL, 0, CTL_ZERO_BYTES, stream);
    Args a{};
    for (int i = 0; i < 23; ++i) a.in[i] = (const float*)d_in[i];
    a.out = (float*)d_out; a.ws = (unsigned char*)d_ws;
#if MK_PER_PHASE
    for (int ph = 0; ph < NPHASE; ++ph) {
        { unsigned char* w_ = args.ws; asm volatile("" : "+s"(w_)); F.ws = w_; F.ctl = (unsigned*)(w_ + WS_CTL); }
        { int wv_ = __builtin_amdgcn_readfirstlane(ftid() >> 6); F.wave = wv_; int g_ = (int)gridDim.x; asm volatile("" : "+s"(g_)); F.G = g_; const int bx = fbid(); F.vcu = (g_ % 8 == 0) ? (bx % 8) * (g_ / 8) + bx / 8 : bx; }
        const float* mod = (const float*)(F.ws + WS_MOD);
        const int kind = (ph == 0) ? 0 : (ph == NPHASE - 1 ? 10 : 1 + (ph - 1) % 9); const int l = (ph - 1) / 9; const bool odd = (l & 1) != 0;
        if (kind == 5 && odd) continue;
        a.ph_lo = ph; a.ph_hi = ph + 1;
        switch (kind) {
            case 0: launch_kernel<1u << 0>(grid, stream, a); break;
            case 1: launch_kernel<1u << 1>(grid, stream, a); break;
            case 2: launch_kernel<1u << 2>(grid, stream, a); break;
            case 3: if (odd) launch_kernel<(1u << 3) | KOD>(grid, stream, a); else launch_kernel<(1u << 3) | KEV>(grid, stream, a); break;
            case 4: if (odd) launch_kernel<(1u << 4) | KOD>(grid, stream, a); else launch_kernel<(1u << 4) | KEV>(grid, stream, a); break;
            case 5: launch_kernel<(1u << 5) | KEV>(grid, stream, a); break;
            case 6: launch_kernel<1u << 6>(grid, stream, a); break;
            case 7: launch_kernel<1u << 7>(grid, stream, a); break;
            case 8: launch_kernel<1u << 8>(grid, stream, a); break;
            case 9: launch_kernel<1u << 9>(grid, stream, a); break;
            default: launch_kernel<1u << 10>(grid, stream, a); break;
        }
    }
#else
    a.ph_lo = 0; a.ph_hi = NPHASE;
    hipLaunchKernelGGL(mk_one, dim3(grid), dim3(NWAVES * 64), LDS_BYTES, stream, a);
#endif
}
```

```cpp
#include <hip/hip_runtime.h>
#include <cstdio>
#include <cstdint>

#ifndef MK_PER_PHASE
#define MK_PER_PHASE 0
#endif

#ifndef CONTRIB_EVEN
#define CONTRIB_EVEN 1
#endif
#ifndef CONTRIB_ODD
#define CONTRIB_ODD 1
#endif
#ifndef CONTRIB_MOE
#define CONTRIB_MOE 1
#endif
#ifndef ABL_ATT0
#define ABL_ATT0 0
#endif
#ifndef ABL_RET0
#define ABL_RET0 0
#endif
#ifndef ABL_HGB0
#define ABL_HGB0 0
#endif
#ifndef RET_DIRECT
#define RET_DIRECT 0
#endif
#ifndef NAIVE_G1
#define NAIVE_G1 0
#endif
#ifndef NAIVE_G2
#define NAIVE_G2 0
#endif
#ifndef NAIVE_MOD
#define NAIVE_MOD 0
#endif
#ifndef NAIVE_MOE
#define NAIVE_MOE 0
#endif
#ifndef NAIVE_ATT
#define NAIVE_ATT 0
#endif
#ifndef NAIVE_HG
#define NAIVE_HG 0
#endif
#ifndef NAIVE_N2R
#define NAIVE_N2R 0
#endif
#ifndef NAIVE_COPY
#define NAIVE_COPY 0
#endif
#ifndef NAIVE_N1
#define NAIVE_N1 0
#endif
#ifndef NAIVE_FINAL
#define NAIVE_FINAL 0
#endif
#ifndef MUT_A
#define MUT_A 0
#endif
#ifndef MUT_B
#define MUT_B 0
#endif
#ifndef MUT_D
#define MUT_D 0
#endif
#ifndef REP_CONV
#define REP_CONV 0
#endif
#ifndef REP_HG
#define REP_HG 0
#endif
#ifndef REP_MIXE
#define REP_MIXE 0
#endif
#define LAS __attribute__((address_space(3)))
#define GAS __attribute__((address_space(1)))
typedef unsigned short bf16_t;
typedef short bf16x8 __attribute__((ext_vector_type(8)));
typedef float f32x4 __attribute__((ext_vector_type(4)));
typedef float f32x2 __attribute__((ext_vector_type(2)));
typedef unsigned u32x4 __attribute__((ext_vector_type(4)));
typedef unsigned u32x2 __attribute__((ext_vector_type(2)));

constexpr int NB = 4, LSEQ = 4096, DM = 1024, NCTX = 256, SU = NCTX + LSEQ  , MTOK = NB * SU  , DEPTH = 4;
constexpr int EV_N = 3072, OD_N = 5120, NEXP = 32, FF = 512;
constexpr int NCHUNK = SU / 128;
constexpr float EPS = 1e-6f;
constexpr int LIST_CAP = MTOK;
constexpr int MOE_MAXROWS = 43008;

constexpr size_t MiB = 1u << 20;
constexpr size_t WS_CTL = 0, CTL_ZERO_BYTES = 1 * MiB;
constexpr size_t WS_MOD = 1 * MiB;
constexpr size_t WS_LB = 1 * MiB + 512 * 1024;
constexpr size_t WS_ROPEC = WS_LB + 16384;
constexpr size_t WS_ROPES = WS_ROPEC + 8192;
constexpr size_t WS_W = 2 * MiB;
constexpr size_t WS_W_EVIN = WS_W;
constexpr size_t WS_W_EVOUT = WS_W + 12 * MiB;
constexpr size_t WS_W_ODIN = WS_W + 16 * MiB;
constexpr size_t WS_W_ODOUT = WS_W + 36 * MiB;
constexpr size_t WS_W_MOE = WS_W + 40 * MiB;
constexpr size_t WS_XRES = 426 * MiB;
constexpr size_t WS_HB = 494 * MiB;
constexpr size_t WS_YB16 = 528 * MiB;
constexpr size_t WS_R = 562 * MiB;
constexpr size_t WS_PE = WS_R;
constexpr size_t WS_ST = WS_R + 102 * MiB;
constexpr size_t WS_PQ = WS_R, WS_PI = WS_R + 34 * MiB, WS_PG = WS_R + 68 * MiB;
constexpr size_t WS_FF = WS_R + 102 * MiB, WS_FB = WS_R + 170 * MiB, WS_OF = WS_R + 238 * MiB, WS_OB = WS_R + 306 * MiB;
constexpr size_t WS_LIST = WS_R;
constexpr size_t WS_TOKINFO = WS_R + 5 * MiB;
constexpr size_t WS_ACT = WS_R + 6 * MiB;
constexpr size_t WS_YB = WS_R + 50 * MiB;
constexpr size_t WS_YN = WS_R + 140 * MiB;
constexpr size_t WS_END = 936 * MiB;
constexpr size_t WS_SP = 256 * 1024;
constexpr int SP_NORMW = 0, SP_FNORMW = 8192, SP_WG = 9216, SP_BG = 25600, SP_WE = 25616, SP_BE = 156688, SP_DECAY = 156816, SP_SINK = 156832, SP_HGNW = 156840, SP_END = 157096;
static_assert(WS_SP + (size_t)SP_END * 4 <= CTL_ZERO_BYTES, "small parameters fit in the control MiB");
constexpr int CW_BAR = 4096;
constexpr int CW_CNT = 8192;

constexpr int RING_BYTES = 150528;
constexpr int LDSCTL_OFF = RING_BYTES, MISC_OFF = LDSCTL_OFF + 320;
constexpr int LDS_BYTES = RING_BYTES + 4096;
constexpr int NWAVES = 8;

typedef __bf16 bf16v2_t __attribute__((ext_vector_type(2)));
__device__ __forceinline__ unsigned pk2(float lo, float hi) { const f32x2 v = {lo, hi}; const bf16v2_t r = __builtin_convertvector(v, bf16v2_t); return __builtin_bit_cast(unsigned, r); }
__device__ __forceinline__ unsigned f2bf(float f) { return pk2(f, f) & 0xffffu; }
__device__ __forceinline__ float bf2f(unsigned h) { return __builtin_bit_cast(float, h << 16); }
__device__ __forceinline__ float bflo(unsigned w) { return __builtin_bit_cast(float, w << 16); }
__device__ __forceinline__ float bfhi(unsigned w) { return __builtin_bit_cast(float, w & 0xffff0000u); }
__device__ __forceinline__ float shx(float v, int o, int lane) { return __builtin_bit_cast(float, __builtin_amdgcn_ds_bpermute((lane ^ o) << 2, __builtin_bit_cast(int, v))); }
__device__ __forceinline__ int shup_i(int v, int o, int lane) { return __builtin_amdgcn_ds_bpermute((lane - o) << 2, v); }
__device__ __forceinline__ int shidx_i(int v, int src) { return __builtin_amdgcn_ds_bpermute(src << 2, v); }
__device__ __forceinline__ float wave_sum(float v, int lane) {
#pragma unroll
    for (int o = 1; o < 64; o <<= 1) v += shx(v, o, lane);
    return v;
}
__device__ __forceinline__ float siluf(float x) { return x / (1.0f + __expf(-x)); }
#define LDS_WAIT() asm volatile("s_waitcnt lgkmcnt(0)" ::: "memory")
#define VM_WAIT() asm volatile("s_waitcnt vmcnt(0)" ::: "memory")

namespace pg8 {
constexpr int BM = 256, BK = 64, HALF = 128, HTB = HALF * BK * 2, STAGE_BYTES = 8 * HTB, NXCD = 8, WGM = 8;
__host__ __device__ __forceinline__ int lds_byte(int r, int c) { const int st = (r >> 4) * 2 + (c >> 5), rr = r & 15, cc = c & 31, ob = rr * 64 + cc * 2; return st * 1024 + (ob ^ (((ob >> 9) & 1) << 5)); }
__host__ __device__ __forceinline__ void stage_rc(int b, int& R, int& C) { const int st = b / 1024, sb = b % 1024, swz = sb ^ (((sb >> 9) & 1) << 5); R = (st >> 1) * 16 + swz / 64; C = (st & 1) * 32 + (swz % 64) / 2; }
__host__ __device__ __forceinline__ int perm32(int rho) { const int n = rho >> 4, i = rho & 15; return 8 * (i >> 2) + 4 * n + (i & 3); }

struct Unit { int pm, pn, e, cnt, tile; };

__device__ __forceinline__ int xcd_remap(int L, int nwg) { const int q = nwg / NXCD, r = nwg % NXCD, xcd = L % NXCD, off = L / NXCD; return (xcd < r ? xcd * (q + 1) : r * (q + 1) + (xcd - r) * q) + off; }

struct StaticOrder {
    int nM, nN, nwg, G, c, skipctx;
    __device__ void init(int M, int N, int G_, int c_, int skip_ = 0) { skipctx = skip_; nM = skip_ ? 64 : M / BM; nN = N / BM; nwg = nM * nN; G = G_; c = c_; }
    __device__ bool next(int i, Unit& u) const {
        const long L = (long)i * G + c; if (L >= nwg) return false;
        const int wgid = xcd_remap((int)L, nwg);
        const int nig = WGM * nN, gid = wgid / nig, fm = gid * WGM, gsz = (nM - fm) < WGM ? (nM - fm) : WGM;
        u.pm = fm + ((wgid % nig) % gsz); u.pn = (wgid % nig) / gsz; u.e = 0; u.cnt = 0; u.tile = 0;
        if (skipctx) u.pm = u.pm + u.pm / 16 + 1;
        return true;
    }
};
struct MoeOrder {
    const LAS int* tstart; const LAS int* cnts; int ntiles, G, c;
    __device__ bool next(int i, Unit& u) const {
        const int nwg = ntiles * 4; const long L = (long)i * G + c; if (L >= nwg) return false;
        const int wgid = xcd_remap((int)L, nwg);
        const int tile = wgid >> 2; u.pn = wgid & 3; u.tile = tile;
        int e = 0;
        for (int k = 1; k < NEXP; ++k) e += (tstart[k] <= tile) ? 1 : 0;
        u.e = e; u.pm = tile - tstart[e]; u.cnt = cnts[e]; return true;
    }
};

struct PlainAddr {
    static constexpr bool GATHER = false;
    const bf16_t* A; const bf16_t* Bt; int K;
    __device__ __forceinline__ void base(const Unit& u, const char*& cA, const char*& cB) const { cA = (const char*)(A + (size_t)u.pm * BM * K); cB = (const char*)(Bt + (size_t)u.pn * BM * K); }
    __device__ __forceinline__ void rows(const Unit&, const int (&)[2], const int (&)[2], unsigned (&)[2], unsigned (&)[2]) const {}
};
struct MoeGatherAddr {
    static constexpr bool GATHER = true;
    const bf16_t* HB; const bf16_t* Wbase; const unsigned* list; int K;
    __device__ __forceinline__ void base(const Unit& u, const char*& cA, const char*& cB) const { cA = (const char*)HB; cB = (const char*)Wbase + (size_t)u.e * (3u << 20) + (size_t)u.pn * BM * K * 2; }
    __device__ __forceinline__ void rows(const Unit& u, const int (&R)[2], const int (&C)[2], unsigned (&v0)[2], unsigned (&v1)[2]) const {
        const unsigned* lp = list + (size_t)u.e * LIST_CAP;
#pragma unroll
        for (int i = 0; i < 2; ++i) {
            int i0 = u.pm * BM + R[i], i1 = i0 + HALF; const int mx = u.cnt - 1; i0 = i0 < mx ? i0 : mx; i1 = i1 < mx ? i1 : mx;
            const unsigned t0 = __hip_atomic_load(lp + i0, __ATOMIC_RELAXED, __HIP_MEMORY_SCOPE_AGENT), t1 = __hip_atomic_load(lp + i1, __ATOMIC_RELAXED, __HIP_MEMORY_SCOPE_AGENT);
            v0[i] = (t0 * (unsigned)K + (unsigned)C[i]) * 2u; v1[i] = (t1 * (unsigned)K + (unsigned)C[i]) * 2u;
        }
    }
};
struct MoeActAddr {
    static constexpr bool GATHER = false;
    const bf16_t* Act; const bf16_t* Wbase; int K;
    __device__ __forceinline__ void base(const Unit& u, const char*& cA, const char*& cB) const { cA = (const char*)(Act + (size_t)u.tile * BM * K); cB = (const char*)Wbase + (size_t)u.e * (3u << 20) + (size_t)u.pn * BM * K * 2; }
    __device__ __forceinline__ void rows(const Unit&, const int (&)[2], const int (&)[2], unsigned (&)[2], unsigned (&)[2]) const {}
};

__device__ __forceinline__ unsigned cvt_pk_bf16(float lo, float hi) { unsigned r; asm volatile("v_cvt_pk_bf16_f32 %0, %1, %2" : "=v"(r) : "v"(lo), "v"(hi)); return r; }

template <class Epi, class Sched, class Addr>
__device__ __forceinline__ void gemm_phase(LAS unsigned char* lds, const Addr& AD, const Sched& S, const Epi& E, const int K) {
    int tid = threadIdx.x; asm volatile("" : "+v"(tid));
    const int wid = __builtin_amdgcn_readfirstlane(tid >> 6), lane = tid & 63, wr = wid >> 2, wc = wid & 3, fr = lane & 15, fq = lane >> 4;
    const int nt = K / BK;
    int sR[2], sC[2]; unsigned voffA[2], voffB[2];
#pragma unroll
    for (int i = 0; i < 2; ++i) { int R, C; stage_rc(tid * 16 + i * 8192, R, C); sR[i] = R; sC[i] = C; const int Rb = Epi::PERM ? ((R & ~31) + perm32(R & 31)) : R; voffA[i] = (unsigned)(R * K + C) * 2u; voffB[i] = (unsigned)(Rb * K + C) * 2u; }
    const size_t kstep = (size_t)(BK * 2);
    const size_t hstep = (size_t)HALF * K * 2;
    const unsigned ldsw = (unsigned)wid * 1024u;
    const int aoff = lds_byte(wr * 64 + fr, fq * 8), boff = lds_byte(wc * 32 + fr, fq * 8);
#define PG8_SA(b, h) (((b) * 2 + (h)) * HTB)
#define PG8_SB(b, h) ((4 + (b) * 2 + (h)) * HTB)
#define PG8_STAGE(bufoff, gbase, voff) do { _Pragma("unroll") for (int _i = 0; _i < 2; ++_i) \
        __builtin_amdgcn_global_load_lds((const unsigned*)((const char*)(gbase) + (voff)[_i]), (LAS unsigned*)(lds + (bufoff) + ldsw + _i * 8192), 16, 0, 0); } while (0)
#define PG8_LDA(dst, b, h) do { _Pragma("unroll") for (int m = 0; m < 4; ++m) _Pragma("unroll") for (int k = 0; k < 2; ++k) dst[m][k] = *(const LAS bf16x8*)(lds + PG8_SA(b, h) + aoff + m * 2048 + k * 1024); } while (0)
#define PG8_LDB(dst, b, h) do { _Pragma("unroll") for (int n = 0; n < 2; ++n) _Pragma("unroll") for (int k = 0; k < 2; ++k) dst[n][k] = *(const LAS bf16x8*)(lds + PG8_SB(b, h) + boff + n * 2048 + k * 1024); } while (0)
#define PG8_MMA(ai, bj, At, Bt) do { __builtin_amdgcn_s_setprio(1); _Pragma("unroll") for (int m = 0; m < 4; ++m) _Pragma("unroll") for (int n = 0; n < 2; ++n) _Pragma("unroll") for (int k = 0; k < 2; ++k) \
        acc[ai][bj][m][n] = __builtin_amdgcn_mfma_f32_16x16x32_bf16(Bt[n][k], At[m][k], acc[ai][bj][m][n], 0, 0, 0); __builtin_amdgcn_s_setprio(0); } while (0)
#define PG8_WAIT_V(n) asm volatile("s_waitcnt vmcnt(" #n ")" ::: "memory")
#define PG8_WAIT_L(n) asm volatile("s_waitcnt lgkmcnt(" #n ")" ::: "memory")
#define PG8_BAR __builtin_amdgcn_s_barrier()
#define PG8_SCHED __builtin_amdgcn_sched_barrier(0)
    Unit cur, nxt; int ui = 0;
    if (!S.next(0, cur)) return;
    f32x4 acc[2][2][4][2];
#pragma unroll
    for (int a = 0; a < 2; ++a)
#pragma unroll
        for (int b = 0; b < 2; ++b)
#pragma unroll
            for (int m = 0; m < 4; ++m)
#pragma unroll
                for (int n = 0; n < 2; ++n) acc[a][b][m][n] = (f32x4){0.f, 0.f, 0.f, 0.f};
    bf16x8 At[4][2], B0[2][2], B1[2][2];
    const char* cA; const char* cB; unsigned cv0[2] = {voffA[0], voffA[1]}, cv1[2] = {voffA[0], voffA[1]};
    AD.base(cur, cA, cB); AD.rows(cur, sR, sC, cv0, cv1);
    const size_t ah = Addr::GATHER ? (size_t)0 : hstep;
    PG8_STAGE(PG8_SB(0, 0), cB, voffB); PG8_STAGE(PG8_SB(0, 1), cB + hstep, voffB); PG8_STAGE(PG8_SA(0, 0), cA, cv0); PG8_STAGE(PG8_SA(0, 1), cA + ah, cv1);
    if (wr == 1) PG8_BAR;
    PG8_WAIT_V(2); PG8_BAR;
    PG8_STAGE(PG8_SB(1, 0), cB + kstep, voffB); PG8_STAGE(PG8_SA(1, 0), cA + kstep, cv0); PG8_STAGE(PG8_SB(1, 1), cB + hstep + kstep, voffB);
    PG8_WAIT_V(6); PG8_BAR;
    for (;;) {
        const bool has_next = S.next(ui + 1, nxt);
        const char* nA = cA; const char* nB = cB; unsigned nv0[2] = {cv0[0], cv0[1]}, nv1[2] = {cv1[0], cv1[1]};
        if (has_next) { AD.base(nxt, nA, nB); AD.rows(nxt, sR, sC, nv0, nv1); }
        for (int t = 0; t < nt; t += 2) {
            const bool last = (t == nt - 2);
            const char* a1 = cA + (size_t)(t + 1) * kstep;
            const char* a2 = last ? nA : cA + (size_t)(t + 2) * kstep; const char* b2 = last ? nB : cB + (size_t)(t + 2) * kstep;
            const char* a3 = a2 + kstep; const char* b3 = b2 + kstep;
            unsigned x0[2] = {cv0[0], cv0[1]}, x1[2] = {cv1[0], cv1[1]};
            if constexpr (Addr::GATHER) { if (last) { x0[0] = nv0[0]; x0[1] = nv0[1]; x1[0] = nv1[0]; x1[1] = nv1[1]; } }
            PG8_LDB(B0, 0, 0); PG8_LDB(B1, 0, 1); PG8_SCHED; PG8_LDA(At, 0, 0); PG8_STAGE(PG8_SA(1, 1), a1 + ah, cv1);
            PG8_WAIT_V(8); PG8_WAIT_L(0); PG8_BAR; PG8_MMA(0, 0, At, B0); PG8_MMA(0, 1, At, B1); PG8_BAR; PG8_SCHED;
            PG8_LDA(At, 0, 1); PG8_STAGE(PG8_SB(0, 0), b2, voffB); PG8_STAGE(PG8_SB(0, 1), b2 + hstep, voffB); PG8_STAGE(PG8_SA(0, 0), a2, x0);
            PG8_WAIT_V(8); PG8_WAIT_L(0); PG8_BAR; PG8_MMA(1, 0, At, B0); PG8_MMA(1, 1, At, B1); PG8_BAR; PG8_SCHED;
            PG8_LDB(B0, 1, 0); PG8_LDB(B1, 1, 1); PG8_SCHED; PG8_LDA(At, 1, 0); PG8_STAGE(PG8_SA(0, 1), a2 + ah, x1);
            PG8_WAIT_V(8); PG8_WAIT_L(0); PG8_BAR; PG8_MMA(0, 0, At, B0); PG8_MMA(0, 1, At, B1); PG8_BAR; PG8_SCHED;
            PG8_LDA(At, 1, 1); PG8_STAGE(PG8_SB(1, 0), b3, voffB); PG8_STAGE(PG8_SB(1, 1), b3 + hstep, voffB); PG8_STAGE(PG8_SA(1, 0), a3, x0);
            PG8_WAIT_V(8); PG8_WAIT_L(0); PG8_BAR; PG8_MMA(1, 0, At, B0); PG8_MMA(1, 1, At, B1); PG8_BAR; PG8_SCHED;
        }
        if (wr == 0) PG8_BAR;
        E(acc, cur, wr, wc, fr, fq);
        if (!has_next) break;
#pragma unroll
        for (int a = 0; a < 2; ++a)
#pragma unroll
            for (int b = 0; b < 2; ++b)
#pragma unroll
                for (int m = 0; m < 4; ++m)
#pragma unroll
                    for (int n = 0; n < 2; ++n) acc[a][b][m][n] = (f32x4){0.f, 0.f, 0.f, 0.f};
        cur = nxt; cA = nA; cB = nB; cv0[0] = nv0[0]; cv0[1] = nv0[1]; cv1[0] = nv1[0]; cv1[1] = nv1[1]; ++ui;
        if (wr == 1) PG8_BAR;
    }
    PG8_WAIT_V(0);
    PG8_BAR;
#undef PG8_SA
#undef PG8_SB
#undef PG8_STAGE
#undef PG8_LDA
#undef PG8_LDB
#undef PG8_MMA
#undef PG8_WAIT_V
#undef PG8_WAIT_L
#undef PG8_BAR
#undef PG8_SCHED
}
}

#define XB_TMO      128
#define XB_XCNT(j)  (256  + 64 * (j))
#define XB_XSUB(j)  (1280 + 64 * (j))
#define XB_XGEN(j)  (2304 + 64 * (j))
#define XB_TOP      3328
#define XB_TOPGEN   3392
#define XCD_BAR_WORDS 3456
#define XB_SPIN_CAP (1u << 20)
__device__ __forceinline__ unsigned xb_ld(unsigned* p)              { return __hip_atomic_load((GAS unsigned*)p, __ATOMIC_RELAXED, __HIP_MEMORY_SCOPE_AGENT); }
__device__ __forceinline__ unsigned xb_add(unsigned* p, unsigned v) { return __hip_atomic_fetch_add((GAS unsigned*)p, v, __ATOMIC_RELAXED, __HIP_MEMORY_SCOPE_AGENT); }
__device__ __forceinline__ unsigned xb_xcc_id() { return (unsigned)__builtin_amdgcn_s_getreg((3 << 11) | 20) & 0xFu; }
#define XB_SPIN(cond, bar) do { unsigned _sp = 0; while (cond) { __builtin_amdgcn_s_sleep(1); \
    if ((++_sp & 255u) == 0u) { if (xb_ld(&(bar)[XB_TMO])) break; if (_sp > XB_SPIN_CAP) { xb_add(&(bar)[XB_TMO], 1u); break; } } } } while (0)
struct XcdBarrier { unsigned* bar; unsigned x; volatile LAS unsigned* st; };
__device__ __forceinline__ XcdBarrier xcd_barrier_post(unsigned* bar, volatile LAS unsigned* st) {
    XcdBarrier b; b.bar = bar; b.x = xb_xcc_id(); b.st = st;
    if (threadIdx.x == 0) (void)xb_add(&bar[XB_XCNT(b.x)], 1u);
    return b;
}
__device__ __forceinline__ void xcd_barrier_complete(unsigned* bar, unsigned x, unsigned& nloc, unsigned& nx) {
    const unsigned G = gridDim.x * gridDim.y * gridDim.z;
    unsigned sum, cnt, mine, sp = 0u;
    for (;;) {
        sum = 0u; cnt = 0u; mine = 0u;
#pragma unroll
        for (unsigned j = 0; j < 16; ++j) { const unsigned c = xb_ld(&bar[XB_XCNT(j)]); sum += c; cnt += (c > 0u) ? 1u : 0u; }
        mine = xb_ld(&bar[XB_XCNT(x)]);
        if (sum == G) break;
        __builtin_amdgcn_s_sleep(1);
        if ((++sp & 255u) == 0u) { if (xb_ld(&bar[XB_TMO])) break; if (sp > XB_SPIN_CAP) { xb_add(&bar[XB_TMO], 1u); break; } }
    }
    nloc = mine > 0u ? mine : 1u; nx = cnt > 0u ? cnt : 1u;
}
__device__ __forceinline__ void xcd_barrier(const XcdBarrier& b) {
    asm volatile("s_waitcnt vmcnt(0)" ::: "memory");
    __syncthreads();
    if (threadIdx.x == 0) {
        unsigned* bar = b.bar; asm volatile("" : "+s"(bar));
        __builtin_amdgcn_s_waitcnt(0);
        unsigned nloc = b.st[0], nx = b.st[1];
        if (nloc == 0u) { xcd_barrier_complete(bar, b.x, nloc, nx); b.st[0] = nloc; b.st[1] = nx; }
        const unsigned old = xb_add(&bar[XB_XSUB(b.x)], 1u);
        const unsigned gen = old / nloc;
        if (old + 1u == (gen + 1u) * nloc) {
            __builtin_amdgcn_fence(__ATOMIC_RELEASE, "agent");
            asm volatile("s_waitcnt vmcnt(0)" ::: "memory");
            const unsigned og = xb_add(&bar[XB_TOP], 1u);
            const unsigned tg = og / nx;
            if (og + 1u == (tg + 1u) * nx) xb_add(&bar[XB_TOPGEN], 1u);
            else XB_SPIN(xb_ld(&bar[XB_TOPGEN]) == tg, bar);
            __builtin_amdgcn_fence(__ATOMIC_ACQUIRE, "agent");
            xb_add(&bar[XB_XGEN(b.x)], 1u);
            asm volatile("s_waitcnt vmcnt(0)" ::: "memory");
        } else {
            XB_SPIN(xb_ld(&bar[XB_XGEN(b.x)]) == gen, bar);
            __builtin_amdgcn_fence(__ATOMIC_ACQUIRE, "agent");
            asm volatile("s_waitcnt vmcnt(0)" ::: "memory");
        }
    }
    __syncthreads();
}

__device__ __forceinline__ int ftid() { int t = (int)threadIdx.x; asm volatile("" : "+v"(t)); return t; }
__device__ __forceinline__ int flane() { return ftid() & 63; }
__device__ __forceinline__ int fbid() { int b = (int)blockIdx.x; asm volatile("" : "+s"(b)); return b; }
struct Args { const float* in[23]; float* out; unsigned char* ws; int ph_lo, ph_hi; };
struct Frame {
    LAS unsigned char* lds;
    volatile LAS unsigned* MISC;
    unsigned* ctl;
    unsigned char* ws;
    int wave, vcu, G;
};
enum { I_X = 0, I_C, I_CTX, I_CCTX, I_ADAW, I_ADAB, I_NORMW, I_FNORMW, I_EVWIN, I_EVWOUT, I_RETDECAY, I_SINK, I_ODWIN, I_ODWOUT, I_LBLOG, I_HGNW,
       I_WG, I_BG, I_WE, I_BE, I_W1, I_W3, I_W2 };

__device__ __forceinline__ void conv_item(const float* srcp, int src_ld, bf16_t* WT, int K, int n0, int k0, LAS float* scr, int lane) {
#pragma unroll 8
    for (int i = 0; i < 32; ++i) { const int kk = 2 * i + (lane >> 5); scr[kk * 33 + (lane & 31)] = srcp[(size_t)(k0 + kk) * src_ld]; }
    LDS_WAIT(); asm volatile("" ::: "memory");
    const int c = lane & 7;
#pragma unroll
    for (int j = 0; j < 4; ++j) { const int n = (lane >> 3) + 8 * j; const LAS float* s = scr + (8 * c) * 33 + n;
        u32x4 o; o.x = pk2(s[0 * 33], s[1 * 33]); o.y = pk2(s[2 * 33], s[3 * 33]); o.z = pk2(s[4 * 33], s[5 * 33]); o.w = pk2(s[6 * 33], s[7 * 33]);
        *(u32x4*)(WT + (size_t)(n0 + n) * K + k0 + 8 * c) = o; }
    LDS_WAIT(); asm volatile("" ::: "memory");
}
__device__ __forceinline__ int head_perm(int n) { const int hh = n >> 7, phi = n & 127, g = phi >> 3, u = phi & 7; return hh * 128 + 64 * (g >> 3) + 4 * (g & 7) + (u & 3) + 32 * (u >> 2); }

__device__ __forceinline__ void p0_prologue(Frame& F, const Args& args) {
    LAS float* scr = (LAS float*)(F.lds + F.wave * 16384);
    const int gw = F.vcu * NWAVES + F.wave, NGW = F.G * NWAVES, lane = flane();
    constexpr int NI_EVIN = 16 * (EV_N / 32), NI_ODIN = 16 * (OD_N / 32), NI_OUT = 16 * 32, NI_W13 = 16 * 32, NI_W2 = 8 * 32;
    constexpr int NI_MOE1 = NI_W13 + NI_W2;
    constexpr int NITEMS = 2 * NI_EVIN + 2 * NI_ODIN + 4 * NI_OUT + DEPTH * NEXP * NI_MOE1;
    for (int rep_ = 0; rep_ <= REP_CONV; ++rep_)
    for (int it = gw; it < NITEMS; it += NGW) {
        int r = it;
        if (r < 2 * NI_EVIN) { const int p = r / NI_EVIN; r %= NI_EVIN; const int nblk = EV_N / 32, kb = r / nblk, nb = r % nblk; const int n = nb * 32 + (lane & 31);
            conv_item(args.in[I_EVWIN] + (size_t)p * DM * EV_N + head_perm(n), EV_N, (bf16_t*)(F.ws + WS_W_EVIN + (size_t)p * 6 * MiB), DM, nb * 32, kb * 64, scr, lane); continue; }
        r -= 2 * NI_EVIN;
        if (r < 2 * NI_ODIN) { const int p = r / NI_ODIN; r %= NI_ODIN; const int nblk = OD_N / 32, kb = r / nblk, nb = r % nblk; const int n = nb * 32 + (lane & 31);
            conv_item(args.in[I_ODWIN] + (size_t)p * DM * OD_N + head_perm(n), OD_N, (bf16_t*)(F.ws + WS_W_ODIN + (size_t)p * 10 * MiB), DM, nb * 32, kb * 64, scr, lane); continue; }
        r -= 2 * NI_ODIN;
        if (r < 4 * NI_OUT) { const int q = r / NI_OUT; r %= NI_OUT; const int kb = r / 32, nb = r % 32; const int n = nb * 32 + (lane & 31);
            const float* src = (q < 2 ? args.in[I_EVWOUT] + (size_t)q * DM * DM : args.in[I_ODWOUT] + (size_t)(q - 2) * DM * DM);
            bf16_t* dst = (bf16_t*)(F.ws + (q < 2 ? WS_W_EVOUT + (size_t)q * 2 * MiB : WS_W_ODOUT + (size_t)(q - 2) * 2 * MiB));
            conv_item(src + n, DM, dst, DM, nb * 32, kb * 64, scr, lane); continue; }
        r -= 4 * NI_OUT;
        { const int le = r / NI_MOE1; r %= NI_MOE1;
            bf16_t* dst = (bf16_t*)(F.ws + WS_W_MOE + (size_t)le * 3 * MiB);
            if (r < NI_W13) { const int kb = r / 32, nb = r % 32; const int n = nb * 32 + (lane & 31);
                const int Gq = n >> 3, u = n & 7; const float* src = (u < 4 ? args.in[I_W1] : args.in[I_W3]) + (size_t)le * DM * FF + 4 * Gq + (u & 3);
                conv_item(src, FF, dst, DM, nb * 32, kb * 64, scr, lane); }
            else { r -= NI_W13; const int kb = r / 32, nb = r % 32; const int n = nb * 32 + (lane & 31);
                conv_item(args.in[I_W2] + (size_t)le * FF * DM + n, DM, dst + (size_t)DM * DM, FF, nb * 32, kb * 64, scr, lane); }
        }
    }
    {
        f32x4* xr = (f32x4*)(F.ws + WS_XRES);
        const f32x4* xs = (const f32x4*)args.in[I_X]; const f32x4* cs = (const f32x4*)args.in[I_CTX];
        const size_t total = (size_t)MTOK * 256;
        for (size_t i = (size_t)fbid() * 512 + ftid(); i < total; i += (size_t)F.G * 512) {
            const int row = (int)(i >> 8), c4 = (int)(i & 255); const int b = row / SU, p = row % SU;
            xr[i] = (p < NCTX) ? cs[((size_t)(b * NCTX + p) << 8) + c4] : xs[((size_t)(b * LSEQ + p - NCTX) << 8) + c4];
        }
    }
    if (NAIVE_COPY) { float* xr2 = (float*)(F.ws + WS_XRES);
        for (size_t i = (size_t)fbid() * 512 + ftid(); i < (size_t)MTOK * DM; i += (size_t)F.G * 512) { const size_t row = i / DM; const int k = (int)(i % DM); const int b = (int)(row / SU), p = (int)(row % SU);
            xr2[i] = p < NCTX ? args.in[I_CTX][((size_t)b * NCTX + p) * DM + k] : args.in[I_X][((size_t)b * LSEQ + (p - NCTX)) * DM + k]; } }
    {
        float* sp = (float*)(F.ws + WS_SP);
        for (int i = fbid() * 512 + ftid(); i < SP_END; i += F.G * 512) {
            float v;
            if (i < SP_FNORMW) v = args.in[I_NORMW][i]; else if (i < SP_WG) v = args.in[I_FNORMW][i - SP_FNORMW]; else if (i < SP_BG) v = args.in[I_WG][i - SP_WG]; else if (i < SP_WE) v = args.in[I_BG][i - SP_BG];
            else if (i < SP_BE) v = args.in[I_WE][i - SP_WE]; else if (i < SP_DECAY) v = args.in[I_BE][i - SP_BE]; else if (i < SP_SINK) v = args.in[I_RETDECAY][i - SP_DECAY]; else if (i < SP_HGNW) v = args.in[I_SINK][i - SP_SINK]; else v = args.in[I_HGNW][i - SP_HGNW];
            sp[i] = v;
        }
    }
    if (blockIdx.x == 0) {
        float* lb = (float*)(F.ws + WS_LB); const float* lg = args.in[I_LBLOG];
        for (int c = ftid(); c < DM; c += 512) {
            const float a0 = lg[c], a1 = lg[DM + c], a2 = lg[2 * DM + c], a3 = lg[3 * DM + c];
            const float mx = fmaxf(fmaxf(a0, a1), fmaxf(a2, a3));
            const float e0 = expf(a0 - mx), e1 = expf(a1 - mx), e2 = expf(a2 - mx), e3 = expf(a3 - mx); const float inv = 1.0f / (e0 + e1 + e2 + e3);
            lb[c] = 0.f; lb[DM + c] = e1 * inv; lb[2 * DM + c] = (e1 + e2) * inv; lb[3 * DM + c] = (e1 + e2 + e3) * inv;
        }
    }
    if (blockIdx.x == 1) {
        float* rc = (float*)(F.ws + WS_ROPEC); float* rs = (float*)(F.ws + WS_ROPES);
        for (int i = ftid(); i < 64 * 32; i += 512) { const int pos = i >> 5, fi = i & 31;
            const float invf = powf(10000.0f, -(float)(2 * fi) / 64.0f); const float ang = (float)pos * invf;
            rc[i] = cosf(ang); rs[i] = sinf(ang); }
    }
    {
        __syncthreads();
        LAS float* sv = (LAS float*)F.lds;
        LAS float* part = (LAS float*)(F.lds + 20480);
        for (int i = ftid(); i < 5 * DM; i += 512) { const int r = i >> 10, k = i & 1023; const float v = (r < 4) ? args.in[I_C][r * DM + k] : args.in[I_CCTX][k]; sv[i] = siluf(v); }
        __syncthreads();
        float* mod = (float*)(F.ws + WS_MOD);
        for (int it = fbid(); it < DEPTH * 96; it += F.G) {
            const int l = it / 96, cg = it % 96; const int col = cg * 64 + lane;
            const float* w = args.in[I_ADAW] + (size_t)l * DM * 6144 + col;
            float a[5] = {0.f, 0.f, 0.f, 0.f, 0.f};
            const int k0 = F.wave * 128;
#pragma unroll 8
            for (int k = 0; k < 128; ++k) { const float wv = w[(size_t)(k0 + k) * 6144];
#pragma unroll
                for (int r = 0; r < 5; ++r) a[r] += sv[r * DM + k0 + k] * wv; }
#pragma unroll
            for (int r = 0; r < 5; ++r) part[(F.wave * 5 + r) * 64 + lane] = a[r];
            __syncthreads();
            if (ftid() < 320) { const int r = ftid() >> 6, c = ftid() & 63; float s = 0.f;
#pragma unroll
                for (int w8 = 0; w8 < 8; ++w8) s += part[(w8 * 5 + r) * 64 + c];
                mod[((size_t)l * 5 + r) * 6144 + cg * 64 + c] = s + args.in[I_ADAB][l * 6144 + cg * 64 + c]; }
            __syncthreads();
        }
    }
}

__device__ __forceinline__ int moe_tile_prefix(const unsigned* cnt, int lane, int& mycnt) {
    const int c = (lane < NEXP) ? (int)__hip_atomic_load(cnt + lane, __ATOMIC_RELAXED, __HIP_MEMORY_SCOPE_AGENT) : 0; mycnt = c;
    const int nt = (c + 255) >> 8; int incl = nt;
#pragma unroll
    for (int o = 1; o < 64; o <<= 1) { const int v = shup_i(incl, o, lane); if (lane >= o) incl += v; }
    return incl - nt;
}

template <bool FINAL>
__device__ __forceinline__ void n1_phase(Frame& F, const Args& args, int l) {
    const int gw = (MUT_A ? fbid() : F.vcu) * NWAVES + F.wave, NGW = F.G * NWAVES, lane = flane();
    float* xres = (float*)(F.ws + WS_XRES);
    const float* mod = (const float*)(F.ws + WS_MOD);
    int tprefix = 0, dummy;
    if (l > 0) tprefix = moe_tile_prefix(F.ctl + CW_CNT + (l - 1) * NEXP, lane, dummy);
    for (int rr_ = 0; rr_ < (MUT_D ? 64 : 9); ++rr_) {
        const int row = MUT_D ? (fbid() * 512 + F.wave * 64 + rr_) : (gw + rr_ * NGW); if (row >= MTOK) continue;
        const int b = row / SU, p = row % SU; const int mrow = (p < NCTX) ? 4 : b;
        if (FINAL && p < NCTX) continue;
        f32x4* xr = (f32x4*)(xres + (size_t)row * DM) + lane;
        f32x4 v[4];
#pragma unroll
        for (int j = 0; j < 4; ++j) v[j] = xr[64 * j];
        if (l > 0 && CONTRIB_MOE) {
            {
                unsigned* tiw = (unsigned*)(F.ws + WS_TOKINFO) + (size_t)row * 8;
                u32x4 t0, t1;
                t0.x = __hip_atomic_load(tiw + 0, __ATOMIC_RELAXED, __HIP_MEMORY_SCOPE_AGENT); t0.y = __hip_atomic_load(tiw + 1, __ATOMIC_RELAXED, __HIP_MEMORY_SCOPE_AGENT);
                t0.z = __hip_atomic_load(tiw + 2, __ATOMIC_RELAXED, __HIP_MEMORY_SCOPE_AGENT); t0.w = __hip_atomic_load(tiw + 3, __ATOMIC_RELAXED, __HIP_MEMORY_SCOPE_AGENT);
                t1.x = __hip_atomic_load(tiw + 4, __ATOMIC_RELAXED, __HIP_MEMORY_SCOPE_AGENT); t1.y = __hip_atomic_load(tiw + 5, __ATOMIC_RELAXED, __HIP_MEMORY_SCOPE_AGENT); t1.z = 0u; t1.w = 0u;
                const int ts0 = shidx_i(tprefix, (int)t0.x), ts1 = shidx_i(tprefix, (int)t0.z);
                const size_t s0 = (size_t)ts0 * 256 + t0.y, s1 = (size_t)ts1 * 256 + t0.w;
                const unsigned gb0 = t1.x, gb1 = t1.y;
                const float g0 = __builtin_bit_cast(float, gb0), g1 = __builtin_bit_cast(float, gb1);
                const u32x2* y0 = (const u32x2*)(F.ws + WS_YB + s0 * (DM * 2)) + lane; const u32x2* y1 = (const u32x2*)(F.ws + WS_YB + s1 * (DM * 2)) + lane;
                const f32x4* gp = (const f32x4*)(mod + ((size_t)(l - 1) * 5 + mrow) * 6144 + 5 * DM) + lane;
                if (NAIVE_MOE) {
                    const f32x4* n0 = (const f32x4*)(F.ws + WS_YN + (size_t)row * 2 * DM * 4) + lane; const f32x4* n1 = n0 + 256;
#pragma unroll
                    for (int j = 0; j < 4; ++j) { const f32x4 g = gp[64 * j]; v[j] = v[j] + g * (n0[64 * j] * g0 + n1[64 * j] * g1); }
                } else {
                if (MUT_B) {
                    const bf16_t* yy0 = (const bf16_t*)(F.ws + WS_YB) + s0 * DM; const bf16_t* yy1 = (const bf16_t*)(F.ws + WS_YB) + s1 * DM;
                    const float* gate = mod + ((size_t)(l - 1) * 5 + mrow) * 6144 + 5 * DM;
#pragma unroll
                    for (int j = 0; j < 4; ++j) { const int k = 4 * lane + 256 * j;
                        v[j].x += gate[k] * (g0 * bf2f(yy0[k]) + g1 * bf2f(yy1[k])); v[j].y += gate[k + 1] * (g0 * bf2f(yy0[k + 1]) + g1 * bf2f(yy1[k + 1]));
                        v[j].z += gate[k + 2] * (g0 * bf2f(yy0[k + 2]) + g1 * bf2f(yy1[k + 2])); v[j].w += gate[k + 3] * (g0 * bf2f(yy0[k + 3]) + g1 * bf2f(yy1[k + 3])); }
                } else {
#pragma unroll
                for (int j = 0; j < 4; ++j) { const u32x2 a = y0[64 * j], c = y1[64 * j]; const f32x4 g = gp[64 * j];
                    v[j].x += g.x * (g0 * bflo(a.x) + g1 * bflo(c.x)); v[j].y += g.y * (g0 * bfhi(a.x) + g1 * bfhi(c.x));
                    v[j].z += g.z * (g0 * bflo(a.y) + g1 * bflo(c.y)); v[j].w += g.w * (g0 * bfhi(a.y) + g1 * bfhi(c.y)); }
                }
                }
                if (!FINAL) {
#pragma unroll
                    for (int j = 0; j < 4; ++j) xr[64 * j] = v[j];
                }
            }
        }
        float s = 0.f;
#pragma unroll
        for (int j = 0; j < 4; ++j) s += (v[j].x * v[j].x + v[j].y * v[j].y) + (v[j].z * v[j].z + v[j].w * v[j].w);
        const float rstd = 1.0f / sqrtf(wave_sum(s, lane) * (1.0f / DM) + EPS);
        if (FINAL) {
            const f32x4* nw = (const f32x4*)((const float*)(F.ws + WS_SP) + SP_FNORMW) + lane;
            f32x4* o = (f32x4*)(args.out + ((size_t)b * LSEQ + (p - NCTX)) * DM) + lane;
#pragma unroll
            for (int j = 0; j < 4; ++j) { const f32x4 w = nw[64 * j]; o[64 * j] = v[j] * rstd * w; }
        } else {
            const f32x4* nw = (const f32x4*)(((const float*)(F.ws + WS_SP) + SP_NORMW) + (size_t)(l * 2 + 0) * DM) + lane;
            const f32x4* sh = (const f32x4*)(mod + ((size_t)l * 5 + mrow) * 6144 + 0 * DM) + lane;
            const f32x4* sc = (const f32x4*)(mod + ((size_t)l * 5 + mrow) * 6144 + 1 * DM) + lane;
            u32x2* o = (u32x2*)(F.ws + WS_HB + (size_t)row * (DM * 2)) + lane;
#pragma unroll
            for (int j = 0; j < 4; ++j) { const f32x4 w = nw[64 * j], a = sh[64 * j], c = sc[64 * j]; const f32x4 h = v[j] * rstd * w * (c + 1.0f) + a;
                u32x2 q; q.x = pk2(h.x, h.y); q.y = pk2(h.z, h.w); o[64 * j] = q; }
        }
    }
}

__device__ __forceinline__ void naive_n1(Frame& F, const Args& args, int l, bool final_) {
    float* xres = (float*)(F.ws + WS_XRES);
    const float* mod = (const float*)(F.ws + WS_MOD);
    for (int row = fbid() * 512 + ftid(); row < MTOK; row += F.G * 512) {
        const int b = row / SU, p = row % SU; const int mrow = (p < NCTX) ? 4 : b;
        if (final_ && p < NCTX) continue;
        float* xr = xres + (size_t)row * DM;
        if (l > 0) {
            const unsigned* cnt = F.ctl + CW_CNT + (l - 1) * NEXP;
            const unsigned* ti = (const unsigned*)(F.ws + WS_TOKINFO) + (size_t)row * 8;
            const unsigned e0 = ti[0], p0 = ti[1], e1 = ti[2], p1 = ti[3]; const float g0 = __builtin_bit_cast(float, ti[4]), g1 = __builtin_bit_cast(float, ti[5]);
            int ts0 = 0, ts1 = 0; for (unsigned e = 0; e < e0; ++e) ts0 += ((int)cnt[e] + 255) / 256; for (unsigned e = 0; e < e1; ++e) ts1 += ((int)cnt[e] + 255) / 256;
            const bf16_t* y0 = (const bf16_t*)(F.ws + WS_YB) + ((size_t)ts0 * 256 + p0) * DM; const bf16_t* y1 = (const bf16_t*)(F.ws + WS_YB) + ((size_t)ts1 * 256 + p1) * DM;
            const float* gate = mod + ((size_t)(l - 1) * 5 + mrow) * 6144 + 5 * DM;
            for (int k = 0; k < DM; ++k) xr[k] = xr[k] + gate[k] * (g0 * bf2f(y0[k]) + g1 * bf2f(y1[k]));
        }
        double ss = 0.0; for (int k = 0; k < DM; ++k) ss += (double)xr[k] * xr[k];
        const float rstd = 1.0f / sqrtf((float)(ss / DM) + EPS);
        if (final_) { float* o = args.out + ((size_t)b * LSEQ + (p - NCTX)) * DM; for (int k = 0; k < DM; ++k) o[k] = xr[k] * rstd * args.in[I_FNORMW][k]; }
        else { bf16_t* hb = (bf16_t*)(F.ws + WS_HB) + (size_t)row * DM; const float* nw = args.in[I_NORMW] + (size_t)(l * 2) * DM; const float* mr = mod + ((size_t)l * 5 + mrow) * 6144;
            for (int k = 0; k < DM; ++k) hb[k] = (bf16_t)f2bf(xr[k] * rstd * nw[k] * (1.0f + mr[DM + k]) + mr[k]); }
    }
}
__device__ __forceinline__ void wave_n1(Frame& F, const Args& args, int l, bool final_) {
    float* xres = (float*)(F.ws + WS_XRES);
    const float* mod = (const float*)(F.ws + WS_MOD);
    const int gw = F.vcu * NWAVES + F.wave, NGW = F.G * NWAVES, lane = flane();
    for (int row = gw; row < MTOK; row += NGW) {
        const int b = row / SU, p = row % SU; const int mrow = (p < NCTX) ? 4 : b;
        if (final_ && p < NCTX) continue;
        float* xr = xres + (size_t)row * DM;
        float xv[16];
#pragma unroll
        for (int i = 0; i < 16; ++i) xv[i] = xr[lane + 64 * i];
        if (l > 0) {
            const unsigned* cnt = F.ctl + CW_CNT + (l - 1) * NEXP;
            const unsigned* ti = (const unsigned*)(F.ws + WS_TOKINFO) + (size_t)row * 8;
            const unsigned e0 = ti[0], p0 = ti[1], e1 = ti[2], p1 = ti[3]; const float g0 = __builtin_bit_cast(float, ti[4]), g1 = __builtin_bit_cast(float, ti[5]);
            int ts0 = 0, ts1 = 0; for (unsigned e = 0; e < e0; ++e) ts0 += ((int)cnt[e] + 255) / 256; for (unsigned e = 0; e < e1; ++e) ts1 += ((int)cnt[e] + 255) / 256;
            const bf16_t* y0 = (const bf16_t*)(F.ws + WS_YB) + ((size_t)ts0 * 256 + p0) * DM; const bf16_t* y1 = (const bf16_t*)(F.ws + WS_YB) + ((size_t)ts1 * 256 + p1) * DM;
            const float* gate = mod + ((size_t)(l - 1) * 5 + mrow) * 6144 + 5 * DM;
#pragma unroll
            for (int i = 0; i < 16; ++i) { const int k = lane + 64 * i; xv[i] = xv[i] + gate[k] * (g0 * bf2f(y0[k]) + g1 * bf2f(y1[k])); if (!final_) xr[k] = xv[i]; }
        }
        float ss = 0.f;
#pragma unroll
        for (int i = 0; i < 16; ++i) ss += xv[i] * xv[i];
        const float rstd = 1.0f / sqrtf(wave_sum(ss, lane) * (1.0f / DM) + EPS);
        if (final_) { float* o = args.out + ((size_t)b * LSEQ + (p - NCTX)) * DM;
#pragma unroll
            for (int i = 0; i < 16; ++i) { const int k = lane + 64 * i; o[k] = xv[i] * rstd * args.in[I_FNORMW][k]; } }
        else { bf16_t* hb = (bf16_t*)(F.ws + WS_HB) + (size_t)row * DM; const float* nw = args.in[I_NORMW] + (size_t)(l * 2) * DM; const float* mr = mod + ((size_t)l * 5 + mrow) * 6144;
#pragma unroll
            for (int i = 0; i < 16; ++i) { const int k = lane + 64 * i; hb[k] = (bf16_t)f2bf(xv[i] * rstd * nw[k] * (1.0f + mr[DM + k]) + mr[k]); } }
    }
}
__device__ __forceinline__ void n2r_phase(Frame& F, const Args& args, int l) {
    const int gw = F.vcu * NWAVES + F.wave, NGW = F.G * NWAVES, lane = flane();
    const float* xres = (const float*)(F.ws + WS_XRES);
    const float* mod = (const float*)(F.ws + WS_MOD);
    unsigned* cnt = F.ctl + CW_CNT + l * NEXP;
    unsigned* list = (unsigned*)(F.ws + WS_LIST);
    const float* wg = ((const float*)(F.ws + WS_SP) + SP_WG) + (size_t)l * DM * 4; const float* bg = ((const float*)(F.ws + WS_SP) + SP_BG) + l * 4;
    const float* we = ((const float*)(F.ws + WS_SP) + SP_WE) + (size_t)l * 4 * DM * 8; const float* be = ((const float*)(F.ws + WS_SP) + SP_BE) + l * 32;
    LAS float* wgT = (LAS float*)F.lds; LAS float* weT = wgT + 4 * DM;
    LAS unsigned* hist = (LAS unsigned*)(F.lds + LDSCTL_OFF + 1024); LAS unsigned* baseL = hist + 32; LAS unsigned* rec = hist + 64 + F.wave * 36;
    __syncthreads();
    if (ftid() < 32) hist[ftid()] = 0u;
    {   const int t = ftid();
        for (int r = t; r < DM; r += 512) { const f32x4 a = *(const f32x4*)(wg + (size_t)r * 4); wgT[r] = a.x; wgT[DM + r] = a.y; wgT[2 * DM + r] = a.z; wgT[3 * DM + r] = a.w; }
        for (int r = t; r < 4 * DM; r += 512) { const int g = r >> 10, c = r & 1023; const f32x4 a = *(const f32x4*)(we + (size_t)r * 8), b2 = *(const f32x4*)(we + (size_t)r * 8 + 4);
            LAS float* d = weT + g * 8 * DM + c; d[0] = a.x; d[DM] = a.y; d[2 * DM] = a.z; d[3 * DM] = a.w; d[4 * DM] = b2.x; d[5 * DM] = b2.y; d[6 * DM] = b2.z; d[7 * DM] = b2.w; }
    }
    __syncthreads();
    for (int k_ = 0; k_ < 9; ++k_) {
        const int row = gw + k_ * NGW; if (row >= MTOK) break;
        const int b = row / SU, p = row % SU; const int mrow = (p < NCTX) ? 4 : b;
        if (l == DEPTH - 1 && p < NCTX) continue;
        const f32x4* xr = (const f32x4*)(xres + (size_t)row * DM) + lane;
        f32x4 v[4]; float s = 0.f;
#pragma unroll
        for (int j = 0; j < 4; ++j) { v[j] = xr[64 * j]; s += (v[j].x * v[j].x + v[j].y * v[j].y) + (v[j].z * v[j].z + v[j].w * v[j].w); }
        const float rstd = 1.0f / sqrtf(wave_sum(s, lane) * (1.0f / DM) + EPS);
        const f32x4* nw = (const f32x4*)(((const float*)(F.ws + WS_SP) + SP_NORMW) + (size_t)(l * 2 + 1) * DM) + lane;
        const f32x4* sh = (const f32x4*)(mod + ((size_t)l * 5 + mrow) * 6144 + 3 * DM) + lane;
        const f32x4* sc = (const f32x4*)(mod + ((size_t)l * 5 + mrow) * 6144 + 4 * DM) + lane;
        u32x2* o = (u32x2*)(F.ws + WS_HB + (size_t)row * (DM * 2)) + lane;
        float gl[4] = {0.f, 0.f, 0.f, 0.f};
#pragma unroll
        for (int j = 0; j < 4; ++j) { const f32x4 w = nw[64 * j], a = sh[64 * j], c = sc[64 * j]; const f32x4 h = v[j] * rstd * w * (c + 1.0f) + a; v[j] = h;
            u32x2 q; q.x = pk2(h.x, h.y); q.y = pk2(h.z, h.w); o[64 * j] = q;
#pragma unroll
            for (int g = 0; g < 4; ++g) { const f32x4 wv = *(const LAS f32x4*)(wgT + g * DM + 4 * lane + 256 * j); gl[g] += (h.x * wv.x + h.y * wv.y) + (h.z * wv.z + h.w * wv.w); } }
#pragma unroll
        for (int g = 0; g < 4; ++g) gl[g] = wave_sum(gl[g], lane) + bg[g];
        int gi = 0; float gm = gl[0];
#pragma unroll
        for (int g = 1; g < 4; ++g) if (gl[g] > gm) { gm = gl[g]; gi = g; }
        const float gp = 1.0f / (expf(gl[0] - gm) + expf(gl[1] - gm) + expf(gl[2] - gm) + expf(gl[3] - gm));
        const LAS float* weg = weT + gi * 8 * DM;
        float el[8] = {0.f, 0.f, 0.f, 0.f, 0.f, 0.f, 0.f, 0.f};
#pragma unroll
        for (int j = 0; j < 4; ++j) {
#pragma unroll
            for (int e = 0; e < 8; ++e) { const f32x4 wv = *(const LAS f32x4*)(weg + e * DM + 4 * lane + 256 * j); el[e] += (v[j].x * wv.x + v[j].y * wv.y) + (v[j].z * wv.z + v[j].w * wv.w); }
        }
#pragma unroll
        for (int e = 0; e < 8; ++e) el[e] = wave_sum(el[e], lane) + be[gi * 8 + e];
        int i0 = 0; float v0 = el[0];
#pragma unroll
        for (int e = 1; e < 8; ++e) if (el[e] > v0) { v0 = el[e]; i0 = e; }
        int i1 = -1; float v1 = -3.0e38f;
#pragma unroll
        for (int e = 0; e < 8; ++e) if (e != i0 && el[e] > v1) { v1 = el[e]; i1 = e; }
        const float w0 = 1.0f / (1.0f + expf(v1 - v0)), w1 = 1.0f - w0;
        if (lane == 0) {
            const unsigned e0 = (unsigned)(gi * 8 + i0), e1 = (unsigned)(gi * 8 + i1);
            const unsigned lp0 = __hip_atomic_fetch_add(hist + e0, 1u, __ATOMIC_RELAXED, __HIP_MEMORY_SCOPE_WORKGROUP), lp1 = __hip_atomic_fetch_add(hist + e1, 1u, __ATOMIC_RELAXED, __HIP_MEMORY_SCOPE_WORKGROUP);
            rec[k_ * 4 + 0] = e0; rec[k_ * 4 + 1] = lp0; rec[k_ * 4 + 2] = e1; rec[k_ * 4 + 3] = lp1;
            u32x4* ti = (u32x4*)(F.ws + WS_TOKINFO) + (size_t)row * 2;
            ti[1] = (u32x4){__builtin_bit_cast(unsigned, gp * w0), __builtin_bit_cast(unsigned, gp * w1), 0u, 0u};
        }
    }
    __syncthreads();
    if (ftid() < 32) { const unsigned hc = hist[ftid()]; baseL[ftid()] = hc ? atomicAdd(cnt + ftid(), hc) : 0u; }
    __syncthreads();
    if (lane == 0) {
        for (int k_ = 0; k_ < 9; ++k_) {
            const int row = gw + k_ * NGW; if (row >= MTOK) break;
            if (l == DEPTH - 1 && (row % SU) < NCTX) continue;
            const unsigned e0 = rec[k_ * 4 + 0], e1 = rec[k_ * 4 + 2]; const unsigned p0 = baseL[e0] + rec[k_ * 4 + 1], p1 = baseL[e1] + rec[k_ * 4 + 3];
            list[(size_t)e0 * LIST_CAP + p0] = (unsigned)row; list[(size_t)e1 * LIST_CAP + p1] = (unsigned)row;
            u32x4* ti = (u32x4*)(F.ws + WS_TOKINFO) + (size_t)row * 2;
            ti[0] = (u32x4){e0, p0, e1, p1};
        }
    }
    __syncthreads();
}

__device__ __forceinline__ void naive_n2r(Frame& F, const Args& args, int l) {
    const float* xres = (const float*)(F.ws + WS_XRES);
    const float* mod = (const float*)(F.ws + WS_MOD);
    unsigned* cnt = F.ctl + CW_CNT + l * NEXP;
    unsigned* list = (unsigned*)(F.ws + WS_LIST);
    const float* wg = args.in[I_WG] + (size_t)l * DM * 4; const float* bg = args.in[I_BG] + l * 4;
    const float* we = args.in[I_WE] + (size_t)l * 4 * DM * 8; const float* be = args.in[I_BE] + l * 32;
    for (int row = fbid() * 512 + ftid(); row < MTOK; row += F.G * 512) {
        const int b = row / SU, p = row % SU; const int mrow = (p < NCTX) ? 4 : b;
        if (l == DEPTH - 1 && p < NCTX) continue;
        const float* xr = xres + (size_t)row * DM; double ss = 0.0;
        for (int k = 0; k < DM; ++k) ss += (double)xr[k] * xr[k];
        const float rstd = 1.0f / sqrtf((float)(ss / DM) + EPS);
        const float* nw = args.in[I_NORMW] + (size_t)(l * 2 + 1) * DM; const float* mr = mod + ((size_t)l * 5 + mrow) * 6144;
        bf16_t* hb = (bf16_t*)(F.ws + WS_HB) + (size_t)row * DM;
        float gl[4] = {bg[0], bg[1], bg[2], bg[3]};
        for (int k = 0; k < DM; ++k) { const float h = xr[k] * rstd * nw[k] * (1.0f + mr[4 * DM + k]) + mr[3 * DM + k]; hb[k] = (bf16_t)f2bf(h);
            gl[0] += h * wg[k * 4 + 0]; gl[1] += h * wg[k * 4 + 1]; gl[2] += h * wg[k * 4 + 2]; gl[3] += h * wg[k * 4 + 3]; }
        int gi = 0; for (int g = 1; g < 4; ++g) if (gl[g] > gl[gi]) gi = g;
        float den = 0.f; for (int g = 0; g < 4; ++g) den += expf(gl[g] - gl[gi]);
        const float gp = 1.0f / den;
        float el[8]; for (int e = 0; e < 8; ++e) el[e] = be[gi * 8 + e];
        for (int k = 0; k < DM; ++k) { const float h = xr[k] * rstd * nw[k] * (1.0f + mr[4 * DM + k]) + mr[3 * DM + k]; const float* wr = we + ((size_t)gi * DM + k) * 8;
#pragma unroll
            for (int e = 0; e < 8; ++e) el[e] += h * wr[e]; }
        int i0 = 0; for (int e = 1; e < 8; ++e) if (el[e] > el[i0]) i0 = e;
        int i1 = (i0 == 0) ? 1 : 0; for (int e = 0; e < 8; ++e) if (e != i0 && el[e] > el[i1]) i1 = e;
        const float m2 = el[i0]; const float a0 = 1.0f, a1 = expf(el[i1] - m2); const float w0 = a0 / (a0 + a1), w1 = a1 / (a0 + a1);
        const unsigned e0 = (unsigned)(gi * 8 + i0), e1 = (unsigned)(gi * 8 + i1);
        const unsigned p0 = atomicAdd(cnt + e0, 1u), p1 = atomicAdd(cnt + e1, 1u);
        list[(size_t)e0 * LIST_CAP + p0] = (unsigned)row; list[(size_t)e1 * LIST_CAP + p1] = (unsigned)row;
        u32x4* ti = (u32x4*)(F.ws + WS_TOKINFO) + (size_t)row * 2;
        ti[0] = (u32x4){e0, p0, e1, p1}; ti[1] = (u32x4){__builtin_bit_cast(unsigned, gp * w0), __builtin_bit_cast(unsigned, gp * w1), 0u, 0u};
    }
}

struct EpiProj {
    static constexpr bool PERM = true;
    unsigned char* ws; const float* lb; int odd;
    __device__ __forceinline__ void operator()(const f32x4 (&acc)[2][2][4][2], const pg8::Unit& u, int wr, int wc, int fr, int fq) const {
        const int pmb = u.pm % 17; const bool isctx = (pmb == 0); const int tbase = (pmb - 1) * 256;
        const int g = 4 * wc + fq, half = g >> 3, f0 = 4 * (g & 7);
        const float* ropec = (const float*)(ws + WS_ROPEC); const float* ropes = (const float*)(ws + WS_ROPES);
#pragma unroll
        for (int bj = 0; bj < 2; ++bj) {
            const int hcol = 256 * u.pn + 128 * bj; const int lc0 = hcol + 64 * half + f0;
            if (!odd) {
                const bool rope = !isctx && (hcol < 1024 || (hcol >= 2048 && hcol < 2816));
                const float scale = (hcol >= 512 && hcol < 1024) ? 0.08838834764831845f : 1.0f;
                bf16_t* dst = (bf16_t*)(ws + WS_PE);
#pragma unroll
                for (int ai = 0; ai < 2; ++ai)
#pragma unroll
                    for (int m = 0; m < 4; ++m) {
                        const int rr = 128 * ai + 64 * wr + 16 * m + fr; const size_t row = (size_t)u.pm * 256 + rr;
                        f32x4 x1 = acc[ai][bj][m][0] * scale, x2 = acc[ai][bj][m][1] * scale;
                        if (rope) { const int t = tbase + rr; const int pos = half ? (t & 63) : (t >> 6);
                            const f32x4 c = *(const f32x4*)(ropec + pos * 32 + f0), s = *(const f32x4*)(ropes + pos * 32 + f0);
                            const f32x4 o1 = x1 * c - x2 * s, o2 = x2 * c + x1 * s; x1 = o1; x2 = o2; }
                        u32x2 q1, q2; q1.x = pk2(x1.x, x1.y); q1.y = pk2(x1.z, x1.w); q2.x = pk2(x2.x, x2.y); q2.y = pk2(x2.z, x2.w);
                        *(u32x2*)(dst + row * EV_N + lc0) = q1; *(u32x2*)(dst + row * EV_N + lc0 + 32) = q2;
                    }
            } else {
                const int seg = hcol >> 10, c0 = lc0 & 1023;
                if (seg == 1 || seg == 2) {
                    float* dst = (float*)(ws + (seg == 1 ? WS_FF : WS_FB));
                    const f32x4 l1 = *(const f32x4*)(lb + c0), l2 = *(const f32x4*)(lb + c0 + 32);
#pragma unroll
                    for (int ai = 0; ai < 2; ++ai)
#pragma unroll
                        for (int m = 0; m < 4; ++m) {
                            const size_t row = (size_t)u.pm * 256 + 128 * ai + 64 * wr + 16 * m + fr;
                            const f32x4 z1 = acc[ai][bj][m][0], z2 = acc[ai][bj][m][1]; f32x4 f1, f2;
                            f1.x = l1.x + (1.f - l1.x) / (1.f + __expf(-z1.x)); f1.y = l1.y + (1.f - l1.y) / (1.f + __expf(-z1.y)); f1.z = l1.z + (1.f - l1.z) / (1.f + __expf(-z1.z)); f1.w = l1.w + (1.f - l1.w) / (1.f + __expf(-z1.w));
                            f2.x = l2.x + (1.f - l2.x) / (1.f + __expf(-z2.x)); f2.y = l2.y + (1.f - l2.y) / (1.f + __expf(-z2.y)); f2.z = l2.z + (1.f - l2.z) / (1.f + __expf(-z2.z)); f2.w = l2.w + (1.f - l2.w) / (1.f + __expf(-z2.w));
                            *(f32x4*)(dst + row * DM + c0) = f1; *(f32x4*)(dst + row * DM + c0 + 32) = f2;
                        }
                } else {
                    bf16_t* dst = (bf16_t*)(ws + (seg == 0 ? WS_PQ : (seg == 3 ? WS_PI : WS_PG)));
#pragma unroll
                    for (int ai = 0; ai < 2; ++ai)
#pragma unroll
                        for (int m = 0; m < 4; ++m) {
                            const size_t row = (size_t)u.pm * 256 + 128 * ai + 64 * wr + 16 * m + fr;
                            const f32x4 x1 = acc[ai][bj][m][0], x2 = acc[ai][bj][m][1];
                            u32x2 q1, q2; q1.x = pk2(x1.x, x1.y); q1.y = pk2(x1.z, x1.w); q2.x = pk2(x2.x, x2.y); q2.y = pk2(x2.z, x2.w);
                            *(u32x2*)(dst + row * DM + c0) = q1; *(u32x2*)(dst + row * DM + c0 + 32) = q2;
                        }
                }
            }
        }
    }
};
struct EpiOut {
    static constexpr bool PERM = false;
    float* xres; const float* modl; int enable;
    __device__ __forceinline__ void operator()(const f32x4 (&acc)[2][2][4][2], const pg8::Unit& u, int wr, int wc, int fr, int fq) const {
        if (!enable) return;
        const int pmb = u.pm % 17; const int mrow = (pmb == 0) ? 4 : (u.pm / 17);
        const float* gate = modl + (size_t)mrow * 6144 + 2 * DM;
#pragma unroll
        for (int bj = 0; bj < 2; ++bj)
#pragma unroll
            for (int n = 0; n < 2; ++n) {
                const int c = 256 * u.pn + 128 * bj + 32 * wc + 16 * n + 4 * fq; const f32x4 gv = *(const f32x4*)(gate + c);
#pragma unroll
                for (int ai = 0; ai < 2; ++ai)
#pragma unroll
                    for (int m = 0; m < 4; ++m) { f32x4* p = (f32x4*)(xres + ((size_t)u.pm * 256 + 128 * ai + 64 * wr + 16 * m + fr) * DM + c); *p = *p + gv * acc[ai][bj][m][n]; }
            }
    }
};
struct EpiAct {
    static constexpr bool PERM = true;
    bf16_t* Act;
    __device__ __forceinline__ void operator()(const f32x4 (&acc)[2][2][4][2], const pg8::Unit& u, int wr, int wc, int fr, int fq) const {
#pragma unroll
        for (int bj = 0; bj < 2; ++bj) { const int Gq = 32 * u.pn + 16 * bj + 4 * wc + fq;
#pragma unroll
            for (int ai = 0; ai < 2; ++ai)
#pragma unroll
                for (int m = 0; m < 4; ++m) { const size_t row = (size_t)u.tile * 256 + 128 * ai + 64 * wr + 16 * m + fr;
                    const f32x4 a = acc[ai][bj][m][0], b = acc[ai][bj][m][1];
                    u32x2 q; q.x = pk2(siluf(a.x) * b.x, siluf(a.y) * b.y); q.y = pk2(siluf(a.z) * b.z, siluf(a.w) * b.w);
                    *(u32x2*)(Act + row * FF + 4 * Gq) = q; } }
    }
};
struct EpiY {
    static constexpr bool PERM = true;
    bf16_t* YB;
    __device__ __forceinline__ void operator()(const f32x4 (&acc)[2][2][4][2], const pg8::Unit& u, int wr, int wc, int fr, int fq) const {
#pragma unroll
        for (int bj = 0; bj < 2; ++bj) { const int c = 256 * u.pn + 128 * bj + 32 * wc + 8 * fq;
#pragma unroll
            for (int ai = 0; ai < 2; ++ai)
#pragma unroll
                for (int m = 0; m < 4; ++m) { const size_t row = (size_t)u.tile * 256 + 128 * ai + 64 * wr + 16 * m + fr;
                    const f32x4 a = acc[ai][bj][m][0], b = acc[ai][bj][m][1];
                    u32x4 q; q.x = pk2(a.x, a.y); q.y = pk2(a.z, a.w); q.z = pk2(b.x, b.y); q.w = pk2(b.z, b.w);
                    *(u32x4*)(YB + row * DM + c) = q; } }
    }
};

__device__ __forceinline__ void naive_g1(Frame& F, const Args& args, int l) {
    const int odd = l & 1, p = l >> 1; const int N = odd ? OD_N : EV_N;
    const float* W = (odd ? args.in[I_ODWIN] : args.in[I_EVWIN]) + (size_t)p * DM * N;
    LAS float* sh = (LAS float*)F.lds;
    const float* lb = (const float*)(F.ws + WS_LB) + l * DM;
    const float* ropec = (const float*)(F.ws + WS_ROPEC); const float* ropes = (const float*)(F.ws + WS_ROPES);
    for (int rg = fbid(); rg < MTOK / 8; rg += F.G) {
        __syncthreads();
        if (NAIVE_G1 == 2) {
            const int row = rg * 8 + F.wave; const int bb = row / SU, pp = row % SU; const int mrow = pp < NCTX ? 4 : bb;
            const float* xr = (const float*)(F.ws + WS_XRES) + (size_t)row * DM; float ssq = 0.f;
            for (int k = flane(); k < DM; k += 64) ssq += xr[k] * xr[k];
            ssq = wave_sum(ssq, flane()); const float rs = 1.0f / sqrtf(ssq / (float)DM + EPS);
            const float* modr = (const float*)(F.ws + WS_MOD) + ((size_t)l * 5 + mrow) * 6144;
            for (int k = flane(); k < DM; k += 64) sh[F.wave * DM + k] = xr[k] * rs * args.in[I_NORMW][(size_t)(l * 2) * DM + k] * (1.0f + modr[DM + k]) + modr[k];
        } else
        for (int i = ftid(); i < 8 * DM; i += 512) sh[i] = bf2f(((const bf16_t*)(F.ws + WS_HB))[(size_t)rg * 8 * DM + i]);
        __syncthreads();
        for (int pi = ftid(); pi < N / 2; pi += 512) {
            const int hh = pi >> 6, rem = pi & 63, half = rem >> 5, d = rem & 31; const int cA = 128 * hh + 64 * half + d, cB = cA + 32;
            float a[8], bq[8];
#pragma unroll
            for (int r = 0; r < 8; ++r) { a[r] = 0.f; bq[r] = 0.f; }
            for (int k = 0; k < DM; ++k) { const float wa = W[(size_t)k * N + cA], wb = W[(size_t)k * N + cB];
#pragma unroll
                for (int r = 0; r < 8; ++r) { const float hv = sh[r * DM + k]; a[r] += hv * wa; bq[r] += hv * wb; } }
            const int hcol = 128 * hh;
#pragma unroll
            for (int r = 0; r < 8; ++r) {
                const int row = rg * 8 + r; const int pp = row % SU; const bool isctx = pp < NCTX; const int t = pp - NCTX;
                float x1 = a[r], x2 = bq[r];
                if (!odd) {
                    const bool rope = !isctx && (hcol < 1024 || (hcol >= 2048 && hcol < 2816));
                    if (hcol >= 512 && hcol < 1024) { x1 *= 0.08838834764831845f; x2 *= 0.08838834764831845f; }
                    if (rope) { const int pos = half ? (t & 63) : (t >> 6); float cc = ropec[pos * 32 + d], sn = ropes[pos * 32 + d];
                        if (NAIVE_G1 == 3) { const double ang = (double)((float)pos * powf(10000.0f, -(float)d / 32.0f)); cc = (float)cos(ang); sn = (float)sin(ang); }
                        const float o1 = x1 * cc - x2 * sn, o2 = x2 * cc + x1 * sn; x1 = o1; x2 = o2; }
                    bf16_t* dst = (bf16_t*)(F.ws + WS_PE) + (size_t)row * EV_N; dst[cA] = (bf16_t)f2bf(x1); dst[cB] = (bf16_t)f2bf(x2);
                } else {
                    const int seg = hcol >> 10, c0 = cA & 1023;
                    if (seg == 1 || seg == 2) { float* dst = (float*)(F.ws + (seg == 1 ? WS_FF : WS_FB)) + (size_t)row * DM;
                        float lba = lb[c0], lbb = lb[c0 + 32];
                        if (NAIVE_G1 == 3) { const float* lg = args.in[I_LBLOG]; float ea[4], eb[4], sa = 0.f, sb2 = 0.f; for (int q = 0; q < 4; ++q) { ea[q] = expf(lg[q * DM + c0]); eb[q] = expf(lg[q * DM + c0 + 32]); sa += ea[q]; sb2 += eb[q]; }
                            lba = 0.f; lbb = 0.f; for (int q = 1; q <= l; ++q) { lba += ea[q] / sa; lbb += eb[q] / sb2; } }
                        dst[c0] = lba + (1.f - lba) / (1.f + expf(-x1)); dst[c0 + 32] = lbb + (1.f - lbb) / (1.f + expf(-x2)); }
                    else { bf16_t* dst = (bf16_t*)(F.ws + (seg == 0 ? WS_PQ : (seg == 3 ? WS_PI : WS_PG))) + (size_t)row * DM; dst[c0] = (bf16_t)f2bf(x1); dst[c0 + 32] = (bf16_t)f2bf(x2); }
                }
            }
        }
    }
    __syncthreads();
}

__device__ __forceinline__ void naive_g2(Frame& F, const Args& args, int l) {
    const int odd = l & 1, p = l >> 1;
    const float* W = (odd ? args.in[I_ODWOUT] : args.in[I_EVWOUT]) + (size_t)p * DM * DM;
    LAS float* sh = (LAS float*)F.lds;
    const float* modl = (const float*)(F.ws + WS_MOD) + (size_t)l * 5 * 6144;
    float* xres = (float*)(F.ws + WS_XRES);
    for (int rg = fbid(); rg < MTOK / 8; rg += F.G) {
        __syncthreads();
        for (int i = ftid(); i < 8 * DM; i += 512) sh[i] = bf2f(((const bf16_t*)(F.ws + WS_YB16))[(size_t)rg * 8 * DM + i]);
        __syncthreads();
        for (int col = ftid(); col < DM; col += 512) {
            float a[8];
#pragma unroll
            for (int r = 0; r < 8; ++r) a[r] = 0.f;
            for (int k = 0; k < DM; ++k) { const float wa = W[(size_t)k * DM + col];
#pragma unroll
                for (int r = 0; r < 8; ++r) a[r] += sh[r * DM + k] * wa; }
#pragma unroll
            for (int r = 0; r < 8; ++r) { const int row = rg * 8 + r; const int b = row / SU, pp = row % SU; const int mrow = pp < NCTX ? 4 : b;
                xres[(size_t)row * DM + col] += modl[(size_t)mrow * 6144 + 2 * DM + col] * a[r]; }
        }
    }
    __syncthreads();
}
__device__ __forceinline__ void naive_mod(Frame& F, const Args& args) {
    float* mod = (float*)(F.ws + WS_MOD);
    for (int i = fbid() * 512 + ftid(); i < DEPTH * 5 * 6144; i += F.G * 512) {
        const int col = i % 6144, r = (i / 6144) % 5, l = i / (5 * 6144);
        const float* cv = r < 4 ? args.in[I_C] + r * DM : args.in[I_CCTX];
        const float* w = args.in[I_ADAW] + (size_t)l * DM * 6144 + col;
        float a = 0.f;
        for (int k = 0; k < DM; ++k) { const float v = cv[k]; a += (v / (1.0f + expf(-v))) * w[(size_t)k * 6144]; }
        mod[i] = a + args.in[I_ADAB][l * 6144 + col];
    }
}

__device__ __forceinline__ void naive_moe(Frame& F, const Args& args, int l) {
    LAS float* sh = (LAS float*)F.lds;
    LAS float* sa = sh + 8 * DM;
    LAS int* gstart = (LAS int*)(sa + 8 * FF);
    LAS int* stok = gstart + 40;
    const unsigned* cnt = F.ctl + CW_CNT + l * NEXP;
    const unsigned* list = (const unsigned*)(F.ws + WS_LIST);
    __syncthreads();
    if (ftid() == 0) { int acc = 0; for (int e = 0; e < NEXP; ++e) { gstart[e] = acc; acc += ((int)cnt[e] + 7) / 8; } gstart[NEXP] = acc; }
    __syncthreads();
    const int total = gstart[NEXP];
    float* YN = (float*)(F.ws + WS_YN);
    for (int gi = fbid(); gi < total; gi += F.G) {
        int e = 0; for (int k = 1; k < NEXP; ++k) e += (gstart[k] <= gi) ? 1 : 0;
        const int g = gi - gstart[e]; const int ce = (int)cnt[e];
        __syncthreads();
        if (ftid() < 8) { const int idx = 8 * g + ftid(); stok[ftid()] = idx < ce ? (int)list[(size_t)e * LIST_CAP + idx] : -1; }
        __syncthreads();
        for (int i = ftid(); i < 8 * DM; i += 512) { const int r = i >> 10, k = i & 1023; const int tk = stok[r]; sh[i] = tk >= 0 ? bf2f(((const bf16_t*)(F.ws + WS_HB))[(size_t)tk * DM + k]) : 0.f; }
        __syncthreads();
        const float* w1 = args.in[I_W1] + ((size_t)l * NEXP + e) * DM * FF; const float* w3 = args.in[I_W3] + ((size_t)l * NEXP + e) * DM * FF; const float* w2 = args.in[I_W2] + ((size_t)l * NEXP + e) * FF * DM;
        { const int col = ftid(); float a[8], b[8];
#pragma unroll
            for (int r = 0; r < 8; ++r) { a[r] = 0.f; b[r] = 0.f; }
            for (int k = 0; k < DM; ++k) { const float wa = w1[(size_t)k * FF + col], wb = w3[(size_t)k * FF + col];
#pragma unroll
                for (int r = 0; r < 8; ++r) { const float hv = sh[r * DM + k]; a[r] += hv * wa; b[r] += hv * wb; } }
#pragma unroll
            for (int r = 0; r < 8; ++r) sa[r * FF + col] = (a[r] / (1.0f + expf(-a[r]))) * b[r]; }
        __syncthreads();
        for (int col = ftid(); col < DM; col += 512) { float y[8];
#pragma unroll
            for (int r = 0; r < 8; ++r) y[r] = 0.f;
            for (int k = 0; k < FF; ++k) { const float wv = w2[(size_t)k * DM + col];
#pragma unroll
                for (int r = 0; r < 8; ++r) y[r] += sa[r * FF + k] * wv; }
#pragma unroll
            for (int r = 0; r < 8; ++r) { const int tk = stok[r]; if (tk >= 0) { const unsigned e0 = ((const unsigned*)(F.ws + WS_TOKINFO))[(size_t)tk * 8]; const int kk = (e0 == (unsigned)e) ? 0 : 1;
                YN[((size_t)tk * 2 + kk) * DM + col] = y[r]; } } }
    }
    __syncthreads();
}

constexpr int TLD = 136;
constexpr int TILE_BYTES = 128 * TLD * 2;
template <int NT, int KS>
__device__ __forceinline__ void wave_mma(f32x4 (&acc)[NT], const bf16x8 (&afr)[KS], const LAS bf16_t* Bt, int ldb, int lane) {
    const LAS bf16_t* bp = Bt + (lane & 15) * ldb + 8 * (lane >> 4);
#pragma unroll
    for (int nt = 0; nt < NT; ++nt)
#pragma unroll
        for (int ks = 0; ks < KS; ++ks) { const bf16x8 b = *(const LAS bf16x8*)(bp + nt * 16 * ldb + 32 * ks); acc[nt] = __builtin_amdgcn_mfma_f32_16x16x32_bf16(afr[ks], b, acc[nt], 0, 0, 0);
            if ((ks & 3) == 3 && (nt & 1) == 1) asm volatile("" ::: "memory"); }
}
__device__ __forceinline__ void stage_rowmajor(LAS bf16_t* T, const bf16_t* src, size_t ld, int tid) {
#pragma unroll
    for (int i = 0; i < 4; ++i) { const int q = tid + 512 * i, r = q >> 4, cc = q & 15; const u32x4 v = *(const u32x4*)(src + (size_t)r * ld + 8 * cc); *(LAS u32x4*)(T + r * TLD + 8 * cc) = v; }
}
__device__ __forceinline__ void stage_transposed(LAS bf16_t* T, const bf16_t* src, size_t ld, int tid, bool scaled, float sa, float sb) {
#pragma unroll
    for (int i = 0; i < 4; ++i) { const int q = tid + 512 * i, r = q >> 4, cc = q & 15; const u32x4 v = *(const u32x4*)(src + (size_t)r * ld + 8 * cc);
        const unsigned w[4] = {v.x, v.y, v.z, v.w};
        if (scaled) { const float sc = exp2f(sa * (float)r + sb);
#pragma unroll
            for (int k = 0; k < 4; ++k) { T[(8 * cc + 2 * k) * TLD + r] = (bf16_t)f2bf(bflo(w[k]) * sc); T[(8 * cc + 2 * k + 1) * TLD + r] = (bf16_t)f2bf(bfhi(w[k]) * sc); }
        } else {
#pragma unroll
            for (int k = 0; k < 4; ++k) { T[(8 * cc + 2 * k) * TLD + r] = (bf16_t)(w[k] & 0xffffu); T[(8 * cc + 2 * k + 1) * TLD + r] = (bf16_t)(w[k] >> 16); }
        }
    }
}
__device__ __forceinline__ void stage_f32_rowmajor(LAS bf16_t* T, const float* src, int tid) {
#pragma unroll
    for (int i = 0; i < 8; ++i) { const int q = tid + 512 * i, r = q >> 5, cc = q & 31; const f32x4 v = *(const f32x4*)(src + (size_t)r * 128 + 4 * cc);
        u32x2 o; o.x = pk2(v.x, v.y); o.y = pk2(v.z, v.w); *(LAS u32x2*)(T + r * TLD + 4 * cc) = o; }
}
__device__ __forceinline__ float log2_gamma_f(const Frame& F, int p, int dir, int h) { return -expf(((const float*)(F.ws + WS_SP) + SP_DECAY)[(p * 2 + dir) * 4 + h]) * 1.4426950408889634f; }
#define log2_gamma(args, p, dir, h) log2_gamma_f(F, p, dir, h)

__device__ __forceinline__ void ret_state_item(Frame& F, const Args& args, int p, int item) {
    const int c = item % NCHUNK, h = (item / NCHUNK) & 3, b = item / (NCHUNK * 4);
    int tid = ftid(); asm volatile("" : "+v"(tid)); const int lane = tid & 63, w = F.wave;
    LAS bf16_t* T0 = (LAS bf16_t*)F.lds; LAS bf16_t* T1 = (LAS bf16_t*)(F.lds + TILE_BYTES); LAS bf16_t* T2 = (LAS bf16_t*)(F.lds + 2 * TILE_BYTES);
    const bf16_t* pe = (const bf16_t*)(F.ws + WS_PE) + ((size_t)b * SU + 128 * c) * EV_N;
    const float lgf = log2_gamma(args, p, 0, h), lgb = log2_gamma(args, p, 1, h);
    __syncthreads();
    stage_transposed(T0, pe + 512 + h * 128, EV_N, tid, false, 0.f, 0.f);
    stage_transposed(T1, pe + 1024 + h * 128, EV_N, tid, true, -lgf, 127.f * lgf);
    stage_transposed(T2, pe + 1024 + h * 128, EV_N, tid, true, lgb, 0.f);
    __syncthreads();
    float* st = (float*)(F.ws + WS_ST);
#pragma unroll
    for (int dir = 0; dir < 2; ++dir) {
        const LAS bf16_t* VT = dir ? T2 : T1;
        bf16x8 afr[4];
#pragma unroll
        for (int ks = 0; ks < 4; ++ks) afr[ks] = *(const LAS bf16x8*)(VT + (16 * w + (lane & 15)) * TLD + 32 * ks + 8 * (lane >> 4));
        f32x4 acc[8];
#pragma unroll
        for (int nt = 0; nt < 8; ++nt) acc[nt] = (f32x4){0.f, 0.f, 0.f, 0.f};
        wave_mma<8, 4>(acc, afr, T0, TLD, lane);
        float* dst = st + ((((size_t)(b * 4 + h) * 2 + dir) * NCHUNK + c) * 128) * 128;
#pragma unroll
        for (int nt = 0; nt < 8; ++nt)
#pragma unroll
            for (int j = 0; j < 4; ++j) dst[(size_t)(16 * w + 4 * (lane >> 4) + j) * 128 + 16 * nt + (lane & 15)] = acc[nt][j];
    }
}
__device__ __forceinline__ void ret_scan_phase(Frame& F, const Args& args, int p) {
    f32x4* st = (f32x4*)(F.ws + WS_ST);
    for (int i = fbid() * 512 + ftid(); i < 32 * 4096; i += F.G * 512) {
        const int bhd = i >> 12, el = i & 4095; const int dir = bhd & 1, h = (bhd >> 1) & 3;
        const float g128 = exp2f(128.f * log2_gamma(args, p, dir, h));
        f32x4* base = st + (size_t)bhd * NCHUNK * 4096 + el;
        f32x4 s = (f32x4){0.f, 0.f, 0.f, 0.f};
        for (int k = 0; k < NCHUNK; ++k) {
            const int c = dir == 0 ? k : (k < 2 ? 1 - k : NCHUNK + 1 - k);
            const f32x4 u = base[(size_t)c * 4096]; base[(size_t)c * 4096] = s; s = s * g128 + u;
        }
    }
}
__device__ __forceinline__ bf16x8 scale_frag(const bf16x8 a, float sc) {
    bf16x8 r;
#pragma unroll
    for (int k = 0; k < 8; ++k) r[k] = (short)f2bf(bf2f((unsigned)(unsigned short)a[k]) * sc);
    return r;
}
__device__ __forceinline__ void ret_out_item(Frame& F, const Args& args, int p, int item) {
    const int c = item % NCHUNK, h = (item / NCHUNK) & 3, b = item / (NCHUNK * 4);
    int tid = ftid(); asm volatile("" : "+v"(tid)); const int lane = tid & 63, w = F.wave, quad = lane >> 4, l15 = lane & 15;
    LAS bf16_t* T0 = (LAS bf16_t*)F.lds; LAS bf16_t* T1 = (LAS bf16_t*)(F.lds + TILE_BYTES); LAS bf16_t* T2 = (LAS bf16_t*)(F.lds + 2 * TILE_BYTES);
    const size_t row0 = (size_t)b * SU + 128 * c;
    const bf16_t* pe = (const bf16_t*)(F.ws + WS_PE) + row0 * EV_N;
    const float lgf = log2_gamma(args, p, 0, h), lgb = log2_gamma(args, p, 1, h);
    const float* stf = (const float*)(F.ws + WS_ST) + ((((size_t)(b * 4 + h) * 2 + 0) * NCHUNK + c) * 128) * 128;
    const float* stb = (const float*)(F.ws + WS_ST) + ((((size_t)(b * 4 + h) * 2 + 1) * NCHUNK + c) * 128) * 128;
    bf16x8 qf[4];
#pragma unroll
    for (int ks = 0; ks < 4; ++ks) qf[ks] = *(const bf16x8*)(pe + (size_t)(16 * w + l15) * EV_N + h * 128 + 32 * ks + 8 * quad);
    __syncthreads();
    stage_rowmajor(T0, pe + 512 + h * 128, EV_N, tid);
    stage_transposed(T1, pe + 1024 + h * 128, EV_N, tid, false, 0.f, 0.f);
    stage_f32_rowmajor(T2, stf, tid);
    __syncthreads();
    f32x4 ao[8];
#pragma unroll
    for (int nt = 0; nt < 8; ++nt) ao[nt] = (f32x4){0.f, 0.f, 0.f, 0.f};
    {
        const float cf = exp2f(lgf * (float)(16 * w + l15 + 1));
        bf16x8 qs[4];
#pragma unroll
        for (int ks = 0; ks < 4; ++ks) qs[ks] = scale_frag(qf[ks], cf);
        wave_mma<8, 4>(ao, qs, T2, TLD, lane);
    }
    {
        f32x4 aw[8];
#pragma unroll
        for (int nt = 0; nt < 8; ++nt) aw[nt] = (f32x4){0.f, 0.f, 0.f, 0.f};
        wave_mma<8, 4>(aw, qf, T0, TLD, lane);
        __syncthreads();
#pragma unroll
        for (int nt = 0; nt < 8; ++nt)
#pragma unroll
            for (int j = 0; j < 4; ++j) { const int i = 16 * w + 4 * quad + j, jj = 16 * nt + l15; const int d = i - jj;
                const float dec = d > 0 ? exp2f(lgf * (float)d) : (d < 0 ? exp2f(lgb * (float)(-d)) : 2.0f);
                T0[i * TLD + jj] = (bf16_t)f2bf(aw[nt][j] * dec); }
    }
    stage_f32_rowmajor(T2, stb, tid);
    __syncthreads();
    {
        bf16x8 pf[4];
#pragma unroll
        for (int ks = 0; ks < 4; ++ks) pf[ks] = *(const LAS bf16x8*)(T0 + (16 * w + l15) * TLD + 32 * ks + 8 * quad);
        wave_mma<8, 4>(ao, pf, T1, TLD, lane);
        const float cb = exp2f(lgb * (float)(128 - (16 * w + l15)));
#pragma unroll
        for (int ks = 0; ks < 4; ++ks) pf[ks] = scale_frag(qf[ks], cb);
        wave_mma<8, 4>(ao, pf, T2, TLD, lane);
    }
    bf16_t* yb = (bf16_t*)(F.ws + WS_YB16);
#pragma unroll
    for (int j = 0; j < 4; ++j) { const int i = 16 * w + 4 * quad + j;
        float ss = 0.f;
#pragma unroll
        for (int nt = 0; nt < 8; ++nt) ss += ao[nt][j] * ao[nt][j];
        ss += shx(ss, 1, lane); ss += shx(ss, 2, lane); ss += shx(ss, 4, lane); ss += shx(ss, 8, lane);
        const float rstd = 1.0f / sqrtf(ss * (1.0f / 128.f) + EPS);
        const bf16_t* gp = pe + (size_t)i * EV_N + 1536 + h * 128;
#pragma unroll
        for (int nt = 0; nt < 8; ++nt) { const float gt = bf2f(gp[16 * nt + l15]); yb[(row0 + i) * DM + h * 128 + 16 * nt + l15] = ABL_RET0 ? (bf16_t)0 : (bf16_t)f2bf(siluf(gt) * ao[nt][j] * rstd); }
    }
}
__device__ __forceinline__ void ret_direct_item(Frame& F, const Args& args, int p, int item) {
    const int c = item % NCHUNK, h = (item / NCHUNK) & 3, b = item / (NCHUNK * 4);
    int tid = ftid(); asm volatile("" : "+v"(tid)); const int lane = tid & 63, w = F.wave, quad = lane >> 4, l15 = lane & 15;
    LAS bf16_t* T0 = (LAS bf16_t*)F.lds; LAS bf16_t* T1 = (LAS bf16_t*)(F.lds + TILE_BYTES); LAS bf16_t* T2 = (LAS bf16_t*)(F.lds + 2 * TILE_BYTES);
    const size_t row0 = (size_t)b * SU + 128 * c;
    const bf16_t* peb = (const bf16_t*)(F.ws + WS_PE) + (size_t)b * SU * EV_N;
    const bf16_t* pe = peb + (size_t)128 * c * EV_N;
    const float lgf = log2_gamma(args, p, 0, h), lgb = log2_gamma(args, p, 1, h);
    bf16x8 qf[4];
#pragma unroll
    for (int ks = 0; ks < 4; ++ks) qf[ks] = *(const bf16x8*)(pe + (size_t)(16 * w + l15) * EV_N + h * 128 + 32 * ks + 8 * quad);
    f32x4 ao[8];
#pragma unroll
    for (int nt = 0; nt < 8; ++nt) ao[nt] = (f32x4){0.f, 0.f, 0.f, 0.f};
    for (int c2 = 0; c2 < NCHUNK; ++c2) {
        __syncthreads();
        stage_rowmajor(T0, peb + (size_t)128 * c2 * EV_N + 512 + h * 128, EV_N, tid);
        stage_transposed(T1, peb + (size_t)128 * c2 * EV_N + 1024 + h * 128, EV_N, tid, false, 0.f, 0.f);
        __syncthreads();
        f32x4 aw[8];
#pragma unroll
        for (int nt = 0; nt < 8; ++nt) aw[nt] = (f32x4){0.f, 0.f, 0.f, 0.f};
        wave_mma<8, 4>(aw, qf, T0, TLD, lane);
#pragma unroll
        for (int nt = 0; nt < 8; ++nt)
#pragma unroll
            for (int j = 0; j < 4; ++j) { const int i = 16 * w + 4 * quad + j, jj = 16 * nt + l15;
                const int px = 128 * c + i, py = 128 * c2 + jj;
                const int ubx = px < NCTX ? NCTX - 1 - px : SU + NCTX - 1 - px, uby = py < NCTX ? NCTX - 1 - py : SU + NCTX - 1 - py;
                float dec = 0.f;
                if (py <= px && !(px >= NCTX && false)) dec += exp2f(lgf * (float)(px - py));
                if (uby <= ubx) dec += exp2f(lgb * (float)(ubx - uby));
                if (px < NCTX && py >= NCTX) dec = 0.f;
                T2[i * TLD + jj] = (bf16_t)f2bf(aw[nt][j] * dec); }
        LDS_WAIT(); asm volatile("" ::: "memory");
        bf16x8 pf[4];
#pragma unroll
        for (int ks = 0; ks < 4; ++ks) pf[ks] = *(const LAS bf16x8*)(T2 + (16 * w + l15) * TLD + 32 * ks + 8 * quad);
        wave_mma<8, 4>(ao, pf, T1, TLD, lane);
    }
    bf16_t* yb = (bf16_t*)(F.ws + WS_YB16);
#pragma unroll
    for (int j = 0; j < 4; ++j) { const int i = 16 * w + 4 * quad + j;
        float ss = 0.f;
#pragma unroll
        for (int nt = 0; nt < 8; ++nt) ss += ao[nt][j] * ao[nt][j];
        ss += shx(ss, 1, lane); ss += shx(ss, 2, lane); ss += shx(ss, 4, lane); ss += shx(ss, 8, lane);
        const float rstd = 1.0f / sqrtf(ss * (1.0f / 128.f) + EPS);
        const bf16_t* gp = pe + (size_t)i * EV_N + 1536 + h * 128;
#pragma unroll
        for (int nt = 0; nt < 8; ++nt) { const float gt = bf2f(gp[16 * nt + l15]); yb[(row0 + i) * DM + h * 128 + 16 * nt + l15] = (bf16_t)f2bf(siluf(gt) * ao[nt][j] * rstd); }
    }
}
__device__ __forceinline__ void att_item(Frame& F, const Args& args, int p, int item) {
    const int qb = item % NCHUNK, hk = (item / NCHUNK) & 1, b = item / (NCHUNK * 2);
    int tid = ftid(); asm volatile("" : "+v"(tid)); const int lane = tid & 63, w = F.wave, quad = lane >> 4, l15 = lane & 15;
    const int g = w >> 2, hq = 2 * hk + g, qr0 = 32 * (w & 3);
    LAS bf16_t* T0 = (LAS bf16_t*)F.lds; LAS bf16_t* T1 = (LAS bf16_t*)(F.lds + TILE_BYTES);
    LAS bf16_t* Pw = (LAS bf16_t*)(F.lds + 2 * TILE_BYTES) + w * 32 * TLD;
    const bf16_t* peb = (const bf16_t*)(F.ws + WS_PE) + (size_t)b * SU * EV_N;
    const size_t qrow0 = (size_t)128 * qb + qr0;
    bf16x8 qf[2][4];
#pragma unroll
    for (int rt = 0; rt < 2; ++rt)
#pragma unroll
        for (int ks = 0; ks < 4; ++ks) qf[rt][ks] = *(const bf16x8*)(peb + (qrow0 + 16 * rt + l15) * EV_N + 2048 + hq * 128 + 32 * ks + 8 * quad);
    const float sink = ((const float*)(F.ws + WS_SP) + SP_SINK)[p * 4 + hq];
    const float scale = 0.08838834764831845f;
    float mrow[2][4], lrow[2][4]; f32x4 ao[2][8];
#pragma unroll
    for (int rt = 0; rt < 2; ++rt) {
#pragma unroll
        for (int j = 0; j < 4; ++j) { mrow[rt][j] = sink; lrow[rt][j] = 1.0f; }
#pragma unroll
        for (int nt = 0; nt < 8; ++nt) ao[rt][nt] = (f32x4){0.f, 0.f, 0.f, 0.f};
    }
    const int ntile = (qb < 2) ? 2 : 5;
    for (int ti = 0; ti < ntile; ++ti) {
        int kt, mode = 0;
        if (ti < 2) kt = ti; else { kt = qb + (ti - 3); mode = (ti == 2) ? 1 : (ti == 4 ? 2 : 0); }
        if (ti >= 2 && (kt < 2 || kt >= NCHUNK)) continue;
        __syncthreads();
        stage_rowmajor(T0, peb + (size_t)128 * kt * EV_N + 2560 + hk * 128, EV_N, tid);
        stage_transposed(T1, peb + (size_t)128 * kt * EV_N + 2816 + hk * 128, EV_N, tid, false, 0.f, 0.f);
        __syncthreads();
#pragma unroll
        for (int rt = 0; rt < 2; ++rt) {
            f32x4 s[8];
#pragma unroll
            for (int nt = 0; nt < 8; ++nt) s[nt] = (f32x4){0.f, 0.f, 0.f, 0.f};
            wave_mma<8, 4>(s, qf[rt], T0, TLD, lane);
#pragma unroll
            for (int j = 0; j < 4; ++j) {
                const int qq = qr0 + 16 * rt + 4 * quad + j;
                float mx = -3.0e38f;
#pragma unroll
                for (int nt = 0; nt < 8; ++nt) { const int kk = 16 * nt + l15; float v = s[nt][j] * scale;
                    const bool valid = (mode == 0) || (mode == 1 ? (kk >= qq) : (kk <= qq));
                    v = valid ? v : -3.0e38f; s[nt][j] = v; mx = fmaxf(mx, v); }
                mx = fmaxf(mx, shx(mx, 1, lane)); mx = fmaxf(mx, shx(mx, 2, lane)); mx = fmaxf(mx, shx(mx, 4, lane)); mx = fmaxf(mx, shx(mx, 8, lane));
                const float mn = fmaxf(mrow[rt][j], mx); const float alpha = __expf(mrow[rt][j] - mn);
                float rs = 0.f;
#pragma unroll
                for (int nt = 0; nt < 8; ++nt) { const float pv = (s[nt][j] > -1.0e38f) ? __expf(s[nt][j] - mn) : 0.f; rs += pv; Pw[(16 * rt + 4 * quad + j) * TLD + 16 * nt + l15] = (bf16_t)f2bf(pv); }
                rs += shx(rs, 1, lane); rs += shx(rs, 2, lane); rs += shx(rs, 4, lane); rs += shx(rs, 8, lane);
                lrow[rt][j] = lrow[rt][j] * alpha + rs; mrow[rt][j] = mn;
#pragma unroll
                for (int nt = 0; nt < 8; ++nt) ao[rt][nt][j] *= alpha;
            }
        }
        LDS_WAIT(); asm volatile("" ::: "memory");
#pragma unroll
        for (int rt = 0; rt < 2; ++rt) {
            bf16x8 pf[4];
#pragma unroll
            for (int ks = 0; ks < 4; ++ks) pf[ks] = *(const LAS bf16x8*)(Pw + (16 * rt + l15) * TLD + 32 * ks + 8 * quad);
            wave_mma<8, 4>(ao[rt], pf, T1, TLD, lane);
        }
    }
    bf16_t* yb = (bf16_t*)(F.ws + WS_YB16) + ((size_t)b * SU + qrow0) * DM + 512 + hq * 128;
#pragma unroll
    for (int rt = 0; rt < 2; ++rt)
#pragma unroll
        for (int j = 0; j < 4; ++j) { const float inv = 1.0f / lrow[rt][j];
#pragma unroll
            for (int nt = 0; nt < 8; ++nt) yb[(size_t)(16 * rt + 4 * quad + j) * DM + 16 * nt + l15] = ABL_ATT0 ? (bf16_t)0 : (bf16_t)f2bf(ao[rt][nt][j] * inv); }
}
__device__ __forceinline__ void naive_att(Frame& F, const Args& args, int p) {
    const int gw = F.vcu * NWAVES + F.wave, NGW = F.G * NWAVES, lane = flane();
    LAS float* sq = (LAS float*)F.lds + F.wave * 1024;
    LAS float* sc = sq + 128;
    const bf16_t* pe = (const bf16_t*)(F.ws + WS_PE);
    for (int task = gw; task < MTOK * 4; task += NGW) {
        const int row = task >> 2, hq = task & 3, hk = hq >> 1; const int b = row / SU, pq = row % SU;
        const bf16_t* peb = pe + (size_t)b * SU * EV_N;
        sq[lane] = bf2f(peb[(size_t)pq * EV_N + 2048 + hq * 128 + lane]) * 0.08838834764831845f; sq[lane + 64] = bf2f(peb[(size_t)pq * EV_N + 2048 + hq * 128 + lane + 64]) * 0.08838834764831845f;
        LDS_WAIT(); asm volatile("" ::: "memory");
        int lo = 0, nloc = 0;
        if (pq >= NCTX) { const int t = pq - NCTX; lo = t - 128 < 0 ? 0 : t - 128; const int hi = t + 128 > LSEQ - 1 ? LSEQ - 1 : t + 128; nloc = hi - lo + 1; }
        const int nk = NCTX + nloc;
        const float sink = args.in[I_SINK][p * 4 + hq];
        float mx = sink;
        for (int ki = lane; ki < nk; ki += 64) { const int kp = ki < NCTX ? ki : NCTX + lo + (ki - NCTX);
            const bf16_t* kr = peb + (size_t)kp * EV_N + 2560 + hk * 128; float d = 0.f;
            for (int x = 0; x < 128; ++x) d += sq[x] * bf2f(kr[x]);
            sc[ki] = d; mx = fmaxf(mx, d); }
#pragma unroll
        for (int o = 1; o < 64; o <<= 1) mx = fmaxf(mx, shx(mx, o, lane));
        float sum = 0.f;
        for (int ki = lane; ki < nk; ki += 64) { const float e = expf(sc[ki] - mx); sc[ki] = e; sum += e; }
        sum = wave_sum(sum, lane) + expf(sink - mx);
        LDS_WAIT(); asm volatile("" ::: "memory");
        float o0 = 0.f, o1 = 0.f;
        for (int ki = 0; ki < nk; ++ki) { const int kp = ki < NCTX ? ki : NCTX + lo + (ki - NCTX); const bf16_t* vr = peb + (size_t)kp * EV_N + 2816 + hk * 128; const float pv = sc[ki];
            o0 += pv * bf2f(vr[lane]); o1 += pv * bf2f(vr[lane + 64]); }
        bf16_t* yb = (bf16_t*)(F.ws + WS_YB16) + (size_t)row * DM + 512 + hq * 128;
        yb[lane] = (bf16_t)f2bf(o0 / sum); yb[lane + 64] = (bf16_t)f2bf(o1 / sum);
        LDS_WAIT(); asm volatile("" ::: "memory");
    }
}
__device__ __forceinline__ void hg_scan_item_plain(Frame& F, int item) {
    const int es = item & 3, dir = (item >> 2) & 1, h = (item >> 3) & 7, b = item >> 6;
    const int tid = ftid(), e = tid & 31, dg = tid >> 5;
    LAS float* sP = (LAS float*)F.lds;
    LAS float* sIn = sP + 32 * 16 * 32;
    constexpr int INB = 32 * 128 * 2 + 32 * 32;
    const float* fsrc = (const float*)(F.ws + (dir ? WS_FB : WS_FF));
    const bf16_t* qsrc = (const bf16_t*)(F.ws + WS_PQ); const bf16_t* vsrc = (const bf16_t*)(F.ws + WS_PI);
    float* osrc = (float*)(F.ws + (dir ? WS_OB : WS_OF));
    float S[8];
#pragma unroll
    for (int k = 0; k < 8; ++k) S[k] = 0.f;
    const size_t rb = (size_t)b * SU;
    f32x4 rf0, rf1; u32x4 rq, rv;
    auto pos_of = [&](int s) { return dir ? (s < NCTX ? NCTX - 1 - s : SU + NCTX - 1 - s) : s; };
#define HG_ISSUE(s0_) do { const int pA = pos_of((s0_) + (tid >> 5)), pB = pos_of((s0_) + 16 + (tid >> 5)), pQ = pos_of((s0_) + (tid >> 4)); \
        rf0 = *(const f32x4*)(fsrc + (rb + pA) * DM + h * 128 + 4 * (tid & 31)); rf1 = *(const f32x4*)(fsrc + (rb + pB) * DM + h * 128 + 4 * (tid & 31)); \
        rq = *(const u32x4*)(qsrc + (rb + pQ) * DM + h * 128 + 8 * (tid & 15)); \
        if (tid < 128) { const int pV = pos_of((s0_) + (tid >> 2)); rv = *(const u32x4*)(vsrc + (rb + pV) * DM + h * 128 + 32 * es + 8 * (tid & 3)); } } while (0)
#define HG_WRITE(buf_) do { LAS float* bF = sIn + (buf_) * INB; LAS float* bQ = bF + 32 * 128; LAS float* bV = bQ + 32 * 128; \
        *(LAS f32x4*)(bF + (tid >> 5) * 128 + 4 * (tid & 31)) = rf0; *(LAS f32x4*)(bF + (16 + (tid >> 5)) * 128 + 4 * (tid & 31)) = rf1; \
        { LAS float* d = bQ + (tid >> 4) * 128 + 8 * (tid & 15); *(LAS f32x4*)d = (f32x4){bflo(rq.x), bfhi(rq.x), bflo(rq.y), bfhi(rq.y)}; *(LAS f32x4*)(d + 4) = (f32x4){bflo(rq.z), bfhi(rq.z), bflo(rq.w), bfhi(rq.w)}; } \
        if (tid < 128) { LAS float* d = bV + (tid >> 2) * 32 + 8 * (tid & 3); *(LAS f32x4*)d = (f32x4){bflo(rv.x), bfhi(rv.x), bflo(rv.y), bfhi(rv.y)}; *(LAS f32x4*)(d + 4) = (f32x4){bflo(rv.z), bfhi(rv.z), bflo(rv.w), bfhi(rv.w)}; } } while (0)
    __syncthreads();
    HG_ISSUE(0); HG_WRITE(0);
    __syncthreads();
    constexpr int NTB = SU / 32;
    for (int tb = 0; tb < NTB; ++tb) {
        const int s0 = 32 * tb, cur = tb & 1;
        if (tb + 1 < NTB) HG_ISSUE(s0 + 32);
        const LAS float* sF = sIn + cur * INB; const LAS float* sQ = sF + 32 * 128; const LAS float* sV = sQ + 32 * 128;
#pragma unroll 4
        for (int tt = 0; tt < 32; ++tt) {
            const f32x4 f0 = *(const LAS f32x4*)(sF + tt * 128 + 8 * dg), f1 = *(const LAS f32x4*)(sF + tt * 128 + 8 * dg + 4);
            const f32x4 q0 = *(const LAS f32x4*)(sQ + tt * 128 + 8 * dg), q1 = *(const LAS f32x4*)(sQ + tt * 128 + 8 * dg + 4);
            const float v = sV[tt * 32 + e];
            const float ff[8] = {f0.x, f0.y, f0.z, f0.w, f1.x, f1.y, f1.z, f1.w}; const float qq[8] = {q0.x, q0.y, q0.z, q0.w, q1.x, q1.y, q1.z, q1.w};
            float part = 0.f;
#pragma unroll
            for (int k = 0; k < 8; ++k) { S[k] = ff[k] * S[k] + (1.0f - ff[k]) * v; part += qq[k] * S[k]; }
            sP[(tt * 16 + dg) * 32 + e] = part;
        }
        __syncthreads();
#pragma unroll
        for (int i = 0; i < 2; ++i) { const int q = tid + 512 * i, tt = q >> 5, ee = q & 31; float o = 0.f;
#pragma unroll
            for (int k = 0; k < 16; ++k) o += sP[(tt * 16 + k) * 32 + ee];
            osrc[(rb + pos_of(s0 + tt)) * DM + h * 128 + 32 * es + ee] = o; }
        if (tb + 1 < NTB) HG_WRITE(cur ^ 1);
        __syncthreads();
    }
#undef HG_ISSUE
#undef HG_WRITE
}
__device__ __forceinline__ void hg_scan_item_c16(Frame& F, int item) {
    const int es = item & 3, dir = (item >> 2) & 1, h = (item >> 3) & 7, b = item >> 6;
    const int tid = ftid(), lane = tid & 63, w = F.wave, quad = lane >> 4, l15 = lane & 15;
    constexpr int INB = 32 * 128 * 2 + 32 * 32;
    LAS float* sIn = (LAS float*)F.lds;
    LAS bf16_t* QA = (LAS bf16_t*)(sIn + 2 * INB);
    LAS bf16_t* KB = QA + 2 * 16 * 136;
    LAS bf16_t* KC = KB + 2 * 16 * 136;
    LAS bf16_t* VT = KC + 2 * 128 * 40;
    LAS bf16_t* PP = VT + 2 * 32 * 40;
    LAS bf16_t* ST = PP + 2 * 16 * 40;
    LAS float* DEC = (LAS float*)(ST + 32 * 136);
    const float* fsrc = (const float*)(F.ws + (dir ? WS_FB : WS_FF));
    const bf16_t* qsrc = (const bf16_t*)(F.ws + WS_PQ); const bf16_t* vsrc = (const bf16_t*)(F.ws + WS_PI);
    float* osrc = (float*)(F.ws + (dir ? WS_OB : WS_OF));
    const size_t rb = (size_t)b * SU;
    f32x4 S[2] = {(f32x4){0.f, 0.f, 0.f, 0.f}, (f32x4){0.f, 0.f, 0.f, 0.f}};
    f32x4 rf0, rf1; u32x4 rq, rv;
    auto pos_of = [&](int s) { return dir ? (s < NCTX ? NCTX - 1 - s : SU + NCTX - 1 - s) : s; };
#define HG_ISSUE(s0_) do { const int pA = pos_of((s0_) + (tid >> 5)), pB = pos_of((s0_) + 16 + (tid >> 5)), pQ = pos_of((s0_) + (tid >> 4)); \
        rf0 = *(const f32x4*)(fsrc + (rb + pA) * DM + h * 128 + 4 * (tid & 31)); rf1 = *(const f32x4*)(fsrc + (rb + pB) * DM + h * 128 + 4 * (tid & 31)); \
        rq = *(const u32x4*)(qsrc + (rb + pQ) * DM + h * 128 + 8 * (tid & 15)); \
        if (tid < 128) { const int pV = pos_of((s0_) + (tid >> 2)); rv = *(const u32x4*)(vsrc + (rb + pV) * DM + h * 128 + 32 * es + 8 * (tid & 3)); } } while (0)
#define HG_WRITE(buf_) do { LAS float* bF = sIn + (buf_) * INB; LAS float* bQ = bF + 32 * 128; LAS float* bV = bQ + 32 * 128; \
        *(LAS f32x4*)(bF + (tid >> 5) * 128 + 4 * (tid & 31)) = rf0; *(LAS f32x4*)(bF + (16 + (tid >> 5)) * 128 + 4 * (tid & 31)) = rf1; \
        { LAS float* d = bQ + (tid >> 4) * 128 + 8 * (tid & 15); *(LAS f32x4*)d = (f32x4){bflo(rq.x), bfhi(rq.x), bflo(rq.y), bfhi(rq.y)}; *(LAS f32x4*)(d + 4) = (f32x4){bflo(rq.z), bfhi(rq.z), bflo(rq.w), bfhi(rq.w)}; } \
        if (tid < 128) { LAS float* d = bV + (tid >> 2) * 32 + 8 * (tid & 3); *(LAS f32x4*)d = (f32x4){bflo(rv.x), bfhi(rv.x), bflo(rv.y), bfhi(rv.y)}; *(LAS f32x4*)(d + 4) = (f32x4){bflo(rv.z), bfhi(rv.z), bflo(rv.w), bfhi(rv.w)}; } } while (0)
    __syncthreads();
    for (int i = tid; i < 2 * 128 * 40; i += 512) KC[i] = 0;
    for (int i = tid; i < 2 * 32 * 40; i += 512) VT[i] = 0;
    for (int i = tid; i < 2 * 16 * 40; i += 512) PP[i] = 0;
    for (int i = tid; i < 32 * 136; i += 512) ST[i] = 0;
    HG_ISSUE(0); HG_WRITE(0);
    __syncthreads();
    constexpr int NTB = SU / 32;
#define HG_BAR() do { asm volatile("s_waitcnt lgkmcnt(0)" ::: "memory"); __builtin_amdgcn_s_barrier(); asm volatile("" ::: "memory"); } while (0)
    for (int tb = 0; tb < NTB; ++tb) {
        const int s0 = 32 * tb, cur = tb & 1;
        if (tb + 1 < NTB) HG_ISSUE(s0 + 32);
        const LAS float* sF = sIn + cur * INB; const LAS float* sQ = sF + 32 * 128; const LAS float* sV = sQ + 32 * 128;
        if (tid < 256) {
            const int c = tid >> 7, d = tid & 127;
            float a = 0.f, kbv[16], fv[16], qv[16];
#pragma unroll
            for (int i = 0; i < 16; ++i) { fv[i] = sF[(16 * c + i) * 128 + d]; qv[i] = sQ[(16 * c + i) * 128 + d]; }
#pragma unroll
            for (int i = 0; i < 16; ++i) { const float f = fv[i], q = qv[i];
                a += __builtin_amdgcn_logf(f); const float ea = __builtin_amdgcn_exp2f(a);
                QA[(c * 16 + i) * 136 + d] = (bf16_t)f2bf(q * ea); kbv[i] = (1.0f - f) * __builtin_amdgcn_exp2f(-a); }
            const float al = __builtin_amdgcn_exp2f(a); DEC[c * 128 + d] = al;
            unsigned pk[8];
#pragma unroll
            for (int j = 0; j < 16; ++j) { KB[(c * 16 + j) * 136 + d] = (bf16_t)f2bf(kbv[j]); }
#pragma unroll
            for (int j = 0; j < 8; ++j) pk[j] = pk2(kbv[2 * j] * al, kbv[2 * j + 1] * al);
            LAS u32x4* kd = (LAS u32x4*)(KC + (c * 128 + d) * 40); kd[0] = (u32x4){pk[0], pk[1], pk[2], pk[3]}; kd[1] = (u32x4){pk[4], pk[5], pk[6], pk[7]};
        } else {
            const int idx = tid - 256, c = idx >> 7, e = (idx >> 2) & 31, jq = idx & 3;
            const float v0 = sV[(16 * c + 4 * jq + 0) * 32 + e], v1 = sV[(16 * c + 4 * jq + 1) * 32 + e], v2 = sV[(16 * c + 4 * jq + 2) * 32 + e], v3 = sV[(16 * c + 4 * jq + 3) * 32 + e];
            u32x2 o; o.x = pk2(v0, v1); o.y = pk2(v2, v3); *(LAS u32x2*)(VT + (c * 32 + e) * 40 + 4 * jq) = o;
        }
        HG_BAR();
        bf16x8 qa[4]; f32x4 oi[2] = {(f32x4){0.f, 0.f, 0.f, 0.f}, (f32x4){0.f, 0.f, 0.f, 0.f}};
        bf16x8 sb0[2][4];
        if (w < 2) {
            const int c = w;
            bf16x8 kbf[4], vbf[2];
#pragma unroll
            for (int ks = 0; ks < 4; ++ks) { qa[ks] = *(const LAS bf16x8*)(QA + (c * 16 + l15) * 136 + 32 * ks + 8 * quad); kbf[ks] = *(const LAS bf16x8*)(KB + (c * 16 + l15) * 136 + 32 * ks + 8 * quad); }
#pragma unroll
            for (int nt = 0; nt < 2; ++nt) vbf[nt] = *(const LAS bf16x8*)(VT + (c * 32 + 16 * nt + l15) * 40 + 8 * quad);
            if (c == 0) {
#pragma unroll
                for (int nt = 0; nt < 2; ++nt)
#pragma unroll
                    for (int ks = 0; ks < 4; ++ks) sb0[nt][ks] = *(const LAS bf16x8*)(ST + (16 * nt + l15) * 136 + 32 * ks + 8 * quad);
            }
            f32x4 sc = (f32x4){0.f, 0.f, 0.f, 0.f};
#pragma unroll
            for (int ks = 0; ks < 4; ++ks) sc = __builtin_amdgcn_mfma_f32_16x16x32_bf16(qa[ks], kbf[ks], sc, 0, 0, 0);
#pragma unroll
            for (int jj = 0; jj < 4; ++jj) { const int i = 4 * quad + jj; PP[(c * 16 + i) * 40 + l15] = (bf16_t)f2bf(l15 <= i ? sc[jj] : 0.f); }
            LDS_WAIT(); asm volatile("" ::: "memory");
            const bf16x8 pa = *(const LAS bf16x8*)(PP + (c * 16 + l15) * 40 + 8 * quad);
#pragma unroll
            for (int nt = 0; nt < 2; ++nt) oi[nt] = __builtin_amdgcn_mfma_f32_16x16x32_bf16(pa, vbf[nt], oi[nt], 0, 0, 0);
        }
#pragma unroll
        for (int c = 0; c < 2; ++c) {
            if (w == c) {
                if (c == 1) {
#pragma unroll
                    for (int nt = 0; nt < 2; ++nt)
#pragma unroll
                        for (int ks = 0; ks < 4; ++ks) sb0[nt][ks] = *(const LAS bf16x8*)(ST + (16 * nt + l15) * 136 + 32 * ks + 8 * quad);
                }
#pragma unroll
                for (int ks = 0; ks < 4; ++ks)
#pragma unroll
                    for (int nt = 0; nt < 2; ++nt) oi[nt] = __builtin_amdgcn_mfma_f32_16x16x32_bf16(qa[ks], sb0[nt][ks], oi[nt], 0, 0, 0);
#pragma unroll
                for (int jj = 0; jj < 4; ++jj) { const int pp = pos_of(s0 + 16 * c + 4 * quad + jj); float* op = osrc + (rb + pp) * DM + h * 128 + 32 * es + l15; op[0] = oi[0][jj]; op[16] = oi[1][jj]; }
            }
            {
                const f32x4 dc = *(const LAS f32x4*)(DEC + c * 128 + 16 * w + 4 * quad);
                const bf16x8 ka = *(const LAS bf16x8*)(KC + (c * 128 + 16 * w + l15) * 40 + 8 * quad);
#pragma unroll
                for (int nt = 0; nt < 2; ++nt) { const bf16x8 vb = *(const LAS bf16x8*)(VT + (c * 32 + 16 * nt + l15) * 40 + 8 * quad); S[nt] = S[nt] * dc; S[nt] = __builtin_amdgcn_mfma_f32_16x16x32_bf16(ka, vb, S[nt], 0, 0, 0); }
            }
            HG_BAR();
#pragma unroll
            for (int nt = 0; nt < 2; ++nt)
#pragma unroll
                for (int jj = 0; jj < 4; ++jj) ST[(16 * nt + l15) * 136 + 16 * w + 4 * quad + jj] = (bf16_t)f2bf(S[nt][jj]);
            if (c == 1 && tb + 1 < NTB) HG_WRITE(cur ^ 1);
            HG_BAR();
        }
    }
#undef HG_ISSUE
#undef HG_WRITE
#undef HG_BAR
}
__device__ __forceinline__ void hg_scan_item_c32(Frame& F, int item) {
    const int es = item & 3, dir = (item >> 2) & 1, h = (item >> 3) & 7, b = item >> 6;
    const int tid = ftid(), lane = tid & 63, w = F.wave, quad = lane >> 4, l15 = lane & 15;
    constexpr int INB = 32 * 128 * 2 + 32 * 32;
    LAS float* sIn = (LAS float*)F.lds;
    LAS bf16_t* QA = (LAS bf16_t*)(sIn + 2 * INB);
    LAS bf16_t* KB = QA + 32 * 136;
    LAS bf16_t* KC = KB + 32 * 136;
    LAS bf16_t* VT = KC + 128 * 40;
    LAS bf16_t* PP = VT + 32 * 40;
    LAS bf16_t* ST = PP + 32 * 40;
    LAS float* DEC = (LAS float*)(ST + 32 * 136);
    const float* fsrc = (const float*)(F.ws + (dir ? WS_FB : WS_FF));
    const bf16_t* qsrc = (const bf16_t*)(F.ws + WS_PQ); const bf16_t* vsrc = (const bf16_t*)(F.ws + WS_PI);
    float* osrc = (float*)(F.ws + (dir ? WS_OB : WS_OF));
    const size_t rb = (size_t)b * SU;
    f32x4 S[2] = {(f32x4){0.f, 0.f, 0.f, 0.f}, (f32x4){0.f, 0.f, 0.f, 0.f}};
    f32x4 rf0A, rf1A, rf0B, rf1B; u32x4 rqA, rvA, rqB, rvB;
    auto pos_of = [&](int s) { return dir ? (s < NCTX ? NCTX - 1 - s : SU + NCTX - 1 - s) : s; };
#define HG_ISSUE(rf0, rf1, rq, rv, s0_) do { const int pA = pos_of((s0_) + (tid >> 5)), pB = pos_of((s0_) + 16 + (tid >> 5)), pQ = pos_of((s0_) + (tid >> 4)); \
        rf0 = *(const f32x4*)(fsrc + (rb + pA) * DM + h * 128 + 4 * (tid & 31)); rf1 = *(const f32x4*)(fsrc + (rb + pB) * DM + h * 128 + 4 * (tid & 31)); \
        rq = *(const u32x4*)(qsrc + (rb + pQ) * DM + h * 128 + 8 * (tid & 15)); \
        if (tid < 128) { const int pV = pos_of((s0_) + (tid >> 2)); rv = *(const u32x4*)(vsrc + (rb + pV) * DM + h * 128 + 32 * es + 8 * (tid & 3)); } } while (0)
#define HG_WRITE(rf0, rf1, rq, rv, buf_) do { LAS float* bF = sIn + (buf_) * INB; LAS float* bQ = bF + 32 * 128; LAS float* bV = bQ + 32 * 128; \
        *(LAS f32x4*)(bF + (tid >> 5) * 128 + 4 * (tid & 31)) = rf0; *(LAS f32x4*)(bF + (16 + (tid >> 5)) * 128 + 4 * (tid & 31)) = rf1; \
        { LAS float* d = bQ + (tid >> 4) * 128 + 8 * (tid & 15); *(LAS f32x4*)d = (f32x4){bflo(rq.x), bfhi(rq.x), bflo(rq.y), bfhi(rq.y)}; *(LAS f32x4*)(d + 4) = (f32x4){bflo(rq.z), bfhi(rq.z), bflo(rq.w), bfhi(rq.w)}; } \
        if (tid < 128) { LAS float* d = bV + (tid >> 2) * 32 + 8 * (tid & 3); *(LAS f32x4*)d = (f32x4){bflo(rv.x), bfhi(rv.x), bflo(rv.y), bfhi(rv.y)}; *(LAS f32x4*)(d + 4) = (f32x4){bflo(rv.z), bfhi(rv.z), bflo(rv.w), bfhi(rv.w)}; } } while (0)
#define HG_BAR() do { asm volatile("s_waitcnt lgkmcnt(0)" ::: "memory"); __builtin_amdgcn_s_barrier(); asm volatile("" ::: "memory"); } while (0)
    __syncthreads();
    for (int i = tid; i < 32 * 136; i += 512) ST[i] = 0;
    HG_ISSUE(rf0A, rf1A, rqA, rvA, 0); HG_WRITE(rf0A, rf1A, rqA, rvA, 0);
    HG_ISSUE(rf0B, rf1B, rqB, rvB, 32);
    __syncthreads();
    constexpr int NTB = SU / 32;
    auto blk = [&](const int tb, const int cur) __attribute__((always_inline)) {
        const int s0 = 32 * tb;
        const LAS float* sF = sIn + cur * INB; const LAS float* sQ = sF + 32 * 128; const LAS float* sV = sQ + 32 * 128;
        if (tid < 256) {
            const int c = tid & 1, d = tid >> 1;
            float fv[16], qv[16], kbv[16];
#pragma unroll
            for (int i = 0; i < 16; ++i) { fv[i] = sF[(16 * c + i) * 128 + d]; qv[i] = sQ[(16 * c + i) * 128 + d]; }
            float tot = 1.f;
#pragma unroll
            for (int i = 0; i < 16; ++i) tot *= fv[i];
            const float oth = shx(tot, 1, lane);
            float ea = c ? oth : 1.f;
            float eia = __builtin_amdgcn_rcpf(ea);
            const float al = tot * oth;
#pragma unroll
            for (int i = 0; i < 16; ++i) { const float fo = fv[i]; ea *= fo; eia *= __builtin_amdgcn_rcpf(fo);
                QA[(16 * c + i) * 136 + d] = (bf16_t)f2bf(qv[i] * ea); kbv[i] = (1.0f - fo) * eia; }
            if (c == 0) DEC[d] = al;
            unsigned pk[8];
#pragma unroll
            for (int j = 0; j < 16; ++j) KB[(16 * c + j) * 136 + d] = (bf16_t)f2bf(kbv[j]);
#pragma unroll
            for (int j = 0; j < 8; ++j) pk[j] = pk2(kbv[2 * j] * al, kbv[2 * j + 1] * al);
            LAS u32x4* kd = (LAS u32x4*)(KC + d * 40 + 16 * c); kd[0] = (u32x4){pk[0], pk[1], pk[2], pk[3]}; kd[1] = (u32x4){pk[4], pk[5], pk[6], pk[7]};
        } else {
            const int idx = tid - 256, e = idx >> 3, jq = idx & 7;
            const float v0 = sV[(4 * jq + 0) * 32 + e], v1 = sV[(4 * jq + 1) * 32 + e], v2 = sV[(4 * jq + 2) * 32 + e], v3 = sV[(4 * jq + 3) * 32 + e];
            u32x2 o; o.x = pk2(v0, v1); o.y = pk2(v2, v3); *(LAS u32x2*)(VT + e * 40 + 4 * jq) = o;
        }
        HG_BAR();
        if (w < 2) {
            const int it = w;
            bf16x8 qa[4], kbf[2][4], vbf[2], sbf[2][4];
#pragma unroll
            for (int ks = 0; ks < 4; ++ks) { qa[ks] = *(const LAS bf16x8*)(QA + (16 * it + l15) * 136 + 32 * ks + 8 * quad);
                kbf[0][ks] = *(const LAS bf16x8*)(KB + (l15) * 136 + 32 * ks + 8 * quad); kbf[1][ks] = *(const LAS bf16x8*)(KB + (16 + l15) * 136 + 32 * ks + 8 * quad); }
#pragma unroll
            for (int nt = 0; nt < 2; ++nt) { vbf[nt] = *(const LAS bf16x8*)(VT + (16 * nt + l15) * 40 + 8 * quad);
#pragma unroll
                for (int ks = 0; ks < 4; ++ks) sbf[nt][ks] = *(const LAS bf16x8*)(ST + (16 * nt + l15) * 136 + 32 * ks + 8 * quad); }
            f32x4 sc0 = (f32x4){0.f, 0.f, 0.f, 0.f}, sc1 = (f32x4){0.f, 0.f, 0.f, 0.f};
#pragma unroll
            for (int ks = 0; ks < 4; ++ks) { sc0 = __builtin_amdgcn_mfma_f32_16x16x32_bf16(qa[ks], kbf[0][ks], sc0, 0, 0, 0); sc1 = __builtin_amdgcn_mfma_f32_16x16x32_bf16(qa[ks], kbf[1][ks], sc1, 0, 0, 0); }
#pragma unroll
            for (int jj = 0; jj < 4; ++jj) { const int i = 16 * it + 4 * quad + jj;
                PP[i * 40 + l15] = (bf16_t)f2bf(l15 <= i ? sc0[jj] : 0.f); PP[i * 40 + 16 + l15] = (bf16_t)f2bf(16 + l15 <= i ? sc1[jj] : 0.f); }
            LDS_WAIT(); asm volatile("" ::: "memory");
            const bf16x8 pa = *(const LAS bf16x8*)(PP + (16 * it + l15) * 40 + 8 * quad);
            f32x4 oi[2];
#pragma unroll
            for (int nt = 0; nt < 2; ++nt) { oi[nt] = __builtin_amdgcn_mfma_f32_16x16x32_bf16(pa, vbf[nt], (f32x4){0.f, 0.f, 0.f, 0.f}, 0, 0, 0);
#pragma unroll
                for (int ks = 0; ks < 4; ++ks) oi[nt] = __builtin_amdgcn_mfma_f32_16x16x32_bf16(qa[ks], sbf[nt][ks], oi[nt], 0, 0, 0); }
#pragma unroll
            for (int jj = 0; jj < 4; ++jj) { const int pp = pos_of(s0 + 16 * it + 4 * quad + jj); float* op = osrc + (rb + pp) * DM + h * 128 + 32 * es + l15; op[0] = oi[0][jj]; op[16] = oi[1][jj]; }
        }
        {
            const f32x4 dc = *(const LAS f32x4*)(DEC + 16 * w + 4 * quad);
            const bf16x8 ka = *(const LAS bf16x8*)(KC + (16 * w + l15) * 40 + 8 * quad);
#pragma unroll
            for (int nt = 0; nt < 2; ++nt) { const bf16x8 vb = *(const LAS bf16x8*)(VT + (16 * nt + l15) * 40 + 8 * quad); S[nt] = S[nt] * dc; S[nt] = __builtin_amdgcn_mfma_f32_16x16x32_bf16(ka, vb, S[nt], 0, 0, 0); }
        }
        HG_BAR();
#pragma unroll
        for (int nt = 0; nt < 2; ++nt)
#pragma unroll
            for (int jj = 0; jj < 4; ++jj) ST[(16 * nt + l15) * 136 + 16 * w + 4 * quad + jj] = (bf16_t)f2bf(S[nt][jj]);
    };
    for (int tb = 0; tb < NTB; tb += 2) {
        { const int nb = tb + 2 < NTB ? tb + 2 : NTB - 1; HG_ISSUE(rf0A, rf1A, rqA, rvA, 32 * nb); }
        blk(tb, 0);
        HG_WRITE(rf0B, rf1B, rqB, rvB, 1);
        HG_BAR();
        { const int nb = tb + 3 < NTB ? tb + 3 : NTB - 1; HG_ISSUE(rf0B, rf1B, rqB, rvB, 32 * nb); }
        blk(tb + 1, 1);
        HG_WRITE(rf0A, rf1A, rqA, rvA, 0);
        HG_BAR();
    }
#undef HG_ISSUE
#undef HG_WRITE
#undef HG_BAR
}
__device__ __forceinline__ void hg_scan_item(Frame& F, int item) {
    const int es = item & 3, dir = (item >> 2) & 1, h = (item >> 3) & 7, b = item >> 6;
    const int tid = ftid(), lane = tid & 63, w = F.wave, quad = lane >> 4, l15 = lane & 15;
    constexpr int INB = 32 * 128 * 2 + 32 * 32;
    LAS float* sIn = (LAS float*)F.lds;
    LAS bf16_t* QA = (LAS bf16_t*)(sIn + 2 * INB);
    LAS bf16_t* KB = QA + 2 * 32 * 136;
    LAS bf16_t* KC = KB + 32 * 136;
    LAS bf16_t* VT = KC + 2 * 128 * 40;
    LAS bf16_t* PP = VT + 2 * 32 * 40;
    LAS bf16_t* ST = PP + 2 * 32 * 40;
    LAS float* DEC = (LAS float*)(ST + 2 * 32 * 136);
    const float* fsrc = (const float*)(F.ws + (dir ? WS_FB : WS_FF));
    const bf16_t* qsrc = (const bf16_t*)(F.ws + WS_PQ); const bf16_t* vsrc = (const bf16_t*)(F.ws + WS_PI);
    float* osrc = (float*)(F.ws + (dir ? WS_OB : WS_OF));
    const size_t rb = (size_t)b * SU;
    auto pos_of = [&](int s) { return dir ? (s < NCTX ? NCTX - 1 - s : SU + NCTX - 1 - s) : s; };
    constexpr int NTB = SU / 32;
#define HG_BAR() do { asm volatile("s_waitcnt lgkmcnt(0)" ::: "memory"); __builtin_amdgcn_s_barrier(); asm volatile("" ::: "memory"); } while (0)
    f32x4 rf[4]; u32x4 rq[2], rv;
#define HG_ISSUE(s0_) do { \
        _Pragma("unroll") for (int r_ = 0; r_ < 4; ++r_) rf[r_] = *(const f32x4*)(fsrc + (rb + pos_of((s0_) + (tid >> 5) + 8 * r_)) * DM + h * 128 + 4 * (tid & 31)); \
        _Pragma("unroll") for (int r_ = 0; r_ < 2; ++r_) rq[r_] = *(const u32x4*)(qsrc + (rb + pos_of((s0_) + (tid >> 4) + 16 * r_)) * DM + h * 128 + 8 * (tid & 15)); \
        if (tid < 128) rv = *(const u32x4*)(vsrc + (rb + pos_of((s0_) + (tid >> 2))) * DM + h * 128 + 32 * es + 8 * (tid & 3)); } while (0)
#define HG_WRITE(buf_) do { LAS float* bF = sIn + (buf_) * INB; LAS float* bQ = bF + 32 * 128; LAS float* bV = bQ + 32 * 128; \
        _Pragma("unroll") for (int r_ = 0; r_ < 4; ++r_) *(LAS f32x4*)(bF + ((tid >> 5) + 8 * r_) * 128 + 4 * (tid & 31)) = rf[r_]; \
        _Pragma("unroll") for (int r_ = 0; r_ < 2; ++r_) { LAS float* d = bQ + ((tid >> 4) + 16 * r_) * 128 + 8 * (tid & 15); *(LAS f32x4*)d = (f32x4){bflo(rq[r_].x), bfhi(rq[r_].x), bflo(rq[r_].y), bfhi(rq[r_].y)}; *(LAS f32x4*)(d + 4) = (f32x4){bflo(rq[r_].z), bfhi(rq[r_].z), bflo(rq[r_].w), bfhi(rq[r_].w)}; } \
        if (tid < 128) { LAS float* d = bV + (tid >> 2) * 32 + 8 * (tid & 3); *(LAS f32x4*)d = (f32x4){bflo(rv.x), bfhi(rv.x), bflo(rv.y), bfhi(rv.y)}; *(LAS f32x4*)(d + 4) = (f32x4){bflo(rv.z), bfhi(rv.z), bflo(rv.w), bfhi(rv.w)}; } } while (0)
    f32x4 S[2][2];
#pragma unroll
    for (int a = 0; a < 2; ++a)
#pragma unroll
        for (int c2 = 0; c2 < 2; ++c2) S[a][c2] = (f32x4){0.f, 0.f, 0.f, 0.f};
    __syncthreads();
    for (int i = tid; i < 2 * 32 * 136; i += 512) ST[i] = 0;
    if (w < 4) { HG_ISSUE(0); HG_WRITE(0); HG_ISSUE(32); }
    __syncthreads();
    for (int j = 0; j <= NTB; ++j) {
        const int sp = j & 1;
        const int t = j - 1, sc_ = t & 1;
        f32x4 oi = (f32x4){0.f, 0.f, 0.f, 0.f};
        if (w < 4) {
            if (j < NTB) {
                const LAS float* sF = sIn + sp * INB; const LAS float* sQ = sF + 32 * 128; const LAS float* sV = sQ + 32 * 128;
                const int cq = w, dp = lane;
                f32x2 fv[32], qv[8];
#pragma unroll
                for (int i = 0; i < 32; ++i) fv[i] = *(const LAS f32x2*)(sF + i * 128 + 2 * dp);
                f32x2 fq[8];
#pragma unroll
                for (int i = 0; i < 8; ++i) { qv[i] = *(const LAS f32x2*)(sQ + (8 * cq + i) * 128 + 2 * dp); fq[i] = *(const LAS f32x2*)(sF + (8 * cq + i) * 128 + 2 * dp); }
                const int e = tid >> 3, jq = tid & 7;
                const float v0 = sV[(4 * jq + 0) * 32 + e], v1 = sV[(4 * jq + 1) * 32 + e], v2 = sV[(4 * jq + 2) * 32 + e], v3 = sV[(4 * jq + 3) * 32 + e];
                f32x2 qp[4];
#pragma unroll
                for (int c4 = 0; c4 < 4; ++c4) { f32x2 pr = fv[8 * c4];
#pragma unroll
                    for (int i = 1; i < 8; ++i) pr = pr * fv[8 * c4 + i]; qp[c4] = pr; }
                f32x2 ea = (f32x2){1.f, 1.f};
#pragma unroll
                for (int c4 = 0; c4 < 3; ++c4) { if (c4 < cq) ea = ea * qp[c4]; }
                const f32x2 al = (qp[0] * qp[1]) * (qp[2] * qp[3]);
                f32x2 eia; eia.x = __builtin_amdgcn_rcpf(ea.x); eia.y = __builtin_amdgcn_rcpf(ea.y);
                LAS bf16_t* qa_ = QA + sp * 32 * 136;
                f32x2 kbv[8];
#pragma unroll
                for (int i = 0; i < 8; ++i) { const f32x2 fo = fq[i];
                    ea = ea * fo; f32x2 rf_; rf_.x = __builtin_amdgcn_rcpf(fo.x); rf_.y = __builtin_amdgcn_rcpf(fo.y); eia = eia * rf_;
                    const f32x2 qa2 = qv[i] * ea; kbv[i] = ((f32x2){1.f, 1.f} - fo) * eia;
                    *(LAS unsigned*)(qa_ + (8 * cq + i) * 136 + 2 * dp) = pk2(qa2.x, qa2.y);
                    *(LAS unsigned*)(KB + (8 * cq + i) * 136 + 2 * dp) = pk2(kbv[i].x, kbv[i].y); }
                if (cq == 0) *(LAS f32x2*)(DEC + sp * 128 + 2 * dp) = al;
                u32x4 k0, k1;
                k0.x = pk2(kbv[0].x * al.x, kbv[1].x * al.x); k0.y = pk2(kbv[2].x * al.x, kbv[3].x * al.x); k0.z = pk2(kbv[4].x * al.x, kbv[5].x * al.x); k0.w = pk2(kbv[6].x * al.x, kbv[7].x * al.x);
                k1.x = pk2(kbv[0].y * al.y, kbv[1].y * al.y); k1.y = pk2(kbv[2].y * al.y, kbv[3].y * al.y); k1.z = pk2(kbv[4].y * al.y, kbv[5].y * al.y); k1.w = pk2(kbv[6].y * al.y, kbv[7].y * al.y);
                *(LAS u32x4*)(KC + (sp * 128 + 2 * dp) * 40 + 8 * cq) = k0; *(LAS u32x4*)(KC + (sp * 128 + 2 * dp + 1) * 40 + 8 * cq) = k1;
                u32x2 o; o.x = pk2(v0, v1); o.y = pk2(v2, v3); *(LAS u32x2*)(VT + (sp * 32 + e) * 40 + 4 * jq) = o;
            }
        } else if (t >= 0) {
            const int k = w - 4, it = k >> 1, nt = k & 1;
            const bf16x8 pa = *(const LAS bf16x8*)(PP + (sc_ * 32 + 16 * it + l15) * 40 + 8 * quad);
            const bf16x8 vb = *(const LAS bf16x8*)(VT + (sc_ * 32 + 16 * nt + l15) * 40 + 8 * quad);
            bf16x8 qa[4], sb[4];
#pragma unroll
            for (int ks = 0; ks < 4; ++ks) { qa[ks] = *(const LAS bf16x8*)(QA + (sc_ * 32 + 16 * it + l15) * 136 + 32 * ks + 8 * quad); sb[ks] = *(const LAS bf16x8*)(ST + (sc_ * 32 + 16 * nt + l15) * 136 + 32 * ks + 8 * quad); }
            oi = __builtin_amdgcn_mfma_f32_16x16x32_bf16(pa, vb, oi, 0, 0, 0);
#pragma unroll
            for (int ks = 0; ks < 4; ++ks) oi = __builtin_amdgcn_mfma_f32_16x16x32_bf16(qa[ks], sb[ks], oi, 0, 0, 0);
#pragma unroll
            for (int jj = 0; jj < 4; ++jj) { const int pp = pos_of(32 * t + 16 * it + 4 * quad + jj); osrc[(rb + pp) * DM + h * 128 + 32 * es + 16 * nt + l15] = oi[jj]; }
        }
        HG_BAR();
        if (w < 2) {
            if (j < NTB) {
                const int it = w;
                bf16x8 qa[4], kbf[2][4];
#pragma unroll
                for (int ks = 0; ks < 4; ++ks) { qa[ks] = *(const LAS bf16x8*)(QA + (sp * 32 + 16 * it + l15) * 136 + 32 * ks + 8 * quad);
                    kbf[0][ks] = *(const LAS bf16x8*)(KB + (l15) * 136 + 32 * ks + 8 * quad); kbf[1][ks] = *(const LAS bf16x8*)(KB + (16 + l15) * 136 + 32 * ks + 8 * quad); }
                f32x4 sc0 = (f32x4){0.f, 0.f, 0.f, 0.f}, sc1 = (f32x4){0.f, 0.f, 0.f, 0.f};
#pragma unroll
                for (int ks = 0; ks < 4; ++ks) { sc0 = __builtin_amdgcn_mfma_f32_16x16x32_bf16(qa[ks], kbf[0][ks], sc0, 0, 0, 0); sc1 = __builtin_amdgcn_mfma_f32_16x16x32_bf16(qa[ks], kbf[1][ks], sc1, 0, 0, 0); }
#pragma unroll
                for (int jj = 0; jj < 4; ++jj) { const int i = 16 * it + 4 * quad + jj;
                    PP[(sp * 32 + i) * 40 + l15] = (bf16_t)f2bf(l15 <= i ? sc0[jj] : 0.f); PP[(sp * 32 + i) * 40 + 16 + l15] = (bf16_t)f2bf(16 + l15 <= i ? sc1[jj] : 0.f); }
            }
        } else if (w >= 4 && t >= 0) {
            const int k = w - 4;
#pragma unroll
            for (int mt = 0; mt < 2; ++mt) {
                const f32x4 dc = *(const LAS f32x4*)(DEC + sc_ * 128 + 32 * k + 16 * mt + 4 * quad);
                const bf16x8 ka = *(const LAS bf16x8*)(KC + (sc_ * 128 + 32 * k + 16 * mt + l15) * 40 + 8 * quad);
#pragma unroll
                for (int n2 = 0; n2 < 2; ++n2) { const bf16x8 vb2 = *(const LAS bf16x8*)(VT + (sc_ * 32 + 16 * n2 + l15) * 40 + 8 * quad); S[mt][n2] = S[mt][n2] * dc; S[mt][n2] = __builtin_amdgcn_mfma_f32_16x16x32_bf16(ka, vb2, S[mt][n2], 0, 0, 0); }
            }
            LAS bf16_t* stn = ST + (sc_ ^ 1) * 32 * 136;
#pragma unroll
            for (int mt = 0; mt < 2; ++mt)
#pragma unroll
                for (int n2 = 0; n2 < 2; ++n2)
                    { u32x2 o2; o2.x = pk2(S[mt][n2][0], S[mt][n2][1]); o2.y = pk2(S[mt][n2][2], S[mt][n2][3]); *(LAS u32x2*)(stn + (16 * n2 + l15) * 136 + 32 * k + 16 * mt + 4 * quad) = o2; }
        }
        if (w < 4 && j + 1 < NTB) { HG_WRITE((j + 1) & 1); if (j + 2 < NTB) HG_ISSUE(32 * (j + 2)); }
        HG_BAR();
    }
#undef HG_ISSUE
#undef HG_WRITE
#undef HG_BAR
}
__device__ __forceinline__ void naive_hg_scan(Frame& F) {
    const int gt = fbid() * 512 + ftid();
    if (gt >= NB * 8 * 2 * 128) return;
    const int e = gt & 127, dir = (gt >> 7) & 1, h = (gt >> 8) & 7, b = gt >> 11;
    const float* fsrc = (const float*)(F.ws + (dir ? WS_FB : WS_FF));
    const bf16_t* qsrc = (const bf16_t*)(F.ws + WS_PQ); const bf16_t* vsrc = (const bf16_t*)(F.ws + WS_PI);
    float* osrc = (float*)(F.ws + (dir ? WS_OB : WS_OF));
    float S[128];
#pragma unroll
    for (int d = 0; d < 128; ++d) S[d] = 0.f;
    for (int s_ = 0; s_ < SU; ++s_) {
        const int pp = dir ? (s_ < NCTX ? NCTX - 1 - s_ : SU + NCTX - 1 - s_) : s_;
        const size_t row = (size_t)b * SU + pp;
        const float v = bf2f(vsrc[row * DM + h * 128 + e]);
        const float* fr = fsrc + row * DM + h * 128; const bf16_t* qr = qsrc + row * DM + h * 128;
        float o = 0.f;
#pragma unroll
        for (int d = 0; d < 128; ++d) { const float f = fr[d]; S[d] = f * S[d] + (1.0f - f) * v; o += bf2f(qr[d]) * S[d]; }
        osrc[row * DM + h * 128 + e] = o;
    }
}
__device__ __forceinline__ void naive_hg_readout(Frame& F, const Args& args, int p) {
    for (int i = fbid() * 512 + ftid(); i < MTOK * 8; i += F.G * 512) {
        const int row = i >> 3, h = i & 7;
        const float* a = (const float*)(F.ws + WS_OF) + (size_t)row * DM + h * 128; const float* c = (const float*)(F.ws + WS_OB) + (size_t)row * DM + h * 128;
        float ss = 0.f;
        for (int d = 0; d < 128; ++d) { const float o = a[d] + c[d]; ss += o * o; }
        const float rstd = 1.0f / sqrtf(ss / 128.f + EPS);
        const bf16_t* g = (const bf16_t*)(F.ws + WS_PG) + (size_t)row * DM + h * 128; bf16_t* y = (bf16_t*)(F.ws + WS_YB16) + (size_t)row * DM + h * 128;
        for (int d = 0; d < 128; ++d) { const float o = a[d] + c[d]; const float gv = bf2f(g[d]); y[d] = (bf16_t)f2bf(o * rstd * args.in[I_HGNW][p * 128 + d] * (gv / (1.0f + expf(-gv)))); }
    }
}
__device__ __forceinline__ void hg_readout_phase(Frame& F, const Args& args, int p) {
    const int gw = F.vcu * NWAVES + F.wave, NGW = F.G * NWAVES, lane = flane();
    const float* nw = ((const float*)(F.ws + WS_SP) + SP_HGNW) + p * 128 + 16 * (lane & 7);
    for (int row = gw; row < MTOK; row += NGW) {
        const f32x4* a = (const f32x4*)(F.ws + WS_OF + (size_t)row * DM * 4) + 4 * lane; const f32x4* c = (const f32x4*)(F.ws + WS_OB + (size_t)row * DM * 4) + 4 * lane;
        f32x4 o[4]; float ss = 0.f;
#pragma unroll
        for (int j = 0; j < 4; ++j) { o[j] = ABL_HGB0 ? a[j] : a[j] + c[j]; ss += (o[j].x * o[j].x + o[j].y * o[j].y) + (o[j].z * o[j].z + o[j].w * o[j].w); }
        ss += shx(ss, 1, lane); ss += shx(ss, 2, lane); ss += shx(ss, 4, lane);
        const float rstd = 1.0f / sqrtf(ss * (1.0f / 128.f) + EPS);
        const u32x4* gp = (const u32x4*)(F.ws + WS_PG + (size_t)row * DM * 2) + 2 * lane;
        const u32x4 g0 = gp[0], g1 = gp[1]; const unsigned gwv[8] = {g0.x, g0.y, g0.z, g0.w, g1.x, g1.y, g1.z, g1.w};
        unsigned outw[8];
#pragma unroll
        for (int j = 0; j < 4; ++j) { const f32x4 wv = *(const f32x4*)(nw + 4 * j);
            const float y0 = o[j].x * rstd * wv.x * siluf(bflo(gwv[2 * j])), y1 = o[j].y * rstd * wv.y * siluf(bfhi(gwv[2 * j]));
            const float y2 = o[j].z * rstd * wv.z * siluf(bflo(gwv[2 * j + 1])), y3 = o[j].w * rstd * wv.w * siluf(bfhi(gwv[2 * j + 1]));
            outw[2 * j] = pk2(y0, y1); outw[2 * j + 1] = pk2(y2, y3); }
        u32x4* op = (u32x4*)(F.ws + WS_YB16 + (size_t)row * DM * 2) + 2 * lane;
        op[0] = (u32x4){outw[0], outw[1], outw[2], outw[3]}; op[1] = (u32x4){outw[4], outw[5], outw[6], outw[7]};
    }
}

constexpr int NPHASE = 2 + 9 * DEPTH;
constexpr unsigned KM_ALL = 0x7ffu | (3u << 16);
template <unsigned KM>
__device__ __forceinline__ void mk_body(const Args& args, unsigned char* lds_raw) {
    Frame F;
    F.lds = (LAS unsigned char*)lds_raw;
    F.MISC = (volatile LAS unsigned*)(F.lds + MISC_OFF);
    F.wave = __builtin_amdgcn_readfirstlane(ftid() >> 6);
    F.G = gridDim.x; { const int bx = blockIdx.x; F.vcu = (F.G % 8 == 0) ? (bx % 8) * (F.G / 8) + bx / 8 : bx; }
    F.ws = args.ws; F.ctl = (unsigned*)(args.ws + WS_CTL);
    for (int u = ftid(); u < (LDS_BYTES - LDSCTL_OFF) / 4; u += NWAVES * 64) ((LAS unsigned*)(F.lds + LDSCTL_OFF))[u] = 0u;
    __syncthreads();
    XcdBarrier bar; bar.bar = F.ctl + CW_BAR; bar.x = 0; bar.st = nullptr;
    const int lo = args.ph_lo, hi = args.ph_hi;
    if (hi - lo > 1) bar = xcd_barrier_post(F.ctl + CW_BAR, F.MISC + 8);
#define HAS(kind) ((KM >> (kind)) & 1u)
    if constexpr (HAS(0)) { if (lo == 0) { p0_prologue(F, args); if (NAIVE_MOD) { __syncthreads(); naive_mod(F, args); } if (hi > 1) xcd_barrier(bar); } }
    float* const outp = args.out;
#pragma nounroll
    for (int ph = (lo == 0 ? 1 : lo); ph < hi; ++ph) {
        const Args* ap = &args;
        { unsigned char* w_ = args.ws; asm volatile("" : "+s"(w_)); F.ws = w_; F.ctl = (unsigned*)(w_ + WS_CTL); }
        { int wv_ = __builtin_amdgcn_readfirstlane(ftid() >> 6); F.wave = wv_; int g_ = (int)gridDim.x; asm volatile("" : "+s"(g_)); F.G = g_; const int bx = fbid(); F.vcu = (g_ % 8 == 0) ? (bx % 8) * (g_ / 8) + bx / 8 : bx; }
        const float* mod = (const float*)(F.ws + WS_MOD);
        const int kind = (ph == 0) ? 0 : (ph == NPHASE - 1 ? 10 : 1 + (ph - 1) % 9);
        const int l = (ph - 1) / 9; const int odd = l & 1, p = l >> 1;
        if (kind == 5 && odd) continue;
        switch (kind) {
        case 1: if constexpr (HAS(1)) { if (NAIVE_N1 == 1) naive_n1(F, *ap, l, false); else if (NAIVE_N1 == 2) wave_n1(F, *ap, l, false); else n1_phase<false>(F, *ap, l); } break;
        case 2: if constexpr (HAS(2)) {
            const int N = odd ? OD_N : EV_N;
            if (NAIVE_G1) { naive_g1(F, *ap, l); } else {
            pg8::PlainAddr AD{(const bf16_t*)(F.ws + WS_HB), (const bf16_t*)(F.ws + (odd ? WS_W_ODIN + (size_t)p * 10 * MiB : WS_W_EVIN + (size_t)p * 6 * MiB)), DM};
            pg8::StaticOrder S; S.init(MTOK, N, F.G, fbid());
            EpiProj E{F.ws, (const float*)(F.ws + WS_LB) + l * DM, odd};
            pg8::gemm_phase(F.lds, AD, S, E, DM);
            } } break;
        case 3: if constexpr (HAS(3)) {
            if (!odd) {
                if constexpr (HAS(16)) {
                    for (int it = fbid(); it < NB * 4 * NCHUNK + (NAIVE_ATT ? 0 : NB * 2 * NCHUNK); it += F.G) {
                        if (it < NB * 4 * NCHUNK) ret_state_item(F, *ap, p, it); else att_item(F, *ap, p, it - NB * 4 * NCHUNK);
                    }
                    if (NAIVE_ATT) { __syncthreads(); naive_att(F, *ap, p); }
                }
            } else {
                if constexpr (HAS(17)) { if (NAIVE_HG) naive_hg_scan(F); else for (int it = fbid(); it < NB * 8 * 2 * 4; it += F.G) hg_scan_item(F, it); }
            }
            __syncthreads(); } break;
        case 4: if constexpr (HAS(4)) {
            if (!odd) { if constexpr (HAS(16)) ret_scan_phase(F, *ap, p); } else { if constexpr (HAS(17)) { if (NAIVE_HG) naive_hg_readout(F, *ap, p); else hg_readout_phase(F, *ap, p); } } } break;
        case 5: if constexpr (HAS(5)) { for (int it = fbid(); it < NB * 4 * NCHUNK; it += F.G) { if (RET_DIRECT) ret_direct_item(F, *ap, p, it); else ret_out_item(F, *ap, p, it); } __syncthreads(); } break;
        case 6: if constexpr (HAS(6)) {
            if (NAIVE_G2) { if (odd ? CONTRIB_ODD : CONTRIB_EVEN) naive_g2(F, *ap, l); } else {
            pg8::PlainAddr AD{(const bf16_t*)(F.ws + WS_YB16), (const bf16_t*)(F.ws + (odd ? WS_W_ODOUT : WS_W_EVOUT) + (size_t)p * 2 * MiB), DM};
            pg8::StaticOrder S; S.init(MTOK, DM, F.G, fbid());
            EpiOut E{(float*)(F.ws + WS_XRES), mod + (size_t)l * 5 * 6144, odd ? CONTRIB_ODD : CONTRIB_EVEN};
            pg8::gemm_phase(F.lds, AD, S, E, DM);
            } } break;
        case 7: if constexpr (HAS(7)) { if (NAIVE_N2R) naive_n2r(F, *ap, l); else n2r_phase(F, *ap, l); } break;
        case 8: case 9: if constexpr (HAS(8) || HAS(9)) {
            LAS int* tstart = (LAS int*)(F.lds + LDSCTL_OFF + 512); LAS int* cnts = (LAS int*)(F.lds + LDSCTL_OFF + 768);
            __syncthreads();
            if (F.wave == 0) { int mycnt; const int pre = moe_tile_prefix(F.ctl + CW_CNT + l * NEXP, flane(), mycnt); if (flane() <= NEXP) tstart[flane()] = pre; if (flane() < NEXP) cnts[flane()] = mycnt; }
            __syncthreads();
            const int ntiles = tstart[NEXP];
            const bf16_t* wmoe = (const bf16_t*)(F.ws + WS_W_MOE + (size_t)l * NEXP * 3 * MiB);
            if (kind == 8) { if constexpr (HAS(8)) {
                if (NAIVE_MOE) naive_moe(F, *ap, l); else {
                pg8::MoeGatherAddr AD{(const bf16_t*)(F.ws + WS_HB), wmoe, (const unsigned*)(F.ws + WS_LIST), DM};
                pg8::MoeOrder S{tstart, cnts, ntiles, F.G, fbid()};
                EpiAct E{(bf16_t*)(F.ws + WS_ACT)};
                pg8::gemm_phase(F.lds, AD, S, E, DM); }
            } } else { if constexpr (HAS(9)) {
                pg8::MoeActAddr AD{(const bf16_t*)(F.ws + WS_ACT), wmoe + (size_t)DM * DM, FF};
                pg8::MoeOrder S{tstart, cnts, ntiles, F.G, fbid()};
                EpiY E{(bf16_t*)(F.ws + WS_YB)};
                pg8::gemm_phase(F.lds, AD, S, E, FF);
            } } } break;
        default: if constexpr (HAS(10)) { if (NAIVE_FINAL == 1) naive_n1(F, *ap, DEPTH, true); else if (NAIVE_FINAL == 2) wave_n1(F, *ap, DEPTH, true); else n1_phase<true>(F, *ap, DEPTH); } break;
        }
        if (ph + 1 < hi) xcd_barrier(bar);
    }
#undef HAS
}
template <int L>
__device__ __forceinline__ void layer_sl(Frame& F, const Args& args, const XcdBarrier& bar) {
    constexpr int l = L; constexpr int odd = L & 1, p = L >> 1;
    const float* mod = (const float*)(F.ws + WS_MOD);
    n1_phase<false>(F, args, l); xcd_barrier(bar);
    { pg8::PlainAddr AD{(const bf16_t*)(F.ws + WS_HB), (const bf16_t*)(F.ws + (odd ? WS_W_ODIN + (size_t)p * 10 * MiB : WS_W_EVIN + (size_t)p * 6 * MiB)), DM};
      pg8::StaticOrder S; S.init(MTOK, odd ? OD_N : EV_N, F.G, fbid());
      EpiProj E{F.ws, (const float*)(F.ws + WS_LB) + l * DM, odd};
      pg8::gemm_phase(F.lds, AD, S, E, DM); }
    xcd_barrier(bar);
    if constexpr (!odd) {
        {
            const int bx = fbid();
            if (F.G == 256) {
                att_item(F, args, p, bx);
                if (bx < 16) att_item(F, args, p, 256 + bx);
                else { const int r0 = 2 * (bx - 16); ret_state_item(F, args, p, r0); ret_state_item(F, args, p, r0 + 1); if (bx - 16 < 64) ret_state_item(F, args, p, 480 + (bx - 16)); }
            } else {
                for (int it = bx; it < NB * 4 * NCHUNK + NB * 2 * NCHUNK; it += F.G) { if (it < NB * 2 * NCHUNK) att_item(F, args, p, it); else ret_state_item(F, args, p, it - NB * 2 * NCHUNK); }
            }
        }
        __syncthreads(); xcd_barrier(bar);
        ret_scan_phase(F, args, p); xcd_barrier(bar);
        for (int rep_ = 0; rep_ <= REP_MIXE; ++rep_) for (int it = fbid(); it < NB * 4 * NCHUNK; it += F.G) ret_out_item(F, args, p, it);
        __syncthreads(); xcd_barrier(bar);
    } else {
        for (int rep_ = 0; rep_ <= REP_HG; ++rep_) for (int it = F.vcu; it < NB * 8 * 2 * 4; it += F.G) hg_scan_item(F, it);
        __syncthreads(); xcd_barrier(bar);
        hg_readout_phase(F, args, p); xcd_barrier(bar);
    }
    { pg8::PlainAddr AD{(const bf16_t*)(F.ws + WS_YB16), (const bf16_t*)(F.ws + (odd ? WS_W_ODOUT : WS_W_EVOUT) + (size_t)p * 2 * MiB), DM};
      pg8::StaticOrder S; S.init(MTOK, DM, F.G, fbid(), l == DEPTH - 1 ? 1 : 0);
      EpiOut E{(float*)(F.ws + WS_XRES), mod + (size_t)l * 5 * 6144, 1};
      pg8::gemm_phase(F.lds, AD, S, E, DM); }
    xcd_barrier(bar);
    n2r_phase(F, args, l); xcd_barrier(bar);
    {   LAS int* tstart = (LAS int*)(F.lds + LDSCTL_OFF + 512); LAS int* cnts = (LAS int*)(F.lds + LDSCTL_OFF + 768);
        __syncthreads();
        if (F.wave == 0) { int mycnt; const int ln = flane(); const int pre = moe_tile_prefix(F.ctl + CW_CNT + l * NEXP, ln, mycnt); if (ln <= NEXP) tstart[ln] = pre; if (ln < NEXP) cnts[ln] = mycnt; }
        __syncthreads();
        const int ntiles = tstart[NEXP];
        const bf16_t* wmoe = (const bf16_t*)(F.ws + WS_W_MOE + (size_t)l * NEXP * 3 * MiB);
        { pg8::MoeGatherAddr AD{(const bf16_t*)(F.ws + WS_HB), wmoe, (const unsigned*)(F.ws + WS_LIST), DM};
          pg8::MoeOrder S{tstart, cnts, ntiles, F.G, fbid()};
          EpiAct E{(bf16_t*)(F.ws + WS_ACT)};
          pg8::gemm_phase(F.lds, AD, S, E, DM); }
        xcd_barrier(bar);
        { pg8::MoeActAddr AD{(const bf16_t*)(F.ws + WS_ACT), wmoe + (size_t)DM * DM, FF};
          pg8::MoeOrder S{tstart, cnts, ntiles, F.G, fbid()};
          EpiY E{(bf16_t*)(F.ws + WS_YB)};
          pg8::gemm_phase(F.lds, AD, S, E, FF); }
        xcd_barrier(bar);
    }
}
__global__ void __launch_bounds__(NWAVES * 64, 2) mk_one(Args args) {
    extern __shared__ __attribute__((aligned(16))) unsigned char lds_raw[];
    Frame F;
    F.lds = (LAS unsigned char*)lds_raw;
    F.MISC = (volatile LAS unsigned*)(F.lds + MISC_OFF);
    F.wave = __builtin_amdgcn_readfirstlane(ftid() >> 6);
    F.G = gridDim.x; { const int bx = blockIdx.x; F.vcu = (F.G % 8 == 0) ? (bx % 8) * (F.G / 8) + bx / 8 : bx; }
    F.ws = args.ws; F.ctl = (unsigned*)(args.ws + WS_CTL);
    for (int u = ftid(); u < (LDS_BYTES - LDSCTL_OFF) / 4; u += NWAVES * 64) ((LAS unsigned*)(F.lds + LDSCTL_OFF))[u] = 0u;
    __syncthreads();
    const XcdBarrier bar = xcd_barrier_post(F.ctl + CW_BAR, F.MISC + 8);
    p0_prologue(F, args); xcd_barrier(bar);
    layer_sl<0>(F, args, bar);
    layer_sl<1>(F, args, bar);
    layer_sl<2>(F, args, bar);
    layer_sl<3>(F, args, bar);
    n1_phase<true>(F, args, DEPTH);
}

template <unsigned KM>
__global__ void __launch_bounds__(NWAVES * 64, 2) mk_fwd(Args args) {
    extern __shared__ __attribute__((aligned(16))) unsigned char lds_raw[];
    mk_body<KM>(args, lds_raw);
}

template <unsigned KM> static bool prep_kernel() { return hipFuncSetAttribute((const void*)mk_fwd<KM>, hipFuncAttributeMaxDynamicSharedMemorySize, LDS_BYTES) == hipSuccess; }
template <unsigned KM> static void launch_kernel(int grid, hipStream_t stream, const Args& a) { hipLaunchKernelGGL(mk_fwd<KM>, dim3(grid), dim3(NWAVES * 64), LDS_BYTES, stream, a); }
#define KEV (1u << 16)
#define KOD (1u << 17)
extern "C" void kernel_launch(void* const* d_in, const int* in_sizes, int n_in, void* d_out, int out_size, void* d_ws, size_t ws_size, hipStream_t stream) {
    static int grid = 0;
    if (grid == 0) {
        const int exp_sizes[23] = {NB * LSEQ * DM, NB * DM, NB * NCTX * DM, DM, DEPTH * DM * 6 * DM, DEPTH * 6 * DM, DEPTH * 2 * DM, DM, 2 * DM * EV_N, 2 * DM * DM, 16, 8,
                                   2 * DM * OD_N, 2 * DM * DM, DEPTH * DM, 2 * 128, DEPTH * DM * 4, DEPTH * 4, DEPTH * 4 * DM * 8, DEPTH * 32, DEPTH * NEXP * DM * FF, DEPTH * NEXP * DM * FF, DEPTH * NEXP * FF * DM};
        bool sz_ok = (n_in == 23) && out_size == NB * LSEQ * DM;
        for (int i = 0; i < 23 && sz_ok; ++i) sz_ok = (in_sizes[i] == exp_sizes[i]);
        if (!sz_ok) { fprintf(stderr, "kernel_launch: unexpected input sizes\n"); grid = -1; return; }
        if (n_in != 23 || ws_size < WS_END) { fprintf(stderr, "kernel_launch: unexpected n_in %d / ws_size %zu\n", n_in, ws_size); grid = -1; return; }
        int dev = 0, cus = 0;
        if (hipGetDevice(&dev) != hipSuccess || hipDeviceGetAttribute(&cus, hipDeviceAttributeMultiprocessorCount, dev) != hipSuccess) { grid = -1; return; }
        bool ok = true;
#if MK_PER_PHASE
        ok = ok && prep_kernel<1u << 0>() && prep_kernel<1u << 1>() && prep_kernel<1u << 2>() && prep_kernel<(1u << 3) | KEV>() && prep_kernel<(1u << 3) | KOD>()
                && prep_kernel<(1u << 4) | KEV>() && prep_kernel<(1u << 4) | KOD>() && prep_kernel<(1u << 5) | KEV>() && prep_kernel<1u << 6>() && prep_kernel<1u << 7>()
                && prep_kernel<1u << 8>() && prep_kernel<1u << 9>() && prep_kernel<1u << 10>();
#else
        ok = ok && (hipFuncSetAttribute((const void*)mk_one, hipFuncAttributeMaxDynamicSharedMemorySize, LDS_BYTES) == hipSuccess);
#ifdef PROBE_MASKS
        ok = ok && prep_kernel<(1u<<3)|(3u<<16)>() && prep_kernel<(1u<<3)|(1u<<5)|(1u<<16)>() && prep_kernel<(1u<<0)|(1u<<1)|(1u<<7)|(1u<<10)>() && prep_kernel<(1u<<3)|(1u<<4)|(1u<<5)|(3u<<16)>() && prep_kernel<(1u<<0)|(1u<<3)|(1u<<16)>() && prep_kernel<(1u<<1)|(1u<<3)|(1u<<16)>();
#endif
#endif
        if (!ok) { fprintf(stderr, "kernel_launch: hipFuncSetAttribute failed\n"); grid = -1; return; }
        (void)hipGetLastError();
        grid = cus > 256 ? 256 : cus;
    }
    if (grid < 0) return;
    (void)hipMemsetAsync((char*)d_ws + WS_CTL, 0, CTL_ZERO_BYTES, stream);
    Args a{};
    for (int i = 0; i < 23; ++i) a.in[i] = (const float*)d_in[i];
    a.out = (float*)d_out; a.ws = (unsigned char*)d_ws;
#if MK_PER_PHASE
    for (int ph = 0; ph < NPHASE; ++ph) {
        { unsigned char* w_ = args.ws; asm volatile("" : "+s"(w_)); F.ws = w_; F.ctl = (unsigned*)(w_ + WS_CTL); }
        { int wv_ = __builtin_amdgcn_readfirstlane(ftid() >> 6); F.wave = wv_; int g_ = (int)gridDim.x; asm volatile("" : "+s"(g_)); F.G = g_; const int bx = fbid(); F.vcu = (g_ % 8 == 0) ? (bx % 8) * (g_ / 8) + bx / 8 : bx; }
        const float* mod = (const float*)(F.ws + WS_MOD);
        const int kind = (ph == 0) ? 0 : (ph == NPHASE - 1 ? 10 : 1 + (ph - 1) % 9); const int l = (ph - 1) / 9; const bool odd = (l & 1) != 0;
        if (kind == 5 && odd) continue;
        a.ph_lo = ph; a.ph_hi = ph + 1;
        switch (kind) {
            case 0: launch_kernel<1u << 0>(grid, stream, a); break;
            case 1: launch_kernel<1u << 1>(grid, stream, a); break;
            case 2: launch_kernel<1u << 2>(grid, stream, a); break;
            case 3: if (odd) launch_kernel<(1u << 3) | KOD>(grid, stream, a); else launch_kernel<(1u << 3) | KEV>(grid, stream, a); break;
            case 4: if (odd) launch_kernel<(1u << 4) | KOD>(grid, stream, a); else launch_kernel<(1u << 4) | KEV>(grid, stream, a); break;
            case 5: launch_kernel<(1u << 5) | KEV>(grid, stream, a); break;
            case 6: launch_kernel<1u << 6>(grid, stream, a); break;
            case 7: launch_kernel<1u << 7>(grid, stream, a); break;
            case 8: launch_kernel<1u << 8>(grid, stream, a); break;
            case 9: launch_kernel<1u << 9>(grid, stream, a); break;
            default: launch_kernel<1u << 10>(grid, stream, a); break;
        }
    }
#else
    a.ph_lo = 0; a.ph_hi = NPHASE;
    hipLaunchKernelGGL(mk_one, dim3(grid), dim3(NWAVES * 64), LDS_BYTES, stream, a);
#endif
}
```

```cpp
#include <hip/hip_runtime.h>
#include <cstdio>
#include <cstdint>

#ifndef MK_PER_PHASE
#define MK_PER_PHASE 0
#endif

#ifndef CONTRIB_EVEN
#define CONTRIB_EVEN 1
#endif
#ifndef CONTRIB_ODD
#define CONTRIB_ODD 1
#endif
#ifndef CONTRIB_MOE
#define CONTRIB_MOE 1
#endif
#ifndef ABL_ATT0
#define ABL_ATT0 0
#endif
#ifndef ABL_RET0
#define ABL_RET0 0
#endif
#ifndef ABL_HGB0
#define ABL_HGB0 0
#endif
#ifndef RET_DIRECT
#define RET_DIRECT 0
#endif
#ifndef NAIVE_G1
#define NAIVE_G1 0
#endif
#ifndef NAIVE_G2
#define NAIVE_G2 0
#endif
#ifndef NAIVE_MOD
#define NAIVE_MOD 0
#endif
#ifndef NAIVE_MOE
#define NAIVE_MOE 0
#endif
#ifndef NAIVE_ATT
#define NAIVE_ATT 0
#endif
#ifndef NAIVE_HG
#define NAIVE_HG 0
#endif
#ifndef NAIVE_N2R
#define NAIVE_N2R 0
#endif
#ifndef NAIVE_COPY
#define NAIVE_COPY 0
#endif
#ifndef NAIVE_N1
#define NAIVE_N1 0
#endif
#ifndef NAIVE_FINAL
#define NAIVE_FINAL 0
#endif
#ifndef MUT_A
#define MUT_A 0
#endif
#ifndef MUT_B
#define MUT_B 0
#endif
#ifndef MUT_D
#define MUT_D 0
#endif
#ifndef REP_CONV
#define REP_CONV 0
#endif
#ifndef REP_HG
#define REP_HG 0
#endif
#ifndef REP_MIXE
#define REP_MIXE 0
#endif
#define LAS __attribute__((address_space(3)))
#define GAS __attribute__((address_space(1)))
typedef unsigned short bf16_t;
typedef short bf16x8 __attribute__((ext_vector_type(8)));
typedef float f32x4 __attribute__((ext_vector_type(4)));
typedef float f32x2 __attribute__((ext_vector_type(2)));
typedef unsigned u32x4 __attribute__((ext_vector_type(4)));
typedef unsigned u32x2 __attribute__((ext_vector_type(2)));

constexpr int NB = 4, LSEQ = 4096, DM = 1024, NCTX = 256, SU = NCTX + LSEQ  , MTOK = NB * SU  , DEPTH = 4;
constexpr int EV_N = 3072, OD_N = 5120, NEXP = 32, FF = 512;
constexpr int NCHUNK = SU / 128;
constexpr float EPS = 1e-6f;
constexpr int LIST_CAP = MTOK;
constexpr int MOE_MAXROWS = 43008;

constexpr size_t MiB = 1u << 20;
constexpr size_t WS_CTL = 0, CTL_ZERO_BYTES = 1 * MiB;
constexpr size_t WS_MOD = 1 * MiB;
constexpr size_t WS_LB = 1 * MiB + 512 * 1024;
constexpr size_t WS_ROPEC = WS_LB + 16384;
constexpr size_t WS_ROPES = WS_ROPEC + 8192;
constexpr size_t WS_W = 2 * MiB;
constexpr size_t WS_W_EVIN = WS_W;
constexpr size_t WS_W_EVOUT = WS_W + 12 * MiB;
constexpr size_t WS_W_ODIN = WS_W + 16 * MiB;
constexpr size_t WS_W_ODOUT = WS_W + 36 * MiB;
constexpr size_t WS_W_MOE = WS_W + 40 * MiB;
constexpr size_t WS_XRES = 426 * MiB;
constexpr size_t WS_HB = 494 * MiB;
constexpr size_t WS_YB16 = 528 * MiB;
constexpr size_t WS_R = 562 * MiB;
constexpr size_t WS_PE = WS_R;
constexpr size_t WS_ST = WS_R + 102 * MiB;
constexpr size_t WS_PQ = WS_R, WS_PI = WS_R + 34 * MiB, WS_PG = WS_R + 68 * MiB;
constexpr size_t WS_FF = WS_R + 102 * MiB, WS_FB = WS_R + 170 * MiB, WS_OF = WS_R + 238 * MiB, WS_OB = WS_R + 306 * MiB;
constexpr size_t WS_LIST = WS_R;
constexpr size_t WS_TOKINFO = WS_R + 5 * MiB;
constexpr size_t WS_ACT = WS_R + 6 * MiB;
constexpr size_t WS_YB = WS_R + 50 * MiB;
constexpr size_t WS_YN = WS_R + 140 * MiB;
constexpr size_t WS_END = 936 * MiB;
constexpr size_t WS_SP = 256 * 1024;
constexpr int SP_NORMW = 0, SP_FNORMW = 8192, SP_WG = 9216, SP_BG = 25600, SP_WE = 25616, SP_BE = 156688, SP_DECAY = 156816, SP_SINK = 156832, SP_HGNW = 156840, SP_END = 157096;
static_assert(WS_SP + (size_t)SP_END * 4 <= CTL_ZERO_BYTES, "small parameters fit in the control MiB");
constexpr int CW_BAR = 4096;
constexpr int CW_CNT = 8192;

constexpr int RING_BYTES = 150528;
constexpr int LDSCTL_OFF = RING_BYTES, MISC_OFF = LDSCTL_OFF + 320;
constexpr int LDS_BYTES = RING_BYTES + 4096;
constexpr int NWAVES = 8;

typedef __bf16 bf16v2_t __attribute__((ext_vector_type(2)));
__device__ __forceinline__ unsigned pk2(float lo, float hi) { const f32x2 v = {lo, hi}; const bf16v2_t r = __builtin_convertvector(v, bf16v2_t); return __builtin_bit_cast(unsigned, r); }
__device__ __forceinline__ unsigned f2bf(float f) { return pk2(f, f) & 0xffffu; }
__device__ __forceinline__ float bf2f(unsigned h) { return __builtin_bit_cast(float, h << 16); }
__device__ __forceinline__ float bflo(unsigned w) { return __builtin_bit_cast(float, w << 16); }
__device__ __forceinline__ float bfhi(unsigned w) { return __builtin_bit_cast(float, w & 0xffff0000u); }
__device__ __forceinline__ float shx(float v, int o, int lane) { return __builtin_bit_cast(float, __builtin_amdgcn_ds_bpermute((lane ^ o) << 2, __builtin_bit_cast(int, v))); }
__device__ __forceinline__ int shup_i(int v, int o, int lane) { return __builtin_amdgcn_ds_bpermute((lane - o) << 2, v); }
__device__ __forceinline__ int shidx_i(int v, int src) { return __builtin_amdgcn_ds_bpermute(src << 2, v); }
__device__ __forceinline__ float wave_sum(float v, int lane) {
#pragma unroll
    for (int o = 1; o < 64; o <<= 1) v += shx(v, o, lane);
    return v;
}
__device__ __forceinline__ float siluf(float x) { return x / (1.0f + __expf(-x)); }
#define LDS_WAIT() asm volatile("s_waitcnt lgkmcnt(0)" ::: "memory")
#define VM_WAIT() asm volatile("s_waitcnt vmcnt(0)" ::: "memory")

namespace pg8 {
constexpr int BM = 256, BK = 64, HALF = 128, HTB = HALF * BK * 2, STAGE_BYTES = 8 * HTB, NXCD = 8, WGM = 8;
__host__ __device__ __forceinline__ int lds_byte(int r, int c) { const int st = (r >> 4) * 2 + (c >> 5), rr = r & 15, cc = c & 31, ob = rr * 64 + cc * 2; return st * 1024 + (ob ^ (((ob >> 9) & 1) << 5)); }
__host__ __device__ __forceinline__ void stage_rc(int b, int& R, int& C) { const int st = b / 1024, sb = b % 1024, swz = sb ^ (((sb >> 9) & 1) << 5); R = (st >> 1) * 16 + swz / 64; C = (st & 1) * 32 + (swz % 64) / 2; }
__host__ __device__ __forceinline__ int perm32(int rho) { const int n = rho >> 4, i = rho & 15; return 8 * (i >> 2) + 4 * n + (i & 3); }

struct Unit { int pm, pn, e, cnt, tile; };

__device__ __forceinline__ int xcd_remap(int L, int nwg) { const int q = nwg / NXCD, r = nwg % NXCD, xcd = L % NXCD, off = L / NXCD; return (xcd < r ? xcd * (q + 1) : r * (q + 1) + (xcd - r) * q) + off; }

struct StaticOrder {
    int nM, nN, nwg, G, c, skipctx;
    __device__ void init(int M, int N, int G_, int c_, int skip_ = 0) { skipctx = skip_; nM = skip_ ? 64 : M / BM; nN = N / BM; nwg = nM * nN; G = G_; c = c_; }
    __device__ bool next(int i, Unit& u) const {
        const long L = (long)i * G + c; if (L >= nwg) return false;
        const int wgid = xcd_remap((int)L, nwg);
        const int nig = WGM * nN, gid = wgid / nig, fm = gid * WGM, gsz = (nM - fm) < WGM ? (nM - fm) : WGM;
        u.pm = fm + ((wgid % nig) % gsz); u.pn = (wgid % nig) / gsz; u.e = 0; u.cnt = 0; u.tile = 0;
        if (skipctx) u.pm = u.pm + u.pm / 16 + 1;
        return true;
    }
};
struct MoeOrder {
    const LAS int* tstart; const LAS int* cnts; int ntiles, G, c;
    __device__ bool next(int i, Unit& u) const {
        const int nwg = ntiles * 4; const long L = (long)i * G + c; if (L >= nwg) return false;
        const int wgid = xcd_remap((int)L, nwg);
        const int tile = wgid >> 2; u.pn = wgid & 3; u.tile = tile;
        int e = 0;
        for (int k = 1; k < NEXP; ++k) e += (tstart[k] <= tile) ? 1 : 0;
        u.e = e; u.pm = tile - tstart[e]; u.cnt = cnts[e]; return true;
    }
};

struct PlainAddr {
    static constexpr bool GATHER = false;
    const bf16_t* A; const bf16_t* Bt; int K;
    __device__ __forceinline__ void base(const Unit& u, const char*& cA, const char*& cB) const { cA = (const char*)(A + (size_t)u.pm * BM * K); cB = (const char*)(Bt + (size_t)u.pn * BM * K); }
    __device__ __forceinline__ void rows(const Unit&, const int (&)[2], const int (&)[2], unsigned (&)[2], unsigned (&)[2]) const {}
};
struct MoeGatherAddr {
    static constexpr bool GATHER = true;
    const bf16_t* HB; const bf16_t* Wbase; const unsigned* list; int K;
    __device__ __forceinline__ void base(const Unit& u, const char*& cA, const char*& cB) const { cA = (const char*)HB; cB = (const char*)Wbase + (size_t)u.e * (3u << 20) + (size_t)u.pn * BM * K * 2; }
    __device__ __forceinline__ void rows(const Unit& u, const int (&R)[2], const int (&C)[2], unsigned (&v0)[2], unsigned (&v1)[2]) const {
        const unsigned* lp = list + (size_t)u.e * LIST_CAP;
#pragma unroll
        for (int i = 0; i < 2; ++i) {
            int i0 = u.pm * BM + R[i], i1 = i0 + HALF; const int mx = u.cnt - 1; i0 = i0 < mx ? i0 : mx; i1 = i1 < mx ? i1 : mx;
            const unsigned t0 = __hip_atomic_load(lp + i0, __ATOMIC_RELAXED, __HIP_MEMORY_SCOPE_AGENT), t1 = __hip_atomic_load(lp + i1, __ATOMIC_RELAXED, __HIP_MEMORY_SCOPE_AGENT);
            v0[i] = (t0 * (unsigned)K + (unsigned)C[i]) * 2u; v1[i] = (t1 * (unsigned)K + (unsigned)C[i]) * 2u;
        }
    }
};
struct MoeActAddr {
    static constexpr bool GATHER = false;
    const bf16_t* Act; const bf16_t* Wbase; int K;
    __device__ __forceinline__ void base(const Unit& u, const char*& cA, const char*& cB) const { cA = (const char*)(Act + (size_t)u.tile * BM * K); cB = (const char*)Wbase + (size_t)u.e * (3u << 20) + (size_t)u.pn * BM * K * 2; }
    __device__ __forceinline__ void rows(const Unit&, const int (&)[2], const int (&)[2], unsigned (&)[2], unsigned (&)[2]) const {}
};

__device__ __forceinline__ unsigned cvt_pk_bf16(float lo, float hi) { unsigned r; asm volatile("v_cvt_pk_bf16_f32 %0, %1, %2" : "=v"(r) : "v"(lo), "v"(hi)); return r; }

template <class Epi, class Sched, class Addr>
__device__ __forceinline__ void gemm_phase(LAS unsigned char* lds, const Addr& AD, const Sched& S, const Epi& E, const int K) {
    int tid = threadIdx.x; asm volatile("" : "+v"(tid));
    const int wid = __builtin_amdgcn_readfirstlane(tid >> 6), lane = tid & 63, wr = wid >> 2, wc = wid & 3, fr = lane & 15, fq = lane >> 4;
    const int nt = K / BK;
    int sR[2], sC[2]; unsigned voffA[2], voffB[2];
#pragma unroll
    for (int i = 0; i < 2; ++i) { int R, C; stage_rc(tid * 16 + i * 8192, R, C); sR[i] = R; sC[i] = C; const int Rb = Epi::PERM ? ((R & ~31) + perm32(R & 31)) : R; voffA[i] = (unsigned)(R * K + C) * 2u; voffB[i] = (unsigned)(Rb * K + C) * 2u; }
    const size_t kstep = (size_t)(BK * 2);
    const size_t hstep = (size_t)HALF * K * 2;
    const unsigned ldsw = (unsigned)wid * 1024u;
    const int aoff = lds_byte(wr * 64 + fr, fq * 8), boff = lds_byte(wc * 32 + fr, fq * 8);
#define PG8_SA(b, h) (((b) * 2 + (h)) * HTB)
#define PG8_SB(b, h) ((4 + (b) * 2 + (h)) * HTB)
#define PG8_STAGE(bufoff, gbase, voff) do { _Pragma("unroll") for (int _i = 0; _i < 2; ++_i) \
        __builtin_amdgcn_global_load_lds((const unsigned*)((const char*)(gbase) + (voff)[_i]), (LAS unsigned*)(lds + (bufoff) + ldsw + _i * 8192), 16, 0, 0); } while (0)
#define PG8_LDA(dst, b, h) do { _Pragma("unroll") for (int m = 0; m < 4; ++m) _Pragma("unroll") for (int k = 0; k < 2; ++k) dst[m][k] = *(const LAS bf16x8*)(lds + PG8_SA(b, h) + aoff + m * 2048 + k * 1024); } while (0)
#define PG8_LDB(dst, b, h) do { _Pragma("unroll") for (int n = 0; n < 2; ++n) _Pragma("unroll") for (int k = 0; k < 2; ++k) dst[n][k] = *(const LAS bf16x8*)(lds + PG8_SB(b, h) + boff + n * 2048 + k * 1024); } while (0)
#define PG8_MMA(ai, bj, At, Bt) do { __builtin_amdgcn_s_setprio(1); _Pragma("unroll") for (int m = 0; m < 4; ++m) _Pragma("unroll") for (int n = 0; n < 2; ++n) _Pragma("unroll") for (int k = 0; k < 2; ++k) \
        acc[ai][bj][m][n] = __builtin_amdgcn_mfma_f32_16x16x32_bf16(Bt[n][k], At[m][k], acc[ai][bj][m][n], 0, 0, 0); __builtin_amdgcn_s_setprio(0); } while (0)
#define PG8_WAIT_V(n) asm volatile("s_waitcnt vmcnt(" #n ")" ::: "memory")
#define PG8_WAIT_L(n) asm volatile("s_waitcnt lgkmcnt(" #n ")" ::: "memory")
#define PG8_BAR __builtin_amdgcn_s_barrier()
#define PG8_SCHED __builtin_amdgcn_sched_barrier(0)
    Unit cur, nxt; int ui = 0;
    if (!S.next(0, cur)) return;
    f32x4 acc[2][2][4][2];
#pragma unroll
    for (int a = 0; a < 2; ++a)
#pragma unroll
        for (int b = 0; b < 2; ++b)
#pragma unroll
            for (int m = 0; m < 4; ++m)
#pragma unroll
                for (int n = 0; n < 2; ++n) acc[a][b][m][n] = (f32x4){0.f, 0.f, 0.f, 0.f};
    bf16x8 At[4][2], B0[2][2], B1[2][2];
    const char* cA; const char* cB; unsigned cv0[2] = {voffA[0], voffA[1]}, cv1[2] = {voffA[0], voffA[1]};
    AD.base(cur, cA, cB); AD.rows(cur, sR, sC, cv0, cv1);
    const size_t ah = Addr::GATHER ? (size_t)0 : hstep;
    PG8_STAGE(PG8_SB(0, 0), cB, voffB); PG8_STAGE(PG8_SB(0, 1), cB + hstep, voffB); PG8_STAGE(PG8_SA(0, 0), cA, cv0); PG8_STAGE(PG8_SA(0, 1), cA + ah, cv1);
    if (wr == 1) PG8_BAR;
    PG8_WAIT_V(2); PG8_BAR;
    PG8_STAGE(PG8_SB(1, 0), cB + kstep, voffB); PG8_STAGE(PG8_SA(1, 0), cA + kstep, cv0); PG8_STAGE(PG8_SB(1, 1), cB + hstep + kstep, voffB);
    PG8_WAIT_V(6); PG8_BAR;
    for (;;) {
        const bool has_next = S.next(ui + 1, nxt);
        const char* nA = cA; const char* nB = cB; unsigned nv0[2] = {cv0[0], cv0[1]}, nv1[2] = {cv1[0], cv1[1]};
        if (has_next) { AD.base(nxt, nA, nB); AD.rows(nxt, sR, sC, nv0, nv1); }
        for (int t = 0; t < nt; t += 2) {
            const bool last = (t == nt - 2);
            const char* a1 = cA + (size_t)(t + 1) * kstep;
            const char* a2 = last ? nA : cA + (size_t)(t + 2) * kstep; const char* b2 = last ? nB : cB + (size_t)(t + 2) * kstep;
            const char* a3 = a2 + kstep; const char* b3 = b2 + kstep;
            unsigned x0[2] = {cv0[0], cv0[1]}, x1[2] = {cv1[0], cv1[1]};
            if constexpr (Addr::GATHER) { if (last) { x0[0] = nv0[0]; x0[1] = nv0[1]; x1[0] = nv1[0]; x1[1] = nv1[1]; } }
            PG8_LDB(B0, 0, 0); PG8_LDB(B1, 0, 1); PG8_SCHED; PG8_LDA(At, 0, 0); PG8_STAGE(PG8_SA(1, 1), a1 + ah, cv1);
            PG8_WAIT_V(8); PG8_WAIT_L(0); PG8_BAR; PG8_MMA(0, 0, At, B0); PG8_MMA(0, 1, At, B1); PG8_BAR; PG8_SCHED;
            PG8_LDA(At, 0, 1); PG8_STAGE(PG8_SB(0, 0), b2, voffB); PG8_STAGE(PG8_SB(0, 1), b2 + hstep, voffB); PG8_STAGE(PG8_SA(0, 0), a2, x0);
            PG8_WAIT_V(8); PG8_WAIT_L(0); PG8_BAR; PG8_MMA(1, 0, At, B0); PG8_MMA(1, 1, At, B1); PG8_BAR; PG8_SCHED;
            PG8_LDB(B0, 1, 0); PG8_LDB(B1, 1, 1); PG8_SCHED; PG8_LDA(At, 1, 0); PG8_STAGE(PG8_SA(0, 1), a2 + ah, x1);
            PG8_WAIT_V(8); PG8_WAIT_L(0); PG8_BAR; PG8_MMA(0, 0, At, B0); PG8_MMA(0, 1, At, B1); PG8_BAR; PG8_SCHED;
            PG8_LDA(At, 1, 1); PG8_STAGE(PG8_SB(1, 0), b3, voffB); PG8_STAGE(PG8_SB(1, 1), b3 + hstep, voffB); PG8_STAGE(PG8_SA(1, 0), a3, x0);
            PG8_WAIT_V(8); PG8_WAIT_L(0); PG8_BAR; PG8_MMA(1, 0, At, B0); PG8_MMA(1, 1, At, B1); PG8_BAR; PG8_SCHED;
        }
        if (wr == 0) PG8_BAR;
        E(acc, cur, wr, wc, fr, fq);
        if (!has_next) break;
#pragma unroll
        for (int a = 0; a < 2; ++a)
#pragma unroll
            for (int b = 0; b < 2; ++b)
#pragma unroll
                for (int m = 0; m < 4; ++m)
#pragma unroll
                    for (int n = 0; n < 2; ++n) acc[a][b][m][n] = (f32x4){0.f, 0.f, 0.f, 0.f};
        cur = nxt; cA = nA; cB = nB; cv0[0] = nv0[0]; cv0[1] = nv0[1]; cv1[0] = nv1[0]; cv1[1] = nv1[1]; ++ui;
        if (wr == 1) PG8_BAR;
    }
    PG8_WAIT_V(0);
    PG8_BAR;
#undef PG8_SA
#undef PG8_SB
#undef PG8_STAGE
#undef PG8_LDA
#undef PG8_LDB
#undef PG8_MMA
#undef PG8_WAIT_V
#undef PG8_WAIT_L
#undef PG8_BAR
#undef PG8_SCHED
}
}

#define XB_TMO      128
#define XB_XCNT(j)  (256  + 64 * (j))
#define XB_XSUB(j)  (1280 + 64 * (j))
#define XB_XGEN(j)  (2304 + 64 * (j))
#define XB_TOP      3328
#define XB_TOPGEN   3392
#define XCD_BAR_WORDS 3456
#define XB_SPIN_CAP (1u << 20)
__device__ __forceinline__ unsigned xb_ld(unsigned* p)              { return __hip_atomic_load((GAS unsigned*)p, __ATOMIC_RELAXED, __HIP_MEMORY_SCOPE_AGENT); }
__device__ __forceinline__ unsigned xb_add(unsigned* p, unsigned v) { return __hip_atomic_fetch_add((GAS unsigned*)p, v, __ATOMIC_RELAXED, __HIP_MEMORY_SCOPE_AGENT); }
__device__ __forceinline__ unsigned xb_xcc_id() { return (unsigned)__builtin_amdgcn_s_getreg((3 << 11) | 20) & 0xFu; }
#define XB_SPIN(cond, bar) do { unsigned _sp = 0; while (cond) { __builtin_amdgcn_s_sleep(1); \
    if ((++_sp & 255u) == 0u) { if (xb_ld(&(bar)[XB_TMO])) break; if (_sp > XB_SPIN_CAP) { xb_add(&(bar)[XB_TMO], 1u); break; } } } } while (0)
struct XcdBarrier { unsigned* bar; unsigned x; volatile LAS unsigned* st; };
__device__ __forceinline__ XcdBarrier xcd_barrier_post(unsigned* bar, volatile LAS unsigned* st) {
    XcdBarrier b; b.bar = bar; b.x = xb_xcc_id(); b.st = st;
    if (threadIdx.x == 0) (void)xb_add(&bar[XB_XCNT(b.x)], 1u);
    return b;
}
__device__ __forceinline__ void xcd_barrier_complete(unsigned* bar, unsigned x, unsigned& nloc, unsigned& nx) {
    const unsigned G = gridDim.x * gridDim.y * gridDim.z;
    unsigned sum, cnt, mine, sp = 0u;
    for (;;) {
        sum = 0u; cnt = 0u; mine = 0u;
#pragma unroll
        for (unsigned j = 0; j < 16; ++j) { const unsigned c = xb_ld(&bar[XB_XCNT(j)]); sum += c; cnt += (c > 0u) ? 1u : 0u; }
        mine = xb_ld(&bar[XB_XCNT(x)]);
        if (sum == G) break;
        __builtin_amdgcn_s_sleep(1);
        if ((++sp & 255u) == 0u) { if (xb_ld(&bar[XB_TMO])) break; if (sp > XB_SPIN_CAP) { xb_add(&bar[XB_TMO], 1u); break; } }
    }
    nloc = mine > 0u ? mine : 1u; nx = cnt > 0u ? cnt : 1u;
}
__device__ __forceinline__ void xcd_barrier(const XcdBarrier& b) {
    asm volatile("s_waitcnt vmcnt(0)" ::: "memory");
    __syncthreads();
    if (threadIdx.x == 0) {
        unsigned* bar = b.bar; asm volatile("" : "+s"(bar));
        __builtin_amdgcn_s_waitcnt(0);
        unsigned nloc = b.st[0], nx = b.st[1];
        if (nloc == 0u) { xcd_barrier_complete(bar, b.x, nloc, nx); b.st[0] = nloc; b.st[1] = nx; }
        const unsigned old = xb_add(&bar[XB_XSUB(b.x)], 1u);
        const unsigned gen = old / nloc;
        if (old + 1u == (gen + 1u) * nloc) {
            __builtin_amdgcn_fence(__ATOMIC_RELEASE, "agent");
            asm volatile("s_waitcnt vmcnt(0)" ::: "memory");
            const unsigned og = xb_add(&bar[XB_TOP], 1u);
            const unsigned tg = og / nx;
            if (og + 1u == (tg + 1u) * nx) xb_add(&bar[XB_TOPGEN], 1u);
            else XB_SPIN(xb_ld(&bar[XB_TOPGEN]) == tg, bar);
            __builtin_amdgcn_fence(__ATOMIC_ACQUIRE, "agent");
            xb_add(&bar[XB_XGEN(b.x)], 1u);
            asm volatile("s_waitcnt vmcnt(0)" ::: "memory");
        } else {
            XB_SPIN(xb_ld(&bar[XB_XGEN(b.x)]) == gen, bar);
            __builtin_amdgcn_fence(__ATOMIC_ACQUIRE, "agent");
            asm volatile("s_waitcnt vmcnt(0)" ::: "memory");
        }
    }
    __syncthreads();
}

__device__ __forceinline__ int ftid() { int t = (int)threadIdx.x; asm volatile("" : "+v"(t)); return t; }
__device__ __forceinline__ int flane() { return ftid() & 63; }
__device__ __forceinline__ int fbid() { int b = (int)blockIdx.x; asm volatile("" : "+s"(b)); return b; }
struct Args { const float* in[23]; float* out; unsigned char* ws; int ph_lo, ph_hi; };
struct Frame {
    LAS unsigned char* lds;
    volatile LAS unsigned* MISC;
    unsigned* ctl;
    unsigned char* ws;
    int wave, vcu, G;
};
enum { I_X = 0, I_C, I_CTX, I_CCTX, I_ADAW, I_ADAB, I_NORMW, I_FNORMW, I_EVWIN, I_EVWOUT, I_RETDECAY, I_SINK, I_ODWIN, I_ODWOUT, I_LBLOG, I_HGNW,
       I_WG, I_BG, I_WE, I_BE, I_W1, I_W3, I_W2 };

__device__ __forceinline__ void conv_item(const float* srcp, int src_ld, bf16_t* WT, int K, int n0, int k0, LAS float* scr, int lane) {
#pragma unroll 8
    for (int i = 0; i < 32; ++i) { const int kk = 2 * i + (lane >> 5); scr[kk * 33 + (lane & 31)] = srcp[(size_t)(k0 + kk) * src_ld]; }
    LDS_WAIT(); asm volatile("" ::: "memory");
    const int c = lane & 7;
#pragma unroll
    for (int j = 0; j < 4; ++j) { const int n = (lane >> 3) + 8 * j; const LAS float* s = scr + (8 * c) * 33 + n;
        u32x4 o; o.x = pk2(s[0 * 33], s[1 * 33]); o.y = pk2(s[2 * 33], s[3 * 33]); o.z = pk2(s[4 * 33], s[5 * 33]); o.w = pk2(s[6 * 33], s[7 * 33]);
        *(u32x4*)(WT + (size_t)(n0 + n) * K + k0 + 8 * c) = o; }
    LDS_WAIT(); asm volatile("" ::: "memory");
}
__device__ __forceinline__ int head_perm(int n) { const int hh = n >> 7, phi = n & 127, g = phi >> 3, u = phi & 7; return hh * 128 + 64 * (g >> 3) + 4 * (g & 7) + (u & 3) + 32 * (u >> 2); }

__device__ __forceinline__ void p0_prologue(Frame& F, const Args& args) {
    LAS float* scr = (LAS float*)(F.lds + F.wave * 16384);
    const int gw = F.vcu * NWAVES + F.wave, NGW = F.G * NWAVES, lane = flane();
    constexpr int NI_EVIN = 16 * (EV_N / 32), NI_ODIN = 16 * (OD_N / 32), NI_OUT = 16 * 32, NI_W13 = 16 * 32, NI_W2 = 8 * 32;
    constexpr int NI_MOE1 = NI_W13 + NI_W2;
    constexpr int NITEMS = 2 * NI_EVIN + 2 * NI_ODIN + 4 * NI_OUT + DEPTH * NEXP * NI_MOE1;
    for (int rep_ = 0; rep_ <= REP_CONV; ++rep_)
    for (int it = gw; it < NITEMS; it += NGW) {
        int r = it;
        if (r < 2 * NI_EVIN) { const int p = r / NI_EVIN; r %= NI_EVIN; const int nblk = EV_N / 32, kb = r / nblk, nb = r % nblk; const int n = nb * 32 + (lane & 31);
            conv_item(args.in[I_EVWIN] + (size_t)p * DM * EV_N + head_perm(n), EV_N, (bf16_t*)(F.ws + WS_W_EVIN + (size_t)p * 6 * MiB), DM, nb * 32, kb * 64, scr, lane); continue; }
        r -= 2 * NI_EVIN;
        if (r < 2 * NI_ODIN) { const int p = r / NI_ODIN; r %= NI_ODIN; const int nblk = OD_N / 32, kb = r / nblk, nb = r % nblk; const int n = nb * 32 + (lane & 31);
            conv_item(args.in[I_ODWIN] + (size_t)p * DM * OD_N + head_perm(n), OD_N, (bf16_t*)(F.ws + WS_W_ODIN + (size_t)p * 10 * MiB), DM, nb * 32, kb * 64, scr, lane); continue; }
        r -= 2 * NI_ODIN;
        if (r < 4 * NI_OUT) { const int q = r / NI_OUT; r %= NI_OUT; const int kb = r / 32, nb = r % 32; const int n = nb * 32 + (lane & 31);
            const float* src = (q < 2 ? args.in[I_EVWOUT] + (size_t)q * DM * DM : args.in[I_ODWOUT] + (size_t)(q - 2) * DM * DM);
            bf16_t* dst = (bf16_t*)(F.ws + (q < 2 ? WS_W_EVOUT + (size_t)q * 2 * MiB : WS_W_ODOUT + (size_t)(q - 2) * 2 * MiB));
            conv_item(src + n, DM, dst, DM, nb * 32, kb * 64, scr, lane); continue; }
        r -= 4 * NI_OUT;
        { const int le = r / NI_MOE1; r %= NI_MOE1;
            bf16_t* dst = (bf16_t*)(F.ws + WS_W_MOE + (size_t)le * 3 * MiB);
            if (r < NI_W13) { const int kb = r / 32, nb = r % 32; const int n = nb * 32 + (lane & 31);
                const int Gq = n >> 3, u = n & 7; const float* src = (u < 4 ? args.in[I_W1] : args.in[I_W3]) + (size_t)le * DM * FF + 4 * Gq + (u & 3);
                conv_item(src, FF, dst, DM, nb * 32, kb * 64, scr, lane); }
            else { r -= NI_W13; const int kb = r / 32, nb = r % 32; const int n = nb * 32 + (lane & 31);
                conv_item(args.in[I_W2] + (size_t)le * FF * DM + n, DM, dst + (size_t)DM * DM, FF, nb * 32, kb * 64, scr, lane); }
        }
    }
    {
        f32x4* xr = (f32x4*)(F.ws + WS_XRES);
        const f32x4* xs = (const f32x4*)args.in[I_X]; const f32x4* cs = (const f32x4*)args.in[I_CTX];
        const size_t total = (size_t)MTOK * 256;
        for (size_t i = (size_t)fbid() * 512 + ftid(); i < total; i += (size_t)F.G * 512) {
            const int row = (int)(i >> 8), c4 = (int)(i & 255); const int b = row / SU, p = row % SU;
            xr[i] = (p < NCTX) ? cs[((size_t)(b * NCTX + p) << 8) + c4] : xs[((size_t)(b * LSEQ + p - NCTX) << 8) + c4];
        }
    }
    if (NAIVE_COPY) { float* xr2 = (float*)(F.ws + WS_XRES);
        for (size_t i = (size_t)fbid() * 512 + ftid(); i < (size_t)MTOK * DM; i += (size_t)F.G * 512) { const size_t row = i / DM; const int k = (int)(i % DM); const int b = (int)(row / SU), p = (int)(row % SU);
            xr2[i] = p < NCTX ? args.in[I_CTX][((size_t)b * NCTX + p) * DM + k] : args.in[I_X][((size_t)b * LSEQ + (p - NCTX)) * DM + k]; } }
    {
        float* sp = (float*)(F.ws + WS_SP);
        for (int i = fbid() * 512 + ftid(); i < SP_END; i += F.G * 512) {
            float v;
            if (i < SP_FNORMW) v = args.in[I_NORMW][i]; else if (i < SP_WG) v = args.in[I_FNORMW][i - SP_FNORMW]; else if (i < SP_BG) v = args.in[I_WG][i - SP_WG]; else if (i < SP_WE) v = args.in[I_BG][i - SP_BG];
            else if (i < SP_BE) v = args.in[I_WE][i - SP_WE]; else if (i < SP_DECAY) v = args.in[I_BE][i - SP_BE]; else if (i < SP_SINK) v = args.in[I_RETDECAY][i - SP_DECAY]; else if (i < SP_HGNW) v = args.in[I_SINK][i - SP_SINK]; else v = args.in[I_HGNW][i - SP_HGNW];
            sp[i] = v;
        }
    }
    if (blockIdx.x == 0) {
        float* lb = (float*)(F.ws + WS_LB); const float* lg = args.in[I_LBLOG];
        for (int c = ftid(); c < DM; c += 512) {
            const float a0 = lg[c], a1 = lg[DM + c], a2 = lg[2 * DM + c], a3 = lg[3 * DM + c];
            const float mx = fmaxf(fmaxf(a0, a1), fmaxf(a2, a3));
            const float e0 = expf(a0 - mx), e1 = expf(a1 - mx), e2 = expf(a2 - mx), e3 = expf(a3 - mx); const float inv = 1.0f / (e0 + e1 + e2 + e3);
            lb[c] = 0.f; lb[DM + c] = e1 * inv; lb[2 * DM + c] = (e1 + e2) * inv; lb[3 * DM + c] = (e1 + e2 + e3) * inv;
        }
    }
    if (blockIdx.x == 1) {
        float* rc = (float*)(F.ws + WS_ROPEC); float* rs = (float*)(F.ws + WS_ROPES);
        for (int i = ftid(); i < 64 * 32; i += 512) { const int pos = i >> 5, fi = i & 31;
            const float invf = powf(10000.0f, -(float)(2 * fi) / 64.0f); const float ang = (float)pos * invf;
            rc[i] = cosf(ang); rs[i] = sinf(ang); }
    }
    {
        __syncthreads();
        LAS float* sv = (LAS float*)F.lds;
        LAS float* part = (LAS float*)(F.lds + 20480);
        for (int i = ftid(); i < 5 * DM; i += 512) { const int r = i >> 10, k = i & 1023; const float v = (r < 4) ? args.in[I_C][r * DM + k] : args.in[I_CCTX][k]; sv[i] = siluf(v); }
        __syncthreads();
        float* mod = (float*)(F.ws + WS_MOD);
        for (int it = fbid(); it < DEPTH * 96; it += F.G) {
            const int l = it / 96, cg = it % 96; const int col = cg * 64 + lane;
            const float* w = args.in[I_ADAW] + (size_t)l * DM * 6144 + col;
            float a[5] = {0.f, 0.f, 0.f, 0.f, 0.f};
            const int k0 = F.wave * 128;
#pragma unroll 8
            for (int k = 0; k < 128; ++k) { const float wv = w[(size_t)(k0 + k) * 6144];
#pragma unroll
                for (int r = 0; r < 5; ++r) a[r] += sv[r * DM + k0 + k] * wv; }
#pragma unroll
            for (int r = 0; r < 5; ++r) part[(F.wave * 5 + r) * 64 + lane] = a[r];
            __syncthreads();
            if (ftid() < 320) { const int r = ftid() >> 6, c = ftid() & 63; float s = 0.f;
#pragma unroll
                for (int w8 = 0; w8 < 8; ++w8) s += part[(w8 * 5 + r) * 64 + c];
                mod[((size_t)l * 5 + r) * 6144 + cg * 64 + c] = s + args.in[I_ADAB][l * 6144 + cg * 64 + c]; }
            __syncthreads();
        }
    }
}

__device__ __forceinline__ int moe_tile_prefix(const unsigned* cnt, int lane, int& mycnt) {
    const int c = (lane < NEXP) ? (int)__hip_atomic_load(cnt + lane, __ATOMIC_RELAXED, __HIP_MEMORY_SCOPE_AGENT) : 0; mycnt = c;
    const int nt = (c + 255) >> 8; int incl = nt;
#pragma unroll
    for (int o = 1; o < 64; o <<= 1) { const int v = shup_i(incl, o, lane); if (lane >= o) incl += v; }
    return incl - nt;
}

template <bool FINAL>
__device__ __forceinline__ void n1_phase(Frame& F, const Args& args, int l) {
    const int gw = (MUT_A ? fbid() : F.vcu) * NWAVES + F.wave, NGW = F.G * NWAVES, lane = flane();
    float* xres = (float*)(F.ws + WS_XRES);
    const float* mod = (const float*)(F.ws + WS_MOD);
    int tprefix = 0, dummy;
    if (l > 0) tprefix = moe_tile_prefix(F.ctl + CW_CNT + (l - 1) * NEXP, lane, dummy);
    for (int rr_ = 0; rr_ < (MUT_D ? 64 : 9); ++rr_) {
        const int row = MUT_D ? (fbid() * 512 + F.wave * 64 + rr_) : (gw + rr_ * NGW); if (row >= MTOK) continue;
        const int b = row / SU, p = row % SU; const int mrow = (p < NCTX) ? 4 : b;
        if (FINAL && p < NCTX) continue;
        f32x4* xr = (f32x4*)(xres + (size_t)row * DM) + lane;
        f32x4 v[4];
#pragma unroll
        for (int j = 0; j < 4; ++j) v[j] = xr[64 * j];
        if (l > 0 && CONTRIB_MOE) {
            {
                unsigned* tiw = (unsigned*)(F.ws + WS_TOKINFO) + (size_t)row * 8;
                u32x4 t0, t1;
                t0.x = __hip_atomic_load(tiw + 0, __ATOMIC_RELAXED, __HIP_MEMORY_SCOPE_AGENT); t0.y = __hip_atomic_load(tiw + 1, __ATOMIC_RELAXED, __HIP_MEMORY_SCOPE_AGENT);
                t0.z = __hip_atomic_load(tiw + 2, __ATOMIC_RELAXED, __HIP_MEMORY_SCOPE_AGENT); t0.w = __hip_atomic_load(tiw + 3, __ATOMIC_RELAXED, __HIP_MEMORY_SCOPE_AGENT);
                t1.x = __hip_atomic_load(tiw + 4, __ATOMIC_RELAXED, __HIP_MEMORY_SCOPE_AGENT); t1.y = __hip_atomic_load(tiw + 5, __ATOMIC_RELAXED, __HIP_MEMORY_SCOPE_AGENT); t1.z = 0u; t1.w = 0u;
                const int ts0 = shidx_i(tprefix, (int)t0.x), ts1 = shidx_i(tprefix, (int)t0.z);
                const size_t s0 = (size_t)ts0 * 256 + t0.y, s1 = (size_t)ts1 * 256 + t0.w;
                const unsigned gb0 = t1.x, gb1 = t1.y;
                const float g0 = __builtin_bit_cast(float, gb0), g1 = __builtin_bit_cast(float, gb1);
                const u32x2* y0 = (const u32x2*)(F.ws + WS_YB + s0 * (DM * 2)) + lane; const u32x2* y1 = (const u32x2*)(F.ws + WS_YB + s1 * (DM * 2)) + lane;
                const f32x4* gp = (const f32x4*)(mod + ((size_t)(l - 1) * 5 + mrow) * 6144 + 5 * DM) + lane;
                if (NAIVE_MOE) {
                    const f32x4* n0 = (const f32x4*)(F.ws + WS_YN + (size_t)row * 2 * DM * 4) + lane; const f32x4* n1 = n0 + 256;
#pragma unroll
                    for (int j = 0; j < 4; ++j) { const f32x4 g = gp[64 * j]; v[j] = v[j] + g * (n0[64 * j] * g0 + n1[64 * j] * g1); }
                } else {
                if (MUT_B) {
                    const bf16_t* yy0 = (const bf16_t*)(F.ws + WS_YB) + s0 * DM; const bf16_t* yy1 = (const bf16_t*)(F.ws + WS_YB) + s1 * DM;
                    const float* gate = mod + ((size_t)(l - 1) * 5 + mrow) * 6144 + 5 * DM;
#pragma unroll
                    for (int j = 0; j < 4; ++j) { const int k = 4 * lane + 256 * j;
                        v[j].x += gate[k] * (g0 * bf2f(yy0[k]) + g1 * bf2f(yy1[k])); v[j].y += gate[k + 1] * (g0 * bf2f(yy0[k + 1]) + g1 * bf2f(yy1[k + 1]));
                        v[j].z += gate[k + 2] * (g0 * bf2f(yy0[k + 2]) + g1 * bf2f(yy1[k + 2])); v[j].w += gate[k + 3] * (g0 * bf2f(yy0[k + 3]) + g1 * bf2f(yy1[k + 3])); }
                } else {
#pragma unroll
                for (int j = 0; j < 4; ++j) { const u32x2 a = y0[64 * j], c = y1[64 * j]; const f32x4 g = gp[64 * j];
                    v[j].x += g.x * (g0 * bflo(a.x) + g1 * bflo(c.x)); v[j].y += g.y * (g0 * bfhi(a.x) + g1 * bfhi(c.x));
                    v[j].z += g.z * (g0 * bflo(a.y) + g1 * bflo(c.y)); v[j].w += g.w * (g0 * bfhi(a.y) + g1 * bfhi(c.y)); }
                }
                }
                if (!FINAL) {
#pragma unroll
                    for (int j = 0; j < 4; ++j) xr[64 * j] = v[j];
                }
            }
        }
        float s = 0.f;
#pragma unroll
        for (int j = 0; j < 4; ++j) s += (v[j].x * v[j].x + v[j].y * v[j].y) + (v[j].z * v[j].z + v[j].w * v[j].w);
        const float rstd = 1.0f / sqrtf(wave_sum(s, lane) * (1.0f / DM) + EPS);
        if (FINAL) {
            const f32x4* nw = (const f32x4*)((const float*)(F.ws + WS_SP) + SP_FNORMW) + lane;
            f32x4* o = (f32x4*)(args.out + ((size_t)b * LSEQ + (p - NCTX)) * DM) + lane;
#pragma unroll
            for (int j = 0; j < 4; ++j) { const f32x4 w = nw[64 * j]; o[64 * j] = v[j] * rstd * w; }
        } else {
            const f32x4* nw = (const f32x4*)(((const float*)(F.ws + WS_SP) + SP_NORMW) + (size_t)(l * 2 + 0) * DM) + lane;
            const f32x4* sh = (const f32x4*)(mod + ((size_t)l * 5 + mrow) * 6144 + 0 * DM) + lane;
            const f32x4* sc = (const f32x4*)(mod + ((size_t)l * 5 + mrow) * 6144 + 1 * DM) + lane;
            u32x2* o = (u32x2*)(F.ws + WS_HB + (size_t)row * (DM * 2)) + lane;
#pragma unroll
            for (int j = 0; j < 4; ++j) { const f32x4 w = nw[64 * j], a = sh[64 * j], c = sc[64 * j]; const f32x4 h = v[j] * rstd * w * (c + 1.0f) + a;
                u32x2 q; q.x = pk2(h.x, h.y); q.y = pk2(h.z, h.w); o[64 * j] = q; }
        }
    }
}

__device__ __forceinline__ void naive_n1(Frame& F, const Args& args, int l, bool final_) {
    float* xres = (float*)(F.ws + WS_XRES);
    const float* mod = (const float*)(F.ws + WS_MOD);
    for (int row = fbid() * 512 + ftid(); row < MTOK; row += F.G * 512) {
        const int b = row / SU, p = row % SU; const int mrow = (p < NCTX) ? 4 : b;
        if (final_ && p < NCTX) continue;
        float* xr = xres + (size_t)row * DM;
        if (l > 0) {
            const unsigned* cnt = F.ctl + CW_CNT + (l - 1) * NEXP;
            const unsigned* ti = (const unsigned*)(F.ws + WS_TOKINFO) + (size_t)row * 8;
            const unsigned e0 = ti[0], p0 = ti[1], e1 = ti[2], p1 = ti[3]; const float g0 = __builtin_bit_cast(float, ti[4]), g1 = __builtin_bit_cast(float, ti[5]);
            int ts0 = 0, ts1 = 0; for (unsigned e = 0; e < e0; ++e) ts0 += ((int)cnt[e] + 255) / 256; for (unsigned e = 0; e < e1; ++e) ts1 += ((int)cnt[e] + 255) / 256;
            const bf16_t* y0 = (const bf16_t*)(F.ws + WS_YB) + ((size_t)ts0 * 256 + p0) * DM; const bf16_t* y1 = (const bf16_t*)(F.ws + WS_YB) + ((size_t)ts1 * 256 + p1) * DM;
            const float* gate = mod + ((size_t)(l - 1) * 5 + mrow) * 6144 + 5 * DM;
            for (int k = 0; k < DM; ++k) xr[k] = xr[k] + gate[k] * (g0 * bf2f(y0[k]) + g1 * bf2f(y1[k]));
        }
        double ss = 0.0; for (int k = 0; k < DM; ++k) ss += (double)xr[k] * xr[k];
        const float rstd = 1.0f / sqrtf((float)(ss / DM) + EPS);
        if (final_) { float* o = args.out + ((size_t)b * LSEQ + (p - NCTX)) * DM; for (int k = 0; k < DM; ++k) o[k] = xr[k] * rstd * args.in[I_FNORMW][k]; }
        else { bf16_t* hb = (bf16_t*)(F.ws + WS_HB) + (size_t)row * DM; const float* nw = args.in[I_NORMW] + (size_t)(l * 2) * DM; const float* mr = mod + ((size_t)l * 5 + mrow) * 6144;
            for (int k = 0; k < DM; ++k) hb[k] = (bf16_t)f2bf(xr[k] * rstd * nw[k] * (1.0f + mr[DM + k]) + mr[k]); }
    }
}
__device__ __forceinline__ void wave_n1(Frame& F, const Args& args, int l, bool final_) {
    float* xres = (float*)(F.ws + WS_XRES);
    const float* mod = (const float*)(F.ws + WS_MOD);
    const int gw = F.vcu * NWAVES + F.wave, NGW = F.G * NWAVES, lane = flane();
    for (int row = gw; row < MTOK; row += NGW) {
        const int b = row / SU, p = row % SU; const int mrow = (p < NCTX) ? 4 : b;
        if (final_ && p < NCTX) continue;
        float* xr = xres + (size_t)row * DM;
        float xv[16];
#pragma unroll
        for (int i = 0; i < 16; ++i) xv[i] = xr[lane + 64 * i];
        if (l > 0) {
            const unsigned* cnt = F.ctl + CW_CNT + (l - 1) * NEXP;
            const unsigned* ti = (const unsigned*)(F.ws + WS_TOKINFO) + (size_t)row * 8;
            const unsigned e0 = ti[0], p0 = ti[1], e1 = ti[2], p1 = ti[3]; const float g0 = __builtin_bit_cast(float, ti[4]), g1 = __builtin_bit_cast(float, ti[5]);
            int ts0 = 0, ts1 = 0; for (unsigned e = 0; e < e0; ++e) ts0 += ((int)cnt[e] + 255) / 256; for (unsigned e = 0; e < e1; ++e) ts1 += ((int)cnt[e] + 255) / 256;
            const bf16_t* y0 = (const bf16_t*)(F.ws + WS_YB) + ((size_t)ts0 * 256 + p0) * DM; const bf16_t* y1 = (const bf16_t*)(F.ws + WS_YB) + ((size_t)ts1 * 256 + p1) * DM;
            const float* gate = mod + ((size_t)(l - 1) * 5 + mrow) * 6144 + 5 * DM;
#pragma unroll
            for (int i = 0; i < 16; ++i) { const int k = lane + 64 * i; xv[i] = xv[i] + gate[k] * (g0 * bf2f(y0[k]) + g1 * bf2f(y1[k])); if (!final_) xr[k] = xv[i]; }
        }
        float ss = 0.f;
#pragma unroll
        for (int i = 0; i < 16; ++i) ss += xv[i] * xv[i];
        const float rstd = 1.0f / sqrtf(wave_sum(ss, lane) * (1.0f / DM) + EPS);
        if (final_) { float* o = args.out + ((size_t)b * LSEQ + (p - NCTX)) * DM;
#pragma unroll
            for (int i = 0; i < 16; ++i) { const int k = lane + 64 * i; o[k] = xv[i] * rstd * args.in[I_FNORMW][k]; } }
        else { bf16_t* hb = (bf16_t*)(F.ws + WS_HB) + (size_t)row * DM; const float* nw = args.in[I_NORMW] + (size_t)(l * 2) * DM; const float* mr = mod + ((size_t)l * 5 + mrow) * 6144;
#pragma unroll
            for (int i = 0; i < 16; ++i) { const int k = lane + 64 * i; hb[k] = (bf16_t)f2bf(xv[i] * rstd * nw[k] * (1.0f + mr[DM + k]) + mr[k]); } }
    }
}
__device__ __forceinline__ void n2r_phase(Frame& F, const Args& args, int l) {
    const int gw = F.vcu * NWAVES + F.wave, NGW = F.G * NWAVES, lane = flane();
    const float* xres = (const float*)(F.ws + WS_XRES);
    const float* mod = (const float*)(F.ws + WS_MOD);
    unsigned* cnt = F.ctl + CW_CNT + l * NEXP;
    unsigned* list = (unsigned*)(F.ws + WS_LIST);
    const float* wg = ((const float*)(F.ws + WS_SP) + SP_WG) + (size_t)l * DM * 4; const float* bg = ((const float*)(F.ws + WS_SP) + SP_BG) + l * 4;
    const float* we = ((const float*)(F.ws + WS_SP) + SP_WE) + (size_t)l * 4 * DM * 8; const float* be = ((const float*)(F.ws + WS_SP) + SP_BE) + l * 32;
    LAS float* wgT = (LAS float*)F.lds; LAS float* weT = wgT + 4 * DM;
    LAS unsigned* hist = (LAS unsigned*)(F.lds + LDSCTL_OFF + 1024); LAS unsigned* baseL = hist + 32; LAS unsigned* rec = hist + 64 + F.wave * 36;
    __syncthreads();
    if (ftid() < 32) hist[ftid()] = 0u;
    {   const int t = ftid();
        for (int r = t; r < DM; r += 512) { const f32x4 a = *(const f32x4*)(wg + (size_t)r * 4); wgT[r] = a.x; wgT[DM + r] = a.y; wgT[2 * DM + r] = a.z; wgT[3 * DM + r] = a.w; }
        for (int r = t; r < 4 * DM; r += 512) { const int g = r >> 10, c = r & 1023; const f32x4 a = *(const f32x4*)(we + (size_t)r * 8), b2 = *(const f32x4*)(we + (size_t)r * 8 + 4);
            LAS float* d = weT + g * 8 * DM + c; d[0] = a.x; d[DM] = a.y; d[2 * DM] = a.z; d[3 * DM] = a.w; d[4 * DM] = b2.x; d[5 * DM] = b2.y; d[6 * DM] = b2.z; d[7 * DM] = b2.w; }
    }
    __syncthreads();
    for (int k_ = 0; k_ < 9; ++k_) {
        const int row = gw + k_ * NGW; if (row >= MTOK) break;
        const int b = row / SU, p = row % SU; const int mrow = (p < NCTX) ? 4 : b;
        if (l == DEPTH - 1 && p < NCTX) continue;
        const f32x4* xr = (const f32x4*)(xres + (size_t)row * DM) + lane;
        f32x4 v[4]; float s = 0.f;
#pragma unroll
        for (int j = 0; j < 4; ++j) { v[j] = xr[64 * j]; s += (v[j].x * v[j].x + v[j].y * v[j].y) + (v[j].z * v[j].z + v[j].w * v[j].w); }
        const float rstd = 1.0f / sqrtf(wave_sum(s, lane) * (1.0f / DM) + EPS);
        const f32x4* nw = (const f32x4*)(((const float*)(F.ws + WS_SP) + SP_NORMW) + (size_t)(l * 2 + 1) * DM) + lane;
        const f32x4* sh = (const f32x4*)(mod + ((size_t)l * 5 + mrow) * 6144 + 3 * DM) + lane;
        const f32x4* sc = (const f32x4*)(mod + ((size_t)l * 5 + mrow) * 6144 + 4 * DM) + lane;
        u32x2* o = (u32x2*)(F.ws + WS_HB + (size_t)row * (DM * 2)) + lane;
        float gl[4] = {0.f, 0.f, 0.f, 0.f};
#pragma unroll
        for (int j = 0; j < 4; ++j) { const f32x4 w = nw[64 * j], a = sh[64 * j], c = sc[64 * j]; const f32x4 h = v[j] * rstd * w * (c + 1.0f) + a; v[j] = h;
            u32x2 q; q.x = pk2(h.x, h.y); q.y = pk2(h.z, h.w); o[64 * j] = q;
#pragma unroll
            for (int g = 0; g < 4; ++g) { const f32x4 wv = *(const LAS f32x4*)(wgT + g * DM + 4 * lane + 256 * j); gl[g] += (h.x * wv.x + h.y * wv.y) + (h.z * wv.z + h.w * wv.w); } }
#pragma unroll
        for (int g = 0; g < 4; ++g) gl[g] = wave_sum(gl[g], lane) + bg[g];
        int gi = 0; float gm = gl[0];
#pragma unroll
        for (int g = 1; g < 4; ++g) if (gl[g] > gm) { gm = gl[g]; gi = g; }
        const float gp = 1.0f / (expf(gl[0] - gm) + expf(gl[1] - gm) + expf(gl[2] - gm) + expf(gl[3] - gm));
        const LAS float* weg = weT + gi * 8 * DM;
        float el[8] = {0.f, 0.f, 0.f, 0.f, 0.f, 0.f, 0.f, 0.f};
#pragma unroll
        for (int j = 0; j < 4; ++j) {
#pragma unroll
            for (int e = 0; e < 8; ++e) { const f32x4 wv = *(const LAS f32x4*)(weg + e * DM + 4 * lane + 256 * j); el[e] += (v[j].x * wv.x + v[j].y * wv.y) + (v[j].z * wv.z + v[j].w * wv.w); }
        }
#pragma unroll
        for (int e = 0; e < 8; ++e) el[e] = wave_sum(el[e], lane) + be[gi * 8 + e];
        int i0 = 0; float v0 = el[0];
#pragma unroll
        for (int e = 1; e < 8; ++e) if (el[e] > v0) { v0 = el[e]; i0 = e; }
        int i1 = -1; float v1 = -3.0e38f;
#pragma unroll
        for (int e = 0; e < 8; ++e) if (e != i0 && el[e] > v1) { v1 = el[e]; i1 = e; }
        const float w0 = 1.0f / (1.0f + expf(v1 - v0)), w1 = 1.0f - w0;
        if (lane == 0) {
            const unsigned e0 = (unsigned)(gi * 8 + i0), e1 = (unsigned)(gi * 8 + i1);
            const unsigned lp0 = __hip_atomic_fetch_add(hist + e0, 1u, __ATOMIC_RELAXED, __HIP_MEMORY_SCOPE_WORKGROUP), lp1 = __hip_atomic_fetch_add(hist + e1, 1u, __ATOMIC_RELAXED, __HIP_MEMORY_SCOPE_WORKGROUP);
            rec[k_ * 4 + 0] = e0; rec[k_ * 4 + 1] = lp0; rec[k_ * 4 + 2] = e1; rec[k_ * 4 + 3] = lp1;
            u32x4* ti = (u32x4*)(F.ws + WS_TOKINFO) + (size_t)row * 2;
            ti[1] = (u32x4){__builtin_bit_cast(unsigned, gp * w0), __builtin_bit_cast(unsigned, gp * w1), 0u, 0u};
        }
    }
    __syncthreads();
    if (ftid() < 32) { const unsigned hc = hist[ftid()]; baseL[ftid()] = hc ? atomicAdd(cnt + ftid(), hc) : 0u; }
    __syncthreads();
    if (lane == 0) {
        for (int k_ = 0; k_ < 9; ++k_) {
            const int row = gw + k_ * NGW; if (row >= MTOK) break;
            if (l == DEPTH - 1 && (row % SU) < NCTX) continue;
            const unsigned e0 = rec[k_ * 4 + 0], e1 = rec[k_ * 4 + 2]; const unsigned p0 = baseL[e0] + rec[k_ * 4 + 1], p1 = baseL[e1] + rec[k_ * 4 + 3];
            list[(size_t)e0 * LIST_CAP + p0] = (unsigned)row; list[(size_t)e1 * LIST_CAP + p1] = (unsigned)row;
            u32x4* ti = (u32x4*)(F.ws + WS_TOKINFO) + (size_t)row * 2;
            ti[0] = (u32x4){e0, p0, e1, p1};
        }
    }
    __syncthreads();
}

__device__ __forceinline__ void naive_n2r(Frame& F, const Args& args, int l) {
    const float* xres = (const float*)(F.ws + WS_XRES);
    const float* mod = (const float*)(F.ws + WS_MOD);
    unsigned* cnt = F.ctl + CW_CNT + l * NEXP;
    unsigned* list = (unsigned*)(F.ws + WS_LIST);
    const float* wg = args.in[I_WG] + (size_t)l * DM * 4; const float* bg = args.in[I_BG] + l * 4;
    const float* we = args.in[I_WE] + (size_t)l * 4 * DM * 8; const float* be = args.in[I_BE] + l * 32;
    for (int row = fbid() * 512 + ftid(); row < MTOK; row += F.G * 512) {
        const int b = row / SU, p = row % SU; const int mrow = (p < NCTX) ? 4 : b;
        if (l == DEPTH - 1 && p < NCTX) continue;
        const float* xr = xres + (size_t)row * DM; double ss = 0.0;
        for (int k = 0; k < DM; ++k) ss += (double)xr[k] * xr[k];
        const float rstd = 1.0f / sqrtf((float)(ss / DM) + EPS);
        const float* nw = args.in[I_NORMW] + (size_t)(l * 2 + 1) * DM; const float* mr = mod + ((size_t)l * 5 + mrow) * 6144;
        bf16_t* hb = (bf16_t*)(F.ws + WS_HB) + (size_t)row * DM;
        float gl[4] = {bg[0], bg[1], bg[2], bg[3]};
        for (int k = 0; k < DM; ++k) { const float h = xr[k] * rstd * nw[k] * (1.0f + mr[4 * DM + k]) + mr[3 * DM + k]; hb[k] = (bf16_t)f2bf(h);
            gl[0] += h * wg[k * 4 + 0]; gl[1] += h * wg[k * 4 + 1]; gl[2] += h * wg[k * 4 + 2]; gl[3] += h * wg[k * 4 + 3]; }
        int gi = 0; for (int g = 1; g < 4; ++g) if (gl[g] > gl[gi]) gi = g;
        float den = 0.f; for (int g = 0; g < 4; ++g) den += expf(gl[g] - gl[gi]);
        const float gp = 1.0f / den;
        float el[8]; for (int e = 0; e < 8; ++e) el[e] = be[gi * 8 + e];
        for (int k = 0; k < DM; ++k) { const float h = xr[k] * rstd * nw[k] * (1.0f + mr[4 * DM + k]) + mr[3 * DM + k]; const float* wr = we + ((size_t)gi * DM + k) * 8;
#pragma unroll
            for (int e = 0; e < 8; ++e) el[e] += h * wr[e]; }
        int i0 = 0; for (int e = 1; e < 8; ++e) if (el[e] > el[i0]) i0 = e;
        int i1 = (i0 == 0) ? 1 : 0; for (int e = 0; e < 8; ++e) if (e != i0 && el[e] > el[i1]) i1 = e;
        const float m2 = el[i0]; const float a0 = 1.0f, a1 = expf(el[i1] - m2); const float w0 = a0 / (a0 + a1), w1 = a1 / (a0 + a1);
        const unsigned e0 = (unsigned)(gi * 8 + i0), e1 = (unsigned)(gi * 8 + i1);
        const unsigned p0 = atomicAdd(cnt + e0, 1u), p1 = atomicAdd(cnt + e1, 1u);
        list[(size_t)e0 * LIST_CAP + p0] = (unsigned)row; list[(size_t)e1 * LIST_CAP + p1] = (unsigned)row;
        u32x4* ti = (u32x4*)(F.ws + WS_TOKINFO) + (size_t)row * 2;
        ti[0] = (u32x4){e0, p0, e1, p1}; ti[1] = (u32x4){__builtin_bit_cast(unsigned, gp * w0), __builtin_bit_cast(unsigned, gp * w1), 0u, 0u};
    }
}

struct EpiProj {
    static constexpr bool PERM = true;
    unsigned char* ws; const float* lb; int odd;
    __device__ __forceinline__ void operator()(const f32x4 (&acc)[2][2][4][2], const pg8::Unit& u, int wr, int wc, int fr, int fq) const {
        const int pmb = u.pm % 17; const bool isctx = (pmb == 0); const int tbase = (pmb - 1) * 256;
        const int g = 4 * wc + fq, half = g >> 3, f0 = 4 * (g & 7);
        const float* ropec = (const float*)(ws + WS_ROPEC); const float* ropes = (const float*)(ws + WS_ROPES);
#pragma unroll
        for (int bj = 0; bj < 2; ++bj) {
            const int hcol = 256 * u.pn + 128 * bj; const int lc0 = hcol + 64 * half + f0;
            if (!odd) {
                const bool rope = !isctx && (hcol < 1024 || (hcol >= 2048 && hcol < 2816));
                const float scale = (hcol >= 512 && hcol < 1024) ? 0.08838834764831845f : 1.0f;
                bf16_t* dst = (bf16_t*)(ws + WS_PE);
#pragma unroll
                for (int ai = 0; ai < 2; ++ai)
#pragma unroll
                    for (int m = 0; m < 4; ++m) {
                        const int rr = 128 * ai + 64 * wr + 16 * m + fr; const size_t row = (size_t)u.pm * 256 + rr;
                        f32x4 x1 = acc[ai][bj][m][0] * scale, x2 = acc[ai][bj][m][1] * scale;
                        if (rope) { const int t = tbase + rr; const int pos = half ? (t & 63) : (t >> 6);
                            const f32x4 c = *(const f32x4*)(ropec + pos * 32 + f0), s = *(const f32x4*)(ropes + pos * 32 + f0);
                            const f32x4 o1 = x1 * c - x2 * s, o2 = x2 * c + x1 * s; x1 = o1; x2 = o2; }
                        u32x2 q1, q2; q1.x = pk2(x1.x, x1.y); q1.y = pk2(x1.z, x1.w); q2.x = pk2(x2.x, x2.y); q2.y = pk2(x2.z, x2.w);
                        *(u32x2*)(dst + row * EV_N + lc0) = q1; *(u32x2*)(dst + row * EV_N + lc0 + 32) = q2;
                    }
            } else {
                const int seg = hcol >> 10, c0 = lc0 & 1023;
                if (seg == 1 || seg == 2) {
                    float* dst = (float*)(ws + (seg == 1 ? WS_FF : WS_FB));
                    const f32x4 l1 = *(const f32x4*)(lb + c0), l2 = *(const f32x4*)(lb + c0 + 32);
#pragma unroll
                    for (int ai = 0; ai < 2; ++ai)
#pragma unroll
                        for (int m = 0; m < 4; ++m) {
                            const size_t row = (size_t)u.pm * 256 + 128 * ai + 64 * wr + 16 * m + fr;
                            const f32x4 z1 = acc[ai][bj][m][0], z2 = acc[ai][bj][m][1]; f32x4 f1, f2;
                            f1.x = l1.x + (1.f - l1.x) / (1.f + __expf(-z1.x)); f1.y = l1.y + (1.f - l1.y) / (1.f + __expf(-z1.y)); f1.z = l1.z + (1.f - l1.z) / (1.f + __expf(-z1.z)); f1.w = l1.w + (1.f - l1.w) / (1.f + __expf(-z1.w));
                            f2.x = l2.x + (1.f - l2.x) / (1.f + __expf(-z2.x)); f2.y = l2.y + (1.f - l2.y) / (1.f + __expf(-z2.y)); f2.z = l2.z + (1.f - l2.z) / (1.f + __expf(-z2.z)); f2.w = l2.w + (1.f - l2.w) / (1.f + __expf(-z2.w));
                            *(f32x4*)(dst + row * DM + c0) = f1; *(f32x4*)(dst + row * DM + c0 + 32) = f2;
                        }
                } else {
                    bf16_t* dst = (bf16_t*)(ws + (seg == 0 ? WS_PQ : (seg == 3 ? WS_PI : WS_PG)));
#pragma unroll
                    for (int ai = 0; ai < 2; ++ai)
#pragma unroll
                        for (int m = 0; m < 4; ++m) {
                            const size_t row = (size_t)u.pm * 256 + 128 * ai + 64 * wr + 16 * m + fr;
                            const f32x4 x1 = acc[ai][bj][m][0], x2 = acc[ai][bj][m][1];
                            u32x2 q1, q2; q1.x = pk2(x1.x, x1.y); q1.y = pk2(x1.z, x1.w); q2.x = pk2(x2.x, x2.y); q2.y = pk2(x2.z, x2.w);
                            *(u32x2*)(dst + row * DM + c0) = q1; *(u32x2*)(dst + row * DM + c0 + 32) = q2;
                        }
                }
            }
        }
    }
};
struct EpiOut {
    static constexpr bool PERM = false;
    float* xres; const float* modl; int enable;
    __device__ __forceinline__ void operator()(const f32x4 (&acc)[2][2][4][2], const pg8::Unit& u, int wr, int wc, int fr, int fq) const {
        if (!enable) return;
        const int pmb = u.pm % 17; const int mrow = (pmb == 0) ? 4 : (u.pm / 17);
        const float* gate = modl + (size_t)mrow * 6144 + 2 * DM;
#pragma unroll
        for (int bj = 0; bj < 2; ++bj)
#pragma unroll
            for (int n = 0; n < 2; ++n) {
                const int c = 256 * u.pn + 128 * bj + 32 * wc + 16 * n + 4 * fq; const f32x4 gv = *(const f32x4*)(gate + c);
#pragma unroll
                for (int ai = 0; ai < 2; ++ai)
#pragma unroll
                    for (int m = 0; m < 4; ++m) { f32x4* p = (f32x4*)(xres + ((size_t)u.pm * 256 + 128 * ai + 64 * wr + 16 * m + fr) * DM + c); *p = *p + gv * acc[ai][bj][m][n]; }
            }
    }
};
struct EpiAct {
    static constexpr bool PERM = true;
    bf16_t* Act;
    __device__ __forceinline__ void operator()(const f32x4 (&acc)[2][2][4][2], const pg8::Unit& u, int wr, int wc, int fr, int fq) const {
#pragma unroll
        for (int bj = 0; bj < 2; ++bj) { const int Gq = 32 * u.pn + 16 * bj + 4 * wc + fq;
#pragma unroll
            for (int ai = 0; ai < 2; ++ai)
#pragma unroll
                for (int m = 0; m < 4; ++m) { const size_t row = (size_t)u.tile * 256 + 128 * ai + 64 * wr + 16 * m + fr;
                    const f32x4 a = acc[ai][bj][m][0], b = acc[ai][bj][m][1];
                    u32x2 q; q.x = pk2(siluf(a.x) * b.x, siluf(a.y) * b.y); q.y = pk2(siluf(a.z) * b.z, siluf(a.w) * b.w);
                    *(u32x2*)(Act + row * FF + 4 * Gq) = q; } }
    }
};
struct EpiY {
    static constexpr bool PERM = true;
    bf16_t* YB;
    __device__ __forceinline__ void operator()(const f32x4 (&acc)[2][2][4][2], const pg8::Unit& u, int wr, int wc, int fr, int fq) const {
#pragma unroll
        for (int bj = 0; bj < 2; ++bj) { const int c = 256 * u.pn + 128 * bj + 32 * wc + 8 * fq;
#pragma unroll
            for (int ai = 0; ai < 2; ++ai)
#pragma unroll
                for (int m = 0; m < 4; ++m) { const size_t row = (size_t)u.tile * 256 + 128 * ai + 64 * wr + 16 * m + fr;
                    const f32x4 a = acc[ai][bj][m][0], b = acc[ai][bj][m][1];
                    u32x4 q; q.x = pk2(a.x, a.y); q.y = pk2(a.z, a.w); q.z = pk2(b.x, b.y); q.w = pk2(b.z, b.w);
                    *(u32x4*)(YB + row * DM + c) = q; } }
    }
};

__device__ __forceinline__ void naive_g1(Frame& F, const Args& args, int l) {
    const int odd = l & 1, p = l >> 1; const int N = odd ? OD_N : EV_N;
    const float* W = (odd ? args.in[I_ODWIN] : args.in[I_EVWIN]) + (size_t)p * DM * N;
    LAS float* sh = (LAS float*)F.lds;
    const float* lb = (const float*)(F.ws + WS_LB) + l * DM;
    const float* ropec = (const float*)(F.ws + WS_ROPEC); const float* ropes = (const float*)(F.ws + WS_ROPES);
    for (int rg = fbid(); rg < MTOK / 8; rg += F.G) {
        __syncthreads();
        if (NAIVE_G1 == 2) {
            const int row = rg * 8 + F.wave; const int bb = row / SU, pp = row % SU; const int mrow = pp < NCTX ? 4 : bb;
            const float* xr = (const float*)(F.ws + WS_XRES) + (size_t)row * DM; float ssq = 0.f;
            for (int k = flane(); k < DM; k += 64) ssq += xr[k] * xr[k];
            ssq = wave_sum(ssq, flane()); const float rs = 1.0f / sqrtf(ssq / (float)DM + EPS);
            const float* modr = (const float*)(F.ws + WS_MOD) + ((size_t)l * 5 + mrow) * 6144;
            for (int k = flane(); k < DM; k += 64) sh[F.wave * DM + k] = xr[k] * rs * args.in[I_NORMW][(size_t)(l * 2) * DM + k] * (1.0f + modr[DM + k]) + modr[k];
        } else
        for (int i = ftid(); i < 8 * DM; i += 512) sh[i] = bf2f(((const bf16_t*)(F.ws + WS_HB))[(size_t)rg * 8 * DM + i]);
        __syncthreads();
        for (int pi = ftid(); pi < N / 2; pi += 512) {
            const int hh = pi >> 6, rem = pi & 63, half = rem >> 5, d = rem & 31; const int cA = 128 * hh + 64 * half + d, cB = cA + 32;
            float a[8], bq[8];
#pragma unroll
            for (int r = 0; r < 8; ++r) { a[r] = 0.f; bq[r] = 0.f; }
            for (int k = 0; k < DM; ++k) { const float wa = W[(size_t)k * N + cA], wb = W[(size_t)k * N + cB];
#pragma unroll
                for (int r = 0; r < 8; ++r) { const float hv = sh[r * DM + k]; a[r] += hv * wa; bq[r] += hv * wb; } }
            const int hcol = 128 * hh;
#pragma unroll
            for (int r = 0; r < 8; ++r) {
                const int row = rg * 8 + r; const int pp = row % SU; const bool isctx = pp < NCTX; const int t = pp - NCTX;
                float x1 = a[r], x2 = bq[r];
                if (!odd) {
                    const bool rope = !isctx && (hcol < 1024 || (hcol >= 2048 && hcol < 2816));
                    if (hcol >= 512 && hcol < 1024) { x1 *= 0.08838834764831845f; x2 *= 0.08838834764831845f; }
                    if (rope) { const int pos = half ? (t & 63) : (t >> 6); float cc = ropec[pos * 32 + d], sn = ropes[pos * 32 + d];
                        if (NAIVE_G1 == 3) { const double ang = (double)((float)pos * powf(10000.0f, -(float)d / 32.0f)); cc = (float)cos(ang); sn = (float)sin(ang); }
                        const float o1 = x1 * cc - x2 * sn, o2 = x2 * cc + x1 * sn; x1 = o1; x2 = o2; }
                    bf16_t* dst = (bf16_t*)(F.ws + WS_PE) + (size_t)row * EV_N; dst[cA] = (bf16_t)f2bf(x1); dst[cB] = (bf16_t)f2bf(x2);
                } else {
                    const int seg = hcol >> 10, c0 = cA & 1023;
                    if (seg == 1 || seg == 2) { float* dst = (float*)(F.ws + (seg == 1 ? WS_FF : WS_FB)) + (size_t)row * DM;
                        float lba = lb[c0], lbb = lb[c0 + 32];
                        if (NAIVE_G1 == 3) { const float* lg = args.in[I_LBLOG]; float ea[4], eb[4], sa = 0.f, sb2 = 0.f; for (int q = 0; q < 4; ++q) { ea[q] = expf(lg[q * DM + c0]); eb[q] = expf(lg[q * DM + c0 + 32]); sa += ea[q]; sb2 += eb[q]; }
                            lba = 0.f; lbb = 0.f; for (int q = 1; q <= l; ++q) { lba += ea[q] / sa; lbb += eb[q] / sb2; } }
                        dst[c0] = lba + (1.f - lba) / (1.f + expf(-x1)); dst[c0 + 32] = lbb + (1.f - lbb) / (1.f + expf(-x2)); }
                    else { bf16_t* dst = (bf16_t*)(F.ws + (seg == 0 ? WS_PQ : (seg == 3 ? WS_PI : WS_PG))) + (size_t)row * DM; dst[c0] = (bf16_t)f2bf(x1); dst[c0 + 32] = (bf16_t)f2bf(x2); }
                }
            }
        }
    }
    __syncthreads();
}

__device__ __forceinline__ void naive_g2(Frame& F, const Args& args, int l) {
    const int odd = l & 1, p = l >> 1;
    const float* W = (odd ? args.in[I_ODWOUT] : args.in[I_EVWOUT]) + (size_t)p * DM * DM;
    LAS float* sh = (LAS float*)F.lds;
    const float* modl = (const float*)(F.ws + WS_MOD) + (size_t)l * 5 * 6144;
    float* xres = (float*)(F.ws + WS_XRES);
    for (int rg = fbid(); rg < MTOK / 8; rg += F.G) {
        __syncthreads();
        for (int i = ftid(); i < 8 * DM; i += 512) sh[i] = bf2f(((const bf16_t*)(F.ws + WS_YB16))[(size_t)rg * 8 * DM + i]);
        __syncthreads();
        for (int col = ftid(); col < DM; col += 512) {
            float a[8];
#pragma unroll
            for (int r = 0; r < 8; ++r) a[r] = 0.f;
            for (int k = 0; k < DM; ++k) { const float wa = W[(size_t)k * DM + col];
#pragma unroll
                for (int r = 0; r < 8; ++r) a[r] += sh[r * DM + k] * wa; }
#pragma unroll
            for (int r = 0; r < 8; ++r) { const int row = rg * 8 + r; const int b = row / SU, pp = row % SU; const int mrow = pp < NCTX ? 4 : b;
                xres[(size_t)row * DM + col] += modl[(size_t)mrow * 6144 + 2 * DM + col] * a[r]; }
        }
    }
    __syncthreads();
}
__device__ __forceinline__ void naive_mod(Frame& F, const Args& args) {
    float* mod = (float*)(F.ws + WS_MOD);
    for (int i = fbid() * 512 + ftid(); i < DEPTH * 5 * 6144; i += F.G * 512) {
        const int col = i % 6144, r = (i / 6144) % 5, l = i / (5 * 6144);
        const float* cv = r < 4 ? args.in[I_C] + r * DM : args.in[I_CCTX];
        const float* w = args.in[I_ADAW] + (size_t)l * DM * 6144 + col;
        float a = 0.f;
        for (int k = 0; k < DM; ++k) { const float v = cv[k]; a += (v / (1.0f + expf(-v))) * w[(size_t)k * 6144]; }
        mod[i] = a + args.in[I_ADAB][l * 6144 + col];
    }
}

__device__ __forceinline__ void naive_moe(Frame& F, const Args& args, int l) {
    LAS float* sh = (LAS float*)F.lds;
    LAS float* sa = sh + 8 * DM;
    LAS int* gstart = (LAS int*)(sa + 8 * FF);
    LAS int* stok = gstart + 40;
    const unsigned* cnt = F.ctl + CW_CNT + l * NEXP;
    const unsigned* list = (const unsigned*)(F.ws + WS_LIST);
    __syncthreads();
    if (ftid() == 0) { int acc = 0; for (int e = 0; e < NEXP; ++e) { gstart[e] = acc; acc += ((int)cnt[e] + 7) / 8; } gstart[NEXP] = acc; }
    __syncthreads();
    const int total = gstart[NEXP];
    float* YN = (float*)(F.ws + WS_YN);
    for (int gi = fbid(); gi < total; gi += F.G) {
        int e = 0; for (int k = 1; k < NEXP; ++k) e += (gstart[k] <= gi) ? 1 : 0;
        const int g = gi - gstart[e]; const int ce = (int)cnt[e];
        __syncthreads();
        if (ftid() < 8) { const int idx = 8 * g + ftid(); stok[ftid()] = idx < ce ? (int)list[(size_t)e * LIST_CAP + idx] : -1; }
        __syncthreads();
        for (int i = ftid(); i < 8 * DM; i += 512) { const int r = i >> 10, k = i & 1023; const int tk = stok[r]; sh[i] = tk >= 0 ? bf2f(((const bf16_t*)(F.ws + WS_HB))[(size_t)tk * DM + k]) : 0.f; }
        __syncthreads();
        const float* w1 = args.in[I_W1] + ((size_t)l * NEXP + e) * DM * FF; const float* w3 = args.in[I_W3] + ((size_t)l * NEXP + e) * DM * FF; const float* w2 = args.in[I_W2] + ((size_t)l * NEXP + e) * FF * DM;
        { const int col = ftid(); float a[8], b[8];
#pragma unroll
            for (int r = 0; r < 8; ++r) { a[r] = 0.f; b[r] = 0.f; }
            for (int k = 0; k < DM; ++k) { const float wa = w1[(size_t)k * FF + col], wb = w3[(size_t)k * FF + col];
#pragma unroll
                for (int r = 0; r < 8; ++r) { const float hv = sh[r * DM + k]; a[r] += hv * wa; b[r] += hv * wb; } }
#pragma unroll
            for (int r = 0; r < 8; ++r) sa[r * FF + col] = (a[r] / (1.0f + expf(-a[r]))) * b[r]; }
        __syncthreads();
        for (int col = ftid(); col < DM; col += 512) { float y[8];
#pragma unroll
            for (int r = 0; r < 8; ++r) y[r] = 0.f;
            for (int k = 0; k < FF; ++k) { const float wv = w2[(size_t)k * DM + col];
#pragma unroll
                for (int r = 0; r < 8; ++r) y[r] += sa[r * FF + k] * wv; }
#pragma unroll
            for (int r = 0; r < 8; ++r) { const int tk = stok[r]; if (tk >= 0) { const unsigned e0 = ((const unsigned*)(F.ws + WS_TOKINFO))[(size_t)tk * 8]; const int kk = (e0 == (unsigned)e) ? 0 : 1;
                YN[((size_t)tk * 2 + kk) * DM + col] = y[r]; } } }
    }
    __syncthreads();
}

constexpr int TLD = 136;
constexpr int TILE_BYTES = 128 * TLD * 2;
template <int NT, int KS>
__device__ __forceinline__ void wave_mma(f32x4 (&acc)[NT], const bf16x8 (&afr)[KS], const LAS bf16_t* Bt, int ldb, int lane) {
    const LAS bf16_t* bp = Bt + (lane & 15) * ldb + 8 * (lane >> 4);
#pragma unroll
    for (int nt = 0; nt < NT; ++nt)
#pragma unroll
        for (int ks = 0; ks < KS; ++ks) { const bf16x8 b = *(const LAS bf16x8*)(bp + nt * 16 * ldb + 32 * ks); acc[nt] = __builtin_amdgcn_mfma_f32_16x16x32_bf16(afr[ks], b, acc[nt], 0, 0, 0);
            if ((ks & 3) == 3 && (nt & 1) == 1) asm volatile("" ::: "memory"); }
}
template <int NT, int KS>
__device__ __forceinline__ void wave_mma2(f32x4 (&acc0)[NT], f32x4 (&acc1)[NT], const bf16x8 (&a0)[KS], const bf16x8 (&a1)[KS], const LAS bf16_t* Bt, int ldb, int lane) {
    const LAS bf16_t* bp = Bt + (lane & 15) * ldb + 8 * (lane >> 4);
#pragma unroll
    for (int nt = 0; nt < NT; ++nt) {
        bf16x8 b[KS];
#pragma unroll
        for (int ks = 0; ks < KS; ++ks) b[ks] = *(const LAS bf16x8*)(bp + nt * 16 * ldb + 32 * ks);
#pragma unroll
        for (int ks = 0; ks < KS; ++ks) { acc0[nt] = __builtin_amdgcn_mfma_f32_16x16x32_bf16(a0[ks], b[ks], acc0[nt], 0, 0, 0); acc1[nt] = __builtin_amdgcn_mfma_f32_16x16x32_bf16(a1[ks], b[ks], acc1[nt], 0, 0, 0); }
        if ((nt & 1) == 1) asm volatile("" ::: "memory");
    }
}
__device__ __forceinline__ void stage_rowmajor(LAS bf16_t* T, const bf16_t* src, size_t ld, int tid) {
#pragma unroll
    for (int i = 0; i < 4; ++i) { const int q = tid + 512 * i, r = q >> 4, cc = q & 15; const u32x4 v = *(const u32x4*)(src + (size_t)r * ld + 8 * cc); *(LAS u32x4*)(T + r * TLD + 8 * cc) = v; }
}
__device__ __forceinline__ void stage_transposed(LAS bf16_t* T, const bf16_t* src, size_t ld, int tid, bool scaled, float sa, float sb) {
#pragma unroll
    for (int i = 0; i < 2; ++i) { const int q = tid + 512 * i, rp = q & 63, cc = q >> 6;
        const u32x4 v0 = *(const u32x4*)(src + (size_t)(2 * rp) * ld + 8 * cc), v1 = *(const u32x4*)(src + (size_t)(2 * rp + 1) * ld + 8 * cc);
        const unsigned w0[4] = {v0.x, v0.y, v0.z, v0.w}, w1[4] = {v1.x, v1.y, v1.z, v1.w};
        LAS unsigned* tp = (LAS unsigned*)(T + (8 * cc) * TLD + 2 * rp);
        if (scaled) { const float s0 = exp2f(sa * (float)(2 * rp) + sb), s1 = exp2f(sa * (float)(2 * rp + 1) + sb);
#pragma unroll
            for (int k = 0; k < 4; ++k) { tp[(2 * k) * (TLD / 2)] = pk2(bflo(w0[k]) * s0, bflo(w1[k]) * s1); tp[(2 * k + 1) * (TLD / 2)] = pk2(bfhi(w0[k]) * s0, bfhi(w1[k]) * s1); }
        } else {
#pragma unroll
            for (int k = 0; k < 4; ++k) { tp[(2 * k) * (TLD / 2)] = (w0[k] & 0xffffu) | (w1[k] << 16); tp[(2 * k + 1) * (TLD / 2)] = (w0[k] >> 16) | (w1[k] & 0xffff0000u); }
        }
    }
}
__device__ __forceinline__ void stage_f32_rowmajor(LAS bf16_t* T, const float* src, int tid) {
#pragma unroll
    for (int i = 0; i < 8; ++i) { const int q = tid + 512 * i, r = q >> 5, cc = q & 31; const f32x4 v = *(const f32x4*)(src + (size_t)r * 128 + 4 * cc);
        u32x2 o; o.x = pk2(v.x, v.y); o.y = pk2(v.z, v.w); *(LAS u32x2*)(T + r * TLD + 4 * cc) = o; }
}
__device__ __forceinline__ float log2_gamma_f(const Frame& F, int p, int dir, int h) { return -expf(((const float*)(F.ws + WS_SP) + SP_DECAY)[(p * 2 + dir) * 4 + h]) * 1.4426950408889634f; }
#define log2_gamma(args, p, dir, h) log2_gamma_f(F, p, dir, h)

__device__ __forceinline__ void ret_state_item(Frame& F, const Args& args, int p, int item) {
    const int c = item % NCHUNK, h = (item / NCHUNK) & 3, b = item / (NCHUNK * 4);
    int tid = ftid(); asm volatile("" : "+v"(tid)); const int lane = tid & 63, w = F.wave;
    LAS bf16_t* T0 = (LAS bf16_t*)F.lds; LAS bf16_t* T1 = (LAS bf16_t*)(F.lds + TILE_BYTES); LAS bf16_t* T2 = (LAS bf16_t*)(F.lds + 2 * TILE_BYTES);
    const bf16_t* pe = (const bf16_t*)(F.ws + WS_PE) + ((size_t)b * SU + 128 * c) * EV_N;
    const float lgf = log2_gamma(args, p, 0, h), lgb = log2_gamma(args, p, 1, h);
    __syncthreads();
    stage_transposed(T0, pe + 512 + h * 128, EV_N, tid, false, 0.f, 0.f);
    stage_transposed(T1, pe + 1024 + h * 128, EV_N, tid, true, -lgf, 127.f * lgf);
    stage_transposed(T2, pe + 1024 + h * 128, EV_N, tid, true, lgb, 0.f);
    __syncthreads();
    float* st = (float*)(F.ws + WS_ST);
    {
        bf16x8 af[4], ab[4];
#pragma unroll
        for (int ks = 0; ks < 4; ++ks) { af[ks] = *(const LAS bf16x8*)(T1 + (16 * w + (lane & 15)) * TLD + 32 * ks + 8 * (lane >> 4)); ab[ks] = *(const LAS bf16x8*)(T2 + (16 * w + (lane & 15)) * TLD + 32 * ks + 8 * (lane >> 4)); }
        f32x4 accf[8], accb[8];
#pragma unroll
        for (int nt = 0; nt < 8; ++nt) { accf[nt] = (f32x4){0.f, 0.f, 0.f, 0.f}; accb[nt] = (f32x4){0.f, 0.f, 0.f, 0.f}; }
        wave_mma2<8, 4>(accf, accb, af, ab, T0, TLD, lane);
        float* dstf = st + ((((size_t)(b * 4 + h) * 2 + 0) * NCHUNK + c) * 128) * 128; float* dstb = st + ((((size_t)(b * 4 + h) * 2 + 1) * NCHUNK + c) * 128) * 128;
#pragma unroll
        for (int nt = 0; nt < 8; ++nt)
#pragma unroll
            for (int j = 0; j < 4; ++j) { const size_t o_ = (size_t)(16 * w + 4 * (lane >> 4) + j) * 128 + 16 * nt + (lane & 15); dstf[o_] = accf[nt][j]; dstb[o_] = accb[nt][j]; }
    }
}
__device__ __forceinline__ void ret_scan_phase(Frame& F, const Args& args, int p) {
    f32x4* st = (f32x4*)(F.ws + WS_ST);
    for (int i = fbid() * 512 + ftid(); i < 32 * 4096; i += F.G * 512) {
        const int bhd = i >> 12, el = i & 4095; const int dir = bhd & 1, h = (bhd >> 1) & 3;
        const float g128 = exp2f(128.f * log2_gamma(args, p, dir, h));
        f32x4* base = st + (size_t)bhd * NCHUNK * 4096 + el;
        f32x4 s = (f32x4){0.f, 0.f, 0.f, 0.f};
        for (int k = 0; k < NCHUNK; ++k) {
            const int c = dir == 0 ? k : (k < 2 ? 1 - k : NCHUNK + 1 - k);
            const f32x4 u = base[(size_t)c * 4096]; base[(size_t)c * 4096] = s; s = s * g128 + u;
        }
    }
}
__device__ __forceinline__ bf16x8 scale_frag(const bf16x8 a, float sc) {
    bf16x8 r;
#pragma unroll
    for (int k = 0; k < 8; ++k) r[k] = (short)f2bf(bf2f((unsigned)(unsigned short)a[k]) * sc);
    return r;
}
__device__ __forceinline__ void ret_out_item(Frame& F, const Args& args, int p, int item) {
    const int c = item % NCHUNK, h = (item / NCHUNK) & 3, b = item / (NCHUNK * 4);
    int tid = ftid(); asm volatile("" : "+v"(tid)); const int lane = tid & 63, w = F.wave, quad = lane >> 4, l15 = lane & 15;
    LAS bf16_t* T0 = (LAS bf16_t*)F.lds; LAS bf16_t* T1 = (LAS bf16_t*)(F.lds + TILE_BYTES); LAS bf16_t* T2 = (LAS bf16_t*)(F.lds + 2 * TILE_BYTES);
    const size_t row0 = (size_t)b * SU + 128 * c;
    const bf16_t* pe = (const bf16_t*)(F.ws + WS_PE) + row0 * EV_N;
    const float lgf = log2_gamma(args, p, 0, h), lgb = log2_gamma(args, p, 1, h);
    const float* stf = (const float*)(F.ws + WS_ST) + ((((size_t)(b * 4 + h) * 2 + 0) * NCHUNK + c) * 128) * 128;
    const float* stb = (const float*)(F.ws + WS_ST) + ((((size_t)(b * 4 + h) * 2 + 1) * NCHUNK + c) * 128) * 128;
    bf16x8 qf[4];
#pragma unroll
    for (int ks = 0; ks < 4; ++ks) qf[ks] = *(const bf16x8*)(pe + (size_t)(16 * w + l15) * EV_N + h * 128 + 32 * ks + 8 * quad);
    __syncthreads();
    stage_rowmajor(T0, pe + 512 + h * 128, EV_N, tid);
    stage_transposed(T1, pe + 1024 + h * 128, EV_N, tid, false, 0.f, 0.f);
    stage_f32_rowmajor(T2, stf, tid);
    __syncthreads();
    f32x4 ao[8];
#pragma unroll
    for (int nt = 0; nt < 8; ++nt) ao[nt] = (f32x4){0.f, 0.f, 0.f, 0.f};
    {
        const float cf = exp2f(lgf * (float)(16 * w + l15 + 1));
        bf16x8 qs[4];
#pragma unroll
        for (int ks = 0; ks < 4; ++ks) qs[ks] = scale_frag(qf[ks], cf);
        wave_mma<8, 4>(ao, qs, T2, TLD, lane);
    }
    {
        f32x4 aw[8];
#pragma unroll
        for (int nt = 0; nt < 8; ++nt) aw[nt] = (f32x4){0.f, 0.f, 0.f, 0.f};
        wave_mma<8, 4>(aw, qf, T0, TLD, lane);
        __syncthreads();
#pragma unroll
        for (int nt = 0; nt < 8; ++nt)
#pragma unroll
            for (int j = 0; j < 4; ++j) { const int i = 16 * w + 4 * quad + j, jj = 16 * nt + l15; const int d = i - jj;
                const float dec = d > 0 ? exp2f(lgf * (float)d) : (d < 0 ? exp2f(lgb * (float)(-d)) : 2.0f);
                T0[i * TLD + jj] = (bf16_t)f2bf(aw[nt][j] * dec); }
    }
    stage_f32_rowmajor(T2, stb, tid);
    __syncthreads();
    {
        bf16x8 pf[4];
#pragma unroll
        for (int ks = 0; ks < 4; ++ks) pf[ks] = *(const LAS bf16x8*)(T0 + (16 * w + l15) * TLD + 32 * ks + 8 * quad);
        wave_mma<8, 4>(ao, pf, T1, TLD, lane);
        const float cb = exp2f(lgb * (float)(128 - (16 * w + l15)));
#pragma unroll
        for (int ks = 0; ks < 4; ++ks) pf[ks] = scale_frag(qf[ks], cb);
        wave_mma<8, 4>(ao, pf, T2, TLD, lane);
    }
    bf16_t* yb = (bf16_t*)(F.ws + WS_YB16);
#pragma unroll
    for (int j = 0; j < 4; ++j) { const int i = 16 * w + 4 * quad + j;
        float ss = 0.f;
#pragma unroll
        for (int nt = 0; nt < 8; ++nt) ss += ao[nt][j] * ao[nt][j];
        ss += shx(ss, 1, lane); ss += shx(ss, 2, lane); ss += shx(ss, 4, lane); ss += shx(ss, 8, lane);
        const float rstd = 1.0f / sqrtf(ss * (1.0f / 128.f) + EPS);
        const bf16_t* gp = pe + (size_t)i * EV_N + 1536 + h * 128;
#pragma unroll
        for (int nt = 0; nt < 8; ++nt) { const float gt = bf2f(gp[16 * nt + l15]); yb[(row0 + i) * DM + h * 128 + 16 * nt + l15] = ABL_RET0 ? (bf16_t)0 : (bf16_t)f2bf(siluf(gt) * ao[nt][j] * rstd); }
    }
}
__device__ __forceinline__ void ret_direct_item(Frame& F, const Args& args, int p, int item) {
    const int c = item % NCHUNK, h = (item / NCHUNK) & 3, b = item / (NCHUNK * 4);
    int tid = ftid(); asm volatile("" : "+v"(tid)); const int lane = tid & 63, w = F.wave, quad = lane >> 4, l15 = lane & 15;
    LAS bf16_t* T0 = (LAS bf16_t*)F.lds; LAS bf16_t* T1 = (LAS bf16_t*)(F.lds + TILE_BYTES); LAS bf16_t* T2 = (LAS bf16_t*)(F.lds + 2 * TILE_BYTES);
    const size_t row0 = (size_t)b * SU + 128 * c;
    const bf16_t* peb = (const bf16_t*)(F.ws + WS_PE) + (size_t)b * SU * EV_N;
    const bf16_t* pe = peb + (size_t)128 * c * EV_N;
    const float lgf = log2_gamma(args, p, 0, h), lgb = log2_gamma(args, p, 1, h);
    bf16x8 qf[4];
#pragma unroll
    for (int ks = 0; ks < 4; ++ks) qf[ks] = *(const bf16x8*)(pe + (size_t)(16 * w + l15) * EV_N + h * 128 + 32 * ks + 8 * quad);
    f32x4 ao[8];
#pragma unroll
    for (int nt = 0; nt < 8; ++nt) ao[nt] = (f32x4){0.f, 0.f, 0.f, 0.f};
    for (int c2 = 0; c2 < NCHUNK; ++c2) {
        __syncthreads();
        stage_rowmajor(T0, peb + (size_t)128 * c2 * EV_N + 512 + h * 128, EV_N, tid);
        stage_transposed(T1, peb + (size_t)128 * c2 * EV_N + 1024 + h * 128, EV_N, tid, false, 0.f, 0.f);
        __syncthreads();
        f32x4 aw[8];
#pragma unroll
        for (int nt = 0; nt < 8; ++nt) aw[nt] = (f32x4){0.f, 0.f, 0.f, 0.f};
        wave_mma<8, 4>(aw, qf, T0, TLD, lane);
#pragma unroll
        for (int nt = 0; nt < 8; ++nt)
#pragma unroll
            for (int j = 0; j < 4; ++j) { const int i = 16 * w + 4 * quad + j, jj = 16 * nt + l15;
                const int px = 128 * c + i, py = 128 * c2 + jj;
                const int ubx = px < NCTX ? NCTX - 1 - px : SU + NCTX - 1 - px, uby = py < NCTX ? NCTX - 1 - py : SU + NCTX - 1 - py;
                float dec = 0.f;
                if (py <= px && !(px >= NCTX && false)) dec += exp2f(lgf * (float)(px - py));
                if (uby <= ubx) dec += exp2f(lgb * (float)(ubx - uby));
                if (px < NCTX && py >= NCTX) dec = 0.f;
                T2[i * TLD + jj] = (bf16_t)f2bf(aw[nt][j] * dec); }
        LDS_WAIT(); asm volatile("" ::: "memory");
        bf16x8 pf[4];
#pragma unroll
        for (int ks = 0; ks < 4; ++ks) pf[ks] = *(const LAS bf16x8*)(T2 + (16 * w + l15) * TLD + 32 * ks + 8 * quad);
        wave_mma<8, 4>(ao, pf, T1, TLD, lane);
    }
    bf16_t* yb = (bf16_t*)(F.ws + WS_YB16);
#pragma unroll
    for (int j = 0; j < 4; ++j) { const int i = 16 * w + 4 * quad + j;
        float ss = 0.f;
#pragma unroll
        for (int nt = 0; nt < 8; ++nt) ss += ao[nt][j] * ao[nt][j];
        ss += shx(ss, 1, lane); ss += shx(ss, 2, lane); ss += shx(ss, 4, lane); ss += shx(ss, 8, lane);
        const float rstd = 1.0f / sqrtf(ss * (1.0f / 128.f) + EPS);
        const bf16_t* gp = pe + (size_t)i * EV_N + 1536 + h * 128;
#pragma unroll
        for (int nt = 0; nt < 8; ++nt) { const float gt = bf2f(gp[16 * nt + l15]); yb[(row0 + i) * DM + h * 128 + 16 * nt + l15] = (bf16_t)f2bf(siluf(gt) * ao[nt][j] * rstd); }
    }
}
__device__ __forceinline__ void att_item(Frame& F, const Args& args, int p, int item) {
    const int qb = item % NCHUNK, hk = (item / NCHUNK) & 1, b = item / (NCHUNK * 2);
    int tid = ftid(); asm volatile("" : "+v"(tid)); const int lane = tid & 63, w = F.wave, quad = lane >> 4, l15 = lane & 15;
    const int g = w >> 2, hq = 2 * hk + g, qr0 = 32 * (w & 3);
    LAS bf16_t* T0 = (LAS bf16_t*)F.lds; LAS bf16_t* T1 = (LAS bf16_t*)(F.lds + TILE_BYTES);
    LAS bf16_t* Pw = (LAS bf16_t*)(F.lds + 2 * TILE_BYTES) + w * 32 * TLD;
    const bf16_t* peb = (const bf16_t*)(F.ws + WS_PE) + (size_t)b * SU * EV_N;
    const size_t qrow0 = (size_t)128 * qb + qr0;
    bf16x8 qf[2][4];
#pragma unroll
    for (int rt = 0; rt < 2; ++rt)
#pragma unroll
        for (int ks = 0; ks < 4; ++ks) qf[rt][ks] = *(const bf16x8*)(peb + (qrow0 + 16 * rt + l15) * EV_N + 2048 + hq * 128 + 32 * ks + 8 * quad);
    const float sink = ((const float*)(F.ws + WS_SP) + SP_SINK)[p * 4 + hq] * 1.4426950408889634f;
    const float scale = 0.08838834764831845f * 1.4426950408889634f;
    float mrow[2][4], lrow[2][4]; f32x4 ao[2][8];
#pragma unroll
    for (int rt = 0; rt < 2; ++rt) {
#pragma unroll
        for (int j = 0; j < 4; ++j) { mrow[rt][j] = sink; lrow[rt][j] = 1.0f; }
#pragma unroll
        for (int nt = 0; nt < 8; ++nt) ao[rt][nt] = (f32x4){0.f, 0.f, 0.f, 0.f};
    }
    const int ntile = (qb < 2) ? 2 : 5;
    for (int ti = 0; ti < ntile; ++ti) {
        int kt, mode = 0;
        if (ti < 2) kt = ti; else { kt = qb + (ti - 3); mode = (ti == 2) ? 1 : (ti == 4 ? 2 : 0); }
        if (ti >= 2 && (kt < 2 || kt >= NCHUNK)) continue;
        __syncthreads();
        stage_rowmajor(T0, peb + (size_t)128 * kt * EV_N + 2560 + hk * 128, EV_N, tid);
        stage_transposed(T1, peb + (size_t)128 * kt * EV_N + 2816 + hk * 128, EV_N, tid, false, 0.f, 0.f);
        __syncthreads();
        f32x4 s2[2][8];
#pragma unroll
        for (int nt = 0; nt < 8; ++nt) { s2[0][nt] = (f32x4){0.f, 0.f, 0.f, 0.f}; s2[1][nt] = (f32x4){0.f, 0.f, 0.f, 0.f}; }
        wave_mma2<8, 4>(s2[0], s2[1], qf[0], qf[1], T0, TLD, lane);
#pragma unroll
        for (int rt = 0; rt < 2; ++rt) {
            f32x4 (&s)[8] = s2[rt];
#pragma unroll
            for (int j = 0; j < 4; ++j) {
                const int qq = qr0 + 16 * rt + 4 * quad + j;
                float mx = -3.0e38f;
                if (mode == 0) {
#pragma unroll
                    for (int nt = 0; nt < 8; ++nt) { const float v = s[nt][j] * scale; s[nt][j] = v; mx = fmaxf(mx, v); }
                } else {
#pragma unroll
                    for (int nt = 0; nt < 8; ++nt) { const int kk = 16 * nt + l15; float v = s[nt][j] * scale;
                        const bool valid = (mode == 1 ? (kk >= qq) : (kk <= qq));
                        v = valid ? v : -3.0e38f; s[nt][j] = v; mx = fmaxf(mx, v); }
                }
                mx = fmaxf(mx, shx(mx, 1, lane)); mx = fmaxf(mx, shx(mx, 2, lane)); mx = fmaxf(mx, shx(mx, 4, lane)); mx = fmaxf(mx, shx(mx, 8, lane));
                const float mn = fmaxf(mrow[rt][j], mx); const float alpha = __builtin_amdgcn_exp2f(mrow[rt][j] - mn);
                float rs = 0.f;
#pragma unroll
                for (int nt = 0; nt < 8; ++nt) { const float pv = __builtin_amdgcn_exp2f(s[nt][j] - mn); rs += pv;     Pw[(16 * rt + 4 * quad + j) * TLD + 16 * nt + l15] = (bf16_t)f2bf(pv); }
                rs += shx(rs, 1, lane); rs += shx(rs, 2, lane); rs += shx(rs, 4, lane); rs += shx(rs, 8, lane);
                lrow[rt][j] = lrow[rt][j] * alpha + rs; mrow[rt][j] = mn;
#pragma unroll
                for (int nt = 0; nt < 8; ++nt) ao[rt][nt][j] *= alpha;
            }
        }
        LDS_WAIT(); asm volatile("" ::: "memory");
        {
            bf16x8 pf0[4], pf1[4];
#pragma unroll
            for (int ks = 0; ks < 4; ++ks) { pf0[ks] = *(const LAS bf16x8*)(Pw + (l15) * TLD + 32 * ks + 8 * quad); pf1[ks] = *(const LAS bf16x8*)(Pw + (16 + l15) * TLD + 32 * ks + 8 * quad); }
            wave_mma2<8, 4>(ao[0], ao[1], pf0, pf1, T1, TLD, lane);
        }
    }
    bf16_t* yb = (bf16_t*)(F.ws + WS_YB16) + ((size_t)b * SU + qrow0) * DM + 512 + hq * 128;
#pragma unroll
    for (int rt = 0; rt < 2; ++rt)
#pragma unroll
        for (int j = 0; j < 4; ++j) { const float inv = 1.0f / lrow[rt][j];
#pragma unroll
            for (int nt = 0; nt < 8; ++nt) yb[(size_t)(16 * rt + 4 * quad + j) * DM + 16 * nt + l15] = ABL_ATT0 ? (bf16_t)0 : (bf16_t)f2bf(ao[rt][nt][j] * inv); }
}
__device__ __forceinline__ void naive_att(Frame& F, const Args& args, int p) {
    const int gw = F.vcu * NWAVES + F.wave, NGW = F.G * NWAVES, lane = flane();
    LAS float* sq = (LAS float*)F.lds + F.wave * 1024;
    LAS float* sc = sq + 128;
    const bf16_t* pe = (const bf16_t*)(F.ws + WS_PE);
    for (int task = gw; task < MTOK * 4; task += NGW) {
        const int row = task >> 2, hq = task & 3, hk = hq >> 1; const int b = row / SU, pq = row % SU;
        const bf16_t* peb = pe + (size_t)b * SU * EV_N;
        sq[lane] = bf2f(peb[(size_t)pq * EV_N + 2048 + hq * 128 + lane]) * 0.08838834764831845f; sq[lane + 64] = bf2f(peb[(size_t)pq * EV_N + 2048 + hq * 128 + lane + 64]) * 0.08838834764831845f;
        LDS_WAIT(); asm volatile("" ::: "memory");
        int lo = 0, nloc = 0;
        if (pq >= NCTX) { const int t = pq - NCTX; lo = t - 128 < 0 ? 0 : t - 128; const int hi = t + 128 > LSEQ - 1 ? LSEQ - 1 : t + 128; nloc = hi - lo + 1; }
        const int nk = NCTX + nloc;
        const float sink = args.in[I_SINK][p * 4 + hq];
        float mx = sink;
        for (int ki = lane; ki < nk; ki += 64) { const int kp = ki < NCTX ? ki : NCTX + lo + (ki - NCTX);
            const bf16_t* kr = peb + (size_t)kp * EV_N + 2560 + hk * 128; float d = 0.f;
            for (int x = 0; x < 128; ++x) d += sq[x] * bf2f(kr[x]);
            sc[ki] = d; mx = fmaxf(mx, d); }
#pragma unroll
        for (int o = 1; o < 64; o <<= 1) mx = fmaxf(mx, shx(mx, o, lane));
        float sum = 0.f;
        for (int ki = lane; ki < nk; ki += 64) { const float e = expf(sc[ki] - mx); sc[ki] = e; sum += e; }
        sum = wave_sum(sum, lane) + expf(sink - mx);
        LDS_WAIT(); asm volatile("" ::: "memory");
        float o0 = 0.f, o1 = 0.f;
        for (int ki = 0; ki < nk; ++ki) { const int kp = ki < NCTX ? ki : NCTX + lo + (ki - NCTX); const bf16_t* vr = peb + (size_t)kp * EV_N + 2816 + hk * 128; const float pv = sc[ki];
            o0 += pv * bf2f(vr[lane]); o1 += pv * bf2f(vr[lane + 64]); }
        bf16_t* yb = (bf16_t*)(F.ws + WS_YB16) + (size_t)row * DM + 512 + hq * 128;
        yb[lane] = (bf16_t)f2bf(o0 / sum); yb[lane + 64] = (bf16_t)f2bf(o1 / sum);
        LDS_WAIT(); asm volatile("" ::: "memory");
    }
}
__device__ __forceinline__ void hg_scan_item_plain(Frame& F, int item) {
    const int es = item & 3, dir = (item >> 2) & 1, h = (item >> 3) & 7, b = item >> 6;
    const int tid = ftid(), e = tid & 31, dg = tid >> 5;
    LAS float* sP = (LAS float*)F.lds;
    LAS float* sIn = sP + 32 * 16 * 32;
    constexpr int INB = 32 * 128 * 2 + 32 * 32;
    const float* fsrc = (const float*)(F.ws + (dir ? WS_FB : WS_FF));
    const bf16_t* qsrc = (const bf16_t*)(F.ws + WS_PQ); const bf16_t* vsrc = (const bf16_t*)(F.ws + WS_PI);
    float* osrc = (float*)(F.ws + (dir ? WS_OB : WS_OF));
    float S[8];
#pragma unroll
    for (int k = 0; k < 8; ++k) S[k] = 0.f;
    const size_t rb = (size_t)b * SU;
    f32x4 rf0, rf1; u32x4 rq, rv;
    auto pos_of = [&](int s) { return dir ? (s < NCTX ? NCTX - 1 - s : SU + NCTX - 1 - s) : s; };
#define HG_ISSUE(s0_) do { const int pA = pos_of((s0_) + (tid >> 5)), pB = pos_of((s0_) + 16 + (tid >> 5)), pQ = pos_of((s0_) + (tid >> 4)); \
        rf0 = *(const f32x4*)(fsrc + (rb + pA) * DM + h * 128 + 4 * (tid & 31)); rf1 = *(const f32x4*)(fsrc + (rb + pB) * DM + h * 128 + 4 * (tid & 31)); \
        rq = *(const u32x4*)(qsrc + (rb + pQ) * DM + h * 128 + 8 * (tid & 15)); \
        if (tid < 128) { const int pV = pos_of((s0_) + (tid >> 2)); rv = *(const u32x4*)(vsrc + (rb + pV) * DM + h * 128 + 32 * es + 8 * (tid & 3)); } } while (0)
#define HG_WRITE(buf_) do { LAS float* bF = sIn + (buf_) * INB; LAS float* bQ = bF + 32 * 128; LAS float* bV = bQ + 32 * 128; \
        *(LAS f32x4*)(bF + (tid >> 5) * 128 + 4 * (tid & 31)) = rf0; *(LAS f32x4*)(bF + (16 + (tid >> 5)) * 128 + 4 * (tid & 31)) = rf1; \
        { LAS float* d = bQ + (tid >> 4) * 128 + 8 * (tid & 15); *(LAS f32x4*)d = (f32x4){bflo(rq.x), bfhi(rq.x), bflo(rq.y), bfhi(rq.y)}; *(LAS f32x4*)(d + 4) = (f32x4){bflo(rq.z), bfhi(rq.z), bflo(rq.w), bfhi(rq.w)}; } \
        if (tid < 128) { LAS float* d = bV + (tid >> 2) * 32 + 8 * (tid & 3); *(LAS f32x4*)d = (f32x4){bflo(rv.x), bfhi(rv.x), bflo(rv.y), bfhi(rv.y)}; *(LAS f32x4*)(d + 4) = (f32x4){bflo(rv.z), bfhi(rv.z), bflo(rv.w), bfhi(rv.w)}; } } while (0)
    __syncthreads();
    HG_ISSUE(0); HG_WRITE(0);
    __syncthreads();
    constexpr int NTB = SU / 32;
    for (int tb = 0; tb < NTB; ++tb) {
        const int s0 = 32 * tb, cur = tb & 1;
        if (tb + 1 < NTB) HG_ISSUE(s0 + 32);
        const LAS float* sF = sIn + cur * INB; const LAS float* sQ = sF + 32 * 128; const LAS float* sV = sQ + 32 * 128;
#pragma unroll 4
        for (int tt = 0; tt < 32; ++tt) {
            const f32x4 f0 = *(const LAS f32x4*)(sF + tt * 128 + 8 * dg), f1 = *(const LAS f32x4*)(sF + tt * 128 + 8 * dg + 4);
            const f32x4 q0 = *(const LAS f32x4*)(sQ + tt * 128 + 8 * dg), q1 = *(const LAS f32x4*)(sQ + tt * 128 + 8 * dg + 4);
            const float v = sV[tt * 32 + e];
            const float ff[8] = {f0.x, f0.y, f0.z, f0.w, f1.x, f1.y, f1.z, f1.w}; const float qq[8] = {q0.x, q0.y, q0.z, q0.w, q1.x, q1.y, q1.z, q1.w};
            float part = 0.f;
#pragma unroll
            for (int k = 0; k < 8; ++k) { S[k] = ff[k] * S[k] + (1.0f - ff[k]) * v; part += qq[k] * S[k]; }
            sP[(tt * 16 + dg) * 32 + e] = part;
        }
        __syncthreads();
#pragma unroll
        for (int i = 0; i < 2; ++i) { const int q = tid + 512 * i, tt = q >> 5, ee = q & 31; float o = 0.f;
#pragma unroll
            for (int k = 0; k < 16; ++k) o += sP[(tt * 16 + k) * 32 + ee];
            osrc[(rb + pos_of(s0 + tt)) * DM + h * 128 + 32 * es + ee] = o; }
        if (tb + 1 < NTB) HG_WRITE(cur ^ 1);
        __syncthreads();
    }
#undef HG_ISSUE
#undef HG_WRITE
}
__device__ __forceinline__ void hg_scan_item_c16(Frame& F, int item) {
    const int es = item & 3, dir = (item >> 2) & 1, h = (item >> 3) & 7, b = item >> 6;
    const int tid = ftid(), lane = tid & 63, w = F.wave, quad = lane >> 4, l15 = lane & 15;
    constexpr int INB = 32 * 128 * 2 + 32 * 32;
    LAS float* sIn = (LAS float*)F.lds;
    LAS bf16_t* QA = (LAS bf16_t*)(sIn + 2 * INB);
    LAS bf16_t* KB = QA + 2 * 16 * 136;
    LAS bf16_t* KC = KB + 2 * 16 * 136;
    LAS bf16_t* VT = KC + 2 * 128 * 40;
    LAS bf16_t* PP = VT + 2 * 32 * 40;
    LAS bf16_t* ST = PP + 2 * 16 * 40;
    LAS float* DEC = (LAS float*)(ST + 32 * 136);
    const float* fsrc = (const float*)(F.ws + (dir ? WS_FB : WS_FF));
    const bf16_t* qsrc = (const bf16_t*)(F.ws + WS_PQ); const bf16_t* vsrc = (const bf16_t*)(F.ws + WS_PI);
    float* osrc = (float*)(F.ws + (dir ? WS_OB : WS_OF));
    const size_t rb = (size_t)b * SU;
    f32x4 S[2] = {(f32x4){0.f, 0.f, 0.f, 0.f}, (f32x4){0.f, 0.f, 0.f, 0.f}};
    f32x4 rf0, rf1; u32x4 rq, rv;
    auto pos_of = [&](int s) { return dir ? (s < NCTX ? NCTX - 1 - s : SU + NCTX - 1 - s) : s; };
#define HG_ISSUE(s0_) do { const int pA = pos_of((s0_) + (tid >> 5)), pB = pos_of((s0_) + 16 + (tid >> 5)), pQ = pos_of((s0_) + (tid >> 4)); \
        rf0 = *(const f32x4*)(fsrc + (rb + pA) * DM + h * 128 + 4 * (tid & 31)); rf1 = *(const f32x4*)(fsrc + (rb + pB) * DM + h * 128 + 4 * (tid & 31)); \
        rq = *(const u32x4*)(qsrc + (rb + pQ) * DM + h * 128 + 8 * (tid & 15)); \
        if (tid < 128) { const int pV = pos_of((s0_) + (tid >> 2)); rv = *(const u32x4*)(vsrc + (rb + pV) * DM + h * 128 + 32 * es + 8 * (tid & 3)); } } while (0)
#define HG_WRITE(buf_) do { LAS float* bF = sIn + (buf_) * INB; LAS float* bQ = bF + 32 * 128; LAS float* bV = bQ + 32 * 128; \
        *(LAS f32x4*)(bF + (tid >> 5) * 128 + 4 * (tid & 31)) = rf0; *(LAS f32x4*)(bF + (16 + (tid >> 5)) * 128 + 4 * (tid & 31)) = rf1; \
        { LAS float* d = bQ + (tid >> 4) * 128 + 8 * (tid & 15); *(LAS f32x4*)d = (f32x4){bflo(rq.x), bfhi(rq.x), bflo(rq.y), bfhi(rq.y)}; *(LAS f32x4*)(d + 4) = (f32x4){bflo(rq.z), bfhi(rq.z), bflo(rq.w), bfhi(rq.w)}; } \
        if (tid < 128) { LAS float* d = bV + (tid >> 2) * 32 + 8 * (tid & 3); *(LAS f32x4*)d = (f32x4){bflo(rv.x), bfhi(rv.x), bflo(rv.y), bfhi(rv.y)}; *(LAS f32x4*)(d + 4) = (f32x4){bflo(rv.z), bfhi(rv.z), bflo(rv.w), bfhi(rv.w)}; } } while (0)
    __syncthreads();
    for (int i = tid; i < 2 * 128 * 40; i += 512) KC[i] = 0;
    for (int i = tid; i < 2 * 32 * 40; i += 512) VT[i] = 0;
    for (int i = tid; i < 2 * 16 * 40; i += 512) PP[i] = 0;
    for (int i = tid; i < 32 * 136; i += 512) ST[i] = 0;
    HG_ISSUE(0); HG_WRITE(0);
    __syncthreads();
    constexpr int NTB = SU / 32;
#define HG_BAR() do { asm volatile("s_waitcnt lgkmcnt(0)" ::: "memory"); __builtin_amdgcn_s_barrier(); asm volatile("" ::: "memory"); } while (0)
    for (int tb = 0; tb < NTB; ++tb) {
        const int s0 = 32 * tb, cur = tb & 1;
        if (tb + 1 < NTB) HG_ISSUE(s0 + 32);
        const LAS float* sF = sIn + cur * INB; const LAS float* sQ = sF + 32 * 128; const LAS float* sV = sQ + 32 * 128;
        if (tid < 256) {
            const int c = tid >> 7, d = tid & 127;
            float a = 0.f, kbv[16], fv[16], qv[16];
#pragma unroll
            for (int i = 0; i < 16; ++i) { fv[i] = sF[(16 * c + i) * 128 + d]; qv[i] = sQ[(16 * c + i) * 128 + d]; }
#pragma unroll
            for (int i = 0; i < 16; ++i) { const float f = fv[i], q = qv[i];
                a += __builtin_amdgcn_logf(f); const float ea = __builtin_amdgcn_exp2f(a);
                QA[(c * 16 + i) * 136 + d] = (bf16_t)f2bf(q * ea); kbv[i] = (1.0f - f) * __builtin_amdgcn_exp2f(-a); }
            const float al = __builtin_amdgcn_exp2f(a); DEC[c * 128 + d] = al;
            unsigned pk[8];
#pragma unroll
            for (int j = 0; j < 16; ++j) { KB[(c * 16 + j) * 136 + d] = (bf16_t)f2bf(kbv[j]); }
#pragma unroll
            for (int j = 0; j < 8; ++j) pk[j] = pk2(kbv[2 * j] * al, kbv[2 * j + 1] * al);
            LAS u32x4* kd = (LAS u32x4*)(KC + (c * 128 + d) * 40); kd[0] = (u32x4){pk[0], pk[1], pk[2], pk[3]}; kd[1] = (u32x4){pk[4], pk[5], pk[6], pk[7]};
        } else {
            const int idx = tid - 256, c = idx >> 7, e = (idx >> 2) & 31, jq = idx & 3;
            const float v0 = sV[(16 * c + 4 * jq + 0) * 32 + e], v1 = sV[(16 * c + 4 * jq + 1) * 32 + e], v2 = sV[(16 * c + 4 * jq + 2) * 32 + e], v3 = sV[(16 * c + 4 * jq + 3) * 32 + e];
            u32x2 o; o.x = pk2(v0, v1); o.y = pk2(v2, v3); *(LAS u32x2*)(VT + (c * 32 + e) * 40 + 4 * jq) = o;
        }
        HG_BAR();
        bf16x8 qa[4]; f32x4 oi[2] = {(f32x4){0.f, 0.f, 0.f, 0.f}, (f32x4){0.f, 0.f, 0.f, 0.f}};
        bf16x8 sb0[2][4];
        if (w < 2) {
            const int c = w;
            bf16x8 kbf[4], vbf[2];
#pragma unroll
            for (int ks = 0; ks < 4; ++ks) { qa[ks] = *(const LAS bf16x8*)(QA + (c * 16 + l15) * 136 + 32 * ks + 8 * quad); kbf[ks] = *(const LAS bf16x8*)(KB + (c * 16 + l15) * 136 + 32 * ks + 8 * quad); }
#pragma unroll
            for (int nt = 0; nt < 2; ++nt) vbf[nt] = *(const LAS bf16x8*)(VT + (c * 32 + 16 * nt + l15) * 40 + 8 * quad);
            if (c == 0) {
#pragma unroll
                for (int nt = 0; nt < 2; ++nt)
#pragma unroll
                    for (int ks = 0; ks < 4; ++ks) sb0[nt][ks] = *(const LAS bf16x8*)(ST + (16 * nt + l15) * 136 + 32 * ks + 8 * quad);
            }
            f32x4 sc = (f32x4){0.f, 0.f, 0.f, 0.f};
#pragma unroll
            for (int ks = 0; ks < 4; ++ks) sc = __builtin_amdgcn_mfma_f32_16x16x32_bf16(qa[ks], kbf[ks], sc, 0, 0, 0);
#pragma unroll
            for (int jj = 0; jj < 4; ++jj) { const int i = 4 * quad + jj; PP[(c * 16 + i) * 40 + l15] = (bf16_t)f2bf(l15 <= i ? sc[jj] : 0.f); }
            LDS_WAIT(); asm volatile("" ::: "memory");
            const bf16x8 pa = *(const LAS bf16x8*)(PP + (c * 16 + l15) * 40 + 8 * quad);
#pragma unroll
            for (int nt = 0; nt < 2; ++nt) oi[nt] = __builtin_amdgcn_mfma_f32_16x16x32_bf16(pa, vbf[nt], oi[nt], 0, 0, 0);
        }
#pragma unroll
        for (int c = 0; c < 2; ++c) {
            if (w == c) {
                if (c == 1) {
#pragma unroll
                    for (int nt = 0; nt < 2; ++nt)
#pragma unroll
                        for (int ks = 0; ks < 4; ++ks) sb0[nt][ks] = *(const LAS bf16x8*)(ST + (16 * nt + l15) * 136 + 32 * ks + 8 * quad);
                }
#pragma unroll
                for (int ks = 0; ks < 4; ++ks)
#pragma unroll
                    for (int nt = 0; nt < 2; ++nt) oi[nt] = __builtin_amdgcn_mfma_f32_16x16x32_bf16(qa[ks], sb0[nt][ks], oi[nt], 0, 0, 0);
#pragma unroll
                for (int jj = 0; jj < 4; ++jj) { const int pp = pos_of(s0 + 16 * c + 4 * quad + jj); float* op = osrc + (rb + pp) * DM + h * 128 + 32 * es + l15; op[0] = oi[0][jj]; op[16] = oi[1][jj]; }
            }
            {
                const f32x4 dc = *(const LAS f32x4*)(DEC + c * 128 + 16 * w + 4 * quad);
                const bf16x8 ka = *(const LAS bf16x8*)(KC + (c * 128 + 16 * w + l15) * 40 + 8 * quad);
#pragma unroll
                for (int nt = 0; nt < 2; ++nt) { const bf16x8 vb = *(const LAS bf16x8*)(VT + (c * 32 + 16 * nt + l15) * 40 + 8 * quad); S[nt] = S[nt] * dc; S[nt] = __builtin_amdgcn_mfma_f32_16x16x32_bf16(ka, vb, S[nt], 0, 0, 0); }
            }
            HG_BAR();
#pragma unroll
            for (int nt = 0; nt < 2; ++nt)
#pragma unroll
                for (int jj = 0; jj < 4; ++jj) ST[(16 * nt + l15) * 136 + 16 * w + 4 * quad + jj] = (bf16_t)f2bf(S[nt][jj]);
            if (c == 1 && tb + 1 < NTB) HG_WRITE(cur ^ 1);
            HG_BAR();
        }
    }
#undef HG_ISSUE
#undef HG_WRITE
#undef HG_BAR
}
__device__ __forceinline__ void hg_scan_item_c32(Frame& F, int item) {
    const int es = item & 3, dir = (item >> 2) & 1, h = (item >> 3) & 7, b = item >> 6;
    const int tid = ftid(), lane = tid & 63, w = F.wave, quad = lane >> 4, l15 = lane & 15;
    constexpr int INB = 32 * 128 * 2 + 32 * 32;
    LAS float* sIn = (LAS float*)F.lds;
    LAS bf16_t* QA = (LAS bf16_t*)(sIn + 2 * INB);
    LAS bf16_t* KB = QA + 32 * 136;
    LAS bf16_t* KC = KB + 32 * 136;
    LAS bf16_t* VT = KC + 128 * 40;
    LAS bf16_t* PP = VT + 32 * 40;
    LAS bf16_t* ST = PP + 32 * 40;
    LAS float* DEC = (LAS float*)(ST + 32 * 136);
    const float* fsrc = (const float*)(F.ws + (dir ? WS_FB : WS_FF));
    const bf16_t* qsrc = (const bf16_t*)(F.ws + WS_PQ); const bf16_t* vsrc = (const bf16_t*)(F.ws + WS_PI);
    float* osrc = (float*)(F.ws + (dir ? WS_OB : WS_OF));
    const size_t rb = (size_t)b * SU;
    f32x4 S[2] = {(f32x4){0.f, 0.f, 0.f, 0.f}, (f32x4){0.f, 0.f, 0.f, 0.f}};
    f32x4 rf0A, rf1A, rf0B, rf1B; u32x4 rqA, rvA, rqB, rvB;
    auto pos_of = [&](int s) { return dir ? (s < NCTX ? NCTX - 1 - s : SU + NCTX - 1 - s) : s; };
#define HG_ISSUE(rf0, rf1, rq, rv, s0_) do { const int pA = pos_of((s0_) + (tid >> 5)), pB = pos_of((s0_) + 16 + (tid >> 5)), pQ = pos_of((s0_) + (tid >> 4)); \
        rf0 = *(const f32x4*)(fsrc + (rb + pA) * DM + h * 128 + 4 * (tid & 31)); rf1 = *(const f32x4*)(fsrc + (rb + pB) * DM + h * 128 + 4 * (tid & 31)); \
        rq = *(const u32x4*)(qsrc + (rb + pQ) * DM + h * 128 + 8 * (tid & 15)); \
        if (tid < 128) { const int pV = pos_of((s0_) + (tid >> 2)); rv = *(const u32x4*)(vsrc + (rb + pV) * DM + h * 128 + 32 * es + 8 * (tid & 3)); } } while (0)
#define HG_WRITE(rf0, rf1, rq, rv, buf_) do { LAS float* bF = sIn + (buf_) * INB; LAS float* bQ = bF + 32 * 128; LAS float* bV = bQ + 32 * 128; \
        *(LAS f32x4*)(bF + (tid >> 5) * 128 + 4 * (tid & 31)) = rf0; *(LAS f32x4*)(bF + (16 + (tid >> 5)) * 128 + 4 * (tid & 31)) = rf1; \
        { LAS float* d = bQ + (tid >> 4) * 128 + 8 * (tid & 15); *(LAS f32x4*)d = (f32x4){bflo(rq.x), bfhi(rq.x), bflo(rq.y), bfhi(rq.y)}; *(LAS f32x4*)(d + 4) = (f32x4){bflo(rq.z), bfhi(rq.z), bflo(rq.w), bfhi(rq.w)}; } \
        if (tid < 128) { LAS float* d = bV + (tid >> 2) * 32 + 8 * (tid & 3); *(LAS f32x4*)d = (f32x4){bflo(rv.x), bfhi(rv.x), bflo(rv.y), bfhi(rv.y)}; *(LAS f32x4*)(d + 4) = (f32x4){bflo(rv.z), bfhi(rv.z), bflo(rv.w), bfhi(rv.w)}; } } while (0)
#define HG_BAR() do { asm volatile("s_waitcnt lgkmcnt(0)" ::: "memory"); __builtin_amdgcn_s_barrier(); asm volatile("" ::: "memory"); } while (0)
    __syncthreads();
    for (int i = tid; i < 32 * 136; i += 512) ST[i] = 0;
    HG_ISSUE(rf0A, rf1A, rqA, rvA, 0); HG_WRITE(rf0A, rf1A, rqA, rvA, 0);
    HG_ISSUE(rf0B, rf1B, rqB, rvB, 32);
    __syncthreads();
    constexpr int NTB = SU / 32;
    auto blk = [&](const int tb, const int cur) __attribute__((always_inline)) {
        const int s0 = 32 * tb;
        const LAS float* sF = sIn + cur * INB; const LAS float* sQ = sF + 32 * 128; const LAS float* sV = sQ + 32 * 128;
        if (tid < 256) {
            const int c = tid & 1, d = tid >> 1;
            float fv[16], qv[16], kbv[16];
#pragma unroll
            for (int i = 0; i < 16; ++i) { fv[i] = sF[(16 * c + i) * 128 + d]; qv[i] = sQ[(16 * c + i) * 128 + d]; }
            float tot = 1.f;
#pragma unroll
            for (int i = 0; i < 16; ++i) tot *= fv[i];
            const float oth = shx(tot, 1, lane);
            float ea = c ? oth : 1.f;
            float eia = __builtin_amdgcn_rcpf(ea);
            const float al = tot * oth;
#pragma unroll
            for (int i = 0; i < 16; ++i) { const float fo = fv[i]; ea *= fo; eia *= __builtin_amdgcn_rcpf(fo);
                QA[(16 * c + i) * 136 + d] = (bf16_t)f2bf(qv[i] * ea); kbv[i] = (1.0f - fo) * eia; }
            if (c == 0) DEC[d] = al;
            unsigned pk[8];
#pragma unroll
            for (int j = 0; j < 16; ++j) KB[(16 * c + j) * 136 + d] = (bf16_t)f2bf(kbv[j]);
#pragma unroll
            for (int j = 0; j < 8; ++j) pk[j] = pk2(kbv[2 * j] * al, kbv[2 * j + 1] * al);
            LAS u32x4* kd = (LAS u32x4*)(KC + d * 40 + 16 * c); kd[0] = (u32x4){pk[0], pk[1], pk[2], pk[3]}; kd[1] = (u32x4){pk[4], pk[5], pk[6], pk[7]};
        } else {
            const int idx = tid - 256, e = idx >> 3, jq = idx & 7;
            const float v0 = sV[(4 * jq + 0) * 32 + e], v1 = sV[(4 * jq + 1) * 32 + e], v2 = sV[(4 * jq + 2) * 32 + e], v3 = sV[(4 * jq + 3) * 32 + e];
            u32x2 o; o.x = pk2(v0, v1); o.y = pk2(v2, v3); *(LAS u32x2*)(VT + e * 40 + 4 * jq) = o;
        }
        HG_BAR();
        if (w < 2) {
            const int it = w;
            bf16x8 qa[4], kbf[2][4], vbf[2], sbf[2][4];
#pragma unroll
            for (int ks = 0; ks < 4; ++ks) { qa[ks] = *(const LAS bf16x8*)(QA + (16 * it + l15) * 136 + 32 * ks + 8 * quad);
                kbf[0][ks] = *(const LAS bf16x8*)(KB + (l15) * 136 + 32 * ks + 8 * quad); kbf[1][ks] = *(const LAS bf16x8*)(KB + (16 + l15) * 136 + 32 * ks + 8 * quad); }
#pragma unroll
            for (int nt = 0; nt < 2; ++nt) { vbf[nt] = *(const LAS bf16x8*)(VT + (16 * nt + l15) * 40 + 8 * quad);
#pragma unroll
                for (int ks = 0; ks < 4; ++ks) sbf[nt][ks] = *(const LAS bf16x8*)(ST + (16 * nt + l15) * 136 + 32 * ks + 8 * quad); }
            f32x4 sc0 = (f32x4){0.f, 0.f, 0.f, 0.f}, sc1 = (f32x4){0.f, 0.f, 0.f, 0.f};
#pragma unroll
            for (int ks = 0; ks < 4; ++ks) { sc0 = __builtin_amdgcn_mfma_f32_16x16x32_bf16(qa[ks], kbf[0][ks], sc0, 0, 0, 0); sc1 = __builtin_amdgcn_mfma_f32_16x16x32_bf16(qa[ks], kbf[1][ks], sc1, 0, 0, 0); }
#pragma unroll
            for (int jj = 0; jj < 4; ++jj) { const int i = 16 * it + 4 * quad + jj;
                PP[i * 40 + l15] = (bf16_t)f2bf(l15 <= i ? sc0[jj] : 0.f); PP[i * 40 + 16 + l15] = (bf16_t)f2bf(16 + l15 <= i ? sc1[jj] : 0.f); }
            LDS_WAIT(); asm volatile("" ::: "memory");
            const bf16x8 pa = *(const LAS bf16x8*)(PP + (16 * it + l15) * 40 + 8 * quad);
            f32x4 oi[2];
#pragma unroll
            for (int nt = 0; nt < 2; ++nt) { oi[nt] = __builtin_amdgcn_mfma_f32_16x16x32_bf16(pa, vbf[nt], (f32x4){0.f, 0.f, 0.f, 0.f}, 0, 0, 0);
#pragma unroll
                for (int ks = 0; ks < 4; ++ks) oi[nt] = __builtin_amdgcn_mfma_f32_16x16x32_bf16(qa[ks], sbf[nt][ks], oi[nt], 0, 0, 0); }
#pragma unroll
            for (int jj = 0; jj < 4; ++jj) { const int pp = pos_of(s0 + 16 * it + 4 * quad + jj); float* op = osrc + (rb + pp) * DM + h * 128 + 32 * es + l15; op[0] = oi[0][jj]; op[16] = oi[1][jj]; }
        }
        {
            const f32x4 dc = *(const LAS f32x4*)(DEC + 16 * w + 4 * quad);
            const bf16x8 ka = *(const LAS bf16x8*)(KC + (16 * w + l15) * 40 + 8 * quad);
#pragma unroll
            for (int nt = 0; nt < 2; ++nt) { const bf16x8 vb = *(const LAS bf16x8*)(VT + (16 * nt + l15) * 40 + 8 * quad); S[nt] = S[nt] * dc; S[nt] = __builtin_amdgcn_mfma_f32_16x16x32_bf16(ka, vb, S[nt], 0, 0, 0); }
        }
        HG_BAR();
#pragma unroll
        for (int nt = 0; nt < 2; ++nt)
#pragma unroll
            for (int jj = 0; jj < 4; ++jj) ST[(16 * nt + l15) * 136 + 16 * w + 4 * quad + jj] = (bf16_t)f2bf(S[nt][jj]);
    };
    for (int tb = 0; tb < NTB; tb += 2) {
        { const int nb = tb + 2 < NTB ? tb + 2 : NTB - 1; HG_ISSUE(rf0A, rf1A, rqA, rvA, 32 * nb); }
        blk(tb, 0);
        HG_WRITE(rf0B, rf1B, rqB, rvB, 1);
        HG_BAR();
        { const int nb = tb + 3 < NTB ? tb + 3 : NTB - 1; HG_ISSUE(rf0B, rf1B, rqB, rvB, 32 * nb); }
        blk(tb + 1, 1);
        HG_WRITE(rf0A, rf1A, rqA, rvA, 0);
        HG_BAR();
    }
#undef HG_ISSUE
#undef HG_WRITE
#undef HG_BAR
}
__device__ __forceinline__ void hg_scan_item(Frame& F, int item) {
    const int es = item & 3, dir = (item >> 2) & 1, h = (item >> 3) & 7, b = item >> 6;
    const int tid = ftid(), lane = tid & 63, w = F.wave, quad = lane >> 4, l15 = lane & 15;
    constexpr int INB = 32 * 128 * 2 + 32 * 32;
    LAS float* sIn = (LAS float*)F.lds;
    LAS bf16_t* QA = (LAS bf16_t*)(sIn + 2 * INB);
    LAS bf16_t* KB = QA + 2 * 32 * 136;
    LAS bf16_t* KC = KB + 32 * 136;
    LAS bf16_t* VT = KC + 2 * 128 * 40;
    LAS bf16_t* PP = VT + 2 * 32 * 40;
    LAS bf16_t* ST = PP + 2 * 32 * 40;
    LAS float* DEC = (LAS float*)(ST + 2 * 32 * 136);
    const float* fsrc = (const float*)(F.ws + (dir ? WS_FB : WS_FF));
    const bf16_t* qsrc = (const bf16_t*)(F.ws + WS_PQ); const bf16_t* vsrc = (const bf16_t*)(F.ws + WS_PI);
    float* osrc = (float*)(F.ws + (dir ? WS_OB : WS_OF));
    const size_t rb = (size_t)b * SU;
    auto pos_of = [&](int s) { return dir ? (s < NCTX ? NCTX - 1 - s : SU + NCTX - 1 - s) : s; };
    constexpr int NTB = SU / 32;
#define HG_BAR() do { asm volatile("s_waitcnt lgkmcnt(0)" ::: "memory"); __builtin_amdgcn_s_barrier(); asm volatile("" ::: "memory"); } while (0)
    f32x4 rf[4]; u32x4 rq[2], rv;
#define HG_ISSUE(s0_) do { \
        _Pragma("unroll") for (int r_ = 0; r_ < 4; ++r_) rf[r_] = *(const f32x4*)(fsrc + (rb + pos_of((s0_) + (tid >> 5) + 8 * r_)) * DM + h * 128 + 4 * (tid & 31)); \
        _Pragma("unroll") for (int r_ = 0; r_ < 2; ++r_) rq[r_] = *(const u32x4*)(qsrc + (rb + pos_of((s0_) + (tid >> 4) + 16 * r_)) * DM + h * 128 + 8 * (tid & 15)); \
        if (tid < 128) rv = *(const u32x4*)(vsrc + (rb + pos_of((s0_) + (tid >> 2))) * DM + h * 128 + 32 * es + 8 * (tid & 3)); } while (0)
#define HG_WRITE(buf_) do { LAS float* bF = sIn + (buf_) * INB; LAS float* bQ = bF + 32 * 128; LAS float* bV = bQ + 32 * 128; \
        _Pragma("unroll") for (int r_ = 0; r_ < 4; ++r_) *(LAS f32x4*)(bF + ((tid >> 5) + 8 * r_) * 128 + 4 * (tid & 31)) = rf[r_]; \
        _Pragma("unroll") for (int r_ = 0; r_ < 2; ++r_) { LAS float* d = bQ + ((tid >> 4) + 16 * r_) * 128 + 8 * (tid & 15); *(LAS f32x4*)d = (f32x4){bflo(rq[r_].x), bfhi(rq[r_].x), bflo(rq[r_].y), bfhi(rq[r_].y)}; *(LAS f32x4*)(d + 4) = (f32x4){bflo(rq[r_].z), bfhi(rq[r_].z), bflo(rq[r_].w), bfhi(rq[r_].w)}; } \
        if (tid < 128) { LAS float* d = bV + (tid >> 2) * 32 + 8 * (tid & 3); *(LAS f32x4*)d = (f32x4){bflo(rv.x), bfhi(rv.x), bflo(rv.y), bfhi(rv.y)}; *(LAS f32x4*)(d + 4) = (f32x4){bflo(rv.z), bfhi(rv.z), bflo(rv.w), bfhi(rv.w)}; } } while (0)
    f32x4 S[2][2];
#pragma unroll
    for (int a = 0; a < 2; ++a)
#pragma unroll
        for (int c2 = 0; c2 < 2; ++c2) S[a][c2] = (f32x4){0.f, 0.f, 0.f, 0.f};
    __syncthreads();
    for (int i = tid; i < 2 * 32 * 136; i += 512) ST[i] = 0;
    if (w < 4) { HG_ISSUE(0); HG_WRITE(0); HG_ISSUE(32); }
    __syncthreads();
    for (int j = 0; j <= NTB; ++j) {
        const int sp = j & 1;
        const int t = j - 1, sc_ = t & 1;
        f32x4 oi = (f32x4){0.f, 0.f, 0.f, 0.f};
        if (w < 4) {
            if (j < NTB) {
                const LAS float* sF = sIn + sp * INB; const LAS float* sQ = sF + 32 * 128; const LAS float* sV = sQ + 32 * 128;
                const int cq = w, dp = lane;
                f32x2 fv[32], qv[8];
#pragma unroll
                for (int i = 0; i < 32; ++i) fv[i] = *(const LAS f32x2*)(sF + i * 128 + 2 * dp);
                f32x2 fq[8];
#pragma unroll
                for (int i = 0; i < 8; ++i) { qv[i] = *(const LAS f32x2*)(sQ + (8 * cq + i) * 128 + 2 * dp); fq[i] = *(const LAS f32x2*)(sF + (8 * cq + i) * 128 + 2 * dp); }
                const int e = tid >> 3, jq = tid & 7;
                const float v0 = sV[(4 * jq + 0) * 32 + e], v1 = sV[(4 * jq + 1) * 32 + e], v2 = sV[(4 * jq + 2) * 32 + e], v3 = sV[(4 * jq + 3) * 32 + e];
                f32x2 qp[4];
#pragma unroll
                for (int c4 = 0; c4 < 4; ++c4) { f32x2 pr = fv[8 * c4];
#pragma unroll
                    for (int i = 1; i < 8; ++i) pr = pr * fv[8 * c4 + i]; qp[c4] = pr; }
                f32x2 ea = (f32x2){1.f, 1.f};
#pragma unroll
                for (int c4 = 0; c4 < 3; ++c4) { if (c4 < cq) ea = ea * qp[c4]; }
                const f32x2 al = (qp[0] * qp[1]) * (qp[2] * qp[3]);
                f32x2 eia; eia.x = __builtin_amdgcn_rcpf(ea.x); eia.y = __builtin_amdgcn_rcpf(ea.y);
                LAS bf16_t* qa_ = QA + sp * 32 * 136;
                f32x2 kbv[8];
#pragma unroll
                for (int i = 0; i < 8; ++i) { const f32x2 fo = fq[i];
                    ea = ea * fo; f32x2 rf_; rf_.x = __builtin_amdgcn_rcpf(fo.x); rf_.y = __builtin_amdgcn_rcpf(fo.y); eia = eia * rf_;
                    const f32x2 qa2 = qv[i] * ea; kbv[i] = ((f32x2){1.f, 1.f} - fo) * eia;
                    *(LAS unsigned*)(qa_ + (8 * cq + i) * 136 + 2 * dp) = pk2(qa2.x, qa2.y);
                    *(LAS unsigned*)(KB + (8 * cq + i) * 136 + 2 * dp) = pk2(kbv[i].x, kbv[i].y); }
                if (cq == 0) *(LAS f32x2*)(DEC + sp * 128 + 2 * dp) = al;
                u32x4 k0, k1;
                k0.x = pk2(kbv[0].x * al.x, kbv[1].x * al.x); k0.y = pk2(kbv[2].x * al.x, kbv[3].x * al.x); k0.z = pk2(kbv[4].x * al.x, kbv[5].x * al.x); k0.w = pk2(kbv[6].x * al.x, kbv[7].x * al.x);
                k1.x = pk2(kbv[0].y * al.y, kbv[1].y * al.y); k1.y = pk2(kbv[2].y * al.y, kbv[3].y * al.y); k1.z = pk2(kbv[4].y * al.y, kbv[5].y * al.y); k1.w = pk2(kbv[6].y * al.y, kbv[7].y * al.y);
                *(LAS u32x4*)(KC + (sp * 128 + 2 * dp) * 40 + 8 * cq) = k0; *(LAS u32x4*)(KC + (sp * 128 + 2 * dp + 1) * 40 + 8 * cq) = k1;
                u32x2 o; o.x = pk2(v0, v1); o.y = pk2(v2, v3); *(LAS u32x2*)(VT + (sp * 32 + e) * 40 + 4 * jq) = o;
            }
        } else if (t >= 0) {
            const int k = w - 4, it = k >> 1, nt = k & 1;
            const bf16x8 pa = *(const LAS bf16x8*)(PP + (sc_ * 32 + 16 * it + l15) * 40 + 8 * quad);
            const bf16x8 vb = *(const LAS bf16x8*)(VT + (sc_ * 32 + 16 * nt + l15) * 40 + 8 * quad);
            bf16x8 qa[4], sb[4];
#pragma unroll
            for (int ks = 0; ks < 4; ++ks) { qa[ks] = *(const LAS bf16x8*)(QA + (sc_ * 32 + 16 * it + l15) * 136 + 32 * ks + 8 * quad); sb[ks] = *(const LAS bf16x8*)(ST + (sc_ * 32 + 16 * nt + l15) * 136 + 32 * ks + 8 * quad); }
            oi = __builtin_amdgcn_mfma_f32_16x16x32_bf16(pa, vb, oi, 0, 0, 0);
#pragma unroll
            for (int ks = 0; ks < 4; ++ks) oi = __builtin_amdgcn_mfma_f32_16x16x32_bf16(qa[ks], sb[ks], oi, 0, 0, 0);
#pragma unroll
            for (int jj = 0; jj < 4; ++jj) { const int pp = pos_of(32 * t + 16 * it + 4 * quad + jj); osrc[(rb + pp) * DM + h * 128 + 32 * es + 16 * nt + l15] = oi[jj]; }
        }
        HG_BAR();
        if (w < 2) {
            if (j < NTB) {
                const int it = w;
                bf16x8 qa[4], kbf[2][4];
#pragma unroll
                for (int ks = 0; ks < 4; ++ks) { qa[ks] = *(const LAS bf16x8*)(QA + (sp * 32 + 16 * it + l15) * 136 + 32 * ks + 8 * quad);
                    kbf[0][ks] = *(const LAS bf16x8*)(KB + (l15) * 136 + 32 * ks + 8 * quad); kbf[1][ks] = *(const LAS bf16x8*)(KB + (16 + l15) * 136 + 32 * ks + 8 * quad); }
                f32x4 sc0 = (f32x4){0.f, 0.f, 0.f, 0.f}, sc1 = (f32x4){0.f, 0.f, 0.f, 0.f};
#pragma unroll
                for (int ks = 0; ks < 4; ++ks) { sc0 = __builtin_amdgcn_mfma_f32_16x16x32_bf16(qa[ks], kbf[0][ks], sc0, 0, 0, 0); sc1 = __builtin_amdgcn_mfma_f32_16x16x32_bf16(qa[ks], kbf[1][ks], sc1, 0, 0, 0); }
#pragma unroll
                for (int jj = 0; jj < 4; ++jj) { const int i = 16 * it + 4 * quad + jj;
                    PP[(sp * 32 + i) * 40 + l15] = (bf16_t)f2bf(l15 <= i ? sc0[jj] : 0.f); PP[(sp * 32 + i) * 40 + 16 + l15] = (bf16_t)f2bf(16 + l15 <= i ? sc1[jj] : 0.f); }
            }
        } else if (w >= 4 && t >= 0) {
            const int k = w - 4;
#pragma unroll
            for (int mt = 0; mt < 2; ++mt) {
                const f32x4 dc = *(const LAS f32x4*)(DEC + sc_ * 128 + 32 * k + 16 * mt + 4 * quad);
                const bf16x8 ka = *(const LAS bf16x8*)(KC + (sc_ * 128 + 32 * k + 16 * mt + l15) * 40 + 8 * quad);
#pragma unroll
                for (int n2 = 0; n2 < 2; ++n2) { const bf16x8 vb2 = *(const LAS bf16x8*)(VT + (sc_ * 32 + 16 * n2 + l15) * 40 + 8 * quad); S[mt][n2] = S[mt][n2] * dc; S[mt][n2] = __builtin_amdgcn_mfma_f32_16x16x32_bf16(ka, vb2, S[mt][n2], 0, 0, 0); }
            }
            LAS bf16_t* stn = ST + (sc_ ^ 1) * 32 * 136;
#pragma unroll
            for (int mt = 0; mt < 2; ++mt)
#pragma unroll
                for (int n2 = 0; n2 < 2; ++n2)
                    { u32x2 o2; o2.x = pk2(S[mt][n2][0], S[mt][n2][1]); o2.y = pk2(S[mt][n2][2], S[mt][n2][3]); *(LAS u32x2*)(stn + (16 * n2 + l15) * 136 + 32 * k + 16 * mt + 4 * quad) = o2; }
        }
        if (w < 4 && j + 1 < NTB) { HG_WRITE((j + 1) & 1); if (j + 2 < NTB) HG_ISSUE(32 * (j + 2)); }
        HG_BAR();
    }
#undef HG_ISSUE
#undef HG_WRITE
#undef HG_BAR
}
__device__ __forceinline__ void naive_hg_scan(Frame& F) {
    const int gt = fbid() * 512 + ftid();
    if (gt >= NB * 8 * 2 * 128) return;
    const int e = gt & 127, dir = (gt >> 7) & 1, h = (gt >> 8) & 7, b = gt >> 11;
    const float* fsrc = (const float*)(F.ws + (dir ? WS_FB : WS_FF));
    const bf16_t* qsrc = (const bf16_t*)(F.ws + WS_PQ); const bf16_t* vsrc = (const bf16_t*)(F.ws + WS_PI);
    float* osrc = (float*)(F.ws + (dir ? WS_OB : WS_OF));
    float S[128];
#pragma unroll
    for (int d = 0; d < 128; ++d) S[d] = 0.f;
    for (int s_ = 0; s_ < SU; ++s_) {
        const int pp = dir ? (s_ < NCTX ? NCTX - 1 - s_ : SU + NCTX - 1 - s_) : s_;
        const size_t row = (size_t)b * SU + pp;
        const float v = bf2f(vsrc[row * DM + h * 128 + e]);
        const float* fr = fsrc + row * DM + h * 128; const bf16_t* qr = qsrc + row * DM + h * 128;
        float o = 0.f;
#pragma unroll
        for (int d = 0; d < 128; ++d) { const float f = fr[d]; S[d] = f * S[d] + (1.0f - f) * v; o += bf2f(qr[d]) * S[d]; }
        osrc[row * DM + h * 128 + e] = o;
    }
}
__device__ __forceinline__ void naive_hg_readout(Frame& F, const Args& args, int p) {
    for (int i = fbid() * 512 + ftid(); i < MTOK * 8; i += F.G * 512) {
        const int row = i >> 3, h = i & 7;
        const float* a = (const float*)(F.ws + WS_OF) + (size_t)row * DM + h * 128; const float* c = (const float*)(F.ws + WS_OB) + (size_t)row * DM + h * 128;
        float ss = 0.f;
        for (int d = 0; d < 128; ++d) { const float o = a[d] + c[d]; ss += o * o; }
        const float rstd = 1.0f / sqrtf(ss / 128.f + EPS);
        const bf16_t* g = (const bf16_t*)(F.ws + WS_PG) + (size_t)row * DM + h * 128; bf16_t* y = (bf16_t*)(F.ws + WS_YB16) + (size_t)row * DM + h * 128;
        for (int d = 0; d < 128; ++d) { const float o = a[d] + c[d]; const float gv = bf2f(g[d]); y[d] = (bf16_t)f2bf(o * rstd * args.in[I_HGNW][p * 128 + d] * (gv / (1.0f + expf(-gv)))); }
    }
}
__device__ __forceinline__ void hg_readout_phase(Frame& F, const Args& args, int p) {
    const int gw = F.vcu * NWAVES + F.wave, NGW = F.G * NWAVES, lane = flane();
    const float* nw = ((const float*)(F.ws + WS_SP) + SP_HGNW) + p * 128 + 16 * (lane & 7);
    for (int row = gw; row < MTOK; row += NGW) {
        const f32x4* a = (const f32x4*)(F.ws + WS_OF + (size_t)row * DM * 4) + 4 * lane; const f32x4* c = (const f32x4*)(F.ws + WS_OB + (size_t)row * DM * 4) + 4 * lane;
        f32x4 o[4]; float ss = 0.f;
#pragma unroll
        for (int j = 0; j < 4; ++j) { o[j] = ABL_HGB0 ? a[j] : a[j] + c[j]; ss += (o[j].x * o[j].x + o[j].y * o[j].y) + (o[j].z * o[j].z + o[j].w * o[j].w); }
        ss += shx(ss, 1, lane); ss += shx(ss, 2, lane); ss += shx(ss, 4, lane);
        const float rstd = 1.0f / sqrtf(ss * (1.0f / 128.f) + EPS);
        const u32x4* gp = (const u32x4*)(F.ws + WS_PG + (size_t)row * DM * 2) + 2 * lane;
        const u32x4 g0 = gp[0], g1 = gp[1]; const unsigned gwv[8] = {g0.x, g0.y, g0.z, g0.w, g1.x, g1.y, g1.z, g1.w};
        unsigned outw[8];
#pragma unroll
        for (int j = 0; j < 4; ++j) { const f32x4 wv = *(const f32x4*)(nw + 4 * j);
            const float y0 = o[j].x * rstd * wv.x * siluf(bflo(gwv[2 * j])), y1 = o[j].y * rstd * wv.y * siluf(bfhi(gwv[2 * j]));
            const float y2 = o[j].z * rstd * wv.z * siluf(bflo(gwv[2 * j + 1])), y3 = o[j].w * rstd * wv.w * siluf(bfhi(gwv[2 * j + 1]));
            outw[2 * j] = pk2(y0, y1); outw[2 * j + 1] = pk2(y2, y3); }
        u32x4* op = (u32x4*)(F.ws + WS_YB16 + (size_t)row * DM * 2) + 2 * lane;
        op[0] = (u32x4){outw[0], outw[1], outw[2], outw[3]}; op[1] = (u32x4){outw[4], outw[5], outw[6], outw[7]};
    }
}

constexpr int NPHASE = 2 + 9 * DEPTH;
constexpr unsigned KM_ALL = 0x7ffu | (3u << 16);
template <unsigned KM>
__device__ __forceinline__ void mk_body(const Args& args, unsigned char* lds_raw) {
    Frame F;
    F.lds = (LAS unsigned char*)lds_raw;
    F.MISC = (volatile LAS unsigned*)(F.lds + MISC_OFF);
    F.wave = __builtin_amdgcn_readfirstlane(ftid() >> 6);
    F.G = gridDim.x; { const int bx = blockIdx.x; F.vcu = (F.G % 8 == 0) ? (bx % 8) * (F.G / 8) + bx / 8 : bx; }
    F.ws = args.ws; F.ctl = (unsigned*)(args.ws + WS_CTL);
    for (int u = ftid(); u < (LDS_BYTES - LDSCTL_OFF) / 4; u += NWAVES * 64) ((LAS unsigned*)(F.lds + LDSCTL_OFF))[u] = 0u;
    __syncthreads();
    XcdBarrier bar; bar.bar = F.ctl + CW_BAR; bar.x = 0; bar.st = nullptr;
    const int lo = args.ph_lo, hi = args.ph_hi;
    if (hi - lo > 1) bar = xcd_barrier_post(F.ctl + CW_BAR, F.MISC + 8);
#define HAS(kind) ((KM >> (kind)) & 1u)
    if constexpr (HAS(0)) { if (lo == 0) { p0_prologue(F, args); if (NAIVE_MOD) { __syncthreads(); naive_mod(F, args); } if (hi > 1) xcd_barrier(bar); } }
    float* const outp = args.out;
#pragma nounroll
    for (int ph = (lo == 0 ? 1 : lo); ph < hi; ++ph) {
        const Args* ap = &args;
        { unsigned char* w_ = args.ws; asm volatile("" : "+s"(w_)); F.ws = w_; F.ctl = (unsigned*)(w_ + WS_CTL); }
        { int wv_ = __builtin_amdgcn_readfirstlane(ftid() >> 6); F.wave = wv_; int g_ = (int)gridDim.x; asm volatile("" : "+s"(g_)); F.G = g_; const int bx = fbid(); F.vcu = (g_ % 8 == 0) ? (bx % 8) * (g_ / 8) + bx / 8 : bx; }
        const float* mod = (const float*)(F.ws + WS_MOD);
        const int kind = (ph == 0) ? 0 : (ph == NPHASE - 1 ? 10 : 1 + (ph - 1) % 9);
        const int l = (ph - 1) / 9; const int odd = l & 1, p = l >> 1;
        if (kind == 5 && odd) continue;
        switch (kind) {
        case 1: if constexpr (HAS(1)) { if (NAIVE_N1 == 1) naive_n1(F, *ap, l, false); else if (NAIVE_N1 == 2) wave_n1(F, *ap, l, false); else n1_phase<false>(F, *ap, l); } break;
        case 2: if constexpr (HAS(2)) {
            const int N = odd ? OD_N : EV_N;
            if (NAIVE_G1) { naive_g1(F, *ap, l); } else {
            pg8::PlainAddr AD{(const bf16_t*)(F.ws + WS_HB), (const bf16_t*)(F.ws + (odd ? WS_W_ODIN + (size_t)p * 10 * MiB : WS_W_EVIN + (size_t)p * 6 * MiB)), DM};
            pg8::StaticOrder S; S.init(MTOK, N, F.G, fbid());
            EpiProj E{F.ws, (const float*)(F.ws + WS_LB) + l * DM, odd};
            pg8::gemm_phase(F.lds, AD, S, E, DM);
            } } break;
        case 3: if constexpr (HAS(3)) {
            if (!odd) {
                if constexpr (HAS(16)) {
                    for (int it = fbid(); it < NB * 4 * NCHUNK + (NAIVE_ATT ? 0 : NB * 2 * NCHUNK); it += F.G) {
                        if (it < NB * 4 * NCHUNK) ret_state_item(F, *ap, p, it); else att_item(F, *ap, p, it - NB * 4 * NCHUNK);
                    }
                    if (NAIVE_ATT) { __syncthreads(); naive_att(F, *ap, p); }
                }
            } else {
                if constexpr (HAS(17)) { if (NAIVE_HG) naive_hg_scan(F); else for (int it = fbid(); it < NB * 8 * 2 * 4; it += F.G) hg_scan_item(F, it); }
            }
            __syncthreads(); } break;
        case 4: if constexpr (HAS(4)) {
            if (!odd) { if constexpr (HAS(16)) ret_scan_phase(F, *ap, p); } else { if constexpr (HAS(17)) { if (NAIVE_HG) naive_hg_readout(F, *ap, p); else hg_readout_phase(F, *ap, p); } } } break;
        case 5: if constexpr (HAS(5)) { for (int it = fbid(); it < NB * 4 * NCHUNK; it += F.G) { if (RET_DIRECT) ret_direct_item(F, *ap, p, it); else ret_out_item(F, *ap, p, it); } __syncthreads(); } break;
        case 6: if constexpr (HAS(6)) {
            if (NAIVE_G2) { if (odd ? CONTRIB_ODD : CONTRIB_EVEN) naive_g2(F, *ap, l); } else {
            pg8::PlainAddr AD{(const bf16_t*)(F.ws + WS_YB16), (const bf16_t*)(F.ws + (odd ? WS_W_ODOUT : WS_W_EVOUT) + (size_t)p * 2 * MiB), DM};
            pg8::StaticOrder S; S.init(MTOK, DM, F.G, fbid());
            EpiOut E{(float*)(F.ws + WS_XRES), mod + (size_t)l * 5 * 6144, odd ? CONTRIB_ODD : CONTRIB_EVEN};
            pg8::gemm_phase(F.lds, AD, S, E, DM);
            } } break;
        case 7: if constexpr (HAS(7)) { if (NAIVE_N2R) naive_n2r(F, *ap, l); else n2r_phase(F, *ap, l); } break;
        case 8: case 9: if constexpr (HAS(8) || HAS(9)) {
            LAS int* tstart = (LAS int*)(F.lds + LDSCTL_OFF + 512); LAS int* cnts = (LAS int*)(F.lds + LDSCTL_OFF + 768);
            __syncthreads();
            if (F.wave == 0) { int mycnt; const int pre = moe_tile_prefix(F.ctl + CW_CNT + l * NEXP, flane(), mycnt); if (flane() <= NEXP) tstart[flane()] = pre; if (flane() < NEXP) cnts[flane()] = mycnt; }
            __syncthreads();
            const int ntiles = tstart[NEXP];
            const bf16_t* wmoe = (const bf16_t*)(F.ws + WS_W_MOE + (size_t)l * NEXP * 3 * MiB);
            if (kind == 8) { if constexpr (HAS(8)) {
                if (NAIVE_MOE) naive_moe(F, *ap, l); else {
                pg8::MoeGatherAddr AD{(const bf16_t*)(F.ws + WS_HB), wmoe, (const unsigned*)(F.ws + WS_LIST), DM};
                pg8::MoeOrder S{tstart, cnts, ntiles, F.G, fbid()};
                EpiAct E{(bf16_t*)(F.ws + WS_ACT)};
                pg8::gemm_phase(F.lds, AD, S, E, DM); }
            } } else { if constexpr (HAS(9)) {
                pg8::MoeActAddr AD{(const bf16_t*)(F.ws + WS_ACT), wmoe + (size_t)DM * DM, FF};
                pg8::MoeOrder S{tstart, cnts, ntiles, F.G, fbid()};
                EpiY E{(bf16_t*)(F.ws + WS_YB)};
                pg8::gemm_phase(F.lds, AD, S, E, FF);
            } } } break;
        default: if constexpr (HAS(10)) { if (NAIVE_FINAL == 1) naive_n1(F, *ap, DEPTH, true); else if (NAIVE_FINAL == 2) wave_n1(F, *ap, DEPTH, true); else n1_phase<true>(F, *ap, DEPTH); } break;
        }
        if (ph + 1 < hi) xcd_barrier(bar);
    }
#undef HAS
}
template <int L>
__device__ __forceinline__ void layer_sl(Frame& F, const Args& args, const XcdBarrier& bar) {
    constexpr int l = L; constexpr int odd = L & 1, p = L >> 1;
    const float* mod = (const float*)(F.ws + WS_MOD);
    n1_phase<false>(F, args, l); xcd_barrier(bar);
    { pg8::PlainAddr AD{(const bf16_t*)(F.ws + WS_HB), (const bf16_t*)(F.ws + (odd ? WS_W_ODIN + (size_t)p * 10 * MiB : WS_W_EVIN + (size_t)p * 6 * MiB)), DM};
      pg8::StaticOrder S; S.init(MTOK, odd ? OD_N : EV_N, F.G, fbid());
      EpiProj E{F.ws, (const float*)(F.ws + WS_LB) + l * DM, odd};
      pg8::gemm_phase(F.lds, AD, S, E, DM); }
    xcd_barrier(bar);
    if constexpr (!odd) {
        {
            const int bx = fbid();
            if (F.G == 256) {
                att_item(F, args, p, bx);
                if (bx < 16) att_item(F, args, p, 256 + bx);
                else { const int r0 = 2 * (bx - 16); ret_state_item(F, args, p, r0); ret_state_item(F, args, p, r0 + 1); if (bx - 16 < 64) ret_state_item(F, args, p, 480 + (bx - 16)); }
            } else {
                for (int it = bx; it < NB * 4 * NCHUNK + NB * 2 * NCHUNK; it += F.G) { if (it < NB * 2 * NCHUNK) att_item(F, args, p, it); else ret_state_item(F, args, p, it - NB * 2 * NCHUNK); }
            }
        }
        __syncthreads(); xcd_barrier(bar);
        ret_scan_phase(F, args, p); xcd_barrier(bar);
        for (int rep_ = 0; rep_ <= REP_MIXE; ++rep_) for (int it = fbid(); it < NB * 4 * NCHUNK; it += F.G) ret_out_item(F, args, p, it);
        __syncthreads(); xcd_barrier(bar);
    } else {
        for (int rep_ = 0; rep_ <= REP_HG; ++rep_) for (int it = F.vcu; it < NB * 8 * 2 * 4; it += F.G) hg_scan_item(F, it);
        __syncthreads(); xcd_barrier(bar);
        hg_readout_phase(F, args, p); xcd_barrier(bar);
    }
    { pg8::PlainAddr AD{(const bf16_t*)(F.ws + WS_YB16), (const bf16_t*)(F.ws + (odd ? WS_W_ODOUT : WS_W_EVOUT) + (size_t)p * 2 * MiB), DM};
      pg8::StaticOrder S; S.init(MTOK, DM, F.G, fbid(), l == DEPTH - 1 ? 1 : 0);
      EpiOut E{(float*)(F.ws + WS_XRES), mod + (size_t)l * 5 * 6144, 1};
      pg8::gemm_phase(F.lds, AD, S, E, DM); }
    xcd_barrier(bar);
    n2r_phase(F, args, l); xcd_barrier(bar);
    {   LAS int* tstart = (LAS int*)(F.lds + LDSCTL_OFF + 512); LAS int* cnts = (LAS int*)(F.lds + LDSCTL_OFF + 768);
        __syncthreads();
        if (F.wave == 0) { int mycnt; const int ln = flane(); const int pre = moe_tile_prefix(F.ctl + CW_CNT + l * NEXP, ln, mycnt); if (ln <= NEXP) tstart[ln] = pre; if (ln < NEXP) cnts[ln] = mycnt; }
        __syncthreads();
        const int ntiles = tstart[NEXP];
        const bf16_t* wmoe = (const bf16_t*)(F.ws + WS_W_MOE + (size_t)l * NEXP * 3 * MiB);
        { pg8::MoeGatherAddr AD{(const bf16_t*)(F.ws + WS_HB), wmoe, (const unsigned*)(F.ws + WS_LIST), DM};
          pg8::MoeOrder S{tstart, cnts, ntiles, F.G, fbid()};
          EpiAct E{(bf16_t*)(F.ws + WS_ACT)};
          pg8::gemm_phase(F.lds, AD, S, E, DM); }
        xcd_barrier(bar);
        { pg8::MoeActAddr AD{(const bf16_t*)(F.ws + WS_ACT), wmoe + (size_t)DM * DM, FF};
          pg8::MoeOrder S{tstart, cnts, ntiles, F.G, fbid()};
          EpiY E{(bf16_t*)(F.ws + WS_YB)};
          pg8::gemm_phase(F.lds, AD, S, E, FF); }
        xcd_barrier(bar);
    }
}
__global__ void __launch_bounds__(NWAVES * 64, 2) mk_one(Args args) {
    extern __shared__ __attribute__((aligned(16))) unsigned char lds_raw[];
    Frame F;
    F.lds = (LAS unsigned char*)lds_raw;
    F.MISC = (volatile LAS unsigned*)(F.lds + MISC_OFF);
    F.wave = __builtin_amdgcn_readfirstlane(ftid() >> 6);
    F.G = gridDim.x; { const int bx = blockIdx.x; F.vcu = (F.G % 8 == 0) ? (bx % 8) * (F.G / 8) + bx / 8 : bx; }
    F.ws = args.ws; F.ctl = (unsigned*)(args.ws + WS_CTL);
    for (int u = ftid(); u < (LDS_BYTES - LDSCTL_OFF) / 4; u += NWAVES * 64) ((LAS unsigned*)(F.lds + LDSCTL_OFF))[u] = 0u;
    __syncthreads();
    const XcdBarrier bar = xcd_barrier_post(F.ctl + CW_BAR, F.MISC + 8);
    p0_prologue(F, args); xcd_barrier(bar);
    layer_sl<0>(F, args, bar);
    layer_sl<1>(F, args, bar);
    layer_sl<2>(F, args, bar);
    layer_sl<3>(F, args, bar);
    n1_phase<true>(F, args, DEPTH);
}

template <unsigned KM>
__global__ void __launch_bounds__(NWAVES * 64, 2) mk_fwd(Args args) {
    extern __shared__ __attribute__((aligned(16))) unsigned char lds_raw[];
    mk_body<KM>(args, lds_raw);
}

template <unsigned KM> static bool prep_kernel() { return hipFuncSetAttribute((const void*)mk_fwd<KM>, hipFuncAttributeMaxDynamicSharedMemorySize, LDS_BYTES) == hipSuccess; }
template <unsigned KM> static void launch_kernel(int grid, hipStream_t stream, const Args& a) { hipLaunchKernelGGL(mk_fwd<KM>, dim3(grid), dim3(NWAVES * 64), LDS_BYTES, stream, a); }
#define KEV (1u << 16)
#define KOD (1u << 17)
extern "C" void kernel_launch(void* const* d_in, const int* in_sizes, int n_in, void* d_out, int out_size, void* d_ws, size_t ws_size, hipStream_t stream) {
    static int grid = 0;
    if (grid == 0) {
        const int exp_sizes[23] = {NB * LSEQ * DM, NB * DM, NB * NCTX * DM, DM, DEPTH * DM * 6 * DM, DEPTH * 6 * DM, DEPTH * 2 * DM, DM, 2 * DM * EV_N, 2 * DM * DM, 16, 8,
                                   2 * DM * OD_N, 2 * DM * DM, DEPTH * DM, 2 * 128, DEPTH * DM * 4, DEPTH * 4, DEPTH * 4 * DM * 8, DEPTH * 32, DEPTH * NEXP * DM * FF, DEPTH * NEXP * DM * FF, DEPTH * NEXP * FF * DM};
        bool sz_ok = (n_in == 23) && out_size == NB * LSEQ * DM;
        for (int i = 0; i < 23 && sz_ok; ++i) sz_ok = (in_sizes[i] == exp_sizes[i]);
        if (!sz_ok) { fprintf(stderr, "kernel_launch: unexpected input sizes\n"); grid = -1; return; }
        if (n_in != 23 || ws_size < WS_END) { fprintf(stderr, "kernel_launch: unexpected n_in %d / ws_size %zu\n", n_in, ws_size); grid = -1; return; }
        int dev = 0, cus = 0;
        if (hipGetDevice(&dev) != hipSuccess || hipDeviceGetAttribute(&cus, hipDeviceAttributeMultiprocessorCount, dev) != hipSuccess) { grid = -1; return; }
        bool ok = true;
#if MK_PER_PHASE
        ok = ok && prep_kernel<1u << 0>() && prep_kernel<1u << 1>() && prep_kernel<1u << 2>() && prep_kernel<(1u << 3) | KEV>() && prep_kernel<(1u << 3) | KOD>()
                && prep_kernel<(1u << 4) | KEV>() && prep_kernel<(1u << 4) | KOD>() && prep_kernel<(1u << 5) | KEV>() && prep_kernel<1u << 6>() && prep_kernel<1u << 7>()
                && prep_kernel<1u << 8>() && prep_kernel<1u << 9>() && prep_kernel<1u << 10>();
#else
        ok = ok && (hipFuncSetAttribute((const void*)mk_one, hipFuncAttributeMaxDynamicSharedMemorySize, LDS_BYTES) == hipSuccess);
#ifdef PROBE_MASKS
        ok = ok && prep_kernel<(1u<<3)|(3u<<16)>() && prep_kernel<(1u<<3)|(1u<<5)|(1u<<16)>() && prep_kernel<(1u<<0)|(1u<<1)|(1u<<7)|(1u<<10)>() && prep_kernel<(1u<<3)|(1u<<4)|(1u<<5)|(3u<<16)>() && prep_kernel<(1u<<0)|(1u<<3)|(1u<<16)>() && prep_kernel<(1u<<1)|(1u<<3)|(1u<<16)>();
#endif
#endif
        if (!ok) { fprintf(stderr, "kernel_launch: hipFuncSetAttribute failed\n"); grid = -1; return; }
        (void)hipGetLastError();
        grid = cus > 256 ? 256 : cus;
    }
    if (grid < 0) return;
    (void)hipMemsetAsync((char*)d_ws + WS_CTL, 0, CTL_ZERO_BYTES, stream);
    Args a{};
    for (int i = 0; i < 23; ++i) a.in[i] = (const float*)d_in[i];
    a.out = (float*)d_out; a.ws = (unsigned char*)d_ws;
#if MK_PER_PHASE
    for (int ph = 0; ph < NPHASE; ++ph) {
        { unsigned char* w_ = args.ws; asm volatile("" : "+s"(w_)); F.ws = w_; F.ctl = (unsigned*)(w_ + WS_CTL); }
        { int wv_ = __builtin_amdgcn_readfirstlane(ftid() >> 6); F.wave = wv_; int g_ = (int)gridDim.x; asm volatile("" : "+s"(g_)); F.G = g_; const int bx = fbid(); F.vcu = (g_ % 8 == 0) ? (bx % 8) * (g_ / 8) + bx / 8 : bx; }
        const float* mod = (const float*)(F.ws + WS_MOD);
        const int kind = (ph == 0) ? 0 : (ph == NPHASE - 1 ? 10 : 1 + (ph - 1) % 9); const int l = (ph - 1) / 9; const bool odd = (l & 1) != 0;
        if (kind == 5 && odd) continue;
        a.ph_lo = ph; a.ph_hi = ph + 1;
        switch (kind) {
            case 0: launch_kernel<1u << 0>(grid, stream, a); break;
            case 1: launch_kernel<1u << 1>(grid, stream, a); break;
            case 2: launch_kernel<1u << 2>(grid, stream, a); break;
            case 3: if (odd) launch_kernel<(1u << 3) | KOD>(grid, stream, a); else launch_kernel<(1u << 3) | KEV>(grid, stream, a); break;
            case 4: if (odd) launch_kernel<(1u << 4) | KOD>(grid, stream, a); else launch_kernel<(1u << 4) | KEV>(grid, stream, a); break;
            case 5: launch_kernel<(1u << 5) | KEV>(grid, stream, a); break;
            case 6: launch_kernel<1u << 6>(grid, stream, a); break;
            case 7: launch_kernel<1u << 7>(grid, stream, a); break;
            case 8: launch_kernel<1u << 8>(grid, stream, a); break;
            case 9: launch_kernel<1u << 9>(grid, stream, a); break;
            default: launch_kernel<1u << 10>(grid, stream, a); break;
        }
    }
#else
    a.ph_lo = 0; a.ph_hi = NPHASE;
    hipLaunchKernelGGL(mk_one, dim3(grid), dim3(NWAVES * 64), LDS_BYTES, stream, a);
#endif
}
```

```cpp
#include <hip/hip_runtime.h>
#include <cstdio>
#include <cstdint>

#ifndef MK_PER_PHASE
#define MK_PER_PHASE 0
#endif

#ifndef CONTRIB_EVEN
#define CONTRIB_EVEN 1
#endif
#ifndef CONTRIB_ODD
#define CONTRIB_ODD 1
#endif
#ifndef CONTRIB_MOE
#define CONTRIB_MOE 1
#endif
#ifndef ABL_ATT0
#define ABL_ATT0 0
#endif
#ifndef ABL_RET0
#define ABL_RET0 0
#endif
#ifndef ABL_HGB0
#define ABL_HGB0 0
#endif
#ifndef RET_DIRECT
#define RET_DIRECT 0
#endif
#ifndef NAIVE_G1
#define NAIVE_G1 0
#endif
#ifndef NAIVE_G2
#define NAIVE_G2 0
#endif
#ifndef NAIVE_MOD
#define NAIVE_MOD 0
#endif
#ifndef NAIVE_MOE
#define NAIVE_MOE 0
#endif
#ifndef NAIVE_ATT
#define NAIVE_ATT 0
#endif
#ifndef NAIVE_HG
#define NAIVE_HG 0
#endif
#ifndef NAIVE_N2R
#define NAIVE_N2R 0
#endif
#ifndef NAIVE_COPY
#define NAIVE_COPY 0
#endif
#ifndef NAIVE_N1
#define NAIVE_N1 0
#endif
#ifndef NAIVE_FINAL
#define NAIVE_FINAL 0
#endif
#ifndef MUT_A
#define MUT_A 0
#endif
#ifndef MUT_B
#define MUT_B 0
#endif
#ifndef MUT_D
#define MUT_D 0
#endif
#ifndef REP_CONV
#define REP_CONV 0
#endif
#ifndef REP_HG
#define REP_HG 0
#endif
#ifndef REP_MIXE
#define REP_MIXE 0
#endif
#define LAS __attribute__((address_space(3)))
#define GAS __attribute__((address_space(1)))
typedef unsigned short bf16_t;
typedef short bf16x8 __attribute__((ext_vector_type(8)));
typedef float f32x4 __attribute__((ext_vector_type(4)));
typedef float f32x2 __attribute__((ext_vector_type(2)));
typedef unsigned u32x4 __attribute__((ext_vector_type(4)));
typedef unsigned u32x2 __attribute__((ext_vector_type(2)));

constexpr int NB = 4, LSEQ = 4096, DM = 1024, NCTX = 256, SU = NCTX + LSEQ  , MTOK = NB * SU  , DEPTH = 4;
constexpr int EV_N = 3072, OD_N = 5120, NEXP = 32, FF = 512;
constexpr int NCHUNK = SU / 128;
constexpr float EPS = 1e-6f;
constexpr int LIST_CAP = MTOK;
constexpr int MOE_MAXROWS = 43008;

constexpr size_t MiB = 1u << 20;
constexpr size_t WS_CTL = 0, CTL_ZERO_BYTES = 1 * MiB;
constexpr size_t WS_MOD = 1 * MiB;
constexpr size_t WS_LB = 1 * MiB + 512 * 1024;
constexpr size_t WS_ROPEC = WS_LB + 16384;
constexpr size_t WS_ROPES = WS_ROPEC + 8192;
constexpr size_t WS_W = 2 * MiB;
constexpr size_t WS_W_EVIN = WS_W;
constexpr size_t WS_W_EVOUT = WS_W + 12 * MiB;
constexpr size_t WS_W_ODIN = WS_W + 16 * MiB;
constexpr size_t WS_W_ODOUT = WS_W + 36 * MiB;
constexpr size_t WS_W_MOE = WS_W + 40 * MiB;
constexpr size_t WS_XRES = 426 * MiB;
constexpr size_t WS_HB = 494 * MiB;
constexpr size_t WS_YB16 = 528 * MiB;
constexpr size_t WS_R = 562 * MiB;
constexpr size_t WS_PE = WS_R;
constexpr size_t WS_ST = WS_R + 102 * MiB;
constexpr size_t WS_PQ = WS_R, WS_PI = WS_R + 34 * MiB, WS_PG = WS_R + 68 * MiB;
constexpr size_t WS_FF = WS_R + 102 * MiB, WS_FB = WS_R + 170 * MiB, WS_OF = WS_R + 238 * MiB, WS_OB = WS_R + 306 * MiB;
constexpr size_t WS_LIST = WS_R;
constexpr size_t WS_TOKINFO = WS_R + 5 * MiB;
constexpr size_t WS_ACT = WS_R + 6 * MiB;
constexpr size_t WS_YB = WS_R + 50 * MiB;
constexpr size_t WS_YN = WS_R + 140 * MiB;
constexpr size_t WS_END = 936 * MiB;
constexpr size_t WS_SP = 256 * 1024;
constexpr int SP_NORMW = 0, SP_FNORMW = 8192, SP_WG = 9216, SP_BG = 25600, SP_WE = 25616, SP_BE = 156688, SP_DECAY = 156816, SP_SINK = 156832, SP_HGNW = 156840, SP_END = 157096;
static_assert(WS_SP + (size_t)SP_END * 4 <= CTL_ZERO_BYTES, "small parameters fit in the control MiB");
constexpr int CW_BAR = 4096;
constexpr int CW_CNT = 8192;

constexpr int RING_BYTES = 150528;
constexpr int LDSCTL_OFF = RING_BYTES, MISC_OFF = LDSCTL_OFF + 320;
constexpr int LDS_BYTES = RING_BYTES + 4096;
constexpr int NWAVES = 8;

typedef __bf16 bf16v2_t __attribute__((ext_vector_type(2)));
__device__ __forceinline__ unsigned pk2(float lo, float hi) { const f32x2 v = {lo, hi}; const bf16v2_t r = __builtin_convertvector(v, bf16v2_t); return __builtin_bit_cast(unsigned, r); }
__device__ __forceinline__ unsigned f2bf(float f) { return pk2(f, f) & 0xffffu; }
__device__ __forceinline__ float bf2f(unsigned h) { return __builtin_bit_cast(float, h << 16); }
__device__ __forceinline__ float bflo(unsigned w) { return __builtin_bit_cast(float, w << 16); }
__device__ __forceinline__ float bfhi(unsigned w) { return __builtin_bit_cast(float, w & 0xffff0000u); }
__device__ __forceinline__ float shx(float v, int o, int lane) { return __builtin_bit_cast(float, __builtin_amdgcn_ds_bpermute((lane ^ o) << 2, __builtin_bit_cast(int, v))); }
__device__ __forceinline__ int shup_i(int v, int o, int lane) { return __builtin_amdgcn_ds_bpermute((lane - o) << 2, v); }
__device__ __forceinline__ int shidx_i(int v, int src) { return __builtin_amdgcn_ds_bpermute(src << 2, v); }
__device__ __forceinline__ float wave_sum(float v, int lane) {
#pragma unroll
    for (int o = 1; o < 64; o <<= 1) v += shx(v, o, lane);
    return v;
}
__device__ __forceinline__ float siluf(float x) { return x / (1.0f + __expf(-x)); }
#define LDS_WAIT() asm volatile("s_waitcnt lgkmcnt(0)" ::: "memory")
#define VM_WAIT() asm volatile("s_waitcnt vmcnt(0)" ::: "memory")

namespace pg8 {
constexpr int BM = 256, BK = 64, HALF = 128, HTB = HALF * BK * 2, STAGE_BYTES = 8 * HTB, NXCD = 8, WGM = 8;
__host__ __device__ __forceinline__ int lds_byte(int r, int c) { const int st = (r >> 4) * 2 + (c >> 5), rr = r & 15, cc = c & 31, ob = rr * 64 + cc * 2; return st * 1024 + (ob ^ (((ob >> 9) & 1) << 5)); }
__host__ __device__ __forceinline__ void stage_rc(int b, int& R, int& C) { const int st = b / 1024, sb = b % 1024, swz = sb ^ (((sb >> 9) & 1) << 5); R = (st >> 1) * 16 + swz / 64; C = (st & 1) * 32 + (swz % 64) / 2; }
__host__ __device__ __forceinline__ int perm32(int rho) { const int n = rho >> 4, i = rho & 15; return 8 * (i >> 2) + 4 * n + (i & 3); }

struct Unit { int pm, pn, e, cnt, tile; };

__device__ __forceinline__ int xcd_remap(int L, int nwg) { const int q = nwg / NXCD, r = nwg % NXCD, xcd = L % NXCD, off = L / NXCD; return (xcd < r ? xcd * (q + 1) : r * (q + 1) + (xcd - r) * q) + off; }

struct StaticOrder {
    int nM, nN, nwg, G, c, skipctx;
    __device__ void init(int M, int N, int G_, int c_, int skip_ = 0) { skipctx = skip_; nM = skip_ ? 64 : M / BM; nN = N / BM; nwg = nM * nN; G = G_; c = c_; }
    __device__ bool next(int i, Unit& u) const {
        const long L = (long)i * G + c; if (L >= nwg) return false;
        const int wgid = xcd_remap((int)L, nwg);
        const int nig = WGM * nN, gid = wgid / nig, fm = gid * WGM, gsz = (nM - fm) < WGM ? (nM - fm) : WGM;
        u.pm = fm + ((wgid % nig) % gsz); u.pn = (wgid % nig) / gsz; u.e = 0; u.cnt = 0; u.tile = 0;
        if (skipctx) u.pm = u.pm + u.pm / 16 + 1;
        return true;
    }
};
struct MoeOrder {
    const LAS int* tstart; const LAS int* cnts; int ntiles, G, c;
    __device__ bool next(int i, Unit& u) const {
        const int nwg = ntiles * 4; const long L = (long)i * G + c; if (L >= nwg) return false;
        const int wgid = xcd_remap((int)L, nwg);
        const int tile = wgid >> 2; u.pn = wgid & 3; u.tile = tile;
        int e = 0;
        for (int k = 1; k < NEXP; ++k) e += (tstart[k] <= tile) ? 1 : 0;
        u.e = e; u.pm = tile - tstart[e]; u.cnt = cnts[e]; return true;
    }
};

struct PlainAddr {
    static constexpr bool GATHER = false;
    const bf16_t* A; const bf16_t* Bt; int K;
    __device__ __forceinline__ void base(const Unit& u, const char*& cA, const char*& cB) const { cA = (const char*)(A + (size_t)u.pm * BM * K); cB = (const char*)(Bt + (size_t)u.pn * BM * K); }
    __device__ __forceinline__ void rows(const Unit&, const int (&)[2], const int (&)[2], unsigned (&)[2], unsigned (&)[2]) const {}
};
struct MoeGatherAddr {
    static constexpr bool GATHER = true;
    const bf16_t* HB; const bf16_t* Wbase; const unsigned* list; int K;
    __device__ __forceinline__ void base(const Unit& u, const char*& cA, const char*& cB) const { cA = (const char*)HB; cB = (const char*)Wbase + (size_t)u.e * (3u << 20) + (size_t)u.pn * BM * K * 2; }
    __device__ __forceinline__ void rows(const Unit& u, const int (&R)[2], const int (&C)[2], unsigned (&v0)[2], unsigned (&v1)[2]) const {
        const unsigned* lp = list + (size_t)u.e * LIST_CAP;
#pragma unroll
        for (int i = 0; i < 2; ++i) {
            int i0 = u.pm * BM + R[i], i1 = i0 + HALF; const int mx = u.cnt - 1; i0 = i0 < mx ? i0 : mx; i1 = i1 < mx ? i1 : mx;
            const unsigned t0 = __hip_atomic_load(lp + i0, __ATOMIC_RELAXED, __HIP_MEMORY_SCOPE_AGENT), t1 = __hip_atomic_load(lp + i1, __ATOMIC_RELAXED, __HIP_MEMORY_SCOPE_AGENT);
            v0[i] = (t0 * (unsigned)K + (unsigned)C[i]) * 2u; v1[i] = (t1 * (unsigned)K + (unsigned)C[i]) * 2u;
        }
    }
};
struct MoeActAddr {
    static constexpr bool GATHER = false;
    const bf16_t* Act; const bf16_t* Wbase; int K;
    __device__ __forceinline__ void base(const Unit& u, const char*& cA, const char*& cB) const { cA = (const char*)(Act + (size_t)u.tile * BM * K); cB = (const char*)Wbase + (size_t)u.e * (3u << 20) + (size_t)u.pn * BM * K * 2; }
    __device__ __forceinline__ void rows(const Unit&, const int (&)[2], const int (&)[2], unsigned (&)[2], unsigned (&)[2]) const {}
};

__device__ __forceinline__ unsigned cvt_pk_bf16(float lo, float hi) { unsigned r; asm volatile("v_cvt_pk_bf16_f32 %0, %1, %2" : "=v"(r) : "v"(lo), "v"(hi)); return r; }

template <class Epi, class Sched, class Addr>
__device__ __forceinline__ void gemm_phase(LAS unsigned char* lds, const Addr& AD, const Sched& S, const Epi& E, const int K) {
    int tid = threadIdx.x; asm volatile("" : "+v"(tid));
    const int wid = __builtin_amdgcn_readfirstlane(tid >> 6), lane = tid & 63, wr = wid >> 2, wc = wid & 3, fr = lane & 15, fq = lane >> 4;
    const int nt = K / BK;
    int sR[2], sC[2]; unsigned voffA[2], voffB[2];
#pragma unroll
    for (int i = 0; i < 2; ++i) { int R, C; stage_rc(tid * 16 + i * 8192, R, C); sR[i] = R; sC[i] = C; const int Rb = Epi::PERM ? ((R & ~31) + perm32(R & 31)) : R; voffA[i] = (unsigned)(R * K + C) * 2u; voffB[i] = (unsigned)(Rb * K + C) * 2u; }
    const size_t kstep = (size_t)(BK * 2);
    const size_t hstep = (size_t)HALF * K * 2;
    const unsigned ldsw = (unsigned)wid * 1024u;
    const int aoff = lds_byte(wr * 64 + fr, fq * 8), boff = lds_byte(wc * 32 + fr, fq * 8);
#define PG8_SA(b, h) (((b) * 2 + (h)) * HTB)
#define PG8_SB(b, h) ((4 + (b) * 2 + (h)) * HTB)
#define PG8_STAGE(bufoff, gbase, voff) do { _Pragma("unroll") for (int _i = 0; _i < 2; ++_i) \
        __builtin_amdgcn_global_load_lds((const unsigned*)((const char*)(gbase) + (voff)[_i]), (LAS unsigned*)(lds + (bufoff) + ldsw + _i * 8192), 16, 0, 0); } while (0)
#define PG8_LDA(dst, b, h) do { _Pragma("unroll") for (int m = 0; m < 4; ++m) _Pragma("unroll") for (int k = 0; k < 2; ++k) dst[m][k] = *(const LAS bf16x8*)(lds + PG8_SA(b, h) + aoff + m * 2048 + k * 1024); } while (0)
#define PG8_LDB(dst, b, h) do { _Pragma("unroll") for (int n = 0; n < 2; ++n) _Pragma("unroll") for (int k = 0; k < 2; ++k) dst[n][k] = *(const LAS bf16x8*)(lds + PG8_SB(b, h) + boff + n * 2048 + k * 1024); } while (0)
#define PG8_MMA(ai, bj, At, Bt) do { __builtin_amdgcn_s_setprio(1); _Pragma("unroll") for (int m = 0; m < 4; ++m) _Pragma("unroll") for (int n = 0; n < 2; ++n) _Pragma("unroll") for (int k = 0; k < 2; ++k) \
        acc[ai][bj][m][n] = __builtin_amdgcn_mfma_f32_16x16x32_bf16(Bt[n][k], At[m][k], acc[ai][bj][m][n], 0, 0, 0); __builtin_amdgcn_s_setprio(0); } while (0)
#define PG8_WAIT_V(n) asm volatile("s_waitcnt vmcnt(" #n ")" ::: "memory")
#define PG8_WAIT_L(n) asm volatile("s_waitcnt lgkmcnt(" #n ")" ::: "memory")
#define PG8_BAR __builtin_amdgcn_s_barrier()
#define PG8_SCHED __builtin_amdgcn_sched_barrier(0)
    Unit cur, nxt; int ui = 0;
    if (!S.next(0, cur)) return;
    f32x4 acc[2][2][4][2];
#pragma unroll
    for (int a = 0; a < 2; ++a)
#pragma unroll
        for (int b = 0; b < 2; ++b)
#pragma unroll
            for (int m = 0; m < 4; ++m)
#pragma unroll
                for (int n = 0; n < 2; ++n) acc[a][b][m][n] = (f32x4){0.f, 0.f, 0.f, 0.f};
    bf16x8 At[4][2], B0[2][2], B1[2][2];
    const char* cA; const char* cB; unsigned cv0[2] = {voffA[0], voffA[1]}, cv1[2] = {voffA[0], voffA[1]};
    AD.base(cur, cA, cB); AD.rows(cur, sR, sC, cv0, cv1);
    const size_t ah = Addr::GATHER ? (size_t)0 : hstep;
    PG8_STAGE(PG8_SB(0, 0), cB, voffB); PG8_STAGE(PG8_SB(0, 1), cB + hstep, voffB); PG8_STAGE(PG8_SA(0, 0), cA, cv0); PG8_STAGE(PG8_SA(0, 1), cA + ah, cv1);
    if (wr == 1) PG8_BAR;
    PG8_WAIT_V(2); PG8_BAR;
    PG8_STAGE(PG8_SB(1, 0), cB + kstep, voffB); PG8_STAGE(PG8_SA(1, 0), cA + kstep, cv0); PG8_STAGE(PG8_SB(1, 1), cB + hstep + kstep, voffB);
    PG8_WAIT_V(6); PG8_BAR;
    for (;;) {
        const bool has_next = S.next(ui + 1, nxt);
        const char* nA = cA; const char* nB = cB; unsigned nv0[2] = {cv0[0], cv0[1]}, nv1[2] = {cv1[0], cv1[1]};
        if (has_next) { AD.base(nxt, nA, nB); AD.rows(nxt, sR, sC, nv0, nv1); }
        for (int t = 0; t < nt; t += 2) {
            const bool last = (t == nt - 2);
            const char* a1 = cA + (size_t)(t + 1) * kstep;
            const char* a2 = last ? nA : cA + (size_t)(t + 2) * kstep; const char* b2 = last ? nB : cB + (size_t)(t + 2) * kstep;
            const char* a3 = a2 + kstep; const char* b3 = b2 + kstep;
            unsigned x0[2] = {cv0[0], cv0[1]}, x1[2] = {cv1[0], cv1[1]};
            if constexpr (Addr::GATHER) { if (last) { x0[0] = nv0[0]; x0[1] = nv0[1]; x1[0] = nv1[0]; x1[1] = nv1[1]; } }
            PG8_LDB(B0, 0, 0); PG8_LDB(B1, 0, 1); PG8_SCHED; PG8_LDA(At, 0, 0); PG8_STAGE(PG8_SA(1, 1), a1 + ah, cv1);
            PG8_WAIT_V(8); PG8_WAIT_L(0); PG8_BAR; PG8_MMA(0, 0, At, B0); PG8_MMA(0, 1, At, B1); PG8_BAR; PG8_SCHED;
            PG8_LDA(At, 0, 1); PG8_STAGE(PG8_SB(0, 0), b2, voffB); PG8_STAGE(PG8_SB(0, 1), b2 + hstep, voffB); PG8_STAGE(PG8_SA(0, 0), a2, x0);
            PG8_WAIT_V(8); PG8_WAIT_L(0); PG8_BAR; PG8_MMA(1, 0, At, B0); PG8_MMA(1, 1, At, B1); PG8_BAR; PG8_SCHED;
            PG8_LDB(B0, 1, 0); PG8_LDB(B1, 1, 1); PG8_SCHED; PG8_LDA(At, 1, 0); PG8_STAGE(PG8_SA(0, 1), a2 + ah, x1);
            PG8_WAIT_V(8); PG8_WAIT_L(0); PG8_BAR; PG8_MMA(0, 0, At, B0); PG8_MMA(0, 1, At, B1); PG8_BAR; PG8_SCHED;
            PG8_LDA(At, 1, 1); PG8_STAGE(PG8_SB(1, 0), b3, voffB); PG8_STAGE(PG8_SB(1, 1), b3 + hstep, voffB); PG8_STAGE(PG8_SA(1, 0), a3, x0);
            PG8_WAIT_V(8); PG8_WAIT_L(0); PG8_BAR; PG8_MMA(1, 0, At, B0); PG8_MMA(1, 1, At, B1); PG8_BAR; PG8_SCHED;
        }
        if (wr == 0) PG8_BAR;
        E(acc, cur, wr, wc, fr, fq);
        if (!has_next) break;
#pragma unroll
        for (int a = 0; a < 2; ++a)
#pragma unroll
            for (int b = 0; b < 2; ++b)
#pragma unroll
                for (int m = 0; m < 4; ++m)
#pragma unroll
                    for (int n = 0; n < 2; ++n) acc[a][b][m][n] = (f32x4){0.f, 0.f, 0.f, 0.f};
        cur = nxt; cA = nA; cB = nB; cv0[0] = nv0[0]; cv0[1] = nv0[1]; cv1[0] = nv1[0]; cv1[1] = nv1[1]; ++ui;
        if (wr == 1) PG8_BAR;
    }
    PG8_WAIT_V(0);
    PG8_BAR;
#undef PG8_SA
#undef PG8_SB
#undef PG8_STAGE
#undef PG8_LDA
#undef PG8_LDB
#undef PG8_MMA
#undef PG8_WAIT_V
#undef PG8_WAIT_L
#undef PG8_BAR
#undef PG8_SCHED
}
}

#define XB_TMO      128
#define XB_XCNT(j)  (256  + 64 * (j))
#define XB_XSUB(j)  (1280 + 64 * (j))
#define XB_XGEN(j)  (2304 + 64 * (j))
#define XB_TOP      3328
#define XB_TOPGEN   3392
#define XCD_BAR_WORDS 3456
#define XB_SPIN_CAP (1u << 20)
__device__ __forceinline__ unsigned xb_ld(unsigned* p)              { return __hip_atomic_load((GAS unsigned*)p, __ATOMIC_RELAXED, __HIP_MEMORY_SCOPE_AGENT); }
__device__ __forceinline__ unsigned xb_add(unsigned* p, unsigned v) { return __hip_atomic_fetch_add((GAS unsigned*)p, v, __ATOMIC_RELAXED, __HIP_MEMORY_SCOPE_AGENT); }
__device__ __forceinline__ unsigned xb_xcc_id() { return (unsigned)__builtin_amdgcn_s_getreg((3 << 11) | 20) & 0xFu; }
#define XB_SPIN(cond, bar) do { unsigned _sp = 0; while (cond) { __builtin_amdgcn_s_sleep(1); \
    if ((++_sp & 255u) == 0u) { if (xb_ld(&(bar)[XB_TMO])) break; if (_sp > XB_SPIN_CAP) { xb_add(&(bar)[XB_TMO], 1u); break; } } } } while (0)
struct XcdBarrier { unsigned* bar; unsigned x; volatile LAS unsigned* st; };
__device__ __forceinline__ XcdBarrier xcd_barrier_post(unsigned* bar, volatile LAS unsigned* st) {
    XcdBarrier b; b.bar = bar; b.x = xb_xcc_id(); b.st = st;
    if (threadIdx.x == 0) (void)xb_add(&bar[XB_XCNT(b.x)], 1u);
    return b;
}
__device__ __forceinline__ void xcd_barrier_complete(unsigned* bar, unsigned x, unsigned& nloc, unsigned& nx) {
    const unsigned G = gridDim.x * gridDim.y * gridDim.z;
    unsigned sum, cnt, mine, sp = 0u;
    for (;;) {
        sum = 0u; cnt = 0u; mine = 0u;
#pragma unroll
        for (unsigned j = 0; j < 16; ++j) { const unsigned c = xb_ld(&bar[XB_XCNT(j)]); sum += c; cnt += (c > 0u) ? 1u : 0u; }
        mine = xb_ld(&bar[XB_XCNT(x)]);
        if (sum == G) break;
        __builtin_amdgcn_s_sleep(1);
        if ((++sp & 255u) == 0u) { if (xb_ld(&bar[XB_TMO])) break; if (sp > XB_SPIN_CAP) { xb_add(&bar[XB_TMO], 1u); break; } }
    }
    nloc = mine > 0u ? mine : 1u; nx = cnt > 0u ? cnt : 1u;
}
__device__ __forceinline__ void xcd_barrier(const XcdBarrier& b) {
    asm volatile("s_waitcnt vmcnt(0)" ::: "memory");
    __syncthreads();
    if (threadIdx.x == 0) {
        unsigned* bar = b.bar; asm volatile("" : "+s"(bar));
        __builtin_amdgcn_s_waitcnt(0);
        unsigned nloc = b.st[0], nx = b.st[1];
        if (nloc == 0u) { xcd_barrier_complete(bar, b.x, nloc, nx); b.st[0] = nloc; b.st[1] = nx; }
        const unsigned old = xb_add(&bar[XB_XSUB(b.x)], 1u);
        const unsigned gen = old / nloc;
        if (old + 1u == (gen + 1u) * nloc) {
            __builtin_amdgcn_fence(__ATOMIC_RELEASE, "agent");
            asm volatile("s_waitcnt vmcnt(0)" ::: "memory");
            const unsigned og = xb_add(&bar[XB_TOP], 1u);
            const unsigned tg = og / nx;
            if (og + 1u == (tg + 1u) * nx) xb_add(&bar[XB_TOPGEN], 1u);
            else XB_SPIN(xb_ld(&bar[XB_TOPGEN]) == tg, bar);
            __builtin_amdgcn_fence(__ATOMIC_ACQUIRE, "agent");
            xb_add(&bar[XB_XGEN(b.x)], 1u);
            asm volatile("s_waitcnt vmcnt(0)" ::: "memory");
        } else {
            XB_SPIN(xb_ld(&bar[XB_XGEN(b.x)]) == gen, bar);
            __builtin_amdgcn_fence(__ATOMIC_ACQUIRE, "agent");
            asm volatile("s_waitcnt vmcnt(0)" ::: "memory");
        }
    }
    __syncthreads();
}

__device__ __forceinline__ int ftid() { int t = (int)threadIdx.x; asm volatile("" : "+v"(t)); return t; }
__device__ __forceinline__ int flane() { return ftid() & 63; }
__device__ __forceinline__ int fbid() { int b = (int)blockIdx.x; asm volatile("" : "+s"(b)); return b; }
struct Args { const float* in[23]; float* out; unsigned char* ws; int ph_lo, ph_hi; };
struct Frame {
    LAS unsigned char* lds;
    volatile LAS unsigned* MISC;
    unsigned* ctl;
    unsigned char* ws;
    int wave, vcu, G;
};
enum { I_X = 0, I_C, I_CTX, I_CCTX, I_ADAW, I_ADAB, I_NORMW, I_FNORMW, I_EVWIN, I_EVWOUT, I_RETDECAY, I_SINK, I_ODWIN, I_ODWOUT, I_LBLOG, I_HGNW,
       I_WG, I_BG, I_WE, I_BE, I_W1, I_W3, I_W2 };

__device__ __forceinline__ void conv_item(const float* srcp, int src_ld, bf16_t* WT, int K, int n0, int k0, LAS float* scr, int lane) {
#pragma unroll 8
    for (int i = 0; i < 32; ++i) { const int kk = 2 * i + (lane >> 5); scr[kk * 33 + (lane & 31)] = srcp[(size_t)(k0 + kk) * src_ld]; }
    LDS_WAIT(); asm volatile("" ::: "memory");
    const int c = lane & 7;
#pragma unroll
    for (int j = 0; j < 4; ++j) { const int n = (lane >> 3) + 8 * j; const LAS float* s = scr + (8 * c) * 33 + n;
        u32x4 o; o.x = pk2(s[0 * 33], s[1 * 33]); o.y = pk2(s[2 * 33], s[3 * 33]); o.z = pk2(s[4 * 33], s[5 * 33]); o.w = pk2(s[6 * 33], s[7 * 33]);
        *(u32x4*)(WT + (size_t)(n0 + n) * K + k0 + 8 * c) = o; }
    LDS_WAIT(); asm volatile("" ::: "memory");
}
__device__ __forceinline__ int head_perm(int n) { const int hh = n >> 7, phi = n & 127, g = phi >> 3, u = phi & 7; return hh * 128 + 64 * (g >> 3) + 4 * (g & 7) + (u & 3) + 32 * (u >> 2); }

constexpr int NI_W13 = 16 * 32, NI_W2 = 8 * 32, NI_MOE1 = NI_W13 + NI_W2, MOE_NI = NEXP * NI_MOE1;
#ifndef CONV_TAIL_WAVES
#define CONV_TAIL_WAVES 4
#endif
#ifndef MOE_G1_EVEN
#define MOE_G1_EVEN 7168
#endif
#ifndef MOE_G1_ODD
#define MOE_G1_ODD 6144
#endif
#ifndef MOE_G2_EVEN
#define MOE_G2_EVEN 10240
#endif
#ifndef MOE_G2_ODD
#define MOE_G2_ODD 10240
#endif
__host__ __device__ constexpr int moe_g1_hi(int l) { return (l & 1) ? MOE_G1_ODD : MOE_G1_EVEN; }
__host__ __device__ constexpr int moe_g2_hi(int l) { return l == DEPTH - 1 ? moe_g1_hi(l) : moe_g1_hi(l) + ((l & 1) ? MOE_G2_ODD : MOE_G2_EVEN); }
__host__ __device__ constexpr int moe_p0_cnt(int l) { return MOE_NI - moe_g2_hi(l); }
__device__ __forceinline__ void conv_moe_item(Frame& F, const Args& args, int l, int r, LAS float* scr, int lane) {
    const int le = l * NEXP + r / NI_MOE1; r %= NI_MOE1;
    bf16_t* dst = (bf16_t*)(F.ws + WS_W_MOE + (size_t)le * 3 * MiB);
    if (r < NI_W13) { const int kb = r / 32, nb = r % 32; const int n = nb * 32 + (lane & 31);
        const int Gq = n >> 3, u = n & 7; const float* src = (u < 4 ? args.in[I_W1] : args.in[I_W3]) + (size_t)le * DM * FF + 4 * Gq + (u & 3);
        conv_item(src, FF, dst, DM, nb * 32, kb * 64, scr, lane); }
    else { r -= NI_W13; const int kb = r / 32, nb = r % 32; const int n = nb * 32 + (lane & 31);
        conv_item(args.in[I_W2] + (size_t)le * FF * DM + n, DM, dst + (size_t)DM * DM, FF, nb * 32, kb * 64, scr, lane); }
}
__device__ __forceinline__ void conv_moe_tail(Frame& F, const Args& args, int l, int lo, int hi, int nwg) {
    const int r = nwg % F.G, c = fbid();
    if (c >= r) {
        __syncthreads();
        LAS float* scr = (LAS float*)(F.lds + F.wave * 16384); const int lane = flane();
        const int nslot = (F.G - r) * CONV_TAIL_WAVES;
        if (F.wave < CONV_TAIL_WAVES)
        for (int it = lo + (c - r) * CONV_TAIL_WAVES + F.wave; it < hi; it += nslot) conv_moe_item(F, args, l, it, scr, lane);
    }
}

__device__ __forceinline__ void p0_prologue(Frame& F, const Args& args) {
    LAS float* scr = (LAS float*)(F.lds + F.wave * 16384);
    const int gw = F.vcu * NWAVES + F.wave, NGW = F.G * NWAVES, lane = flane();
    constexpr int NI_EVIN = 16 * (EV_N / 32), NI_ODIN = 16 * (OD_N / 32), NI_OUT = 16 * 32;
    constexpr int NITEMS = 2 * NI_EVIN + 2 * NI_ODIN + 4 * NI_OUT + moe_p0_cnt(0) + moe_p0_cnt(1) + moe_p0_cnt(2) + moe_p0_cnt(3);
    for (int rep_ = 0; rep_ <= REP_CONV; ++rep_)
    for (int it = gw; it < NITEMS; it += NGW) {
        int r = it;
        if (r < 2 * NI_EVIN) { const int p = r / NI_EVIN; r %= NI_EVIN; const int nblk = EV_N / 32, kb = r / nblk, nb = r % nblk; const int n = nb * 32 + (lane & 31);
            conv_item(args.in[I_EVWIN] + (size_t)p * DM * EV_N + head_perm(n), EV_N, (bf16_t*)(F.ws + WS_W_EVIN + (size_t)p * 6 * MiB), DM, nb * 32, kb * 64, scr, lane); continue; }
        r -= 2 * NI_EVIN;
        if (r < 2 * NI_ODIN) { const int p = r / NI_ODIN; r %= NI_ODIN; const int nblk = OD_N / 32, kb = r / nblk, nb = r % nblk; const int n = nb * 32 + (lane & 31);
            conv_item(args.in[I_ODWIN] + (size_t)p * DM * OD_N + head_perm(n), OD_N, (bf16_t*)(F.ws + WS_W_ODIN + (size_t)p * 10 * MiB), DM, nb * 32, kb * 64, scr, lane); continue; }
        r -= 2 * NI_ODIN;
        if (r < 4 * NI_OUT) { const int q = r / NI_OUT; r %= NI_OUT; const int kb = r / 32, nb = r % 32; const int n = nb * 32 + (lane & 31);
            const float* src = (q < 2 ? args.in[I_EVWOUT] + (size_t)q * DM * DM : args.in[I_ODWOUT] + (size_t)(q - 2) * DM * DM);
            bf16_t* dst = (bf16_t*)(F.ws + (q < 2 ? WS_W_EVOUT + (size_t)q * 2 * MiB : WS_W_ODOUT + (size_t)(q - 2) * 2 * MiB));
            conv_item(src + n, DM, dst, DM, nb * 32, kb * 64, scr, lane); continue; }
        r -= 4 * NI_OUT;
        if (r < moe_p0_cnt(0)) { conv_moe_item(F, args, 0, moe_g2_hi(0) + r, scr, lane); continue; }
        r -= moe_p0_cnt(0);
        if (r < moe_p0_cnt(1)) { conv_moe_item(F, args, 1, moe_g2_hi(1) + r, scr, lane); continue; }
        r -= moe_p0_cnt(1);
        if (r < moe_p0_cnt(2)) { conv_moe_item(F, args, 2, moe_g2_hi(2) + r, scr, lane); continue; }
        r -= moe_p0_cnt(2);
        conv_moe_item(F, args, 3, moe_g2_hi(3) + r, scr, lane);
    }
    {
        f32x4* xr = (f32x4*)(F.ws + WS_XRES);
        const f32x4* xs = (const f32x4*)args.in[I_X]; const f32x4* cs = (const f32x4*)args.in[I_CTX];
        const size_t total = (size_t)MTOK * 256;
        for (size_t i = (size_t)fbid() * 512 + ftid(); i < total; i += (size_t)F.G * 512) {
            const int row = (int)(i >> 8), c4 = (int)(i & 255); const int b = row / SU, p = row % SU;
            xr[i] = (p < NCTX) ? cs[((size_t)(b * NCTX + p) << 8) + c4] : xs[((size_t)(b * LSEQ + p - NCTX) << 8) + c4];
        }
    }
    if (NAIVE_COPY) { float* xr2 = (float*)(F.ws + WS_XRES);
        for (size_t i = (size_t)fbid() * 512 + ftid(); i < (size_t)MTOK * DM; i += (size_t)F.G * 512) { const size_t row = i / DM; const int k = (int)(i % DM); const int b = (int)(row / SU), p = (int)(row % SU);
            xr2[i] = p < NCTX ? args.in[I_CTX][((size_t)b * NCTX + p) * DM + k] : args.in[I_X][((size_t)b * LSEQ + (p - NCTX)) * DM + k]; } }
    {
        float* sp = (float*)(F.ws + WS_SP);
        for (int i = fbid() * 512 + ftid(); i < SP_END; i += F.G * 512) {
            float v;
            if (i < SP_FNORMW) v = args.in[I_NORMW][i]; else if (i < SP_WG) v = args.in[I_FNORMW][i - SP_FNORMW]; else if (i < SP_BG) v = args.in[I_WG][i - SP_WG]; else if (i < SP_WE) v = args.in[I_BG][i - SP_BG];
            else if (i < SP_BE) v = args.in[I_WE][i - SP_WE]; else if (i < SP_DECAY) v = args.in[I_BE][i - SP_BE]; else if (i < SP_SINK) v = args.in[I_RETDECAY][i - SP_DECAY]; else if (i < SP_HGNW) v = args.in[I_SINK][i - SP_SINK]; else v = args.in[I_HGNW][i - SP_HGNW];
            sp[i] = v;
        }
    }
    if (blockIdx.x == 0) {
        float* lb = (float*)(F.ws + WS_LB); const float* lg = args.in[I_LBLOG];
        for (int c = ftid(); c < DM; c += 512) {
            const float a0 = lg[c], a1 = lg[DM + c], a2 = lg[2 * DM + c], a3 = lg[3 * DM + c];
            const float mx = fmaxf(fmaxf(a0, a1), fmaxf(a2, a3));
            const float e0 = expf(a0 - mx), e1 = expf(a1 - mx), e2 = expf(a2 - mx), e3 = expf(a3 - mx); const float inv = 1.0f / (e0 + e1 + e2 + e3);
            lb[c] = 0.f; lb[DM + c] = e1 * inv; lb[2 * DM + c] = (e1 + e2) * inv; lb[3 * DM + c] = (e1 + e2 + e3) * inv;
        }
    }
    if (blockIdx.x == 1) {
        float* rc = (float*)(F.ws + WS_ROPEC); float* rs = (float*)(F.ws + WS_ROPES);
        for (int i = ftid(); i < 64 * 32; i += 512) { const int pos = i >> 5, fi = i & 31;
            const float invf = powf(10000.0f, -(float)(2 * fi) / 64.0f); const float ang = (float)pos * invf;
            rc[i] = cosf(ang); rs[i] = sinf(ang); }
    }
    {
        __syncthreads();
        LAS float* sv = (LAS float*)F.lds;
        LAS float* part = (LAS float*)(F.lds + 20480);
        for (int i = ftid(); i < 5 * DM; i += 512) { const int r = i >> 10, k = i & 1023; const float v = (r < 4) ? args.in[I_C][r * DM + k] : args.in[I_CCTX][k]; sv[i] = siluf(v); }
        __syncthreads();
        float* mod = (float*)(F.ws + WS_MOD);
        for (int it = fbid(); it < DEPTH * 96; it += F.G) {
            const int l = it / 96, cg = it % 96; const int col = cg * 64 + lane;
            const float* w = args.in[I_ADAW] + (size_t)l * DM * 6144 + col;
            float a[5] = {0.f, 0.f, 0.f, 0.f, 0.f};
            const int k0 = F.wave * 128;
#pragma unroll 8
            for (int k = 0; k < 128; ++k) { const float wv = w[(size_t)(k0 + k) * 6144];
#pragma unroll
                for (int r = 0; r < 5; ++r) a[r] += sv[r * DM + k0 + k] * wv; }
#pragma unroll
            for (int r = 0; r < 5; ++r) part[(F.wave * 5 + r) * 64 + lane] = a[r];
            __syncthreads();
            if (ftid() < 320) { const int r = ftid() >> 6, c = ftid() & 63; float s = 0.f;
#pragma unroll
                for (int w8 = 0; w8 < 8; ++w8) s += part[(w8 * 5 + r) * 64 + c];
                mod[((size_t)l * 5 + r) * 6144 + cg * 64 + c] = s + args.in[I_ADAB][l * 6144 + cg * 64 + c]; }
            __syncthreads();
        }
    }
}

__device__ __forceinline__ int moe_tile_prefix(const unsigned* cnt, int lane, int& mycnt) {
    const int c = (lane < NEXP) ? (int)__hip_atomic_load(cnt + lane, __ATOMIC_RELAXED, __HIP_MEMORY_SCOPE_AGENT) : 0; mycnt = c;
    const int nt = (c + 255) >> 8; int incl = nt;
#pragma unroll
    for (int o = 1; o < 64; o <<= 1) { const int v = shup_i(incl, o, lane); if (lane >= o) incl += v; }
    return incl - nt;
}

template <bool FINAL>
__device__ __forceinline__ void n1_phase(Frame& F, const Args& args, int l) {
    const int gw = (MUT_A ? fbid() : F.vcu) * NWAVES + F.wave, NGW = F.G * NWAVES, lane = flane();
    float* xres = (float*)(F.ws + WS_XRES);
    const float* mod = (const float*)(F.ws + WS_MOD);
    int tprefix = 0, dummy;
    if (l > 0) tprefix = moe_tile_prefix(F.ctl + CW_CNT + (l - 1) * NEXP, lane, dummy);
    for (int rr_ = 0; rr_ < (MUT_D ? 64 : 9); ++rr_) {
        const int row = MUT_D ? (fbid() * 512 + F.wave * 64 + rr_) : (gw + rr_ * NGW); if (row >= MTOK) continue;
        const int b = row / SU, p = row % SU; const int mrow = (p < NCTX) ? 4 : b;
        if (FINAL && p < NCTX) continue;
        f32x4* xr = (f32x4*)(xres + (size_t)row * DM) + lane;
        f32x4 v[4];
#pragma unroll
        for (int j = 0; j < 4; ++j) v[j] = xr[64 * j];
        if (l > 0 && CONTRIB_MOE) {
            {
                unsigned* tiw = (unsigned*)(F.ws + WS_TOKINFO) + (size_t)row * 8;
                u32x4 t0, t1;
                t0.x = __hip_atomic_load(tiw + 0, __ATOMIC_RELAXED, __HIP_MEMORY_SCOPE_AGENT); t0.y = __hip_atomic_load(tiw + 1, __ATOMIC_RELAXED, __HIP_MEMORY_SCOPE_AGENT);
                t0.z = __hip_atomic_load(tiw + 2, __ATOMIC_RELAXED, __HIP_MEMORY_SCOPE_AGENT); t0.w = __hip_atomic_load(tiw + 3, __ATOMIC_RELAXED, __HIP_MEMORY_SCOPE_AGENT);
                t1.x = __hip_atomic_load(tiw + 4, __ATOMIC_RELAXED, __HIP_MEMORY_SCOPE_AGENT); t1.y = __hip_atomic_load(tiw + 5, __ATOMIC_RELAXED, __HIP_MEMORY_SCOPE_AGENT); t1.z = 0u; t1.w = 0u;
                const int ts0 = shidx_i(tprefix, (int)t0.x), ts1 = shidx_i(tprefix, (int)t0.z);
                const size_t s0 = (size_t)ts0 * 256 + t0.y, s1 = (size_t)ts1 * 256 + t0.w;
                const unsigned gb0 = t1.x, gb1 = t1.y;
                const float g0 = __builtin_bit_cast(float, gb0), g1 = __builtin_bit_cast(float, gb1);
                const u32x2* y0 = (const u32x2*)(F.ws + WS_YB + s0 * (DM * 2)) + lane; const u32x2* y1 = (const u32x2*)(F.ws + WS_YB + s1 * (DM * 2)) + lane;
                const f32x4* gp = (const f32x4*)(mod + ((size_t)(l - 1) * 5 + mrow) * 6144 + 5 * DM) + lane;
                if (NAIVE_MOE) {
                    const f32x4* n0 = (const f32x4*)(F.ws + WS_YN + (size_t)row * 2 * DM * 4) + lane; const f32x4* n1 = n0 + 256;
#pragma unroll
                    for (int j = 0; j < 4; ++j) { const f32x4 g = gp[64 * j]; v[j] = v[j] + g * (n0[64 * j] * g0 + n1[64 * j] * g1); }
                } else {
                if (MUT_B) {
                    const bf16_t* yy0 = (const bf16_t*)(F.ws + WS_YB) + s0 * DM; const bf16_t* yy1 = (const bf16_t*)(F.ws + WS_YB) + s1 * DM;
                    const float* gate = mod + ((size_t)(l - 1) * 5 + mrow) * 6144 + 5 * DM;
#pragma unroll
                    for (int j = 0; j < 4; ++j) { const int k = 4 * lane + 256 * j;
                        v[j].x += gate[k] * (g0 * bf2f(yy0[k]) + g1 * bf2f(yy1[k])); v[j].y += gate[k + 1] * (g0 * bf2f(yy0[k + 1]) + g1 * bf2f(yy1[k + 1]));
                        v[j].z += gate[k + 2] * (g0 * bf2f(yy0[k + 2]) + g1 * bf2f(yy1[k + 2])); v[j].w += gate[k + 3] * (g0 * bf2f(yy0[k + 3]) + g1 * bf2f(yy1[k + 3])); }
                } else {
#pragma unroll
                for (int j = 0; j < 4; ++j) { const u32x2 a = y0[64 * j], c = y1[64 * j]; const f32x4 g = gp[64 * j];
                    v[j].x += g.x * (g0 * bflo(a.x) + g1 * bflo(c.x)); v[j].y += g.y * (g0 * bfhi(a.x) + g1 * bfhi(c.x));
                    v[j].z += g.z * (g0 * bflo(a.y) + g1 * bflo(c.y)); v[j].w += g.w * (g0 * bfhi(a.y) + g1 * bfhi(c.y)); }
                }
                }
                if (!FINAL) {
#pragma unroll
                    for (int j = 0; j < 4; ++j) xr[64 * j] = v[j];
                }
            }
        }
        float s = 0.f;
#pragma unroll
        for (int j = 0; j < 4; ++j) s += (v[j].x * v[j].x + v[j].y * v[j].y) + (v[j].z * v[j].z + v[j].w * v[j].w);
        const float rstd = 1.0f / sqrtf(wave_sum(s, lane) * (1.0f / DM) + EPS);
        if (FINAL) {
            const f32x4* nw = (const f32x4*)((const float*)(F.ws + WS_SP) + SP_FNORMW) + lane;
            f32x4* o = (f32x4*)(args.out + ((size_t)b * LSEQ + (p - NCTX)) * DM) + lane;
#pragma unroll
            for (int j = 0; j < 4; ++j) { const f32x4 w = nw[64 * j]; o[64 * j] = v[j] * rstd * w; }
        } else {
            const f32x4* nw = (const f32x4*)(((const float*)(F.ws + WS_SP) + SP_NORMW) + (size_t)(l * 2 + 0) * DM) + lane;
            const f32x4* sh = (const f32x4*)(mod + ((size_t)l * 5 + mrow) * 6144 + 0 * DM) + lane;
            const f32x4* sc = (const f32x4*)(mod + ((size_t)l * 5 + mrow) * 6144 + 1 * DM) + lane;
            u32x2* o = (u32x2*)(F.ws + WS_HB + (size_t)row * (DM * 2)) + lane;
#pragma unroll
            for (int j = 0; j < 4; ++j) { const f32x4 w = nw[64 * j], a = sh[64 * j], c = sc[64 * j]; const f32x4 h = v[j] * rstd * w * (c + 1.0f) + a;
                u32x2 q; q.x = pk2(h.x, h.y); q.y = pk2(h.z, h.w); o[64 * j] = q; }
        }
    }
}

__device__ __forceinline__ void naive_n1(Frame& F, const Args& args, int l, bool final_) {
    float* xres = (float*)(F.ws + WS_XRES);
    const float* mod = (const float*)(F.ws + WS_MOD);
    for (int row = fbid() * 512 + ftid(); row < MTOK; row += F.G * 512) {
        const int b = row / SU, p = row % SU; const int mrow = (p < NCTX) ? 4 : b;
        if (final_ && p < NCTX) continue;
        float* xr = xres + (size_t)row * DM;
        if (l > 0) {
            const unsigned* cnt = F.ctl + CW_CNT + (l - 1) * NEXP;
            const unsigned* ti = (const unsigned*)(F.ws + WS_TOKINFO) + (size_t)row * 8;
            const unsigned e0 = ti[0], p0 = ti[1], e1 = ti[2], p1 = ti[3]; const float g0 = __builtin_bit_cast(float, ti[4]), g1 = __builtin_bit_cast(float, ti[5]);
            int ts0 = 0, ts1 = 0; for (unsigned e = 0; e < e0; ++e) ts0 += ((int)cnt[e] + 255) / 256; for (unsigned e = 0; e < e1; ++e) ts1 += ((int)cnt[e] + 255) / 256;
            const bf16_t* y0 = (const bf16_t*)(F.ws + WS_YB) + ((size_t)ts0 * 256 + p0) * DM; const bf16_t* y1 = (const bf16_t*)(F.ws + WS_YB) + ((size_t)ts1 * 256 + p1) * DM;
            const float* gate = mod + ((size_t)(l - 1) * 5 + mrow) * 6144 + 5 * DM;
            for (int k = 0; k < DM; ++k) xr[k] = xr[k] + gate[k] * (g0 * bf2f(y0[k]) + g1 * bf2f(y1[k]));
        }
        double ss = 0.0; for (int k = 0; k < DM; ++k) ss += (double)xr[k] * xr[k];
        const float rstd = 1.0f / sqrtf((float)(ss / DM) + EPS);
        if (final_) { float* o = args.out + ((size_t)b * LSEQ + (p - NCTX)) * DM; for (int k = 0; k < DM; ++k) o[k] = xr[k] * rstd * args.in[I_FNORMW][k]; }
        else { bf16_t* hb = (bf16_t*)(F.ws + WS_HB) + (size_t)row * DM; const float* nw = args.in[I_NORMW] + (size_t)(l * 2) * DM; const float* mr = mod + ((size_t)l * 5 + mrow) * 6144;
            for (int k = 0; k < DM; ++k) hb[k] = (bf16_t)f2bf(xr[k] * rstd * nw[k] * (1.0f + mr[DM + k]) + mr[k]); }
    }
}
__device__ __forceinline__ void wave_n1(Frame& F, const Args& args, int l, bool final_) {
    float* xres = (float*)(F.ws + WS_XRES);
    const float* mod = (const float*)(F.ws + WS_MOD);
    const int gw = F.vcu * NWAVES + F.wave, NGW = F.G * NWAVES, lane = flane();
    for (int row = gw; row < MTOK; row += NGW) {
        const int b = row / SU, p = row % SU; const int mrow = (p < NCTX) ? 4 : b;
        if (final_ && p < NCTX) continue;
        float* xr = xres + (size_t)row * DM;
        float xv[16];
#pragma unroll
        for (int i = 0; i < 16; ++i) xv[i] = xr[lane + 64 * i];
        if (l > 0) {
            const unsigned* cnt = F.ctl + CW_CNT + (l - 1) * NEXP;
            const unsigned* ti = (const unsigned*)(F.ws + WS_TOKINFO) + (size_t)row * 8;
            const unsigned e0 = ti[0], p0 = ti[1], e1 = ti[2], p1 = ti[3]; const float g0 = __builtin_bit_cast(float, ti[4]), g1 = __builtin_bit_cast(float, ti[5]);
            int ts0 = 0, ts1 = 0; for (unsigned e = 0; e < e0; ++e) ts0 += ((int)cnt[e] + 255) / 256; for (unsigned e = 0; e < e1; ++e) ts1 += ((int)cnt[e] + 255) / 256;
            const bf16_t* y0 = (const bf16_t*)(F.ws + WS_YB) + ((size_t)ts0 * 256 + p0) * DM; const bf16_t* y1 = (const bf16_t*)(F.ws + WS_YB) + ((size_t)ts1 * 256 + p1) * DM;
            const float* gate = mod + ((size_t)(l - 1) * 5 + mrow) * 6144 + 5 * DM;
#pragma unroll
            for (int i = 0; i < 16; ++i) { const int k = lane + 64 * i; xv[i] = xv[i] + gate[k] * (g0 * bf2f(y0[k]) + g1 * bf2f(y1[k])); if (!final_) xr[k] = xv[i]; }
        }
        float ss = 0.f;
#pragma unroll
        for (int i = 0; i < 16; ++i) ss += xv[i] * xv[i];
        const float rstd = 1.0f / sqrtf(wave_sum(ss, lane) * (1.0f / DM) + EPS);
        if (final_) { float* o = args.out + ((size_t)b * LSEQ + (p - NCTX)) * DM;
#pragma unroll
            for (int i = 0; i < 16; ++i) { const int k = lane + 64 * i; o[k] = xv[i] * rstd * args.in[I_FNORMW][k]; } }
        else { bf16_t* hb = (bf16_t*)(F.ws + WS_HB) + (size_t)row * DM; const float* nw = args.in[I_NORMW] + (size_t)(l * 2) * DM; const float* mr = mod + ((size_t)l * 5 + mrow) * 6144;
#pragma unroll
            for (int i = 0; i < 16; ++i) { const int k = lane + 64 * i; hb[k] = (bf16_t)f2bf(xv[i] * rstd * nw[k] * (1.0f + mr[DM + k]) + mr[k]); } }
    }
}
__device__ __forceinline__ void n2r_phase(Frame& F, const Args& args, int l) {
    const int gw = F.vcu * NWAVES + F.wave, NGW = F.G * NWAVES, lane = flane();
    const float* xres = (const float*)(F.ws + WS_XRES);
    const float* mod = (const float*)(F.ws + WS_MOD);
    unsigned* cnt = F.ctl + CW_CNT + l * NEXP;
    unsigned* list = (unsigned*)(F.ws + WS_LIST);
    const float* wg = ((const float*)(F.ws + WS_SP) + SP_WG) + (size_t)l * DM * 4; const float* bg = ((const float*)(F.ws + WS_SP) + SP_BG) + l * 4;
    const float* we = ((const float*)(F.ws + WS_SP) + SP_WE) + (size_t)l * 4 * DM * 8; const float* be = ((const float*)(F.ws + WS_SP) + SP_BE) + l * 32;
    LAS float* wgT = (LAS float*)F.lds; LAS float* weT = wgT + 4 * DM;
    LAS unsigned* hist = (LAS unsigned*)(F.lds + LDSCTL_OFF + 1024); LAS unsigned* baseL = hist + 32; LAS unsigned* rec = hist + 64 + F.wave * 36;
    __syncthreads();
    if (ftid() < 32) hist[ftid()] = 0u;
    {   const int t = ftid();
        for (int r = t; r < DM; r += 512) { const f32x4 a = *(const f32x4*)(wg + (size_t)r * 4); wgT[r] = a.x; wgT[DM + r] = a.y; wgT[2 * DM + r] = a.z; wgT[3 * DM + r] = a.w; }
        for (int r = t; r < 4 * DM; r += 512) { const int g = r >> 10, c = r & 1023; const f32x4 a = *(const f32x4*)(we + (size_t)r * 8), b2 = *(const f32x4*)(we + (size_t)r * 8 + 4);
            LAS float* d = weT + g * 8 * DM + c; d[0] = a.x; d[DM] = a.y; d[2 * DM] = a.z; d[3 * DM] = a.w; d[4 * DM] = b2.x; d[5 * DM] = b2.y; d[6 * DM] = b2.z; d[7 * DM] = b2.w; }
    }
    __syncthreads();
    for (int k_ = 0; k_ < 9; ++k_) {
        const int row = gw + k_ * NGW; if (row >= MTOK) break;
        const int b = row / SU, p = row % SU; const int mrow = (p < NCTX) ? 4 : b;
        if (l == DEPTH - 1 && p < NCTX) continue;
        const f32x4* xr = (const f32x4*)(xres + (size_t)row * DM) + lane;
        f32x4 v[4]; float s = 0.f;
#pragma unroll
        for (int j = 0; j < 4; ++j) { v[j] = xr[64 * j]; s += (v[j].x * v[j].x + v[j].y * v[j].y) + (v[j].z * v[j].z + v[j].w * v[j].w); }
        const float rstd = 1.0f / sqrtf(wave_sum(s, lane) * (1.0f / DM) + EPS);
        const f32x4* nw = (const f32x4*)(((const float*)(F.ws + WS_SP) + SP_NORMW) + (size_t)(l * 2 + 1) * DM) + lane;
        const f32x4* sh = (const f32x4*)(mod + ((size_t)l * 5 + mrow) * 6144 + 3 * DM) + lane;
        const f32x4* sc = (const f32x4*)(mod + ((size_t)l * 5 + mrow) * 6144 + 4 * DM) + lane;
        u32x2* o = (u32x2*)(F.ws + WS_HB + (size_t)row * (DM * 2)) + lane;
        float gl[4] = {0.f, 0.f, 0.f, 0.f};
#pragma unroll
        for (int j = 0; j < 4; ++j) { const f32x4 w = nw[64 * j], a = sh[64 * j], c = sc[64 * j]; const f32x4 h = v[j] * rstd * w * (c + 1.0f) + a; v[j] = h;
            u32x2 q; q.x = pk2(h.x, h.y); q.y = pk2(h.z, h.w); o[64 * j] = q;
#pragma unroll
            for (int g = 0; g < 4; ++g) { const f32x4 wv = *(const LAS f32x4*)(wgT + g * DM + 4 * lane + 256 * j); gl[g] += (h.x * wv.x + h.y * wv.y) + (h.z * wv.z + h.w * wv.w); } }
#pragma unroll
        for (int g = 0; g < 4; ++g) gl[g] = wave_sum(gl[g], lane) + bg[g];
        int gi = 0; float gm = gl[0];
#pragma unroll
        for (int g = 1; g < 4; ++g) if (gl[g] > gm) { gm = gl[g]; gi = g; }
        const float gp = 1.0f / (expf(gl[0] - gm) + expf(gl[1] - gm) + expf(gl[2] - gm) + expf(gl[3] - gm));
        const LAS float* weg = weT + gi * 8 * DM;
        float el[8] = {0.f, 0.f, 0.f, 0.f, 0.f, 0.f, 0.f, 0.f};
#pragma unroll
        for (int j = 0; j < 4; ++j) {
#pragma unroll
            for (int e = 0; e < 8; ++e) { const f32x4 wv = *(const LAS f32x4*)(weg + e * DM + 4 * lane + 256 * j); el[e] += (v[j].x * wv.x + v[j].y * wv.y) + (v[j].z * wv.z + v[j].w * wv.w); }
        }
#pragma unroll
        for (int e = 0; e < 8; ++e) el[e] = wave_sum(el[e], lane) + be[gi * 8 + e];
        int i0 = 0; float v0 = el[0];
#pragma unroll
        for (int e = 1; e < 8; ++e) if (el[e] > v0) { v0 = el[e]; i0 = e; }
        int i1 = -1; float v1 = -3.0e38f;
#pragma unroll
        for (int e = 0; e < 8; ++e) if (e != i0 && el[e] > v1) { v1 = el[e]; i1 = e; }
        const float w0 = 1.0f / (1.0f + expf(v1 - v0)), w1 = 1.0f - w0;
        if (lane == 0) {
            const unsigned e0 = (unsigned)(gi * 8 + i0), e1 = (unsigned)(gi * 8 + i1);
            const unsigned lp0 = __hip_atomic_fetch_add(hist + e0, 1u, __ATOMIC_RELAXED, __HIP_MEMORY_SCOPE_WORKGROUP), lp1 = __hip_atomic_fetch_add(hist + e1, 1u, __ATOMIC_RELAXED, __HIP_MEMORY_SCOPE_WORKGROUP);
            rec[k_ * 4 + 0] = e0; rec[k_ * 4 + 1] = lp0; rec[k_ * 4 + 2] = e1; rec[k_ * 4 + 3] = lp1;
            u32x4* ti = (u32x4*)(F.ws + WS_TOKINFO) + (size_t)row * 2;
            ti[1] = (u32x4){__builtin_bit_cast(unsigned, gp * w0), __builtin_bit_cast(unsigned, gp * w1), 0u, 0u};
        }
    }
    __syncthreads();
    if (ftid() < 32) { const unsigned hc = hist[ftid()]; baseL[ftid()] = hc ? atomicAdd(cnt + ftid(), hc) : 0u; }
    __syncthreads();
    if (lane == 0) {
        for (int k_ = 0; k_ < 9; ++k_) {
            const int row = gw + k_ * NGW; if (row >= MTOK) break;
            if (l == DEPTH - 1 && (row % SU) < NCTX) continue;
            const unsigned e0 = rec[k_ * 4 + 0], e1 = rec[k_ * 4 + 2]; const unsigned p0 = baseL[e0] + rec[k_ * 4 + 1], p1 = baseL[e1] + rec[k_ * 4 + 3];
            list[(size_t)e0 * LIST_CAP + p0] = (unsigned)row; list[(size_t)e1 * LIST_CAP + p1] = (unsigned)row;
            u32x4* ti = (u32x4*)(F.ws + WS_TOKINFO) + (size_t)row * 2;
            ti[0] = (u32x4){e0, p0, e1, p1};
        }
    }
    __syncthreads();
}

__device__ __forceinline__ void naive_n2r(Frame& F, const Args& args, int l) {
    const float* xres = (const float*)(F.ws + WS_XRES);
    const float* mod = (const float*)(F.ws + WS_MOD);
    unsigned* cnt = F.ctl + CW_CNT + l * NEXP;
    unsigned* list = (unsigned*)(F.ws + WS_LIST);
    const float* wg = args.in[I_WG] + (size_t)l * DM * 4; const float* bg = args.in[I_BG] + l * 4;
    const float* we = args.in[I_WE] + (size_t)l * 4 * DM * 8; const float* be = args.in[I_BE] + l * 32;
    for (int row = fbid() * 512 + ftid(); row < MTOK; row += F.G * 512) {
        const int b = row / SU, p = row % SU; const int mrow = (p < NCTX) ? 4 : b;
        if (l == DEPTH - 1 && p < NCTX) continue;
        const float* xr = xres + (size_t)row * DM; double ss = 0.0;
        for (int k = 0; k < DM; ++k) ss += (double)xr[k] * xr[k];
        const float rstd = 1.0f / sqrtf((float)(ss / DM) + EPS);
        const float* nw = args.in[I_NORMW] + (size_t)(l * 2 + 1) * DM; const float* mr = mod + ((size_t)l * 5 + mrow) * 6144;
        bf16_t* hb = (bf16_t*)(F.ws + WS_HB) + (size_t)row * DM;
        float gl[4] = {bg[0], bg[1], bg[2], bg[3]};
        for (int k = 0; k < DM; ++k) { const float h = xr[k] * rstd * nw[k] * (1.0f + mr[4 * DM + k]) + mr[3 * DM + k]; hb[k] = (bf16_t)f2bf(h);
            gl[0] += h * wg[k * 4 + 0]; gl[1] += h * wg[k * 4 + 1]; gl[2] += h * wg[k * 4 + 2]; gl[3] += h * wg[k * 4 + 3]; }
        int gi = 0; for (int g = 1; g < 4; ++g) if (gl[g] > gl[gi]) gi = g;
        float den = 0.f; for (int g = 0; g < 4; ++g) den += expf(gl[g] - gl[gi]);
        const float gp = 1.0f / den;
        float el[8]; for (int e = 0; e < 8; ++e) el[e] = be[gi * 8 + e];
        for (int k = 0; k < DM; ++k) { const float h = xr[k] * rstd * nw[k] * (1.0f + mr[4 * DM + k]) + mr[3 * DM + k]; const float* wr = we + ((size_t)gi * DM + k) * 8;
#pragma unroll
            for (int e = 0; e < 8; ++e) el[e] += h * wr[e]; }
        int i0 = 0; for (int e = 1; e < 8; ++e) if (el[e] > el[i0]) i0 = e;
        int i1 = (i0 == 0) ? 1 : 0; for (int e = 0; e < 8; ++e) if (e != i0 && el[e] > el[i1]) i1 = e;
        const float m2 = el[i0]; const float a0 = 1.0f, a1 = expf(el[i1] - m2); const float w0 = a0 / (a0 + a1), w1 = a1 / (a0 + a1);
        const unsigned e0 = (unsigned)(gi * 8 + i0), e1 = (unsigned)(gi * 8 + i1);
        const unsigned p0 = atomicAdd(cnt + e0, 1u), p1 = atomicAdd(cnt + e1, 1u);
        list[(size_t)e0 * LIST_CAP + p0] = (unsigned)row; list[(size_t)e1 * LIST_CAP + p1] = (unsigned)row;
        u32x4* ti = (u32x4*)(F.ws + WS_TOKINFO) + (size_t)row * 2;
        ti[0] = (u32x4){e0, p0, e1, p1}; ti[1] = (u32x4){__builtin_bit_cast(unsigned, gp * w0), __builtin_bit_cast(unsigned, gp * w1), 0u, 0u};
    }
}

struct EpiProj {
    static constexpr bool PERM = true;
    unsigned char* ws; const float* lb; int odd;
    __device__ __forceinline__ void operator()(const f32x4 (&acc)[2][2][4][2], const pg8::Unit& u, int wr, int wc, int fr, int fq) const {
        const int pmb = u.pm % 17; const bool isctx = (pmb == 0); const int tbase = (pmb - 1) * 256;
        const int g = 4 * wc + fq, half = g >> 3, f0 = 4 * (g & 7);
        const float* ropec = (const float*)(ws + WS_ROPEC); const float* ropes = (const float*)(ws + WS_ROPES);
#pragma unroll
        for (int bj = 0; bj < 2; ++bj) {
            const int hcol = 256 * u.pn + 128 * bj; const int lc0 = hcol + 64 * half + f0;
            if (!odd) {
                const bool rope = !isctx && (hcol < 1024 || (hcol >= 2048 && hcol < 2816));
                const float scale = (hcol >= 512 && hcol < 1024) ? 0.08838834764831845f : 1.0f;
                bf16_t* dst = (bf16_t*)(ws + WS_PE);
#pragma unroll
                for (int ai = 0; ai < 2; ++ai)
#pragma unroll
                    for (int m = 0; m < 4; ++m) {
                        const int rr = 128 * ai + 64 * wr + 16 * m + fr; const size_t row = (size_t)u.pm * 256 + rr;
                        f32x4 x1 = acc[ai][bj][m][0] * scale, x2 = acc[ai][bj][m][1] * scale;
                        if (rope) { const int t = tbase + rr; const int pos = half ? (t & 63) : (t >> 6);
                            const f32x4 c = *(const f32x4*)(ropec + pos * 32 + f0), s = *(const f32x4*)(ropes + pos * 32 + f0);
                            const f32x4 o1 = x1 * c - x2 * s, o2 = x2 * c + x1 * s; x1 = o1; x2 = o2; }
                        u32x2 q1, q2; q1.x = pk2(x1.x, x1.y); q1.y = pk2(x1.z, x1.w); q2.x = pk2(x2.x, x2.y); q2.y = pk2(x2.z, x2.w);
                        *(u32x2*)(dst + row * EV_N + lc0) = q1; *(u32x2*)(dst + row * EV_N + lc0 + 32) = q2;
                    }
            } else {
                const int seg = hcol >> 10, c0 = lc0 & 1023;
                if (seg == 1 || seg == 2) {
                    float* dst = (float*)(ws + (seg == 1 ? WS_FF : WS_FB));
                    const f32x4 l1 = *(const f32x4*)(lb + c0), l2 = *(const f32x4*)(lb + c0 + 32);
#pragma unroll
                    for (int ai = 0; ai < 2; ++ai)
#pragma unroll
                        for (int m = 0; m < 4; ++m) {
                            const size_t row = (size_t)u.pm * 256 + 128 * ai + 64 * wr + 16 * m + fr;
                            const f32x4 z1 = acc[ai][bj][m][0], z2 = acc[ai][bj][m][1]; f32x4 f1, f2;
                            f1.x = l1.x + (1.f - l1.x) / (1.f + __expf(-z1.x)); f1.y = l1.y + (1.f - l1.y) / (1.f + __expf(-z1.y)); f1.z = l1.z + (1.f - l1.z) / (1.f + __expf(-z1.z)); f1.w = l1.w + (1.f - l1.w) / (1.f + __expf(-z1.w));
                            f2.x = l2.x + (1.f - l2.x) / (1.f + __expf(-z2.x)); f2.y = l2.y + (1.f - l2.y) / (1.f + __expf(-z2.y)); f2.z = l2.z + (1.f - l2.z) / (1.f + __expf(-z2.z)); f2.w = l2.w + (1.f - l2.w) / (1.f + __expf(-z2.w));
                            *(f32x4*)(dst + row * DM + c0) = f1; *(f32x4*)(dst + row * DM + c0 + 32) = f2;
                        }
                } else {
                    bf16_t* dst = (bf16_t*)(ws + (seg == 0 ? WS_PQ : (seg == 3 ? WS_PI : WS_PG)));
#pragma unroll
                    for (int ai = 0; ai < 2; ++ai)
#pragma unroll
                        for (int m = 0; m < 4; ++m) {
                            const size_t row = (size_t)u.pm * 256 + 128 * ai + 64 * wr + 16 * m + fr;
                            const f32x4 x1 = acc[ai][bj][m][0], x2 = acc[ai][bj][m][1];
                            u32x2 q1, q2; q1.x = pk2(x1.x, x1.y); q1.y = pk2(x1.z, x1.w); q2.x = pk2(x2.x, x2.y); q2.y = pk2(x2.z, x2.w);
                            *(u32x2*)(dst + row * DM + c0) = q1; *(u32x2*)(dst + row * DM + c0 + 32) = q2;
                        }
                }
            }
        }
    }
};
struct EpiOut {
    static constexpr bool PERM = false;
    float* xres; const float* modl; int enable;
    __device__ __forceinline__ void operator()(const f32x4 (&acc)[2][2][4][2], const pg8::Unit& u, int wr, int wc, int fr, int fq) const {
        if (!enable) return;
        const int pmb = u.pm % 17; const int mrow = (pmb == 0) ? 4 : (u.pm / 17);
        const float* gate = modl + (size_t)mrow * 6144 + 2 * DM;
#pragma unroll
        for (int bj = 0; bj < 2; ++bj)
#pragma unroll
            for (int n = 0; n < 2; ++n) {
                const int c = 256 * u.pn + 128 * bj + 32 * wc + 16 * n + 4 * fq; const f32x4 gv = *(const f32x4*)(gate + c);
#pragma unroll
                for (int ai = 0; ai < 2; ++ai)
#pragma unroll
                    for (int m = 0; m < 4; ++m) { f32x4* p = (f32x4*)(xres + ((size_t)u.pm * 256 + 128 * ai + 64 * wr + 16 * m + fr) * DM + c); *p = *p + gv * acc[ai][bj][m][n]; }
            }
    }
};
struct EpiAct {
    static constexpr bool PERM = true;
    bf16_t* Act;
    __device__ __forceinline__ void operator()(const f32x4 (&acc)[2][2][4][2], const pg8::Unit& u, int wr, int wc, int fr, int fq) const {
#pragma unroll
        for (int bj = 0; bj < 2; ++bj) { const int Gq = 32 * u.pn + 16 * bj + 4 * wc + fq;
#pragma unroll
            for (int ai = 0; ai < 2; ++ai)
#pragma unroll
                for (int m = 0; m < 4; ++m) { const size_t row = (size_t)u.tile * 256 + 128 * ai + 64 * wr + 16 * m + fr;
                    const f32x4 a = acc[ai][bj][m][0], b = acc[ai][bj][m][1];
                    u32x2 q; q.x = pk2(siluf(a.x) * b.x, siluf(a.y) * b.y); q.y = pk2(siluf(a.z) * b.z, siluf(a.w) * b.w);
                    *(u32x2*)(Act + row * FF + 4 * Gq) = q; } }
    }
};
struct EpiY {
    static constexpr bool PERM = true;
    bf16_t* YB;
    __device__ __forceinline__ void operator()(const f32x4 (&acc)[2][2][4][2], const pg8::Unit& u, int wr, int wc, int fr, int fq) const {
#pragma unroll
        for (int bj = 0; bj < 2; ++bj) { const int c = 256 * u.pn + 128 * bj + 32 * wc + 8 * fq;
#pragma unroll
            for (int ai = 0; ai < 2; ++ai)
#pragma unroll
                for (int m = 0; m < 4; ++m) { const size_t row = (size_t)u.tile * 256 + 128 * ai + 64 * wr + 16 * m + fr;
                    const f32x4 a = acc[ai][bj][m][0], b = acc[ai][bj][m][1];
                    u32x4 q; q.x = pk2(a.x, a.y); q.y = pk2(a.z, a.w); q.z = pk2(b.x, b.y); q.w = pk2(b.z, b.w);
                    *(u32x4*)(YB + row * DM + c) = q; } }
    }
};

__device__ __forceinline__ void naive_g1(Frame& F, const Args& args, int l) {
    const int odd = l & 1, p = l >> 1; const int N = odd ? OD_N : EV_N;
    const float* W = (odd ? args.in[I_ODWIN] : args.in[I_EVWIN]) + (size_t)p * DM * N;
    LAS float* sh = (LAS float*)F.lds;
    const float* lb = (const float*)(F.ws + WS_LB) + l * DM;
    const float* ropec = (const float*)(F.ws + WS_ROPEC); const float* ropes = (const float*)(F.ws + WS_ROPES);
    for (int rg = fbid(); rg < MTOK / 8; rg += F.G) {
        __syncthreads();
        if (NAIVE_G1 == 2) {
            const int row = rg * 8 + F.wave; const int bb = row / SU, pp = row % SU; const int mrow = pp < NCTX ? 4 : bb;
            const float* xr = (const float*)(F.ws + WS_XRES) + (size_t)row * DM; float ssq = 0.f;
            for (int k = flane(); k < DM; k += 64) ssq += xr[k] * xr[k];
            ssq = wave_sum(ssq, flane()); const float rs = 1.0f / sqrtf(ssq / (float)DM + EPS);
            const float* modr = (const float*)(F.ws + WS_MOD) + ((size_t)l * 5 + mrow) * 6144;
            for (int k = flane(); k < DM; k += 64) sh[F.wave * DM + k] = xr[k] * rs * args.in[I_NORMW][(size_t)(l * 2) * DM + k] * (1.0f + modr[DM + k]) + modr[k];
        } else
        for (int i = ftid(); i < 8 * DM; i += 512) sh[i] = bf2f(((const bf16_t*)(F.ws + WS_HB))[(size_t)rg * 8 * DM + i]);
        __syncthreads();
        for (int pi = ftid(); pi < N / 2; pi += 512) {
            const int hh = pi >> 6, rem = pi & 63, half = rem >> 5, d = rem & 31; const int cA = 128 * hh + 64 * half + d, cB = cA + 32;
            float a[8], bq[8];
#pragma unroll
            for (int r = 0; r < 8; ++r) { a[r] = 0.f; bq[r] = 0.f; }
            for (int k = 0; k < DM; ++k) { const float wa = W[(size_t)k * N + cA], wb = W[(size_t)k * N + cB];
#pragma unroll
                for (int r = 0; r < 8; ++r) { const float hv = sh[r * DM + k]; a[r] += hv * wa; bq[r] += hv * wb; } }
            const int hcol = 128 * hh;
#pragma unroll
            for (int r = 0; r < 8; ++r) {
                const int row = rg * 8 + r; const int pp = row % SU; const bool isctx = pp < NCTX; const int t = pp - NCTX;
                float x1 = a[r], x2 = bq[r];
                if (!odd) {
                    const bool rope = !isctx && (hcol < 1024 || (hcol >= 2048 && hcol < 2816));
                    if (hcol >= 512 && hcol < 1024) { x1 *= 0.08838834764831845f; x2 *= 0.08838834764831845f; }
                    if (rope) { const int pos = half ? (t & 63) : (t >> 6); float cc = ropec[pos * 32 + d], sn = ropes[pos * 32 + d];
                        if (NAIVE_G1 == 3) { const double ang = (double)((float)pos * powf(10000.0f, -(float)d / 32.0f)); cc = (float)cos(ang); sn = (float)sin(ang); }
                        const float o1 = x1 * cc - x2 * sn, o2 = x2 * cc + x1 * sn; x1 = o1; x2 = o2; }
                    bf16_t* dst = (bf16_t*)(F.ws + WS_PE) + (size_t)row * EV_N; dst[cA] = (bf16_t)f2bf(x1); dst[cB] = (bf16_t)f2bf(x2);
                } else {
                    const int seg = hcol >> 10, c0 = cA & 1023;
                    if (seg == 1 || seg == 2) { float* dst = (float*)(F.ws + (seg == 1 ? WS_FF : WS_FB)) + (size_t)row * DM;
                        float lba = lb[c0], lbb = lb[c0 + 32];
                        if (NAIVE_G1 == 3) { const float* lg = args.in[I_LBLOG]; float ea[4], eb[4], sa = 0.f, sb2 = 0.f; for (int q = 0; q < 4; ++q) { ea[q] = expf(lg[q * DM + c0]); eb[q] = expf(lg[q * DM + c0 + 32]); sa += ea[q]; sb2 += eb[q]; }
                            lba = 0.f; lbb = 0.f; for (int q = 1; q <= l; ++q) { lba += ea[q] / sa; lbb += eb[q] / sb2; } }
                        dst[c0] = lba + (1.f - lba) / (1.f + expf(-x1)); dst[c0 + 32] = lbb + (1.f - lbb) / (1.f + expf(-x2)); }
                    else { bf16_t* dst = (bf16_t*)(F.ws + (seg == 0 ? WS_PQ : (seg == 3 ? WS_PI : WS_PG))) + (size_t)row * DM; dst[c0] = (bf16_t)f2bf(x1); dst[c0 + 32] = (bf16_t)f2bf(x2); }
                }
            }
        }
    }
    __syncthreads();
}

__device__ __forceinline__ void naive_g2(Frame& F, const Args& args, int l) {
    const int odd = l & 1, p = l >> 1;
    const float* W = (odd ? args.in[I_ODWOUT] : args.in[I_EVWOUT]) + (size_t)p * DM * DM;
    LAS float* sh = (LAS float*)F.lds;
    const float* modl = (const float*)(F.ws + WS_MOD) + (size_t)l * 5 * 6144;
    float* xres = (float*)(F.ws + WS_XRES);
    for (int rg = fbid(); rg < MTOK / 8; rg += F.G) {
        __syncthreads();
        for (int i = ftid(); i < 8 * DM; i += 512) sh[i] = bf2f(((const bf16_t*)(F.ws + WS_YB16))[(size_t)rg * 8 * DM + i]);
        __syncthreads();
        for (int col = ftid(); col < DM; col += 512) {
            float a[8];
#pragma unroll
            for (int r = 0; r < 8; ++r) a[r] = 0.f;
            for (int k = 0; k < DM; ++k) { const float wa = W[(size_t)k * DM + col];
#pragma unroll
                for (int r = 0; r < 8; ++r) a[r] += sh[r * DM + k] * wa; }
#pragma unroll
            for (int r = 0; r < 8; ++r) { const int row = rg * 8 + r; const int b = row / SU, pp = row % SU; const int mrow = pp < NCTX ? 4 : b;
                xres[(size_t)row * DM + col] += modl[(size_t)mrow * 6144 + 2 * DM + col] * a[r]; }
        }
    }
    __syncthreads();
}
__device__ __forceinline__ void naive_mod(Frame& F, const Args& args) {
    float* mod = (float*)(F.ws + WS_MOD);
    for (int i = fbid() * 512 + ftid(); i < DEPTH * 5 * 6144; i += F.G * 512) {
        const int col = i % 6144, r = (i / 6144) % 5, l = i / (5 * 6144);
        const float* cv = r < 4 ? args.in[I_C] + r * DM : args.in[I_CCTX];
        const float* w = args.in[I_ADAW] + (size_t)l * DM * 6144 + col;
        float a = 0.f;
        for (int k = 0; k < DM; ++k) { const float v = cv[k]; a += (v / (1.0f + expf(-v))) * w[(size_t)k * 6144]; }
        mod[i] = a + args.in[I_ADAB][l * 6144 + col];
    }
}

__device__ __forceinline__ void naive_moe(Frame& F, const Args& args, int l) {
    LAS float* sh = (LAS float*)F.lds;
    LAS float* sa = sh + 8 * DM;
    LAS int* gstart = (LAS int*)(sa + 8 * FF);
    LAS int* stok = gstart + 40;
    const unsigned* cnt = F.ctl + CW_CNT + l * NEXP;
    const unsigned* list = (const unsigned*)(F.ws + WS_LIST);
    __syncthreads();
    if (ftid() == 0) { int acc = 0; for (int e = 0; e < NEXP; ++e) { gstart[e] = acc; acc += ((int)cnt[e] + 7) / 8; } gstart[NEXP] = acc; }
    __syncthreads();
    const int total = gstart[NEXP];
    float* YN = (float*)(F.ws + WS_YN);
    for (int gi = fbid(); gi < total; gi += F.G) {
        int e = 0; for (int k = 1; k < NEXP; ++k) e += (gstart[k] <= gi) ? 1 : 0;
        const int g = gi - gstart[e]; const int ce = (int)cnt[e];
        __syncthreads();
        if (ftid() < 8) { const int idx = 8 * g + ftid(); stok[ftid()] = idx < ce ? (int)list[(size_t)e * LIST_CAP + idx] : -1; }
        __syncthreads();
        for (int i = ftid(); i < 8 * DM; i += 512) { const int r = i >> 10, k = i & 1023; const int tk = stok[r]; sh[i] = tk >= 0 ? bf2f(((const bf16_t*)(F.ws + WS_HB))[(size_t)tk * DM + k]) : 0.f; }
        __syncthreads();
        const float* w1 = args.in[I_W1] + ((size_t)l * NEXP + e) * DM * FF; const float* w3 = args.in[I_W3] + ((size_t)l * NEXP + e) * DM * FF; const float* w2 = args.in[I_W2] + ((size_t)l * NEXP + e) * FF * DM;
        { const int col = ftid(); float a[8], b[8];
#pragma unroll
            for (int r = 0; r < 8; ++r) { a[r] = 0.f; b[r] = 0.f; }
            for (int k = 0; k < DM; ++k) { const float wa = w1[(size_t)k * FF + col], wb = w3[(size_t)k * FF + col];
#pragma unroll
                for (int r = 0; r < 8; ++r) { const float hv = sh[r * DM + k]; a[r] += hv * wa; b[r] += hv * wb; } }
#pragma unroll
            for (int r = 0; r < 8; ++r) sa[r * FF + col] = (a[r] / (1.0f + expf(-a[r]))) * b[r]; }
        __syncthreads();
        for (int col = ftid(); col < DM; col += 512) { float y[8];
#pragma unroll
            for (int r = 0; r < 8; ++r) y[r] = 0.f;
            for (int k = 0; k < FF; ++k) { const float wv = w2[(size_t)k * DM + col];
#pragma unroll
                for (int r = 0; r < 8; ++r) y[r] += sa[r * FF + k] * wv; }
#pragma unroll
            for (int r = 0; r < 8; ++r) { const int tk = stok[r]; if (tk >= 0) { const unsigned e0 = ((const unsigned*)(F.ws + WS_TOKINFO))[(size_t)tk * 8]; const int kk = (e0 == (unsigned)e) ? 0 : 1;
                YN[((size_t)tk * 2 + kk) * DM + col] = y[r]; } } }
    }
    __syncthreads();
}

constexpr int TLD = 136;
constexpr int TILE_BYTES = 128 * TLD * 2;
template <int NT, int KS>
__device__ __forceinline__ void wave_mma(f32x4 (&acc)[NT], const bf16x8 (&afr)[KS], const LAS bf16_t* Bt, int ldb, int lane) {
    const LAS bf16_t* bp = Bt + (lane & 15) * ldb + 8 * (lane >> 4);
#pragma unroll
    for (int nt = 0; nt < NT; ++nt)
#pragma unroll
        for (int ks = 0; ks < KS; ++ks) { const bf16x8 b = *(const LAS bf16x8*)(bp + nt * 16 * ldb + 32 * ks); acc[nt] = __builtin_amdgcn_mfma_f32_16x16x32_bf16(afr[ks], b, acc[nt], 0, 0, 0);
            if ((ks & 3) == 3 && (nt & 1) == 1) asm volatile("" ::: "memory"); }
}
template <int NT, int KS>
__device__ __forceinline__ void wave_mma2(f32x4 (&acc0)[NT], f32x4 (&acc1)[NT], const bf16x8 (&a0)[KS], const bf16x8 (&a1)[KS], const LAS bf16_t* Bt, int ldb, int lane) {
    const LAS bf16_t* bp = Bt + (lane & 15) * ldb + 8 * (lane >> 4);
#pragma unroll
    for (int nt = 0; nt < NT; ++nt) {
        bf16x8 b[KS];
#pragma unroll
        for (int ks = 0; ks < KS; ++ks) b[ks] = *(const LAS bf16x8*)(bp + nt * 16 * ldb + 32 * ks);
#pragma unroll
        for (int ks = 0; ks < KS; ++ks) { acc0[nt] = __builtin_amdgcn_mfma_f32_16x16x32_bf16(a0[ks], b[ks], acc0[nt], 0, 0, 0); acc1[nt] = __builtin_amdgcn_mfma_f32_16x16x32_bf16(a1[ks], b[ks], acc1[nt], 0, 0, 0); }
        if ((nt & 1) == 1) asm volatile("" ::: "memory");
    }
}
__device__ __forceinline__ void stage_rowmajor(LAS bf16_t* T, const bf16_t* src, size_t ld, int tid) {
#pragma unroll
    for (int i = 0; i < 4; ++i) { const int q = tid + 512 * i, r = q >> 4, cc = q & 15; const u32x4 v = *(const u32x4*)(src + (size_t)r * ld + 8 * cc); *(LAS u32x4*)(T + r * TLD + 8 * cc) = v; }
}
__device__ __forceinline__ void stage_transposed(LAS bf16_t* T, const bf16_t* src, size_t ld, int tid, bool scaled, float sa, float sb) {
#pragma unroll
    for (int i = 0; i < 2; ++i) { const int q = tid + 512 * i, rp = q & 63, cc = q >> 6;
        const u32x4 v0 = *(const u32x4*)(src + (size_t)(2 * rp) * ld + 8 * cc), v1 = *(const u32x4*)(src + (size_t)(2 * rp + 1) * ld + 8 * cc);
        const unsigned w0[4] = {v0.x, v0.y, v0.z, v0.w}, w1[4] = {v1.x, v1.y, v1.z, v1.w};
        LAS unsigned* tp = (LAS unsigned*)(T + (8 * cc) * TLD + 2 * rp);
        if (scaled) { const float s0 = exp2f(sa * (float)(2 * rp) + sb), s1 = exp2f(sa * (float)(2 * rp + 1) + sb);
#pragma unroll
            for (int k = 0; k < 4; ++k) { tp[(2 * k) * (TLD / 2)] = pk2(bflo(w0[k]) * s0, bflo(w1[k]) * s1); tp[(2 * k + 1) * (TLD / 2)] = pk2(bfhi(w0[k]) * s0, bfhi(w1[k]) * s1); }
        } else {
#pragma unroll
            for (int k = 0; k < 4; ++k) { tp[(2 * k) * (TLD / 2)] = (w0[k] & 0xffffu) | (w1[k] << 16); tp[(2 * k + 1) * (TLD / 2)] = (w0[k] >> 16) | (w1[k] & 0xffff0000u); }
        }
    }
}
__device__ __forceinline__ void stage_f32_rowmajor(LAS bf16_t* T, const float* src, int tid) {
#pragma unroll
    for (int i = 0; i < 8; ++i) { const int q = tid + 512 * i, r = q >> 5, cc = q & 31; const f32x4 v = *(const f32x4*)(src + (size_t)r * 128 + 4 * cc);
        u32x2 o; o.x = pk2(v.x, v.y); o.y = pk2(v.z, v.w); *(LAS u32x2*)(T + r * TLD + 4 * cc) = o; }
}
__device__ __forceinline__ float log2_gamma_f(const Frame& F, int p, int dir, int h) { return -expf(((const float*)(F.ws + WS_SP) + SP_DECAY)[(p * 2 + dir) * 4 + h]) * 1.4426950408889634f; }
#define log2_gamma(args, p, dir, h) log2_gamma_f(F, p, dir, h)

__device__ __forceinline__ void ret_state_item(Frame& F, const Args& args, int p, int item) {
    const int c = item % NCHUNK, h = (item / NCHUNK) & 3, b = item / (NCHUNK * 4);
    int tid = ftid(); asm volatile("" : "+v"(tid)); const int lane = tid & 63, w = F.wave;
    LAS bf16_t* T0 = (LAS bf16_t*)F.lds; LAS bf16_t* T1 = (LAS bf16_t*)(F.lds + TILE_BYTES); LAS bf16_t* T2 = (LAS bf16_t*)(F.lds + 2 * TILE_BYTES);
    const bf16_t* pe = (const bf16_t*)(F.ws + WS_PE) + ((size_t)b * SU + 128 * c) * EV_N;
    const float lgf = log2_gamma(args, p, 0, h), lgb = log2_gamma(args, p, 1, h);
    __syncthreads();
    stage_transposed(T0, pe + 512 + h * 128, EV_N, tid, false, 0.f, 0.f);
    stage_transposed(T1, pe + 1024 + h * 128, EV_N, tid, true, -lgf, 127.f * lgf);
    stage_transposed(T2, pe + 1024 + h * 128, EV_N, tid, true, lgb, 0.f);
    __syncthreads();
    float* st = (float*)(F.ws + WS_ST);
    {
        bf16x8 af[4], ab[4];
#pragma unroll
        for (int ks = 0; ks < 4; ++ks) { af[ks] = *(const LAS bf16x8*)(T1 + (16 * w + (lane & 15)) * TLD + 32 * ks + 8 * (lane >> 4)); ab[ks] = *(const LAS bf16x8*)(T2 + (16 * w + (lane & 15)) * TLD + 32 * ks + 8 * (lane >> 4)); }
        f32x4 accf[8], accb[8];
#pragma unroll
        for (int nt = 0; nt < 8; ++nt) { accf[nt] = (f32x4){0.f, 0.f, 0.f, 0.f}; accb[nt] = (f32x4){0.f, 0.f, 0.f, 0.f}; }
        wave_mma2<8, 4>(accf, accb, af, ab, T0, TLD, lane);
        float* dstf = st + ((((size_t)(b * 4 + h) * 2 + 0) * NCHUNK + c) * 128) * 128; float* dstb = st + ((((size_t)(b * 4 + h) * 2 + 1) * NCHUNK + c) * 128) * 128;
#pragma unroll
        for (int nt = 0; nt < 8; ++nt)
#pragma unroll
            for (int j = 0; j < 4; ++j) { const size_t o_ = (size_t)(16 * w + 4 * (lane >> 4) + j) * 128 + 16 * nt + (lane & 15); dstf[o_] = accf[nt][j]; dstb[o_] = accb[nt][j]; }
    }
}
__device__ __forceinline__ void ret_scan_phase(Frame& F, const Args& args, int p) {
    f32x4* st = (f32x4*)(F.ws + WS_ST);
    for (int i = fbid() * 512 + ftid(); i < 32 * 4096; i += F.G * 512) {
        const int bhd = i >> 12, el = i & 4095; const int dir = bhd & 1, h = (bhd >> 1) & 3;
        const float g128 = exp2f(128.f * log2_gamma(args, p, dir, h));
        f32x4* base = st + (size_t)bhd * NCHUNK * 4096 + el;
        f32x4 s = (f32x4){0.f, 0.f, 0.f, 0.f};
        for (int k = 0; k < NCHUNK; ++k) {
            const int c = dir == 0 ? k : (k < 2 ? 1 - k : NCHUNK + 1 - k);
            const f32x4 u = base[(size_t)c * 4096]; base[(size_t)c * 4096] = s; s = s * g128 + u;
        }
    }
}
__device__ __forceinline__ bf16x8 scale_frag(const bf16x8 a, float sc) {
    bf16x8 r;
#pragma unroll
    for (int k = 0; k < 8; ++k) r[k] = (short)f2bf(bf2f((unsigned)(unsigned short)a[k]) * sc);
    return r;
}
__device__ __forceinline__ void ret_out_item(Frame& F, const Args& args, int p, int item) {
    const int c = item % NCHUNK, h = (item / NCHUNK) & 3, b = item / (NCHUNK * 4);
    int tid = ftid(); asm volatile("" : "+v"(tid)); const int lane = tid & 63, w = F.wave, quad = lane >> 4, l15 = lane & 15;
    LAS bf16_t* T0 = (LAS bf16_t*)F.lds; LAS bf16_t* T1 = (LAS bf16_t*)(F.lds + TILE_BYTES); LAS bf16_t* T2 = (LAS bf16_t*)(F.lds + 2 * TILE_BYTES);
    const size_t row0 = (size_t)b * SU + 128 * c;
    const bf16_t* pe = (const bf16_t*)(F.ws + WS_PE) + row0 * EV_N;
    const float lgf = log2_gamma(args, p, 0, h), lgb = log2_gamma(args, p, 1, h);
    const float* stf = (const float*)(F.ws + WS_ST) + ((((size_t)(b * 4 + h) * 2 + 0) * NCHUNK + c) * 128) * 128;
    const float* stb = (const float*)(F.ws + WS_ST) + ((((size_t)(b * 4 + h) * 2 + 1) * NCHUNK + c) * 128) * 128;
    bf16x8 qf[4];
#pragma unroll
    for (int ks = 0; ks < 4; ++ks) qf[ks] = *(const bf16x8*)(pe + (size_t)(16 * w + l15) * EV_N + h * 128 + 32 * ks + 8 * quad);
    __syncthreads();
    stage_rowmajor(T0, pe + 512 + h * 128, EV_N, tid);
    stage_transposed(T1, pe + 1024 + h * 128, EV_N, tid, false, 0.f, 0.f);
    stage_f32_rowmajor(T2, stf, tid);
    __syncthreads();
    f32x4 ao[8];
#pragma unroll
    for (int nt = 0; nt < 8; ++nt) ao[nt] = (f32x4){0.f, 0.f, 0.f, 0.f};
    {
        const float cf = exp2f(lgf * (float)(16 * w + l15 + 1));
        bf16x8 qs[4];
#pragma unroll
        for (int ks = 0; ks < 4; ++ks) qs[ks] = scale_frag(qf[ks], cf);
        wave_mma<8, 4>(ao, qs, T2, TLD, lane);
    }
    {
        f32x4 aw[8];
#pragma unroll
        for (int nt = 0; nt < 8; ++nt) aw[nt] = (f32x4){0.f, 0.f, 0.f, 0.f};
        wave_mma<8, 4>(aw, qf, T0, TLD, lane);
        __syncthreads();
#pragma unroll
        for (int nt = 0; nt < 8; ++nt)
#pragma unroll
            for (int j = 0; j < 4; ++j) { const int i = 16 * w + 4 * quad + j, jj = 16 * nt + l15; const int d = i - jj;
                const float dec = d > 0 ? exp2f(lgf * (float)d) : (d < 0 ? exp2f(lgb * (float)(-d)) : 2.0f);
                T0[i * TLD + jj] = (bf16_t)f2bf(aw[nt][j] * dec); }
    }
    stage_f32_rowmajor(T2, stb, tid);
    __syncthreads();
    {
        bf16x8 pf[4];
#pragma unroll
        for (int ks = 0; ks < 4; ++ks) pf[ks] = *(const LAS bf16x8*)(T0 + (16 * w + l15) * TLD + 32 * ks + 8 * quad);
        wave_mma<8, 4>(ao, pf, T1, TLD, lane);
        const float cb = exp2f(lgb * (float)(128 - (16 * w + l15)));
#pragma unroll
        for (int ks = 0; ks < 4; ++ks) pf[ks] = scale_frag(qf[ks], cb);
        wave_mma<8, 4>(ao, pf, T2, TLD, lane);
    }
    bf16_t* yb = (bf16_t*)(F.ws + WS_YB16);
#pragma unroll
    for (int j = 0; j < 4; ++j) { const int i = 16 * w + 4 * quad + j;
        float ss = 0.f;
#pragma unroll
        for (int nt = 0; nt < 8; ++nt) ss += ao[nt][j] * ao[nt][j];
        ss += shx(ss, 1, lane); ss += shx(ss, 2, lane); ss += shx(ss, 4, lane); ss += shx(ss, 8, lane);
        const float rstd = 1.0f / sqrtf(ss * (1.0f / 128.f) + EPS);
        const bf16_t* gp = pe + (size_t)i * EV_N + 1536 + h * 128;
#pragma unroll
        for (int nt = 0; nt < 8; ++nt) { const float gt = bf2f(gp[16 * nt + l15]); yb[(row0 + i) * DM + h * 128 + 16 * nt + l15] = ABL_RET0 ? (bf16_t)0 : (bf16_t)f2bf(siluf(gt) * ao[nt][j] * rstd); }
    }
}
__device__ __forceinline__ void ret_direct_item(Frame& F, const Args& args, int p, int item) {
    const int c = item % NCHUNK, h = (item / NCHUNK) & 3, b = item / (NCHUNK * 4);
    int tid = ftid(); asm volatile("" : "+v"(tid)); const int lane = tid & 63, w = F.wave, quad = lane >> 4, l15 = lane & 15;
    LAS bf16_t* T0 = (LAS bf16_t*)F.lds; LAS bf16_t* T1 = (LAS bf16_t*)(F.lds + TILE_BYTES); LAS bf16_t* T2 = (LAS bf16_t*)(F.lds + 2 * TILE_BYTES);
    const size_t row0 = (size_t)b * SU + 128 * c;
    const bf16_t* peb = (const bf16_t*)(F.ws + WS_PE) + (size_t)b * SU * EV_N;
    const bf16_t* pe = peb + (size_t)128 * c * EV_N;
    const float lgf = log2_gamma(args, p, 0, h), lgb = log2_gamma(args, p, 1, h);
    bf16x8 qf[4];
#pragma unroll
    for (int ks = 0; ks < 4; ++ks) qf[ks] = *(const bf16x8*)(pe + (size_t)(16 * w + l15) * EV_N + h * 128 + 32 * ks + 8 * quad);
    f32x4 ao[8];
#pragma unroll
    for (int nt = 0; nt < 8; ++nt) ao[nt] = (f32x4){0.f, 0.f, 0.f, 0.f};
    for (int c2 = 0; c2 < NCHUNK; ++c2) {
        __syncthreads();
        stage_rowmajor(T0, peb + (size_t)128 * c2 * EV_N + 512 + h * 128, EV_N, tid);
        stage_transposed(T1, peb + (size_t)128 * c2 * EV_N + 1024 + h * 128, EV_N, tid, false, 0.f, 0.f);
        __syncthreads();
        f32x4 aw[8];
#pragma unroll
        for (int nt = 0; nt < 8; ++nt) aw[nt] = (f32x4){0.f, 0.f, 0.f, 0.f};
        wave_mma<8, 4>(aw, qf, T0, TLD, lane);
#pragma unroll
        for (int nt = 0; nt < 8; ++nt)
#pragma unroll
            for (int j = 0; j < 4; ++j) { const int i = 16 * w + 4 * quad + j, jj = 16 * nt + l15;
                const int px = 128 * c + i, py = 128 * c2 + jj;
                const int ubx = px < NCTX ? NCTX - 1 - px : SU + NCTX - 1 - px, uby = py < NCTX ? NCTX - 1 - py : SU + NCTX - 1 - py;
                float dec = 0.f;
                if (py <= px && !(px >= NCTX && false)) dec += exp2f(lgf * (float)(px - py));
                if (uby <= ubx) dec += exp2f(lgb * (float)(ubx - uby));
                if (px < NCTX && py >= NCTX) dec = 0.f;
                T2[i * TLD + jj] = (bf16_t)f2bf(aw[nt][j] * dec); }
        LDS_WAIT(); asm volatile("" ::: "memory");
        bf16x8 pf[4];
#pragma unroll
        for (int ks = 0; ks < 4; ++ks) pf[ks] = *(const LAS bf16x8*)(T2 + (16 * w + l15) * TLD + 32 * ks + 8 * quad);
        wave_mma<8, 4>(ao, pf, T1, TLD, lane);
    }
    bf16_t* yb = (bf16_t*)(F.ws + WS_YB16);
#pragma unroll
    for (int j = 0; j < 4; ++j) { const int i = 16 * w + 4 * quad + j;
        float ss = 0.f;
#pragma unroll
        for (int nt = 0; nt < 8; ++nt) ss += ao[nt][j] * ao[nt][j];
        ss += shx(ss, 1, lane); ss += shx(ss, 2, lane); ss += shx(ss, 4, lane); ss += shx(ss, 8, lane);
        const float rstd = 1.0f / sqrtf(ss * (1.0f / 128.f) + EPS);
        const bf16_t* gp = pe + (size_t)i * EV_N + 1536 + h * 128;
#pragma unroll
        for (int nt = 0; nt < 8; ++nt) { const float gt = bf2f(gp[16 * nt + l15]); yb[(row0 + i) * DM + h * 128 + 16 * nt + l15] = (bf16_t)f2bf(siluf(gt) * ao[nt][j] * rstd); }
    }
}
__device__ __forceinline__ void att_item(Frame& F, const Args& args, int p, int item) {
    const int qb = item % NCHUNK, hk = (item / NCHUNK) & 1, b = item / (NCHUNK * 2);
    int tid = ftid(); asm volatile("" : "+v"(tid)); const int lane = tid & 63, w = F.wave, quad = lane >> 4, l15 = lane & 15;
    const int g = w >> 2, hq = 2 * hk + g, qr0 = 32 * (w & 3);
    LAS bf16_t* T0 = (LAS bf16_t*)F.lds; LAS bf16_t* T1 = (LAS bf16_t*)(F.lds + TILE_BYTES);
    LAS bf16_t* Pw = (LAS bf16_t*)(F.lds + 2 * TILE_BYTES) + w * 32 * TLD;
    const bf16_t* peb = (const bf16_t*)(F.ws + WS_PE) + (size_t)b * SU * EV_N;
    const size_t qrow0 = (size_t)128 * qb + qr0;
    bf16x8 qf[2][4];
#pragma unroll
    for (int rt = 0; rt < 2; ++rt)
#pragma unroll
        for (int ks = 0; ks < 4; ++ks) qf[rt][ks] = *(const bf16x8*)(peb + (qrow0 + 16 * rt + l15) * EV_N + 2048 + hq * 128 + 32 * ks + 8 * quad);
    const float sink = ((const float*)(F.ws + WS_SP) + SP_SINK)[p * 4 + hq] * 1.4426950408889634f;
    const float scale = 0.08838834764831845f * 1.4426950408889634f;
    float mrow[2][4], lrow[2][4]; f32x4 ao[2][8];
#pragma unroll
    for (int rt = 0; rt < 2; ++rt) {
#pragma unroll
        for (int j = 0; j < 4; ++j) { mrow[rt][j] = sink; lrow[rt][j] = 1.0f; }
#pragma unroll
        for (int nt = 0; nt < 8; ++nt) ao[rt][nt] = (f32x4){0.f, 0.f, 0.f, 0.f};
    }
    const int ntile = (qb < 2) ? 2 : 5;
    for (int ti = 0; ti < ntile; ++ti) {
        int kt, mode = 0;
        if (ti < 2) kt = ti; else { kt = qb + (ti - 3); mode = (ti == 2) ? 1 : (ti == 4 ? 2 : 0); }
        if (ti >= 2 && (kt < 2 || kt >= NCHUNK)) continue;
        __syncthreads();
        stage_rowmajor(T0, peb + (size_t)128 * kt * EV_N + 2560 + hk * 128, EV_N, tid);
        stage_transposed(T1, peb + (size_t)128 * kt * EV_N + 2816 + hk * 128, EV_N, tid, false, 0.f, 0.f);
        __syncthreads();
        f32x4 s2[2][8];
#pragma unroll
        for (int nt = 0; nt < 8; ++nt) { s2[0][nt] = (f32x4){0.f, 0.f, 0.f, 0.f}; s2[1][nt] = (f32x4){0.f, 0.f, 0.f, 0.f}; }
        wave_mma2<8, 4>(s2[0], s2[1], qf[0], qf[1], T0, TLD, lane);
#pragma unroll
        for (int rt = 0; rt < 2; ++rt) {
            f32x4 (&s)[8] = s2[rt];
#pragma unroll
            for (int j = 0; j < 4; ++j) {
                const int qq = qr0 + 16 * rt + 4 * quad + j;
                float mx = -3.0e38f;
                if (mode == 0) {
#pragma unroll
                    for (int nt = 0; nt < 8; ++nt) { const float v = s[nt][j] * scale; s[nt][j] = v; mx = fmaxf(mx, v); }
                } else {
#pragma unroll
                    for (int nt = 0; nt < 8; ++nt) { const int kk = 16 * nt + l15; float v = s[nt][j] * scale;
                        const bool valid = (mode == 1 ? (kk >= qq) : (kk <= qq));
                        v = valid ? v : -3.0e38f; s[nt][j] = v; mx = fmaxf(mx, v); }
                }
                mx = fmaxf(mx, shx(mx, 1, lane)); mx = fmaxf(mx, shx(mx, 2, lane)); mx = fmaxf(mx, shx(mx, 4, lane)); mx = fmaxf(mx, shx(mx, 8, lane));
                const float mn = fmaxf(mrow[rt][j], mx); const float alpha = __builtin_amdgcn_exp2f(mrow[rt][j] - mn);
                float rs = 0.f;
#pragma unroll
                for (int nt = 0; nt < 8; ++nt) { const float pv = __builtin_amdgcn_exp2f(s[nt][j] - mn); rs += pv;     Pw[(16 * rt + 4 * quad + j) * TLD + 16 * nt + l15] = (bf16_t)f2bf(pv); }
                rs += shx(rs, 1, lane); rs += shx(rs, 2, lane); rs += shx(rs, 4, lane); rs += shx(rs, 8, lane);
                lrow[rt][j] = lrow[rt][j] * alpha + rs; mrow[rt][j] = mn;
#pragma unroll
                for (int nt = 0; nt < 8; ++nt) ao[rt][nt][j] *= alpha;
            }
        }
        LDS_WAIT(); asm volatile("" ::: "memory");
        {
            bf16x8 pf0[4], pf1[4];
#pragma unroll
            for (int ks = 0; ks < 4; ++ks) { pf0[ks] = *(const LAS bf16x8*)(Pw + (l15) * TLD + 32 * ks + 8 * quad); pf1[ks] = *(const LAS bf16x8*)(Pw + (16 + l15) * TLD + 32 * ks + 8 * quad); }
            wave_mma2<8, 4>(ao[0], ao[1], pf0, pf1, T1, TLD, lane);
        }
    }
    bf16_t* yb = (bf16_t*)(F.ws + WS_YB16) + ((size_t)b * SU + qrow0) * DM + 512 + hq * 128;
#pragma unroll
    for (int rt = 0; rt < 2; ++rt)
#pragma unroll
        for (int j = 0; j < 4; ++j) { const float inv = 1.0f / lrow[rt][j];
#pragma unroll
            for (int nt = 0; nt < 8; ++nt) yb[(size_t)(16 * rt + 4 * quad + j) * DM + 16 * nt + l15] = ABL_ATT0 ? (bf16_t)0 : (bf16_t)f2bf(ao[rt][nt][j] * inv); }
}
__device__ __forceinline__ void naive_att(Frame& F, const Args& args, int p) {
    const int gw = F.vcu * NWAVES + F.wave, NGW = F.G * NWAVES, lane = flane();
    LAS float* sq = (LAS float*)F.lds + F.wave * 1024;
    LAS float* sc = sq + 128;
    const bf16_t* pe = (const bf16_t*)(F.ws + WS_PE);
    for (int task = gw; task < MTOK * 4; task += NGW) {
        const int row = task >> 2, hq = task & 3, hk = hq >> 1; const int b = row / SU, pq = row % SU;
        const bf16_t* peb = pe + (size_t)b * SU * EV_N;
        sq[lane] = bf2f(peb[(size_t)pq * EV_N + 2048 + hq * 128 + lane]) * 0.08838834764831845f; sq[lane + 64] = bf2f(peb[(size_t)pq * EV_N + 2048 + hq * 128 + lane + 64]) * 0.08838834764831845f;
        LDS_WAIT(); asm volatile("" ::: "memory");
        int lo = 0, nloc = 0;
        if (pq >= NCTX) { const int t = pq - NCTX; lo = t - 128 < 0 ? 0 : t - 128; const int hi = t + 128 > LSEQ - 1 ? LSEQ - 1 : t + 128; nloc = hi - lo + 1; }
        const int nk = NCTX + nloc;
        const float sink = args.in[I_SINK][p * 4 + hq];
        float mx = sink;
        for (int ki = lane; ki < nk; ki += 64) { const int kp = ki < NCTX ? ki : NCTX + lo + (ki - NCTX);
            const bf16_t* kr = peb + (size_t)kp * EV_N + 2560 + hk * 128; float d = 0.f;
            for (int x = 0; x < 128; ++x) d += sq[x] * bf2f(kr[x]);
            sc[ki] = d; mx = fmaxf(mx, d); }
#pragma unroll
        for (int o = 1; o < 64; o <<= 1) mx = fmaxf(mx, shx(mx, o, lane));
        float sum = 0.f;
        for (int ki = lane; ki < nk; ki += 64) { const float e = expf(sc[ki] - mx); sc[ki] = e; sum += e; }
        sum = wave_sum(sum, lane) + expf(sink - mx);
        LDS_WAIT(); asm volatile("" ::: "memory");
        float o0 = 0.f, o1 = 0.f;
        for (int ki = 0; ki < nk; ++ki) { const int kp = ki < NCTX ? ki : NCTX + lo + (ki - NCTX); const bf16_t* vr = peb + (size_t)kp * EV_N + 2816 + hk * 128; const float pv = sc[ki];
            o0 += pv * bf2f(vr[lane]); o1 += pv * bf2f(vr[lane + 64]); }
        bf16_t* yb = (bf16_t*)(F.ws + WS_YB16) + (size_t)row * DM + 512 + hq * 128;
        yb[lane] = (bf16_t)f2bf(o0 / sum); yb[lane + 64] = (bf16_t)f2bf(o1 / sum);
        LDS_WAIT(); asm volatile("" ::: "memory");
    }
}
__device__ __forceinline__ void hg_scan_item_plain(Frame& F, int item) {
    const int es = item & 3, dir = (item >> 2) & 1, h = (item >> 3) & 7, b = item >> 6;
    const int tid = ftid(), e = tid & 31, dg = tid >> 5;
    LAS float* sP = (LAS float*)F.lds;
    LAS float* sIn = sP + 32 * 16 * 32;
    constexpr int INB = 32 * 128 * 2 + 32 * 32;
    const float* fsrc = (const float*)(F.ws + (dir ? WS_FB : WS_FF));
    const bf16_t* qsrc = (const bf16_t*)(F.ws + WS_PQ); const bf16_t* vsrc = (const bf16_t*)(F.ws + WS_PI);
    float* osrc = (float*)(F.ws + (dir ? WS_OB : WS_OF));
    float S[8];
#pragma unroll
    for (int k = 0; k < 8; ++k) S[k] = 0.f;
    const size_t rb = (size_t)b * SU;
    f32x4 rf0, rf1; u32x4 rq, rv;
    auto pos_of = [&](int s) { return dir ? (s < NCTX ? NCTX - 1 - s : SU + NCTX - 1 - s) : s; };
#define HG_ISSUE(s0_) do { const int pA = pos_of((s0_) + (tid >> 5)), pB = pos_of((s0_) + 16 + (tid >> 5)), pQ = pos_of((s0_) + (tid >> 4)); \
        rf0 = *(const f32x4*)(fsrc + (rb + pA) * DM + h * 128 + 4 * (tid & 31)); rf1 = *(const f32x4*)(fsrc + (rb + pB) * DM + h * 128 + 4 * (tid & 31)); \
        rq = *(const u32x4*)(qsrc + (rb + pQ) * DM + h * 128 + 8 * (tid & 15)); \
        if (tid < 128) { const int pV = pos_of((s0_) + (tid >> 2)); rv = *(const u32x4*)(vsrc + (rb + pV) * DM + h * 128 + 32 * es + 8 * (tid & 3)); } } while (0)
#define HG_WRITE(buf_) do { LAS float* bF = sIn + (buf_) * INB; LAS float* bQ = bF + 32 * 128; LAS float* bV = bQ + 32 * 128; \
        *(LAS f32x4*)(bF + (tid >> 5) * 128 + 4 * (tid & 31)) = rf0; *(LAS f32x4*)(bF + (16 + (tid >> 5)) * 128 + 4 * (tid & 31)) = rf1; \
        { LAS float* d = bQ + (tid >> 4) * 128 + 8 * (tid & 15); *(LAS f32x4*)d = (f32x4){bflo(rq.x), bfhi(rq.x), bflo(rq.y), bfhi(rq.y)}; *(LAS f32x4*)(d + 4) = (f32x4){bflo(rq.z), bfhi(rq.z), bflo(rq.w), bfhi(rq.w)}; } \
        if (tid < 128) { LAS float* d = bV + (tid >> 2) * 32 + 8 * (tid & 3); *(LAS f32x4*)d = (f32x4){bflo(rv.x), bfhi(rv.x), bflo(rv.y), bfhi(rv.y)}; *(LAS f32x4*)(d + 4) = (f32x4){bflo(rv.z), bfhi(rv.z), bflo(rv.w), bfhi(rv.w)}; } } while (0)
    __syncthreads();
    HG_ISSUE(0); HG_WRITE(0);
    __syncthreads();
    constexpr int NTB = SU / 32;
    for (int tb = 0; tb < NTB; ++tb) {
        const int s0 = 32 * tb, cur = tb & 1;
        if (tb + 1 < NTB) HG_ISSUE(s0 + 32);
        const LAS float* sF = sIn + cur * INB; const LAS float* sQ = sF + 32 * 128; const LAS float* sV = sQ + 32 * 128;
#pragma unroll 4
        for (int tt = 0; tt < 32; ++tt) {
            const f32x4 f0 = *(const LAS f32x4*)(sF + tt * 128 + 8 * dg), f1 = *(const LAS f32x4*)(sF + tt * 128 + 8 * dg + 4);
            const f32x4 q0 = *(const LAS f32x4*)(sQ + tt * 128 + 8 * dg), q1 = *(const LAS f32x4*)(sQ + tt * 128 + 8 * dg + 4);
            const float v = sV[tt * 32 + e];
            const float ff[8] = {f0.x, f0.y, f0.z, f0.w, f1.x, f1.y, f1.z, f1.w}; const float qq[8] = {q0.x, q0.y, q0.z, q0.w, q1.x, q1.y, q1.z, q1.w};
            float part = 0.f;
#pragma unroll
            for (int k = 0; k < 8; ++k) { S[k] = ff[k] * S[k] + (1.0f - ff[k]) * v; part += qq[k] * S[k]; }
            sP[(tt * 16 + dg) * 32 + e] = part;
        }
        __syncthreads();
#pragma unroll
        for (int i = 0; i < 2; ++i) { const int q = tid + 512 * i, tt = q >> 5, ee = q & 31; float o = 0.f;
#pragma unroll
            for (int k = 0; k < 16; ++k) o += sP[(tt * 16 + k) * 32 + ee];
            osrc[(rb + pos_of(s0 + tt)) * DM + h * 128 + 32 * es + ee] = o; }
        if (tb + 1 < NTB) HG_WRITE(cur ^ 1);
        __syncthreads();
    }
#undef HG_ISSUE
#undef HG_WRITE
}
__device__ __forceinline__ void hg_scan_item_c16(Frame& F, int item) {
    const int es = item & 3, dir = (item >> 2) & 1, h = (item >> 3) & 7, b = item >> 6;
    const int tid = ftid(), lane = tid & 63, w = F.wave, quad = lane >> 4, l15 = lane & 15;
    constexpr int INB = 32 * 128 * 2 + 32 * 32;
    LAS float* sIn = (LAS float*)F.lds;
    LAS bf16_t* QA = (LAS bf16_t*)(sIn + 2 * INB);
    LAS bf16_t* KB = QA + 2 * 16 * 136;
    LAS bf16_t* KC = KB + 2 * 16 * 136;
    LAS bf16_t* VT = KC + 2 * 128 * 40;
    LAS bf16_t* PP = VT + 2 * 32 * 40;
    LAS bf16_t* ST = PP + 2 * 16 * 40;
    LAS float* DEC = (LAS float*)(ST + 32 * 136);
    const float* fsrc = (const float*)(F.ws + (dir ? WS_FB : WS_FF));
    const bf16_t* qsrc = (const bf16_t*)(F.ws + WS_PQ); const bf16_t* vsrc = (const bf16_t*)(F.ws + WS_PI);
    float* osrc = (float*)(F.ws + (dir ? WS_OB : WS_OF));
    const size_t rb = (size_t)b * SU;
    f32x4 S[2] = {(f32x4){0.f, 0.f, 0.f, 0.f}, (f32x4){0.f, 0.f, 0.f, 0.f}};
    f32x4 rf0, rf1; u32x4 rq, rv;
    auto pos_of = [&](int s) { return dir ? (s < NCTX ? NCTX - 1 - s : SU + NCTX - 1 - s) : s; };
#define HG_ISSUE(s0_) do { const int pA = pos_of((s0_) + (tid >> 5)), pB = pos_of((s0_) + 16 + (tid >> 5)), pQ = pos_of((s0_) + (tid >> 4)); \
        rf0 = *(const f32x4*)(fsrc + (rb + pA) * DM + h * 128 + 4 * (tid & 31)); rf1 = *(const f32x4*)(fsrc + (rb + pB) * DM + h * 128 + 4 * (tid & 31)); \
        rq = *(const u32x4*)(qsrc + (rb + pQ) * DM + h * 128 + 8 * (tid & 15)); \
        if (tid < 128) { const int pV = pos_of((s0_) + (tid >> 2)); rv = *(const u32x4*)(vsrc + (rb + pV) * DM + h * 128 + 32 * es + 8 * (tid & 3)); } } while (0)
#define HG_WRITE(buf_) do { LAS float* bF = sIn + (buf_) * INB; LAS float* bQ = bF + 32 * 128; LAS float* bV = bQ + 32 * 128; \
        *(LAS f32x4*)(bF + (tid >> 5) * 128 + 4 * (tid & 31)) = rf0; *(LAS f32x4*)(bF + (16 + (tid >> 5)) * 128 + 4 * (tid & 31)) = rf1; \
        { LAS float* d = bQ + (tid >> 4) * 128 + 8 * (tid & 15); *(LAS f32x4*)d = (f32x4){bflo(rq.x), bfhi(rq.x), bflo(rq.y), bfhi(rq.y)}; *(LAS f32x4*)(d + 4) = (f32x4){bflo(rq.z), bfhi(rq.z), bflo(rq.w), bfhi(rq.w)}; } \
        if (tid < 128) { LAS float* d = bV + (tid >> 2) * 32 + 8 * (tid & 3); *(LAS f32x4*)d = (f32x4){bflo(rv.x), bfhi(rv.x), bflo(rv.y), bfhi(rv.y)}; *(LAS f32x4*)(d + 4) = (f32x4){bflo(rv.z), bfhi(rv.z), bflo(rv.w), bfhi(rv.w)}; } } while (0)
    __syncthreads();
    for (int i = tid; i < 2 * 128 * 40; i += 512) KC[i] = 0;
    for (int i = tid; i < 2 * 32 * 40; i += 512) VT[i] = 0;
    for (int i = tid; i < 2 * 16 * 40; i += 512) PP[i] = 0;
    for (int i = tid; i < 32 * 136; i += 512) ST[i] = 0;
    HG_ISSUE(0); HG_WRITE(0);
    __syncthreads();
    constexpr int NTB = SU / 32;
#define HG_BAR() do { asm volatile("s_waitcnt lgkmcnt(0)" ::: "memory"); __builtin_amdgcn_s_barrier(); asm volatile("" ::: "memory"); } while (0)
    for (int tb = 0; tb < NTB; ++tb) {
        const int s0 = 32 * tb, cur = tb & 1;
        if (tb + 1 < NTB) HG_ISSUE(s0 + 32);
        const LAS float* sF = sIn + cur * INB; const LAS float* sQ = sF + 32 * 128; const LAS float* sV = sQ + 32 * 128;
        if (tid < 256) {
            const int c = tid >> 7, d = tid & 127;
            float a = 0.f, kbv[16], fv[16], qv[16];
#pragma unroll
            for (int i = 0; i < 16; ++i) { fv[i] = sF[(16 * c + i) * 128 + d]; qv[i] = sQ[(16 * c + i) * 128 + d]; }
#pragma unroll
            for (int i = 0; i < 16; ++i) { const float f = fv[i], q = qv[i];
                a += __builtin_amdgcn_logf(f); const float ea = __builtin_amdgcn_exp2f(a);
                QA[(c * 16 + i) * 136 + d] = (bf16_t)f2bf(q * ea); kbv[i] = (1.0f - f) * __builtin_amdgcn_exp2f(-a); }
            const float al = __builtin_amdgcn_exp2f(a); DEC[c * 128 + d] = al;
            unsigned pk[8];
#pragma unroll
            for (int j = 0; j < 16; ++j) { KB[(c * 16 + j) * 136 + d] = (bf16_t)f2bf(kbv[j]); }
#pragma unroll
            for (int j = 0; j < 8; ++j) pk[j] = pk2(kbv[2 * j] * al, kbv[2 * j + 1] * al);
            LAS u32x4* kd = (LAS u32x4*)(KC + (c * 128 + d) * 40); kd[0] = (u32x4){pk[0], pk[1], pk[2], pk[3]}; kd[1] = (u32x4){pk[4], pk[5], pk[6], pk[7]};
        } else {
            const int idx = tid - 256, c = idx >> 7, e = (idx >> 2) & 31, jq = idx & 3;
            const float v0 = sV[(16 * c + 4 * jq + 0) * 32 + e], v1 = sV[(16 * c + 4 * jq + 1) * 32 + e], v2 = sV[(16 * c + 4 * jq + 2) * 32 + e], v3 = sV[(16 * c + 4 * jq + 3) * 32 + e];
            u32x2 o; o.x = pk2(v0, v1); o.y = pk2(v2, v3); *(LAS u32x2*)(VT + (c * 32 + e) * 40 + 4 * jq) = o;
        }
        HG_BAR();
        bf16x8 qa[4]; f32x4 oi[2] = {(f32x4){0.f, 0.f, 0.f, 0.f}, (f32x4){0.f, 0.f, 0.f, 0.f}};
        bf16x8 sb0[2][4];
        if (w < 2) {
            const int c = w;
            bf16x8 kbf[4], vbf[2];
#pragma unroll
            for (int ks = 0; ks < 4; ++ks) { qa[ks] = *(const LAS bf16x8*)(QA + (c * 16 + l15) * 136 + 32 * ks + 8 * quad); kbf[ks] = *(const LAS bf16x8*)(KB + (c * 16 + l15) * 136 + 32 * ks + 8 * quad); }
#pragma unroll
            for (int nt = 0; nt < 2; ++nt) vbf[nt] = *(const LAS bf16x8*)(VT + (c * 32 + 16 * nt + l15) * 40 + 8 * quad);
            if (c == 0) {
#pragma unroll
                for (int nt = 0; nt < 2; ++nt)
#pragma unroll
                    for (int ks = 0; ks < 4; ++ks) sb0[nt][ks] = *(const LAS bf16x8*)(ST + (16 * nt + l15) * 136 + 32 * ks + 8 * quad);
            }
            f32x4 sc = (f32x4){0.f, 0.f, 0.f, 0.f};
#pragma unroll
            for (int ks = 0; ks < 4; ++ks) sc = __builtin_amdgcn_mfma_f32_16x16x32_bf16(qa[ks], kbf[ks], sc, 0, 0, 0);
#pragma unroll
            for (int jj = 0; jj < 4; ++jj) { const int i = 4 * quad + jj; PP[(c * 16 + i) * 40 + l15] = (bf16_t)f2bf(l15 <= i ? sc[jj] : 0.f); }
            LDS_WAIT(); asm volatile("" ::: "memory");
            const bf16x8 pa = *(const LAS bf16x8*)(PP + (c * 16 + l15) * 40 + 8 * quad);
#pragma unroll
            for (int nt = 0; nt < 2; ++nt) oi[nt] = __builtin_amdgcn_mfma_f32_16x16x32_bf16(pa, vbf[nt], oi[nt], 0, 0, 0);
        }
#pragma unroll
        for (int c = 0; c < 2; ++c) {
            if (w == c) {
                if (c == 1) {
#pragma unroll
                    for (int nt = 0; nt < 2; ++nt)
#pragma unroll
                        for (int ks = 0; ks < 4; ++ks) sb0[nt][ks] = *(const LAS bf16x8*)(ST + (16 * nt + l15) * 136 + 32 * ks + 8 * quad);
                }
#pragma unroll
                for (int ks = 0; ks < 4; ++ks)
#pragma unroll
                    for (int nt = 0; nt < 2; ++nt) oi[nt] = __builtin_amdgcn_mfma_f32_16x16x32_bf16(qa[ks], sb0[nt][ks], oi[nt], 0, 0, 0);
#pragma unroll
                for (int jj = 0; jj < 4; ++jj) { const int pp = pos_of(s0 + 16 * c + 4 * quad + jj); float* op = osrc + (rb + pp) * DM + h * 128 + 32 * es + l15; op[0] = oi[0][jj]; op[16] = oi[1][jj]; }
            }
            {
                const f32x4 dc = *(const LAS f32x4*)(DEC + c * 128 + 16 * w + 4 * quad);
                const bf16x8 ka = *(const LAS bf16x8*)(KC + (c * 128 + 16 * w + l15) * 40 + 8 * quad);
#pragma unroll
                for (int nt = 0; nt < 2; ++nt) { const bf16x8 vb = *(const LAS bf16x8*)(VT + (c * 32 + 16 * nt + l15) * 40 + 8 * quad); S[nt] = S[nt] * dc; S[nt] = __builtin_amdgcn_mfma_f32_16x16x32_bf16(ka, vb, S[nt], 0, 0, 0); }
            }
            HG_BAR();
#pragma unroll
            for (int nt = 0; nt < 2; ++nt)
#pragma unroll
                for (int jj = 0; jj < 4; ++jj) ST[(16 * nt + l15) * 136 + 16 * w + 4 * quad + jj] = (bf16_t)f2bf(S[nt][jj]);
            if (c == 1 && tb + 1 < NTB) HG_WRITE(cur ^ 1);
            HG_BAR();
        }
    }
#undef HG_ISSUE
#undef HG_WRITE
#undef HG_BAR
}
__device__ __forceinline__ void hg_scan_item_c32(Frame& F, int item) {
    const int es = item & 3, dir = (item >> 2) & 1, h = (item >> 3) & 7, b = item >> 6;
    const int tid = ftid(), lane = tid & 63, w = F.wave, quad = lane >> 4, l15 = lane & 15;
    constexpr int INB = 32 * 128 * 2 + 32 * 32;
    LAS float* sIn = (LAS float*)F.lds;
    LAS bf16_t* QA = (LAS bf16_t*)(sIn + 2 * INB);
    LAS bf16_t* KB = QA + 32 * 136;
    LAS bf16_t* KC = KB + 32 * 136;
    LAS bf16_t* VT = KC + 128 * 40;
    LAS bf16_t* PP = VT + 32 * 40;
    LAS bf16_t* ST = PP + 32 * 40;
    LAS float* DEC = (LAS float*)(ST + 32 * 136);
    const float* fsrc = (const float*)(F.ws + (dir ? WS_FB : WS_FF));
    const bf16_t* qsrc = (const bf16_t*)(F.ws + WS_PQ); const bf16_t* vsrc = (const bf16_t*)(F.ws + WS_PI);
    float* osrc = (float*)(F.ws + (dir ? WS_OB : WS_OF));
    const size_t rb = (size_t)b * SU;
    f32x4 S[2] = {(f32x4){0.f, 0.f, 0.f, 0.f}, (f32x4){0.f, 0.f, 0.f, 0.f}};
    f32x4 rf0A, rf1A, rf0B, rf1B; u32x4 rqA, rvA, rqB, rvB;
    auto pos_of = [&](int s) { return dir ? (s < NCTX ? NCTX - 1 - s : SU + NCTX - 1 - s) : s; };
#define HG_ISSUE(rf0, rf1, rq, rv, s0_) do { const int pA = pos_of((s0_) + (tid >> 5)), pB = pos_of((s0_) + 16 + (tid >> 5)), pQ = pos_of((s0_) + (tid >> 4)); \
        rf0 = *(const f32x4*)(fsrc + (rb + pA) * DM + h * 128 + 4 * (tid & 31)); rf1 = *(const f32x4*)(fsrc + (rb + pB) * DM + h * 128 + 4 * (tid & 31)); \
        rq = *(const u32x4*)(qsrc + (rb + pQ) * DM + h * 128 + 8 * (tid & 15)); \
        if (tid < 128) { const int pV = pos_of((s0_) + (tid >> 2)); rv = *(const u32x4*)(vsrc + (rb + pV) * DM + h * 128 + 32 * es + 8 * (tid & 3)); } } while (0)
#define HG_WRITE(rf0, rf1, rq, rv, buf_) do { LAS float* bF = sIn + (buf_) * INB; LAS float* bQ = bF + 32 * 128; LAS float* bV = bQ + 32 * 128; \
        *(LAS f32x4*)(bF + (tid >> 5) * 128 + 4 * (tid & 31)) = rf0; *(LAS f32x4*)(bF + (16 + (tid >> 5)) * 128 + 4 * (tid & 31)) = rf1; \
        { LAS float* d = bQ + (tid >> 4) * 128 + 8 * (tid & 15); *(LAS f32x4*)d = (f32x4){bflo(rq.x), bfhi(rq.x), bflo(rq.y), bfhi(rq.y)}; *(LAS f32x4*)(d + 4) = (f32x4){bflo(rq.z), bfhi(rq.z), bflo(rq.w), bfhi(rq.w)}; } \
        if (tid < 128) { LAS float* d = bV + (tid >> 2) * 32 + 8 * (tid & 3); *(LAS f32x4*)d = (f32x4){bflo(rv.x), bfhi(rv.x), bflo(rv.y), bfhi(rv.y)}; *(LAS f32x4*)(d + 4) = (f32x4){bflo(rv.z), bfhi(rv.z), bflo(rv.w), bfhi(rv.w)}; } } while (0)
#define HG_BAR() do { asm volatile("s_waitcnt lgkmcnt(0)" ::: "memory"); __builtin_amdgcn_s_barrier(); asm volatile("" ::: "memory"); } while (0)
    __syncthreads();
    for (int i = tid; i < 32 * 136; i += 512) ST[i] = 0;
    HG_ISSUE(rf0A, rf1A, rqA, rvA, 0); HG_WRITE(rf0A, rf1A, rqA, rvA, 0);
    HG_ISSUE(rf0B, rf1B, rqB, rvB, 32);
    __syncthreads();
    constexpr int NTB = SU / 32;
    auto blk = [&](const int tb, const int cur) __attribute__((always_inline)) {
        const int s0 = 32 * tb;
        const LAS float* sF = sIn + cur * INB; const LAS float* sQ = sF + 32 * 128; const LAS float* sV = sQ + 32 * 128;
        if (tid < 256) {
            const int c = tid & 1, d = tid >> 1;
            float fv[16], qv[16], kbv[16];
#pragma unroll
            for (int i = 0; i < 16; ++i) { fv[i] = sF[(16 * c + i) * 128 + d]; qv[i] = sQ[(16 * c + i) * 128 + d]; }
            float tot = 1.f;
#pragma unroll
            for (int i = 0; i < 16; ++i) tot *= fv[i];
            const float oth = shx(tot, 1, lane);
            float ea = c ? oth : 1.f;
            float eia = __builtin_amdgcn_rcpf(ea);
            const float al = tot * oth;
#pragma unroll
            for (int i = 0; i < 16; ++i) { const float fo = fv[i]; ea *= fo; eia *= __builtin_amdgcn_rcpf(fo);
                QA[(16 * c + i) * 136 + d] = (bf16_t)f2bf(qv[i] * ea); kbv[i] = (1.0f - fo) * eia; }
            if (c == 0) DEC[d] = al;
            unsigned pk[8];
#pragma unroll
            for (int j = 0; j < 16; ++j) KB[(16 * c + j) * 136 + d] = (bf16_t)f2bf(kbv[j]);
#pragma unroll
            for (int j = 0; j < 8; ++j) pk[j] = pk2(kbv[2 * j] * al, kbv[2 * j + 1] * al);
            LAS u32x4* kd = (LAS u32x4*)(KC + d * 40 + 16 * c); kd[0] = (u32x4){pk[0], pk[1], pk[2], pk[3]}; kd[1] = (u32x4){pk[4], pk[5], pk[6], pk[7]};
        } else {
            const int idx = tid - 256, e = idx >> 3, jq = idx & 7;
            const float v0 = sV[(4 * jq + 0) * 32 + e], v1 = sV[(4 * jq + 1) * 32 + e], v2 = sV[(4 * jq + 2) * 32 + e], v3 = sV[(4 * jq + 3) * 32 + e];
            u32x2 o; o.x = pk2(v0, v1); o.y = pk2(v2, v3); *(LAS u32x2*)(VT + e * 40 + 4 * jq) = o;
        }
        HG_BAR();
        if (w < 2) {
            const int it = w;
            bf16x8 qa[4], kbf[2][4], vbf[2], sbf[2][4];
#pragma unroll
            for (int ks = 0; ks < 4; ++ks) { qa[ks] = *(const LAS bf16x8*)(QA + (16 * it + l15) * 136 + 32 * ks + 8 * quad);
                kbf[0][ks] = *(const LAS bf16x8*)(KB + (l15) * 136 + 32 * ks + 8 * quad); kbf[1][ks] = *(const LAS bf16x8*)(KB + (16 + l15) * 136 + 32 * ks + 8 * quad); }
#pragma unroll
            for (int nt = 0; nt < 2; ++nt) { vbf[nt] = *(const LAS bf16x8*)(VT + (16 * nt + l15) * 40 + 8 * quad);
#pragma unroll
                for (int ks = 0; ks < 4; ++ks) sbf[nt][ks] = *(const LAS bf16x8*)(ST + (16 * nt + l15) * 136 + 32 * ks + 8 * quad); }
            f32x4 sc0 = (f32x4){0.f, 0.f, 0.f, 0.f}, sc1 = (f32x4){0.f, 0.f, 0.f, 0.f};
#pragma unroll
            for (int ks = 0; ks < 4; ++ks) { sc0 = __builtin_amdgcn_mfma_f32_16x16x32_bf16(qa[ks], kbf[0][ks], sc0, 0, 0, 0); sc1 = __builtin_amdgcn_mfma_f32_16x16x32_bf16(qa[ks], kbf[1][ks], sc1, 0, 0, 0); }
#pragma unroll
            for (int jj = 0; jj < 4; ++jj) { const int i = 16 * it + 4 * quad + jj;
                PP[i * 40 + l15] = (bf16_t)f2bf(l15 <= i ? sc0[jj] : 0.f); PP[i * 40 + 16 + l15] = (bf16_t)f2bf(16 + l15 <= i ? sc1[jj] : 0.f); }
            LDS_WAIT(); asm volatile("" ::: "memory");
            const bf16x8 pa = *(const LAS bf16x8*)(PP + (16 * it + l15) * 40 + 8 * quad);
            f32x4 oi[2];
#pragma unroll
            for (int nt = 0; nt < 2; ++nt) { oi[nt] = __builtin_amdgcn_mfma_f32_16x16x32_bf16(pa, vbf[nt], (f32x4){0.f, 0.f, 0.f, 0.f}, 0, 0, 0);
#pragma unroll
                for (int ks = 0; ks < 4; ++ks) oi[nt] = __builtin_amdgcn_mfma_f32_16x16x32_bf16(qa[ks], sbf[nt][ks], oi[nt], 0, 0, 0); }
#pragma unroll
            for (int jj = 0; jj < 4; ++jj) { const int pp = pos_of(s0 + 16 * it + 4 * quad + jj); float* op = osrc + (rb + pp) * DM + h * 128 + 32 * es + l15; op[0] = oi[0][jj]; op[16] = oi[1][jj]; }
        }
        {
            const f32x4 dc = *(const LAS f32x4*)(DEC + 16 * w + 4 * quad);
            const bf16x8 ka = *(const LAS bf16x8*)(KC + (16 * w + l15) * 40 + 8 * quad);
#pragma unroll
            for (int nt = 0; nt < 2; ++nt) { const bf16x8 vb = *(const LAS bf16x8*)(VT + (16 * nt + l15) * 40 + 8 * quad); S[nt] = S[nt] * dc; S[nt] = __builtin_amdgcn_mfma_f32_16x16x32_bf16(ka, vb, S[nt], 0, 0, 0); }
        }
        HG_BAR();
#pragma unroll
        for (int nt = 0; nt < 2; ++nt)
#pragma unroll
            for (int jj = 0; jj < 4; ++jj) ST[(16 * nt + l15) * 136 + 16 * w + 4 * quad + jj] = (bf16_t)f2bf(S[nt][jj]);
    };
    for (int tb = 0; tb < NTB; tb += 2) {
        { const int nb = tb + 2 < NTB ? tb + 2 : NTB - 1; HG_ISSUE(rf0A, rf1A, rqA, rvA, 32 * nb); }
        blk(tb, 0);
        HG_WRITE(rf0B, rf1B, rqB, rvB, 1);
        HG_BAR();
        { const int nb = tb + 3 < NTB ? tb + 3 : NTB - 1; HG_ISSUE(rf0B, rf1B, rqB, rvB, 32 * nb); }
        blk(tb + 1, 1);
        HG_WRITE(rf0A, rf1A, rqA, rvA, 0);
        HG_BAR();
    }
#undef HG_ISSUE
#undef HG_WRITE
#undef HG_BAR
}
__device__ __forceinline__ void hg_scan_item(Frame& F, int item) {
    const int es = item & 3, dir = (item >> 2) & 1, h = (item >> 3) & 7, b = item >> 6;
    const int tid = ftid(), lane = tid & 63, w = F.wave, quad = lane >> 4, l15 = lane & 15;
    constexpr int INB = 32 * 128 * 2 + 32 * 32;
    LAS float* sIn = (LAS float*)F.lds;
    LAS bf16_t* QA = (LAS bf16_t*)(sIn + 2 * INB);
    LAS bf16_t* KB = QA + 2 * 32 * 136;
    LAS bf16_t* KC = KB + 32 * 136;
    LAS bf16_t* VT = KC + 2 * 128 * 40;
    LAS bf16_t* PP = VT + 2 * 32 * 40;
    LAS bf16_t* ST = PP + 2 * 32 * 40;
    LAS float* DEC = (LAS float*)(ST + 2 * 32 * 136);
    const float* fsrc = (const float*)(F.ws + (dir ? WS_FB : WS_FF));
    const bf16_t* qsrc = (const bf16_t*)(F.ws + WS_PQ); const bf16_t* vsrc = (const bf16_t*)(F.ws + WS_PI);
    float* osrc = (float*)(F.ws + (dir ? WS_OB : WS_OF));
    const size_t rb = (size_t)b * SU;
    auto pos_of = [&](int s) { return dir ? (s < NCTX ? NCTX - 1 - s : SU + NCTX - 1 - s) : s; };
    constexpr int NTB = SU / 32;
#define HG_BAR() do { asm volatile("s_waitcnt lgkmcnt(0)" ::: "memory"); __builtin_amdgcn_s_barrier(); asm volatile("" ::: "memory"); } while (0)
    f32x4 rf[4]; u32x4 rq[2], rv;
#define HG_ISSUE(s0_) do { \
        _Pragma("unroll") for (int r_ = 0; r_ < 4; ++r_) rf[r_] = *(const f32x4*)(fsrc + (rb + pos_of((s0_) + (tid >> 5) + 8 * r_)) * DM + h * 128 + 4 * (tid & 31)); \
        _Pragma("unroll") for (int r_ = 0; r_ < 2; ++r_) rq[r_] = *(const u32x4*)(qsrc + (rb + pos_of((s0_) + (tid >> 4) + 16 * r_)) * DM + h * 128 + 8 * (tid & 15)); \
        if (tid < 128) rv = *(const u32x4*)(vsrc + (rb + pos_of((s0_) + (tid >> 2))) * DM + h * 128 + 32 * es + 8 * (tid & 3)); } while (0)
#define HG_WRITE(buf_) do { LAS float* bF = sIn + (buf_) * INB; LAS float* bQ = bF + 32 * 128; LAS float* bV = bQ + 32 * 128; \
        _Pragma("unroll") for (int r_ = 0; r_ < 4; ++r_) *(LAS f32x4*)(bF + ((tid >> 5) + 8 * r_) * 128 + 4 * (tid & 31)) = rf[r_]; \
        _Pragma("unroll") for (int r_ = 0; r_ < 2; ++r_) { LAS float* d = bQ + ((tid >> 4) + 16 * r_) * 128 + 8 * (tid & 15); *(LAS f32x4*)d = (f32x4){bflo(rq[r_].x), bfhi(rq[r_].x), bflo(rq[r_].y), bfhi(rq[r_].y)}; *(LAS f32x4*)(d + 4) = (f32x4){bflo(rq[r_].z), bfhi(rq[r_].z), bflo(rq[r_].w), bfhi(rq[r_].w)}; } \
        if (tid < 128) { LAS float* d = bV + (tid >> 2) * 32 + 8 * (tid & 3); *(LAS f32x4*)d = (f32x4){bflo(rv.x), bfhi(rv.x), bflo(rv.y), bfhi(rv.y)}; *(LAS f32x4*)(d + 4) = (f32x4){bflo(rv.z), bfhi(rv.z), bflo(rv.w), bfhi(rv.w)}; } } while (0)
    f32x4 S[2][2];
#pragma unroll
    for (int a = 0; a < 2; ++a)
#pragma unroll
        for (int c2 = 0; c2 < 2; ++c2) S[a][c2] = (f32x4){0.f, 0.f, 0.f, 0.f};
    __syncthreads();
    for (int i = tid; i < 2 * 32 * 136; i += 512) ST[i] = 0;
    if (w < 4) { HG_ISSUE(0); HG_WRITE(0); HG_ISSUE(32); }
    __syncthreads();
    for (int j = 0; j <= NTB; ++j) {
        const int sp = j & 1;
        const int t = j - 1, sc_ = t & 1;
        f32x4 oi = (f32x4){0.f, 0.f, 0.f, 0.f};
        if (w < 4) {
            if (j < NTB) {
                const LAS float* sF = sIn + sp * INB; const LAS float* sQ = sF + 32 * 128; const LAS float* sV = sQ + 32 * 128;
                const int cq = w, dp = lane;
                f32x2 fv[32], qv[8];
#pragma unroll
                for (int i = 0; i < 32; ++i) fv[i] = *(const LAS f32x2*)(sF + i * 128 + 2 * dp);
                f32x2 fq[8];
#pragma unroll
                for (int i = 0; i < 8; ++i) { qv[i] = *(const LAS f32x2*)(sQ + (8 * cq + i) * 128 + 2 * dp); fq[i] = *(const LAS f32x2*)(sF + (8 * cq + i) * 128 + 2 * dp); }
                const int e = tid >> 3, jq = tid & 7;
                const float v0 = sV[(4 * jq + 0) * 32 + e], v1 = sV[(4 * jq + 1) * 32 + e], v2 = sV[(4 * jq + 2) * 32 + e], v3 = sV[(4 * jq + 3) * 32 + e];
                f32x2 qp[4];
#pragma unroll
                for (int c4 = 0; c4 < 4; ++c4) { f32x2 pr = fv[8 * c4];
#pragma unroll
                    for (int i = 1; i < 8; ++i) pr = pr * fv[8 * c4 + i]; qp[c4] = pr; }
                f32x2 ea = (f32x2){1.f, 1.f};
#pragma unroll
                for (int c4 = 0; c4 < 3; ++c4) { if (c4 < cq) ea = ea * qp[c4]; }
                const f32x2 al = (qp[0] * qp[1]) * (qp[2] * qp[3]);
                f32x2 eia; eia.x = __builtin_amdgcn_rcpf(ea.x); eia.y = __builtin_amdgcn_rcpf(ea.y);
                LAS bf16_t* qa_ = QA + sp * 32 * 136;
                f32x2 kbv[8];
#pragma unroll
                for (int i = 0; i < 8; ++i) { const f32x2 fo = fq[i];
                    ea = ea * fo; f32x2 rf_; rf_.x = __builtin_amdgcn_rcpf(fo.x); rf_.y = __builtin_amdgcn_rcpf(fo.y); eia = eia * rf_;
                    const f32x2 qa2 = qv[i] * ea; kbv[i] = ((f32x2){1.f, 1.f} - fo) * eia;
                    *(LAS unsigned*)(qa_ + (8 * cq + i) * 136 + 2 * dp) = pk2(qa2.x, qa2.y);
                    *(LAS unsigned*)(KB + (8 * cq + i) * 136 + 2 * dp) = pk2(kbv[i].x, kbv[i].y); }
                if (cq == 0) *(LAS f32x2*)(DEC + sp * 128 + 2 * dp) = al;
                u32x4 k0, k1;
                k0.x = pk2(kbv[0].x * al.x, kbv[1].x * al.x); k0.y = pk2(kbv[2].x * al.x, kbv[3].x * al.x); k0.z = pk2(kbv[4].x * al.x, kbv[5].x * al.x); k0.w = pk2(kbv[6].x * al.x, kbv[7].x * al.x);
                k1.x = pk2(kbv[0].y * al.y, kbv[1].y * al.y); k1.y = pk2(kbv[2].y * al.y, kbv[3].y * al.y); k1.z = pk2(kbv[4].y * al.y, kbv[5].y * al.y); k1.w = pk2(kbv[6].y * al.y, kbv[7].y * al.y);
                *(LAS u32x4*)(KC + (sp * 128 + 2 * dp) * 40 + 8 * cq) = k0; *(LAS u32x4*)(KC + (sp * 128 + 2 * dp + 1) * 40 + 8 * cq) = k1;
                u32x2 o; o.x = pk2(v0, v1); o.y = pk2(v2, v3); *(LAS u32x2*)(VT + (sp * 32 + e) * 40 + 4 * jq) = o;
            }
        } else if (t >= 0) {
            const int k = w - 4, it = k >> 1, nt = k & 1;
            const bf16x8 pa = *(const LAS bf16x8*)(PP + (sc_ * 32 + 16 * it + l15) * 40 + 8 * quad);
            const bf16x8 vb = *(const LAS bf16x8*)(VT + (sc_ * 32 + 16 * nt + l15) * 40 + 8 * quad);
            bf16x8 qa[4], sb[4];
#pragma unroll
            for (int ks = 0; ks < 4; ++ks) { qa[ks] = *(const LAS bf16x8*)(QA + (sc_ * 32 + 16 * it + l15) * 136 + 32 * ks + 8 * quad); sb[ks] = *(const LAS bf16x8*)(ST + (sc_ * 32 + 16 * nt + l15) * 136 + 32 * ks + 8 * quad); }
            oi = __builtin_amdgcn_mfma_f32_16x16x32_bf16(pa, vb, oi, 0, 0, 0);
#pragma unroll
            for (int ks = 0; ks < 4; ++ks) oi = __builtin_amdgcn_mfma_f32_16x16x32_bf16(qa[ks], sb[ks], oi, 0, 0, 0);
#pragma unroll
            for (int jj = 0; jj < 4; ++jj) { const int pp = pos_of(32 * t + 16 * it + 4 * quad + jj); osrc[(rb + pp) * DM + h * 128 + 32 * es + 16 * nt + l15] = oi[jj]; }
        }
        HG_BAR();
        if (w < 2) {
            if (j < NTB) {
                const int it = w;
                bf16x8 qa[4], kbf[2][4];
#pragma unroll
                for (int ks = 0; ks < 4; ++ks) { qa[ks] = *(const LAS bf16x8*)(QA + (sp * 32 + 16 * it + l15) * 136 + 32 * ks + 8 * quad);
                    kbf[0][ks] = *(const LAS bf16x8*)(KB + (l15) * 136 + 32 * ks + 8 * quad); kbf[1][ks] = *(const LAS bf16x8*)(KB + (16 + l15) * 136 + 32 * ks + 8 * quad); }
                f32x4 sc0 = (f32x4){0.f, 0.f, 0.f, 0.f}, sc1 = (f32x4){0.f, 0.f, 0.f, 0.f};
#pragma unroll
                for (int ks = 0; ks < 4; ++ks) { sc0 = __builtin_amdgcn_mfma_f32_16x16x32_bf16(qa[ks], kbf[0][ks], sc0, 0, 0, 0); sc1 = __builtin_amdgcn_mfma_f32_16x16x32_bf16(qa[ks], kbf[1][ks], sc1, 0, 0, 0); }
#pragma unroll
                for (int jj = 0; jj < 4; ++jj) { const int i = 16 * it + 4 * quad + jj;
                    PP[(sp * 32 + i) * 40 + l15] = (bf16_t)f2bf(l15 <= i ? sc0[jj] : 0.f); PP[(sp * 32 + i) * 40 + 16 + l15] = (bf16_t)f2bf(16 + l15 <= i ? sc1[jj] : 0.f); }
            }
        } else if (w >= 4 && t >= 0) {
            const int k = w - 4;
#pragma unroll
            for (int mt = 0; mt < 2; ++mt) {
                const f32x4 dc = *(const LAS f32x4*)(DEC + sc_ * 128 + 32 * k + 16 * mt + 4 * quad);
                const bf16x8 ka = *(const LAS bf16x8*)(KC + (sc_ * 128 + 32 * k + 16 * mt + l15) * 40 + 8 * quad);
#pragma unroll
                for (int n2 = 0; n2 < 2; ++n2) { const bf16x8 vb2 = *(const LAS bf16x8*)(VT + (sc_ * 32 + 16 * n2 + l15) * 40 + 8 * quad); S[mt][n2] = S[mt][n2] * dc; S[mt][n2] = __builtin_amdgcn_mfma_f32_16x16x32_bf16(ka, vb2, S[mt][n2], 0, 0, 0); }
            }
            LAS bf16_t* stn = ST + (sc_ ^ 1) * 32 * 136;
#pragma unroll
            for (int mt = 0; mt < 2; ++mt)
#pragma unroll
                for (int n2 = 0; n2 < 2; ++n2)
                    { u32x2 o2; o2.x = pk2(S[mt][n2][0], S[mt][n2][1]); o2.y = pk2(S[mt][n2][2], S[mt][n2][3]); *(LAS u32x2*)(stn + (16 * n2 + l15) * 136 + 32 * k + 16 * mt + 4 * quad) = o2; }
        }
        if (w < 4 && j + 1 < NTB) { HG_WRITE((j + 1) & 1); if (j + 2 < NTB) HG_ISSUE(32 * (j + 2)); }
        HG_BAR();
    }
#undef HG_ISSUE
#undef HG_WRITE
#undef HG_BAR
}
__device__ __forceinline__ void naive_hg_scan(Frame& F) {
    const int gt = fbid() * 512 + ftid();
    if (gt >= NB * 8 * 2 * 128) return;
    const int e = gt & 127, dir = (gt >> 7) & 1, h = (gt >> 8) & 7, b = gt >> 11;
    const float* fsrc = (const float*)(F.ws + (dir ? WS_FB : WS_FF));
    const bf16_t* qsrc = (const bf16_t*)(F.ws + WS_PQ); const bf16_t* vsrc = (const bf16_t*)(F.ws + WS_PI);
    float* osrc = (float*)(F.ws + (dir ? WS_OB : WS_OF));
    float S[128];
#pragma unroll
    for (int d = 0; d < 128; ++d) S[d] = 0.f;
    for (int s_ = 0; s_ < SU; ++s_) {
        const int pp = dir ? (s_ < NCTX ? NCTX - 1 - s_ : SU + NCTX - 1 - s_) : s_;
        const size_t row = (size_t)b * SU + pp;
        const float v = bf2f(vsrc[row * DM + h * 128 + e]);
        const float* fr = fsrc + row * DM + h * 128; const bf16_t* qr = qsrc + row * DM + h * 128;
        float o = 0.f;
#pragma unroll
        for (int d = 0; d < 128; ++d) { const float f = fr[d]; S[d] = f * S[d] + (1.0f - f) * v; o += bf2f(qr[d]) * S[d]; }
        osrc[row * DM + h * 128 + e] = o;
    }
}
__device__ __forceinline__ void naive_hg_readout(Frame& F, const Args& args, int p) {
    for (int i = fbid() * 512 + ftid(); i < MTOK * 8; i += F.G * 512) {
        const int row = i >> 3, h = i & 7;
        const float* a = (const float*)(F.ws + WS_OF) + (size_t)row * DM + h * 128; const float* c = (const float*)(F.ws + WS_OB) + (size_t)row * DM + h * 128;
        float ss = 0.f;
        for (int d = 0; d < 128; ++d) { const float o = a[d] + c[d]; ss += o * o; }
        const float rstd = 1.0f / sqrtf(ss / 128.f + EPS);
        const bf16_t* g = (const bf16_t*)(F.ws + WS_PG) + (size_t)row * DM + h * 128; bf16_t* y = (bf16_t*)(F.ws + WS_YB16) + (size_t)row * DM + h * 128;
        for (int d = 0; d < 128; ++d) { const float o = a[d] + c[d]; const float gv = bf2f(g[d]); y[d] = (bf16_t)f2bf(o * rstd * args.in[I_HGNW][p * 128 + d] * (gv / (1.0f + expf(-gv)))); }
    }
}
__device__ __forceinline__ void hg_readout_phase(Frame& F, const Args& args, int p) {
    const int gw = F.vcu * NWAVES + F.wave, NGW = F.G * NWAVES, lane = flane();
    const float* nw = ((const float*)(F.ws + WS_SP) + SP_HGNW) + p * 128 + 16 * (lane & 7);
    for (int row = gw; row < MTOK; row += NGW) {
        const f32x4* a = (const f32x4*)(F.ws + WS_OF + (size_t)row * DM * 4) + 4 * lane; const f32x4* c = (const f32x4*)(F.ws + WS_OB + (size_t)row * DM * 4) + 4 * lane;
        f32x4 o[4]; float ss = 0.f;
#pragma unroll
        for (int j = 0; j < 4; ++j) { o[j] = ABL_HGB0 ? a[j] : a[j] + c[j]; ss += (o[j].x * o[j].x + o[j].y * o[j].y) + (o[j].z * o[j].z + o[j].w * o[j].w); }
        ss += shx(ss, 1, lane); ss += shx(ss, 2, lane); ss += shx(ss, 4, lane);
        const float rstd = 1.0f / sqrtf(ss * (1.0f / 128.f) + EPS);
        const u32x4* gp = (const u32x4*)(F.ws + WS_PG + (size_t)row * DM * 2) + 2 * lane;
        const u32x4 g0 = gp[0], g1 = gp[1]; const unsigned gwv[8] = {g0.x, g0.y, g0.z, g0.w, g1.x, g1.y, g1.z, g1.w};
        unsigned outw[8];
#pragma unroll
        for (int j = 0; j < 4; ++j) { const f32x4 wv = *(const f32x4*)(nw + 4 * j);
            const float y0 = o[j].x * rstd * wv.x * siluf(bflo(gwv[2 * j])), y1 = o[j].y * rstd * wv.y * siluf(bfhi(gwv[2 * j]));
            const float y2 = o[j].z * rstd * wv.z * siluf(bflo(gwv[2 * j + 1])), y3 = o[j].w * rstd * wv.w * siluf(bfhi(gwv[2 * j + 1]));
            outw[2 * j] = pk2(y0, y1); outw[2 * j + 1] = pk2(y2, y3); }
        u32x4* op = (u32x4*)(F.ws + WS_YB16 + (size_t)row * DM * 2) + 2 * lane;
        op[0] = (u32x4){outw[0], outw[1], outw[2], outw[3]}; op[1] = (u32x4){outw[4], outw[5], outw[6], outw[7]};
    }
}

constexpr int NPHASE = 2 + 9 * DEPTH;
constexpr unsigned KM_ALL = 0x7ffu | (3u << 16);
template <unsigned KM>
__device__ __forceinline__ void mk_body(const Args& args, unsigned char* lds_raw) {
    Frame F;
    F.lds = (LAS unsigned char*)lds_raw;
    F.MISC = (volatile LAS unsigned*)(F.lds + MISC_OFF);
    F.wave = __builtin_amdgcn_readfirstlane(ftid() >> 6);
    F.G = gridDim.x; { const int bx = blockIdx.x; F.vcu = (F.G % 8 == 0) ? (bx % 8) * (F.G / 8) + bx / 8 : bx; }
    F.ws = args.ws; F.ctl = (unsigned*)(args.ws + WS_CTL);
    for (int u = ftid(); u < (LDS_BYTES - LDSCTL_OFF) / 4; u += NWAVES * 64) ((LAS unsigned*)(F.lds + LDSCTL_OFF))[u] = 0u;
    __syncthreads();
    XcdBarrier bar; bar.bar = F.ctl + CW_BAR; bar.x = 0; bar.st = nullptr;
    const int lo = args.ph_lo, hi = args.ph_hi;
    if (hi - lo > 1) bar = xcd_barrier_post(F.ctl + CW_BAR, F.MISC + 8);
#define HAS(kind) ((KM >> (kind)) & 1u)
    if constexpr (HAS(0)) { if (lo == 0) { p0_prologue(F, args); if (NAIVE_MOD) { __syncthreads(); naive_mod(F, args); } if (hi > 1) xcd_barrier(bar); } }
    float* const outp = args.out;
#pragma nounroll
    for (int ph = (lo == 0 ? 1 : lo); ph < hi; ++ph) {
        const Args* ap = &args;
        { unsigned char* w_ = args.ws; asm volatile("" : "+s"(w_)); F.ws = w_; F.ctl = (unsigned*)(w_ + WS_CTL); }
        { int wv_ = __builtin_amdgcn_readfirstlane(ftid() >> 6); F.wave = wv_; int g_ = (int)gridDim.x; asm volatile("" : "+s"(g_)); F.G = g_; const int bx = fbid(); F.vcu = (g_ % 8 == 0) ? (bx % 8) * (g_ / 8) + bx / 8 : bx; }
        const float* mod = (const float*)(F.ws + WS_MOD);
        const int kind = (ph == 0) ? 0 : (ph == NPHASE - 1 ? 10 : 1 + (ph - 1) % 9);
        const int l = (ph - 1) / 9; const int odd = l & 1, p = l >> 1;
        if (kind == 5 && odd) continue;
        switch (kind) {
        case 1: if constexpr (HAS(1)) { if (NAIVE_N1 == 1) naive_n1(F, *ap, l, false); else if (NAIVE_N1 == 2) wave_n1(F, *ap, l, false); else n1_phase<false>(F, *ap, l); } break;
        case 2: if constexpr (HAS(2)) {
            const int N = odd ? OD_N : EV_N;
            if (NAIVE_G1) { naive_g1(F, *ap, l); } else {
            pg8::PlainAddr AD{(const bf16_t*)(F.ws + WS_HB), (const bf16_t*)(F.ws + (odd ? WS_W_ODIN + (size_t)p * 10 * MiB : WS_W_EVIN + (size_t)p * 6 * MiB)), DM};
            pg8::StaticOrder S; S.init(MTOK, N, F.G, fbid());
            EpiProj E{F.ws, (const float*)(F.ws + WS_LB) + l * DM, odd};
            pg8::gemm_phase(F.lds, AD, S, E, DM);
            } } break;
        case 3: if constexpr (HAS(3)) {
            if (!odd) {
                if constexpr (HAS(16)) {
                    for (int it = fbid(); it < NB * 4 * NCHUNK + (NAIVE_ATT ? 0 : NB * 2 * NCHUNK); it += F.G) {
                        if (it < NB * 4 * NCHUNK) ret_state_item(F, *ap, p, it); else att_item(F, *ap, p, it - NB * 4 * NCHUNK);
                    }
                    if (NAIVE_ATT) { __syncthreads(); naive_att(F, *ap, p); }
                }
            } else {
                if constexpr (HAS(17)) { if (NAIVE_HG) naive_hg_scan(F); else for (int it = fbid(); it < NB * 8 * 2 * 4; it += F.G) hg_scan_item(F, it); }
            }
            __syncthreads(); } break;
        case 4: if constexpr (HAS(4)) {
            if (!odd) { if constexpr (HAS(16)) ret_scan_phase(F, *ap, p); } else { if constexpr (HAS(17)) { if (NAIVE_HG) naive_hg_readout(F, *ap, p); else hg_readout_phase(F, *ap, p); } } } break;
        case 5: if constexpr (HAS(5)) { for (int it = fbid(); it < NB * 4 * NCHUNK; it += F.G) { if (RET_DIRECT) ret_direct_item(F, *ap, p, it); else ret_out_item(F, *ap, p, it); } __syncthreads(); } break;
        case 6: if constexpr (HAS(6)) {
            if (NAIVE_G2) { if (odd ? CONTRIB_ODD : CONTRIB_EVEN) naive_g2(F, *ap, l); } else {
            pg8::PlainAddr AD{(const bf16_t*)(F.ws + WS_YB16), (const bf16_t*)(F.ws + (odd ? WS_W_ODOUT : WS_W_EVOUT) + (size_t)p * 2 * MiB), DM};
            pg8::StaticOrder S; S.init(MTOK, DM, F.G, fbid());
            EpiOut E{(float*)(F.ws + WS_XRES), mod + (size_t)l * 5 * 6144, odd ? CONTRIB_ODD : CONTRIB_EVEN};
            pg8::gemm_phase(F.lds, AD, S, E, DM);
            } } break;
        case 7: if constexpr (HAS(7)) { if (NAIVE_N2R) naive_n2r(F, *ap, l); else n2r_phase(F, *ap, l); } break;
        case 8: case 9: if constexpr (HAS(8) || HAS(9)) {
            LAS int* tstart = (LAS int*)(F.lds + LDSCTL_OFF + 512); LAS int* cnts = (LAS int*)(F.lds + LDSCTL_OFF + 768);
            __syncthreads();
            if (F.wave == 0) { int mycnt; const int pre = moe_tile_prefix(F.ctl + CW_CNT + l * NEXP, flane(), mycnt); if (flane() <= NEXP) tstart[flane()] = pre; if (flane() < NEXP) cnts[flane()] = mycnt; }
            __syncthreads();
            const int ntiles = tstart[NEXP];
            const bf16_t* wmoe = (const bf16_t*)(F.ws + WS_W_MOE + (size_t)l * NEXP * 3 * MiB);
            if (kind == 8) { if constexpr (HAS(8)) {
                if (NAIVE_MOE) naive_moe(F, *ap, l); else {
                pg8::MoeGatherAddr AD{(const bf16_t*)(F.ws + WS_HB), wmoe, (const unsigned*)(F.ws + WS_LIST), DM};
                pg8::MoeOrder S{tstart, cnts, ntiles, F.G, fbid()};
                EpiAct E{(bf16_t*)(F.ws + WS_ACT)};
                pg8::gemm_phase(F.lds, AD, S, E, DM); }
            } } else { if constexpr (HAS(9)) {
                pg8::MoeActAddr AD{(const bf16_t*)(F.ws + WS_ACT), wmoe + (size_t)DM * DM, FF};
                pg8::MoeOrder S{tstart, cnts, ntiles, F.G, fbid()};
                EpiY E{(bf16_t*)(F.ws + WS_YB)};
                pg8::gemm_phase(F.lds, AD, S, E, FF);
            } } } break;
        default: if constexpr (HAS(10)) { if (NAIVE_FINAL == 1) naive_n1(F, *ap, DEPTH, true); else if (NAIVE_FINAL == 2) wave_n1(F, *ap, DEPTH, true); else n1_phase<true>(F, *ap, DEPTH); } break;
        }
        if (ph + 1 < hi) xcd_barrier(bar);
    }
#undef HAS
}
template <int L>
__device__ __forceinline__ void layer_sl(Frame& F, const Args& args, const XcdBarrier& bar) {
    constexpr int l = L; constexpr int odd = L & 1, p = L >> 1;
    const float* mod = (const float*)(F.ws + WS_MOD);
    n1_phase<false>(F, args, l); xcd_barrier(bar);
    { pg8::PlainAddr AD{(const bf16_t*)(F.ws + WS_HB), (const bf16_t*)(F.ws + (odd ? WS_W_ODIN + (size_t)p * 10 * MiB : WS_W_EVIN + (size_t)p * 6 * MiB)), DM};
      pg8::StaticOrder S; S.init(MTOK, odd ? OD_N : EV_N, F.G, fbid());
      EpiProj E{F.ws, (const float*)(F.ws + WS_LB) + l * DM, odd};
      pg8::gemm_phase(F.lds, AD, S, E, DM); }
    conv_moe_tail(F, args, l, 0, moe_g1_hi(l), (MTOK / 256) * ((odd ? OD_N : EV_N) / 256));
    xcd_barrier(bar);
    if constexpr (!odd) {
        {
            const int bx = fbid();
            if (F.G == 256) {
                att_item(F, args, p, bx);
                if (bx < 16) att_item(F, args, p, 256 + bx);
                else { const int r0 = 2 * (bx - 16); ret_state_item(F, args, p, r0); ret_state_item(F, args, p, r0 + 1); if (bx - 16 < 64) ret_state_item(F, args, p, 480 + (bx - 16)); }
            } else {
                for (int it = bx; it < NB * 4 * NCHUNK + NB * 2 * NCHUNK; it += F.G) { if (it < NB * 2 * NCHUNK) att_item(F, args, p, it); else ret_state_item(F, args, p, it - NB * 2 * NCHUNK); }
            }
        }
        __syncthreads(); xcd_barrier(bar);
        ret_scan_phase(F, args, p); xcd_barrier(bar);
        for (int rep_ = 0; rep_ <= REP_MIXE; ++rep_) for (int it = fbid(); it < NB * 4 * NCHUNK; it += F.G) ret_out_item(F, args, p, it);
        __syncthreads(); xcd_barrier(bar);
    } else {
        for (int rep_ = 0; rep_ <= REP_HG; ++rep_) for (int it = F.vcu; it < NB * 8 * 2 * 4; it += F.G) hg_scan_item(F, it);
        __syncthreads(); xcd_barrier(bar);
        hg_readout_phase(F, args, p); xcd_barrier(bar);
    }
    { pg8::PlainAddr AD{(const bf16_t*)(F.ws + WS_YB16), (const bf16_t*)(F.ws + (odd ? WS_W_ODOUT : WS_W_EVOUT) + (size_t)p * 2 * MiB), DM};
      pg8::StaticOrder S; S.init(MTOK, DM, F.G, fbid(), l == DEPTH - 1 ? 1 : 0);
      EpiOut E{(float*)(F.ws + WS_XRES), mod + (size_t)l * 5 * 6144, 1};
      pg8::gemm_phase(F.lds, AD, S, E, DM); }
    if constexpr (l != DEPTH - 1) conv_moe_tail(F, args, l, moe_g1_hi(l), moe_g2_hi(l), (MTOK / 256) * (DM / 256));
    xcd_barrier(bar);
    n2r_phase(F, args, l); xcd_barrier(bar);
    {   LAS int* tstart = (LAS int*)(F.lds + LDSCTL_OFF + 512); LAS int* cnts = (LAS int*)(F.lds + LDSCTL_OFF + 768);
        __syncthreads();
        if (F.wave == 0) { int mycnt; const int ln = flane(); const int pre = moe_tile_prefix(F.ctl + CW_CNT + l * NEXP, ln, mycnt); if (ln <= NEXP) tstart[ln] = pre; if (ln < NEXP) cnts[ln] = mycnt; }
        __syncthreads();
        const int ntiles = tstart[NEXP];
        const bf16_t* wmoe = (const bf16_t*)(F.ws + WS_W_MOE + (size_t)l * NEXP * 3 * MiB);
        { pg8::MoeGatherAddr AD{(const bf16_t*)(F.ws + WS_HB), wmoe, (const unsigned*)(F.ws + WS_LIST), DM};
          pg8::MoeOrder S{tstart, cnts, ntiles, F.G, fbid()};
          EpiAct E{(bf16_t*)(F.ws + WS_ACT)};
          pg8::gemm_phase(F.lds, AD, S, E, DM); }
        xcd_barrier(bar);
        { pg8::MoeActAddr AD{(const bf16_t*)(F.ws + WS_ACT), wmoe + (size_t)DM * DM, FF};
          pg8::MoeOrder S{tstart, cnts, ntiles, F.G, fbid()};
          EpiY E{(bf16_t*)(F.ws + WS_YB)};
          pg8::gemm_phase(F.lds, AD, S, E, FF); }
        xcd_barrier(bar);
    }
}
__global__ void __launch_bounds__(NWAVES * 64, 2) mk_one(Args args) {
    extern __shared__ __attribute__((aligned(16))) unsigned char lds_raw[];
    Frame F;
    F.lds = (LAS unsigned char*)lds_raw;
    F.MISC = (volatile LAS unsigned*)(F.lds + MISC_OFF);
    F.wave = __builtin_amdgcn_readfirstlane(ftid() >> 6);
    F.G = gridDim.x; { const int bx = blockIdx.x; F.vcu = (F.G % 8 == 0) ? (bx % 8) * (F.G / 8) + bx / 8 : bx; }
    F.ws = args.ws; F.ctl = (unsigned*)(args.ws + WS_CTL);
    for (int u = ftid(); u < (LDS_BYTES - LDSCTL_OFF) / 4; u += NWAVES * 64) ((LAS unsigned*)(F.lds + LDSCTL_OFF))[u] = 0u;
    __syncthreads();
    const XcdBarrier bar = xcd_barrier_post(F.ctl + CW_BAR, F.MISC + 8);
    p0_prologue(F, args); xcd_barrier(bar);
    layer_sl<0>(F, args, bar);
    layer_sl<1>(F, args, bar);
    layer_sl<2>(F, args, bar);
    layer_sl<3>(F, args, bar);
    n1_phase<true>(F, args, DEPTH);
}

template <unsigned KM>
__global__ void __launch_bounds__(NWAVES * 64, 2) mk_fwd(Args args) {
    extern __shared__ __attribute__((aligned(16))) unsigned char lds_raw[];
    mk_body<KM>(args, lds_raw);
}

template <unsigned KM> static bool prep_kernel() { return hipFuncSetAttribute((const void*)mk_fwd<KM>, hipFuncAttributeMaxDynamicSharedMemorySize, LDS_BYTES) == hipSuccess; }
template <unsigned KM> static void launch_kernel(int grid, hipStream_t stream, const Args& a) { hipLaunchKernelGGL(mk_fwd<KM>, dim3(grid), dim3(NWAVES * 64), LDS_BYTES, stream, a); }
#define KEV (1u << 16)
#define KOD (1u << 17)
extern "C" void kernel_launch(void* const* d_in, const int* in_sizes, int n_in, void* d_out, int out_size, void* d_ws, size_t ws_size, hipStream_t stream) {
    static int grid = 0;
    if (grid == 0) {
        const int exp_sizes[23] = {NB * LSEQ * DM, NB * DM, NB * NCTX * DM, DM, DEPTH * DM * 6 * DM, DEPTH * 6 * DM, DEPTH * 2 * DM, DM, 2 * DM * EV_N, 2 * DM * DM, 16, 8,
                                   2 * DM * OD_N, 2 * DM * DM, DEPTH * DM, 2 * 128, DEPTH * DM * 4, DEPTH * 4, DEPTH * 4 * DM * 8, DEPTH * 32, DEPTH * NEXP * DM * FF, DEPTH * NEXP * DM * FF, DEPTH * NEXP * FF * DM};
        bool sz_ok = (n_in == 23) && out_size == NB * LSEQ * DM;
        for (int i = 0; i < 23 && sz_ok; ++i) sz_ok = (in_sizes[i] == exp_sizes[i]);
        if (!sz_ok) { fprintf(stderr, "kernel_launch: unexpected input sizes\n"); grid = -1; return; }
        if (n_in != 23 || ws_size < WS_END) { fprintf(stderr, "kernel_launch: unexpected n_in %d / ws_size %zu\n", n_in, ws_size); grid = -1; return; }
        int dev = 0, cus = 0;
        if (hipGetDevice(&dev) != hipSuccess || hipDeviceGetAttribute(&cus, hipDeviceAttributeMultiprocessorCount, dev) != hipSuccess) { grid = -1; return; }
        bool ok = true;
#if MK_PER_PHASE
        ok = ok && prep_kernel<1u << 0>() && prep_kernel<1u << 1>() && prep_kernel<1u << 2>() && prep_kernel<(1u << 3) | KEV>() && prep_kernel<(1u << 3) | KOD>()
                && prep_kernel<(1u << 4) | KEV>() && prep_kernel<(1u << 4) | KOD>() && prep_kernel<(1u << 5) | KEV>() && prep_kernel<1u << 6>() && prep_kernel<1u << 7>()
                && prep_kernel<1u << 8>() && prep_kernel<1u << 9>() && prep_kernel<1u << 10>();
#else
        ok = ok && (hipFuncSetAttribute((const void*)mk_one, hipFuncAttributeMaxDynamicSharedMemorySize, LDS_BYTES) == hipSuccess);
#ifdef PROBE_MASKS
        ok = ok && prep_kernel<(1u<<3)|(3u<<16)>() && prep_kernel<(1u<<3)|(1u<<5)|(1u<<16)>() && prep_kernel<(1u<<0)|(1u<<1)|(1u<<7)|(1u<<10)>() && prep_kernel<(1u<<3)|(1u<<4)|(1u<<5)|(3u<<16)>() && prep_kernel<(1u<<0)|(1u<<3)|(1u<<16)>() && prep_kernel<(1u<<1)|(1u<<3)|(1u<<16)>();
#endif
#endif
        if (!ok) { fprintf(stderr, "kernel_launch: hipFuncSetAttribute failed\n"); grid = -1; return; }
        (void)hipGetLastError();
        grid = cus > 256 ? 256 : cus;
    }
    if (grid < 0) return;
    (void)hipMemsetAsync((char*)d_ws + WS_CTL, 0, CTL_ZERO_BYTES, stream);
    Args a{};
    for (int i = 0; i < 23; ++i) a.in[i] = (const float*)d_in[i];
    a.out = (float*)d_out; a.ws = (unsigned char*)d_ws;
#if MK_PER_PHASE
    for (int ph = 0; ph < NPHASE; ++ph) {
        { unsigned char* w_ = args.ws; asm volatile("" : "+s"(w_)); F.ws = w_; F.ctl = (unsigned*)(w_ + WS_CTL); }
        { int wv_ = __builtin_amdgcn_readfirstlane(ftid() >> 6); F.wave = wv_; int g_ = (int)gridDim.x; asm volatile("" : "+s"(g_)); F.G = g_; const int bx = fbid(); F.vcu = (g_ % 8 == 0) ? (bx % 8) * (g_ / 8) + bx / 8 : bx; }
        const float* mod = (const float*)(F.ws + WS_MOD);
        const int kind = (ph == 0) ? 0 : (ph == NPHASE - 1 ? 10 : 1 + (ph - 1) % 9); const int l = (ph - 1) / 9; const bool odd = (l & 1) != 0;
        if (kind == 5 && odd) continue;
        a.ph_lo = ph; a.ph_hi = ph + 1;
        switch (kind) {
            case 0: launch_kernel<1u << 0>(grid, stream, a); break;
            case 1: launch_kernel<1u << 1>(grid, stream, a); break;
            case 2: launch_kernel<1u << 2>(grid, stream, a); break;
            case 3: if (odd) launch_kernel<(1u << 3) | KOD>(grid, stream, a); else launch_kernel<(1u << 3) | KEV>(grid, stream, a); break;
            case 4: if (odd) launch_kernel<(1u << 4) | KOD>(grid, stream, a); else launch_kernel<(1u << 4) | KEV>(grid, stream, a); break;
            case 5: launch_kernel<(1u << 5) | KEV>(grid, stream, a); break;
            case 6: launch_kernel<1u << 6>(grid, stream, a); break;
            case 7: launch_kernel<1u << 7>(grid, stream, a); break;
            case 8: launch_kernel<1u << 8>(grid, stream, a); break;
            case 9: launch_kernel<1u << 9>(grid, stream, a); break;
            default: launch_kernel<1u << 10>(grid, stream, a); break;
        }
    }
#else
    a.ph_lo = 0; a.ph_hi = NPHASE;
    hipLaunchKernelGGL(mk_one, dim3(grid), dim3(NWAVES * 64), LDS_BYTES, stream, a);
#endif
}
```

```cpp
#include <hip/hip_runtime.h>
#include <cstdio>
#include <cstdint>

#define REPK_EPIPROJ 0
#define REPE_EPIPROJ 0
#define REPE_EPIOUT 0
#define REPE_EPIACT 0
#define REPE_EPIY 0
#define REPK_EPIOUT 0
#define REPK_EPIACT 0
#define REPK_EPIY 0
#ifndef REP_KLOOP
#define REP_KLOOP 0
#endif
#ifndef MK_PER_PHASE
#define MK_PER_PHASE 0
#endif

#ifndef CONTRIB_EVEN
#define CONTRIB_EVEN 1
#endif
#ifndef CONTRIB_ODD
#define CONTRIB_ODD 1
#endif
#ifndef CONTRIB_MOE
#define CONTRIB_MOE 1
#endif
#ifndef ABL_ATT0
#define ABL_ATT0 0
#endif
#ifndef ABL_RET0
#define ABL_RET0 0
#endif
#ifndef ABL_HGB0
#define ABL_HGB0 0
#endif
#ifndef RET_DIRECT
#define RET_DIRECT 0
#endif
#ifndef NAIVE_G1
#define NAIVE_G1 0
#endif
#ifndef NAIVE_G2
#define NAIVE_G2 0
#endif
#ifndef NAIVE_MOD
#define NAIVE_MOD 0
#endif
#ifndef NAIVE_MOE
#define NAIVE_MOE 0
#endif
#ifndef NAIVE_ATT
#define NAIVE_ATT 0
#endif
#ifndef NAIVE_HG
#define NAIVE_HG 0
#endif
#ifndef NAIVE_N2R
#define NAIVE_N2R 0
#endif
#ifndef NAIVE_COPY
#define NAIVE_COPY 0
#endif
#ifndef NAIVE_N1
#define NAIVE_N1 0
#endif
#ifndef NAIVE_FINAL
#define NAIVE_FINAL 0
#endif
#ifndef MUT_A
#define MUT_A 0
#endif
#ifndef MUT_B
#define MUT_B 0
#endif
#ifndef MUT_D
#define MUT_D 0
#endif
#ifndef REP_CONV
#define REP_CONV 0
#endif
#ifndef REP_HG
#define REP_HG 0
#endif
#ifndef REP_MIXE
#define REP_MIXE 0
#endif
#define LAS __attribute__((address_space(3)))
#define GAS __attribute__((address_space(1)))
typedef unsigned short bf16_t;
typedef short bf16x8 __attribute__((ext_vector_type(8)));
typedef float f32x4 __attribute__((ext_vector_type(4)));
typedef float f32x2 __attribute__((ext_vector_type(2)));
typedef unsigned u32x4 __attribute__((ext_vector_type(4)));
typedef unsigned u32x2 __attribute__((ext_vector_type(2)));

constexpr int NB = 4, LSEQ = 4096, DM = 1024, NCTX = 256, SU = NCTX + LSEQ  , MTOK = NB * SU  , DEPTH = 4;
constexpr int EV_N = 3072, OD_N = 5120, NEXP = 32, FF = 512;
constexpr int NCHUNK = SU / 128;
constexpr float EPS = 1e-6f;
constexpr int LIST_CAP = MTOK;
constexpr int MOE_MAXROWS = 43008;

constexpr size_t MiB = 1u << 20;
constexpr size_t WS_CTL = 0, CTL_ZERO_BYTES = 1 * MiB;
constexpr size_t WS_MOD = 1 * MiB;
constexpr size_t WS_LB = 1 * MiB + 512 * 1024;
constexpr size_t WS_ROPEC = WS_LB + 16384;
constexpr size_t WS_ROPES = WS_ROPEC + 8192;
constexpr size_t WS_W = 2 * MiB;
constexpr size_t WS_W_EVIN = WS_W;
constexpr size_t WS_W_EVOUT = WS_W + 12 * MiB;
constexpr size_t WS_W_ODIN = WS_W + 16 * MiB;
constexpr size_t WS_W_ODOUT = WS_W + 36 * MiB;
constexpr size_t WS_W_MOE = WS_W + 40 * MiB;
constexpr size_t WS_XRES = 426 * MiB;
constexpr size_t WS_HB = 494 * MiB;
constexpr size_t WS_YB16 = 528 * MiB;
constexpr size_t WS_R = 562 * MiB;
constexpr size_t WS_PE = WS_R;
constexpr size_t WS_ST = WS_R + 102 * MiB;
constexpr size_t WS_PQ = WS_R, WS_PI = WS_R + 34 * MiB, WS_PG = WS_R + 68 * MiB;
constexpr size_t WS_FF = WS_R + 102 * MiB, WS_FB = WS_R + 170 * MiB, WS_OF = WS_R + 238 * MiB, WS_OB = WS_R + 306 * MiB;
constexpr size_t WS_LIST = WS_R;
constexpr size_t WS_TOKINFO = WS_R + 5 * MiB;
constexpr size_t WS_ACT = WS_R + 6 * MiB;
constexpr size_t WS_YB = WS_R + 50 * MiB;
constexpr size_t WS_YN = WS_R + 140 * MiB;
constexpr size_t WS_END = 936 * MiB;
constexpr size_t WS_SP = 256 * 1024;
constexpr int SP_NORMW = 0, SP_FNORMW = 8192, SP_WG = 9216, SP_BG = 25600, SP_WE = 25616, SP_BE = 156688, SP_DECAY = 156816, SP_SINK = 156832, SP_HGNW = 156840, SP_END = 157096;
static_assert(WS_SP + (size_t)SP_END * 4 <= CTL_ZERO_BYTES, "small parameters fit in the control MiB");
constexpr int CW_BAR = 4096;
constexpr int CW_CNT = 8192;

constexpr int RING_BYTES = 150528;
constexpr int LDSCTL_OFF = RING_BYTES, MISC_OFF = LDSCTL_OFF + 320;
constexpr int LDS_BYTES = RING_BYTES + 4096;
constexpr int NWAVES = 8;

typedef __bf16 bf16v2_t __attribute__((ext_vector_type(2)));
__device__ __forceinline__ unsigned pk2(float lo, float hi) { const f32x2 v = {lo, hi}; const bf16v2_t r = __builtin_convertvector(v, bf16v2_t); return __builtin_bit_cast(unsigned, r); }
__device__ __forceinline__ unsigned f2bf(float f) { return pk2(f, f) & 0xffffu; }
__device__ __forceinline__ float bf2f(unsigned h) { return __builtin_bit_cast(float, h << 16); }
__device__ __forceinline__ float bflo(unsigned w) { return __builtin_bit_cast(float, w << 16); }
__device__ __forceinline__ float bfhi(unsigned w) { return __builtin_bit_cast(float, w & 0xffff0000u); }
__device__ __forceinline__ float shx(float v, int o, int lane) { return __builtin_bit_cast(float, __builtin_amdgcn_ds_bpermute((lane ^ o) << 2, __builtin_bit_cast(int, v))); }
__device__ __forceinline__ int shup_i(int v, int o, int lane) { return __builtin_amdgcn_ds_bpermute((lane - o) << 2, v); }
__device__ __forceinline__ int shidx_i(int v, int src) { return __builtin_amdgcn_ds_bpermute(src << 2, v); }
__device__ __forceinline__ float wave_sum(float v, int lane) {
#pragma unroll
    for (int o = 1; o < 64; o <<= 1) v += shx(v, o, lane);
    return v;
}
__device__ __forceinline__ float siluf(float x) { return x / (1.0f + __expf(-x)); }
#define LDS_WAIT() asm volatile("s_waitcnt lgkmcnt(0)" ::: "memory")
#define VM_WAIT() asm volatile("s_waitcnt vmcnt(0)" ::: "memory")

namespace pg8 {
constexpr int BM = 256, BK = 64, HALF = 128, HTB = HALF * BK * 2, STAGE_BYTES = 8 * HTB, NXCD = 8, WGM = 8;
__host__ __device__ __forceinline__ int lds_byte(int r, int c) { const int st = (r >> 4) * 2 + (c >> 5), rr = r & 15, cc = c & 31, ob = rr * 64 + cc * 2; return st * 1024 + (ob ^ (((ob >> 9) & 1) << 5)); }
__host__ __device__ __forceinline__ void stage_rc(int b, int& R, int& C) { const int st = b / 1024, sb = b % 1024, swz = sb ^ (((sb >> 9) & 1) << 5); R = (st >> 1) * 16 + swz / 64; C = (st & 1) * 32 + (swz % 64) / 2; }
__host__ __device__ __forceinline__ int perm32(int rho) { const int n = rho >> 4, i = rho & 15; return 8 * (i >> 2) + 4 * n + (i & 3); }

struct Unit { int pm, pn, e, cnt, tile; };

__device__ __forceinline__ int xcd_remap(int L, int nwg) { const int q = nwg / NXCD, r = nwg % NXCD, xcd = L % NXCD, off = L / NXCD; return (xcd < r ? xcd * (q + 1) : r * (q + 1) + (xcd - r) * q) + off; }

struct StaticOrder {
    int nM, nN, nwg, G, c, skipctx;
    __device__ void init(int M, int N, int G_, int c_, int skip_ = 0) { skipctx = skip_; nM = skip_ ? 64 : M / BM; nN = N / BM; nwg = nM * nN; G = G_; c = c_; }
    __device__ bool next(int i, Unit& u) const {
        const long L = (long)i * G + c; if (L >= nwg) return false;
        const int wgid = xcd_remap((int)L, nwg);
        const int nig = WGM * nN, gid = wgid / nig, fm = gid * WGM, gsz = (nM - fm) < WGM ? (nM - fm) : WGM;
        u.pm = fm + ((wgid % nig) % gsz); u.pn = (wgid % nig) / gsz; u.e = 0; u.cnt = 0; u.tile = 0;
        if (skipctx) u.pm = u.pm + u.pm / 16 + 1;
        return true;
    }
};
struct MoeOrder {
    const LAS int* tstart; const LAS int* cnts; int ntiles, G, c;
    __device__ bool next(int i, Unit& u) const {
        const int nwg = ntiles * 4; const long L = (long)i * G + c; if (L >= nwg) return false;
        const int wgid = xcd_remap((int)L, nwg);
        const int tile = wgid >> 2; u.pn = wgid & 3; u.tile = tile;
        int e = 0;
        for (int k = 1; k < NEXP; ++k) e += (tstart[k] <= tile) ? 1 : 0;
        u.e = e; u.pm = tile - tstart[e]; u.cnt = cnts[e]; return true;
    }
};

struct PlainAddr {
    static constexpr bool GATHER = false;
    const bf16_t* A; const bf16_t* Bt; int K;
    __device__ __forceinline__ void base(const Unit& u, const char*& cA, const char*& cB) const { cA = (const char*)(A + (size_t)u.pm * BM * K); cB = (const char*)(Bt + (size_t)u.pn * BM * K); }
    __device__ __forceinline__ void rows(const Unit&, const int (&)[2], const int (&)[2], unsigned (&)[2], unsigned (&)[2]) const {}
};
struct MoeGatherAddr {
    static constexpr bool GATHER = true;
    const bf16_t* HB; const bf16_t* Wbase; const unsigned* list; int K;
    __device__ __forceinline__ void base(const Unit& u, const char*& cA, const char*& cB) const { cA = (const char*)HB; cB = (const char*)Wbase + (size_t)u.e * (3u << 20) + (size_t)u.pn * BM * K * 2; }
    __device__ __forceinline__ void rows(const Unit& u, const int (&R)[2], const int (&C)[2], unsigned (&v0)[2], unsigned (&v1)[2]) const {
        const unsigned* lp = list + (size_t)u.e * LIST_CAP;
#pragma unroll
        for (int i = 0; i < 2; ++i) {
            int i0 = u.pm * BM + R[i], i1 = i0 + HALF; const int mx = u.cnt - 1; i0 = i0 < mx ? i0 : mx; i1 = i1 < mx ? i1 : mx;
            const unsigned t0 = __hip_atomic_load(lp + i0, __ATOMIC_RELAXED, __HIP_MEMORY_SCOPE_AGENT), t1 = __hip_atomic_load(lp + i1, __ATOMIC_RELAXED, __HIP_MEMORY_SCOPE_AGENT);
            v0[i] = (t0 * (unsigned)K + (unsigned)C[i]) * 2u; v1[i] = (t1 * (unsigned)K + (unsigned)C[i]) * 2u;
        }
    }
};
struct MoeActAddr {
    static constexpr bool GATHER = false;
    const bf16_t* Act; const bf16_t* Wbase; int K;
    __device__ __forceinline__ void base(const Unit& u, const char*& cA, const char*& cB) const { cA = (const char*)(Act + (size_t)u.tile * BM * K); cB = (const char*)Wbase + (size_t)u.e * (3u << 20) + (size_t)u.pn * BM * K * 2; }
    __device__ __forceinline__ void rows(const Unit&, const int (&)[2], const int (&)[2], unsigned (&)[2], unsigned (&)[2]) const {}
};

__device__ __forceinline__ unsigned cvt_pk_bf16(float lo, float hi) { unsigned r; asm volatile("v_cvt_pk_bf16_f32 %0, %1, %2" : "=v"(r) : "v"(lo), "v"(hi)); return r; }

template <class Epi, class Sched, class Addr>
__device__ __forceinline__ void gemm_phase(LAS unsigned char* lds, const Addr& AD, const Sched& S, const Epi& E, const int K) {
    int tid = threadIdx.x; asm volatile("" : "+v"(tid));
    const int wid = __builtin_amdgcn_readfirstlane(tid >> 6), lane = tid & 63, wr = wid >> 2, wc = wid & 3, fr = lane & 15, fq = lane >> 4;
    const int nt = K / BK;
    int sR[2], sC[2]; unsigned voffA[2], voffB[2];
#pragma unroll
    for (int i = 0; i < 2; ++i) { int R, C; stage_rc(tid * 16 + i * 8192, R, C); sR[i] = R; sC[i] = C; const int Rb = Epi::PERM ? ((R & ~31) + perm32(R & 31)) : R; voffA[i] = (unsigned)(R * K + C) * 2u; voffB[i] = (unsigned)(Rb * K + C) * 2u; }
    const size_t kstep = (size_t)(BK * 2);
    const size_t hstep = (size_t)HALF * K * 2;
    const unsigned ldsw = (unsigned)wid * 1024u;
    const int aoff = lds_byte(wr * 64 + fr, fq * 8), boff = lds_byte(wc * 32 + fr, fq * 8);
#define PG8_SA(b, h) (((b) * 2 + (h)) * HTB)
#define PG8_SB(b, h) ((4 + (b) * 2 + (h)) * HTB)
#define PG8_STAGE(bufoff, gbase, voff) do { _Pragma("unroll") for (int _i = 0; _i < 2; ++_i) \
        __builtin_amdgcn_global_load_lds((const unsigned*)((const char*)(gbase) + (voff)[_i]), (LAS unsigned*)(lds + (bufoff) + ldsw + _i * 8192), 16, 0, 0); } while (0)
#define PG8_LDA(dst, b, h) do { _Pragma("unroll") for (int m = 0; m < 4; ++m) _Pragma("unroll") for (int k = 0; k < 2; ++k) dst[m][k] = *(const LAS bf16x8*)(lds + PG8_SA(b, h) + aoff + m * 2048 + k * 1024); } while (0)
#define PG8_LDB(dst, b, h) do { _Pragma("unroll") for (int n = 0; n < 2; ++n) _Pragma("unroll") for (int k = 0; k < 2; ++k) dst[n][k] = *(const LAS bf16x8*)(lds + PG8_SB(b, h) + boff + n * 2048 + k * 1024); } while (0)
#define PG8_MMA(ai, bj, At, Bt) do { __builtin_amdgcn_s_setprio(1); _Pragma("unroll") for (int m = 0; m < 4; ++m) _Pragma("unroll") for (int n = 0; n < 2; ++n) _Pragma("unroll") for (int k = 0; k < 2; ++k) \
        acc[ai][bj][m][n] = __builtin_amdgcn_mfma_f32_16x16x32_bf16(Bt[n][k], At[m][k], acc[ai][bj][m][n], 0, 0, 0); __builtin_amdgcn_s_setprio(0); } while (0)
#define PG8_WAIT_V(n) asm volatile("s_waitcnt vmcnt(" #n ")" ::: "memory")
#define PG8_WAIT_L(n) asm volatile("s_waitcnt lgkmcnt(" #n ")" ::: "memory")
#define PG8_BAR __builtin_amdgcn_s_barrier()
#define PG8_SCHED __builtin_amdgcn_sched_barrier(0)
    Unit cur, nxt; int ui = 0;
    if (!S.next(0, cur)) return;
    f32x4 acc[2][2][4][2];
#pragma unroll
    for (int a = 0; a < 2; ++a)
#pragma unroll
        for (int b = 0; b < 2; ++b)
#pragma unroll
            for (int m = 0; m < 4; ++m)
#pragma unroll
                for (int n = 0; n < 2; ++n) acc[a][b][m][n] = (f32x4){0.f, 0.f, 0.f, 0.f};
    bf16x8 At[4][2], B0[2][2], B1[2][2];
    const char* cA; const char* cB; unsigned cv0[2] = {voffA[0], voffA[1]}, cv1[2] = {voffA[0], voffA[1]};
    AD.base(cur, cA, cB); AD.rows(cur, sR, sC, cv0, cv1);
    const size_t ah = Addr::GATHER ? (size_t)0 : hstep;
    PG8_STAGE(PG8_SB(0, 0), cB, voffB); PG8_STAGE(PG8_SB(0, 1), cB + hstep, voffB); PG8_STAGE(PG8_SA(0, 0), cA, cv0); PG8_STAGE(PG8_SA(0, 1), cA + ah, cv1);
    if (wr == 1) PG8_BAR;
    PG8_WAIT_V(2); PG8_BAR;
    PG8_STAGE(PG8_SB(1, 0), cB + kstep, voffB); PG8_STAGE(PG8_SA(1, 0), cA + kstep, cv0); PG8_STAGE(PG8_SB(1, 1), cB + hstep + kstep, voffB);
    PG8_WAIT_V(6); PG8_BAR;
    for (;;) {
        const bool has_next = S.next(ui + 1, nxt);
        const char* nA = cA; const char* nB = cB; unsigned nv0[2] = {cv0[0], cv0[1]}, nv1[2] = {cv1[0], cv1[1]};
        if (has_next) { AD.base(nxt, nA, nB); AD.rows(nxt, sR, sC, nv0, nv1); }
#if REP_KLOOP
        for (int rep_ = 0; rep_ <= Epi::REPK; ++rep_) {
        if (rep_ > 0) {
#pragma unroll
            for (int a = 0; a < 2; ++a)
#pragma unroll
                for (int b = 0; b < 2; ++b)
#pragma unroll
                    for (int m = 0; m < 4; ++m)
#pragma unroll
                        for (int n = 0; n < 2; ++n) acc[a][b][m][n] = (f32x4){0.f, 0.f, 0.f, 0.f};
        }
        const bool lastrep = rep_ == Epi::REPK;
#else
        { const bool lastrep = true;
#endif
        for (int t = 0; t < nt; t += 2) {
            const bool last = (t == nt - 2);
            const char* a1 = cA + (size_t)(t + 1) * kstep;
            const char* a2 = last ? (lastrep ? nA : cA) : cA + (size_t)(t + 2) * kstep; const char* b2 = last ? (lastrep ? nB : cB) : cB + (size_t)(t + 2) * kstep;
            const char* a3 = a2 + kstep; const char* b3 = b2 + kstep;
            unsigned x0[2] = {cv0[0], cv0[1]}, x1[2] = {cv1[0], cv1[1]};
            if constexpr (Addr::GATHER) { if (last && lastrep) { x0[0] = nv0[0]; x0[1] = nv0[1]; x1[0] = nv1[0]; x1[1] = nv1[1]; } }
            PG8_LDB(B0, 0, 0); PG8_LDB(B1, 0, 1); PG8_SCHED; PG8_LDA(At, 0, 0); PG8_STAGE(PG8_SA(1, 1), a1 + ah, cv1);
            PG8_WAIT_V(8); PG8_WAIT_L(0); PG8_BAR; PG8_MMA(0, 0, At, B0); PG8_MMA(0, 1, At, B1); PG8_BAR; PG8_SCHED;
            PG8_LDA(At, 0, 1); PG8_STAGE(PG8_SB(0, 0), b2, voffB); PG8_STAGE(PG8_SB(0, 1), b2 + hstep, voffB); PG8_STAGE(PG8_SA(0, 0), a2, x0);
            PG8_WAIT_V(8); PG8_WAIT_L(0); PG8_BAR; PG8_MMA(1, 0, At, B0); PG8_MMA(1, 1, At, B1); PG8_BAR; PG8_SCHED;
            PG8_LDB(B0, 1, 0); PG8_LDB(B1, 1, 1); PG8_SCHED; PG8_LDA(At, 1, 0); PG8_STAGE(PG8_SA(0, 1), a2 + ah, x1);
            PG8_WAIT_V(8); PG8_WAIT_L(0); PG8_BAR; PG8_MMA(0, 0, At, B0); PG8_MMA(0, 1, At, B1); PG8_BAR; PG8_SCHED;
            PG8_LDA(At, 1, 1); PG8_STAGE(PG8_SB(1, 0), b3, voffB); PG8_STAGE(PG8_SB(1, 1), b3 + hstep, voffB); PG8_STAGE(PG8_SA(1, 0), a3, x0);
            PG8_WAIT_V(8); PG8_WAIT_L(0); PG8_BAR; PG8_MMA(1, 0, At, B0); PG8_MMA(1, 1, At, B1); PG8_BAR; PG8_SCHED;
        }
        }
        if (wr == 0) PG8_BAR;
#if REP_KLOOP
        if constexpr (Epi::REPE > 0) { int nrep_ = 1 + Epi::REPE; asm volatile("" : "+s"(nrep_));
#pragma nounroll
          for (int rep_ = 0; rep_ < nrep_; ++rep_) E(acc, cur, wr, wc, fr, fq); }
        else E(acc, cur, wr, wc, fr, fq);
#else
        E(acc, cur, wr, wc, fr, fq);
#endif
        if (!has_next) break;
#pragma unroll
        for (int a = 0; a < 2; ++a)
#pragma unroll
            for (int b = 0; b < 2; ++b)
#pragma unroll
                for (int m = 0; m < 4; ++m)
#pragma unroll
                    for (int n = 0; n < 2; ++n) acc[a][b][m][n] = (f32x4){0.f, 0.f, 0.f, 0.f};
        cur = nxt; cA = nA; cB = nB; cv0[0] = nv0[0]; cv0[1] = nv0[1]; cv1[0] = nv1[0]; cv1[1] = nv1[1]; ++ui;
        if (wr == 1) PG8_BAR;
    }
    PG8_WAIT_V(0);
    PG8_BAR;
#undef PG8_SA
#undef PG8_SB
#undef PG8_STAGE
#undef PG8_LDA
#undef PG8_LDB
#undef PG8_MMA
#undef PG8_WAIT_V
#undef PG8_WAIT_L
#undef PG8_BAR
#undef PG8_SCHED
}
}

#define XB_TMO      128
#define XB_XCNT(j)  (256  + 64 * (j))
#define XB_XSUB(j)  (1280 + 64 * (j))
#define XB_XGEN(j)  (2304 + 64 * (j))
#define XB_TOP      3328
#define XB_TOPGEN   3392
#define XCD_BAR_WORDS 3456
#define XB_SPIN_CAP (1u << 20)
__device__ __forceinline__ unsigned xb_ld(unsigned* p)              { return __hip_atomic_load((GAS unsigned*)p, __ATOMIC_RELAXED, __HIP_MEMORY_SCOPE_AGENT); }
__device__ __forceinline__ unsigned xb_add(unsigned* p, unsigned v) { return __hip_atomic_fetch_add((GAS unsigned*)p, v, __ATOMIC_RELAXED, __HIP_MEMORY_SCOPE_AGENT); }
__device__ __forceinline__ unsigned xb_xcc_id() { return (unsigned)__builtin_amdgcn_s_getreg((3 << 11) | 20) & 0xFu; }
#define XB_SPIN(cond, bar) do { unsigned _sp = 0; while (cond) { __builtin_amdgcn_s_sleep(1); \
    if ((++_sp & 255u) == 0u) { if (xb_ld(&(bar)[XB_TMO])) break; if (_sp > XB_SPIN_CAP) { xb_add(&(bar)[XB_TMO], 1u); break; } } } } while (0)
struct XcdBarrier { unsigned* bar; unsigned x; volatile LAS unsigned* st; };
__device__ __forceinline__ XcdBarrier xcd_barrier_post(unsigned* bar, volatile LAS unsigned* st) {
    XcdBarrier b; b.bar = bar; b.x = xb_xcc_id(); b.st = st;
    if (threadIdx.x == 0) (void)xb_add(&bar[XB_XCNT(b.x)], 1u);
    return b;
}
__device__ __forceinline__ void xcd_barrier_complete(unsigned* bar, unsigned x, unsigned& nloc, unsigned& nx) {
    const unsigned G = gridDim.x * gridDim.y * gridDim.z;
    unsigned sum, cnt, mine, sp = 0u;
    for (;;) {
        sum = 0u; cnt = 0u; mine = 0u;
#pragma unroll
        for (unsigned j = 0; j < 16; ++j) { const unsigned c = xb_ld(&bar[XB_XCNT(j)]); sum += c; cnt += (c > 0u) ? 1u : 0u; }
        mine = xb_ld(&bar[XB_XCNT(x)]);
        if (sum == G) break;
        __builtin_amdgcn_s_sleep(1);
        if ((++sp & 255u) == 0u) { if (xb_ld(&bar[XB_TMO])) break; if (sp > XB_SPIN_CAP) { xb_add(&bar[XB_TMO], 1u); break; } }
    }
    nloc = mine > 0u ? mine : 1u; nx = cnt > 0u ? cnt : 1u;
}
__device__ __forceinline__ void xcd_barrier(const XcdBarrier& b) {
    asm volatile("s_waitcnt vmcnt(0)" ::: "memory");
    __syncthreads();
    if (threadIdx.x == 0) {
        unsigned* bar = b.bar; asm volatile("" : "+s"(bar));
        __builtin_amdgcn_s_waitcnt(0);
        unsigned nloc = b.st[0], nx = b.st[1];
        if (nloc == 0u) { xcd_barrier_complete(bar, b.x, nloc, nx); b.st[0] = nloc; b.st[1] = nx; }
        const unsigned old = xb_add(&bar[XB_XSUB(b.x)], 1u);
        const unsigned gen = old / nloc;
        if (old + 1u == (gen + 1u) * nloc) {
            __builtin_amdgcn_fence(__ATOMIC_RELEASE, "agent");
            asm volatile("s_waitcnt vmcnt(0)" ::: "memory");
            const unsigned og = xb_add(&bar[XB_TOP], 1u);
            const unsigned tg = og / nx;
            if (og + 1u == (tg + 1u) * nx) xb_add(&bar[XB_TOPGEN], 1u);
            else XB_SPIN(xb_ld(&bar[XB_TOPGEN]) == tg, bar);
            __builtin_amdgcn_fence(__ATOMIC_ACQUIRE, "agent");
            xb_add(&bar[XB_XGEN(b.x)], 1u);
            asm volatile("s_waitcnt vmcnt(0)" ::: "memory");
        } else {
            XB_SPIN(xb_ld(&bar[XB_XGEN(b.x)]) == gen, bar);
            __builtin_amdgcn_fence(__ATOMIC_ACQUIRE, "agent");
            asm volatile("s_waitcnt vmcnt(0)" ::: "memory");
        }
    }
    __syncthreads();
}

__device__ __forceinline__ int ftid() { int t = (int)threadIdx.x; asm volatile("" : "+v"(t)); return t; }
__device__ __forceinline__ int flane() { return ftid() & 63; }
__device__ __forceinline__ int fbid() { int b = (int)blockIdx.x; asm volatile("" : "+s"(b)); return b; }
struct Args { const float* in[23]; float* out; unsigned char* ws; int ph_lo, ph_hi; };
struct Frame {
    LAS unsigned char* lds;
    volatile LAS unsigned* MISC;
    unsigned* ctl;
    unsigned char* ws;
    int wave, vcu, G;
};
enum { I_X = 0, I_C, I_CTX, I_CCTX, I_ADAW, I_ADAB, I_NORMW, I_FNORMW, I_EVWIN, I_EVWOUT, I_RETDECAY, I_SINK, I_ODWIN, I_ODWOUT, I_LBLOG, I_HGNW,
       I_WG, I_BG, I_WE, I_BE, I_W1, I_W3, I_W2 };

__device__ __forceinline__ void conv_item(const float* srcp, int src_ld, bf16_t* WT, int K, int n0, int k0, LAS float* scr, int lane) {
#pragma unroll 8
    for (int i = 0; i < 32; ++i) { const int kk = 2 * i + (lane >> 5); scr[kk * 33 + (lane & 31)] = srcp[(size_t)(k0 + kk) * src_ld]; }
    LDS_WAIT(); asm volatile("" ::: "memory");
    const int c = lane & 7;
#pragma unroll
    for (int j = 0; j < 4; ++j) { const int n = (lane >> 3) + 8 * j; const LAS float* s = scr + (8 * c) * 33 + n;
        u32x4 o; o.x = pk2(s[0 * 33], s[1 * 33]); o.y = pk2(s[2 * 33], s[3 * 33]); o.z = pk2(s[4 * 33], s[5 * 33]); o.w = pk2(s[6 * 33], s[7 * 33]);
        *(u32x4*)(WT + (size_t)(n0 + n) * K + k0 + 8 * c) = o; }
    LDS_WAIT(); asm volatile("" ::: "memory");
}
__device__ __forceinline__ int head_perm(int n) { const int hh = n >> 7, phi = n & 127, g = phi >> 3, u = phi & 7; return hh * 128 + 64 * (g >> 3) + 4 * (g & 7) + (u & 3) + 32 * (u >> 2); }

constexpr int NI_W13 = 16 * 32, NI_W2 = 8 * 32, NI_MOE1 = NI_W13 + NI_W2, MOE_NI = NEXP * NI_MOE1;
#ifndef CONV_TAIL_WAVES
#define CONV_TAIL_WAVES 4
#endif
#ifndef MOE_G1_EVEN
#define MOE_G1_EVEN 7168
#endif
#ifndef MOE_G1_ODD
#define MOE_G1_ODD 6144
#endif
#ifndef MOE_G2_EVEN
#define MOE_G2_EVEN 10240
#endif
#ifndef MOE_G2_ODD
#define MOE_G2_ODD 10240
#endif
__host__ __device__ constexpr int moe_g1_hi(int l) { return (l & 1) ? MOE_G1_ODD : MOE_G1_EVEN; }
__host__ __device__ constexpr int moe_g2_hi(int l) { return l == DEPTH - 1 ? moe_g1_hi(l) : moe_g1_hi(l) + ((l & 1) ? MOE_G2_ODD : MOE_G2_EVEN); }
__host__ __device__ constexpr int moe_p0_cnt(int l) { return MOE_NI - moe_g2_hi(l); }
__device__ __forceinline__ void conv_moe_item(Frame& F, const Args& args, int l, int r, LAS float* scr, int lane) {
    const int le = l * NEXP + r / NI_MOE1; r %= NI_MOE1;
    bf16_t* dst = (bf16_t*)(F.ws + WS_W_MOE + (size_t)le * 3 * MiB);
    if (r < NI_W13) { const int kb = r / 32, nb = r % 32; const int n = nb * 32 + (lane & 31);
        const int Gq = n >> 3, u = n & 7; const float* src = (u < 4 ? args.in[I_W1] : args.in[I_W3]) + (size_t)le * DM * FF + 4 * Gq + (u & 3);
        conv_item(src, FF, dst, DM, nb * 32, kb * 64, scr, lane); }
    else { r -= NI_W13; const int kb = r / 32, nb = r % 32; const int n = nb * 32 + (lane & 31);
        conv_item(args.in[I_W2] + (size_t)le * FF * DM + n, DM, dst + (size_t)DM * DM, FF, nb * 32, kb * 64, scr, lane); }
}
__device__ __forceinline__ void conv_moe_tail(Frame& F, const Args& args, int l, int lo, int hi, int nwg) {
    const int r = nwg % F.G, c = fbid();
    if (c >= r) {
        __syncthreads();
        LAS float* scr = (LAS float*)(F.lds + F.wave * 16384); const int lane = flane();
        const int nslot = (F.G - r) * CONV_TAIL_WAVES;
        if (F.wave < CONV_TAIL_WAVES)
        for (int it = lo + (c - r) * CONV_TAIL_WAVES + F.wave; it < hi; it += nslot) conv_moe_item(F, args, l, it, scr, lane);
    }
}

__device__ __forceinline__ void p0_prologue(Frame& F, const Args& args) {
    LAS float* scr = (LAS float*)(F.lds + F.wave * 16384);
    const int gw = F.vcu * NWAVES + F.wave, NGW = F.G * NWAVES, lane = flane();
    constexpr int NI_EVIN = 16 * (EV_N / 32), NI_ODIN = 16 * (OD_N / 32), NI_OUT = 16 * 32;
    constexpr int NITEMS = 2 * NI_EVIN + 2 * NI_ODIN + 4 * NI_OUT + moe_p0_cnt(0) + moe_p0_cnt(1) + moe_p0_cnt(2) + moe_p0_cnt(3);
    for (int rep_ = 0; rep_ <= REP_CONV; ++rep_)
    for (int it = gw; it < NITEMS; it += NGW) {
        int r = it;
        if (r < 2 * NI_EVIN) { const int p = r / NI_EVIN; r %= NI_EVIN; const int nblk = EV_N / 32, kb = r / nblk, nb = r % nblk; const int n = nb * 32 + (lane & 31);
            conv_item(args.in[I_EVWIN] + (size_t)p * DM * EV_N + head_perm(n), EV_N, (bf16_t*)(F.ws + WS_W_EVIN + (size_t)p * 6 * MiB), DM, nb * 32, kb * 64, scr, lane); continue; }
        r -= 2 * NI_EVIN;
        if (r < 2 * NI_ODIN) { const int p = r / NI_ODIN; r %= NI_ODIN; const int nblk = OD_N / 32, kb = r / nblk, nb = r % nblk; const int n = nb * 32 + (lane & 31);
            conv_item(args.in[I_ODWIN] + (size_t)p * DM * OD_N + head_perm(n), OD_N, (bf16_t*)(F.ws + WS_W_ODIN + (size_t)p * 10 * MiB), DM, nb * 32, kb * 64, scr, lane); continue; }
        r -= 2 * NI_ODIN;
        if (r < 4 * NI_OUT) { const int q = r / NI_OUT; r %= NI_OUT; const int kb = r / 32, nb = r % 32; const int n = nb * 32 + (lane & 31);
            const float* src = (q < 2 ? args.in[I_EVWOUT] + (size_t)q * DM * DM : args.in[I_ODWOUT] + (size_t)(q - 2) * DM * DM);
            bf16_t* dst = (bf16_t*)(F.ws + (q < 2 ? WS_W_EVOUT + (size_t)q * 2 * MiB : WS_W_ODOUT + (size_t)(q - 2) * 2 * MiB));
            conv_item(src + n, DM, dst, DM, nb * 32, kb * 64, scr, lane); continue; }
        r -= 4 * NI_OUT;
        if (r < moe_p0_cnt(0)) { conv_moe_item(F, args, 0, moe_g2_hi(0) + r, scr, lane); continue; }
        r -= moe_p0_cnt(0);
        if (r < moe_p0_cnt(1)) { conv_moe_item(F, args, 1, moe_g2_hi(1) + r, scr, lane); continue; }
        r -= moe_p0_cnt(1);
        if (r < moe_p0_cnt(2)) { conv_moe_item(F, args, 2, moe_g2_hi(2) + r, scr, lane); continue; }
        r -= moe_p0_cnt(2);
        conv_moe_item(F, args, 3, moe_g2_hi(3) + r, scr, lane);
    }
    {
        f32x4* xr = (f32x4*)(F.ws + WS_XRES);
        const f32x4* xs = (const f32x4*)args.in[I_X]; const f32x4* cs = (const f32x4*)args.in[I_CTX];
        const size_t total = (size_t)MTOK * 256;
        for (size_t i = (size_t)fbid() * 512 + ftid(); i < total; i += (size_t)F.G * 512) {
            const int row = (int)(i >> 8), c4 = (int)(i & 255); const int b = row / SU, p = row % SU;
            xr[i] = (p < NCTX) ? cs[((size_t)(b * NCTX + p) << 8) + c4] : xs[((size_t)(b * LSEQ + p - NCTX) << 8) + c4];
        }
    }
    if (NAIVE_COPY) { float* xr2 = (float*)(F.ws + WS_XRES);
        for (size_t i = (size_t)fbid() * 512 + ftid(); i < (size_t)MTOK * DM; i += (size_t)F.G * 512) { const size_t row = i / DM; const int k = (int)(i % DM); const int b = (int)(row / SU), p = (int)(row % SU);
            xr2[i] = p < NCTX ? args.in[I_CTX][((size_t)b * NCTX + p) * DM + k] : args.in[I_X][((size_t)b * LSEQ + (p - NCTX)) * DM + k]; } }
    {
        float* sp = (float*)(F.ws + WS_SP);
        for (int i = fbid() * 512 + ftid(); i < SP_END; i += F.G * 512) {
            float v;
            if (i < SP_FNORMW) v = args.in[I_NORMW][i]; else if (i < SP_WG) v = args.in[I_FNORMW][i - SP_FNORMW]; else if (i < SP_BG) v = args.in[I_WG][i - SP_WG]; else if (i < SP_WE) v = args.in[I_BG][i - SP_BG];
            else if (i < SP_BE) v = args.in[I_WE][i - SP_WE]; else if (i < SP_DECAY) v = args.in[I_BE][i - SP_BE]; else if (i < SP_SINK) v = args.in[I_RETDECAY][i - SP_DECAY]; else if (i < SP_HGNW) v = args.in[I_SINK][i - SP_SINK]; else v = args.in[I_HGNW][i - SP_HGNW];
            sp[i] = v;
        }
    }
    if (blockIdx.x == 0) {
        float* lb = (float*)(F.ws + WS_LB); const float* lg = args.in[I_LBLOG];
        for (int c = ftid(); c < DM; c += 512) {
            const float a0 = lg[c], a1 = lg[DM + c], a2 = lg[2 * DM + c], a3 = lg[3 * DM + c];
            const float mx = fmaxf(fmaxf(a0, a1), fmaxf(a2, a3));
            const float e0 = expf(a0 - mx), e1 = expf(a1 - mx), e2 = expf(a2 - mx), e3 = expf(a3 - mx); const float inv = 1.0f / (e0 + e1 + e2 + e3);
            lb[c] = 0.f; lb[DM + c] = e1 * inv; lb[2 * DM + c] = (e1 + e2) * inv; lb[3 * DM + c] = (e1 + e2 + e3) * inv;
        }
    }
    if (blockIdx.x == 1) {
        float* rc = (float*)(F.ws + WS_ROPEC); float* rs = (float*)(F.ws + WS_ROPES);
        for (int i = ftid(); i < 64 * 32; i += 512) { const int pos = i >> 5, fi = i & 31;
            const float invf = powf(10000.0f, -(float)(2 * fi) / 64.0f); const float ang = (float)pos * invf;
            rc[i] = cosf(ang); rs[i] = sinf(ang); }
    }
    {
        __syncthreads();
        LAS float* sv = (LAS float*)F.lds;
        LAS float* part = (LAS float*)(F.lds + 20480);
        for (int i = ftid(); i < 5 * DM; i += 512) { const int r = i >> 10, k = i & 1023; const float v = (r < 4) ? args.in[I_C][r * DM + k] : args.in[I_CCTX][k]; sv[i] = siluf(v); }
        __syncthreads();
        float* mod = (float*)(F.ws + WS_MOD);
        for (int it = fbid(); it < DEPTH * 96; it += F.G) {
            const int l = it / 96, cg = it % 96; const int col = cg * 64 + lane;
            const float* w = args.in[I_ADAW] + (size_t)l * DM * 6144 + col;
            float a[5] = {0.f, 0.f, 0.f, 0.f, 0.f};
            const int k0 = F.wave * 128;
#pragma unroll 8
            for (int k = 0; k < 128; ++k) { const float wv = w[(size_t)(k0 + k) * 6144];
#pragma unroll
                for (int r = 0; r < 5; ++r) a[r] += sv[r * DM + k0 + k] * wv; }
#pragma unroll
            for (int r = 0; r < 5; ++r) part[(F.wave * 5 + r) * 64 + lane] = a[r];
            __syncthreads();
            if (ftid() < 320) { const int r = ftid() >> 6, c = ftid() & 63; float s = 0.f;
#pragma unroll
                for (int w8 = 0; w8 < 8; ++w8) s += part[(w8 * 5 + r) * 64 + c];
                mod[((size_t)l * 5 + r) * 6144 + cg * 64 + c] = s + args.in[I_ADAB][l * 6144 + cg * 64 + c]; }
            __syncthreads();
        }
    }
}

__device__ __forceinline__ int moe_tile_prefix(const unsigned* cnt, int lane, int& mycnt) {
    const int c = (lane < NEXP) ? (int)__hip_atomic_load(cnt + lane, __ATOMIC_RELAXED, __HIP_MEMORY_SCOPE_AGENT) : 0; mycnt = c;
    const int nt = (c + 255) >> 8; int incl = nt;
#pragma unroll
    for (int o = 1; o < 64; o <<= 1) { const int v = shup_i(incl, o, lane); if (lane >= o) incl += v; }
    return incl - nt;
}

template <bool FINAL>
__device__ __forceinline__ void n1_phase(Frame& F, const Args& args, int l) {
    const int gw = (MUT_A ? fbid() : F.vcu) * NWAVES + F.wave, NGW = F.G * NWAVES, lane = flane();
    float* xres = (float*)(F.ws + WS_XRES);
    const float* mod = (const float*)(F.ws + WS_MOD);
    int tprefix = 0, dummy;
    if (l > 0) tprefix = moe_tile_prefix(F.ctl + CW_CNT + (l - 1) * NEXP, lane, dummy);
    for (int rr_ = 0; rr_ < (MUT_D ? 64 : 9); ++rr_) {
        const int row = MUT_D ? (fbid() * 512 + F.wave * 64 + rr_) : (gw + rr_ * NGW); if (row >= MTOK) continue;
        const int b = row / SU, p = row % SU; const int mrow = (p < NCTX) ? 4 : b;
        if (FINAL && p < NCTX) continue;
        f32x4* xr = (f32x4*)(xres + (size_t)row * DM) + lane;
        f32x4 v[4];
#pragma unroll
        for (int j = 0; j < 4; ++j) v[j] = xr[64 * j];
        if (l > 0 && CONTRIB_MOE) {
            {
                unsigned* tiw = (unsigned*)(F.ws + WS_TOKINFO) + (size_t)row * 8;
                u32x4 t0, t1;
                t0.x = __hip_atomic_load(tiw + 0, __ATOMIC_RELAXED, __HIP_MEMORY_SCOPE_AGENT); t0.y = __hip_atomic_load(tiw + 1, __ATOMIC_RELAXED, __HIP_MEMORY_SCOPE_AGENT);
                t0.z = __hip_atomic_load(tiw + 2, __ATOMIC_RELAXED, __HIP_MEMORY_SCOPE_AGENT); t0.w = __hip_atomic_load(tiw + 3, __ATOMIC_RELAXED, __HIP_MEMORY_SCOPE_AGENT);
                t1.x = __hip_atomic_load(tiw + 4, __ATOMIC_RELAXED, __HIP_MEMORY_SCOPE_AGENT); t1.y = __hip_atomic_load(tiw + 5, __ATOMIC_RELAXED, __HIP_MEMORY_SCOPE_AGENT); t1.z = 0u; t1.w = 0u;
                const int ts0 = shidx_i(tprefix, (int)t0.x), ts1 = shidx_i(tprefix, (int)t0.z);
                const size_t s0 = (size_t)ts0 * 256 + t0.y, s1 = (size_t)ts1 * 256 + t0.w;
                const unsigned gb0 = t1.x, gb1 = t1.y;
                const float g0 = __builtin_bit_cast(float, gb0), g1 = __builtin_bit_cast(float, gb1);
                const u32x2* y0 = (const u32x2*)(F.ws + WS_YB + s0 * (DM * 2)) + lane; const u32x2* y1 = (const u32x2*)(F.ws + WS_YB + s1 * (DM * 2)) + lane;
                const f32x4* gp = (const f32x4*)(mod + ((size_t)(l - 1) * 5 + mrow) * 6144 + 5 * DM) + lane;
                if (NAIVE_MOE) {
                    const f32x4* n0 = (const f32x4*)(F.ws + WS_YN + (size_t)row * 2 * DM * 4) + lane; const f32x4* n1 = n0 + 256;
#pragma unroll
                    for (int j = 0; j < 4; ++j) { const f32x4 g = gp[64 * j]; v[j] = v[j] + g * (n0[64 * j] * g0 + n1[64 * j] * g1); }
                } else {
                if (MUT_B) {
                    const bf16_t* yy0 = (const bf16_t*)(F.ws + WS_YB) + s0 * DM; const bf16_t* yy1 = (const bf16_t*)(F.ws + WS_YB) + s1 * DM;
                    const float* gate = mod + ((size_t)(l - 1) * 5 + mrow) * 6144 + 5 * DM;
#pragma unroll
                    for (int j = 0; j < 4; ++j) { const int k = 4 * lane + 256 * j;
                        v[j].x += gate[k] * (g0 * bf2f(yy0[k]) + g1 * bf2f(yy1[k])); v[j].y += gate[k + 1] * (g0 * bf2f(yy0[k + 1]) + g1 * bf2f(yy1[k + 1]));
                        v[j].z += gate[k + 2] * (g0 * bf2f(yy0[k + 2]) + g1 * bf2f(yy1[k + 2])); v[j].w += gate[k + 3] * (g0 * bf2f(yy0[k + 3]) + g1 * bf2f(yy1[k + 3])); }
                } else {
#pragma unroll
                for (int j = 0; j < 4; ++j) { const u32x2 a = y0[64 * j], c = y1[64 * j]; const f32x4 g = gp[64 * j];
                    v[j].x += g.x * (g0 * bflo(a.x) + g1 * bflo(c.x)); v[j].y += g.y * (g0 * bfhi(a.x) + g1 * bfhi(c.x));
                    v[j].z += g.z * (g0 * bflo(a.y) + g1 * bflo(c.y)); v[j].w += g.w * (g0 * bfhi(a.y) + g1 * bfhi(c.y)); }
                }
                }
                if (!FINAL) {
#pragma unroll
                    for (int j = 0; j < 4; ++j) xr[64 * j] = v[j];
                }
            }
        }
        float s = 0.f;
#pragma unroll
        for (int j = 0; j < 4; ++j) s += (v[j].x * v[j].x + v[j].y * v[j].y) + (v[j].z * v[j].z + v[j].w * v[j].w);
        const float rstd = 1.0f / sqrtf(wave_sum(s, lane) * (1.0f / DM) + EPS);
        if (FINAL) {
            const f32x4* nw = (const f32x4*)((const float*)(F.ws + WS_SP) + SP_FNORMW) + lane;
            f32x4* o = (f32x4*)(args.out + ((size_t)b * LSEQ + (p - NCTX)) * DM) + lane;
#pragma unroll
            for (int j = 0; j < 4; ++j) { const f32x4 w = nw[64 * j]; o[64 * j] = v[j] * rstd * w; }
        } else {
            const f32x4* nw = (const f32x4*)(((const float*)(F.ws + WS_SP) + SP_NORMW) + (size_t)(l * 2 + 0) * DM) + lane;
            const f32x4* sh = (const f32x4*)(mod + ((size_t)l * 5 + mrow) * 6144 + 0 * DM) + lane;
            const f32x4* sc = (const f32x4*)(mod + ((size_t)l * 5 + mrow) * 6144 + 1 * DM) + lane;
            u32x2* o = (u32x2*)(F.ws + WS_HB + (size_t)row * (DM * 2)) + lane;
#pragma unroll
            for (int j = 0; j < 4; ++j) { const f32x4 w = nw[64 * j], a = sh[64 * j], c = sc[64 * j]; const f32x4 h = v[j] * rstd * w * (c + 1.0f) + a;
                u32x2 q; q.x = pk2(h.x, h.y); q.y = pk2(h.z, h.w); o[64 * j] = q; }
        }
    }
}

__device__ __forceinline__ void naive_n1(Frame& F, const Args& args, int l, bool final_) {
    float* xres = (float*)(F.ws + WS_XRES);
    const float* mod = (const float*)(F.ws + WS_MOD);
    for (int row = fbid() * 512 + ftid(); row < MTOK; row += F.G * 512) {
        const int b = row / SU, p = row % SU; const int mrow = (p < NCTX) ? 4 : b;
        if (final_ && p < NCTX) continue;
        float* xr = xres + (size_t)row * DM;
        if (l > 0) {
            const unsigned* cnt = F.ctl + CW_CNT + (l - 1) * NEXP;
            const unsigned* ti = (const unsigned*)(F.ws + WS_TOKINFO) + (size_t)row * 8;
            const unsigned e0 = ti[0], p0 = ti[1], e1 = ti[2], p1 = ti[3]; const float g0 = __builtin_bit_cast(float, ti[4]), g1 = __builtin_bit_cast(float, ti[5]);
            int ts0 = 0, ts1 = 0; for (unsigned e = 0; e < e0; ++e) ts0 += ((int)cnt[e] + 255) / 256; for (unsigned e = 0; e < e1; ++e) ts1 += ((int)cnt[e] + 255) / 256;
            const bf16_t* y0 = (const bf16_t*)(F.ws + WS_YB) + ((size_t)ts0 * 256 + p0) * DM; const bf16_t* y1 = (const bf16_t*)(F.ws + WS_YB) + ((size_t)ts1 * 256 + p1) * DM;
            const float* gate = mod + ((size_t)(l - 1) * 5 + mrow) * 6144 + 5 * DM;
            for (int k = 0; k < DM; ++k) xr[k] = xr[k] + gate[k] * (g0 * bf2f(y0[k]) + g1 * bf2f(y1[k]));
        }
        double ss = 0.0; for (int k = 0; k < DM; ++k) ss += (double)xr[k] * xr[k];
        const float rstd = 1.0f / sqrtf((float)(ss / DM) + EPS);
        if (final_) { float* o = args.out + ((size_t)b * LSEQ + (p - NCTX)) * DM; for (int k = 0; k < DM; ++k) o[k] = xr[k] * rstd * args.in[I_FNORMW][k]; }
        else { bf16_t* hb = (bf16_t*)(F.ws + WS_HB) + (size_t)row * DM; const float* nw = args.in[I_NORMW] + (size_t)(l * 2) * DM; const float* mr = mod + ((size_t)l * 5 + mrow) * 6144;
            for (int k = 0; k < DM; ++k) hb[k] = (bf16_t)f2bf(xr[k] * rstd * nw[k] * (1.0f + mr[DM + k]) + mr[k]); }
    }
}
__device__ __forceinline__ void wave_n1(Frame& F, const Args& args, int l, bool final_) {
    float* xres = (float*)(F.ws + WS_XRES);
    const float* mod = (const float*)(F.ws + WS_MOD);
    const int gw = F.vcu * NWAVES + F.wave, NGW = F.G * NWAVES, lane = flane();
    for (int row = gw; row < MTOK; row += NGW) {
        const int b = row / SU, p = row % SU; const int mrow = (p < NCTX) ? 4 : b;
        if (final_ && p < NCTX) continue;
        float* xr = xres + (size_t)row * DM;
        float xv[16];
#pragma unroll
        for (int i = 0; i < 16; ++i) xv[i] = xr[lane + 64 * i];
        if (l > 0) {
            const unsigned* cnt = F.ctl + CW_CNT + (l - 1) * NEXP;
            const unsigned* ti = (const unsigned*)(F.ws + WS_TOKINFO) + (size_t)row * 8;
            const unsigned e0 = ti[0], p0 = ti[1], e1 = ti[2], p1 = ti[3]; const float g0 = __builtin_bit_cast(float, ti[4]), g1 = __builtin_bit_cast(float, ti[5]);
            int ts0 = 0, ts1 = 0; for (unsigned e = 0; e < e0; ++e) ts0 += ((int)cnt[e] + 255) / 256; for (unsigned e = 0; e < e1; ++e) ts1 += ((int)cnt[e] + 255) / 256;
            const bf16_t* y0 = (const bf16_t*)(F.ws + WS_YB) + ((size_t)ts0 * 256 + p0) * DM; const bf16_t* y1 = (const bf16_t*)(F.ws + WS_YB) + ((size_t)ts1 * 256 + p1) * DM;
            const float* gate = mod + ((size_t)(l - 1) * 5 + mrow) * 6144 + 5 * DM;
#pragma unroll
            for (int i = 0; i < 16; ++i) { const int k = lane + 64 * i; xv[i] = xv[i] + gate[k] * (g0 * bf2f(y0[k]) + g1 * bf2f(y1[k])); if (!final_) xr[k] = xv[i]; }
        }
        float ss = 0.f;
#pragma unroll
        for (int i = 0; i < 16; ++i) ss += xv[i] * xv[i];
        const float rstd = 1.0f / sqrtf(wave_sum(ss, lane) * (1.0f / DM) + EPS);
        if (final_) { float* o = args.out + ((size_t)b * LSEQ + (p - NCTX)) * DM;
#pragma unroll
            for (int i = 0; i < 16; ++i) { const int k = lane + 64 * i; o[k] = xv[i] * rstd * args.in[I_FNORMW][k]; } }
        else { bf16_t* hb = (bf16_t*)(F.ws + WS_HB) + (size_t)row * DM; const float* nw = args.in[I_NORMW] + (size_t)(l * 2) * DM; const float* mr = mod + ((size_t)l * 5 + mrow) * 6144;
#pragma unroll
            for (int i = 0; i < 16; ++i) { const int k = lane + 64 * i; hb[k] = (bf16_t)f2bf(xv[i] * rstd * nw[k] * (1.0f + mr[DM + k]) + mr[k]); } }
    }
}
__device__ __forceinline__ void n2r_phase(Frame& F, const Args& args, int l) {
    const int gw = F.vcu * NWAVES + F.wave, NGW = F.G * NWAVES, lane = flane();
    const float* xres = (const float*)(F.ws + WS_XRES);
    const float* mod = (const float*)(F.ws + WS_MOD);
    unsigned* cnt = F.ctl + CW_CNT + l * NEXP;
    unsigned* list = (unsigned*)(F.ws + WS_LIST);
    const float* wg = ((const float*)(F.ws + WS_SP) + SP_WG) + (size_t)l * DM * 4; const float* bg = ((const float*)(F.ws + WS_SP) + SP_BG) + l * 4;
    const float* we = ((const float*)(F.ws + WS_SP) + SP_WE) + (size_t)l * 4 * DM * 8; const float* be = ((const float*)(F.ws + WS_SP) + SP_BE) + l * 32;
    LAS float* wgT = (LAS float*)F.lds; LAS float* weT = wgT + 4 * DM;
    LAS unsigned* hist = (LAS unsigned*)(F.lds + LDSCTL_OFF + 1024); LAS unsigned* baseL = hist + 32; LAS unsigned* rec = hist + 64 + F.wave * 36;
    __syncthreads();
    if (ftid() < 32) hist[ftid()] = 0u;
    {   const int t = ftid();
        for (int r = t; r < DM; r += 512) { const f32x4 a = *(const f32x4*)(wg + (size_t)r * 4); wgT[r] = a.x; wgT[DM + r] = a.y; wgT[2 * DM + r] = a.z; wgT[3 * DM + r] = a.w; }
        for (int r = t; r < 4 * DM; r += 512) { const int g = r >> 10, c = r & 1023; const f32x4 a = *(const f32x4*)(we + (size_t)r * 8), b2 = *(const f32x4*)(we + (size_t)r * 8 + 4);
            LAS float* d = weT + g * 8 * DM + c; d[0] = a.x; d[DM] = a.y; d[2 * DM] = a.z; d[3 * DM] = a.w; d[4 * DM] = b2.x; d[5 * DM] = b2.y; d[6 * DM] = b2.z; d[7 * DM] = b2.w; }
    }
    __syncthreads();
    for (int k_ = 0; k_ < 9; ++k_) {
        const int row = gw + k_ * NGW; if (row >= MTOK) break;
        const int b = row / SU, p = row % SU; const int mrow = (p < NCTX) ? 4 : b;
        if (l == DEPTH - 1 && p < NCTX) continue;
        const f32x4* xr = (const f32x4*)(xres + (size_t)row * DM) + lane;
        f32x4 v[4]; float s = 0.f;
#pragma unroll
        for (int j = 0; j < 4; ++j) { v[j] = xr[64 * j]; s += (v[j].x * v[j].x + v[j].y * v[j].y) + (v[j].z * v[j].z + v[j].w * v[j].w); }
        const float rstd = 1.0f / sqrtf(wave_sum(s, lane) * (1.0f / DM) + EPS);
        const f32x4* nw = (const f32x4*)(((const float*)(F.ws + WS_SP) + SP_NORMW) + (size_t)(l * 2 + 1) * DM) + lane;
        const f32x4* sh = (const f32x4*)(mod + ((size_t)l * 5 + mrow) * 6144 + 3 * DM) + lane;
        const f32x4* sc = (const f32x4*)(mod + ((size_t)l * 5 + mrow) * 6144 + 4 * DM) + lane;
        u32x2* o = (u32x2*)(F.ws + WS_HB + (size_t)row * (DM * 2)) + lane;
        float gl[4] = {0.f, 0.f, 0.f, 0.f};
#pragma unroll
        for (int j = 0; j < 4; ++j) { const f32x4 w = nw[64 * j], a = sh[64 * j], c = sc[64 * j]; const f32x4 h = v[j] * rstd * w * (c + 1.0f) + a; v[j] = h;
            u32x2 q; q.x = pk2(h.x, h.y); q.y = pk2(h.z, h.w); o[64 * j] = q;
#pragma unroll
            for (int g = 0; g < 4; ++g) { const f32x4 wv = *(const LAS f32x4*)(wgT + g * DM + 4 * lane + 256 * j); gl[g] += (h.x * wv.x + h.y * wv.y) + (h.z * wv.z + h.w * wv.w); } }
#pragma unroll
        for (int g = 0; g < 4; ++g) gl[g] = wave_sum(gl[g], lane) + bg[g];
        int gi = 0; float gm = gl[0];
#pragma unroll
        for (int g = 1; g < 4; ++g) if (gl[g] > gm) { gm = gl[g]; gi = g; }
        const float gp = 1.0f / (expf(gl[0] - gm) + expf(gl[1] - gm) + expf(gl[2] - gm) + expf(gl[3] - gm));
        const LAS float* weg = weT + gi * 8 * DM;
        float el[8] = {0.f, 0.f, 0.f, 0.f, 0.f, 0.f, 0.f, 0.f};
#pragma unroll
        for (int j = 0; j < 4; ++j) {
#pragma unroll
            for (int e = 0; e < 8; ++e) { const f32x4 wv = *(const LAS f32x4*)(weg + e * DM + 4 * lane + 256 * j); el[e] += (v[j].x * wv.x + v[j].y * wv.y) + (v[j].z * wv.z + v[j].w * wv.w); }
        }
#pragma unroll
        for (int e = 0; e < 8; ++e) el[e] = wave_sum(el[e], lane) + be[gi * 8 + e];
        int i0 = 0; float v0 = el[0];
#pragma unroll
        for (int e = 1; e < 8; ++e) if (el[e] > v0) { v0 = el[e]; i0 = e; }
        int i1 = -1; float v1 = -3.0e38f;
#pragma unroll
        for (int e = 0; e < 8; ++e) if (e != i0 && el[e] > v1) { v1 = el[e]; i1 = e; }
        const float w0 = 1.0f / (1.0f + expf(v1 - v0)), w1 = 1.0f - w0;
        if (lane == 0) {
            const unsigned e0 = (unsigned)(gi * 8 + i0), e1 = (unsigned)(gi * 8 + i1);
            const unsigned lp0 = __hip_atomic_fetch_add(hist + e0, 1u, __ATOMIC_RELAXED, __HIP_MEMORY_SCOPE_WORKGROUP), lp1 = __hip_atomic_fetch_add(hist + e1, 1u, __ATOMIC_RELAXED, __HIP_MEMORY_SCOPE_WORKGROUP);
            rec[k_ * 4 + 0] = e0; rec[k_ * 4 + 1] = lp0; rec[k_ * 4 + 2] = e1; rec[k_ * 4 + 3] = lp1;
            u32x4* ti = (u32x4*)(F.ws + WS_TOKINFO) + (size_t)row * 2;
            ti[1] = (u32x4){__builtin_bit_cast(unsigned, gp * w0), __builtin_bit_cast(unsigned, gp * w1), 0u, 0u};
        }
    }
    __syncthreads();
    if (ftid() < 32) { const unsigned hc = hist[ftid()]; baseL[ftid()] = hc ? atomicAdd(cnt + ftid(), hc) : 0u; }
    __syncthreads();
    if (lane == 0) {
        for (int k_ = 0; k_ < 9; ++k_) {
            const int row = gw + k_ * NGW; if (row >= MTOK) break;
            if (l == DEPTH - 1 && (row % SU) < NCTX) continue;
            const unsigned e0 = rec[k_ * 4 + 0], e1 = rec[k_ * 4 + 2]; const unsigned p0 = baseL[e0] + rec[k_ * 4 + 1], p1 = baseL[e1] + rec[k_ * 4 + 3];
            list[(size_t)e0 * LIST_CAP + p0] = (unsigned)row; list[(size_t)e1 * LIST_CAP + p1] = (unsigned)row;
            u32x4* ti = (u32x4*)(F.ws + WS_TOKINFO) + (size_t)row * 2;
            ti[0] = (u32x4){e0, p0, e1, p1};
        }
    }
    __syncthreads();
}

__device__ __forceinline__ void naive_n2r(Frame& F, const Args& args, int l) {
    const float* xres = (const float*)(F.ws + WS_XRES);
    const float* mod = (const float*)(F.ws + WS_MOD);
    unsigned* cnt = F.ctl + CW_CNT + l * NEXP;
    unsigned* list = (unsigned*)(F.ws + WS_LIST);
    const float* wg = args.in[I_WG] + (size_t)l * DM * 4; const float* bg = args.in[I_BG] + l * 4;
    const float* we = args.in[I_WE] + (size_t)l * 4 * DM * 8; const float* be = args.in[I_BE] + l * 32;
    for (int row = fbid() * 512 + ftid(); row < MTOK; row += F.G * 512) {
        const int b = row / SU, p = row % SU; const int mrow = (p < NCTX) ? 4 : b;
        if (l == DEPTH - 1 && p < NCTX) continue;
        const float* xr = xres + (size_t)row * DM; double ss = 0.0;
        for (int k = 0; k < DM; ++k) ss += (double)xr[k] * xr[k];
        const float rstd = 1.0f / sqrtf((float)(ss / DM) + EPS);
        const float* nw = args.in[I_NORMW] + (size_t)(l * 2 + 1) * DM; const float* mr = mod + ((size_t)l * 5 + mrow) * 6144;
        bf16_t* hb = (bf16_t*)(F.ws + WS_HB) + (size_t)row * DM;
        float gl[4] = {bg[0], bg[1], bg[2], bg[3]};
        for (int k = 0; k < DM; ++k) { const float h = xr[k] * rstd * nw[k] * (1.0f + mr[4 * DM + k]) + mr[3 * DM + k]; hb[k] = (bf16_t)f2bf(h);
            gl[0] += h * wg[k * 4 + 0]; gl[1] += h * wg[k * 4 + 1]; gl[2] += h * wg[k * 4 + 2]; gl[3] += h * wg[k * 4 + 3]; }
        int gi = 0; for (int g = 1; g < 4; ++g) if (gl[g] > gl[gi]) gi = g;
        float den = 0.f; for (int g = 0; g < 4; ++g) den += expf(gl[g] - gl[gi]);
        const float gp = 1.0f / den;
        float el[8]; for (int e = 0; e < 8; ++e) el[e] = be[gi * 8 + e];
        for (int k = 0; k < DM; ++k) { const float h = xr[k] * rstd * nw[k] * (1.0f + mr[4 * DM + k]) + mr[3 * DM + k]; const float* wr = we + ((size_t)gi * DM + k) * 8;
#pragma unroll
            for (int e = 0; e < 8; ++e) el[e] += h * wr[e]; }
        int i0 = 0; for (int e = 1; e < 8; ++e) if (el[e] > el[i0]) i0 = e;
        int i1 = (i0 == 0) ? 1 : 0; for (int e = 0; e < 8; ++e) if (e != i0 && el[e] > el[i1]) i1 = e;
        const float m2 = el[i0]; const float a0 = 1.0f, a1 = expf(el[i1] - m2); const float w0 = a0 / (a0 + a1), w1 = a1 / (a0 + a1);
        const unsigned e0 = (unsigned)(gi * 8 + i0), e1 = (unsigned)(gi * 8 + i1);
        const unsigned p0 = atomicAdd(cnt + e0, 1u), p1 = atomicAdd(cnt + e1, 1u);
        list[(size_t)e0 * LIST_CAP + p0] = (unsigned)row; list[(size_t)e1 * LIST_CAP + p1] = (unsigned)row;
        u32x4* ti = (u32x4*)(F.ws + WS_TOKINFO) + (size_t)row * 2;
        ti[0] = (u32x4){e0, p0, e1, p1}; ti[1] = (u32x4){__builtin_bit_cast(unsigned, gp * w0), __builtin_bit_cast(unsigned, gp * w1), 0u, 0u};
    }
}

struct EpiProj {
    static constexpr bool PERM = true; static constexpr int REPK = REPK_EPIPROJ, REPE = REPE_EPIPROJ;
    unsigned char* ws; const float* lb; int odd;
    __device__ __forceinline__ void operator()(const f32x4 (&acc)[2][2][4][2], const pg8::Unit& u, int wr, int wc, int fr, int fq) const {
        const int pmb = u.pm % 17; const bool isctx = (pmb == 0); const int tbase = (pmb - 1) * 256;
        const int g = 4 * wc + fq, half = g >> 3, f0 = 4 * (g & 7);
        const float* ropec = (const float*)(ws + WS_ROPEC); const float* ropes = (const float*)(ws + WS_ROPES);
#pragma unroll
        for (int bj = 0; bj < 2; ++bj) {
            const int hcol = 256 * u.pn + 128 * bj; const int lc0 = hcol + 64 * half + f0;
            if (!odd) {
                const bool rope = !isctx && (hcol < 1024 || (hcol >= 2048 && hcol < 2816));
                const float scale = (hcol >= 512 && hcol < 1024) ? 0.08838834764831845f : 1.0f;
                bf16_t* dst = (bf16_t*)(ws + WS_PE);
#pragma unroll
                for (int ai = 0; ai < 2; ++ai)
#pragma unroll
                    for (int m = 0; m < 4; ++m) {
                        const int rr = 128 * ai + 64 * wr + 16 * m + fr; const size_t row = (size_t)u.pm * 256 + rr;
                        f32x4 x1 = acc[ai][bj][m][0] * scale, x2 = acc[ai][bj][m][1] * scale;
                        if (rope) { const int t = tbase + rr; const int pos = half ? (t & 63) : (t >> 6);
                            const f32x4 c = *(const f32x4*)(ropec + pos * 32 + f0), s = *(const f32x4*)(ropes + pos * 32 + f0);
                            const f32x4 o1 = x1 * c - x2 * s, o2 = x2 * c + x1 * s; x1 = o1; x2 = o2; }
                        u32x2 q1, q2; q1.x = pk2(x1.x, x1.y); q1.y = pk2(x1.z, x1.w); q2.x = pk2(x2.x, x2.y); q2.y = pk2(x2.z, x2.w);
                        *(u32x2*)(dst + row * EV_N + lc0) = q1; *(u32x2*)(dst + row * EV_N + lc0 + 32) = q2;
                    }
            } else {
                const int seg = hcol >> 10, c0 = lc0 & 1023;
                if (seg == 1 || seg == 2) {
                    float* dst = (float*)(ws + (seg == 1 ? WS_FF : WS_FB));
                    const f32x4 l1 = *(const f32x4*)(lb + c0), l2 = *(const f32x4*)(lb + c0 + 32);
#pragma unroll
                    for (int ai = 0; ai < 2; ++ai)
#pragma unroll
                        for (int m = 0; m < 4; ++m) {
                            const size_t row = (size_t)u.pm * 256 + 128 * ai + 64 * wr + 16 * m + fr;
                            const f32x4 z1 = acc[ai][bj][m][0], z2 = acc[ai][bj][m][1]; f32x4 f1, f2;
                            f1.x = l1.x + (1.f - l1.x) / (1.f + __expf(-z1.x)); f1.y = l1.y + (1.f - l1.y) / (1.f + __expf(-z1.y)); f1.z = l1.z + (1.f - l1.z) / (1.f + __expf(-z1.z)); f1.w = l1.w + (1.f - l1.w) / (1.f + __expf(-z1.w));
                            f2.x = l2.x + (1.f - l2.x) / (1.f + __expf(-z2.x)); f2.y = l2.y + (1.f - l2.y) / (1.f + __expf(-z2.y)); f2.z = l2.z + (1.f - l2.z) / (1.f + __expf(-z2.z)); f2.w = l2.w + (1.f - l2.w) / (1.f + __expf(-z2.w));
                            *(f32x4*)(dst + row * DM + c0) = f1; *(f32x4*)(dst + row * DM + c0 + 32) = f2;
                        }
                } else {
                    bf16_t* dst = (bf16_t*)(ws + (seg == 0 ? WS_PQ : (seg == 3 ? WS_PI : WS_PG)));
#pragma unroll
                    for (int ai = 0; ai < 2; ++ai)
#pragma unroll
                        for (int m = 0; m < 4; ++m) {
                            const size_t row = (size_t)u.pm * 256 + 128 * ai + 64 * wr + 16 * m + fr;
                            const f32x4 x1 = acc[ai][bj][m][0], x2 = acc[ai][bj][m][1];
                            u32x2 q1, q2; q1.x = pk2(x1.x, x1.y); q1.y = pk2(x1.z, x1.w); q2.x = pk2(x2.x, x2.y); q2.y = pk2(x2.z, x2.w);
                            *(u32x2*)(dst + row * DM + c0) = q1; *(u32x2*)(dst + row * DM + c0 + 32) = q2;
                        }
                }
            }
        }
    }
};
struct EpiOut {
    static constexpr bool PERM = false; static constexpr int REPK = REPK_EPIOUT, REPE = REPE_EPIOUT;
    float* xres; const float* modl; int enable;
    __device__ __forceinline__ void operator()(const f32x4 (&acc)[2][2][4][2], const pg8::Unit& u, int wr, int wc, int fr, int fq) const {
        if (!enable) return;
        const int pmb = u.pm % 17; const int mrow = (pmb == 0) ? 4 : (u.pm / 17);
        const float* gate = modl + (size_t)mrow * 6144 + 2 * DM;
#pragma unroll
        for (int bj = 0; bj < 2; ++bj)
#pragma unroll
            for (int n = 0; n < 2; ++n) {
                const int c = 256 * u.pn + 128 * bj + 32 * wc + 16 * n + 4 * fq; const f32x4 gv = *(const f32x4*)(gate + c);
#pragma unroll
                for (int ai = 0; ai < 2; ++ai)
#pragma unroll
                    for (int m = 0; m < 4; ++m) { f32x4* p = (f32x4*)(xres + ((size_t)u.pm * 256 + 128 * ai + 64 * wr + 16 * m + fr) * DM + c); *p = *p + gv * acc[ai][bj][m][n]; }
            }
    }
};
struct EpiAct {
    static constexpr bool PERM = true; static constexpr int REPK = REPK_EPIACT, REPE = REPE_EPIACT;
    bf16_t* Act;
    __device__ __forceinline__ void operator()(const f32x4 (&acc)[2][2][4][2], const pg8::Unit& u, int wr, int wc, int fr, int fq) const {
#pragma unroll
        for (int bj = 0; bj < 2; ++bj) { const int Gq = 32 * u.pn + 16 * bj + 4 * wc + fq;
#pragma unroll
            for (int ai = 0; ai < 2; ++ai)
#pragma unroll
                for (int m = 0; m < 4; ++m) { const size_t row = (size_t)u.tile * 256 + 128 * ai + 64 * wr + 16 * m + fr;
                    const f32x4 a = acc[ai][bj][m][0], b = acc[ai][bj][m][1];
                    u32x2 q; q.x = pk2(siluf(a.x) * b.x, siluf(a.y) * b.y); q.y = pk2(siluf(a.z) * b.z, siluf(a.w) * b.w);
                    *(u32x2*)(Act + row * FF + 4 * Gq) = q; } }
    }
};
struct EpiY {
    static constexpr bool PERM = true; static constexpr int REPK = REPK_EPIY, REPE = REPE_EPIY;
    bf16_t* YB;
    __device__ __forceinline__ void operator()(const f32x4 (&acc)[2][2][4][2], const pg8::Unit& u, int wr, int wc, int fr, int fq) const {
#pragma unroll
        for (int bj = 0; bj < 2; ++bj) { const int c = 256 * u.pn + 128 * bj + 32 * wc + 8 * fq;
#pragma unroll
            for (int ai = 0; ai < 2; ++ai)
#pragma unroll
                for (int m = 0; m < 4; ++m) { const size_t row = (size_t)u.tile * 256 + 128 * ai + 64 * wr + 16 * m + fr;
                    const f32x4 a = acc[ai][bj][m][0], b = acc[ai][bj][m][1];
                    u32x4 q; q.x = pk2(a.x, a.y); q.y = pk2(a.z, a.w); q.z = pk2(b.x, b.y); q.w = pk2(b.z, b.w);
                    *(u32x4*)(YB + row * DM + c) = q; } }
    }
};

__device__ __forceinline__ void naive_g1(Frame& F, const Args& args, int l) {
    const int odd = l & 1, p = l >> 1; const int N = odd ? OD_N : EV_N;
    const float* W = (odd ? args.in[I_ODWIN] : args.in[I_EVWIN]) + (size_t)p * DM * N;
    LAS float* sh = (LAS float*)F.lds;
    const float* lb = (const float*)(F.ws + WS_LB) + l * DM;
    const float* ropec = (const float*)(F.ws + WS_ROPEC); const float* ropes = (const float*)(F.ws + WS_ROPES);
    for (int rg = fbid(); rg < MTOK / 8; rg += F.G) {
        __syncthreads();
        if (NAIVE_G1 == 2) {
            const int row = rg * 8 + F.wave; const int bb = row / SU, pp = row % SU; const int mrow = pp < NCTX ? 4 : bb;
            const float* xr = (const float*)(F.ws + WS_XRES) + (size_t)row * DM; float ssq = 0.f;
            for (int k = flane(); k < DM; k += 64) ssq += xr[k] * xr[k];
            ssq = wave_sum(ssq, flane()); const float rs = 1.0f / sqrtf(ssq / (float)DM + EPS);
            const float* modr = (const float*)(F.ws + WS_MOD) + ((size_t)l * 5 + mrow) * 6144;
            for (int k = flane(); k < DM; k += 64) sh[F.wave * DM + k] = xr[k] * rs * args.in[I_NORMW][(size_t)(l * 2) * DM + k] * (1.0f + modr[DM + k]) + modr[k];
        } else
        for (int i = ftid(); i < 8 * DM; i += 512) sh[i] = bf2f(((const bf16_t*)(F.ws + WS_HB))[(size_t)rg * 8 * DM + i]);
        __syncthreads();
        for (int pi = ftid(); pi < N / 2; pi += 512) {
            const int hh = pi >> 6, rem = pi & 63, half = rem >> 5, d = rem & 31; const int cA = 128 * hh + 64 * half + d, cB = cA + 32;
            float a[8], bq[8];
#pragma unroll
            for (int r = 0; r < 8; ++r) { a[r] = 0.f; bq[r] = 0.f; }
            for (int k = 0; k < DM; ++k) { const float wa = W[(size_t)k * N + cA], wb = W[(size_t)k * N + cB];
#pragma unroll
                for (int r = 0; r < 8; ++r) { const float hv = sh[r * DM + k]; a[r] += hv * wa; bq[r] += hv * wb; } }
            const int hcol = 128 * hh;
#pragma unroll
            for (int r = 0; r < 8; ++r) {
                const int row = rg * 8 + r; const int pp = row % SU; const bool isctx = pp < NCTX; const int t = pp - NCTX;
                float x1 = a[r], x2 = bq[r];
                if (!odd) {
                    const bool rope = !isctx && (hcol < 1024 || (hcol >= 2048 && hcol < 2816));
                    if (hcol >= 512 && hcol < 1024) { x1 *= 0.08838834764831845f; x2 *= 0.08838834764831845f; }
                    if (rope) { const int pos = half ? (t & 63) : (t >> 6); float cc = ropec[pos * 32 + d], sn = ropes[pos * 32 + d];
                        if (NAIVE_G1 == 3) { const double ang = (double)((float)pos * powf(10000.0f, -(float)d / 32.0f)); cc = (float)cos(ang); sn = (float)sin(ang); }
                        const float o1 = x1 * cc - x2 * sn, o2 = x2 * cc + x1 * sn; x1 = o1; x2 = o2; }
                    bf16_t* dst = (bf16_t*)(F.ws + WS_PE) + (size_t)row * EV_N; dst[cA] = (bf16_t)f2bf(x1); dst[cB] = (bf16_t)f2bf(x2);
                } else {
                    const int seg = hcol >> 10, c0 = cA & 1023;
                    if (seg == 1 || seg == 2) { float* dst = (float*)(F.ws + (seg == 1 ? WS_FF : WS_FB)) + (size_t)row * DM;
                        float lba = lb[c0], lbb = lb[c0 + 32];
                        if (NAIVE_G1 == 3) { const float* lg = args.in[I_LBLOG]; float ea[4], eb[4], sa = 0.f, sb2 = 0.f; for (int q = 0; q < 4; ++q) { ea[q] = expf(lg[q * DM + c0]); eb[q] = expf(lg[q * DM + c0 + 32]); sa += ea[q]; sb2 += eb[q]; }
                            lba = 0.f; lbb = 0.f; for (int q = 1; q <= l; ++q) { lba += ea[q] / sa; lbb += eb[q] / sb2; } }
                        dst[c0] = lba + (1.f - lba) / (1.f + expf(-x1)); dst[c0 + 32] = lbb + (1.f - lbb) / (1.f + expf(-x2)); }
                    else { bf16_t* dst = (bf16_t*)(F.ws + (seg == 0 ? WS_PQ : (seg == 3 ? WS_PI : WS_PG))) + (size_t)row * DM; dst[c0] = (bf16_t)f2bf(x1); dst[c0 + 32] = (bf16_t)f2bf(x2); }
                }
            }
        }
    }
    __syncthreads();
}

__device__ __forceinline__ void naive_g2(Frame& F, const Args& args, int l) {
    const int odd = l & 1, p = l >> 1;
    const float* W = (odd ? args.in[I_ODWOUT] : args.in[I_EVWOUT]) + (size_t)p * DM * DM;
    LAS float* sh = (LAS float*)F.lds;
    const float* modl = (const float*)(F.ws + WS_MOD) + (size_t)l * 5 * 6144;
    float* xres = (float*)(F.ws + WS_XRES);
    for (int rg = fbid(); rg < MTOK / 8; rg += F.G) {
        __syncthreads();
        for (int i = ftid(); i < 8 * DM; i += 512) sh[i] = bf2f(((const bf16_t*)(F.ws + WS_YB16))[(size_t)rg * 8 * DM + i]);
        __syncthreads();
        for (int col = ftid(); col < DM; col += 512) {
            float a[8];
#pragma unroll
            for (int r = 0; r < 8; ++r) a[r] = 0.f;
            for (int k = 0; k < DM; ++k) { const float wa = W[(size_t)k * DM + col];
#pragma unroll
                for (int r = 0; r < 8; ++r) a[r] += sh[r * DM + k] * wa; }
#pragma unroll
            for (int r = 0; r < 8; ++r) { const int row = rg * 8 + r; const int b = row / SU, pp = row % SU; const int mrow = pp < NCTX ? 4 : b;
                xres[(size_t)row * DM + col] += modl[(size_t)mrow * 6144 + 2 * DM + col] * a[r]; }
        }
    }
    __syncthreads();
}
__device__ __forceinline__ void naive_mod(Frame& F, const Args& args) {
    float* mod = (float*)(F.ws + WS_MOD);
    for (int i = fbid() * 512 + ftid(); i < DEPTH * 5 * 6144; i += F.G * 512) {
        const int col = i % 6144, r = (i / 6144) % 5, l = i / (5 * 6144);
        const float* cv = r < 4 ? args.in[I_C] + r * DM : args.in[I_CCTX];
        const float* w = args.in[I_ADAW] + (size_t)l * DM * 6144 + col;
        float a = 0.f;
        for (int k = 0; k < DM; ++k) { const float v = cv[k]; a += (v / (1.0f + expf(-v))) * w[(size_t)k * 6144]; }
        mod[i] = a + args.in[I_ADAB][l * 6144 + col];
    }
}

__device__ __forceinline__ void naive_moe(Frame& F, const Args& args, int l) {
    LAS float* sh = (LAS float*)F.lds;
    LAS float* sa = sh + 8 * DM;
    LAS int* gstart = (LAS int*)(sa + 8 * FF);
    LAS int* stok = gstart + 40;
    const unsigned* cnt = F.ctl + CW_CNT + l * NEXP;
    const unsigned* list = (const unsigned*)(F.ws + WS_LIST);
    __syncthreads();
    if (ftid() == 0) { int acc = 0; for (int e = 0; e < NEXP; ++e) { gstart[e] = acc; acc += ((int)cnt[e] + 7) / 8; } gstart[NEXP] = acc; }
    __syncthreads();
    const int total = gstart[NEXP];
    float* YN = (float*)(F.ws + WS_YN);
    for (int gi = fbid(); gi < total; gi += F.G) {
        int e = 0; for (int k = 1; k < NEXP; ++k) e += (gstart[k] <= gi) ? 1 : 0;
        const int g = gi - gstart[e]; const int ce = (int)cnt[e];
        __syncthreads();
        if (ftid() < 8) { const int idx = 8 * g + ftid(); stok[ftid()] = idx < ce ? (int)list[(size_t)e * LIST_CAP + idx] : -1; }
        __syncthreads();
        for (int i = ftid(); i < 8 * DM; i += 512) { const int r = i >> 10, k = i & 1023; const int tk = stok[r]; sh[i] = tk >= 0 ? bf2f(((const bf16_t*)(F.ws + WS_HB))[(size_t)tk * DM + k]) : 0.f; }
        __syncthreads();
        const float* w1 = args.in[I_W1] + ((size_t)l * NEXP + e) * DM * FF; const float* w3 = args.in[I_W3] + ((size_t)l * NEXP + e) * DM * FF; const float* w2 = args.in[I_W2] + ((size_t)l * NEXP + e) * FF * DM;
        { const int col = ftid(); float a[8], b[8];
#pragma unroll
            for (int r = 0; r < 8; ++r) { a[r] = 0.f; b[r] = 0.f; }
            for (int k = 0; k < DM; ++k) { const float wa = w1[(size_t)k * FF + col], wb = w3[(size_t)k * FF + col];
#pragma unroll
                for (int r = 0; r < 8; ++r) { const float hv = sh[r * DM + k]; a[r] += hv * wa; b[r] += hv * wb; } }
#pragma unroll
            for (int r = 0; r < 8; ++r) sa[r * FF + col] = (a[r] / (1.0f + expf(-a[r]))) * b[r]; }
        __syncthreads();
        for (int col = ftid(); col < DM; col += 512) { float y[8];
#pragma unroll
            for (int r = 0; r < 8; ++r) y[r] = 0.f;
            for (int k = 0; k < FF; ++k) { const float wv = w2[(size_t)k * DM + col];
#pragma unroll
                for (int r = 0; r < 8; ++r) y[r] += sa[r * FF + k] * wv; }
#pragma unroll
            for (int r = 0; r < 8; ++r) { const int tk = stok[r]; if (tk >= 0) { const unsigned e0 = ((const unsigned*)(F.ws + WS_TOKINFO))[(size_t)tk * 8]; const int kk = (e0 == (unsigned)e) ? 0 : 1;
                YN[((size_t)tk * 2 + kk) * DM + col] = y[r]; } } }
    }
    __syncthreads();
}

constexpr int TLD = 136;
constexpr int TILE_BYTES = 128 * TLD * 2;
template <int NT, int KS>
__device__ __forceinline__ void wave_mma(f32x4 (&acc)[NT], const bf16x8 (&afr)[KS], const LAS bf16_t* Bt, int ldb, int lane) {
    const LAS bf16_t* bp = Bt + (lane & 15) * ldb + 8 * (lane >> 4);
#pragma unroll
    for (int nt = 0; nt < NT; ++nt)
#pragma unroll
        for (int ks = 0; ks < KS; ++ks) { const bf16x8 b = *(const LAS bf16x8*)(bp + nt * 16 * ldb + 32 * ks); acc[nt] = __builtin_amdgcn_mfma_f32_16x16x32_bf16(afr[ks], b, acc[nt], 0, 0, 0);
            if ((ks & 3) == 3 && (nt & 1) == 1) asm volatile("" ::: "memory"); }
}
template <int NT, int KS>
__device__ __forceinline__ void wave_mma2(f32x4 (&acc0)[NT], f32x4 (&acc1)[NT], const bf16x8 (&a0)[KS], const bf16x8 (&a1)[KS], const LAS bf16_t* Bt, int ldb, int lane) {
    const LAS bf16_t* bp = Bt + (lane & 15) * ldb + 8 * (lane >> 4);
#pragma unroll
    for (int nt = 0; nt < NT; ++nt) {
        bf16x8 b[KS];
#pragma unroll
        for (int ks = 0; ks < KS; ++ks) b[ks] = *(const LAS bf16x8*)(bp + nt * 16 * ldb + 32 * ks);
#pragma unroll
        for (int ks = 0; ks < KS; ++ks) { acc0[nt] = __builtin_amdgcn_mfma_f32_16x16x32_bf16(a0[ks], b[ks], acc0[nt], 0, 0, 0); acc1[nt] = __builtin_amdgcn_mfma_f32_16x16x32_bf16(a1[ks], b[ks], acc1[nt], 0, 0, 0); }
        if ((nt & 1) == 1) asm volatile("" ::: "memory");
    }
}
__device__ __forceinline__ void stage_rowmajor(LAS bf16_t* T, const bf16_t* src, size_t ld, int tid) {
#pragma unroll
    for (int i = 0; i < 4; ++i) { const int q = tid + 512 * i, r = q >> 4, cc = q & 15; const u32x4 v = *(const u32x4*)(src + (size_t)r * ld + 8 * cc); *(LAS u32x4*)(T + r * TLD + 8 * cc) = v; }
}
__device__ __forceinline__ void stage_transposed(LAS bf16_t* T, const bf16_t* src, size_t ld, int tid, bool scaled, float sa, float sb) {
#pragma unroll
    for (int i = 0; i < 2; ++i) { const int q = tid + 512 * i, rp = q & 63, cc = q >> 6;
        const u32x4 v0 = *(const u32x4*)(src + (size_t)(2 * rp) * ld + 8 * cc), v1 = *(const u32x4*)(src + (size_t)(2 * rp + 1) * ld + 8 * cc);
        const unsigned w0[4] = {v0.x, v0.y, v0.z, v0.w}, w1[4] = {v1.x, v1.y, v1.z, v1.w};
        LAS unsigned* tp = (LAS unsigned*)(T + (8 * cc) * TLD + 2 * rp);
        if (scaled) { const float s0 = exp2f(sa * (float)(2 * rp) + sb), s1 = exp2f(sa * (float)(2 * rp + 1) + sb);
#pragma unroll
            for (int k = 0; k < 4; ++k) { tp[(2 * k) * (TLD / 2)] = pk2(bflo(w0[k]) * s0, bflo(w1[k]) * s1); tp[(2 * k + 1) * (TLD / 2)] = pk2(bfhi(w0[k]) * s0, bfhi(w1[k]) * s1); }
        } else {
#pragma unroll
            for (int k = 0; k < 4; ++k) { tp[(2 * k) * (TLD / 2)] = (w0[k] & 0xffffu) | (w1[k] << 16); tp[(2 * k + 1) * (TLD / 2)] = (w0[k] >> 16) | (w1[k] & 0xffff0000u); }
        }
    }
}
__device__ __forceinline__ void stage_f32_rowmajor(LAS bf16_t* T, const float* src, int tid) {
#pragma unroll
    for (int i = 0; i < 8; ++i) { const int q = tid + 512 * i, r = q >> 5, cc = q & 31; const f32x4 v = *(const f32x4*)(src + (size_t)r * 128 + 4 * cc);
        u32x2 o; o.x = pk2(v.x, v.y); o.y = pk2(v.z, v.w); *(LAS u32x2*)(T + r * TLD + 4 * cc) = o; }
}
__device__ __forceinline__ float log2_gamma_f(const Frame& F, int p, int dir, int h) { return -expf(((const float*)(F.ws + WS_SP) + SP_DECAY)[(p * 2 + dir) * 4 + h]) * 1.4426950408889634f; }
#define log2_gamma(args, p, dir, h) log2_gamma_f(F, p, dir, h)

__device__ __forceinline__ void ret_state_item(Frame& F, const Args& args, int p, int item) {
    const int c = item % NCHUNK, h = (item / NCHUNK) & 3, b = item / (NCHUNK * 4);
    int tid = ftid(); asm volatile("" : "+v"(tid)); const int lane = tid & 63, w = F.wave;
    LAS bf16_t* T0 = (LAS bf16_t*)F.lds; LAS bf16_t* T1 = (LAS bf16_t*)(F.lds + TILE_BYTES); LAS bf16_t* T2 = (LAS bf16_t*)(F.lds + 2 * TILE_BYTES);
    const bf16_t* pe = (const bf16_t*)(F.ws + WS_PE) + ((size_t)b * SU + 128 * c) * EV_N;
    const float lgf = log2_gamma(args, p, 0, h), lgb = log2_gamma(args, p, 1, h);
    __syncthreads();
    stage_transposed(T0, pe + 512 + h * 128, EV_N, tid, false, 0.f, 0.f);
    stage_transposed(T1, pe + 1024 + h * 128, EV_N, tid, true, -lgf, 127.f * lgf);
    stage_transposed(T2, pe + 1024 + h * 128, EV_N, tid, true, lgb, 0.f);
    __syncthreads();
    float* st = (float*)(F.ws + WS_ST);
    {
        bf16x8 af[4], ab[4];
#pragma unroll
        for (int ks = 0; ks < 4; ++ks) { af[ks] = *(const LAS bf16x8*)(T1 + (16 * w + (lane & 15)) * TLD + 32 * ks + 8 * (lane >> 4)); ab[ks] = *(const LAS bf16x8*)(T2 + (16 * w + (lane & 15)) * TLD + 32 * ks + 8 * (lane >> 4)); }
        f32x4 accf[8], accb[8];
#pragma unroll
        for (int nt = 0; nt < 8; ++nt) { accf[nt] = (f32x4){0.f, 0.f, 0.f, 0.f}; accb[nt] = (f32x4){0.f, 0.f, 0.f, 0.f}; }
        wave_mma2<8, 4>(accf, accb, af, ab, T0, TLD, lane);
        float* dstf = st + ((((size_t)(b * 4 + h) * 2 + 0) * NCHUNK + c) * 128) * 128; float* dstb = st + ((((size_t)(b * 4 + h) * 2 + 1) * NCHUNK + c) * 128) * 128;
#pragma unroll
        for (int nt = 0; nt < 8; ++nt)
#pragma unroll
            for (int j = 0; j < 4; ++j) { const size_t o_ = (size_t)(16 * w + 4 * (lane >> 4) + j) * 128 + 16 * nt + (lane & 15); dstf[o_] = accf[nt][j]; dstb[o_] = accb[nt][j]; }
    }
}
__device__ __forceinline__ void ret_scan_phase(Frame& F, const Args& args, int p) {
    f32x4* st = (f32x4*)(F.ws + WS_ST);
    for (int i = fbid() * 512 + ftid(); i < 32 * 4096; i += F.G * 512) {
        const int bhd = i >> 12, el = i & 4095; const int dir = bhd & 1, h = (bhd >> 1) & 3;
        const float g128 = exp2f(128.f * log2_gamma(args, p, dir, h));
        f32x4* base = st + (size_t)bhd * NCHUNK * 4096 + el;
        f32x4 s = (f32x4){0.f, 0.f, 0.f, 0.f};
        for (int k = 0; k < NCHUNK; ++k) {
            const int c = dir == 0 ? k : (k < 2 ? 1 - k : NCHUNK + 1 - k);
            const f32x4 u = base[(size_t)c * 4096]; base[(size_t)c * 4096] = s; s = s * g128 + u;
        }
    }
}
__device__ __forceinline__ bf16x8 scale_frag(const bf16x8 a, float sc) {
    bf16x8 r;
#pragma unroll
    for (int k = 0; k < 8; ++k) r[k] = (short)f2bf(bf2f((unsigned)(unsigned short)a[k]) * sc);
    return r;
}
__device__ __forceinline__ void ret_out_item(Frame& F, const Args& args, int p, int item) {
    const int c = item % NCHUNK, h = (item / NCHUNK) & 3, b = item / (NCHUNK * 4);
    int tid = ftid(); asm volatile("" : "+v"(tid)); const int lane = tid & 63, w = F.wave, quad = lane >> 4, l15 = lane & 15;
    LAS bf16_t* T0 = (LAS bf16_t*)F.lds; LAS bf16_t* T1 = (LAS bf16_t*)(F.lds + TILE_BYTES); LAS bf16_t* T2 = (LAS bf16_t*)(F.lds + 2 * TILE_BYTES);
    const size_t row0 = (size_t)b * SU + 128 * c;
    const bf16_t* pe = (const bf16_t*)(F.ws + WS_PE) + row0 * EV_N;
    const float lgf = log2_gamma(args, p, 0, h), lgb = log2_gamma(args, p, 1, h);
    const float* stf = (const float*)(F.ws + WS_ST) + ((((size_t)(b * 4 + h) * 2 + 0) * NCHUNK + c) * 128) * 128;
    const float* stb = (const float*)(F.ws + WS_ST) + ((((size_t)(b * 4 + h) * 2 + 1) * NCHUNK + c) * 128) * 128;
    bf16x8 qf[4];
#pragma unroll
    for (int ks = 0; ks < 4; ++ks) qf[ks] = *(const bf16x8*)(pe + (size_t)(16 * w + l15) * EV_N + h * 128 + 32 * ks + 8 * quad);
    __syncthreads();
    stage_rowmajor(T0, pe + 512 + h * 128, EV_N, tid);
    stage_transposed(T1, pe + 1024 + h * 128, EV_N, tid, false, 0.f, 0.f);
    stage_f32_rowmajor(T2, stf, tid);
    __syncthreads();
    f32x4 ao[8];
#pragma unroll
    for (int nt = 0; nt < 8; ++nt) ao[nt] = (f32x4){0.f, 0.f, 0.f, 0.f};
    {
        const float cf = exp2f(lgf * (float)(16 * w + l15 + 1));
        bf16x8 qs[4];
#pragma unroll
        for (int ks = 0; ks < 4; ++ks) qs[ks] = scale_frag(qf[ks], cf);
        wave_mma<8, 4>(ao, qs, T2, TLD, lane);
    }
    {
        f32x4 aw[8];
#pragma unroll
        for (int nt = 0; nt < 8; ++nt) aw[nt] = (f32x4){0.f, 0.f, 0.f, 0.f};
        wave_mma<8, 4>(aw, qf, T0, TLD, lane);
        __syncthreads();
#pragma unroll
        for (int nt = 0; nt < 8; ++nt)
#pragma unroll
            for (int j = 0; j < 4; ++j) { const int i = 16 * w + 4 * quad + j, jj = 16 * nt + l15; const int d = i - jj;
                const float dec = d > 0 ? exp2f(lgf * (float)d) : (d < 0 ? exp2f(lgb * (float)(-d)) : 2.0f);
                T0[i * TLD + jj] = (bf16_t)f2bf(aw[nt][j] * dec); }
    }
    stage_f32_rowmajor(T2, stb, tid);
    __syncthreads();
    {
        bf16x8 pf[4];
#pragma unroll
        for (int ks = 0; ks < 4; ++ks) pf[ks] = *(const LAS bf16x8*)(T0 + (16 * w + l15) * TLD + 32 * ks + 8 * quad);
        wave_mma<8, 4>(ao, pf, T1, TLD, lane);
        const float cb = exp2f(lgb * (float)(128 - (16 * w + l15)));
#pragma unroll
        for (int ks = 0; ks < 4; ++ks) pf[ks] = scale_frag(qf[ks], cb);
        wave_mma<8, 4>(ao, pf, T2, TLD, lane);
    }
    bf16_t* yb = (bf16_t*)(F.ws + WS_YB16);
#pragma unroll
    for (int j = 0; j < 4; ++j) { const int i = 16 * w + 4 * quad + j;
        float ss = 0.f;
#pragma unroll
        for (int nt = 0; nt < 8; ++nt) ss += ao[nt][j] * ao[nt][j];
        ss += shx(ss, 1, lane); ss += shx(ss, 2, lane); ss += shx(ss, 4, lane); ss += shx(ss, 8, lane);
        const float rstd = 1.0f / sqrtf(ss * (1.0f / 128.f) + EPS);
        const bf16_t* gp = pe + (size_t)i * EV_N + 1536 + h * 128;
#pragma unroll
        for (int nt = 0; nt < 8; ++nt) { const float gt = bf2f(gp[16 * nt + l15]); yb[(row0 + i) * DM + h * 128 + 16 * nt + l15] = ABL_RET0 ? (bf16_t)0 : (bf16_t)f2bf(siluf(gt) * ao[nt][j] * rstd); }
    }
}
__device__ __forceinline__ void ret_direct_item(Frame& F, const Args& args, int p, int item) {
    const int c = item % NCHUNK, h = (item / NCHUNK) & 3, b = item / (NCHUNK * 4);
    int tid = ftid(); asm volatile("" : "+v"(tid)); const int lane = tid & 63, w = F.wave, quad = lane >> 4, l15 = lane & 15;
    LAS bf16_t* T0 = (LAS bf16_t*)F.lds; LAS bf16_t* T1 = (LAS bf16_t*)(F.lds + TILE_BYTES); LAS bf16_t* T2 = (LAS bf16_t*)(F.lds + 2 * TILE_BYTES);
    const size_t row0 = (size_t)b * SU + 128 * c;
    const bf16_t* peb = (const bf16_t*)(F.ws + WS_PE) + (size_t)b * SU * EV_N;
    const bf16_t* pe = peb + (size_t)128 * c * EV_N;
    const float lgf = log2_gamma(args, p, 0, h), lgb = log2_gamma(args, p, 1, h);
    bf16x8 qf[4];
#pragma unroll
    for (int ks = 0; ks < 4; ++ks) qf[ks] = *(const bf16x8*)(pe + (size_t)(16 * w + l15) * EV_N + h * 128 + 32 * ks + 8 * quad);
    f32x4 ao[8];
#pragma unroll
    for (int nt = 0; nt < 8; ++nt) ao[nt] = (f32x4){0.f, 0.f, 0.f, 0.f};
    for (int c2 = 0; c2 < NCHUNK; ++c2) {
        __syncthreads();
        stage_rowmajor(T0, peb + (size_t)128 * c2 * EV_N + 512 + h * 128, EV_N, tid);
        stage_transposed(T1, peb + (size_t)128 * c2 * EV_N + 1024 + h * 128, EV_N, tid, false, 0.f, 0.f);
        __syncthreads();
        f32x4 aw[8];
#pragma unroll
        for (int nt = 0; nt < 8; ++nt) aw[nt] = (f32x4){0.f, 0.f, 0.f, 0.f};
        wave_mma<8, 4>(aw, qf, T0, TLD, lane);
#pragma unroll
        for (int nt = 0; nt < 8; ++nt)
#pragma unroll
            for (int j = 0; j < 4; ++j) { const int i = 16 * w + 4 * quad + j, jj = 16 * nt + l15;
                const int px = 128 * c + i, py = 128 * c2 + jj;
                const int ubx = px < NCTX ? NCTX - 1 - px : SU + NCTX - 1 - px, uby = py < NCTX ? NCTX - 1 - py : SU + NCTX - 1 - py;
                float dec = 0.f;
                if (py <= px && !(px >= NCTX && false)) dec += exp2f(lgf * (float)(px - py));
                if (uby <= ubx) dec += exp2f(lgb * (float)(ubx - uby));
                if (px < NCTX && py >= NCTX) dec = 0.f;
                T2[i * TLD + jj] = (bf16_t)f2bf(aw[nt][j] * dec); }
        LDS_WAIT(); asm volatile("" ::: "memory");
        bf16x8 pf[4];
#pragma unroll
        for (int ks = 0; ks < 4; ++ks) pf[ks] = *(const LAS bf16x8*)(T2 + (16 * w + l15) * TLD + 32 * ks + 8 * quad);
        wave_mma<8, 4>(ao, pf, T1, TLD, lane);
    }
    bf16_t* yb = (bf16_t*)(F.ws + WS_YB16);
#pragma unroll
    for (int j = 0; j < 4; ++j) { const int i = 16 * w + 4 * quad + j;
        float ss = 0.f;
#pragma unroll
        for (int nt = 0; nt < 8; ++nt) ss += ao[nt][j] * ao[nt][j];
        ss += shx(ss, 1, lane); ss += shx(ss, 2, lane); ss += shx(ss, 4, lane); ss += shx(ss, 8, lane);
        const float rstd = 1.0f / sqrtf(ss * (1.0f / 128.f) + EPS);
        const bf16_t* gp = pe + (size_t)i * EV_N + 1536 + h * 128;
#pragma unroll
        for (int nt = 0; nt < 8; ++nt) { const float gt = bf2f(gp[16 * nt + l15]); yb[(row0 + i) * DM + h * 128 + 16 * nt + l15] = (bf16_t)f2bf(siluf(gt) * ao[nt][j] * rstd); }
    }
}
__device__ __forceinline__ void att_item(Frame& F, const Args& args, int p, int item) {
    const int qb = item % NCHUNK, hk = (item / NCHUNK) & 1, b = item / (NCHUNK * 2);
    int tid = ftid(); asm volatile("" : "+v"(tid)); const int lane = tid & 63, w = F.wave, quad = lane >> 4, l15 = lane & 15;
    const int g = w >> 2, hq = 2 * hk + g, qr0 = 32 * (w & 3);
    LAS bf16_t* T0 = (LAS bf16_t*)F.lds; LAS bf16_t* T1 = (LAS bf16_t*)(F.lds + TILE_BYTES);
    LAS bf16_t* Pw = (LAS bf16_t*)(F.lds + 2 * TILE_BYTES) + w * 32 * TLD;
    const bf16_t* peb = (const bf16_t*)(F.ws + WS_PE) + (size_t)b * SU * EV_N;
    const size_t qrow0 = (size_t)128 * qb + qr0;
    bf16x8 qf[2][4];
#pragma unroll
    for (int rt = 0; rt < 2; ++rt)
#pragma unroll
        for (int ks = 0; ks < 4; ++ks) qf[rt][ks] = *(const bf16x8*)(peb + (qrow0 + 16 * rt + l15) * EV_N + 2048 + hq * 128 + 32 * ks + 8 * quad);
    const float sink = ((const float*)(F.ws + WS_SP) + SP_SINK)[p * 4 + hq] * 1.4426950408889634f;
    const float scale = 0.08838834764831845f * 1.4426950408889634f;
    float mrow[2][4], lrow[2][4]; f32x4 ao[2][8];
#pragma unroll
    for (int rt = 0; rt < 2; ++rt) {
#pragma unroll
        for (int j = 0; j < 4; ++j) { mrow[rt][j] = sink; lrow[rt][j] = 1.0f; }
#pragma unroll
        for (int nt = 0; nt < 8; ++nt) ao[rt][nt] = (f32x4){0.f, 0.f, 0.f, 0.f};
    }
    const int ntile = (qb < 2) ? 2 : 5;
    for (int ti = 0; ti < ntile; ++ti) {
        int kt, mode = 0;
        if (ti < 2) kt = ti; else { kt = qb + (ti - 3); mode = (ti == 2) ? 1 : (ti == 4 ? 2 : 0); }
        if (ti >= 2 && (kt < 2 || kt >= NCHUNK)) continue;
        __syncthreads();
        stage_rowmajor(T0, peb + (size_t)128 * kt * EV_N + 2560 + hk * 128, EV_N, tid);
        stage_transposed(T1, peb + (size_t)128 * kt * EV_N + 2816 + hk * 128, EV_N, tid, false, 0.f, 0.f);
        __syncthreads();
        f32x4 s2[2][8];
#pragma unroll
        for (int nt = 0; nt < 8; ++nt) { s2[0][nt] = (f32x4){0.f, 0.f, 0.f, 0.f}; s2[1][nt] = (f32x4){0.f, 0.f, 0.f, 0.f}; }
        wave_mma2<8, 4>(s2[0], s2[1], qf[0], qf[1], T0, TLD, lane);
#pragma unroll
        for (int rt = 0; rt < 2; ++rt) {
            f32x4 (&s)[8] = s2[rt];
#pragma unroll
            for (int j = 0; j < 4; ++j) {
                const int qq = qr0 + 16 * rt + 4 * quad + j;
                float mx = -3.0e38f;
                if (mode == 0) {
#pragma unroll
                    for (int nt = 0; nt < 8; ++nt) { const float v = s[nt][j] * scale; s[nt][j] = v; mx = fmaxf(mx, v); }
                } else {
#pragma unroll
                    for (int nt = 0; nt < 8; ++nt) { const int kk = 16 * nt + l15; float v = s[nt][j] * scale;
                        const bool valid = (mode == 1 ? (kk >= qq) : (kk <= qq));
                        v = valid ? v : -3.0e38f; s[nt][j] = v; mx = fmaxf(mx, v); }
                }
                mx = fmaxf(mx, shx(mx, 1, lane)); mx = fmaxf(mx, shx(mx, 2, lane)); mx = fmaxf(mx, shx(mx, 4, lane)); mx = fmaxf(mx, shx(mx, 8, lane));
                const float mn = fmaxf(mrow[rt][j], mx); const float alpha = __builtin_amdgcn_exp2f(mrow[rt][j] - mn);
                float rs = 0.f;
#pragma unroll
                for (int nt = 0; nt < 8; ++nt) { const float pv = __builtin_amdgcn_exp2f(s[nt][j] - mn); rs += pv;     Pw[(16 * rt + 4 * quad + j) * TLD + 16 * nt + l15] = (bf16_t)f2bf(pv); }
                rs += shx(rs, 1, lane); rs += shx(rs, 2, lane); rs += shx(rs, 4, lane); rs += shx(rs, 8, lane);
                lrow[rt][j] = lrow[rt][j] * alpha + rs; mrow[rt][j] = mn;
#pragma unroll
                for (int nt = 0; nt < 8; ++nt) ao[rt][nt][j] *= alpha;
            }
        }
        LDS_WAIT(); asm volatile("" ::: "memory");
        {
            bf16x8 pf0[4], pf1[4];
#pragma unroll
            for (int ks = 0; ks < 4; ++ks) { pf0[ks] = *(const LAS bf16x8*)(Pw + (l15) * TLD + 32 * ks + 8 * quad); pf1[ks] = *(const LAS bf16x8*)(Pw + (16 + l15) * TLD + 32 * ks + 8 * quad); }
            wave_mma2<8, 4>(ao[0], ao[1], pf0, pf1, T1, TLD, lane);
        }
    }
    bf16_t* yb = (bf16_t*)(F.ws + WS_YB16) + ((size_t)b * SU + qrow0) * DM + 512 + hq * 128;
#pragma unroll
    for (int rt = 0; rt < 2; ++rt)
#pragma unroll
        for (int j = 0; j < 4; ++j) { const float inv = 1.0f / lrow[rt][j];
#pragma unroll
            for (int nt = 0; nt < 8; ++nt) yb[(size_t)(16 * rt + 4 * quad + j) * DM + 16 * nt + l15] = ABL_ATT0 ? (bf16_t)0 : (bf16_t)f2bf(ao[rt][nt][j] * inv); }
}
__device__ __forceinline__ void naive_att(Frame& F, const Args& args, int p) {
    const int gw = F.vcu * NWAVES + F.wave, NGW = F.G * NWAVES, lane = flane();
    LAS float* sq = (LAS float*)F.lds + F.wave * 1024;
    LAS float* sc = sq + 128;
    const bf16_t* pe = (const bf16_t*)(F.ws + WS_PE);
    for (int task = gw; task < MTOK * 4; task += NGW) {
        const int row = task >> 2, hq = task & 3, hk = hq >> 1; const int b = row / SU, pq = row % SU;
        const bf16_t* peb = pe + (size_t)b * SU * EV_N;
        sq[lane] = bf2f(peb[(size_t)pq * EV_N + 2048 + hq * 128 + lane]) * 0.08838834764831845f; sq[lane + 64] = bf2f(peb[(size_t)pq * EV_N + 2048 + hq * 128 + lane + 64]) * 0.08838834764831845f;
        LDS_WAIT(); asm volatile("" ::: "memory");
        int lo = 0, nloc = 0;
        if (pq >= NCTX) { const int t = pq - NCTX; lo = t - 128 < 0 ? 0 : t - 128; const int hi = t + 128 > LSEQ - 1 ? LSEQ - 1 : t + 128; nloc = hi - lo + 1; }
        const int nk = NCTX + nloc;
        const float sink = args.in[I_SINK][p * 4 + hq];
        float mx = sink;
        for (int ki = lane; ki < nk; ki += 64) { const int kp = ki < NCTX ? ki : NCTX + lo + (ki - NCTX);
            const bf16_t* kr = peb + (size_t)kp * EV_N + 2560 + hk * 128; float d = 0.f;
            for (int x = 0; x < 128; ++x) d += sq[x] * bf2f(kr[x]);
            sc[ki] = d; mx = fmaxf(mx, d); }
#pragma unroll
        for (int o = 1; o < 64; o <<= 1) mx = fmaxf(mx, shx(mx, o, lane));
        float sum = 0.f;
        for (int ki = lane; ki < nk; ki += 64) { const float e = expf(sc[ki] - mx); sc[ki] = e; sum += e; }
        sum = wave_sum(sum, lane) + expf(sink - mx);
        LDS_WAIT(); asm volatile("" ::: "memory");
        float o0 = 0.f, o1 = 0.f;
        for (int ki = 0; ki < nk; ++ki) { const int kp = ki < NCTX ? ki : NCTX + lo + (ki - NCTX); const bf16_t* vr = peb + (size_t)kp * EV_N + 2816 + hk * 128; const float pv = sc[ki];
            o0 += pv * bf2f(vr[lane]); o1 += pv * bf2f(vr[lane + 64]); }
        bf16_t* yb = (bf16_t*)(F.ws + WS_YB16) + (size_t)row * DM + 512 + hq * 128;
        yb[lane] = (bf16_t)f2bf(o0 / sum); yb[lane + 64] = (bf16_t)f2bf(o1 / sum);
        LDS_WAIT(); asm volatile("" ::: "memory");
    }
}
__device__ __forceinline__ void hg_scan_item_plain(Frame& F, int item) {
    const int es = item & 3, dir = (item >> 2) & 1, h = (item >> 3) & 7, b = item >> 6;
    const int tid = ftid(), e = tid & 31, dg = tid >> 5;
    LAS float* sP = (LAS float*)F.lds;
    LAS float* sIn = sP + 32 * 16 * 32;
    constexpr int INB = 32 * 128 * 2 + 32 * 32;
    const float* fsrc = (const float*)(F.ws + (dir ? WS_FB : WS_FF));
    const bf16_t* qsrc = (const bf16_t*)(F.ws + WS_PQ); const bf16_t* vsrc = (const bf16_t*)(F.ws + WS_PI);
    float* osrc = (float*)(F.ws + (dir ? WS_OB : WS_OF));
    float S[8];
#pragma unroll
    for (int k = 0; k < 8; ++k) S[k] = 0.f;
    const size_t rb = (size_t)b * SU;
    f32x4 rf0, rf1; u32x4 rq, rv;
    auto pos_of = [&](int s) { return dir ? (s < NCTX ? NCTX - 1 - s : SU + NCTX - 1 - s) : s; };
#define HG_ISSUE(s0_) do { const int pA = pos_of((s0_) + (tid >> 5)), pB = pos_of((s0_) + 16 + (tid >> 5)), pQ = pos_of((s0_) + (tid >> 4)); \
        rf0 = *(const f32x4*)(fsrc + (rb + pA) * DM + h * 128 + 4 * (tid & 31)); rf1 = *(const f32x4*)(fsrc + (rb + pB) * DM + h * 128 + 4 * (tid & 31)); \
        rq = *(const u32x4*)(qsrc + (rb + pQ) * DM + h * 128 + 8 * (tid & 15)); \
        if (tid < 128) { const int pV = pos_of((s0_) + (tid >> 2)); rv = *(const u32x4*)(vsrc + (rb + pV) * DM + h * 128 + 32 * es + 8 * (tid & 3)); } } while (0)
#define HG_WRITE(buf_) do { LAS float* bF = sIn + (buf_) * INB; LAS float* bQ = bF + 32 * 128; LAS float* bV = bQ + 32 * 128; \
        *(LAS f32x4*)(bF + (tid >> 5) * 128 + 4 * (tid & 31)) = rf0; *(LAS f32x4*)(bF + (16 + (tid >> 5)) * 128 + 4 * (tid & 31)) = rf1; \
        { LAS float* d = bQ + (tid >> 4) * 128 + 8 * (tid & 15); *(LAS f32x4*)d = (f32x4){bflo(rq.x), bfhi(rq.x), bflo(rq.y), bfhi(rq.y)}; *(LAS f32x4*)(d + 4) = (f32x4){bflo(rq.z), bfhi(rq.z), bflo(rq.w), bfhi(rq.w)}; } \
        if (tid < 128) { LAS float* d = bV + (tid >> 2) * 32 + 8 * (tid & 3); *(LAS f32x4*)d = (f32x4){bflo(rv.x), bfhi(rv.x), bflo(rv.y), bfhi(rv.y)}; *(LAS f32x4*)(d + 4) = (f32x4){bflo(rv.z), bfhi(rv.z), bflo(rv.w), bfhi(rv.w)}; } } while (0)
    __syncthreads();
    HG_ISSUE(0); HG_WRITE(0);
    __syncthreads();
    constexpr int NTB = SU / 32;
    for (int tb = 0; tb < NTB; ++tb) {
        const int s0 = 32 * tb, cur = tb & 1;
        if (tb + 1 < NTB) HG_ISSUE(s0 + 32);
        const LAS float* sF = sIn + cur * INB; const LAS float* sQ = sF + 32 * 128; const LAS float* sV = sQ + 32 * 128;
#pragma unroll 4
        for (int tt = 0; tt < 32; ++tt) {
            const f32x4 f0 = *(const LAS f32x4*)(sF + tt * 128 + 8 * dg), f1 = *(const LAS f32x4*)(sF + tt * 128 + 8 * dg + 4);
            const f32x4 q0 = *(const LAS f32x4*)(sQ + tt * 128 + 8 * dg), q1 = *(const LAS f32x4*)(sQ + tt * 128 + 8 * dg + 4);
            const float v = sV[tt * 32 + e];
            const float ff[8] = {f0.x, f0.y, f0.z, f0.w, f1.x, f1.y, f1.z, f1.w}; const float qq[8] = {q0.x, q0.y, q0.z, q0.w, q1.x, q1.y, q1.z, q1.w};
            float part = 0.f;
#pragma unroll
            for (int k = 0; k < 8; ++k) { S[k] = ff[k] * S[k] + (1.0f - ff[k]) * v; part += qq[k] * S[k]; }
            sP[(tt * 16 + dg) * 32 + e] = part;
        }
        __syncthreads();
#pragma unroll
        for (int i = 0; i < 2; ++i) { const int q = tid + 512 * i, tt = q >> 5, ee = q & 31; float o = 0.f;
#pragma unroll
            for (int k = 0; k < 16; ++k) o += sP[(tt * 16 + k) * 32 + ee];
            osrc[(rb + pos_of(s0 + tt)) * DM + h * 128 + 32 * es + ee] = o; }
        if (tb + 1 < NTB) HG_WRITE(cur ^ 1);
        __syncthreads();
    }
#undef HG_ISSUE
#undef HG_WRITE
}
__device__ __forceinline__ void hg_scan_item_c16(Frame& F, int item) {
    const int es = item & 3, dir = (item >> 2) & 1, h = (item >> 3) & 7, b = item >> 6;
    const int tid = ftid(), lane = tid & 63, w = F.wave, quad = lane >> 4, l15 = lane & 15;
    constexpr int INB = 32 * 128 * 2 + 32 * 32;
    LAS float* sIn = (LAS float*)F.lds;
    LAS bf16_t* QA = (LAS bf16_t*)(sIn + 2 * INB);
    LAS bf16_t* KB = QA + 2 * 16 * 136;
    LAS bf16_t* KC = KB + 2 * 16 * 136;
    LAS bf16_t* VT = KC + 2 * 128 * 40;
    LAS bf16_t* PP = VT + 2 * 32 * 40;
    LAS bf16_t* ST = PP + 2 * 16 * 40;
    LAS float* DEC = (LAS float*)(ST + 32 * 136);
    const float* fsrc = (const float*)(F.ws + (dir ? WS_FB : WS_FF));
    const bf16_t* qsrc = (const bf16_t*)(F.ws + WS_PQ); const bf16_t* vsrc = (const bf16_t*)(F.ws + WS_PI);
    float* osrc = (float*)(F.ws + (dir ? WS_OB : WS_OF));
    const size_t rb = (size_t)b * SU;
    f32x4 S[2] = {(f32x4){0.f, 0.f, 0.f, 0.f}, (f32x4){0.f, 0.f, 0.f, 0.f}};
    f32x4 rf0, rf1; u32x4 rq, rv;
    auto pos_of = [&](int s) { return dir ? (s < NCTX ? NCTX - 1 - s : SU + NCTX - 1 - s) : s; };
#define HG_ISSUE(s0_) do { const int pA = pos_of((s0_) + (tid >> 5)), pB = pos_of((s0_) + 16 + (tid >> 5)), pQ = pos_of((s0_) + (tid >> 4)); \
        rf0 = *(const f32x4*)(fsrc + (rb + pA) * DM + h * 128 + 4 * (tid & 31)); rf1 = *(const f32x4*)(fsrc + (rb + pB) * DM + h * 128 + 4 * (tid & 31)); \
        rq = *(const u32x4*)(qsrc + (rb + pQ) * DM + h * 128 + 8 * (tid & 15)); \
        if (tid < 128) { const int pV = pos_of((s0_) + (tid >> 2)); rv = *(const u32x4*)(vsrc + (rb + pV) * DM + h * 128 + 32 * es + 8 * (tid & 3)); } } while (0)
#define HG_WRITE(buf_) do { LAS float* bF = sIn + (buf_) * INB; LAS float* bQ = bF + 32 * 128; LAS float* bV = bQ + 32 * 128; \
        *(LAS f32x4*)(bF + (tid >> 5) * 128 + 4 * (tid & 31)) = rf0; *(LAS f32x4*)(bF + (16 + (tid >> 5)) * 128 + 4 * (tid & 31)) = rf1; \
        { LAS float* d = bQ + (tid >> 4) * 128 + 8 * (tid & 15); *(LAS f32x4*)d = (f32x4){bflo(rq.x), bfhi(rq.x), bflo(rq.y), bfhi(rq.y)}; *(LAS f32x4*)(d + 4) = (f32x4){bflo(rq.z), bfhi(rq.z), bflo(rq.w), bfhi(rq.w)}; } \
        if (tid < 128) { LAS float* d = bV + (tid >> 2) * 32 + 8 * (tid & 3); *(LAS f32x4*)d = (f32x4){bflo(rv.x), bfhi(rv.x), bflo(rv.y), bfhi(rv.y)}; *(LAS f32x4*)(d + 4) = (f32x4){bflo(rv.z), bfhi(rv.z), bflo(rv.w), bfhi(rv.w)}; } } while (0)
    __syncthreads();
    for (int i = tid; i < 2 * 128 * 40; i += 512) KC[i] = 0;
    for (int i = tid; i < 2 * 32 * 40; i += 512) VT[i] = 0;
    for (int i = tid; i < 2 * 16 * 40; i += 512) PP[i] = 0;
    for (int i = tid; i < 32 * 136; i += 512) ST[i] = 0;
    HG_ISSUE(0); HG_WRITE(0);
    __syncthreads();
    constexpr int NTB = SU / 32;
#define HG_BAR() do { asm volatile("s_waitcnt lgkmcnt(0)" ::: "memory"); __builtin_amdgcn_s_barrier(); asm volatile("" ::: "memory"); } while (0)
    for (int tb = 0; tb < NTB; ++tb) {
        const int s0 = 32 * tb, cur = tb & 1;
        if (tb + 1 < NTB) HG_ISSUE(s0 + 32);
        const LAS float* sF = sIn + cur * INB; const LAS float* sQ = sF + 32 * 128; const LAS float* sV = sQ + 32 * 128;
        if (tid < 256) {
            const int c = tid >> 7, d = tid & 127;
            float a = 0.f, kbv[16], fv[16], qv[16];
#pragma unroll
            for (int i = 0; i < 16; ++i) { fv[i] = sF[(16 * c + i) * 128 + d]; qv[i] = sQ[(16 * c + i) * 128 + d]; }
#pragma unroll
            for (int i = 0; i < 16; ++i) { const float f = fv[i], q = qv[i];
                a += __builtin_amdgcn_logf(f); const float ea = __builtin_amdgcn_exp2f(a);
                QA[(c * 16 + i) * 136 + d] = (bf16_t)f2bf(q * ea); kbv[i] = (1.0f - f) * __builtin_amdgcn_exp2f(-a); }
            const float al = __builtin_amdgcn_exp2f(a); DEC[c * 128 + d] = al;
            unsigned pk[8];
#pragma unroll
            for (int j = 0; j < 16; ++j) { KB[(c * 16 + j) * 136 + d] = (bf16_t)f2bf(kbv[j]); }
#pragma unroll
            for (int j = 0; j < 8; ++j) pk[j] = pk2(kbv[2 * j] * al, kbv[2 * j + 1] * al);
            LAS u32x4* kd = (LAS u32x4*)(KC + (c * 128 + d) * 40); kd[0] = (u32x4){pk[0], pk[1], pk[2], pk[3]}; kd[1] = (u32x4){pk[4], pk[5], pk[6], pk[7]};
        } else {
            const int idx = tid - 256, c = idx >> 7, e = (idx >> 2) & 31, jq = idx & 3;
            const float v0 = sV[(16 * c + 4 * jq + 0) * 32 + e], v1 = sV[(16 * c + 4 * jq + 1) * 32 + e], v2 = sV[(16 * c + 4 * jq + 2) * 32 + e], v3 = sV[(16 * c + 4 * jq + 3) * 32 + e];
            u32x2 o; o.x = pk2(v0, v1); o.y = pk2(v2, v3); *(LAS u32x2*)(VT + (c * 32 + e) * 40 + 4 * jq) = o;
        }
        HG_BAR();
        bf16x8 qa[4]; f32x4 oi[2] = {(f32x4){0.f, 0.f, 0.f, 0.f}, (f32x4){0.f, 0.f, 0.f, 0.f}};
        bf16x8 sb0[2][4];
        if (w < 2) {
            const int c = w;
            bf16x8 kbf[4], vbf[2];
#pragma unroll
            for (int ks = 0; ks < 4; ++ks) { qa[ks] = *(const LAS bf16x8*)(QA + (c * 16 + l15) * 136 + 32 * ks + 8 * quad); kbf[ks] = *(const LAS bf16x8*)(KB + (c * 16 + l15) * 136 + 32 * ks + 8 * quad); }
#pragma unroll
            for (int nt = 0; nt < 2; ++nt) vbf[nt] = *(const LAS bf16x8*)(VT + (c * 32 + 16 * nt + l15) * 40 + 8 * quad);
            if (c == 0) {
#pragma unroll
                for (int nt = 0; nt < 2; ++nt)
#pragma unroll
                    for (int ks = 0; ks < 4; ++ks) sb0[nt][ks] = *(const LAS bf16x8*)(ST + (16 * nt + l15) * 136 + 32 * ks + 8 * quad);
            }
            f32x4 sc = (f32x4){0.f, 0.f, 0.f, 0.f};
#pragma unroll
            for (int ks = 0; ks < 4; ++ks) sc = __builtin_amdgcn_mfma_f32_16x16x32_bf16(qa[ks], kbf[ks], sc, 0, 0, 0);
#pragma unroll
            for (int jj = 0; jj < 4; ++jj) { const int i = 4 * quad + jj; PP[(c * 16 + i) * 40 + l15] = (bf16_t)f2bf(l15 <= i ? sc[jj] : 0.f); }
            LDS_WAIT(); asm volatile("" ::: "memory");
            const bf16x8 pa = *(const LAS bf16x8*)(PP + (c * 16 + l15) * 40 + 8 * quad);
#pragma unroll
            for (int nt = 0; nt < 2; ++nt) oi[nt] = __builtin_amdgcn_mfma_f32_16x16x32_bf16(pa, vbf[nt], oi[nt], 0, 0, 0);
        }
#pragma unroll
        for (int c = 0; c < 2; ++c) {
            if (w == c) {
                if (c == 1) {
#pragma unroll
                    for (int nt = 0; nt < 2; ++nt)
#pragma unroll
                        for (int ks = 0; ks < 4; ++ks) sb0[nt][ks] = *(const LAS bf16x8*)(ST + (16 * nt + l15) * 136 + 32 * ks + 8 * quad);
                }
#pragma unroll
                for (int ks = 0; ks < 4; ++ks)
#pragma unroll
                    for (int nt = 0; nt < 2; ++nt) oi[nt] = __builtin_amdgcn_mfma_f32_16x16x32_bf16(qa[ks], sb0[nt][ks], oi[nt], 0, 0, 0);
#pragma unroll
                for (int jj = 0; jj < 4; ++jj) { const int pp = pos_of(s0 + 16 * c + 4 * quad + jj); float* op = osrc + (rb + pp) * DM + h * 128 + 32 * es + l15; op[0] = oi[0][jj]; op[16] = oi[1][jj]; }
            }
            {
                const f32x4 dc = *(const LAS f32x4*)(DEC + c * 128 + 16 * w + 4 * quad);
                const bf16x8 ka = *(const LAS bf16x8*)(KC + (c * 128 + 16 * w + l15) * 40 + 8 * quad);
#pragma unroll
                for (int nt = 0; nt < 2; ++nt) { const bf16x8 vb = *(const LAS bf16x8*)(VT + (c * 32 + 16 * nt + l15) * 40 + 8 * quad); S[nt] = S[nt] * dc; S[nt] = __builtin_amdgcn_mfma_f32_16x16x32_bf16(ka, vb, S[nt], 0, 0, 0); }
            }
            HG_BAR();
#pragma unroll
            for (int nt = 0; nt < 2; ++nt)
#pragma unroll
                for (int jj = 0; jj < 4; ++jj) ST[(16 * nt + l15) * 136 + 16 * w + 4 * quad + jj] = (bf16_t)f2bf(S[nt][jj]);
            if (c == 1 && tb + 1 < NTB) HG_WRITE(cur ^ 1);
            HG_BAR();
        }
    }
#undef HG_ISSUE
#undef HG_WRITE
#undef HG_BAR
}
__device__ __forceinline__ void hg_scan_item_c32(Frame& F, int item) {
    const int es = item & 3, dir = (item >> 2) & 1, h = (item >> 3) & 7, b = item >> 6;
    const int tid = ftid(), lane = tid & 63, w = F.wave, quad = lane >> 4, l15 = lane & 15;
    constexpr int INB = 32 * 128 * 2 + 32 * 32;
    LAS float* sIn = (LAS float*)F.lds;
    LAS bf16_t* QA = (LAS bf16_t*)(sIn + 2 * INB);
    LAS bf16_t* KB = QA + 32 * 136;
    LAS bf16_t* KC = KB + 32 * 136;
    LAS bf16_t* VT = KC + 128 * 40;
    LAS bf16_t* PP = VT + 32 * 40;
    LAS bf16_t* ST = PP + 32 * 40;
    LAS float* DEC = (LAS float*)(ST + 32 * 136);
    const float* fsrc = (const float*)(F.ws + (dir ? WS_FB : WS_FF));
    const bf16_t* qsrc = (const bf16_t*)(F.ws + WS_PQ); const bf16_t* vsrc = (const bf16_t*)(F.ws + WS_PI);
    float* osrc = (float*)(F.ws + (dir ? WS_OB : WS_OF));
    const size_t rb = (size_t)b * SU;
    f32x4 S[2] = {(f32x4){0.f, 0.f, 0.f, 0.f}, (f32x4){0.f, 0.f, 0.f, 0.f}};
    f32x4 rf0A, rf1A, rf0B, rf1B; u32x4 rqA, rvA, rqB, rvB;
    auto pos_of = [&](int s) { return dir ? (s < NCTX ? NCTX - 1 - s : SU + NCTX - 1 - s) : s; };
#define HG_ISSUE(rf0, rf1, rq, rv, s0_) do { const int pA = pos_of((s0_) + (tid >> 5)), pB = pos_of((s0_) + 16 + (tid >> 5)), pQ = pos_of((s0_) + (tid >> 4)); \
        rf0 = *(const f32x4*)(fsrc + (rb + pA) * DM + h * 128 + 4 * (tid & 31)); rf1 = *(const f32x4*)(fsrc + (rb + pB) * DM + h * 128 + 4 * (tid & 31)); \
        rq = *(const u32x4*)(qsrc + (rb + pQ) * DM + h * 128 + 8 * (tid & 15)); \
        if (tid < 128) { const int pV = pos_of((s0_) + (tid >> 2)); rv = *(const u32x4*)(vsrc + (rb + pV) * DM + h * 128 + 32 * es + 8 * (tid & 3)); } } while (0)
#define HG_WRITE(rf0, rf1, rq, rv, buf_) do { LAS float* bF = sIn + (buf_) * INB; LAS float* bQ = bF + 32 * 128; LAS float* bV = bQ + 32 * 128; \
        *(LAS f32x4*)(bF + (tid >> 5) * 128 + 4 * (tid & 31)) = rf0; *(LAS f32x4*)(bF + (16 + (tid >> 5)) * 128 + 4 * (tid & 31)) = rf1; \
        { LAS float* d = bQ + (tid >> 4) * 128 + 8 * (tid & 15); *(LAS f32x4*)d = (f32x4){bflo(rq.x), bfhi(rq.x), bflo(rq.y), bfhi(rq.y)}; *(LAS f32x4*)(d + 4) = (f32x4){bflo(rq.z), bfhi(rq.z), bflo(rq.w), bfhi(rq.w)}; } \
        if (tid < 128) { LAS float* d = bV + (tid >> 2) * 32 + 8 * (tid & 3); *(LAS f32x4*)d = (f32x4){bflo(rv.x), bfhi(rv.x), bflo(rv.y), bfhi(rv.y)}; *(LAS f32x4*)(d + 4) = (f32x4){bflo(rv.z), bfhi(rv.z), bflo(rv.w), bfhi(rv.w)}; } } while (0)
#define HG_BAR() do { asm volatile("s_waitcnt lgkmcnt(0)" ::: "memory"); __builtin_amdgcn_s_barrier(); asm volatile("" ::: "memory"); } while (0)
    __syncthreads();
    for (int i = tid; i < 32 * 136; i += 512) ST[i] = 0;
    HG_ISSUE(rf0A, rf1A, rqA, rvA, 0); HG_WRITE(rf0A, rf1A, rqA, rvA, 0);
    HG_ISSUE(rf0B, rf1B, rqB, rvB, 32);
    __syncthreads();
    constexpr int NTB = SU / 32;
    auto blk = [&](const int tb, const int cur) __attribute__((always_inline)) {
        const int s0 = 32 * tb;
        const LAS float* sF = sIn + cur * INB; const LAS float* sQ = sF + 32 * 128; const LAS float* sV = sQ + 32 * 128;
        if (tid < 256) {
            const int c = tid & 1, d = tid >> 1;
            float fv[16], qv[16], kbv[16];
#pragma unroll
            for (int i = 0; i < 16; ++i) { fv[i] = sF[(16 * c + i) * 128 + d]; qv[i] = sQ[(16 * c + i) * 128 + d]; }
            float tot = 1.f;
#pragma unroll
            for (int i = 0; i < 16; ++i) tot *= fv[i];
            const float oth = shx(tot, 1, lane);
            float ea = c ? oth : 1.f;
            float eia = __builtin_amdgcn_rcpf(ea);
            const float al = tot * oth;
#pragma unroll
            for (int i = 0; i < 16; ++i) { const float fo = fv[i]; ea *= fo; eia *= __builtin_amdgcn_rcpf(fo);
                QA[(16 * c + i) * 136 + d] = (bf16_t)f2bf(qv[i] * ea); kbv[i] = (1.0f - fo) * eia; }
            if (c == 0) DEC[d] = al;
            unsigned pk[8];
#pragma unroll
            for (int j = 0; j < 16; ++j) KB[(16 * c + j) * 136 + d] = (bf16_t)f2bf(kbv[j]);
#pragma unroll
            for (int j = 0; j < 8; ++j) pk[j] = pk2(kbv[2 * j] * al, kbv[2 * j + 1] * al);
            LAS u32x4* kd = (LAS u32x4*)(KC + d * 40 + 16 * c); kd[0] = (u32x4){pk[0], pk[1], pk[2], pk[3]}; kd[1] = (u32x4){pk[4], pk[5], pk[6], pk[7]};
        } else {
            const int idx = tid - 256, e = idx >> 3, jq = idx & 7;
            const float v0 = sV[(4 * jq + 0) * 32 + e], v1 = sV[(4 * jq + 1) * 32 + e], v2 = sV[(4 * jq + 2) * 32 + e], v3 = sV[(4 * jq + 3) * 32 + e];
            u32x2 o; o.x = pk2(v0, v1); o.y = pk2(v2, v3); *(LAS u32x2*)(VT + e * 40 + 4 * jq) = o;
        }
        HG_BAR();
        if (w < 2) {
            const int it = w;
            bf16x8 qa[4], kbf[2][4], vbf[2], sbf[2][4];
#pragma unroll
            for (int ks = 0; ks < 4; ++ks) { qa[ks] = *(const LAS bf16x8*)(QA + (16 * it + l15) * 136 + 32 * ks + 8 * quad);
                kbf[0][ks] = *(const LAS bf16x8*)(KB + (l15) * 136 + 32 * ks + 8 * quad); kbf[1][ks] = *(const LAS bf16x8*)(KB + (16 + l15) * 136 + 32 * ks + 8 * quad); }
#pragma unroll
            for (int nt = 0; nt < 2; ++nt) { vbf[nt] = *(const LAS bf16x8*)(VT + (16 * nt + l15) * 40 + 8 * quad);
#pragma unroll
                for (int ks = 0; ks < 4; ++ks) sbf[nt][ks] = *(const LAS bf16x8*)(ST + (16 * nt + l15) * 136 + 32 * ks + 8 * quad); }
            f32x4 sc0 = (f32x4){0.f, 0.f, 0.f, 0.f}, sc1 = (f32x4){0.f, 0.f, 0.f, 0.f};
#pragma unroll
            for (int ks = 0; ks < 4; ++ks) { sc0 = __builtin_amdgcn_mfma_f32_16x16x32_bf16(qa[ks], kbf[0][ks], sc0, 0, 0, 0); sc1 = __builtin_amdgcn_mfma_f32_16x16x32_bf16(qa[ks], kbf[1][ks], sc1, 0, 0, 0); }
#pragma unroll
            for (int jj = 0; jj < 4; ++jj) { const int i = 16 * it + 4 * quad + jj;
                PP[i * 40 + l15] = (bf16_t)f2bf(l15 <= i ? sc0[jj] : 0.f); PP[i * 40 + 16 + l15] = (bf16_t)f2bf(16 + l15 <= i ? sc1[jj] : 0.f); }
            LDS_WAIT(); asm volatile("" ::: "memory");
            const bf16x8 pa = *(const LAS bf16x8*)(PP + (16 * it + l15) * 40 + 8 * quad);
            f32x4 oi[2];
#pragma unroll
            for (int nt = 0; nt < 2; ++nt) { oi[nt] = __builtin_amdgcn_mfma_f32_16x16x32_bf16(pa, vbf[nt], (f32x4){0.f, 0.f, 0.f, 0.f}, 0, 0, 0);
#pragma unroll
                for (int ks = 0; ks < 4; ++ks) oi[nt] = __builtin_amdgcn_mfma_f32_16x16x32_bf16(qa[ks], sbf[nt][ks], oi[nt], 0, 0, 0); }
#pragma unroll
            for (int jj = 0; jj < 4; ++jj) { const int pp = pos_of(s0 + 16 * it + 4 * quad + jj); float* op = osrc + (rb + pp) * DM + h * 128 + 32 * es + l15; op[0] = oi[0][jj]; op[16] = oi[1][jj]; }
        }
        {
            const f32x4 dc = *(const LAS f32x4*)(DEC + 16 * w + 4 * quad);
            const bf16x8 ka = *(const LAS bf16x8*)(KC + (16 * w + l15) * 40 + 8 * quad);
#pragma unroll
            for (int nt = 0; nt < 2; ++nt) { const bf16x8 vb = *(const LAS bf16x8*)(VT + (16 * nt + l15) * 40 + 8 * quad); S[nt] = S[nt] * dc; S[nt] = __builtin_amdgcn_mfma_f32_16x16x32_bf16(ka, vb, S[nt], 0, 0, 0); }
        }
        HG_BAR();
#pragma unroll
        for (int nt = 0; nt < 2; ++nt)
#pragma unroll
            for (int jj = 0; jj < 4; ++jj) ST[(16 * nt + l15) * 136 + 16 * w + 4 * quad + jj] = (bf16_t)f2bf(S[nt][jj]);
    };
    for (int tb = 0; tb < NTB; tb += 2) {
        { const int nb = tb + 2 < NTB ? tb + 2 : NTB - 1; HG_ISSUE(rf0A, rf1A, rqA, rvA, 32 * nb); }
        blk(tb, 0);
        HG_WRITE(rf0B, rf1B, rqB, rvB, 1);
        HG_BAR();
        { const int nb = tb + 3 < NTB ? tb + 3 : NTB - 1; HG_ISSUE(rf0B, rf1B, rqB, rvB, 32 * nb); }
        blk(tb + 1, 1);
        HG_WRITE(rf0A, rf1A, rqA, rvA, 0);
        HG_BAR();
    }
#undef HG_ISSUE
#undef HG_WRITE
#undef HG_BAR
}
__device__ __forceinline__ void hg_scan_item(Frame& F, int item) {
    const int es = item & 3, dir = (item >> 2) & 1, h = (item >> 3) & 7, b = item >> 6;
    const int tid = ftid(), lane = tid & 63, w = F.wave, quad = lane >> 4, l15 = lane & 15;
    constexpr int INB = 32 * 128 * 2 + 32 * 32;
    LAS float* sIn = (LAS float*)F.lds;
    LAS bf16_t* QA = (LAS bf16_t*)(sIn + 2 * INB);
    LAS bf16_t* KB = QA + 2 * 32 * 136;
    LAS bf16_t* KC = KB + 32 * 136;
    LAS bf16_t* VT = KC + 2 * 128 * 40;
    LAS bf16_t* PP = VT + 2 * 32 * 40;
    LAS bf16_t* ST = PP + 2 * 32 * 40;
    LAS float* DEC = (LAS float*)(ST + 2 * 32 * 136);
    const float* fsrc = (const float*)(F.ws + (dir ? WS_FB : WS_FF));
    const bf16_t* qsrc = (const bf16_t*)(F.ws + WS_PQ); const bf16_t* vsrc = (const bf16_t*)(F.ws + WS_PI);
    float* osrc = (float*)(F.ws + (dir ? WS_OB : WS_OF));
    const size_t rb = (size_t)b * SU;
    auto pos_of = [&](int s) { return dir ? (s < NCTX ? NCTX - 1 - s : SU + NCTX - 1 - s) : s; };
    constexpr int NTB = SU / 32;
#define HG_BAR() do { asm volatile("s_waitcnt lgkmcnt(0)" ::: "memory"); __builtin_amdgcn_s_barrier(); asm volatile("" ::: "memory"); } while (0)
    f32x4 rf[4]; u32x4 rq[2], rv;
#define HG_ISSUE(s0_) do { \
        _Pragma("unroll") for (int r_ = 0; r_ < 4; ++r_) rf[r_] = *(const f32x4*)(fsrc + (rb + pos_of((s0_) + (tid >> 5) + 8 * r_)) * DM + h * 128 + 4 * (tid & 31)); \
        _Pragma("unroll") for (int r_ = 0; r_ < 2; ++r_) rq[r_] = *(const u32x4*)(qsrc + (rb + pos_of((s0_) + (tid >> 4) + 16 * r_)) * DM + h * 128 + 8 * (tid & 15)); \
        if (tid < 128) rv = *(const u32x4*)(vsrc + (rb + pos_of((s0_) + (tid >> 2))) * DM + h * 128 + 32 * es + 8 * (tid & 3)); } while (0)
#define HG_WRITE(buf_) do { LAS float* bF = sIn + (buf_) * INB; LAS float* bQ = bF + 32 * 128; LAS float* bV = bQ + 32 * 128; \
        _Pragma("unroll") for (int r_ = 0; r_ < 4; ++r_) *(LAS f32x4*)(bF + ((tid >> 5) + 8 * r_) * 128 + 4 * (tid & 31)) = rf[r_]; \
        _Pragma("unroll") for (int r_ = 0; r_ < 2; ++r_) { LAS float* d = bQ + ((tid >> 4) + 16 * r_) * 128 + 8 * (tid & 15); *(LAS f32x4*)d = (f32x4){bflo(rq[r_].x), bfhi(rq[r_].x), bflo(rq[r_].y), bfhi(rq[r_].y)}; *(LAS f32x4*)(d + 4) = (f32x4){bflo(rq[r_].z), bfhi(rq[r_].z), bflo(rq[r_].w), bfhi(rq[r_].w)}; } \
        if (tid < 128) { LAS float* d = bV + (tid >> 2) * 32 + 8 * (tid & 3); *(LAS f32x4*)d = (f32x4){bflo(rv.x), bfhi(rv.x), bflo(rv.y), bfhi(rv.y)}; *(LAS f32x4*)(d + 4) = (f32x4){bflo(rv.z), bfhi(rv.z), bflo(rv.w), bfhi(rv.w)}; } } while (0)
    f32x4 S[2][2];
#pragma unroll
    for (int a = 0; a < 2; ++a)
#pragma unroll
        for (int c2 = 0; c2 < 2; ++c2) S[a][c2] = (f32x4){0.f, 0.f, 0.f, 0.f};
    __syncthreads();
    for (int i = tid; i < 2 * 32 * 136; i += 512) ST[i] = 0;
    if (w < 4) { HG_ISSUE(0); HG_WRITE(0); HG_ISSUE(32); }
    __syncthreads();
    for (int j = 0; j <= NTB; ++j) {
        const int sp = j & 1;
        const int t = j - 1, sc_ = t & 1;
        f32x4 oi = (f32x4){0.f, 0.f, 0.f, 0.f};
        if (w < 4) {
            if (j < NTB) {
                const LAS float* sF = sIn + sp * INB; const LAS float* sQ = sF + 32 * 128; const LAS float* sV = sQ + 32 * 128;
                const int cq = w, dp = lane;
                f32x2 fv[32], qv[8];
#pragma unroll
                for (int i = 0; i < 32; ++i) fv[i] = *(const LAS f32x2*)(sF + i * 128 + 2 * dp);
                f32x2 fq[8];
#pragma unroll
                for (int i = 0; i < 8; ++i) { qv[i] = *(const LAS f32x2*)(sQ + (8 * cq + i) * 128 + 2 * dp); fq[i] = *(const LAS f32x2*)(sF + (8 * cq + i) * 128 + 2 * dp); }
                const int e = tid >> 3, jq = tid & 7;
                const float v0 = sV[(4 * jq + 0) * 32 + e], v1 = sV[(4 * jq + 1) * 32 + e], v2 = sV[(4 * jq + 2) * 32 + e], v3 = sV[(4 * jq + 3) * 32 + e];
                f32x2 qp[4];
#pragma unroll
                for (int c4 = 0; c4 < 4; ++c4) { f32x2 pr = fv[8 * c4];
#pragma unroll
                    for (int i = 1; i < 8; ++i) pr = pr * fv[8 * c4 + i]; qp[c4] = pr; }
                f32x2 ea = (f32x2){1.f, 1.f};
#pragma unroll
                for (int c4 = 0; c4 < 3; ++c4) { if (c4 < cq) ea = ea * qp[c4]; }
                const f32x2 al = (qp[0] * qp[1]) * (qp[2] * qp[3]);
                f32x2 eia; eia.x = __builtin_amdgcn_rcpf(ea.x); eia.y = __builtin_amdgcn_rcpf(ea.y);
                LAS bf16_t* qa_ = QA + sp * 32 * 136;
                f32x2 kbv[8];
#pragma unroll
                for (int i = 0; i < 8; ++i) { const f32x2 fo = fq[i];
                    ea = ea * fo; f32x2 rf_; rf_.x = __builtin_amdgcn_rcpf(fo.x); rf_.y = __builtin_amdgcn_rcpf(fo.y); eia = eia * rf_;
                    const f32x2 qa2 = qv[i] * ea; kbv[i] = ((f32x2){1.f, 1.f} - fo) * eia;
                    *(LAS unsigned*)(qa_ + (8 * cq + i) * 136 + 2 * dp) = pk2(qa2.x, qa2.y);
                    *(LAS unsigned*)(KB + (8 * cq + i) * 136 + 2 * dp) = pk2(kbv[i].x, kbv[i].y); }
                if (cq == 0) *(LAS f32x2*)(DEC + sp * 128 + 2 * dp) = al;
                u32x4 k0, k1;
                k0.x = pk2(kbv[0].x * al.x, kbv[1].x * al.x); k0.y = pk2(kbv[2].x * al.x, kbv[3].x * al.x); k0.z = pk2(kbv[4].x * al.x, kbv[5].x * al.x); k0.w = pk2(kbv[6].x * al.x, kbv[7].x * al.x);
                k1.x = pk2(kbv[0].y * al.y, kbv[1].y * al.y); k1.y = pk2(kbv[2].y * al.y, kbv[3].y * al.y); k1.z = pk2(kbv[4].y * al.y, kbv[5].y * al.y); k1.w = pk2(kbv[6].y * al.y, kbv[7].y * al.y);
                *(LAS u32x4*)(KC + (sp * 128 + 2 * dp) * 40 + 8 * cq) = k0; *(LAS u32x4*)(KC + (sp * 128 + 2 * dp + 1) * 40 + 8 * cq) = k1;
                u32x2 o; o.x = pk2(v0, v1); o.y = pk2(v2, v3); *(LAS u32x2*)(VT + (sp * 32 + e) * 40 + 4 * jq) = o;
            }
        } else if (t >= 0) {
            const int k = w - 4, it = k >> 1, nt = k & 1;
            const bf16x8 pa = *(const LAS bf16x8*)(PP + (sc_ * 32 + 16 * it + l15) * 40 + 8 * quad);
            const bf16x8 vb = *(const LAS bf16x8*)(VT + (sc_ * 32 + 16 * nt + l15) * 40 + 8 * quad);
            bf16x8 qa[4], sb[4];
#pragma unroll
            for (int ks = 0; ks < 4; ++ks) { qa[ks] = *(const LAS bf16x8*)(QA + (sc_ * 32 + 16 * it + l15) * 136 + 32 * ks + 8 * quad); sb[ks] = *(const LAS bf16x8*)(ST + (sc_ * 32 + 16 * nt + l15) * 136 + 32 * ks + 8 * quad); }
            oi = __builtin_amdgcn_mfma_f32_16x16x32_bf16(pa, vb, oi, 0, 0, 0);
#pragma unroll
            for (int ks = 0; ks < 4; ++ks) oi = __builtin_amdgcn_mfma_f32_16x16x32_bf16(qa[ks], sb[ks], oi, 0, 0, 0);
#pragma unroll
            for (int jj = 0; jj < 4; ++jj) { const int pp = pos_of(32 * t + 16 * it + 4 * quad + jj); osrc[(rb + pp) * DM + h * 128 + 32 * es + 16 * nt + l15] = oi[jj]; }
        }
        HG_BAR();
        if (w >= 4) {
            if (t >= 0) {
            const int k = w - 4;
#pragma unroll
            for (int mt = 0; mt < 2; ++mt) {
                const f32x4 dc = *(const LAS f32x4*)(DEC + sc_ * 128 + 32 * k + 16 * mt + 4 * quad);
                const bf16x8 ka = *(const LAS bf16x8*)(KC + (sc_ * 128 + 32 * k + 16 * mt + l15) * 40 + 8 * quad);
#pragma unroll
                for (int n2 = 0; n2 < 2; ++n2) { const bf16x8 vb2 = *(const LAS bf16x8*)(VT + (sc_ * 32 + 16 * n2 + l15) * 40 + 8 * quad); S[mt][n2] = S[mt][n2] * dc; S[mt][n2] = __builtin_amdgcn_mfma_f32_16x16x32_bf16(ka, vb2, S[mt][n2], 0, 0, 0); }
            }
            LAS bf16_t* stn = ST + (sc_ ^ 1) * 32 * 136;
#pragma unroll
            for (int mt = 0; mt < 2; ++mt)
#pragma unroll
                for (int n2 = 0; n2 < 2; ++n2)
                    { u32x2 o2; o2.x = pk2(S[mt][n2][0], S[mt][n2][1]); o2.y = pk2(S[mt][n2][2], S[mt][n2][3]); *(LAS u32x2*)(stn + (16 * n2 + l15) * 136 + 32 * k + 16 * mt + 4 * quad) = o2; }
            }
            if (j < NTB) {
                const int k = w - 4, it = k >> 1, jt = k & 1;
                f32x4 sc0 = (f32x4){0.f, 0.f, 0.f, 0.f};
                if (k != 1) {
                    bf16x8 qa[4], kbf[4];
#pragma unroll
                    for (int ks = 0; ks < 4; ++ks) { qa[ks] = *(const LAS bf16x8*)(QA + (sp * 32 + 16 * it + l15) * 136 + 32 * ks + 8 * quad);
                        kbf[ks] = *(const LAS bf16x8*)(KB + (16 * jt + l15) * 136 + 32 * ks + 8 * quad); }
#pragma unroll
                    for (int ks = 0; ks < 4; ++ks) sc0 = __builtin_amdgcn_mfma_f32_16x16x32_bf16(qa[ks], kbf[ks], sc0, 0, 0, 0);
                }
#pragma unroll
                for (int jj = 0; jj < 4; ++jj) { const int i = 16 * it + 4 * quad + jj;
                    PP[(sp * 32 + i) * 40 + 16 * jt + l15] = (bf16_t)f2bf(16 * jt + l15 <= i ? sc0[jj] : 0.f); }
            }
        }
        if (w < 4 && j + 1 < NTB) { HG_WRITE((j + 1) & 1); if (j + 2 < NTB) HG_ISSUE(32 * (j + 2)); }
        HG_BAR();
    }
#undef HG_ISSUE
#undef HG_WRITE
#undef HG_BAR
}
__device__ __forceinline__ void naive_hg_scan(Frame& F) {
    const int gt = fbid() * 512 + ftid();
    if (gt >= NB * 8 * 2 * 128) return;
    const int e = gt & 127, dir = (gt >> 7) & 1, h = (gt >> 8) & 7, b = gt >> 11;
    const float* fsrc = (const float*)(F.ws + (dir ? WS_FB : WS_FF));
    const bf16_t* qsrc = (const bf16_t*)(F.ws + WS_PQ); const bf16_t* vsrc = (const bf16_t*)(F.ws + WS_PI);
    float* osrc = (float*)(F.ws + (dir ? WS_OB : WS_OF));
    float S[128];
#pragma unroll
    for (int d = 0; d < 128; ++d) S[d] = 0.f;
    for (int s_ = 0; s_ < SU; ++s_) {
        const int pp = dir ? (s_ < NCTX ? NCTX - 1 - s_ : SU + NCTX - 1 - s_) : s_;
        const size_t row = (size_t)b * SU + pp;
        const float v = bf2f(vsrc[row * DM + h * 128 + e]);
        const float* fr = fsrc + row * DM + h * 128; const bf16_t* qr = qsrc + row * DM + h * 128;
        float o = 0.f;
#pragma unroll
        for (int d = 0; d < 128; ++d) { const float f = fr[d]; S[d] = f * S[d] + (1.0f - f) * v; o += bf2f(qr[d]) * S[d]; }
        osrc[row * DM + h * 128 + e] = o;
    }
}
__device__ __forceinline__ void naive_hg_readout(Frame& F, const Args& args, int p) {
    for (int i = fbid() * 512 + ftid(); i < MTOK * 8; i += F.G * 512) {
        const int row = i >> 3, h = i & 7;
        const float* a = (const float*)(F.ws + WS_OF) + (size_t)row * DM + h * 128; const float* c = (const float*)(F.ws + WS_OB) + (size_t)row * DM + h * 128;
        float ss = 0.f;
        for (int d = 0; d < 128; ++d) { const float o = a[d] + c[d]; ss += o * o; }
        const float rstd = 1.0f / sqrtf(ss / 128.f + EPS);
        const bf16_t* g = (const bf16_t*)(F.ws + WS_PG) + (size_t)row * DM + h * 128; bf16_t* y = (bf16_t*)(F.ws + WS_YB16) + (size_t)row * DM + h * 128;
        for (int d = 0; d < 128; ++d) { const float o = a[d] + c[d]; const float gv = bf2f(g[d]); y[d] = (bf16_t)f2bf(o * rstd * args.in[I_HGNW][p * 128 + d] * (gv / (1.0f + expf(-gv)))); }
    }
}
__device__ __forceinline__ void hg_readout_phase(Frame& F, const Args& args, int p) {
    const int gw = F.vcu * NWAVES + F.wave, NGW = F.G * NWAVES, lane = flane();
    const float* nw = ((const float*)(F.ws + WS_SP) + SP_HGNW) + p * 128 + 16 * (lane & 7);
    for (int row = gw; row < MTOK; row += NGW) {
        const f32x4* a = (const f32x4*)(F.ws + WS_OF + (size_t)row * DM * 4) + 4 * lane; const f32x4* c = (const f32x4*)(F.ws + WS_OB + (size_t)row * DM * 4) + 4 * lane;
        f32x4 o[4]; float ss = 0.f;
#pragma unroll
        for (int j = 0; j < 4; ++j) { o[j] = ABL_HGB0 ? a[j] : a[j] + c[j]; ss += (o[j].x * o[j].x + o[j].y * o[j].y) + (o[j].z * o[j].z + o[j].w * o[j].w); }
        ss += shx(ss, 1, lane); ss += shx(ss, 2, lane); ss += shx(ss, 4, lane);
        const float rstd = 1.0f / sqrtf(ss * (1.0f / 128.f) + EPS);
        const u32x4* gp = (const u32x4*)(F.ws + WS_PG + (size_t)row * DM * 2) + 2 * lane;
        const u32x4 g0 = gp[0], g1 = gp[1]; const unsigned gwv[8] = {g0.x, g0.y, g0.z, g0.w, g1.x, g1.y, g1.z, g1.w};
        unsigned outw[8];
#pragma unroll
        for (int j = 0; j < 4; ++j) { const f32x4 wv = *(const f32x4*)(nw + 4 * j);
            const float y0 = o[j].x * rstd * wv.x * siluf(bflo(gwv[2 * j])), y1 = o[j].y * rstd * wv.y * siluf(bfhi(gwv[2 * j]));
            const float y2 = o[j].z * rstd * wv.z * siluf(bflo(gwv[2 * j + 1])), y3 = o[j].w * rstd * wv.w * siluf(bfhi(gwv[2 * j + 1]));
            outw[2 * j] = pk2(y0, y1); outw[2 * j + 1] = pk2(y2, y3); }
        u32x4* op = (u32x4*)(F.ws + WS_YB16 + (size_t)row * DM * 2) + 2 * lane;
        op[0] = (u32x4){outw[0], outw[1], outw[2], outw[3]}; op[1] = (u32x4){outw[4], outw[5], outw[6], outw[7]};
    }
}

constexpr int NPHASE = 2 + 9 * DEPTH;
constexpr unsigned KM_ALL = 0x7ffu | (3u << 16);
template <unsigned KM>
__device__ __forceinline__ void mk_body(const Args& args, unsigned char* lds_raw) {
    Frame F;
    F.lds = (LAS unsigned char*)lds_raw;
    F.MISC = (volatile LAS unsigned*)(F.lds + MISC_OFF);
    F.wave = __builtin_amdgcn_readfirstlane(ftid() >> 6);
    F.G = gridDim.x; { const int bx = blockIdx.x; F.vcu = (F.G % 8 == 0) ? (bx % 8) * (F.G / 8) + bx / 8 : bx; }
    F.ws = args.ws; F.ctl = (unsigned*)(args.ws + WS_CTL);
    for (int u = ftid(); u < (LDS_BYTES - LDSCTL_OFF) / 4; u += NWAVES * 64) ((LAS unsigned*)(F.lds + LDSCTL_OFF))[u] = 0u;
    __syncthreads();
    XcdBarrier bar; bar.bar = F.ctl + CW_BAR; bar.x = 0; bar.st = nullptr;
    const int lo = args.ph_lo, hi = args.ph_hi;
    if (hi - lo > 1) bar = xcd_barrier_post(F.ctl + CW_BAR, F.MISC + 8);
#define HAS(kind) ((KM >> (kind)) & 1u)
    if constexpr (HAS(0)) { if (lo == 0) { p0_prologue(F, args); if (NAIVE_MOD) { __syncthreads(); naive_mod(F, args); } if (hi > 1) xcd_barrier(bar); } }
    float* const outp = args.out;
#pragma nounroll
    for (int ph = (lo == 0 ? 1 : lo); ph < hi; ++ph) {
        const Args* ap = &args;
        { unsigned char* w_ = args.ws; asm volatile("" : "+s"(w_)); F.ws = w_; F.ctl = (unsigned*)(w_ + WS_CTL); }
        { int wv_ = __builtin_amdgcn_readfirstlane(ftid() >> 6); F.wave = wv_; int g_ = (int)gridDim.x; asm volatile("" : "+s"(g_)); F.G = g_; const int bx = fbid(); F.vcu = (g_ % 8 == 0) ? (bx % 8) * (g_ / 8) + bx / 8 : bx; }
        const float* mod = (const float*)(F.ws + WS_MOD);
        const int kind = (ph == 0) ? 0 : (ph == NPHASE - 1 ? 10 : 1 + (ph - 1) % 9);
        const int l = (ph - 1) / 9; const int odd = l & 1, p = l >> 1;
        if (kind == 5 && odd) continue;
        switch (kind) {
        case 1: if constexpr (HAS(1)) { if (NAIVE_N1 == 1) naive_n1(F, *ap, l, false); else if (NAIVE_N1 == 2) wave_n1(F, *ap, l, false); else n1_phase<false>(F, *ap, l); } break;
        case 2: if constexpr (HAS(2)) {
            const int N = odd ? OD_N : EV_N;
            if (NAIVE_G1) { naive_g1(F, *ap, l); } else {
            pg8::PlainAddr AD{(const bf16_t*)(F.ws + WS_HB), (const bf16_t*)(F.ws + (odd ? WS_W_ODIN + (size_t)p * 10 * MiB : WS_W_EVIN + (size_t)p * 6 * MiB)), DM};
            pg8::StaticOrder S; S.init(MTOK, N, F.G, fbid());
            EpiProj E{F.ws, (const float*)(F.ws + WS_LB) + l * DM, odd};
            pg8::gemm_phase(F.lds, AD, S, E, DM);
            } } break;
        case 3: if constexpr (HAS(3)) {
            if (!odd) {
                if constexpr (HAS(16)) {
                    for (int it = fbid(); it < NB * 4 * NCHUNK + (NAIVE_ATT ? 0 : NB * 2 * NCHUNK); it += F.G) {
                        if (it < NB * 4 * NCHUNK) ret_state_item(F, *ap, p, it); else att_item(F, *ap, p, it - NB * 4 * NCHUNK);
                    }
                    if (NAIVE_ATT) { __syncthreads(); naive_att(F, *ap, p); }
                }
            } else {
                if constexpr (HAS(17)) { if (NAIVE_HG) naive_hg_scan(F); else for (int it = fbid(); it < NB * 8 * 2 * 4; it += F.G) hg_scan_item(F, it); }
            }
            __syncthreads(); } break;
        case 4: if constexpr (HAS(4)) {
            if (!odd) { if constexpr (HAS(16)) ret_scan_phase(F, *ap, p); } else { if constexpr (HAS(17)) { if (NAIVE_HG) naive_hg_readout(F, *ap, p); else hg_readout_phase(F, *ap, p); } } } break;
        case 5: if constexpr (HAS(5)) { for (int it = fbid(); it < NB * 4 * NCHUNK; it += F.G) { if (RET_DIRECT) ret_direct_item(F, *ap, p, it); else ret_out_item(F, *ap, p, it); } __syncthreads(); } break;
        case 6: if constexpr (HAS(6)) {
            if (NAIVE_G2) { if (odd ? CONTRIB_ODD : CONTRIB_EVEN) naive_g2(F, *ap, l); } else {
            pg8::PlainAddr AD{(const bf16_t*)(F.ws + WS_YB16), (const bf16_t*)(F.ws + (odd ? WS_W_ODOUT : WS_W_EVOUT) + (size_t)p * 2 * MiB), DM};
            pg8::StaticOrder S; S.init(MTOK, DM, F.G, fbid());
            EpiOut E{(float*)(F.ws + WS_XRES), mod + (size_t)l * 5 * 6144, odd ? CONTRIB_ODD : CONTRIB_EVEN};
            pg8::gemm_phase(F.lds, AD, S, E, DM);
            } } break;
        case 7: if constexpr (HAS(7)) { if (NAIVE_N2R) naive_n2r(F, *ap, l); else n2r_phase(F, *ap, l); } break;
        case 8: case 9: if constexpr (HAS(8) || HAS(9)) {
            LAS int* tstart = (LAS int*)(F.lds + LDSCTL_OFF + 512); LAS int* cnts = (LAS int*)(F.lds + LDSCTL_OFF + 768);
            __syncthreads();
            if (F.wave == 0) { int mycnt; const int pre = moe_tile_prefix(F.ctl + CW_CNT + l * NEXP, flane(), mycnt); if (flane() <= NEXP) tstart[flane()] = pre; if (flane() < NEXP) cnts[flane()] = mycnt; }
            __syncthreads();
            const int ntiles = tstart[NEXP];
            const bf16_t* wmoe = (const bf16_t*)(F.ws + WS_W_MOE + (size_t)l * NEXP * 3 * MiB);
            if (kind == 8) { if constexpr (HAS(8)) {
                if (NAIVE_MOE) naive_moe(F, *ap, l); else {
                pg8::MoeGatherAddr AD{(const bf16_t*)(F.ws + WS_HB), wmoe, (const unsigned*)(F.ws + WS_LIST), DM};
                pg8::MoeOrder S{tstart, cnts, ntiles, F.G, fbid()};
                EpiAct E{(bf16_t*)(F.ws + WS_ACT)};
                pg8::gemm_phase(F.lds, AD, S, E, DM); }
            } } else { if constexpr (HAS(9)) {
                pg8::MoeActAddr AD{(const bf16_t*)(F.ws + WS_ACT), wmoe + (size_t)DM * DM, FF};
                pg8::MoeOrder S{tstart, cnts, ntiles, F.G, fbid()};
                EpiY E{(bf16_t*)(F.ws + WS_YB)};
                pg8::gemm_phase(F.lds, AD, S, E, FF);
            } } } break;
        default: if constexpr (HAS(10)) { if (NAIVE_FINAL == 1) naive_n1(F, *ap, DEPTH, true); else if (NAIVE_FINAL == 2) wave_n1(F, *ap, DEPTH, true); else n1_phase<true>(F, *ap, DEPTH); } break;
        }
        if (ph + 1 < hi) xcd_barrier(bar);
    }
#undef HAS
}
template <int L>
__device__ __forceinline__ void layer_sl(Frame& F, const Args& args, const XcdBarrier& bar) {
    constexpr int l = L; constexpr int odd = L & 1, p = L >> 1;
    const float* mod = (const float*)(F.ws + WS_MOD);
    n1_phase<false>(F, args, l); xcd_barrier(bar);
    { pg8::PlainAddr AD{(const bf16_t*)(F.ws + WS_HB), (const bf16_t*)(F.ws + (odd ? WS_W_ODIN + (size_t)p * 10 * MiB : WS_W_EVIN + (size_t)p * 6 * MiB)), DM};
      pg8::StaticOrder S; S.init(MTOK, odd ? OD_N : EV_N, F.G, fbid());
      EpiProj E{F.ws, (const float*)(F.ws + WS_LB) + l * DM, odd};
      pg8::gemm_phase(F.lds, AD, S, E, DM); }
    conv_moe_tail(F, args, l, 0, moe_g1_hi(l), (MTOK / 256) * ((odd ? OD_N : EV_N) / 256));
    xcd_barrier(bar);
    if constexpr (!odd) {
        {
            const int bx = fbid();
            if (F.G == 256) {
                att_item(F, args, p, bx);
                if (bx < 16) att_item(F, args, p, 256 + bx);
                else { const int r0 = 2 * (bx - 16); ret_state_item(F, args, p, r0); ret_state_item(F, args, p, r0 + 1); if (bx - 16 < 64) ret_state_item(F, args, p, 480 + (bx - 16)); }
            } else {
                for (int it = bx; it < NB * 4 * NCHUNK + NB * 2 * NCHUNK; it += F.G) { if (it < NB * 2 * NCHUNK) att_item(F, args, p, it); else ret_state_item(F, args, p, it - NB * 2 * NCHUNK); }
            }
        }
        __syncthreads(); xcd_barrier(bar);
        ret_scan_phase(F, args, p); xcd_barrier(bar);
        for (int rep_ = 0; rep_ <= REP_MIXE; ++rep_) for (int it = fbid(); it < NB * 4 * NCHUNK; it += F.G) ret_out_item(F, args, p, it);
        __syncthreads(); xcd_barrier(bar);
    } else {
        for (int rep_ = 0; rep_ <= REP_HG; ++rep_) for (int it = F.vcu; it < NB * 8 * 2 * 4; it += F.G) hg_scan_item(F, it);
        __syncthreads(); xcd_barrier(bar);
        hg_readout_phase(F, args, p); xcd_barrier(bar);
    }
    { pg8::PlainAddr AD{(const bf16_t*)(F.ws + WS_YB16), (const bf16_t*)(F.ws + (odd ? WS_W_ODOUT : WS_W_EVOUT) + (size_t)p * 2 * MiB), DM};
      pg8::StaticOrder S; S.init(MTOK, DM, F.G, fbid(), l == DEPTH - 1 ? 1 : 0);
      EpiOut E{(float*)(F.ws + WS_XRES), mod + (size_t)l * 5 * 6144, 1};
      pg8::gemm_phase(F.lds, AD, S, E, DM); }
    if constexpr (l != DEPTH - 1) conv_moe_tail(F, args, l, moe_g1_hi(l), moe_g2_hi(l), (MTOK / 256) * (DM / 256));
    xcd_barrier(bar);
    n2r_phase(F, args, l); xcd_barrier(bar);
    {   LAS int* tstart = (LAS int*)(F.lds + LDSCTL_OFF + 512); LAS int* cnts = (LAS int*)(F.lds + LDSCTL_OFF + 768);
        __syncthreads();
        if (F.wave == 0) { int mycnt; const int ln = flane(); const int pre = moe_tile_prefix(F.ctl + CW_CNT + l * NEXP, ln, mycnt); if (ln <= NEXP) tstart[ln] = pre; if (ln < NEXP) cnts[ln] = mycnt; }
        __syncthreads();
        const int ntiles = tstart[NEXP];
        const bf16_t* wmoe = (const bf16_t*)(F.ws + WS_W_MOE + (size_t)l * NEXP * 3 * MiB);
        { pg8::MoeGatherAddr AD{(const bf16_t*)(F.ws + WS_HB), wmoe, (const unsigned*)(F.ws + WS_LIST), DM};
          pg8::MoeOrder S{tstart, cnts, ntiles, F.G, fbid()};
          EpiAct E{(bf16_t*)(F.ws + WS_ACT)};
          pg8::gemm_phase(F.lds, AD, S, E, DM); }
        xcd_barrier(bar);
        { pg8::MoeActAddr AD{(const bf16_t*)(F.ws + WS_ACT), wmoe + (size_t)DM * DM, FF};
          pg8::MoeOrder S{tstart, cnts, ntiles, F.G, fbid()};
          EpiY E{(bf16_t*)(F.ws + WS_YB)};
          pg8::gemm_phase(F.lds, AD, S, E, FF); }
        xcd_barrier(bar);
    }
}
__global__ void __launch_bounds__(NWAVES * 64, 2) mk_one(Args args) {
    extern __shared__ __attribute__((aligned(16))) unsigned char lds_raw[];
    Frame F;
    F.lds = (LAS unsigned char*)lds_raw;
    F.MISC = (volatile LAS unsigned*)(F.lds + MISC_OFF);
    F.wave = __builtin_amdgcn_readfirstlane(ftid() >> 6);
    F.G = gridDim.x; { const int bx = blockIdx.x; F.vcu = (F.G % 8 == 0) ? (bx % 8) * (F.G / 8) + bx / 8 : bx; }
    F.ws = args.ws; F.ctl = (unsigned*)(args.ws + WS_CTL);
    for (int u = ftid(); u < (LDS_BYTES - LDSCTL_OFF) / 4; u += NWAVES * 64) ((LAS unsigned*)(F.lds + LDSCTL_OFF))[u] = 0u;
    __syncthreads();
    const XcdBarrier bar = xcd_barrier_post(F.ctl + CW_BAR, F.MISC + 8);
    p0_prologue(F, args); xcd_barrier(bar);
    layer_sl<0>(F, args, bar);
    layer_sl<1>(F, args, bar);
    layer_sl<2>(F, args, bar);
    layer_sl<3>(F, args, bar);
    n1_phase<true>(F, args, DEPTH);
}

template <unsigned KM>
__global__ void __launch_bounds__(NWAVES * 64, 2) mk_fwd(Args args) {
    extern __shared__ __attribute__((aligned(16))) unsigned char lds_raw[];
    mk_body<KM>(args, lds_raw);
}

template <unsigned KM> static bool prep_kernel() { return hipFuncSetAttribute((const void*)mk_fwd<KM>, hipFuncAttributeMaxDynamicSharedMemorySize, LDS_BYTES) == hipSuccess; }
template <unsigned KM> static void launch_kernel(int grid, hipStream_t stream, const Args& a) { hipLaunchKernelGGL(mk_fwd<KM>, dim3(grid), dim3(NWAVES * 64), LDS_BYTES, stream, a); }
#define KEV (1u << 16)
#define KOD (1u << 17)
extern "C" void kernel_launch(void* const* d_in, const int* in_sizes, int n_in, void* d_out, int out_size, void* d_ws, size_t ws_size, hipStream_t stream) {
    static int grid = 0;
    if (grid == 0) {
        const int exp_sizes[23] = {NB * LSEQ * DM, NB * DM, NB * NCTX * DM, DM, DEPTH * DM * 6 * DM, DEPTH * 6 * DM, DEPTH * 2 * DM, DM, 2 * DM * EV_N, 2 * DM * DM, 16, 8,
                                   2 * DM * OD_N, 2 * DM * DM, DEPTH * DM, 2 * 128, DEPTH * DM * 4, DEPTH * 4, DEPTH * 4 * DM * 8, DEPTH * 32, DEPTH * NEXP * DM * FF, DEPTH * NEXP * DM * FF, DEPTH * NEXP * FF * DM};
        bool sz_ok = (n_in == 23) && out_size == NB * LSEQ * DM;
        for (int i = 0; i < 23 && sz_ok; ++i) sz_ok = (in_sizes[i] == exp_sizes[i]);
        if (!sz_ok) { fprintf(stderr, "kernel_launch: unexpected input sizes\n"); grid = -1; return; }
        if (n_in != 23 || ws_size < WS_END) { fprintf(stderr, "kernel_launch: unexpected n_in %d / ws_size %zu\n", n_in, ws_size); grid = -1; return; }
        int dev = 0, cus = 0;
        if (hipGetDevice(&dev) != hipSuccess || hipDeviceGetAttribute(&cus, hipDeviceAttributeMultiprocessorCount, dev) != hipSuccess) { grid = -1; return; }
        bool ok = true;
#if MK_PER_PHASE
        ok = ok && prep_kernel<1u << 0>() && prep_kernel<1u << 1>() && prep_kernel<1u << 2>() && prep_kernel<(1u << 3) | KEV>() && prep_kernel<(1u << 3) | KOD>()
                && prep_kernel<(1u << 4) | KEV>() && prep_kernel<(1u << 4) | KOD>() && prep_kernel<(1u << 5) | KEV>() && prep_kernel<1u << 6>() && prep_kernel<1u << 7>()
                && prep_kernel<1u << 8>() && prep_kernel<1u << 9>() && prep_kernel<1u << 10>();
#else
        ok = ok && (hipFuncSetAttribute((const void*)mk_one, hipFuncAttributeMaxDynamicSharedMemorySize, LDS_BYTES) == hipSuccess);
#ifdef PROBE_MASKS
        ok = ok && prep_kernel<(1u<<3)|(3u<<16)>() && prep_kernel<(1u<<3)|(1u<<5)|(1u<<16)>() && prep_kernel<(1u<<0)|(1u<<1)|(1u<<7)|(1u<<10)>() && prep_kernel<(1u<<3)|(1u<<4)|(1u<<5)|(3u<<16)>() && prep_kernel<(1u<<0)|(1u<<3)|(1u<<16)>() && prep_kernel<(1u<<1)|(1u<<3)|(1u<<16)>();
#endif
#endif
        if (!ok) { fprintf(stderr, "kernel_launch: hipFuncSetAttribute failed\n"); grid = -1; return; }
        (void)hipGetLastError();
        grid = cus > 256 ? 256 : cus;
    }
    if (grid < 0) return;
    (void)hipMemsetAsync((char*)d_ws + WS_CTL, 0, CTL_ZERO_BYTES, stream);
    Args a{};
    for (int i = 0; i < 23; ++i) a.in[i] = (const float*)d_in[i];
    a.out = (float*)d_out; a.ws = (unsigned char*)d_ws;
#if MK_PER_PHASE
    for (int ph = 0; ph < NPHASE; ++ph) {
        { unsigned char* w_ = args.ws; asm volatile("" : "+s"(w_)); F.ws = w_; F.ctl = (unsigned*)(w_ + WS_CTL); }
        { int wv_ = __builtin_amdgcn_readfirstlane(ftid() >> 6); F.wave = wv_; int g_ = (int)gridDim.x; asm volatile("" : "+s"(g_)); F.G = g_; const int bx = fbid(); F.vcu = (g_ % 8 == 0) ? (bx % 8) * (g_ / 8) + bx / 8 : bx; }
        const float* mod = (const float*)(F.ws + WS_MOD);
        const int kind = (ph == 0) ? 0 : (ph == NPHASE - 1 ? 10 : 1 + (ph - 1) % 9); const int l = (ph - 1) / 9; const bool odd = (l & 1) != 0;
        if (kind == 5 && odd) continue;
        a.ph_lo = ph; a.ph_hi = ph + 1;
        switch (kind) {
            case 0: launch_kernel<1u << 0>(grid, stream, a); break;
            case 1: launch_kernel<1u << 1>(grid, stream, a); break;
            case 2: launch_kernel<1u << 2>(grid, stream, a); break;
            case 3: if (odd) launch_kernel<(1u << 3) | KOD>(grid, stream, a); else launch_kernel<(1u << 3) | KEV>(grid, stream, a); break;
            case 4: if (odd) launch_kernel<(1u << 4) | KOD>(grid, stream, a); else launch_kernel<(1u << 4) | KEV>(grid, stream, a); break;
            case 5: launch_kernel<(1u << 5) | KEV>(grid, stream, a); break;
            case 6: launch_kernel<1u << 6>(grid, stream, a); break;
            case 7: launch_kernel<1u << 7>(grid, stream, a); break;
            case 8: launch_kernel<1u << 8>(grid, stream, a); break;
            case 9: launch_kernel<1u << 9>(grid, stream, a); break;
            default: launch_kernel<1u << 10>(grid, stream, a); break;
        }
    }
#else
    a.ph_lo = 0; a.ph_hi = NPHASE;
    hipLaunchKernelGGL(mk_one, dim3(grid), dim3(NWAVES * 64), LDS_BYTES, stream, a);
#endif
}
```

```cpp
#include <hip/hip_runtime.h>
#include <cstdio>
#include <cstdint>

#define REPK_EPIPROJ 0
#define REPE_EPIPROJ 0
#define REPE_EPIOUT 0
#define REPE_EPIACT 0
#define REPE_EPIY 0
#define REPK_EPIOUT 0
#define REPK_EPIACT 0
#define REPK_EPIY 0
#ifndef REP_KLOOP
#define REP_KLOOP 0
#endif
#ifndef MK_PER_PHASE
#define MK_PER_PHASE 0
#endif

#ifndef CONTRIB_EVEN
#define CONTRIB_EVEN 1
#endif
#ifndef CONTRIB_ODD
#define CONTRIB_ODD 1
#endif
#ifndef CONTRIB_MOE
#define CONTRIB_MOE 1
#endif
#ifndef ABL_ATT0
#define ABL_ATT0 0
#endif
#ifndef ABL_RET0
#define ABL_RET0 0
#endif
#ifndef ABL_HGB0
#define ABL_HGB0 0
#endif
#ifndef RET_DIRECT
#define RET_DIRECT 0
#endif
#ifndef NAIVE_G1
#define NAIVE_G1 0
#endif
#ifndef NAIVE_G2
#define NAIVE_G2 0
#endif
#ifndef NAIVE_MOD
#define NAIVE_MOD 0
#endif
#ifndef NAIVE_MOE
#define NAIVE_MOE 0
#endif
#ifndef NAIVE_ATT
#define NAIVE_ATT 0
#endif
#ifndef NAIVE_HG
#define NAIVE_HG 0
#endif
#ifndef NAIVE_N2R
#define NAIVE_N2R 0
#endif
#ifndef NAIVE_COPY
#define NAIVE_COPY 0
#endif
#ifndef NAIVE_N1
#define NAIVE_N1 0
#endif
#ifndef NAIVE_FINAL
#define NAIVE_FINAL 0
#endif
#ifndef MUT_A
#define MUT_A 0
#endif
#ifndef MUT_B
#define MUT_B 0
#endif
#ifndef MUT_D
#define MUT_D 0
#endif
#ifndef REP_CONV
#define REP_CONV 0
#endif
#ifndef REP_HG
#define REP_HG 0
#endif
#ifndef REP_MIXE
#define REP_MIXE 0
#endif
#define LAS __attribute__((address_space(3)))
#define GAS __attribute__((address_space(1)))
typedef unsigned short bf16_t;
typedef short bf16x8 __attribute__((ext_vector_type(8)));
typedef float f32x4 __attribute__((ext_vector_type(4)));
typedef float f32x2 __attribute__((ext_vector_type(2)));
typedef unsigned u32x4 __attribute__((ext_vector_type(4)));
typedef unsigned u32x2 __attribute__((ext_vector_type(2)));

constexpr int NB = 4, LSEQ = 4096, DM = 1024, NCTX = 256, SU = NCTX + LSEQ  , MTOK = NB * SU  , DEPTH = 4;
constexpr int EV_N = 3072, OD_N = 5120, NEXP = 32, FF = 512;
constexpr int NCHUNK = SU / 128;
constexpr float EPS = 1e-6f;
constexpr int LIST_CAP = MTOK;
constexpr int MOE_MAXROWS = 43008;

constexpr size_t MiB = 1u << 20;
constexpr size_t WS_CTL = 0, CTL_ZERO_BYTES = 1 * MiB;
constexpr size_t WS_MOD = 1 * MiB;
constexpr size_t WS_LB = 1 * MiB + 512 * 1024;
constexpr size_t WS_ROPEC = WS_LB + 16384;
constexpr size_t WS_ROPES = WS_ROPEC + 8192;
constexpr size_t WS_W = 2 * MiB;
constexpr size_t WS_W_EVIN = WS_W;
constexpr size_t WS_W_EVOUT = WS_W + 12 * MiB;
constexpr size_t WS_W_ODIN = WS_W + 16 * MiB;
constexpr size_t WS_W_ODOUT = WS_W + 36 * MiB;
constexpr size_t WS_W_MOE = WS_W + 40 * MiB;
constexpr size_t WS_XRES = 426 * MiB;
constexpr size_t WS_HB = 494 * MiB;
constexpr size_t WS_YB16 = 528 * MiB;
constexpr size_t WS_R = 562 * MiB;
constexpr size_t WS_PE = WS_R;
constexpr size_t WS_ST = WS_R + 102 * MiB;
constexpr size_t WS_PQ = WS_R, WS_PI = WS_R + 34 * MiB, WS_PG = WS_R + 68 * MiB;
constexpr size_t WS_FF = WS_R + 102 * MiB, WS_FB = WS_R + 170 * MiB, WS_OF = WS_R + 238 * MiB, WS_OB = WS_R + 306 * MiB;
constexpr size_t WS_LIST = WS_R;
constexpr size_t WS_TOKINFO = WS_R + 5 * MiB;
constexpr size_t WS_ACT = WS_R + 6 * MiB;
constexpr size_t WS_YB = WS_R + 50 * MiB;
constexpr size_t WS_YN = WS_R + 140 * MiB;
constexpr size_t WS_END = 936 * MiB;
constexpr size_t WS_SP = 256 * 1024;
constexpr int SP_NORMW = 0, SP_FNORMW = 8192, SP_WG = 9216, SP_BG = 25600, SP_WE = 25616, SP_BE = 156688, SP_DECAY = 156816, SP_SINK = 156832, SP_HGNW = 156840, SP_END = 157096;
static_assert(WS_SP + (size_t)SP_END * 4 <= CTL_ZERO_BYTES, "small parameters fit in the control MiB");
constexpr int CW_BAR = 4096;
constexpr int CW_CNT = 8192;

constexpr int RING_BYTES = 150528;
constexpr int LDSCTL_OFF = RING_BYTES, MISC_OFF = LDSCTL_OFF + 320;
constexpr int LDS_BYTES = RING_BYTES + 4096;
constexpr int NWAVES = 8;

typedef __bf16 bf16v2_t __attribute__((ext_vector_type(2)));
__device__ __forceinline__ unsigned pk2(float lo, float hi) { const f32x2 v = {lo, hi}; const bf16v2_t r = __builtin_convertvector(v, bf16v2_t); return __builtin_bit_cast(unsigned, r); }
__device__ __forceinline__ unsigned f2bf(float f) { return pk2(f, f) & 0xffffu; }
__device__ __forceinline__ float bf2f(unsigned h) { return __builtin_bit_cast(float, h << 16); }
__device__ __forceinline__ float bflo(unsigned w) { return __builtin_bit_cast(float, w << 16); }
__device__ __forceinline__ float bfhi(unsigned w) { return __builtin_bit_cast(float, w & 0xffff0000u); }
__device__ __forceinline__ float shx(float v, int o, int lane) { return __builtin_bit_cast(float, __builtin_amdgcn_ds_bpermute((lane ^ o) << 2, __builtin_bit_cast(int, v))); }
__device__ __forceinline__ int shup_i(int v, int o, int lane) { return __builtin_amdgcn_ds_bpermute((lane - o) << 2, v); }
__device__ __forceinline__ int shidx_i(int v, int src) { return __builtin_amdgcn_ds_bpermute(src << 2, v); }
__device__ __forceinline__ float wave_sum(float v, int lane) {
#pragma unroll
    for (int o = 1; o < 64; o <<= 1) v += shx(v, o, lane);
    return v;
}
__device__ __forceinline__ float wave_sum_dpp(float v) {
    v += __builtin_bit_cast(float, __builtin_amdgcn_update_dpp(0, __builtin_bit_cast(int, v), 0x111, 0xf, 0xf, true));
    v += __builtin_bit_cast(float, __builtin_amdgcn_update_dpp(0, __builtin_bit_cast(int, v), 0x112, 0xf, 0xf, true));
    v += __builtin_bit_cast(float, __builtin_amdgcn_update_dpp(0, __builtin_bit_cast(int, v), 0x114, 0xf, 0xf, true));
    v += __builtin_bit_cast(float, __builtin_amdgcn_update_dpp(0, __builtin_bit_cast(int, v), 0x118, 0xf, 0xf, true));
    v += __builtin_bit_cast(float, __builtin_amdgcn_update_dpp(0, __builtin_bit_cast(int, v), 0x142, 0xa, 0xf, false));
    v += __builtin_bit_cast(float, __builtin_amdgcn_update_dpp(0, __builtin_bit_cast(int, v), 0x143, 0xc, 0xf, false));
    return __builtin_bit_cast(float, __builtin_amdgcn_readlane(__builtin_bit_cast(int, v), 63));
}
__device__ __forceinline__ float siluf(float x) { return x / (1.0f + __expf(-x)); }
#define LDS_WAIT() asm volatile("s_waitcnt lgkmcnt(0)" ::: "memory")
#define VM_WAIT() asm volatile("s_waitcnt vmcnt(0)" ::: "memory")

namespace pg8 {
constexpr int BM = 256, BK = 64, HALF = 128, HTB = HALF * BK * 2, STAGE_BYTES = 8 * HTB, NXCD = 8, WGM = 8;
__host__ __device__ __forceinline__ int lds_byte(int r, int c) { const int st = (r >> 4) * 2 + (c >> 5), rr = r & 15, cc = c & 31, ob = rr * 64 + cc * 2; return st * 1024 + (ob ^ (((ob >> 9) & 1) << 5)); }
__host__ __device__ __forceinline__ void stage_rc(int b, int& R, int& C) { const int st = b / 1024, sb = b % 1024, swz = sb ^ (((sb >> 9) & 1) << 5); R = (st >> 1) * 16 + swz / 64; C = (st & 1) * 32 + (swz % 64) / 2; }
__host__ __device__ __forceinline__ int perm32(int rho) { const int n = rho >> 4, i = rho & 15; return 8 * (i >> 2) + 4 * n + (i & 3); }

struct Unit { int pm, pn, e, cnt, tile; };

__device__ __forceinline__ int xcd_remap(int L, int nwg) { const int q = nwg / NXCD, r = nwg % NXCD, xcd = L % NXCD, off = L / NXCD; return (xcd < r ? xcd * (q + 1) : r * (q + 1) + (xcd - r) * q) + off; }

struct StaticOrder {
    int nM, nN, nwg, G, c, skipctx;
    __device__ void init(int M, int N, int G_, int c_, int skip_ = 0) { skipctx = skip_; nM = skip_ ? 64 : M / BM; nN = N / BM; nwg = nM * nN; G = G_; c = c_; }
    __device__ bool next(int i, Unit& u) const {
        const long L = (long)i * G + c; if (L >= nwg) return false;
        const int wgid = xcd_remap((int)L, nwg);
        const int nig = WGM * nN, gid = wgid / nig, fm = gid * WGM, gsz = (nM - fm) < WGM ? (nM - fm) : WGM;
        u.pm = fm + ((wgid % nig) % gsz); u.pn = (wgid % nig) / gsz; u.e = 0; u.cnt = 0; u.tile = 0;
        if (skipctx) u.pm = u.pm + u.pm / 16 + 1;
        return true;
    }
};
struct MoeOrder {
    const LAS int* tstart; const LAS int* cnts; int ntiles, G, c;
    __device__ bool next(int i, Unit& u) const {
        const int nwg = ntiles * 4; const long L = (long)i * G + c; if (L >= nwg) return false;
        const int wgid = xcd_remap((int)L, nwg);
        const int tile = wgid >> 2; u.pn = wgid & 3; u.tile = tile;
        int e = 0;
        for (int k = 1; k < NEXP; ++k) e += (tstart[k] <= tile) ? 1 : 0;
        u.e = e; u.pm = tile - tstart[e]; u.cnt = cnts[e]; return true;
    }
};

struct PlainAddr {
    static constexpr bool GATHER = false;
    const bf16_t* A; const bf16_t* Bt; int K;
    __device__ __forceinline__ void base(const Unit& u, const char*& cA, const char*& cB) const { cA = (const char*)(A + (size_t)u.pm * BM * K); cB = (const char*)(Bt + (size_t)u.pn * BM * K); }
    __device__ __forceinline__ void rows(const Unit&, const int (&)[2], const int (&)[2], unsigned (&)[2], unsigned (&)[2]) const {}
};
struct MoeGatherAddr {
    static constexpr bool GATHER = true;
    const bf16_t* HB; const bf16_t* Wbase; const unsigned* list; int K;
    __device__ __forceinline__ void base(const Unit& u, const char*& cA, const char*& cB) const { cA = (const char*)HB; cB = (const char*)Wbase + (size_t)u.e * (3u << 20) + (size_t)u.pn * BM * K * 2; }
    __device__ __forceinline__ void rows(const Unit& u, const int (&R)[2], const int (&C)[2], unsigned (&v0)[2], unsigned (&v1)[2]) const {
        const unsigned* lp = list + (size_t)u.e * LIST_CAP;
#pragma unroll
        for (int i = 0; i < 2; ++i) {
            int i0 = u.pm * BM + R[i], i1 = i0 + HALF; const int mx = u.cnt - 1; i0 = i0 < mx ? i0 : mx; i1 = i1 < mx ? i1 : mx;
            const unsigned t0 = __hip_atomic_load(lp + i0, __ATOMIC_RELAXED, __HIP_MEMORY_SCOPE_AGENT), t1 = __hip_atomic_load(lp + i1, __ATOMIC_RELAXED, __HIP_MEMORY_SCOPE_AGENT);
            v0[i] = (t0 * (unsigned)K + (unsigned)C[i]) * 2u; v1[i] = (t1 * (unsigned)K + (unsigned)C[i]) * 2u;
        }
    }
};
struct MoeActAddr {
    static constexpr bool GATHER = false;
    const bf16_t* Act; const bf16_t* Wbase; int K;
    __device__ __forceinline__ void base(const Unit& u, const char*& cA, const char*& cB) const { cA = (const char*)(Act + (size_t)u.tile * BM * K); cB = (const char*)Wbase + (size_t)u.e * (3u << 20) + (size_t)u.pn * BM * K * 2; }
    __device__ __forceinline__ void rows(const Unit&, const int (&)[2], const int (&)[2], unsigned (&)[2], unsigned (&)[2]) const {}
};

__device__ __forceinline__ unsigned cvt_pk_bf16(float lo, float hi) { unsigned r; asm volatile("v_cvt_pk_bf16_f32 %0, %1, %2" : "=v"(r) : "v"(lo), "v"(hi)); return r; }

template <class Epi, class Sched, class Addr>
__device__ __forceinline__ void gemm_phase(LAS unsigned char* lds, const Addr& AD, const Sched& S, const Epi& E, const int K) {
    int tid = threadIdx.x; asm volatile("" : "+v"(tid));
    const int wid = __builtin_amdgcn_readfirstlane(tid >> 6), lane = tid & 63, wr = wid >> 2, wc = wid & 3, fr = lane & 15, fq = lane >> 4;
    const int nt = K / BK;
    int sR[2], sC[2]; unsigned voffA[2], voffB[2];
#pragma unroll
    for (int i = 0; i < 2; ++i) { int R, C; stage_rc(tid * 16 + i * 8192, R, C); sR[i] = R; sC[i] = C; const int Rb = Epi::PERM ? ((R & ~31) + perm32(R & 31)) : R; voffA[i] = (unsigned)(R * K + C) * 2u; voffB[i] = (unsigned)(Rb * K + C) * 2u; }
    const size_t kstep = (size_t)(BK * 2);
    const size_t hstep = (size_t)HALF * K * 2;
    const unsigned ldsw = (unsigned)wid * 1024u;
    const int aoff = lds_byte(wr * 64 + fr, fq * 8), boff = lds_byte(wc * 32 + fr, fq * 8);
#define PG8_SA(b, h) (((b) * 2 + (h)) * HTB)
#define PG8_SB(b, h) ((4 + (b) * 2 + (h)) * HTB)
#define PG8_STAGE(bufoff, gbase, voff) do { _Pragma("unroll") for (int _i = 0; _i < 2; ++_i) \
        __builtin_amdgcn_global_load_lds((const unsigned*)((const char*)(gbase) + (voff)[_i]), (LAS unsigned*)(lds + (bufoff) + ldsw + _i * 8192), 16, 0, 0); } while (0)
#define PG8_LDA(dst, b, h) do { _Pragma("unroll") for (int m = 0; m < 4; ++m) _Pragma("unroll") for (int k = 0; k < 2; ++k) dst[m][k] = *(const LAS bf16x8*)(lds + PG8_SA(b, h) + aoff + m * 2048 + k * 1024); } while (0)
#define PG8_LDB(dst, b, h) do { _Pragma("unroll") for (int n = 0; n < 2; ++n) _Pragma("unroll") for (int k = 0; k < 2; ++k) dst[n][k] = *(const LAS bf16x8*)(lds + PG8_SB(b, h) + boff + n * 2048 + k * 1024); } while (0)
#define PG8_MMA(ai, bj, At, Bt) do { __builtin_amdgcn_s_setprio(1); _Pragma("unroll") for (int m = 0; m < 4; ++m) _Pragma("unroll") for (int n = 0; n < 2; ++n) _Pragma("unroll") for (int k = 0; k < 2; ++k) \
        acc[ai][bj][m][n] = __builtin_amdgcn_mfma_f32_16x16x32_bf16(Bt[n][k], At[m][k], acc[ai][bj][m][n], 0, 0, 0); __builtin_amdgcn_s_setprio(0); } while (0)
#define PG8_WAIT_V(n) asm volatile("s_waitcnt vmcnt(" #n ")" ::: "memory")
#define PG8_WAIT_L(n) asm volatile("s_waitcnt lgkmcnt(" #n ")" ::: "memory")
#define PG8_BAR __builtin_amdgcn_s_barrier()
#define PG8_SCHED __builtin_amdgcn_sched_barrier(0)
    Unit cur, nxt; int ui = 0;
    if (!S.next(0, cur)) return;
    f32x4 acc[2][2][4][2];
#pragma unroll
    for (int a = 0; a < 2; ++a)
#pragma unroll
        for (int b = 0; b < 2; ++b)
#pragma unroll
            for (int m = 0; m < 4; ++m)
#pragma unroll
                for (int n = 0; n < 2; ++n) acc[a][b][m][n] = (f32x4){0.f, 0.f, 0.f, 0.f};
    bf16x8 At[4][2], B0[2][2], B1[2][2];
    const char* cA; const char* cB; unsigned cv0[2] = {voffA[0], voffA[1]}, cv1[2] = {voffA[0], voffA[1]};
    AD.base(cur, cA, cB); AD.rows(cur, sR, sC, cv0, cv1);
    const size_t ah = Addr::GATHER ? (size_t)0 : hstep;
    PG8_STAGE(PG8_SB(0, 0), cB, voffB); PG8_STAGE(PG8_SB(0, 1), cB + hstep, voffB); PG8_STAGE(PG8_SA(0, 0), cA, cv0); PG8_STAGE(PG8_SA(0, 1), cA + ah, cv1);
    if (wr == 1) PG8_BAR;
    PG8_WAIT_V(2); PG8_BAR;
    PG8_STAGE(PG8_SB(1, 0), cB + kstep, voffB); PG8_STAGE(PG8_SA(1, 0), cA + kstep, cv0); PG8_STAGE(PG8_SB(1, 1), cB + hstep + kstep, voffB);
    PG8_WAIT_V(6); PG8_BAR;
    for (;;) {
        const bool has_next = S.next(ui + 1, nxt);
        const char* nA = cA; const char* nB = cB; unsigned nv0[2] = {cv0[0], cv0[1]}, nv1[2] = {cv1[0], cv1[1]};
        if (has_next) { AD.base(nxt, nA, nB); AD.rows(nxt, sR, sC, nv0, nv1); }
#if REP_KLOOP
        for (int rep_ = 0; rep_ <= Epi::REPK; ++rep_) {
        if (rep_ > 0) {
#pragma unroll
            for (int a = 0; a < 2; ++a)
#pragma unroll
                for (int b = 0; b < 2; ++b)
#pragma unroll
                    for (int m = 0; m < 4; ++m)
#pragma unroll
                        for (int n = 0; n < 2; ++n) acc[a][b][m][n] = (f32x4){0.f, 0.f, 0.f, 0.f};
        }
        const bool lastrep = rep_ == Epi::REPK;
#else
        { const bool lastrep = true;
#endif
        for (int t = 0; t < nt; t += 2) {
            const bool last = (t == nt - 2);
            const char* a1 = cA + (size_t)(t + 1) * kstep;
            const char* a2 = last ? (lastrep ? nA : cA) : cA + (size_t)(t + 2) * kstep; const char* b2 = last ? (lastrep ? nB : cB) : cB + (size_t)(t + 2) * kstep;
            const char* a3 = a2 + kstep; const char* b3 = b2 + kstep;
            unsigned x0[2] = {cv0[0], cv0[1]}, x1[2] = {cv1[0], cv1[1]};
            if constexpr (Addr::GATHER) { if (last && lastrep) { x0[0] = nv0[0]; x0[1] = nv0[1]; x1[0] = nv1[0]; x1[1] = nv1[1]; } }
            PG8_LDB(B0, 0, 0); PG8_LDB(B1, 0, 1); PG8_SCHED; PG8_LDA(At, 0, 0); PG8_STAGE(PG8_SA(1, 1), a1 + ah, cv1);
            PG8_WAIT_V(8); PG8_WAIT_L(0); PG8_BAR; PG8_MMA(0, 0, At, B0); PG8_MMA(0, 1, At, B1); PG8_BAR; PG8_SCHED;
            PG8_LDA(At, 0, 1); PG8_STAGE(PG8_SB(0, 0), b2, voffB); PG8_STAGE(PG8_SB(0, 1), b2 + hstep, voffB); PG8_STAGE(PG8_SA(0, 0), a2, x0);
            PG8_WAIT_V(8); PG8_WAIT_L(0); PG8_BAR; PG8_MMA(1, 0, At, B0); PG8_MMA(1, 1, At, B1); PG8_BAR; PG8_SCHED;
            PG8_LDB(B0, 1, 0); PG8_LDB(B1, 1, 1); PG8_SCHED; PG8_LDA(At, 1, 0); PG8_STAGE(PG8_SA(0, 1), a2 + ah, x1);
            PG8_WAIT_V(8); PG8_WAIT_L(0); PG8_BAR; PG8_MMA(0, 0, At, B0); PG8_MMA(0, 1, At, B1); PG8_BAR; PG8_SCHED;
            PG8_LDA(At, 1, 1); PG8_STAGE(PG8_SB(1, 0), b3, voffB); PG8_STAGE(PG8_SB(1, 1), b3 + hstep, voffB); PG8_STAGE(PG8_SA(1, 0), a3, x0);
            PG8_WAIT_V(8); PG8_WAIT_L(0); PG8_BAR; PG8_MMA(1, 0, At, B0); PG8_MMA(1, 1, At, B1); PG8_BAR; PG8_SCHED;
        }
        }
        if (wr == 0) PG8_BAR;
#if REP_KLOOP
        if constexpr (Epi::REPE > 0) { int nrep_ = 1 + Epi::REPE; asm volatile("" : "+s"(nrep_));
#pragma nounroll
          for (int rep_ = 0; rep_ < nrep_; ++rep_) E(acc, cur, wr, wc, fr, fq); }
        else E(acc, cur, wr, wc, fr, fq);
#else
        E(acc, cur, wr, wc, fr, fq);
#endif
        if (!has_next) break;
#pragma unroll
        for (int a = 0; a < 2; ++a)
#pragma unroll
            for (int b = 0; b < 2; ++b)
#pragma unroll
                for (int m = 0; m < 4; ++m)
#pragma unroll
                    for (int n = 0; n < 2; ++n) acc[a][b][m][n] = (f32x4){0.f, 0.f, 0.f, 0.f};
        cur = nxt; cA = nA; cB = nB; cv0[0] = nv0[0]; cv0[1] = nv0[1]; cv1[0] = nv1[0]; cv1[1] = nv1[1]; ++ui;
        if (wr == 1) PG8_BAR;
    }
    PG8_WAIT_V(0);
    PG8_BAR;
#undef PG8_SA
#undef PG8_SB
#undef PG8_STAGE
#undef PG8_LDA
#undef PG8_LDB
#undef PG8_MMA
#undef PG8_WAIT_V
#undef PG8_WAIT_L
#undef PG8_BAR
#undef PG8_SCHED
}
}

#define XB_TMO      128
#define XB_XCNT(j)  (256  + 64 * (j))
#define XB_XSUB(j)  (1280 + 64 * (j))
#define XB_XGEN(j)  (2304 + 64 * (j))
#define XB_TOP      3328
#define XB_TOPGEN   3392
#define XCD_BAR_WORDS 3456
#define XB_SPIN_CAP (1u << 20)
__device__ __forceinline__ unsigned xb_ld(unsigned* p)              { return __hip_atomic_load((GAS unsigned*)p, __ATOMIC_RELAXED, __HIP_MEMORY_SCOPE_AGENT); }
__device__ __forceinline__ unsigned xb_add(unsigned* p, unsigned v) { return __hip_atomic_fetch_add((GAS unsigned*)p, v, __ATOMIC_RELAXED, __HIP_MEMORY_SCOPE_AGENT); }
__device__ __forceinline__ unsigned xb_xcc_id() { return (unsigned)__builtin_amdgcn_s_getreg((3 << 11) | 20) & 0xFu; }
#define XB_SPIN(cond, bar) do { unsigned _sp = 0; while (cond) { __builtin_amdgcn_s_sleep(1); \
    if ((++_sp & 255u) == 0u) { if (xb_ld(&(bar)[XB_TMO])) break; if (_sp > XB_SPIN_CAP) { xb_add(&(bar)[XB_TMO], 1u); break; } } } } while (0)
struct XcdBarrier { unsigned* bar; unsigned x; volatile LAS unsigned* st; };
__device__ __forceinline__ XcdBarrier xcd_barrier_post(unsigned* bar, volatile LAS unsigned* st) {
    XcdBarrier b; b.bar = bar; b.x = xb_xcc_id(); b.st = st;
    if (threadIdx.x == 0) st[2] = xb_add(&bar[XB_XCNT(b.x)], 1u);
    return b;
}
__device__ __forceinline__ void xcd_barrier_complete(unsigned* bar, unsigned x, unsigned& nloc, unsigned& nx) {
    const unsigned G = gridDim.x * gridDim.y * gridDim.z;
    unsigned sum, cnt, mine, sp = 0u;
    for (;;) {
        sum = 0u; cnt = 0u; mine = 0u;
#pragma unroll
        for (unsigned j = 0; j < 16; ++j) { const unsigned c = xb_ld(&bar[XB_XCNT(j)]); sum += c; cnt += (c > 0u) ? 1u : 0u; }
        mine = xb_ld(&bar[XB_XCNT(x)]);
        if (sum == G) break;
        __builtin_amdgcn_s_sleep(1);
        if ((++sp & 255u) == 0u) { if (xb_ld(&bar[XB_TMO])) break; if (sp > XB_SPIN_CAP) { xb_add(&bar[XB_TMO], 1u); break; } }
    }
    nloc = mine > 0u ? mine : 1u; nx = cnt > 0u ? cnt : 1u;
}
__device__ __forceinline__ void xcd_barrier(const XcdBarrier& b) {
    asm volatile("s_waitcnt vmcnt(0)" ::: "memory");
    __syncthreads();
    if (threadIdx.x == 0) {
        unsigned* bar = b.bar; asm volatile("" : "+s"(bar));
        __builtin_amdgcn_s_waitcnt(0);
        unsigned nloc = b.st[0], nx = b.st[1];
        if (nloc == 0u) { xcd_barrier_complete(bar, b.x, nloc, nx); b.st[0] = nloc; b.st[1] = nx; }
        const unsigned old = xb_add(&bar[XB_XSUB(b.x)], 1u);
        const unsigned gen = old / nloc;
        if (old + 1u == (gen + 1u) * nloc) {
            __builtin_amdgcn_fence(__ATOMIC_RELEASE, "agent");
            asm volatile("s_waitcnt vmcnt(0)" ::: "memory");
            const unsigned og = xb_add(&bar[XB_TOP], 1u);
            const unsigned tg = og / nx;
            if (og + 1u == (tg + 1u) * nx) xb_add(&bar[XB_TOPGEN], 1u);
            else XB_SPIN(xb_ld(&bar[XB_TOPGEN]) == tg, bar);
            __builtin_amdgcn_fence(__ATOMIC_ACQUIRE, "agent");
            xb_add(&bar[XB_XGEN(b.x)], 1u);
            asm volatile("s_waitcnt vmcnt(0)" ::: "memory");
        } else {
            XB_SPIN(xb_ld(&bar[XB_XGEN(b.x)]) == gen, bar);
            __builtin_amdgcn_fence(__ATOMIC_ACQUIRE, "agent");
            asm volatile("s_waitcnt vmcnt(0)" ::: "memory");
        }
    }
    __syncthreads();
}

__device__ __forceinline__ int ftid() { int t = (int)threadIdx.x; asm volatile("" : "+v"(t)); return t; }
__device__ __forceinline__ int flane() { return ftid() & 63; }
__device__ __forceinline__ int fbid() { int b = (int)blockIdx.x; asm volatile("" : "+s"(b)); return b; }
#define FCG(F) __builtin_amdgcn_readfirstlane((int)(F).MISC[12])
struct Args { const float* in[23]; float* out; unsigned char* ws; int ph_lo, ph_hi; };
struct Frame {
    LAS unsigned char* lds;
    volatile LAS unsigned* MISC;
    unsigned* ctl;
    unsigned char* ws;
    int wave, vcu, G;
};
enum { I_X = 0, I_C, I_CTX, I_CCTX, I_ADAW, I_ADAB, I_NORMW, I_FNORMW, I_EVWIN, I_EVWOUT, I_RETDECAY, I_SINK, I_ODWIN, I_ODWOUT, I_LBLOG, I_HGNW,
       I_WG, I_BG, I_WE, I_BE, I_W1, I_W3, I_W2 };

__device__ __forceinline__ void conv_item(const float* srcp, int src_ld, bf16_t* WT, int K, int n0, int k0, LAS float* scr, int lane) {
#pragma unroll 8
    for (int i = 0; i < 32; ++i) { const int kk = 2 * i + (lane >> 5); scr[kk * 33 + (lane & 31)] = srcp[(size_t)(k0 + kk) * src_ld]; }
    LDS_WAIT(); asm volatile("" ::: "memory");
    const int c = lane & 7;
#pragma unroll
    for (int j = 0; j < 4; ++j) { const int n = (lane >> 3) + 8 * j; const LAS float* s = scr + (8 * c) * 33 + n;
        u32x4 o; o.x = pk2(s[0 * 33], s[1 * 33]); o.y = pk2(s[2 * 33], s[3 * 33]); o.z = pk2(s[4 * 33], s[5 * 33]); o.w = pk2(s[6 * 33], s[7 * 33]);
        *(u32x4*)(WT + (size_t)(n0 + n) * K + k0 + 8 * c) = o; }
    LDS_WAIT(); asm volatile("" ::: "memory");
}
__device__ __forceinline__ int head_perm(int n) { const int hh = n >> 7, phi = n & 127, g = phi >> 3, u = phi & 7; return hh * 128 + 64 * (g >> 3) + 4 * (g & 7) + (u & 3) + 32 * (u >> 2); }

constexpr int NI_W13 = 16 * 32, NI_W2 = 8 * 32, NI_MOE1 = NI_W13 + NI_W2, MOE_NI = NEXP * NI_MOE1;
#ifndef CONV_TAIL_WAVES
#define CONV_TAIL_WAVES 4
#endif
#ifndef MOE_G1_EVEN
#define MOE_G1_EVEN 7168
#endif
#ifndef MOE_G1_ODD
#define MOE_G1_ODD 6144
#endif
#ifndef MOE_G2_EVEN
#define MOE_G2_EVEN 10240
#endif
#ifndef MOE_G2_ODD
#define MOE_G2_ODD 10240
#endif
__host__ __device__ constexpr int moe_g1_hi(int l) { return (l & 1) ? MOE_G1_ODD : MOE_G1_EVEN; }
__host__ __device__ constexpr int moe_g2_hi(int l) { return l == DEPTH - 1 ? moe_g1_hi(l) : moe_g1_hi(l) + ((l & 1) ? MOE_G2_ODD : MOE_G2_EVEN); }
__host__ __device__ constexpr int moe_p0_cnt(int l) { return MOE_NI - moe_g2_hi(l); }
__device__ __forceinline__ void conv_moe_item(Frame& F, const Args& args, int l, int r, LAS float* scr, int lane) {
    const int le = l * NEXP + r / NI_MOE1; r %= NI_MOE1;
    bf16_t* dst = (bf16_t*)(F.ws + WS_W_MOE + (size_t)le * 3 * MiB);
    if (r < NI_W13) { const int kb = r / 32, nb = r % 32; const int n = nb * 32 + (lane & 31);
        const int Gq = n >> 3, u = n & 7; const float* src = (u < 4 ? args.in[I_W1] : args.in[I_W3]) + (size_t)le * DM * FF + 4 * Gq + (u & 3);
        conv_item(src, FF, dst, DM, nb * 32, kb * 64, scr, lane); }
    else { r -= NI_W13; const int kb = r / 32, nb = r % 32; const int n = nb * 32 + (lane & 31);
        conv_item(args.in[I_W2] + (size_t)le * FF * DM + n, DM, dst + (size_t)DM * DM, FF, nb * 32, kb * 64, scr, lane); }
}
__device__ __forceinline__ void conv_moe_tail(Frame& F, const Args& args, int l, int lo, int hi, int nwg) {
    const int r = nwg % F.G, c = FCG(F);
    if (c >= r) {
        __syncthreads();
        LAS float* scr = (LAS float*)(F.lds + F.wave * 16384); const int lane = flane();
        const int nslot = (F.G - r) * CONV_TAIL_WAVES;
        if (F.wave < CONV_TAIL_WAVES)
        for (int it = lo + (c - r) * CONV_TAIL_WAVES + F.wave; it < hi; it += nslot) conv_moe_item(F, args, l, it, scr, lane);
    }
}

__device__ __forceinline__ void p0_prologue(Frame& F, const Args& args) {
    LAS float* scr = (LAS float*)(F.lds + F.wave * 16384);
    const int gw = F.vcu * NWAVES + F.wave, NGW = F.G * NWAVES, lane = flane();
    constexpr int NI_EVIN = 16 * (EV_N / 32), NI_ODIN = 16 * (OD_N / 32), NI_OUT = 16 * 32;
    constexpr int NITEMS = 2 * NI_EVIN + 2 * NI_ODIN + 4 * NI_OUT + moe_p0_cnt(0) + moe_p0_cnt(1) + moe_p0_cnt(2) + moe_p0_cnt(3);
    for (int rep_ = 0; rep_ <= REP_CONV; ++rep_)
    for (int it = gw; it < NITEMS; it += NGW) {
        int r = it;
        if (r < 2 * NI_EVIN) { const int p = r / NI_EVIN; r %= NI_EVIN; const int nblk = EV_N / 32, kb = r / nblk, nb = r % nblk; const int n = nb * 32 + (lane & 31);
            conv_item(args.in[I_EVWIN] + (size_t)p * DM * EV_N + head_perm(n), EV_N, (bf16_t*)(F.ws + WS_W_EVIN + (size_t)p * 6 * MiB), DM, nb * 32, kb * 64, scr, lane); continue; }
        r -= 2 * NI_EVIN;
        if (r < 2 * NI_ODIN) { const int p = r / NI_ODIN; r %= NI_ODIN; const int nblk = OD_N / 32, kb = r / nblk, nb = r % nblk; const int n = nb * 32 + (lane & 31);
            conv_item(args.in[I_ODWIN] + (size_t)p * DM * OD_N + head_perm(n), OD_N, (bf16_t*)(F.ws + WS_W_ODIN + (size_t)p * 10 * MiB), DM, nb * 32, kb * 64, scr, lane); continue; }
        r -= 2 * NI_ODIN;
        if (r < 4 * NI_OUT) { const int q = r / NI_OUT; r %= NI_OUT; const int kb = r / 32, nb = r % 32; const int n = nb * 32 + (lane & 31);
            const float* src = (q < 2 ? args.in[I_EVWOUT] + (size_t)q * DM * DM : args.in[I_ODWOUT] + (size_t)(q - 2) * DM * DM);
            bf16_t* dst = (bf16_t*)(F.ws + (q < 2 ? WS_W_EVOUT + (size_t)q * 2 * MiB : WS_W_ODOUT + (size_t)(q - 2) * 2 * MiB));
            conv_item(src + n, DM, dst, DM, nb * 32, kb * 64, scr, lane); continue; }
        r -= 4 * NI_OUT;
        if (r < moe_p0_cnt(0)) { conv_moe_item(F, args, 0, moe_g2_hi(0) + r, scr, lane); continue; }
        r -= moe_p0_cnt(0);
        if (r < moe_p0_cnt(1)) { conv_moe_item(F, args, 1, moe_g2_hi(1) + r, scr, lane); continue; }
        r -= moe_p0_cnt(1);
        if (r < moe_p0_cnt(2)) { conv_moe_item(F, args, 2, moe_g2_hi(2) + r, scr, lane); continue; }
        r -= moe_p0_cnt(2);
        conv_moe_item(F, args, 3, moe_g2_hi(3) + r, scr, lane);
    }
    {
        f32x4* xr = (f32x4*)(F.ws + WS_XRES);
        const f32x4* xs = (const f32x4*)args.in[I_X]; const f32x4* cs = (const f32x4*)args.in[I_CTX];
        const size_t total = (size_t)MTOK * 256;
        for (size_t i = (size_t)fbid() * 512 + ftid(); i < total; i += (size_t)F.G * 512) {
            const int row = (int)(i >> 8), c4 = (int)(i & 255); const int b = row / SU, p = row % SU;
            xr[i] = (p < NCTX) ? cs[((size_t)(b * NCTX + p) << 8) + c4] : xs[((size_t)(b * LSEQ + p - NCTX) << 8) + c4];
        }
    }
    if (NAIVE_COPY) { float* xr2 = (float*)(F.ws + WS_XRES);
        for (size_t i = (size_t)fbid() * 512 + ftid(); i < (size_t)MTOK * DM; i += (size_t)F.G * 512) { const size_t row = i / DM; const int k = (int)(i % DM); const int b = (int)(row / SU), p = (int)(row % SU);
            xr2[i] = p < NCTX ? args.in[I_CTX][((size_t)b * NCTX + p) * DM + k] : args.in[I_X][((size_t)b * LSEQ + (p - NCTX)) * DM + k]; } }
    {
        float* sp = (float*)(F.ws + WS_SP);
        for (int i = fbid() * 512 + ftid(); i < SP_END; i += F.G * 512) {
            float v;
            if (i < SP_FNORMW) v = args.in[I_NORMW][i]; else if (i < SP_WG) v = args.in[I_FNORMW][i - SP_FNORMW]; else if (i < SP_BG) v = args.in[I_WG][i - SP_WG]; else if (i < SP_WE) v = args.in[I_BG][i - SP_BG];
            else if (i < SP_BE) v = args.in[I_WE][i - SP_WE]; else if (i < SP_DECAY) v = args.in[I_BE][i - SP_BE]; else if (i < SP_SINK) v = args.in[I_RETDECAY][i - SP_DECAY]; else if (i < SP_HGNW) v = args.in[I_SINK][i - SP_SINK]; else v = args.in[I_HGNW][i - SP_HGNW];
            sp[i] = v;
        }
    }
    if (blockIdx.x == 0) {
        float* lb = (float*)(F.ws + WS_LB); const float* lg = args.in[I_LBLOG];
        for (int c = ftid(); c < DM; c += 512) {
            const float a0 = lg[c], a1 = lg[DM + c], a2 = lg[2 * DM + c], a3 = lg[3 * DM + c];
            const float mx = fmaxf(fmaxf(a0, a1), fmaxf(a2, a3));
            const float e0 = expf(a0 - mx), e1 = expf(a1 - mx), e2 = expf(a2 - mx), e3 = expf(a3 - mx); const float inv = 1.0f / (e0 + e1 + e2 + e3);
            lb[c] = 0.f; lb[DM + c] = e1 * inv; lb[2 * DM + c] = (e1 + e2) * inv; lb[3 * DM + c] = (e1 + e2 + e3) * inv;
        }
    }
    if (blockIdx.x == 1) {
        float* rc = (float*)(F.ws + WS_ROPEC); float* rs = (float*)(F.ws + WS_ROPES);
        for (int i = ftid(); i < 64 * 32; i += 512) { const int pos = i >> 5, fi = i & 31;
            const float invf = powf(10000.0f, -(float)(2 * fi) / 64.0f); const float ang = (float)pos * invf;
            rc[i] = cosf(ang); rs[i] = sinf(ang); }
    }
    {
        __syncthreads();
        LAS float* sv = (LAS float*)F.lds;
        LAS float* part = (LAS float*)(F.lds + 20480);
        for (int i = ftid(); i < 5 * DM; i += 512) { const int r = i >> 10, k = i & 1023; const float v = (r < 4) ? args.in[I_C][r * DM + k] : args.in[I_CCTX][k]; sv[i] = siluf(v); }
        __syncthreads();
        float* mod = (float*)(F.ws + WS_MOD);
        for (int it = fbid(); it < DEPTH * 96; it += F.G) {
            const int l = it / 96, cg = it % 96; const int col = cg * 64 + lane;
            const float* w = args.in[I_ADAW] + (size_t)l * DM * 6144 + col;
            float a[5] = {0.f, 0.f, 0.f, 0.f, 0.f};
            const int k0 = F.wave * 128;
#pragma unroll 8
            for (int k = 0; k < 128; ++k) { const float wv = w[(size_t)(k0 + k) * 6144];
#pragma unroll
                for (int r = 0; r < 5; ++r) a[r] += sv[r * DM + k0 + k] * wv; }
#pragma unroll
            for (int r = 0; r < 5; ++r) part[(F.wave * 5 + r) * 64 + lane] = a[r];
            __syncthreads();
            if (ftid() < 320) { const int r = ftid() >> 6, c = ftid() & 63; float s = 0.f;
#pragma unroll
                for (int w8 = 0; w8 < 8; ++w8) s += part[(w8 * 5 + r) * 64 + c];
                mod[((size_t)l * 5 + r) * 6144 + cg * 64 + c] = s + args.in[I_ADAB][l * 6144 + cg * 64 + c]; }
            __syncthreads();
        }
    }
}

__device__ __forceinline__ int moe_tile_prefix(const unsigned* cnt, int lane, int& mycnt) {
    const int c = (lane < NEXP) ? (int)__hip_atomic_load(cnt + lane, __ATOMIC_RELAXED, __HIP_MEMORY_SCOPE_AGENT) : 0; mycnt = c;
    const int nt = (c + 255) >> 8; int incl = nt;
#pragma unroll
    for (int o = 1; o < 64; o <<= 1) { const int v = shup_i(incl, o, lane); if (lane >= o) incl += v; }
    return incl - nt;
}

template <bool FINAL>
__device__ __forceinline__ void n1_phase(Frame& F, const Args& args, int l) {
    const int gw = (MUT_A ? fbid() : F.vcu) * NWAVES + F.wave, NGW = F.G * NWAVES, lane = flane();
    float* xres = (float*)(F.ws + WS_XRES);
    const float* mod = (const float*)(F.ws + WS_MOD);
    int tprefix = 0, dummy;
    if (l > 0) tprefix = moe_tile_prefix(F.ctl + CW_CNT + (l - 1) * NEXP, lane, dummy);
    for (int rr_ = 0; rr_ < (MUT_D ? 64 : 9); ++rr_) {
        const int row = MUT_D ? (fbid() * 512 + F.wave * 64 + rr_) : (gw + rr_ * NGW); if (row >= MTOK) continue;
        const int b = row / SU, p = row % SU; const int mrow = (p < NCTX) ? 4 : b;
        if (FINAL && p < NCTX) continue;
        f32x4* xr = (f32x4*)(xres + (size_t)row * DM) + lane;
        f32x4 v[4];
#pragma unroll
        for (int j = 0; j < 4; ++j) v[j] = xr[64 * j];
        if (l > 0 && CONTRIB_MOE) {
            {
                unsigned* tiw = (unsigned*)(F.ws + WS_TOKINFO) + (size_t)row * 8;
                u32x4 t0, t1;
                t0.x = __hip_atomic_load(tiw + 0, __ATOMIC_RELAXED, __HIP_MEMORY_SCOPE_AGENT); t0.y = __hip_atomic_load(tiw + 1, __ATOMIC_RELAXED, __HIP_MEMORY_SCOPE_AGENT);
                t0.z = __hip_atomic_load(tiw + 2, __ATOMIC_RELAXED, __HIP_MEMORY_SCOPE_AGENT); t0.w = __hip_atomic_load(tiw + 3, __ATOMIC_RELAXED, __HIP_MEMORY_SCOPE_AGENT);
                t1.x = __hip_atomic_load(tiw + 4, __ATOMIC_RELAXED, __HIP_MEMORY_SCOPE_AGENT); t1.y = __hip_atomic_load(tiw + 5, __ATOMIC_RELAXED, __HIP_MEMORY_SCOPE_AGENT); t1.z = 0u; t1.w = 0u;
                const int ts0 = shidx_i(tprefix, (int)t0.x), ts1 = shidx_i(tprefix, (int)t0.z);
                const size_t s0 = (size_t)ts0 * 256 + t0.y, s1 = (size_t)ts1 * 256 + t0.w;
                const unsigned gb0 = t1.x, gb1 = t1.y;
                const float g0 = __builtin_bit_cast(float, gb0), g1 = __builtin_bit_cast(float, gb1);
                const u32x2* y0 = (const u32x2*)(F.ws + WS_YB + s0 * (DM * 2)) + lane; const u32x2* y1 = (const u32x2*)(F.ws + WS_YB + s1 * (DM * 2)) + lane;
                const f32x4* gp = (const f32x4*)(mod + ((size_t)(l - 1) * 5 + mrow) * 6144 + 5 * DM) + lane;
                if (NAIVE_MOE) {
                    const f32x4* n0 = (const f32x4*)(F.ws + WS_YN + (size_t)row * 2 * DM * 4) + lane; const f32x4* n1 = n0 + 256;
#pragma unroll
                    for (int j = 0; j < 4; ++j) { const f32x4 g = gp[64 * j]; v[j] = v[j] + g * (n0[64 * j] * g0 + n1[64 * j] * g1); }
                } else {
                if (MUT_B) {
                    const bf16_t* yy0 = (const bf16_t*)(F.ws + WS_YB) + s0 * DM; const bf16_t* yy1 = (const bf16_t*)(F.ws + WS_YB) + s1 * DM;
                    const float* gate = mod + ((size_t)(l - 1) * 5 + mrow) * 6144 + 5 * DM;
#pragma unroll
                    for (int j = 0; j < 4; ++j) { const int k = 4 * lane + 256 * j;
                        v[j].x += gate[k] * (g0 * bf2f(yy0[k]) + g1 * bf2f(yy1[k])); v[j].y += gate[k + 1] * (g0 * bf2f(yy0[k + 1]) + g1 * bf2f(yy1[k + 1]));
                        v[j].z += gate[k + 2] * (g0 * bf2f(yy0[k + 2]) + g1 * bf2f(yy1[k + 2])); v[j].w += gate[k + 3] * (g0 * bf2f(yy0[k + 3]) + g1 * bf2f(yy1[k + 3])); }
                } else {
#pragma unroll
                for (int j = 0; j < 4; ++j) { const u32x2 a = y0[64 * j], c = y1[64 * j]; const f32x4 g = gp[64 * j];
                    v[j].x += g.x * (g0 * bflo(a.x) + g1 * bflo(c.x)); v[j].y += g.y * (g0 * bfhi(a.x) + g1 * bfhi(c.x));
                    v[j].z += g.z * (g0 * bflo(a.y) + g1 * bflo(c.y)); v[j].w += g.w * (g0 * bfhi(a.y) + g1 * bfhi(c.y)); }
                }
                }
                if (!FINAL) {
#pragma unroll
                    for (int j = 0; j < 4; ++j) xr[64 * j] = v[j];
                }
            }
        }
        float s = 0.f;
#pragma unroll
        for (int j = 0; j < 4; ++j) s += (v[j].x * v[j].x + v[j].y * v[j].y) + (v[j].z * v[j].z + v[j].w * v[j].w);
        const float rstd = 1.0f / sqrtf(wave_sum(s, lane) * (1.0f / DM) + EPS);
        if (FINAL) {
            const f32x4* nw = (const f32x4*)((const float*)(F.ws + WS_SP) + SP_FNORMW) + lane;
            f32x4* o = (f32x4*)(args.out + ((size_t)b * LSEQ + (p - NCTX)) * DM) + lane;
#pragma unroll
            for (int j = 0; j < 4; ++j) { const f32x4 w = nw[64 * j]; o[64 * j] = v[j] * rstd * w; }
        } else {
            const f32x4* nw = (const f32x4*)(((const float*)(F.ws + WS_SP) + SP_NORMW) + (size_t)(l * 2 + 0) * DM) + lane;
            const f32x4* sh = (const f32x4*)(mod + ((size_t)l * 5 + mrow) * 6144 + 0 * DM) + lane;
            const f32x4* sc = (const f32x4*)(mod + ((size_t)l * 5 + mrow) * 6144 + 1 * DM) + lane;
            u32x2* o = (u32x2*)(F.ws + WS_HB + (size_t)row * (DM * 2)) + lane;
#pragma unroll
            for (int j = 0; j < 4; ++j) { const f32x4 w = nw[64 * j], a = sh[64 * j], c = sc[64 * j]; const f32x4 h = v[j] * rstd * w * (c + 1.0f) + a;
                u32x2 q; q.x = pk2(h.x, h.y); q.y = pk2(h.z, h.w); o[64 * j] = q; }
        }
    }
}

__device__ __forceinline__ void naive_n1(Frame& F, const Args& args, int l, bool final_) {
    float* xres = (float*)(F.ws + WS_XRES);
    const float* mod = (const float*)(F.ws + WS_MOD);
    for (int row = fbid() * 512 + ftid(); row < MTOK; row += F.G * 512) {
        const int b = row / SU, p = row % SU; const int mrow = (p < NCTX) ? 4 : b;
        if (final_ && p < NCTX) continue;
        float* xr = xres + (size_t)row * DM;
        if (l > 0) {
            const unsigned* cnt = F.ctl + CW_CNT + (l - 1) * NEXP;
            const unsigned* ti = (const unsigned*)(F.ws + WS_TOKINFO) + (size_t)row * 8;
            const unsigned e0 = ti[0], p0 = ti[1], e1 = ti[2], p1 = ti[3]; const float g0 = __builtin_bit_cast(float, ti[4]), g1 = __builtin_bit_cast(float, ti[5]);
            int ts0 = 0, ts1 = 0; for (unsigned e = 0; e < e0; ++e) ts0 += ((int)cnt[e] + 255) / 256; for (unsigned e = 0; e < e1; ++e) ts1 += ((int)cnt[e] + 255) / 256;
            const bf16_t* y0 = (const bf16_t*)(F.ws + WS_YB) + ((size_t)ts0 * 256 + p0) * DM; const bf16_t* y1 = (const bf16_t*)(F.ws + WS_YB) + ((size_t)ts1 * 256 + p1) * DM;
            const float* gate = mod + ((size_t)(l - 1) * 5 + mrow) * 6144 + 5 * DM;
            for (int k = 0; k < DM; ++k) xr[k] = xr[k] + gate[k] * (g0 * bf2f(y0[k]) + g1 * bf2f(y1[k]));
        }
        double ss = 0.0; for (int k = 0; k < DM; ++k) ss += (double)xr[k] * xr[k];
        const float rstd = 1.0f / sqrtf((float)(ss / DM) + EPS);
        if (final_) { float* o = args.out + ((size_t)b * LSEQ + (p - NCTX)) * DM; for (int k = 0; k < DM; ++k) o[k] = xr[k] * rstd * args.in[I_FNORMW][k]; }
        else { bf16_t* hb = (bf16_t*)(F.ws + WS_HB) + (size_t)row * DM; const float* nw = args.in[I_NORMW] + (size_t)(l * 2) * DM; const float* mr = mod + ((size_t)l * 5 + mrow) * 6144;
            for (int k = 0; k < DM; ++k) hb[k] = (bf16_t)f2bf(xr[k] * rstd * nw[k] * (1.0f + mr[DM + k]) + mr[k]); }
    }
}
__device__ __forceinline__ void wave_n1(Frame& F, const Args& args, int l, bool final_) {
    float* xres = (float*)(F.ws + WS_XRES);
    const float* mod = (const float*)(F.ws + WS_MOD);
    const int gw = F.vcu * NWAVES + F.wave, NGW = F.G * NWAVES, lane = flane();
    for (int row = gw; row < MTOK; row += NGW) {
        const int b = row / SU, p = row % SU; const int mrow = (p < NCTX) ? 4 : b;
        if (final_ && p < NCTX) continue;
        float* xr = xres + (size_t)row * DM;
        float xv[16];
#pragma unroll
        for (int i = 0; i < 16; ++i) xv[i] = xr[lane + 64 * i];
        if (l > 0) {
            const unsigned* cnt = F.ctl + CW_CNT + (l - 1) * NEXP;
            const unsigned* ti = (const unsigned*)(F.ws + WS_TOKINFO) + (size_t)row * 8;
            const unsigned e0 = ti[0], p0 = ti[1], e1 = ti[2], p1 = ti[3]; const float g0 = __builtin_bit_cast(float, ti[4]), g1 = __builtin_bit_cast(float, ti[5]);
            int ts0 = 0, ts1 = 0; for (unsigned e = 0; e < e0; ++e) ts0 += ((int)cnt[e] + 255) / 256; for (unsigned e = 0; e < e1; ++e) ts1 += ((int)cnt[e] + 255) / 256;
            const bf16_t* y0 = (const bf16_t*)(F.ws + WS_YB) + ((size_t)ts0 * 256 + p0) * DM; const bf16_t* y1 = (const bf16_t*)(F.ws + WS_YB) + ((size_t)ts1 * 256 + p1) * DM;
            const float* gate = mod + ((size_t)(l - 1) * 5 + mrow) * 6144 + 5 * DM;
#pragma unroll
            for (int i = 0; i < 16; ++i) { const int k = lane + 64 * i; xv[i] = xv[i] + gate[k] * (g0 * bf2f(y0[k]) + g1 * bf2f(y1[k])); if (!final_) xr[k] = xv[i]; }
        }
        float ss = 0.f;
#pragma unroll
        for (int i = 0; i < 16; ++i) ss += xv[i] * xv[i];
        const float rstd = 1.0f / sqrtf(wave_sum(ss, lane) * (1.0f / DM) + EPS);
        if (final_) { float* o = args.out + ((size_t)b * LSEQ + (p - NCTX)) * DM;
#pragma unroll
            for (int i = 0; i < 16; ++i) { const int k = lane + 64 * i; o[k] = xv[i] * rstd * args.in[I_FNORMW][k]; } }
        else { bf16_t* hb = (bf16_t*)(F.ws + WS_HB) + (size_t)row * DM; const float* nw = args.in[I_NORMW] + (size_t)(l * 2) * DM; const float* mr = mod + ((size_t)l * 5 + mrow) * 6144;
#pragma unroll
            for (int i = 0; i < 16; ++i) { const int k = lane + 64 * i; hb[k] = (bf16_t)f2bf(xv[i] * rstd * nw[k] * (1.0f + mr[DM + k]) + mr[k]); } }
    }
}
__device__ __forceinline__ void n2r_phase(Frame& F, const Args& args, int l) {
    const int gw = F.vcu * NWAVES + F.wave, NGW = F.G * NWAVES, lane = flane();
    const float* xres = (const float*)(F.ws + WS_XRES);
    const float* mod = (const float*)(F.ws + WS_MOD);
    unsigned* cnt = F.ctl + CW_CNT + l * NEXP;
    unsigned* list = (unsigned*)(F.ws + WS_LIST);
    const float* wg = ((const float*)(F.ws + WS_SP) + SP_WG) + (size_t)l * DM * 4; const float* bg = ((const float*)(F.ws + WS_SP) + SP_BG) + l * 4;
    const float* we = ((const float*)(F.ws + WS_SP) + SP_WE) + (size_t)l * 4 * DM * 8; const float* be = ((const float*)(F.ws + WS_SP) + SP_BE) + l * 32;
    LAS float* wgT = (LAS float*)F.lds; LAS float* weT = wgT + 4 * DM;
    LAS unsigned* hist = (LAS unsigned*)(F.lds + LDSCTL_OFF + 1024); LAS unsigned* baseL = hist + 32; LAS unsigned* rec = hist + 64 + F.wave * 36;
    __syncthreads();
    if (ftid() < 32) hist[ftid()] = 0u;
    {   const int t = ftid();
        for (int r = t; r < DM; r += 512) { const f32x4 a = *(const f32x4*)(wg + (size_t)r * 4); wgT[r] = a.x; wgT[DM + r] = a.y; wgT[2 * DM + r] = a.z; wgT[3 * DM + r] = a.w; }
        for (int r = t; r < 4 * DM; r += 512) { const int g = r >> 10, c = r & 1023; const f32x4 a = *(const f32x4*)(we + (size_t)r * 8), b2 = *(const f32x4*)(we + (size_t)r * 8 + 4);
            LAS float* d = weT + g * 8 * DM + c; d[0] = a.x; d[DM] = a.y; d[2 * DM] = a.z; d[3 * DM] = a.w; d[4 * DM] = b2.x; d[5 * DM] = b2.y; d[6 * DM] = b2.z; d[7 * DM] = b2.w; }
    }
    __syncthreads();
    for (int k_ = 0; k_ < 9; ++k_) {
        const int row = gw + k_ * NGW; if (row >= MTOK) break;
        const int b = row / SU, p = row % SU; const int mrow = (p < NCTX) ? 4 : b;
        if (l == DEPTH - 1 && p < NCTX) continue;
        const f32x4* xr = (const f32x4*)(xres + (size_t)row * DM) + lane;
        f32x4 v[4]; f32x4 s4 = (f32x4){0.f, 0.f, 0.f, 0.f};
#pragma unroll
        for (int j = 0; j < 4; ++j) { v[j] = xr[64 * j]; s4 += v[j] * v[j]; }
        const float rstd = __builtin_amdgcn_rsqf(wave_sum_dpp((s4.x + s4.y) + (s4.z + s4.w)) * (1.0f / DM) + EPS);
        const f32x4* nw = (const f32x4*)(((const float*)(F.ws + WS_SP) + SP_NORMW) + (size_t)(l * 2 + 1) * DM) + lane;
        const f32x4* sh = (const f32x4*)(mod + ((size_t)l * 5 + mrow) * 6144 + 3 * DM) + lane;
        const f32x4* sc = (const f32x4*)(mod + ((size_t)l * 5 + mrow) * 6144 + 4 * DM) + lane;
        u32x2* o = (u32x2*)(F.ws + WS_HB + (size_t)row * (DM * 2)) + lane;
        f32x4 ga[4];
#pragma unroll
        for (int g = 0; g < 4; ++g) ga[g] = (f32x4){0.f, 0.f, 0.f, 0.f};
#pragma unroll
        for (int j = 0; j < 4; ++j) { const f32x4 w = nw[64 * j], a = sh[64 * j], c = sc[64 * j]; const f32x4 h = v[j] * rstd * w * (c + 1.0f) + a; v[j] = h;
            u32x2 q; q.x = pk2(h.x, h.y); q.y = pk2(h.z, h.w); o[64 * j] = q;
#pragma unroll
            for (int g = 0; g < 4; ++g) { const f32x4 wv = *(const LAS f32x4*)(wgT + g * DM + 4 * lane + 256 * j); ga[g] += h * wv; } }
        float gl[4];
#pragma unroll
        for (int g = 0; g < 4; ++g) gl[g] = wave_sum_dpp((ga[g].x + ga[g].y) + (ga[g].z + ga[g].w)) + bg[g];
        int gi = 0; float gm = gl[0];
#pragma unroll
        for (int g = 1; g < 4; ++g) if (gl[g] > gm) { gm = gl[g]; gi = g; }
        const float gp = 1.0f / (__expf(gl[0] - gm) + __expf(gl[1] - gm) + __expf(gl[2] - gm) + __expf(gl[3] - gm));
        const LAS float* weg = weT + gi * 8 * DM;
        f32x4 ea[8];
#pragma unroll
        for (int e = 0; e < 8; ++e) ea[e] = (f32x4){0.f, 0.f, 0.f, 0.f};
#pragma unroll
        for (int j = 0; j < 4; ++j) {
#pragma unroll
            for (int e = 0; e < 8; ++e) { const f32x4 wv = *(const LAS f32x4*)(weg + e * DM + 4 * lane + 256 * j); ea[e] += v[j] * wv; }
        }
        float el[8];
#pragma unroll
        for (int e = 0; e < 8; ++e) el[e] = wave_sum_dpp((ea[e].x + ea[e].y) + (ea[e].z + ea[e].w)) + be[gi * 8 + e];
        int i0 = 0; float v0 = el[0];
#pragma unroll
        for (int e = 1; e < 8; ++e) if (el[e] > v0) { v0 = el[e]; i0 = e; }
        int i1 = -1; float v1 = -3.0e38f;
#pragma unroll
        for (int e = 0; e < 8; ++e) if (e != i0 && el[e] > v1) { v1 = el[e]; i1 = e; }
        const float w0 = 1.0f / (1.0f + __expf(v1 - v0)), w1 = 1.0f - w0;
        if (lane == 0) {
            const unsigned e0 = (unsigned)(gi * 8 + i0), e1 = (unsigned)(gi * 8 + i1);
            const unsigned lp0 = __hip_atomic_fetch_add(hist + e0, 1u, __ATOMIC_RELAXED, __HIP_MEMORY_SCOPE_WORKGROUP), lp1 = __hip_atomic_fetch_add(hist + e1, 1u, __ATOMIC_RELAXED, __HIP_MEMORY_SCOPE_WORKGROUP);
            rec[k_ * 4 + 0] = e0; rec[k_ * 4 + 1] = lp0; rec[k_ * 4 + 2] = e1; rec[k_ * 4 + 3] = lp1;
            u32x4* ti = (u32x4*)(F.ws + WS_TOKINFO) + (size_t)row * 2;
            ti[1] = (u32x4){__builtin_bit_cast(unsigned, gp * w0), __builtin_bit_cast(unsigned, gp * w1), 0u, 0u};
        }
    }
    __syncthreads();
    if (ftid() < 32) { const unsigned hc = hist[ftid()]; baseL[ftid()] = hc ? atomicAdd(cnt + ftid(), hc) : 0u; }
    __syncthreads();
    if (lane == 0) {
        for (int k_ = 0; k_ < 9; ++k_) {
            const int row = gw + k_ * NGW; if (row >= MTOK) break;
            if (l == DEPTH - 1 && (row % SU) < NCTX) continue;
            const unsigned e0 = rec[k_ * 4 + 0], e1 = rec[k_ * 4 + 2]; const unsigned p0 = baseL[e0] + rec[k_ * 4 + 1], p1 = baseL[e1] + rec[k_ * 4 + 3];
            list[(size_t)e0 * LIST_CAP + p0] = (unsigned)row; list[(size_t)e1 * LIST_CAP + p1] = (unsigned)row;
            u32x4* ti = (u32x4*)(F.ws + WS_TOKINFO) + (size_t)row * 2;
            ti[0] = (u32x4){e0, p0, e1, p1};
        }
    }
    __syncthreads();
}

__device__ __forceinline__ void naive_n2r(Frame& F, const Args& args, int l) {
    const float* xres = (const float*)(F.ws + WS_XRES);
    const float* mod = (const float*)(F.ws + WS_MOD);
    unsigned* cnt = F.ctl + CW_CNT + l * NEXP;
    unsigned* list = (unsigned*)(F.ws + WS_LIST);
    const float* wg = args.in[I_WG] + (size_t)l * DM * 4; const float* bg = args.in[I_BG] + l * 4;
    const float* we = args.in[I_WE] + (size_t)l * 4 * DM * 8; const float* be = args.in[I_BE] + l * 32;
    for (int row = fbid() * 512 + ftid(); row < MTOK; row += F.G * 512) {
        const int b = row / SU, p = row % SU; const int mrow = (p < NCTX) ? 4 : b;
        if (l == DEPTH - 1 && p < NCTX) continue;
        const float* xr = xres + (size_t)row * DM; double ss = 0.0;
        for (int k = 0; k < DM; ++k) ss += (double)xr[k] * xr[k];
        const float rstd = 1.0f / sqrtf((float)(ss / DM) + EPS);
        const float* nw = args.in[I_NORMW] + (size_t)(l * 2 + 1) * DM; const float* mr = mod + ((size_t)l * 5 + mrow) * 6144;
        bf16_t* hb = (bf16_t*)(F.ws + WS_HB) + (size_t)row * DM;
        float gl[4] = {bg[0], bg[1], bg[2], bg[3]};
        for (int k = 0; k < DM; ++k) { const float h = xr[k] * rstd * nw[k] * (1.0f + mr[4 * DM + k]) + mr[3 * DM + k]; hb[k] = (bf16_t)f2bf(h);
            gl[0] += h * wg[k * 4 + 0]; gl[1] += h * wg[k * 4 + 1]; gl[2] += h * wg[k * 4 + 2]; gl[3] += h * wg[k * 4 + 3]; }
        int gi = 0; for (int g = 1; g < 4; ++g) if (gl[g] > gl[gi]) gi = g;
        float den = 0.f; for (int g = 0; g < 4; ++g) den += expf(gl[g] - gl[gi]);
        const float gp = 1.0f / den;
        float el[8]; for (int e = 0; e < 8; ++e) el[e] = be[gi * 8 + e];
        for (int k = 0; k < DM; ++k) { const float h = xr[k] * rstd * nw[k] * (1.0f + mr[4 * DM + k]) + mr[3 * DM + k]; const float* wr = we + ((size_t)gi * DM + k) * 8;
#pragma unroll
            for (int e = 0; e < 8; ++e) el[e] += h * wr[e]; }
        int i0 = 0; for (int e = 1; e < 8; ++e) if (el[e] > el[i0]) i0 = e;
        int i1 = (i0 == 0) ? 1 : 0; for (int e = 0; e < 8; ++e) if (e != i0 && el[e] > el[i1]) i1 = e;
        const float m2 = el[i0]; const float a0 = 1.0f, a1 = expf(el[i1] - m2); const float w0 = a0 / (a0 + a1), w1 = a1 / (a0 + a1);
        const unsigned e0 = (unsigned)(gi * 8 + i0), e1 = (unsigned)(gi * 8 + i1);
        const unsigned p0 = atomicAdd(cnt + e0, 1u), p1 = atomicAdd(cnt + e1, 1u);
        list[(size_t)e0 * LIST_CAP + p0] = (unsigned)row; list[(size_t)e1 * LIST_CAP + p1] = (unsigned)row;
        u32x4* ti = (u32x4*)(F.ws + WS_TOKINFO) + (size_t)row * 2;
        ti[0] = (u32x4){e0, p0, e1, p1}; ti[1] = (u32x4){__builtin_bit_cast(unsigned, gp * w0), __builtin_bit_cast(unsigned, gp * w1), 0u, 0u};
    }
}

struct EpiProj {
    static constexpr bool PERM = true; static constexpr int REPK = REPK_EPIPROJ, REPE = REPE_EPIPROJ;
    unsigned char* ws; const float* lb; int odd;
    __device__ __forceinline__ void operator()(const f32x4 (&acc)[2][2][4][2], const pg8::Unit& u, int wr, int wc, int fr, int fq) const {
        const int pmb = u.pm % 17; const bool isctx = (pmb == 0); const int tbase = (pmb - 1) * 256;
        const int g = 4 * wc + fq, half = g >> 3, f0 = 4 * (g & 7);
        const float* ropec = (const float*)(ws + WS_ROPEC); const float* ropes = (const float*)(ws + WS_ROPES);
#pragma unroll
        for (int bj = 0; bj < 2; ++bj) {
            const int hcol = 256 * u.pn + 128 * bj; const int lc0 = hcol + 64 * half + f0;
            if (!odd) {
                const bool rope = !isctx && (hcol < 1024 || (hcol >= 2048 && hcol < 2816));
                const float scale = (hcol >= 512 && hcol < 1024) ? 0.08838834764831845f : 1.0f;
                bf16_t* dst = (bf16_t*)(ws + WS_PE);
#pragma unroll
                for (int ai = 0; ai < 2; ++ai)
#pragma unroll
                    for (int m = 0; m < 4; ++m) {
                        const int rr = 128 * ai + 64 * wr + 16 * m + fr; const size_t row = (size_t)u.pm * 256 + rr;
                        f32x4 x1 = acc[ai][bj][m][0] * scale, x2 = acc[ai][bj][m][1] * scale;
                        if (rope) { const int t = tbase + rr; const int pos = half ? (t & 63) : (t >> 6);
                            const f32x4 c = *(const f32x4*)(ropec + pos * 32 + f0), s = *(const f32x4*)(ropes + pos * 32 + f0);
                            const f32x4 o1 = x1 * c - x2 * s, o2 = x2 * c + x1 * s; x1 = o1; x2 = o2; }
                        u32x2 q1, q2; q1.x = pk2(x1.x, x1.y); q1.y = pk2(x1.z, x1.w); q2.x = pk2(x2.x, x2.y); q2.y = pk2(x2.z, x2.w);
                        *(u32x2*)(dst + row * EV_N + lc0) = q1; *(u32x2*)(dst + row * EV_N + lc0 + 32) = q2;
                    }
            } else {
                const int seg = hcol >> 10, c0 = lc0 & 1023;
                if (seg == 1 || seg == 2) {
                    float* dst = (float*)(ws + (seg == 1 ? WS_FF : WS_FB));
                    const f32x4 l1 = *(const f32x4*)(lb + c0), l2 = *(const f32x4*)(lb + c0 + 32);
#pragma unroll
                    for (int ai = 0; ai < 2; ++ai)
#pragma unroll
                        for (int m = 0; m < 4; ++m) {
                            const size_t row = (size_t)u.pm * 256 + 128 * ai + 64 * wr + 16 * m + fr;
                            const f32x4 z1 = acc[ai][bj][m][0], z2 = acc[ai][bj][m][1]; f32x4 f1, f2;
                            f1.x = l1.x + (1.f - l1.x) / (1.f + __expf(-z1.x)); f1.y = l1.y + (1.f - l1.y) / (1.f + __expf(-z1.y)); f1.z = l1.z + (1.f - l1.z) / (1.f + __expf(-z1.z)); f1.w = l1.w + (1.f - l1.w) / (1.f + __expf(-z1.w));
                            f2.x = l2.x + (1.f - l2.x) / (1.f + __expf(-z2.x)); f2.y = l2.y + (1.f - l2.y) / (1.f + __expf(-z2.y)); f2.z = l2.z + (1.f - l2.z) / (1.f + __expf(-z2.z)); f2.w = l2.w + (1.f - l2.w) / (1.f + __expf(-z2.w));
                            *(f32x4*)(dst + row * DM + c0) = f1; *(f32x4*)(dst + row * DM + c0 + 32) = f2;
                        }
                } else {
                    bf16_t* dst = (bf16_t*)(ws + (seg == 0 ? WS_PQ : (seg == 3 ? WS_PI : WS_PG)));
#pragma unroll
                    for (int ai = 0; ai < 2; ++ai)
#pragma unroll
                        for (int m = 0; m < 4; ++m) {
                            const size_t row = (size_t)u.pm * 256 + 128 * ai + 64 * wr + 16 * m + fr;
                            const f32x4 x1 = acc[ai][bj][m][0], x2 = acc[ai][bj][m][1];
                            u32x2 q1, q2; q1.x = pk2(x1.x, x1.y); q1.y = pk2(x1.z, x1.w); q2.x = pk2(x2.x, x2.y); q2.y = pk2(x2.z, x2.w);
                            *(u32x2*)(dst + row * DM + c0) = q1; *(u32x2*)(dst + row * DM + c0 + 32) = q2;
                        }
                }
            }
        }
    }
};
struct EpiOut {
    static constexpr bool PERM = false; static constexpr int REPK = REPK_EPIOUT, REPE = REPE_EPIOUT;
    float* xres; const float* modl; int enable;
    __device__ __forceinline__ void operator()(const f32x4 (&acc)[2][2][4][2], const pg8::Unit& u, int wr, int wc, int fr, int fq) const {
        if (!enable) return;
        const int pmb = u.pm % 17; const int mrow = (pmb == 0) ? 4 : (u.pm / 17);
        const float* gate = modl + (size_t)mrow * 6144 + 2 * DM;
#pragma unroll
        for (int bj = 0; bj < 2; ++bj)
#pragma unroll
            for (int n = 0; n < 2; ++n) {
                const int c = 256 * u.pn + 128 * bj + 32 * wc + 16 * n + 4 * fq; const f32x4 gv = *(const f32x4*)(gate + c);
#pragma unroll
                for (int ai = 0; ai < 2; ++ai)
#pragma unroll
                    for (int m = 0; m < 4; ++m) { f32x4* p = (f32x4*)(xres + ((size_t)u.pm * 256 + 128 * ai + 64 * wr + 16 * m + fr) * DM + c); *p = *p + gv * acc[ai][bj][m][n]; }
            }
    }
};
struct EpiAct {
    static constexpr bool PERM = true; static constexpr int REPK = REPK_EPIACT, REPE = REPE_EPIACT;
    bf16_t* Act;
    __device__ __forceinline__ void operator()(const f32x4 (&acc)[2][2][4][2], const pg8::Unit& u, int wr, int wc, int fr, int fq) const {
#pragma unroll
        for (int bj = 0; bj < 2; ++bj) { const int Gq = 32 * u.pn + 16 * bj + 4 * wc + fq;
#pragma unroll
            for (int ai = 0; ai < 2; ++ai)
#pragma unroll
                for (int m = 0; m < 4; ++m) { const size_t row = (size_t)u.tile * 256 + 128 * ai + 64 * wr + 16 * m + fr;
                    const f32x4 a = acc[ai][bj][m][0], b = acc[ai][bj][m][1];
                    u32x2 q; q.x = pk2(siluf(a.x) * b.x, siluf(a.y) * b.y); q.y = pk2(siluf(a.z) * b.z, siluf(a.w) * b.w);
                    *(u32x2*)(Act + row * FF + 4 * Gq) = q; } }
    }
};
struct EpiY {
    static constexpr bool PERM = true; static constexpr int REPK = REPK_EPIY, REPE = REPE_EPIY;
    bf16_t* YB;
    __device__ __forceinline__ void operator()(const f32x4 (&acc)[2][2][4][2], const pg8::Unit& u, int wr, int wc, int fr, int fq) const {
#pragma unroll
        for (int bj = 0; bj < 2; ++bj) { const int c = 256 * u.pn + 128 * bj + 32 * wc + 8 * fq;
#pragma unroll
            for (int ai = 0; ai < 2; ++ai)
#pragma unroll
                for (int m = 0; m < 4; ++m) { const size_t row = (size_t)u.tile * 256 + 128 * ai + 64 * wr + 16 * m + fr;
                    const f32x4 a = acc[ai][bj][m][0], b = acc[ai][bj][m][1];
                    u32x4 q; q.x = pk2(a.x, a.y); q.y = pk2(a.z, a.w); q.z = pk2(b.x, b.y); q.w = pk2(b.z, b.w);
                    *(u32x4*)(YB + row * DM + c) = q; } }
    }
};

__device__ __forceinline__ void naive_g1(Frame& F, const Args& args, int l) {
    const int odd = l & 1, p = l >> 1; const int N = odd ? OD_N : EV_N;
    const float* W = (odd ? args.in[I_ODWIN] : args.in[I_EVWIN]) + (size_t)p * DM * N;
    LAS float* sh = (LAS float*)F.lds;
    const float* lb = (const float*)(F.ws + WS_LB) + l * DM;
    const float* ropec = (const float*)(F.ws + WS_ROPEC); const float* ropes = (const float*)(F.ws + WS_ROPES);
    for (int rg = fbid(); rg < MTOK / 8; rg += F.G) {
        __syncthreads();
        if (NAIVE_G1 == 2) {
            const int row = rg * 8 + F.wave; const int bb = row / SU, pp = row % SU; const int mrow = pp < NCTX ? 4 : bb;
            const float* xr = (const float*)(F.ws + WS_XRES) + (size_t)row * DM; float ssq = 0.f;
            for (int k = flane(); k < DM; k += 64) ssq += xr[k] * xr[k];
            ssq = wave_sum(ssq, flane()); const float rs = 1.0f / sqrtf(ssq / (float)DM + EPS);
            const float* modr = (const float*)(F.ws + WS_MOD) + ((size_t)l * 5 + mrow) * 6144;
            for (int k = flane(); k < DM; k += 64) sh[F.wave * DM + k] = xr[k] * rs * args.in[I_NORMW][(size_t)(l * 2) * DM + k] * (1.0f + modr[DM + k]) + modr[k];
        } else
        for (int i = ftid(); i < 8 * DM; i += 512) sh[i] = bf2f(((const bf16_t*)(F.ws + WS_HB))[(size_t)rg * 8 * DM + i]);
        __syncthreads();
        for (int pi = ftid(); pi < N / 2; pi += 512) {
            const int hh = pi >> 6, rem = pi & 63, half = rem >> 5, d = rem & 31; const int cA = 128 * hh + 64 * half + d, cB = cA + 32;
            float a[8], bq[8];
#pragma unroll
            for (int r = 0; r < 8; ++r) { a[r] = 0.f; bq[r] = 0.f; }
            for (int k = 0; k < DM; ++k) { const float wa = W[(size_t)k * N + cA], wb = W[(size_t)k * N + cB];
#pragma unroll
                for (int r = 0; r < 8; ++r) { const float hv = sh[r * DM + k]; a[r] += hv * wa; bq[r] += hv * wb; } }
            const int hcol = 128 * hh;
#pragma unroll
            for (int r = 0; r < 8; ++r) {
                const int row = rg * 8 + r; const int pp = row % SU; const bool isctx = pp < NCTX; const int t = pp - NCTX;
                float x1 = a[r], x2 = bq[r];
                if (!odd) {
                    const bool rope = !isctx && (hcol < 1024 || (hcol >= 2048 && hcol < 2816));
                    if (hcol >= 512 && hcol < 1024) { x1 *= 0.08838834764831845f; x2 *= 0.08838834764831845f; }
                    if (rope) { const int pos = half ? (t & 63) : (t >> 6); float cc = ropec[pos * 32 + d], sn = ropes[pos * 32 + d];
                        if (NAIVE_G1 == 3) { const double ang = (double)((float)pos * powf(10000.0f, -(float)d / 32.0f)); cc = (float)cos(ang); sn = (float)sin(ang); }
                        const float o1 = x1 * cc - x2 * sn, o2 = x2 * cc + x1 * sn; x1 = o1; x2 = o2; }
                    bf16_t* dst = (bf16_t*)(F.ws + WS_PE) + (size_t)row * EV_N; dst[cA] = (bf16_t)f2bf(x1); dst[cB] = (bf16_t)f2bf(x2);
                } else {
                    const int seg = hcol >> 10, c0 = cA & 1023;
                    if (seg == 1 || seg == 2) { float* dst = (float*)(F.ws + (seg == 1 ? WS_FF : WS_FB)) + (size_t)row * DM;
                        float lba = lb[c0], lbb = lb[c0 + 32];
                        if (NAIVE_G1 == 3) { const float* lg = args.in[I_LBLOG]; float ea[4], eb[4], sa = 0.f, sb2 = 0.f; for (int q = 0; q < 4; ++q) { ea[q] = expf(lg[q * DM + c0]); eb[q] = expf(lg[q * DM + c0 + 32]); sa += ea[q]; sb2 += eb[q]; }
                            lba = 0.f; lbb = 0.f; for (int q = 1; q <= l; ++q) { lba += ea[q] / sa; lbb += eb[q] / sb2; } }
                        dst[c0] = lba + (1.f - lba) / (1.f + expf(-x1)); dst[c0 + 32] = lbb + (1.f - lbb) / (1.f + expf(-x2)); }
                    else { bf16_t* dst = (bf16_t*)(F.ws + (seg == 0 ? WS_PQ : (seg == 3 ? WS_PI : WS_PG))) + (size_t)row * DM; dst[c0] = (bf16_t)f2bf(x1); dst[c0 + 32] = (bf16_t)f2bf(x2); }
                }
            }
        }
    }
    __syncthreads();
}

__device__ __forceinline__ void naive_g2(Frame& F, const Args& args, int l) {
    const int odd = l & 1, p = l >> 1;
    const float* W = (odd ? args.in[I_ODWOUT] : args.in[I_EVWOUT]) + (size_t)p * DM * DM;
    LAS float* sh = (LAS float*)F.lds;
    const float* modl = (const float*)(F.ws + WS_MOD) + (size_t)l * 5 * 6144;
    float* xres = (float*)(F.ws + WS_XRES);
    for (int rg = fbid(); rg < MTOK / 8; rg += F.G) {
        __syncthreads();
        for (int i = ftid(); i < 8 * DM; i += 512) sh[i] = bf2f(((const bf16_t*)(F.ws + WS_YB16))[(size_t)rg * 8 * DM + i]);
        __syncthreads();
        for (int col = ftid(); col < DM; col += 512) {
            float a[8];
#pragma unroll
            for (int r = 0; r < 8; ++r) a[r] = 0.f;
            for (int k = 0; k < DM; ++k) { const float wa = W[(size_t)k * DM + col];
#pragma unroll
                for (int r = 0; r < 8; ++r) a[r] += sh[r * DM + k] * wa; }
#pragma unroll
            for (int r = 0; r < 8; ++r) { const int row = rg * 8 + r; const int b = row / SU, pp = row % SU; const int mrow = pp < NCTX ? 4 : b;
                xres[(size_t)row * DM + col] += modl[(size_t)mrow * 6144 + 2 * DM + col] * a[r]; }
        }
    }
    __syncthreads();
}
__device__ __forceinline__ void naive_mod(Frame& F, const Args& args) {
    float* mod = (float*)(F.ws + WS_MOD);
    for (int i = fbid() * 512 + ftid(); i < DEPTH * 5 * 6144; i += F.G * 512) {
        const int col = i % 6144, r = (i / 6144) % 5, l = i / (5 * 6144);
        const float* cv = r < 4 ? args.in[I_C] + r * DM : args.in[I_CCTX];
        const float* w = args.in[I_ADAW] + (size_t)l * DM * 6144 + col;
        float a = 0.f;
        for (int k = 0; k < DM; ++k) { const float v = cv[k]; a += (v / (1.0f + expf(-v))) * w[(size_t)k * 6144]; }
        mod[i] = a + args.in[I_ADAB][l * 6144 + col];
    }
}

__device__ __forceinline__ void naive_moe(Frame& F, const Args& args, int l) {
    LAS float* sh = (LAS float*)F.lds;
    LAS float* sa = sh + 8 * DM;
    LAS int* gstart = (LAS int*)(sa + 8 * FF);
    LAS int* stok = gstart + 40;
    const unsigned* cnt = F.ctl + CW_CNT + l * NEXP;
    const unsigned* list = (const unsigned*)(F.ws + WS_LIST);
    __syncthreads();
    if (ftid() == 0) { int acc = 0; for (int e = 0; e < NEXP; ++e) { gstart[e] = acc; acc += ((int)cnt[e] + 7) / 8; } gstart[NEXP] = acc; }
    __syncthreads();
    const int total = gstart[NEXP];
    float* YN = (float*)(F.ws + WS_YN);
    for (int gi = fbid(); gi < total; gi += F.G) {
        int e = 0; for (int k = 1; k < NEXP; ++k) e += (gstart[k] <= gi) ? 1 : 0;
        const int g = gi - gstart[e]; const int ce = (int)cnt[e];
        __syncthreads();
        if (ftid() < 8) { const int idx = 8 * g + ftid(); stok[ftid()] = idx < ce ? (int)list[(size_t)e * LIST_CAP + idx] : -1; }
        __syncthreads();
        for (int i = ftid(); i < 8 * DM; i += 512) { const int r = i >> 10, k = i & 1023; const int tk = stok[r]; sh[i] = tk >= 0 ? bf2f(((const bf16_t*)(F.ws + WS_HB))[(size_t)tk * DM + k]) : 0.f; }
        __syncthreads();
        const float* w1 = args.in[I_W1] + ((size_t)l * NEXP + e) * DM * FF; const float* w3 = args.in[I_W3] + ((size_t)l * NEXP + e) * DM * FF; const float* w2 = args.in[I_W2] + ((size_t)l * NEXP + e) * FF * DM;
        { const int col = ftid(); float a[8], b[8];
#pragma unroll
            for (int r = 0; r < 8; ++r) { a[r] = 0.f; b[r] = 0.f; }
            for (int k = 0; k < DM; ++k) { const float wa = w1[(size_t)k * FF + col], wb = w3[(size_t)k * FF + col];
#pragma unroll
                for (int r = 0; r < 8; ++r) { const float hv = sh[r * DM + k]; a[r] += hv * wa; b[r] += hv * wb; } }
#pragma unroll
            for (int r = 0; r < 8; ++r) sa[r * FF + col] = (a[r] / (1.0f + expf(-a[r]))) * b[r]; }
        __syncthreads();
        for (int col = ftid(); col < DM; col += 512) { float y[8];
#pragma unroll
            for (int r = 0; r < 8; ++r) y[r] = 0.f;
            for (int k = 0; k < FF; ++k) { const float wv = w2[(size_t)k * DM + col];
#pragma unroll
                for (int r = 0; r < 8; ++r) y[r] += sa[r * FF + k] * wv; }
#pragma unroll
            for (int r = 0; r < 8; ++r) { const int tk = stok[r]; if (tk >= 0) { const unsigned e0 = ((const unsigned*)(F.ws + WS_TOKINFO))[(size_t)tk * 8]; const int kk = (e0 == (unsigned)e) ? 0 : 1;
                YN[((size_t)tk * 2 + kk) * DM + col] = y[r]; } } }
    }
    __syncthreads();
}

constexpr int TLD = 136;
constexpr int TILE_BYTES = 128 * TLD * 2;
template <int NT, int KS>
__device__ __forceinline__ void wave_mma(f32x4 (&acc)[NT], const bf16x8 (&afr)[KS], const LAS bf16_t* Bt, int ldb, int lane) {
    const LAS bf16_t* bp = Bt + (lane & 15) * ldb + 8 * (lane >> 4);
#pragma unroll
    for (int nt = 0; nt < NT; ++nt)
#pragma unroll
        for (int ks = 0; ks < KS; ++ks) { const bf16x8 b = *(const LAS bf16x8*)(bp + nt * 16 * ldb + 32 * ks); acc[nt] = __builtin_amdgcn_mfma_f32_16x16x32_bf16(afr[ks], b, acc[nt], 0, 0, 0);
            if ((ks & 3) == 3 && (nt & 1) == 1) asm volatile("" ::: "memory"); }
}
template <int NT, int KS>
__device__ __forceinline__ void wave_mma2(f32x4 (&acc0)[NT], f32x4 (&acc1)[NT], const bf16x8 (&a0)[KS], const bf16x8 (&a1)[KS], const LAS bf16_t* Bt, int ldb, int lane) {
    const LAS bf16_t* bp = Bt + (lane & 15) * ldb + 8 * (lane >> 4);
#pragma unroll
    for (int nt = 0; nt < NT; ++nt) {
        bf16x8 b[KS];
#pragma unroll
        for (int ks = 0; ks < KS; ++ks) b[ks] = *(const LAS bf16x8*)(bp + nt * 16 * ldb + 32 * ks);
#pragma unroll
        for (int ks = 0; ks < KS; ++ks) { acc0[nt] = __builtin_amdgcn_mfma_f32_16x16x32_bf16(a0[ks], b[ks], acc0[nt], 0, 0, 0); acc1[nt] = __builtin_amdgcn_mfma_f32_16x16x32_bf16(a1[ks], b[ks], acc1[nt], 0, 0, 0); }
        if ((nt & 1) == 1) asm volatile("" ::: "memory");
    }
}
__device__ __forceinline__ void stage_rowmajor(LAS bf16_t* T, const bf16_t* src, size_t ld, int tid) {
#pragma unroll
    for (int i = 0; i < 4; ++i) { const int q = tid + 512 * i, r = q >> 4, cc = q & 15; const u32x4 v = *(const u32x4*)(src + (size_t)r * ld + 8 * cc); *(LAS u32x4*)(T + r * TLD + 8 * cc) = v; }
}
__device__ __forceinline__ void stage_transposed(LAS bf16_t* T, const bf16_t* src, size_t ld, int tid, bool scaled, float sa, float sb) {
#pragma unroll
    for (int i = 0; i < 2; ++i) { const int q = tid + 512 * i, rp = q & 63, cc = q >> 6;
        const u32x4 v0 = *(const u32x4*)(src + (size_t)(2 * rp) * ld + 8 * cc), v1 = *(const u32x4*)(src + (size_t)(2 * rp + 1) * ld + 8 * cc);
        const unsigned w0[4] = {v0.x, v0.y, v0.z, v0.w}, w1[4] = {v1.x, v1.y, v1.z, v1.w};
        LAS unsigned* tp = (LAS unsigned*)(T + (8 * cc) * TLD + 2 * rp);
        if (scaled) { const float s0 = exp2f(sa * (float)(2 * rp) + sb), s1 = exp2f(sa * (float)(2 * rp + 1) + sb);
#pragma unroll
            for (int k = 0; k < 4; ++k) { tp[(2 * k) * (TLD / 2)] = pk2(bflo(w0[k]) * s0, bflo(w1[k]) * s1); tp[(2 * k + 1) * (TLD / 2)] = pk2(bfhi(w0[k]) * s0, bfhi(w1[k]) * s1); }
        } else {
#pragma unroll
            for (int k = 0; k < 4; ++k) { tp[(2 * k) * (TLD / 2)] = (w0[k] & 0xffffu) | (w1[k] << 16); tp[(2 * k + 1) * (TLD / 2)] = (w0[k] >> 16) | (w1[k] & 0xffff0000u); }
        }
    }
}
__device__ __forceinline__ void stage_f32_rowmajor(LAS bf16_t* T, const float* src, int tid) {
#pragma unroll
    for (int i = 0; i < 8; ++i) { const int q = tid + 512 * i, r = q >> 5, cc = q & 31; const f32x4 v = *(const f32x4*)(src + (size_t)r * 128 + 4 * cc);
        u32x2 o; o.x = pk2(v.x, v.y); o.y = pk2(v.z, v.w); *(LAS u32x2*)(T + r * TLD + 4 * cc) = o; }
}
__device__ __forceinline__ float log2_gamma_f(const Frame& F, int p, int dir, int h) { return -expf(((const float*)(F.ws + WS_SP) + SP_DECAY)[(p * 2 + dir) * 4 + h]) * 1.4426950408889634f; }
#define log2_gamma(args, p, dir, h) log2_gamma_f(F, p, dir, h)

__device__ __forceinline__ void ret_state_item(Frame& F, const Args& args, int p, int item) {
    const int c = item % NCHUNK, h = (item / NCHUNK) & 3, b = item / (NCHUNK * 4);
    int tid = ftid(); asm volatile("" : "+v"(tid)); const int lane = tid & 63, w = F.wave;
    LAS bf16_t* T0 = (LAS bf16_t*)F.lds; LAS bf16_t* T1 = (LAS bf16_t*)(F.lds + TILE_BYTES); LAS bf16_t* T2 = (LAS bf16_t*)(F.lds + 2 * TILE_BYTES);
    const bf16_t* pe = (const bf16_t*)(F.ws + WS_PE) + ((size_t)b * SU + 128 * c) * EV_N;
    const float lgf = log2_gamma(args, p, 0, h), lgb = log2_gamma(args, p, 1, h);
    __syncthreads();
    stage_transposed(T0, pe + 512 + h * 128, EV_N, tid, false, 0.f, 0.f);
    stage_transposed(T1, pe + 1024 + h * 128, EV_N, tid, true, -lgf, 127.f * lgf);
    stage_transposed(T2, pe + 1024 + h * 128, EV_N, tid, true, lgb, 0.f);
    __syncthreads();
    float* st = (float*)(F.ws + WS_ST);
    {
        bf16x8 af[4], ab[4];
#pragma unroll
        for (int ks = 0; ks < 4; ++ks) { af[ks] = *(const LAS bf16x8*)(T1 + (16 * w + (lane & 15)) * TLD + 32 * ks + 8 * (lane >> 4)); ab[ks] = *(const LAS bf16x8*)(T2 + (16 * w + (lane & 15)) * TLD + 32 * ks + 8 * (lane >> 4)); }
        f32x4 accf[8], accb[8];
#pragma unroll
        for (int nt = 0; nt < 8; ++nt) { accf[nt] = (f32x4){0.f, 0.f, 0.f, 0.f}; accb[nt] = (f32x4){0.f, 0.f, 0.f, 0.f}; }
        wave_mma2<8, 4>(accf, accb, af, ab, T0, TLD, lane);
        float* dstf = st + ((((size_t)(b * 4 + h) * 2 + 0) * NCHUNK + c) * 128) * 128; float* dstb = st + ((((size_t)(b * 4 + h) * 2 + 1) * NCHUNK + c) * 128) * 128;
#pragma unroll
        for (int nt = 0; nt < 8; ++nt)
#pragma unroll
            for (int j = 0; j < 4; ++j) { const size_t o_ = (size_t)(16 * w + 4 * (lane >> 4) + j) * 128 + 16 * nt + (lane & 15); dstf[o_] = accf[nt][j]; dstb[o_] = accb[nt][j]; }
    }
}
__device__ __forceinline__ void ret_scan_phase(Frame& F, const Args& args, int p) {
    f32x4* st = (f32x4*)(F.ws + WS_ST);
    for (int i = fbid() * 512 + ftid(); i < 32 * 4096; i += F.G * 512) {
        const int bhd = i >> 12, el = i & 4095; const int dir = bhd & 1, h = (bhd >> 1) & 3;
        const float g128 = exp2f(128.f * log2_gamma(args, p, dir, h));
        f32x4* base = st + (size_t)bhd * NCHUNK * 4096 + el;
        f32x4 s = (f32x4){0.f, 0.f, 0.f, 0.f};
        for (int k = 0; k < NCHUNK; ++k) {
            const int c = dir == 0 ? k : (k < 2 ? 1 - k : NCHUNK + 1 - k);
            const f32x4 u = base[(size_t)c * 4096]; base[(size_t)c * 4096] = s; s = s * g128 + u;
        }
    }
}
__device__ __forceinline__ bf16x8 scale_frag(const bf16x8 a, float sc) {
    bf16x8 r;
#pragma unroll
    for (int k = 0; k < 8; ++k) r[k] = (short)f2bf(bf2f((unsigned)(unsigned short)a[k]) * sc);
    return r;
}
__device__ __forceinline__ void ret_out_item(Frame& F, const Args& args, int p, int item) {
    const int c = item % NCHUNK, h = (item / NCHUNK) & 3, b = item / (NCHUNK * 4);
    int tid = ftid(); asm volatile("" : "+v"(tid)); const int lane = tid & 63, w = F.wave, quad = lane >> 4, l15 = lane & 15;
    LAS bf16_t* T0 = (LAS bf16_t*)F.lds; LAS bf16_t* T1 = (LAS bf16_t*)(F.lds + TILE_BYTES); LAS bf16_t* T2 = (LAS bf16_t*)(F.lds + 2 * TILE_BYTES);
    const size_t row0 = (size_t)b * SU + 128 * c;
    const bf16_t* pe = (const bf16_t*)(F.ws + WS_PE) + row0 * EV_N;
    const float lgf = log2_gamma(args, p, 0, h), lgb = log2_gamma(args, p, 1, h);
    const float* stf = (const float*)(F.ws + WS_ST) + ((((size_t)(b * 4 + h) * 2 + 0) * NCHUNK + c) * 128) * 128;
    const float* stb = (const float*)(F.ws + WS_ST) + ((((size_t)(b * 4 + h) * 2 + 1) * NCHUNK + c) * 128) * 128;
    bf16x8 qf[4];
#pragma unroll
    for (int ks = 0; ks < 4; ++ks) qf[ks] = *(const bf16x8*)(pe + (size_t)(16 * w + l15) * EV_N + h * 128 + 32 * ks + 8 * quad);
    __syncthreads();
    stage_rowmajor(T0, pe + 512 + h * 128, EV_N, tid);
    stage_transposed(T1, pe + 1024 + h * 128, EV_N, tid, false, 0.f, 0.f);
    stage_f32_rowmajor(T2, stf, tid);
    __syncthreads();
    f32x4 ao[8];
#pragma unroll
    for (int nt = 0; nt < 8; ++nt) ao[nt] = (f32x4){0.f, 0.f, 0.f, 0.f};
    {
        const float cf = exp2f(lgf * (float)(16 * w + l15 + 1));
        bf16x8 qs[4];
#pragma unroll
        for (int ks = 0; ks < 4; ++ks) qs[ks] = scale_frag(qf[ks], cf);
        wave_mma<8, 4>(ao, qs, T2, TLD, lane);
    }
    {
        f32x4 aw[8];
#pragma unroll
        for (int nt = 0; nt < 8; ++nt) aw[nt] = (f32x4){0.f, 0.f, 0.f, 0.f};
        wave_mma<8, 4>(aw, qf, T0, TLD, lane);
        __syncthreads();
#pragma unroll
        for (int nt = 0; nt < 8; ++nt)
#pragma unroll
            for (int j = 0; j < 4; ++j) { const int i = 16 * w + 4 * quad + j, jj = 16 * nt + l15; const int d = i - jj;
                const float dec = d > 0 ? exp2f(lgf * (float)d) : (d < 0 ? exp2f(lgb * (float)(-d)) : 2.0f);
                T0[i * TLD + jj] = (bf16_t)f2bf(aw[nt][j] * dec); }
    }
    stage_f32_rowmajor(T2, stb, tid);
    __syncthreads();
    {
        bf16x8 pf[4];
#pragma unroll
        for (int ks = 0; ks < 4; ++ks) pf[ks] = *(const LAS bf16x8*)(T0 + (16 * w + l15) * TLD + 32 * ks + 8 * quad);
        wave_mma<8, 4>(ao, pf, T1, TLD, lane);
        const float cb = exp2f(lgb * (float)(128 - (16 * w + l15)));
#pragma unroll
        for (int ks = 0; ks < 4; ++ks) pf[ks] = scale_frag(qf[ks], cb);
        wave_mma<8, 4>(ao, pf, T2, TLD, lane);
    }
    bf16_t* yb = (bf16_t*)(F.ws + WS_YB16);
#pragma unroll
    for (int j = 0; j < 4; ++j) { const int i = 16 * w + 4 * quad + j;
        float ss = 0.f;
#pragma unroll
        for (int nt = 0; nt < 8; ++nt) ss += ao[nt][j] * ao[nt][j];
        ss += shx(ss, 1, lane); ss += shx(ss, 2, lane); ss += shx(ss, 4, lane); ss += shx(ss, 8, lane);
        const float rstd = 1.0f / sqrtf(ss * (1.0f / 128.f) + EPS);
        const bf16_t* gp = pe + (size_t)i * EV_N + 1536 + h * 128;
#pragma unroll
        for (int nt = 0; nt < 8; ++nt) { const float gt = bf2f(gp[16 * nt + l15]); yb[(row0 + i) * DM + h * 128 + 16 * nt + l15] = ABL_RET0 ? (bf16_t)0 : (bf16_t)f2bf(siluf(gt) * ao[nt][j] * rstd); }
    }
}
__device__ __forceinline__ void ret_direct_item(Frame& F, const Args& args, int p, int item) {
    const int c = item % NCHUNK, h = (item / NCHUNK) & 3, b = item / (NCHUNK * 4);
    int tid = ftid(); asm volatile("" : "+v"(tid)); const int lane = tid & 63, w = F.wave, quad = lane >> 4, l15 = lane & 15;
    LAS bf16_t* T0 = (LAS bf16_t*)F.lds; LAS bf16_t* T1 = (LAS bf16_t*)(F.lds + TILE_BYTES); LAS bf16_t* T2 = (LAS bf16_t*)(F.lds + 2 * TILE_BYTES);
    const size_t row0 = (size_t)b * SU + 128 * c;
    const bf16_t* peb = (const bf16_t*)(F.ws + WS_PE) + (size_t)b * SU * EV_N;
    const bf16_t* pe = peb + (size_t)128 * c * EV_N;
    const float lgf = log2_gamma(args, p, 0, h), lgb = log2_gamma(args, p, 1, h);
    bf16x8 qf[4];
#pragma unroll
    for (int ks = 0; ks < 4; ++ks) qf[ks] = *(const bf16x8*)(pe + (size_t)(16 * w + l15) * EV_N + h * 128 + 32 * ks + 8 * quad);
    f32x4 ao[8];
#pragma unroll
    for (int nt = 0; nt < 8; ++nt) ao[nt] = (f32x4){0.f, 0.f, 0.f, 0.f};
    for (int c2 = 0; c2 < NCHUNK; ++c2) {
        __syncthreads();
        stage_rowmajor(T0, peb + (size_t)128 * c2 * EV_N + 512 + h * 128, EV_N, tid);
        stage_transposed(T1, peb + (size_t)128 * c2 * EV_N + 1024 + h * 128, EV_N, tid, false, 0.f, 0.f);
        __syncthreads();
        f32x4 aw[8];
#pragma unroll
        for (int nt = 0; nt < 8; ++nt) aw[nt] = (f32x4){0.f, 0.f, 0.f, 0.f};
        wave_mma<8, 4>(aw, qf, T0, TLD, lane);
#pragma unroll
        for (int nt = 0; nt < 8; ++nt)
#pragma unroll
            for (int j = 0; j < 4; ++j) { const int i = 16 * w + 4 * quad + j, jj = 16 * nt + l15;
                const int px = 128 * c + i, py = 128 * c2 + jj;
                const int ubx = px < NCTX ? NCTX - 1 - px : SU + NCTX - 1 - px, uby = py < NCTX ? NCTX - 1 - py : SU + NCTX - 1 - py;
                float dec = 0.f;
                if (py <= px && !(px >= NCTX && false)) dec += exp2f(lgf * (float)(px - py));
                if (uby <= ubx) dec += exp2f(lgb * (float)(ubx - uby));
                if (px < NCTX && py >= NCTX) dec = 0.f;
                T2[i * TLD + jj] = (bf16_t)f2bf(aw[nt][j] * dec); }
        LDS_WAIT(); asm volatile("" ::: "memory");
        bf16x8 pf[4];
#pragma unroll
        for (int ks = 0; ks < 4; ++ks) pf[ks] = *(const LAS bf16x8*)(T2 + (16 * w + l15) * TLD + 32 * ks + 8 * quad);
        wave_mma<8, 4>(ao, pf, T1, TLD, lane);
    }
    bf16_t* yb = (bf16_t*)(F.ws + WS_YB16);
#pragma unroll
    for (int j = 0; j < 4; ++j) { const int i = 16 * w + 4 * quad + j;
        float ss = 0.f;
#pragma unroll
        for (int nt = 0; nt < 8; ++nt) ss += ao[nt][j] * ao[nt][j];
        ss += shx(ss, 1, lane); ss += shx(ss, 2, lane); ss += shx(ss, 4, lane); ss += shx(ss, 8, lane);
        const float rstd = 1.0f / sqrtf(ss * (1.0f / 128.f) + EPS);
        const bf16_t* gp = pe + (size_t)i * EV_N + 1536 + h * 128;
#pragma unroll
        for (int nt = 0; nt < 8; ++nt) { const float gt = bf2f(gp[16 * nt + l15]); yb[(row0 + i) * DM + h * 128 + 16 * nt + l15] = (bf16_t)f2bf(siluf(gt) * ao[nt][j] * rstd); }
    }
}
__device__ __forceinline__ void att_item(Frame& F, const Args& args, int p, int item) {
    const int qb = item % NCHUNK, hk = (item / NCHUNK) & 1, b = item / (NCHUNK * 2);
    int tid = ftid(); asm volatile("" : "+v"(tid)); const int lane = tid & 63, w = F.wave, quad = lane >> 4, l15 = lane & 15;
    const int g = w >> 2, hq = 2 * hk + g, qr0 = 32 * (w & 3);
    LAS bf16_t* T0 = (LAS bf16_t*)F.lds; LAS bf16_t* T1 = (LAS bf16_t*)(F.lds + TILE_BYTES);
    LAS bf16_t* Pw = (LAS bf16_t*)(F.lds + 2 * TILE_BYTES) + w * 32 * TLD;
    const bf16_t* peb = (const bf16_t*)(F.ws + WS_PE) + (size_t)b * SU * EV_N;
    const size_t qrow0 = (size_t)128 * qb + qr0;
    bf16x8 qf[2][4];
#pragma unroll
    for (int rt = 0; rt < 2; ++rt)
#pragma unroll
        for (int ks = 0; ks < 4; ++ks) qf[rt][ks] = *(const bf16x8*)(peb + (qrow0 + 16 * rt + l15) * EV_N + 2048 + hq * 128 + 32 * ks + 8 * quad);
    const float sink = ((const float*)(F.ws + WS_SP) + SP_SINK)[p * 4 + hq] * 1.4426950408889634f;
    const float scale = 0.08838834764831845f * 1.4426950408889634f;
    float mrow[2][4], lrow[2][4]; f32x4 ao[2][8];
#pragma unroll
    for (int rt = 0; rt < 2; ++rt) {
#pragma unroll
        for (int j = 0; j < 4; ++j) { mrow[rt][j] = sink; lrow[rt][j] = 1.0f; }
#pragma unroll
        for (int nt = 0; nt < 8; ++nt) ao[rt][nt] = (f32x4){0.f, 0.f, 0.f, 0.f};
    }
    const int ntile = (qb < 2) ? 2 : 5;
    for (int ti = 0; ti < ntile; ++ti) {
        int kt, mode = 0;
        if (ti < 2) kt = ti; else { kt = qb + (ti - 3); mode = (ti == 2) ? 1 : (ti == 4 ? 2 : 0); }
        if (ti >= 2 && (kt < 2 || kt >= NCHUNK)) continue;
        __syncthreads();
        stage_rowmajor(T0, peb + (size_t)128 * kt * EV_N + 2560 + hk * 128, EV_N, tid);
        stage_transposed(T1, peb + (size_t)128 * kt * EV_N + 2816 + hk * 128, EV_N, tid, false, 0.f, 0.f);
        __syncthreads();
        f32x4 s2[2][8];
#pragma unroll
        for (int nt = 0; nt < 8; ++nt) { s2[0][nt] = (f32x4){0.f, 0.f, 0.f, 0.f}; s2[1][nt] = (f32x4){0.f, 0.f, 0.f, 0.f}; }
        wave_mma2<8, 4>(s2[0], s2[1], qf[0], qf[1], T0, TLD, lane);
#pragma unroll
        for (int rt = 0; rt < 2; ++rt) {
            f32x4 (&s)[8] = s2[rt];
#pragma unroll
            for (int j = 0; j < 4; ++j) {
                const int qq = qr0 + 16 * rt + 4 * quad + j;
                float mx = -3.0e38f;
                if (mode == 0) {
#pragma unroll
                    for (int nt = 0; nt < 8; ++nt) { const float v = s[nt][j] * scale; s[nt][j] = v; mx = fmaxf(mx, v); }
                } else {
#pragma unroll
                    for (int nt = 0; nt < 8; ++nt) { const int kk = 16 * nt + l15; float v = s[nt][j] * scale;
                        const bool valid = (mode == 1 ? (kk >= qq) : (kk <= qq));
                        v = valid ? v : -3.0e38f; s[nt][j] = v; mx = fmaxf(mx, v); }
                }
                mx = fmaxf(mx, shx(mx, 1, lane)); mx = fmaxf(mx, shx(mx, 2, lane)); mx = fmaxf(mx, shx(mx, 4, lane)); mx = fmaxf(mx, shx(mx, 8, lane));
                const float mn = fmaxf(mrow[rt][j], mx); const float alpha = __builtin_amdgcn_exp2f(mrow[rt][j] - mn);
                float rs = 0.f;
#pragma unroll
                for (int nt = 0; nt < 8; ++nt) { const float pv = __builtin_amdgcn_exp2f(s[nt][j] - mn); rs += pv;     Pw[(16 * rt + 4 * quad + j) * TLD + 16 * nt + l15] = (bf16_t)f2bf(pv); }
                rs += shx(rs, 1, lane); rs += shx(rs, 2, lane); rs += shx(rs, 4, lane); rs += shx(rs, 8, lane);
                lrow[rt][j] = lrow[rt][j] * alpha + rs; mrow[rt][j] = mn;
#pragma unroll
                for (int nt = 0; nt < 8; ++nt) ao[rt][nt][j] *= alpha;
            }
        }
        LDS_WAIT(); asm volatile("" ::: "memory");
        {
            bf16x8 pf0[4], pf1[4];
#pragma unroll
            for (int ks = 0; ks < 4; ++ks) { pf0[ks] = *(const LAS bf16x8*)(Pw + (l15) * TLD + 32 * ks + 8 * quad); pf1[ks] = *(const LAS bf16x8*)(Pw + (16 + l15) * TLD + 32 * ks + 8 * quad); }
            wave_mma2<8, 4>(ao[0], ao[1], pf0, pf1, T1, TLD, lane);
        }
    }
    bf16_t* yb = (bf16_t*)(F.ws + WS_YB16) + ((size_t)b * SU + qrow0) * DM + 512 + hq * 128;
#pragma unroll
    for (int rt = 0; rt < 2; ++rt)
#pragma unroll
        for (int j = 0; j < 4; ++j) { const float inv = 1.0f / lrow[rt][j];
#pragma unroll
            for (int nt = 0; nt < 8; ++nt) yb[(size_t)(16 * rt + 4 * quad + j) * DM + 16 * nt + l15] = ABL_ATT0 ? (bf16_t)0 : (bf16_t)f2bf(ao[rt][nt][j] * inv); }
}
__device__ __forceinline__ void naive_att(Frame& F, const Args& args, int p) {
    const int gw = F.vcu * NWAVES + F.wave, NGW = F.G * NWAVES, lane = flane();
    LAS float* sq = (LAS float*)F.lds + F.wave * 1024;
    LAS float* sc = sq + 128;
    const bf16_t* pe = (const bf16_t*)(F.ws + WS_PE);
    for (int task = gw; task < MTOK * 4; task += NGW) {
        const int row = task >> 2, hq = task & 3, hk = hq >> 1; const int b = row / SU, pq = row % SU;
        const bf16_t* peb = pe + (size_t)b * SU * EV_N;
        sq[lane] = bf2f(peb[(size_t)pq * EV_N + 2048 + hq * 128 + lane]) * 0.08838834764831845f; sq[lane + 64] = bf2f(peb[(size_t)pq * EV_N + 2048 + hq * 128 + lane + 64]) * 0.08838834764831845f;
        LDS_WAIT(); asm volatile("" ::: "memory");
        int lo = 0, nloc = 0;
        if (pq >= NCTX) { const int t = pq - NCTX; lo = t - 128 < 0 ? 0 : t - 128; const int hi = t + 128 > LSEQ - 1 ? LSEQ - 1 : t + 128; nloc = hi - lo + 1; }
        const int nk = NCTX + nloc;
        const float sink = args.in[I_SINK][p * 4 + hq];
        float mx = sink;
        for (int ki = lane; ki < nk; ki += 64) { const int kp = ki < NCTX ? ki : NCTX + lo + (ki - NCTX);
            const bf16_t* kr = peb + (size_t)kp * EV_N + 2560 + hk * 128; float d = 0.f;
            for (int x = 0; x < 128; ++x) d += sq[x] * bf2f(kr[x]);
            sc[ki] = d; mx = fmaxf(mx, d); }
#pragma unroll
        for (int o = 1; o < 64; o <<= 1) mx = fmaxf(mx, shx(mx, o, lane));
        float sum = 0.f;
        for (int ki = lane; ki < nk; ki += 64) { const float e = expf(sc[ki] - mx); sc[ki] = e; sum += e; }
        sum = wave_sum(sum, lane) + expf(sink - mx);
        LDS_WAIT(); asm volatile("" ::: "memory");
        float o0 = 0.f, o1 = 0.f;
        for (int ki = 0; ki < nk; ++ki) { const int kp = ki < NCTX ? ki : NCTX + lo + (ki - NCTX); const bf16_t* vr = peb + (size_t)kp * EV_N + 2816 + hk * 128; const float pv = sc[ki];
            o0 += pv * bf2f(vr[lane]); o1 += pv * bf2f(vr[lane + 64]); }
        bf16_t* yb = (bf16_t*)(F.ws + WS_YB16) + (size_t)row * DM + 512 + hq * 128;
        yb[lane] = (bf16_t)f2bf(o0 / sum); yb[lane + 64] = (bf16_t)f2bf(o1 / sum);
        LDS_WAIT(); asm volatile("" ::: "memory");
    }
}
__device__ __forceinline__ void hg_scan_item_plain(Frame& F, int item) {
    const int es = item & 3, dir = (item >> 2) & 1, h = (item >> 3) & 7, b = item >> 6;
    const int tid = ftid(), e = tid & 31, dg = tid >> 5;
    LAS float* sP = (LAS float*)F.lds;
    LAS float* sIn = sP + 32 * 16 * 32;
    constexpr int INB = 32 * 128 * 2 + 32 * 32;
    const float* fsrc = (const float*)(F.ws + (dir ? WS_FB : WS_FF));
    const bf16_t* qsrc = (const bf16_t*)(F.ws + WS_PQ); const bf16_t* vsrc = (const bf16_t*)(F.ws + WS_PI);
    float* osrc = (float*)(F.ws + (dir ? WS_OB : WS_OF));
    float S[8];
#pragma unroll
    for (int k = 0; k < 8; ++k) S[k] = 0.f;
    const size_t rb = (size_t)b * SU;
    f32x4 rf0, rf1; u32x4 rq, rv;
    auto pos_of = [&](int s) { return dir ? (s < NCTX ? NCTX - 1 - s : SU + NCTX - 1 - s) : s; };
#define HG_ISSUE(s0_) do { const int pA = pos_of((s0_) + (tid >> 5)), pB = pos_of((s0_) + 16 + (tid >> 5)), pQ = pos_of((s0_) + (tid >> 4)); \
        rf0 = *(const f32x4*)(fsrc + (rb + pA) * DM + h * 128 + 4 * (tid & 31)); rf1 = *(const f32x4*)(fsrc + (rb + pB) * DM + h * 128 + 4 * (tid & 31)); \
        rq = *(const u32x4*)(qsrc + (rb + pQ) * DM + h * 128 + 8 * (tid & 15)); \
        if (tid < 128) { const int pV = pos_of((s0_) + (tid >> 2)); rv = *(const u32x4*)(vsrc + (rb + pV) * DM + h * 128 + 32 * es + 8 * (tid & 3)); } } while (0)
#define HG_WRITE(buf_) do { LAS float* bF = sIn + (buf_) * INB; LAS float* bQ = bF + 32 * 128; LAS float* bV = bQ + 32 * 128; \
        *(LAS f32x4*)(bF + (tid >> 5) * 128 + 4 * (tid & 31)) = rf0; *(LAS f32x4*)(bF + (16 + (tid >> 5)) * 128 + 4 * (tid & 31)) = rf1; \
        { LAS float* d = bQ + (tid >> 4) * 128 + 8 * (tid & 15); *(LAS f32x4*)d = (f32x4){bflo(rq.x), bfhi(rq.x), bflo(rq.y), bfhi(rq.y)}; *(LAS f32x4*)(d + 4) = (f32x4){bflo(rq.z), bfhi(rq.z), bflo(rq.w), bfhi(rq.w)}; } \
        if (tid < 128) { LAS float* d = bV + (tid >> 2) * 32 + 8 * (tid & 3); *(LAS f32x4*)d = (f32x4){bflo(rv.x), bfhi(rv.x), bflo(rv.y), bfhi(rv.y)}; *(LAS f32x4*)(d + 4) = (f32x4){bflo(rv.z), bfhi(rv.z), bflo(rv.w), bfhi(rv.w)}; } } while (0)
    __syncthreads();
    HG_ISSUE(0); HG_WRITE(0);
    __syncthreads();
    constexpr int NTB = SU / 32;
    for (int tb = 0; tb < NTB; ++tb) {
        const int s0 = 32 * tb, cur = tb & 1;
        if (tb + 1 < NTB) HG_ISSUE(s0 + 32);
        const LAS float* sF = sIn + cur * INB; const LAS float* sQ = sF + 32 * 128; const LAS float* sV = sQ + 32 * 128;
#pragma unroll 4
        for (int tt = 0; tt < 32; ++tt) {
            const f32x4 f0 = *(const LAS f32x4*)(sF + tt * 128 + 8 * dg), f1 = *(const LAS f32x4*)(sF + tt * 128 + 8 * dg + 4);
            const f32x4 q0 = *(const LAS f32x4*)(sQ + tt * 128 + 8 * dg), q1 = *(const LAS f32x4*)(sQ + tt * 128 + 8 * dg + 4);
            const float v = sV[tt * 32 + e];
            const float ff[8] = {f0.x, f0.y, f0.z, f0.w, f1.x, f1.y, f1.z, f1.w}; const float qq[8] = {q0.x, q0.y, q0.z, q0.w, q1.x, q1.y, q1.z, q1.w};
            float part = 0.f;
#pragma unroll
            for (int k = 0; k < 8; ++k) { S[k] = ff[k] * S[k] + (1.0f - ff[k]) * v; part += qq[k] * S[k]; }
            sP[(tt * 16 + dg) * 32 + e] = part;
        }
        __syncthreads();
#pragma unroll
        for (int i = 0; i < 2; ++i) { const int q = tid + 512 * i, tt = q >> 5, ee = q & 31; float o = 0.f;
#pragma unroll
            for (int k = 0; k < 16; ++k) o += sP[(tt * 16 + k) * 32 + ee];
            osrc[(rb + pos_of(s0 + tt)) * DM + h * 128 + 32 * es + ee] = o; }
        if (tb + 1 < NTB) HG_WRITE(cur ^ 1);
        __syncthreads();
    }
#undef HG_ISSUE
#undef HG_WRITE
}
__device__ __forceinline__ void hg_scan_item_c16(Frame& F, int item) {
    const int es = item & 3, dir = (item >> 2) & 1, h = (item >> 3) & 7, b = item >> 6;
    const int tid = ftid(), lane = tid & 63, w = F.wave, quad = lane >> 4, l15 = lane & 15;
    constexpr int INB = 32 * 128 * 2 + 32 * 32;
    LAS float* sIn = (LAS float*)F.lds;
    LAS bf16_t* QA = (LAS bf16_t*)(sIn + 2 * INB);
    LAS bf16_t* KB = QA + 2 * 16 * 136;
    LAS bf16_t* KC = KB + 2 * 16 * 136;
    LAS bf16_t* VT = KC + 2 * 128 * 40;
    LAS bf16_t* PP = VT + 2 * 32 * 40;
    LAS bf16_t* ST = PP + 2 * 16 * 40;
    LAS float* DEC = (LAS float*)(ST + 32 * 136);
    const float* fsrc = (const float*)(F.ws + (dir ? WS_FB : WS_FF));
    const bf16_t* qsrc = (const bf16_t*)(F.ws + WS_PQ); const bf16_t* vsrc = (const bf16_t*)(F.ws + WS_PI);
    float* osrc = (float*)(F.ws + (dir ? WS_OB : WS_OF));
    const size_t rb = (size_t)b * SU;
    f32x4 S[2] = {(f32x4){0.f, 0.f, 0.f, 0.f}, (f32x4){0.f, 0.f, 0.f, 0.f}};
    f32x4 rf0, rf1; u32x4 rq, rv;
    auto pos_of = [&](int s) { return dir ? (s < NCTX ? NCTX - 1 - s : SU + NCTX - 1 - s) : s; };
#define HG_ISSUE(s0_) do { const int pA = pos_of((s0_) + (tid >> 5)), pB = pos_of((s0_) + 16 + (tid >> 5)), pQ = pos_of((s0_) + (tid >> 4)); \
        rf0 = *(const f32x4*)(fsrc + (rb + pA) * DM + h * 128 + 4 * (tid & 31)); rf1 = *(const f32x4*)(fsrc + (rb + pB) * DM + h * 128 + 4 * (tid & 31)); \
        rq = *(const u32x4*)(qsrc + (rb + pQ) * DM + h * 128 + 8 * (tid & 15)); \
        if (tid < 128) { const int pV = pos_of((s0_) + (tid >> 2)); rv = *(const u32x4*)(vsrc + (rb + pV) * DM + h * 128 + 32 * es + 8 * (tid & 3)); } } while (0)
#define HG_WRITE(buf_) do { LAS float* bF = sIn + (buf_) * INB; LAS float* bQ = bF + 32 * 128; LAS float* bV = bQ + 32 * 128; \
        *(LAS f32x4*)(bF + (tid >> 5) * 128 + 4 * (tid & 31)) = rf0; *(LAS f32x4*)(bF + (16 + (tid >> 5)) * 128 + 4 * (tid & 31)) = rf1; \
        { LAS float* d = bQ + (tid >> 4) * 128 + 8 * (tid & 15); *(LAS f32x4*)d = (f32x4){bflo(rq.x), bfhi(rq.x), bflo(rq.y), bfhi(rq.y)}; *(LAS f32x4*)(d + 4) = (f32x4){bflo(rq.z), bfhi(rq.z), bflo(rq.w), bfhi(rq.w)}; } \
        if (tid < 128) { LAS float* d = bV + (tid >> 2) * 32 + 8 * (tid & 3); *(LAS f32x4*)d = (f32x4){bflo(rv.x), bfhi(rv.x), bflo(rv.y), bfhi(rv.y)}; *(LAS f32x4*)(d + 4) = (f32x4){bflo(rv.z), bfhi(rv.z), bflo(rv.w), bfhi(rv.w)}; } } while (0)
    __syncthreads();
    for (int i = tid; i < 2 * 128 * 40; i += 512) KC[i] = 0;
    for (int i = tid; i < 2 * 32 * 40; i += 512) VT[i] = 0;
    for (int i = tid; i < 2 * 16 * 40; i += 512) PP[i] = 0;
    for (int i = tid; i < 32 * 136; i += 512) ST[i] = 0;
    HG_ISSUE(0); HG_WRITE(0);
    __syncthreads();
    constexpr int NTB = SU / 32;
#define HG_BAR() do { asm volatile("s_waitcnt lgkmcnt(0)" ::: "memory"); __builtin_amdgcn_s_barrier(); asm volatile("" ::: "memory"); } while (0)
    for (int tb = 0; tb < NTB; ++tb) {
        const int s0 = 32 * tb, cur = tb & 1;
        if (tb + 1 < NTB) HG_ISSUE(s0 + 32);
        const LAS float* sF = sIn + cur * INB; const LAS float* sQ = sF + 32 * 128; const LAS float* sV = sQ + 32 * 128;
        if (tid < 256) {
            const int c = tid >> 7, d = tid & 127;
            float a = 0.f, kbv[16], fv[16], qv[16];
#pragma unroll
            for (int i = 0; i < 16; ++i) { fv[i] = sF[(16 * c + i) * 128 + d]; qv[i] = sQ[(16 * c + i) * 128 + d]; }
#pragma unroll
            for (int i = 0; i < 16; ++i) { const float f = fv[i], q = qv[i];
                a += __builtin_amdgcn_logf(f); const float ea = __builtin_amdgcn_exp2f(a);
                QA[(c * 16 + i) * 136 + d] = (bf16_t)f2bf(q * ea); kbv[i] = (1.0f - f) * __builtin_amdgcn_exp2f(-a); }
            const float al = __builtin_amdgcn_exp2f(a); DEC[c * 128 + d] = al;
            unsigned pk[8];
#pragma unroll
            for (int j = 0; j < 16; ++j) { KB[(c * 16 + j) * 136 + d] = (bf16_t)f2bf(kbv[j]); }
#pragma unroll
            for (int j = 0; j < 8; ++j) pk[j] = pk2(kbv[2 * j] * al, kbv[2 * j + 1] * al);
            LAS u32x4* kd = (LAS u32x4*)(KC + (c * 128 + d) * 40); kd[0] = (u32x4){pk[0], pk[1], pk[2], pk[3]}; kd[1] = (u32x4){pk[4], pk[5], pk[6], pk[7]};
        } else {
            const int idx = tid - 256, c = idx >> 7, e = (idx >> 2) & 31, jq = idx & 3;
            const float v0 = sV[(16 * c + 4 * jq + 0) * 32 + e], v1 = sV[(16 * c + 4 * jq + 1) * 32 + e], v2 = sV[(16 * c + 4 * jq + 2) * 32 + e], v3 = sV[(16 * c + 4 * jq + 3) * 32 + e];
            u32x2 o; o.x = pk2(v0, v1); o.y = pk2(v2, v3); *(LAS u32x2*)(VT + (c * 32 + e) * 40 + 4 * jq) = o;
        }
        HG_BAR();
        bf16x8 qa[4]; f32x4 oi[2] = {(f32x4){0.f, 0.f, 0.f, 0.f}, (f32x4){0.f, 0.f, 0.f, 0.f}};
        bf16x8 sb0[2][4];
        if (w < 2) {
            const int c = w;
            bf16x8 kbf[4], vbf[2];
#pragma unroll
            for (int ks = 0; ks < 4; ++ks) { qa[ks] = *(const LAS bf16x8*)(QA + (c * 16 + l15) * 136 + 32 * ks + 8 * quad); kbf[ks] = *(const LAS bf16x8*)(KB + (c * 16 + l15) * 136 + 32 * ks + 8 * quad); }
#pragma unroll
            for (int nt = 0; nt < 2; ++nt) vbf[nt] = *(const LAS bf16x8*)(VT + (c * 32 + 16 * nt + l15) * 40 + 8 * quad);
            if (c == 0) {
#pragma unroll
                for (int nt = 0; nt < 2; ++nt)
#pragma unroll
                    for (int ks = 0; ks < 4; ++ks) sb0[nt][ks] = *(const LAS bf16x8*)(ST + (16 * nt + l15) * 136 + 32 * ks + 8 * quad);
            }
            f32x4 sc = (f32x4){0.f, 0.f, 0.f, 0.f};
#pragma unroll
            for (int ks = 0; ks < 4; ++ks) sc = __builtin_amdgcn_mfma_f32_16x16x32_bf16(qa[ks], kbf[ks], sc, 0, 0, 0);
#pragma unroll
            for (int jj = 0; jj < 4; ++jj) { const int i = 4 * quad + jj; PP[(c * 16 + i) * 40 + l15] = (bf16_t)f2bf(l15 <= i ? sc[jj] : 0.f); }
            LDS_WAIT(); asm volatile("" ::: "memory");
            const bf16x8 pa = *(const LAS bf16x8*)(PP + (c * 16 + l15) * 40 + 8 * quad);
#pragma unroll
            for (int nt = 0; nt < 2; ++nt) oi[nt] = __builtin_amdgcn_mfma_f32_16x16x32_bf16(pa, vbf[nt], oi[nt], 0, 0, 0);
        }
#pragma unroll
        for (int c = 0; c < 2; ++c) {
            if (w == c) {
                if (c == 1) {
#pragma unroll
                    for (int nt = 0; nt < 2; ++nt)
#pragma unroll
                        for (int ks = 0; ks < 4; ++ks) sb0[nt][ks] = *(const LAS bf16x8*)(ST + (16 * nt + l15) * 136 + 32 * ks + 8 * quad);
                }
#pragma unroll
                for (int ks = 0; ks < 4; ++ks)
#pragma unroll
                    for (int nt = 0; nt < 2; ++nt) oi[nt] = __builtin_amdgcn_mfma_f32_16x16x32_bf16(qa[ks], sb0[nt][ks], oi[nt], 0, 0, 0);
#pragma unroll
                for (int jj = 0; jj < 4; ++jj) { const int pp = pos_of(s0 + 16 * c + 4 * quad + jj); float* op = osrc + (rb + pp) * DM + h * 128 + 32 * es + l15; op[0] = oi[0][jj]; op[16] = oi[1][jj]; }
            }
            {
                const f32x4 dc = *(const LAS f32x4*)(DEC + c * 128 + 16 * w + 4 * quad);
                const bf16x8 ka = *(const LAS bf16x8*)(KC + (c * 128 + 16 * w + l15) * 40 + 8 * quad);
#pragma unroll
                for (int nt = 0; nt < 2; ++nt) { const bf16x8 vb = *(const LAS bf16x8*)(VT + (c * 32 + 16 * nt + l15) * 40 + 8 * quad); S[nt] = S[nt] * dc; S[nt] = __builtin_amdgcn_mfma_f32_16x16x32_bf16(ka, vb, S[nt], 0, 0, 0); }
            }
            HG_BAR();
#pragma unroll
            for (int nt = 0; nt < 2; ++nt)
#pragma unroll
                for (int jj = 0; jj < 4; ++jj) ST[(16 * nt + l15) * 136 + 16 * w + 4 * quad + jj] = (bf16_t)f2bf(S[nt][jj]);
            if (c == 1 && tb + 1 < NTB) HG_WRITE(cur ^ 1);
            HG_BAR();
        }
    }
#undef HG_ISSUE
#undef HG_WRITE
#undef HG_BAR
}
__device__ __forceinline__ void hg_scan_item_c32(Frame& F, int item) {
    const int es = item & 3, dir = (item >> 2) & 1, h = (item >> 3) & 7, b = item >> 6;
    const int tid = ftid(), lane = tid & 63, w = F.wave, quad = lane >> 4, l15 = lane & 15;
    constexpr int INB = 32 * 128 * 2 + 32 * 32;
    LAS float* sIn = (LAS float*)F.lds;
    LAS bf16_t* QA = (LAS bf16_t*)(sIn + 2 * INB);
    LAS bf16_t* KB = QA + 32 * 136;
    LAS bf16_t* KC = KB + 32 * 136;
    LAS bf16_t* VT = KC + 128 * 40;
    LAS bf16_t* PP = VT + 32 * 40;
    LAS bf16_t* ST = PP + 32 * 40;
    LAS float* DEC = (LAS float*)(ST + 32 * 136);
    const float* fsrc = (const float*)(F.ws + (dir ? WS_FB : WS_FF));
    const bf16_t* qsrc = (const bf16_t*)(F.ws + WS_PQ); const bf16_t* vsrc = (const bf16_t*)(F.ws + WS_PI);
    float* osrc = (float*)(F.ws + (dir ? WS_OB : WS_OF));
    const size_t rb = (size_t)b * SU;
    f32x4 S[2] = {(f32x4){0.f, 0.f, 0.f, 0.f}, (f32x4){0.f, 0.f, 0.f, 0.f}};
    f32x4 rf0A, rf1A, rf0B, rf1B; u32x4 rqA, rvA, rqB, rvB;
    auto pos_of = [&](int s) { return dir ? (s < NCTX ? NCTX - 1 - s : SU + NCTX - 1 - s) : s; };
#define HG_ISSUE(rf0, rf1, rq, rv, s0_) do { const int pA = pos_of((s0_) + (tid >> 5)), pB = pos_of((s0_) + 16 + (tid >> 5)), pQ = pos_of((s0_) + (tid >> 4)); \
        rf0 = *(const f32x4*)(fsrc + (rb + pA) * DM + h * 128 + 4 * (tid & 31)); rf1 = *(const f32x4*)(fsrc + (rb + pB) * DM + h * 128 + 4 * (tid & 31)); \
        rq = *(const u32x4*)(qsrc + (rb + pQ) * DM + h * 128 + 8 * (tid & 15)); \
        if (tid < 128) { const int pV = pos_of((s0_) + (tid >> 2)); rv = *(const u32x4*)(vsrc + (rb + pV) * DM + h * 128 + 32 * es + 8 * (tid & 3)); } } while (0)
#define HG_WRITE(rf0, rf1, rq, rv, buf_) do { LAS float* bF = sIn + (buf_) * INB; LAS float* bQ = bF + 32 * 128; LAS float* bV = bQ + 32 * 128; \
        *(LAS f32x4*)(bF + (tid >> 5) * 128 + 4 * (tid & 31)) = rf0; *(LAS f32x4*)(bF + (16 + (tid >> 5)) * 128 + 4 * (tid & 31)) = rf1; \
        { LAS float* d = bQ + (tid >> 4) * 128 + 8 * (tid & 15); *(LAS f32x4*)d = (f32x4){bflo(rq.x), bfhi(rq.x), bflo(rq.y), bfhi(rq.y)}; *(LAS f32x4*)(d + 4) = (f32x4){bflo(rq.z), bfhi(rq.z), bflo(rq.w), bfhi(rq.w)}; } \
        if (tid < 128) { LAS float* d = bV + (tid >> 2) * 32 + 8 * (tid & 3); *(LAS f32x4*)d = (f32x4){bflo(rv.x), bfhi(rv.x), bflo(rv.y), bfhi(rv.y)}; *(LAS f32x4*)(d + 4) = (f32x4){bflo(rv.z), bfhi(rv.z), bflo(rv.w), bfhi(rv.w)}; } } while (0)
#define HG_BAR() do { asm volatile("s_waitcnt lgkmcnt(0)" ::: "memory"); __builtin_amdgcn_s_barrier(); asm volatile("" ::: "memory"); } while (0)
    __syncthreads();
    for (int i = tid; i < 32 * 136; i += 512) ST[i] = 0;
    HG_ISSUE(rf0A, rf1A, rqA, rvA, 0); HG_WRITE(rf0A, rf1A, rqA, rvA, 0);
    HG_ISSUE(rf0B, rf1B, rqB, rvB, 32);
    __syncthreads();
    constexpr int NTB = SU / 32;
    auto blk = [&](const int tb, const int cur) __attribute__((always_inline)) {
        const int s0 = 32 * tb;
        const LAS float* sF = sIn + cur * INB; const LAS float* sQ = sF + 32 * 128; const LAS float* sV = sQ + 32 * 128;
        if (tid < 256) {
            const int c = tid & 1, d = tid >> 1;
            float fv[16], qv[16], kbv[16];
#pragma unroll
            for (int i = 0; i < 16; ++i) { fv[i] = sF[(16 * c + i) * 128 + d]; qv[i] = sQ[(16 * c + i) * 128 + d]; }
            float tot = 1.f;
#pragma unroll
            for (int i = 0; i < 16; ++i) tot *= fv[i];
            const float oth = shx(tot, 1, lane);
            float ea = c ? oth : 1.f;
            float eia = __builtin_amdgcn_rcpf(ea);
            const float al = tot * oth;
#pragma unroll
            for (int i = 0; i < 16; ++i) { const float fo = fv[i]; ea *= fo; eia *= __builtin_amdgcn_rcpf(fo);
                QA[(16 * c + i) * 136 + d] = (bf16_t)f2bf(qv[i] * ea); kbv[i] = (1.0f - fo) * eia; }
            if (c == 0) DEC[d] = al;
            unsigned pk[8];
#pragma unroll
            for (int j = 0; j < 16; ++j) KB[(16 * c + j) * 136 + d] = (bf16_t)f2bf(kbv[j]);
#pragma unroll
            for (int j = 0; j < 8; ++j) pk[j] = pk2(kbv[2 * j] * al, kbv[2 * j + 1] * al);
            LAS u32x4* kd = (LAS u32x4*)(KC + d * 40 + 16 * c); kd[0] = (u32x4){pk[0], pk[1], pk[2], pk[3]}; kd[1] = (u32x4){pk[4], pk[5], pk[6], pk[7]};
        } else {
            const int idx = tid - 256, e = idx >> 3, jq = idx & 7;
            const float v0 = sV[(4 * jq + 0) * 32 + e], v1 = sV[(4 * jq + 1) * 32 + e], v2 = sV[(4 * jq + 2) * 32 + e], v3 = sV[(4 * jq + 3) * 32 + e];
            u32x2 o; o.x = pk2(v0, v1); o.y = pk2(v2, v3); *(LAS u32x2*)(VT + e * 40 + 4 * jq) = o;
        }
        HG_BAR();
        if (w < 2) {
            const int it = w;
            bf16x8 qa[4], kbf[2][4], vbf[2], sbf[2][4];
#pragma unroll
            for (int ks = 0; ks < 4; ++ks) { qa[ks] = *(const LAS bf16x8*)(QA + (16 * it + l15) * 136 + 32 * ks + 8 * quad);
                kbf[0][ks] = *(const LAS bf16x8*)(KB + (l15) * 136 + 32 * ks + 8 * quad); kbf[1][ks] = *(const LAS bf16x8*)(KB + (16 + l15) * 136 + 32 * ks + 8 * quad); }
#pragma unroll
            for (int nt = 0; nt < 2; ++nt) { vbf[nt] = *(const LAS bf16x8*)(VT + (16 * nt + l15) * 40 + 8 * quad);
#pragma unroll
                for (int ks = 0; ks < 4; ++ks) sbf[nt][ks] = *(const LAS bf16x8*)(ST + (16 * nt + l15) * 136 + 32 * ks + 8 * quad); }
            f32x4 sc0 = (f32x4){0.f, 0.f, 0.f, 0.f}, sc1 = (f32x4){0.f, 0.f, 0.f, 0.f};
#pragma unroll
            for (int ks = 0; ks < 4; ++ks) { sc0 = __builtin_amdgcn_mfma_f32_16x16x32_bf16(qa[ks], kbf[0][ks], sc0, 0, 0, 0); sc1 = __builtin_amdgcn_mfma_f32_16x16x32_bf16(qa[ks], kbf[1][ks], sc1, 0, 0, 0); }
#pragma unroll
            for (int jj = 0; jj < 4; ++jj) { const int i = 16 * it + 4 * quad + jj;
                PP[i * 40 + l15] = (bf16_t)f2bf(l15 <= i ? sc0[jj] : 0.f); PP[i * 40 + 16 + l15] = (bf16_t)f2bf(16 + l15 <= i ? sc1[jj] : 0.f); }
            LDS_WAIT(); asm volatile("" ::: "memory");
            const bf16x8 pa = *(const LAS bf16x8*)(PP + (16 * it + l15) * 40 + 8 * quad);
            f32x4 oi[2];
#pragma unroll
            for (int nt = 0; nt < 2; ++nt) { oi[nt] = __builtin_amdgcn_mfma_f32_16x16x32_bf16(pa, vbf[nt], (f32x4){0.f, 0.f, 0.f, 0.f}, 0, 0, 0);
#pragma unroll
                for (int ks = 0; ks < 4; ++ks) oi[nt] = __builtin_amdgcn_mfma_f32_16x16x32_bf16(qa[ks], sbf[nt][ks], oi[nt], 0, 0, 0); }
#pragma unroll
            for (int jj = 0; jj < 4; ++jj) { const int pp = pos_of(s0 + 16 * it + 4 * quad + jj); float* op = osrc + (rb + pp) * DM + h * 128 + 32 * es + l15; op[0] = oi[0][jj]; op[16] = oi[1][jj]; }
        }
        {
            const f32x4 dc = *(const LAS f32x4*)(DEC + 16 * w + 4 * quad);
            const bf16x8 ka = *(const LAS bf16x8*)(KC + (16 * w + l15) * 40 + 8 * quad);
#pragma unroll
            for (int nt = 0; nt < 2; ++nt) { const bf16x8 vb = *(const LAS bf16x8*)(VT + (16 * nt + l15) * 40 + 8 * quad); S[nt] = S[nt] * dc; S[nt] = __builtin_amdgcn_mfma_f32_16x16x32_bf16(ka, vb, S[nt], 0, 0, 0); }
        }
        HG_BAR();
#pragma unroll
        for (int nt = 0; nt < 2; ++nt)
#pragma unroll
            for (int jj = 0; jj < 4; ++jj) ST[(16 * nt + l15) * 136 + 16 * w + 4 * quad + jj] = (bf16_t)f2bf(S[nt][jj]);
    };
    for (int tb = 0; tb < NTB; tb += 2) {
        { const int nb = tb + 2 < NTB ? tb + 2 : NTB - 1; HG_ISSUE(rf0A, rf1A, rqA, rvA, 32 * nb); }
        blk(tb, 0);
        HG_WRITE(rf0B, rf1B, rqB, rvB, 1);
        HG_BAR();
        { const int nb = tb + 3 < NTB ? tb + 3 : NTB - 1; HG_ISSUE(rf0B, rf1B, rqB, rvB, 32 * nb); }
        blk(tb + 1, 1);
        HG_WRITE(rf0A, rf1A, rqA, rvA, 0);
        HG_BAR();
    }
#undef HG_ISSUE
#undef HG_WRITE
#undef HG_BAR
}
__device__ __forceinline__ void hg_scan_item(Frame& F, int item) {
    const int es = item & 3, dir = (item >> 2) & 1, h = (item >> 3) & 7, b = item >> 6;
    const int tid = ftid(), lane = tid & 63, w = F.wave, quad = lane >> 4, l15 = lane & 15;
    constexpr int INB = 32 * 128 * 2 + 32 * 32;
    LAS float* sIn = (LAS float*)F.lds;
    LAS bf16_t* QA = (LAS bf16_t*)(sIn + 2 * INB);
    LAS bf16_t* KB = QA + 2 * 32 * 136;
    LAS bf16_t* KC = KB + 32 * 136;
    LAS bf16_t* VT = KC + 2 * 128 * 40;
    LAS bf16_t* PP = VT + 2 * 32 * 40;
    LAS bf16_t* ST = PP + 2 * 32 * 40;
    LAS float* DEC = (LAS float*)(ST + 2 * 32 * 136);
    const float* fsrc = (const float*)(F.ws + (dir ? WS_FB : WS_FF));
    const bf16_t* qsrc = (const bf16_t*)(F.ws + WS_PQ); const bf16_t* vsrc = (const bf16_t*)(F.ws + WS_PI);
    float* osrc = (float*)(F.ws + (dir ? WS_OB : WS_OF));
    const size_t rb = (size_t)b * SU;
    auto pos_of = [&](int s) { return dir ? (s < NCTX ? NCTX - 1 - s : SU + NCTX - 1 - s) : s; };
    constexpr int NTB = SU / 32;
#define HG_BAR() do { asm volatile("s_waitcnt lgkmcnt(0)" ::: "memory"); __builtin_amdgcn_s_barrier(); asm volatile("" ::: "memory"); } while (0)
    f32x4 rf[4]; u32x4 rq[2], rv;
#define HG_ISSUE(s0_) do { \
        _Pragma("unroll") for (int r_ = 0; r_ < 4; ++r_) rf[r_] = *(const f32x4*)(fsrc + (rb + pos_of((s0_) + (tid >> 5) + 8 * r_)) * DM + h * 128 + 4 * (tid & 31)); \
        _Pragma("unroll") for (int r_ = 0; r_ < 2; ++r_) rq[r_] = *(const u32x4*)(qsrc + (rb + pos_of((s0_) + (tid >> 4) + 16 * r_)) * DM + h * 128 + 8 * (tid & 15)); \
        if (tid < 128) rv = *(const u32x4*)(vsrc + (rb + pos_of((s0_) + (tid >> 2))) * DM + h * 128 + 32 * es + 8 * (tid & 3)); } while (0)
#define HG_WRITE(buf_) do { LAS float* bF = sIn + (buf_) * INB; LAS float* bQ = bF + 32 * 128; LAS float* bV = bQ + 32 * 128; \
        _Pragma("unroll") for (int r_ = 0; r_ < 4; ++r_) *(LAS f32x4*)(bF + ((tid >> 5) + 8 * r_) * 128 + 4 * (tid & 31)) = rf[r_]; \
        _Pragma("unroll") for (int r_ = 0; r_ < 2; ++r_) { LAS float* d = bQ + ((tid >> 4) + 16 * r_) * 128 + 8 * (tid & 15); *(LAS f32x4*)d = (f32x4){bflo(rq[r_].x), bfhi(rq[r_].x), bflo(rq[r_].y), bfhi(rq[r_].y)}; *(LAS f32x4*)(d + 4) = (f32x4){bflo(rq[r_].z), bfhi(rq[r_].z), bflo(rq[r_].w), bfhi(rq[r_].w)}; } \
        if (tid < 128) { LAS float* d = bV + (tid >> 2) * 32 + 8 * (tid & 3); *(LAS f32x4*)d = (f32x4){bflo(rv.x), bfhi(rv.x), bflo(rv.y), bfhi(rv.y)}; *(LAS f32x4*)(d + 4) = (f32x4){bflo(rv.z), bfhi(rv.z), bflo(rv.w), bfhi(rv.w)}; } } while (0)
    f32x4 S[2][2];
#pragma unroll
    for (int a = 0; a < 2; ++a)
#pragma unroll
        for (int c2 = 0; c2 < 2; ++c2) S[a][c2] = (f32x4){0.f, 0.f, 0.f, 0.f};
    __syncthreads();
    for (int i = tid; i < 2 * 32 * 136; i += 512) ST[i] = 0;
    if (w < 4) { HG_ISSUE(0); HG_WRITE(0); HG_ISSUE(32); }
    __syncthreads();
    for (int j = 0; j <= NTB; ++j) {
        const int sp = j & 1;
        const int t = j - 1, sc_ = t & 1;
        f32x4 oi = (f32x4){0.f, 0.f, 0.f, 0.f};
        f32x2 kbv[8], al; float v0, v1, v2, v3;
        if (w < 4) {
            if (j < NTB) {
                const LAS float* sF = sIn + sp * INB; const LAS float* sQ = sF + 32 * 128; const LAS float* sV = sQ + 32 * 128;
                const int cq = w, dp = lane;
                f32x2 fv[32], qv[8];
#pragma unroll
                for (int i = 0; i < 32; ++i) fv[i] = *(const LAS f32x2*)(sF + i * 128 + 2 * dp);
                f32x2 fq[8];
#pragma unroll
                for (int i = 0; i < 8; ++i) { qv[i] = *(const LAS f32x2*)(sQ + (8 * cq + i) * 128 + 2 * dp); fq[i] = *(const LAS f32x2*)(sF + (8 * cq + i) * 128 + 2 * dp); }
                const int e = tid >> 3, jq = tid & 7;
                v0 = sV[(4 * jq + 0) * 32 + e]; v1 = sV[(4 * jq + 1) * 32 + e]; v2 = sV[(4 * jq + 2) * 32 + e]; v3 = sV[(4 * jq + 3) * 32 + e];
                f32x2 qp[4];
#pragma unroll
                for (int c4 = 0; c4 < 4; ++c4) { f32x2 pr = fv[8 * c4];
#pragma unroll
                    for (int i = 1; i < 8; ++i) pr = pr * fv[8 * c4 + i]; qp[c4] = pr; }
                f32x2 ea = (f32x2){1.f, 1.f};
#pragma unroll
                for (int c4 = 0; c4 < 3; ++c4) { if (c4 < cq) ea = ea * qp[c4]; }
                al = (qp[0] * qp[1]) * (qp[2] * qp[3]);
                f32x2 eia; eia.x = __builtin_amdgcn_rcpf(ea.x); eia.y = __builtin_amdgcn_rcpf(ea.y);
                LAS bf16_t* qa_ = QA + sp * 32 * 136;
#pragma unroll
                for (int i = 0; i < 8; ++i) { const f32x2 fo = fq[i];
                    ea = ea * fo; f32x2 rf_; rf_.x = __builtin_amdgcn_rcpf(fo.x); rf_.y = __builtin_amdgcn_rcpf(fo.y); eia = eia * rf_;
                    const f32x2 qa2 = qv[i] * ea; kbv[i] = ((f32x2){1.f, 1.f} - fo) * eia;
                    *(LAS unsigned*)(qa_ + (8 * cq + i) * 136 + 2 * dp) = pk2(qa2.x, qa2.y);
                    *(LAS unsigned*)(KB + (8 * cq + i) * 136 + 2 * dp) = pk2(kbv[i].x, kbv[i].y); }
            }
        } else if (t >= 0) {
            const int k = w - 4, it = k >> 1, nt = k & 1;
            const bf16x8 pa = *(const LAS bf16x8*)(PP + (sc_ * 32 + 16 * it + l15) * 40 + 8 * quad);
            const bf16x8 vb = *(const LAS bf16x8*)(VT + (sc_ * 32 + 16 * nt + l15) * 40 + 8 * quad);
            bf16x8 qa[4], sb[4];
#pragma unroll
            for (int ks = 0; ks < 4; ++ks) { qa[ks] = *(const LAS bf16x8*)(QA + (sc_ * 32 + 16 * it + l15) * 136 + 32 * ks + 8 * quad); sb[ks] = *(const LAS bf16x8*)(ST + (sc_ * 32 + 16 * nt + l15) * 136 + 32 * ks + 8 * quad); }
            oi = __builtin_amdgcn_mfma_f32_16x16x32_bf16(pa, vb, oi, 0, 0, 0);
#pragma unroll
            for (int ks = 0; ks < 4; ++ks) oi = __builtin_amdgcn_mfma_f32_16x16x32_bf16(qa[ks], sb[ks], oi, 0, 0, 0);
#pragma unroll
            for (int jj = 0; jj < 4; ++jj) { const int pp = pos_of(32 * t + 16 * it + 4 * quad + jj); osrc[(rb + pp) * DM + h * 128 + 32 * es + 16 * nt + l15] = oi[jj]; }
        }
        HG_BAR();
        if (w >= 4) {
            if (t >= 0) {
            const int k = w - 4;
#pragma unroll
            for (int mt = 0; mt < 2; ++mt) {
                const f32x4 dc = *(const LAS f32x4*)(DEC + sc_ * 128 + 32 * k + 16 * mt + 4 * quad);
                const bf16x8 ka = *(const LAS bf16x8*)(KC + (sc_ * 128 + 32 * k + 16 * mt + l15) * 40 + 8 * quad);
#pragma unroll
                for (int n2 = 0; n2 < 2; ++n2) { const bf16x8 vb2 = *(const LAS bf16x8*)(VT + (sc_ * 32 + 16 * n2 + l15) * 40 + 8 * quad); S[mt][n2] = S[mt][n2] * dc; S[mt][n2] = __builtin_amdgcn_mfma_f32_16x16x32_bf16(ka, vb2, S[mt][n2], 0, 0, 0); }
            }
            LAS bf16_t* stn = ST + (sc_ ^ 1) * 32 * 136;
#pragma unroll
            for (int mt = 0; mt < 2; ++mt)
#pragma unroll
                for (int n2 = 0; n2 < 2; ++n2)
                    { u32x2 o2; o2.x = pk2(S[mt][n2][0], S[mt][n2][1]); o2.y = pk2(S[mt][n2][2], S[mt][n2][3]); *(LAS u32x2*)(stn + (16 * n2 + l15) * 136 + 32 * k + 16 * mt + 4 * quad) = o2; }
            }
            if (j < NTB) {
                const int k = w - 4, it = k >> 1, jt = k & 1;
                f32x4 sc0 = (f32x4){0.f, 0.f, 0.f, 0.f};
                if (k != 1) {
                    bf16x8 qa[4], kbf[4];
#pragma unroll
                    for (int ks = 0; ks < 4; ++ks) { qa[ks] = *(const LAS bf16x8*)(QA + (sp * 32 + 16 * it + l15) * 136 + 32 * ks + 8 * quad);
                        kbf[ks] = *(const LAS bf16x8*)(KB + (16 * jt + l15) * 136 + 32 * ks + 8 * quad); }
#pragma unroll
                    for (int ks = 0; ks < 4; ++ks) sc0 = __builtin_amdgcn_mfma_f32_16x16x32_bf16(qa[ks], kbf[ks], sc0, 0, 0, 0);
                }
#pragma unroll
                for (int jj = 0; jj < 4; ++jj) { const int i = 16 * it + 4 * quad + jj;
                    PP[(sp * 32 + i) * 40 + 16 * jt + l15] = (bf16_t)f2bf(16 * jt + l15 <= i ? sc0[jj] : 0.f); }
            }
        }
        if (w < 4 && j < NTB) {
            const int cq = w, dp = lane; const int e = tid >> 3, jq = tid & 7;
                if (cq == 0) *(LAS f32x2*)(DEC + sp * 128 + 2 * dp) = al;
                u32x4 k0, k1;
                k0.x = pk2(kbv[0].x * al.x, kbv[1].x * al.x); k0.y = pk2(kbv[2].x * al.x, kbv[3].x * al.x); k0.z = pk2(kbv[4].x * al.x, kbv[5].x * al.x); k0.w = pk2(kbv[6].x * al.x, kbv[7].x * al.x);
                k1.x = pk2(kbv[0].y * al.y, kbv[1].y * al.y); k1.y = pk2(kbv[2].y * al.y, kbv[3].y * al.y); k1.z = pk2(kbv[4].y * al.y, kbv[5].y * al.y); k1.w = pk2(kbv[6].y * al.y, kbv[7].y * al.y);
                *(LAS u32x4*)(KC + (sp * 128 + 2 * dp) * 40 + 8 * cq) = k0; *(LAS u32x4*)(KC + (sp * 128 + 2 * dp + 1) * 40 + 8 * cq) = k1;
                u32x2 o; o.x = pk2(v0, v1); o.y = pk2(v2, v3); *(LAS u32x2*)(VT + (sp * 32 + e) * 40 + 4 * jq) = o;
        }
        if (w < 4 && j + 1 < NTB) { HG_WRITE((j + 1) & 1); if (j + 2 < NTB) HG_ISSUE(32 * (j + 2)); }
        HG_BAR();
    }
#undef HG_ISSUE
#undef HG_WRITE
#undef HG_BAR
}
__device__ __forceinline__ void naive_hg_scan(Frame& F) {
    const int gt = fbid() * 512 + ftid();
    if (gt >= NB * 8 * 2 * 128) return;
    const int e = gt & 127, dir = (gt >> 7) & 1, h = (gt >> 8) & 7, b = gt >> 11;
    const float* fsrc = (const float*)(F.ws + (dir ? WS_FB : WS_FF));
    const bf16_t* qsrc = (const bf16_t*)(F.ws + WS_PQ); const bf16_t* vsrc = (const bf16_t*)(F.ws + WS_PI);
    float* osrc = (float*)(F.ws + (dir ? WS_OB : WS_OF));
    float S[128];
#pragma unroll
    for (int d = 0; d < 128; ++d) S[d] = 0.f;
    for (int s_ = 0; s_ < SU; ++s_) {
        const int pp = dir ? (s_ < NCTX ? NCTX - 1 - s_ : SU + NCTX - 1 - s_) : s_;
        const size_t row = (size_t)b * SU + pp;
        const float v = bf2f(vsrc[row * DM + h * 128 + e]);
        const float* fr = fsrc + row * DM + h * 128; const bf16_t* qr = qsrc + row * DM + h * 128;
        float o = 0.f;
#pragma unroll
        for (int d = 0; d < 128; ++d) { const float f = fr[d]; S[d] = f * S[d] + (1.0f - f) * v; o += bf2f(qr[d]) * S[d]; }
        osrc[row * DM + h * 128 + e] = o;
    }
}
__device__ __forceinline__ void naive_hg_readout(Frame& F, const Args& args, int p) {
    for (int i = fbid() * 512 + ftid(); i < MTOK * 8; i += F.G * 512) {
        const int row = i >> 3, h = i & 7;
        const float* a = (const float*)(F.ws + WS_OF) + (size_t)row * DM + h * 128; const float* c = (const float*)(F.ws + WS_OB) + (size_t)row * DM + h * 128;
        float ss = 0.f;
        for (int d = 0; d < 128; ++d) { const float o = a[d] + c[d]; ss += o * o; }
        const float rstd = 1.0f / sqrtf(ss / 128.f + EPS);
        const bf16_t* g = (const bf16_t*)(F.ws + WS_PG) + (size_t)row * DM + h * 128; bf16_t* y = (bf16_t*)(F.ws + WS_YB16) + (size_t)row * DM + h * 128;
        for (int d = 0; d < 128; ++d) { const float o = a[d] + c[d]; const float gv = bf2f(g[d]); y[d] = (bf16_t)f2bf(o * rstd * args.in[I_HGNW][p * 128 + d] * (gv / (1.0f + expf(-gv)))); }
    }
}
__device__ __forceinline__ void hg_readout_phase(Frame& F, const Args& args, int p) {
    const int gw = F.vcu * NWAVES + F.wave, NGW = F.G * NWAVES, lane = flane();
    const float* nw = ((const float*)(F.ws + WS_SP) + SP_HGNW) + p * 128 + 16 * (lane & 7);
    for (int row = gw; row < MTOK; row += NGW) {
        const f32x4* a = (const f32x4*)(F.ws + WS_OF + (size_t)row * DM * 4) + 4 * lane; const f32x4* c = (const f32x4*)(F.ws + WS_OB + (size_t)row * DM * 4) + 4 * lane;
        f32x4 o[4]; float ss = 0.f;
#pragma unroll
        for (int j = 0; j < 4; ++j) { o[j] = ABL_HGB0 ? a[j] : a[j] + c[j]; ss += (o[j].x * o[j].x + o[j].y * o[j].y) + (o[j].z * o[j].z + o[j].w * o[j].w); }
        ss += shx(ss, 1, lane); ss += shx(ss, 2, lane); ss += shx(ss, 4, lane);
        const float rstd = 1.0f / sqrtf(ss * (1.0f / 128.f) + EPS);
        const u32x4* gp = (const u32x4*)(F.ws + WS_PG + (size_t)row * DM * 2) + 2 * lane;
        const u32x4 g0 = gp[0], g1 = gp[1]; const unsigned gwv[8] = {g0.x, g0.y, g0.z, g0.w, g1.x, g1.y, g1.z, g1.w};
        unsigned outw[8];
#pragma unroll
        for (int j = 0; j < 4; ++j) { const f32x4 wv = *(const f32x4*)(nw + 4 * j);
            const float y0 = o[j].x * rstd * wv.x * siluf(bflo(gwv[2 * j])), y1 = o[j].y * rstd * wv.y * siluf(bfhi(gwv[2 * j]));
            const float y2 = o[j].z * rstd * wv.z * siluf(bflo(gwv[2 * j + 1])), y3 = o[j].w * rstd * wv.w * siluf(bfhi(gwv[2 * j + 1]));
            outw[2 * j] = pk2(y0, y1); outw[2 * j + 1] = pk2(y2, y3); }
        u32x4* op = (u32x4*)(F.ws + WS_YB16 + (size_t)row * DM * 2) + 2 * lane;
        op[0] = (u32x4){outw[0], outw[1], outw[2], outw[3]}; op[1] = (u32x4){outw[4], outw[5], outw[6], outw[7]};
    }
}

constexpr int NPHASE = 2 + 9 * DEPTH;
constexpr unsigned KM_ALL = 0x7ffu | (3u << 16);
template <unsigned KM>
__device__ __forceinline__ void mk_body(const Args& args, unsigned char* lds_raw) {
    Frame F;
    F.lds = (LAS unsigned char*)lds_raw;
    F.MISC = (volatile LAS unsigned*)(F.lds + MISC_OFF);
    F.wave = __builtin_amdgcn_readfirstlane(ftid() >> 6);
    F.G = gridDim.x; { const int bx = blockIdx.x; F.vcu = (F.G % 8 == 0) ? (bx % 8) * (F.G / 8) + bx / 8 : bx; }
    F.ws = args.ws; F.ctl = (unsigned*)(args.ws + WS_CTL);
    for (int u = ftid(); u < (LDS_BYTES - LDSCTL_OFF) / 4; u += NWAVES * 64) ((LAS unsigned*)(F.lds + LDSCTL_OFF))[u] = 0u;
    __syncthreads();
    XcdBarrier bar; bar.bar = F.ctl + CW_BAR; bar.x = 0; bar.st = nullptr;
    const int lo = args.ph_lo, hi = args.ph_hi;
    if (hi - lo > 1) bar = xcd_barrier_post(F.ctl + CW_BAR, F.MISC + 8);
#define HAS(kind) ((KM >> (kind)) & 1u)
    if constexpr (HAS(0)) { if (lo == 0) { p0_prologue(F, args); if (NAIVE_MOD) { __syncthreads(); naive_mod(F, args); } if (hi > 1) xcd_barrier(bar); } }
    float* const outp = args.out;
#pragma nounroll
    for (int ph = (lo == 0 ? 1 : lo); ph < hi; ++ph) {
        const Args* ap = &args;
        { unsigned char* w_ = args.ws; asm volatile("" : "+s"(w_)); F.ws = w_; F.ctl = (unsigned*)(w_ + WS_CTL); }
        { int wv_ = __builtin_amdgcn_readfirstlane(ftid() >> 6); F.wave = wv_; int g_ = (int)gridDim.x; asm volatile("" : "+s"(g_)); F.G = g_; const int bx = fbid(); F.vcu = (g_ % 8 == 0) ? (bx % 8) * (g_ / 8) + bx / 8 : bx; }
        const float* mod = (const float*)(F.ws + WS_MOD);
        const int kind = (ph == 0) ? 0 : (ph == NPHASE - 1 ? 10 : 1 + (ph - 1) % 9);
        const int l = (ph - 1) / 9; const int odd = l & 1, p = l >> 1;
        if (kind == 5 && odd) continue;
        switch (kind) {
        case 1: if constexpr (HAS(1)) { if (NAIVE_N1 == 1) naive_n1(F, *ap, l, false); else if (NAIVE_N1 == 2) wave_n1(F, *ap, l, false); else n1_phase<false>(F, *ap, l); } break;
        case 2: if constexpr (HAS(2)) {
            const int N = odd ? OD_N : EV_N;
            if (NAIVE_G1) { naive_g1(F, *ap, l); } else {
            pg8::PlainAddr AD{(const bf16_t*)(F.ws + WS_HB), (const bf16_t*)(F.ws + (odd ? WS_W_ODIN + (size_t)p * 10 * MiB : WS_W_EVIN + (size_t)p * 6 * MiB)), DM};
            pg8::StaticOrder S; S.init(MTOK, N, F.G, fbid());
            EpiProj E{F.ws, (const float*)(F.ws + WS_LB) + l * DM, odd};
            pg8::gemm_phase(F.lds, AD, S, E, DM);
            } } break;
        case 3: if constexpr (HAS(3)) {
            if (!odd) {
                if constexpr (HAS(16)) {
                    for (int it = fbid(); it < NB * 4 * NCHUNK + (NAIVE_ATT ? 0 : NB * 2 * NCHUNK); it += F.G) {
                        if (it < NB * 4 * NCHUNK) ret_state_item(F, *ap, p, it); else att_item(F, *ap, p, it - NB * 4 * NCHUNK);
                    }
                    if (NAIVE_ATT) { __syncthreads(); naive_att(F, *ap, p); }
                }
            } else {
                if constexpr (HAS(17)) { if (NAIVE_HG) naive_hg_scan(F); else for (int it = fbid(); it < NB * 8 * 2 * 4; it += F.G) hg_scan_item(F, it); }
            }
            __syncthreads(); } break;
        case 4: if constexpr (HAS(4)) {
            if (!odd) { if constexpr (HAS(16)) ret_scan_phase(F, *ap, p); } else { if constexpr (HAS(17)) { if (NAIVE_HG) naive_hg_readout(F, *ap, p); else hg_readout_phase(F, *ap, p); } } } break;
        case 5: if constexpr (HAS(5)) { for (int it = fbid(); it < NB * 4 * NCHUNK; it += F.G) { if (RET_DIRECT) ret_direct_item(F, *ap, p, it); else ret_out_item(F, *ap, p, it); } __syncthreads(); } break;
        case 6: if constexpr (HAS(6)) {
            if (NAIVE_G2) { if (odd ? CONTRIB_ODD : CONTRIB_EVEN) naive_g2(F, *ap, l); } else {
            pg8::PlainAddr AD{(const bf16_t*)(F.ws + WS_YB16), (const bf16_t*)(F.ws + (odd ? WS_W_ODOUT : WS_W_EVOUT) + (size_t)p * 2 * MiB), DM};
            pg8::StaticOrder S; S.init(MTOK, DM, F.G, fbid());
            EpiOut E{(float*)(F.ws + WS_XRES), mod + (size_t)l * 5 * 6144, odd ? CONTRIB_ODD : CONTRIB_EVEN};
            pg8::gemm_phase(F.lds, AD, S, E, DM);
            } } break;
        case 7: if constexpr (HAS(7)) { if (NAIVE_N2R) naive_n2r(F, *ap, l); else n2r_phase(F, *ap, l); } break;
        case 8: case 9: if constexpr (HAS(8) || HAS(9)) {
            LAS int* tstart = (LAS int*)(F.lds + LDSCTL_OFF + 512); LAS int* cnts = (LAS int*)(F.lds + LDSCTL_OFF + 768);
            __syncthreads();
            if (F.wave == 0) { int mycnt; const int pre = moe_tile_prefix(F.ctl + CW_CNT + l * NEXP, flane(), mycnt); if (flane() <= NEXP) tstart[flane()] = pre; if (flane() < NEXP) cnts[flane()] = mycnt; }
            __syncthreads();
            const int ntiles = tstart[NEXP];
            const bf16_t* wmoe = (const bf16_t*)(F.ws + WS_W_MOE + (size_t)l * NEXP * 3 * MiB);
            if (kind == 8) { if constexpr (HAS(8)) {
                if (NAIVE_MOE) naive_moe(F, *ap, l); else {
                pg8::MoeGatherAddr AD{(const bf16_t*)(F.ws + WS_HB), wmoe, (const unsigned*)(F.ws + WS_LIST), DM};
                pg8::MoeOrder S{tstart, cnts, ntiles, F.G, fbid()};
                EpiAct E{(bf16_t*)(F.ws + WS_ACT)};
                pg8::gemm_phase(F.lds, AD, S, E, DM); }
            } } else { if constexpr (HAS(9)) {
                pg8::MoeActAddr AD{(const bf16_t*)(F.ws + WS_ACT), wmoe + (size_t)DM * DM, FF};
                pg8::MoeOrder S{tstart, cnts, ntiles, F.G, fbid()};
                EpiY E{(bf16_t*)(F.ws + WS_YB)};
                pg8::gemm_phase(F.lds, AD, S, E, FF);
            } } } break;
        default: if constexpr (HAS(10)) { if (NAIVE_FINAL == 1) naive_n1(F, *ap, DEPTH, true); else if (NAIVE_FINAL == 2) wave_n1(F, *ap, DEPTH, true); else n1_phase<true>(F, *ap, DEPTH); } break;
        }
        if (ph + 1 < hi) xcd_barrier(bar);
    }
#undef HAS
}
template <int L>
__device__ __forceinline__ void layer_sl(Frame& F, const Args& args, const XcdBarrier& bar) {
    constexpr int l = L; constexpr int odd = L & 1, p = L >> 1;
    const float* mod = (const float*)(F.ws + WS_MOD);
    n1_phase<false>(F, args, l); xcd_barrier(bar);
    { pg8::PlainAddr AD{(const bf16_t*)(F.ws + WS_HB), (const bf16_t*)(F.ws + (odd ? WS_W_ODIN + (size_t)p * 10 * MiB : WS_W_EVIN + (size_t)p * 6 * MiB)), DM};
      pg8::StaticOrder S; S.init(MTOK, odd ? OD_N : EV_N, F.G, FCG(F));
      EpiProj E{F.ws, (const float*)(F.ws + WS_LB) + l * DM, odd};
      pg8::gemm_phase(F.lds, AD, S, E, DM); }
    conv_moe_tail(F, args, l, 0, moe_g1_hi(l), (MTOK / 256) * ((odd ? OD_N : EV_N) / 256));
    xcd_barrier(bar);
    if constexpr (!odd) {
        {
            const int bx = FCG(F);
            if (F.G == 256) {
                att_item(F, args, p, bx);
                if (bx < 16) att_item(F, args, p, 256 + bx);
                else { const int r0 = 2 * (bx - 16); ret_state_item(F, args, p, r0); ret_state_item(F, args, p, r0 + 1); if (bx - 16 < 64) ret_state_item(F, args, p, 480 + (bx - 16)); }
            } else {
                for (int it = bx; it < NB * 4 * NCHUNK + NB * 2 * NCHUNK; it += F.G) { if (it < NB * 2 * NCHUNK) att_item(F, args, p, it); else ret_state_item(F, args, p, it - NB * 2 * NCHUNK); }
            }
        }
        __syncthreads(); xcd_barrier(bar);
        ret_scan_phase(F, args, p); xcd_barrier(bar);
        for (int rep_ = 0; rep_ <= REP_MIXE; ++rep_) for (int it = FCG(F); it < NB * 4 * NCHUNK; it += F.G) ret_out_item(F, args, p, it);
        __syncthreads(); xcd_barrier(bar);
    } else {
        for (int rep_ = 0; rep_ <= REP_HG; ++rep_) for (int it = F.vcu; it < NB * 8 * 2 * 4; it += F.G) hg_scan_item(F, it);
        __syncthreads(); xcd_barrier(bar);
        hg_readout_phase(F, args, p); xcd_barrier(bar);
    }
    { pg8::PlainAddr AD{(const bf16_t*)(F.ws + WS_YB16), (const bf16_t*)(F.ws + (odd ? WS_W_ODOUT : WS_W_EVOUT) + (size_t)p * 2 * MiB), DM};
      pg8::StaticOrder S; S.init(MTOK, DM, F.G, FCG(F), l == DEPTH - 1 ? 1 : 0);
      EpiOut E{(float*)(F.ws + WS_XRES), mod + (size_t)l * 5 * 6144, 1};
      pg8::gemm_phase(F.lds, AD, S, E, DM); }
    if constexpr (l != DEPTH - 1) conv_moe_tail(F, args, l, moe_g1_hi(l), moe_g2_hi(l), (MTOK / 256) * (DM / 256));
    xcd_barrier(bar);
    n2r_phase(F, args, l); xcd_barrier(bar);
    {   LAS int* tstart = (LAS int*)(F.lds + LDSCTL_OFF + 512); LAS int* cnts = (LAS int*)(F.lds + LDSCTL_OFF + 768);
        __syncthreads();
        if (F.wave == 0) { int mycnt; const int ln = flane(); const int pre = moe_tile_prefix(F.ctl + CW_CNT + l * NEXP, ln, mycnt); if (ln <= NEXP) tstart[ln] = pre; if (ln < NEXP) cnts[ln] = mycnt; }
        __syncthreads();
        const int ntiles = tstart[NEXP];
        const bf16_t* wmoe = (const bf16_t*)(F.ws + WS_W_MOE + (size_t)l * NEXP * 3 * MiB);
        { pg8::MoeGatherAddr AD{(const bf16_t*)(F.ws + WS_HB), wmoe, (const unsigned*)(F.ws + WS_LIST), DM};
          pg8::MoeOrder S{tstart, cnts, ntiles, F.G, FCG(F)};
          EpiAct E{(bf16_t*)(F.ws + WS_ACT)};
          pg8::gemm_phase(F.lds, AD, S, E, DM); }
        xcd_barrier(bar);
        { pg8::MoeActAddr AD{(const bf16_t*)(F.ws + WS_ACT), wmoe + (size_t)DM * DM, FF};
          pg8::MoeOrder S{tstart, cnts, ntiles, F.G, FCG(F)};
          EpiY E{(bf16_t*)(F.ws + WS_YB)};
          pg8::gemm_phase(F.lds, AD, S, E, FF); }
        xcd_barrier(bar);
    }
}
__global__ void __launch_bounds__(NWAVES * 64, 2) mk_one(Args args) {
    extern __shared__ __attribute__((aligned(16))) unsigned char lds_raw[];
    Frame F;
    F.lds = (LAS unsigned char*)lds_raw;
    F.MISC = (volatile LAS unsigned*)(F.lds + MISC_OFF);
    F.wave = __builtin_amdgcn_readfirstlane(ftid() >> 6);
    F.G = gridDim.x; { const int bx = blockIdx.x; F.vcu = (F.G % 8 == 0) ? (bx % 8) * (F.G / 8) + bx / 8 : bx; }
    F.ws = args.ws; F.ctl = (unsigned*)(args.ws + WS_CTL);
    for (int u = ftid(); u < (LDS_BYTES - LDSCTL_OFF) / 4; u += NWAVES * 64) ((LAS unsigned*)(F.lds + LDSCTL_OFF))[u] = 0u;
    __syncthreads();
    const XcdBarrier bar = xcd_barrier_post(F.ctl + CW_BAR, F.MISC + 8);
    p0_prologue(F, args); xcd_barrier(bar);
    {
        if (ftid() == 0) {
            unsigned* bw = F.ctl + CW_BAR; const unsigned G = (unsigned)F.G, per = G / 8u; bool uni = (G % 8u) == 0u;
            for (unsigned j = 0; j < 8; ++j) uni = uni && (xb_ld(&bw[XB_XCNT(j)]) == per);
            const unsigned r = F.MISC[10], x = bar.x;
            F.MISC[12] = (uni && x < 8u && r < per) ? r * 8u + x : (unsigned)blockIdx.x;
            F.MISC[13] = (uni && x < 8u && r < per) ? x * per + r : (unsigned)F.vcu;
        }
        __syncthreads();
        F.vcu = __builtin_amdgcn_readfirstlane((int)F.MISC[13]);
    }
    layer_sl<0>(F, args, bar);
    layer_sl<1>(F, args, bar);
    layer_sl<2>(F, args, bar);
    layer_sl<3>(F, args, bar);
    n1_phase<true>(F, args, DEPTH);
}

template <unsigned KM>
__global__ void __launch_bounds__(NWAVES * 64, 2) mk_fwd(Args args) {
    extern __shared__ __attribute__((aligned(16))) unsigned char lds_raw[];
    mk_body<KM>(args, lds_raw);
}

template <unsigned KM> static bool prep_kernel() { return hipFuncSetAttribute((const void*)mk_fwd<KM>, hipFuncAttributeMaxDynamicSharedMemorySize, LDS_BYTES) == hipSuccess; }
template <unsigned KM> static void launch_kernel(int grid, hipStream_t stream, const Args& a) { hipLaunchKernelGGL(mk_fwd<KM>, dim3(grid), dim3(NWAVES * 64), LDS_BYTES, stream, a); }
#define KEV (1u << 16)
#define KOD (1u << 17)
extern "C" void kernel_launch(void* const* d_in, const int* in_sizes, int n_in, void* d_out, int out_size, void* d_ws, size_t ws_size, hipStream_t stream) {
    static int grid = 0;
    if (grid == 0) {
        const int exp_sizes[23] = {NB * LSEQ * DM, NB * DM, NB * NCTX * DM, DM, DEPTH * DM * 6 * DM, DEPTH * 6 * DM, DEPTH * 2 * DM, DM, 2 * DM * EV_N, 2 * DM * DM, 16, 8,
                                   2 * DM * OD_N, 2 * DM * DM, DEPTH * DM, 2 * 128, DEPTH * DM * 4, DEPTH * 4, DEPTH * 4 * DM * 8, DEPTH * 32, DEPTH * NEXP * DM * FF, DEPTH * NEXP * DM * FF, DEPTH * NEXP * FF * DM};
        bool sz_ok = (n_in == 23) && out_size == NB * LSEQ * DM;
        for (int i = 0; i < 23 && sz_ok; ++i) sz_ok = (in_sizes[i] == exp_sizes[i]);
        if (!sz_ok) { fprintf(stderr, "kernel_launch: unexpected input sizes\n"); grid = -1; return; }
        if (n_in != 23 || ws_size < WS_END) { fprintf(stderr, "kernel_launch: unexpected n_in %d / ws_size %zu\n", n_in, ws_size); grid = -1; return; }
        int dev = 0, cus = 0;
        if (hipGetDevice(&dev) != hipSuccess || hipDeviceGetAttribute(&cus, hipDeviceAttributeMultiprocessorCount, dev) != hipSuccess) { grid = -1; return; }
        bool ok = true;
#if MK_PER_PHASE
        ok = ok && prep_kernel<1u << 0>() && prep_kernel<1u << 1>() && prep_kernel<1u << 2>() && prep_kernel<(1u << 3) | KEV>() && prep_kernel<(1u << 3) | KOD>()
                && prep_kernel<(1u << 4) | KEV>() && prep_kernel<(1u << 4) | KOD>() && prep_kernel<(1u << 5) | KEV>() && prep_kernel<1u << 6>() && prep_kernel<1u << 7>()
                && prep_kernel<1u << 8>() && prep_kernel<1u << 9>() && prep_kernel<1u << 10>();
#else
        ok = ok && (hipFuncSetAttribute((const void*)mk_one, hipFuncAttributeMaxDynamicSharedMemorySize, LDS_BYTES) == hipSuccess);
#ifdef PROBE_MASKS
        ok = ok && prep_kernel<(1u<<3)|(3u<<16)>() && prep_kernel<(1u<<3)|(1u<<5)|(1u<<16)>() && prep_kernel<(1u<<0)|(1u<<1)|(1u<<7)|(1u<<10)>() && prep_kernel<(1u<<3)|(1u<<4)|(1u<<5)|(3u<<16)>() && prep_kernel<(1u<<0)|(1u<<3)|(1u<<16)>() && prep_kernel<(1u<<1)|(1u<<3)|(1u<<16)>();
#endif
#endif
        if (!ok) { fprintf(stderr, "kernel_launch: hipFuncSetAttribute failed\n"); grid = -1; return; }
        (void)hipGetLastError();
        grid = cus > 256 ? 256 : cus;
    }
    if (grid < 0) return;
    (void)hipMemsetAsync((char*)d_ws + WS_CTL, 0, CTL_ZERO_BYTES, stream);
    Args a{};
    for (int i = 0; i < 23; ++i) a.in[i] = (const float*)d_in[i];
    a.out = (float*)d_out; a.ws = (unsigned char*)d_ws;
#if MK_PER_PHASE
    for (int ph = 0; ph < NPHASE; ++ph) {
        { unsigned char* w_ = args.ws; asm volatile("" : "+s"(w_)); F.ws = w_; F.ctl = (unsigned*)(w_ + WS_CTL); }
        { int wv_ = __builtin_amdgcn_readfirstlane(ftid() >> 6); F.wave = wv_; int g_ = (int)gridDim.x; asm volatile("" : "+s"(g_)); F.G = g_; const int bx = fbid(); F.vcu = (g_ % 8 == 0) ? (bx % 8) * (g_ / 8) + bx / 8 : bx; }
        const float* mod = (const float*)(F.ws + WS_MOD);
        const int kind = (ph == 0) ? 0 : (ph == NPHASE - 1 ? 10 : 1 + (ph - 1) % 9); const int l = (ph - 1) / 9; const bool odd = (l & 1) != 0;
        if (kind == 5 && odd) continue;
        a.ph_lo = ph; a.ph_hi = ph + 1;
        switch (kind) {
            case 0: launch_kernel<1u << 0>(grid, stream, a); break;
            case 1: launch_kernel<1u << 1>(grid, stream, a); break;
            case 2: launch_kernel<1u << 2>(grid, stream, a); break;
            case 3: if (odd) launch_kernel<(1u << 3) | KOD>(grid, stream, a); else launch_kernel<(1u << 3) | KEV>(grid, stream, a); break;
            case 4: if (odd) launch_kernel<(1u << 4) | KOD>(grid, stream, a); else launch_kernel<(1u << 4) | KEV>(grid, stream, a); break;
            case 5: launch_kernel<(1u << 5) | KEV>(grid, stream, a); break;
            case 6: launch_kernel<1u << 6>(grid, stream, a); break;
            case 7: launch_kernel<1u << 7>(grid, stream, a); break;
            case 8: launch_kernel<1u << 8>(grid, stream, a); break;
            case 9: launch_kernel<1u << 9>(grid, stream, a); break;
            default: launch_kernel<1u << 10>(grid, stream, a); break;
        }
    }
#else
    a.ph_lo = 0; a.ph_hi = NPHASE;
    hipLaunchKernelGGL(mk_one, dim3(grid), dim3(NWAVES * 64), LDS_BYTES, stream, a);
#endif
}
```

```cpp
#include <hip/hip_runtime.h>
#include <cstdio>
#include <cstdint>

#define REPK_EPIPROJ 0
#define REPE_EPIPROJ 0
#define REPE_EPIOUT 0
#define REPE_EPIACT 0
#define REPE_EPIY 0
#define REPK_EPIOUT 0
#define REPK_EPIACT 0
#define REPK_EPIY 0
#ifndef REP_KLOOP
#define REP_KLOOP 0
#endif
#ifndef MK_PER_PHASE
#define MK_PER_PHASE 0
#endif

#ifndef CONTRIB_EVEN
#define CONTRIB_EVEN 1
#endif
#ifndef CONTRIB_ODD
#define CONTRIB_ODD 1
#endif
#ifndef CONTRIB_MOE
#define CONTRIB_MOE 1
#endif
#ifndef ABL_ATT0
#define ABL_ATT0 0
#endif
#ifndef ABL_RET0
#define ABL_RET0 0
#endif
#ifndef ABL_HGB0
#define ABL_HGB0 0
#endif
#ifndef RET_DIRECT
#define RET_DIRECT 0
#endif
#ifndef NAIVE_G1
#define NAIVE_G1 0
#endif
#ifndef NAIVE_G2
#define NAIVE_G2 0
#endif
#ifndef NAIVE_MOD
#define NAIVE_MOD 0
#endif
#ifndef NAIVE_MOE
#define NAIVE_MOE 0
#endif
#ifndef NAIVE_ATT
#define NAIVE_ATT 0
#endif
#ifndef NAIVE_HG
#define NAIVE_HG 0
#endif
#ifndef NAIVE_N2R
#define NAIVE_N2R 0
#endif
#ifndef NAIVE_COPY
#define NAIVE_COPY 0
#endif
#ifndef NAIVE_N1
#define NAIVE_N1 0
#endif
#ifndef NAIVE_FINAL
#define NAIVE_FINAL 0
#endif
#ifndef MUT_A
#define MUT_A 0
#endif
#ifndef MUT_B
#define MUT_B 0
#endif
#ifndef MUT_D
#define MUT_D 0
#endif
#ifndef REP_CONV
#define REP_CONV 0
#endif
#ifndef REP_HG
#define REP_HG 0
#endif
#ifndef REP_MIXE
#define REP_MIXE 0
#endif
#define LAS __attribute__((address_space(3)))
#define GAS __attribute__((address_space(1)))
typedef unsigned short bf16_t;
typedef short bf16x8 __attribute__((ext_vector_type(8)));
typedef float f32x4 __attribute__((ext_vector_type(4)));
typedef float f32x2 __attribute__((ext_vector_type(2)));
typedef unsigned u32x4 __attribute__((ext_vector_type(4)));
typedef unsigned u32x2 __attribute__((ext_vector_type(2)));

constexpr int NB = 4, LSEQ = 4096, DM = 1024, NCTX = 256, SU = NCTX + LSEQ  , MTOK = NB * SU  , DEPTH = 4;
constexpr int EV_N = 3072, OD_N = 5120, NEXP = 32, FF = 512;
constexpr int NCHUNK = SU / 128;
constexpr float EPS = 1e-6f;
constexpr int LIST_CAP = MTOK;
constexpr int MOE_MAXROWS = 43008;

constexpr size_t MiB = 1u << 20;
constexpr size_t WS_CTL = 0, CTL_ZERO_BYTES = 1 * MiB;
constexpr size_t WS_MOD = 1 * MiB;
constexpr size_t WS_LB = 1 * MiB + 512 * 1024;
constexpr size_t WS_ROPEC = WS_LB + 16384;
constexpr size_t WS_ROPES = WS_ROPEC + 8192;
constexpr size_t WS_W = 2 * MiB;
constexpr size_t WS_W_EVIN = WS_W;
constexpr size_t WS_W_EVOUT = WS_W + 12 * MiB;
constexpr size_t WS_W_ODIN = WS_W + 16 * MiB;
constexpr size_t WS_W_ODOUT = WS_W + 36 * MiB;
constexpr size_t WS_W_MOE = WS_W + 40 * MiB;
constexpr size_t WS_XRES = 426 * MiB;
constexpr size_t WS_HB = 494 * MiB;
constexpr size_t WS_YB16 = 528 * MiB;
constexpr size_t WS_R = 562 * MiB;
constexpr size_t WS_PE = WS_R;
constexpr size_t WS_ST = WS_R + 102 * MiB;
constexpr size_t WS_PQ = WS_R, WS_PI = WS_R + 34 * MiB, WS_PG = WS_R + 68 * MiB;
constexpr size_t WS_FF = WS_R + 102 * MiB, WS_FB = WS_R + 170 * MiB, WS_OF = WS_R + 238 * MiB, WS_OB = WS_R + 306 * MiB;
constexpr size_t WS_LIST = WS_R;
constexpr size_t WS_TOKINFO = WS_R + 5 * MiB;
constexpr size_t WS_ACT = WS_R + 6 * MiB;
constexpr size_t WS_YB = WS_R + 50 * MiB;
constexpr size_t WS_YN = WS_R + 140 * MiB;
constexpr size_t WS_END = 936 * MiB;
constexpr size_t WS_SP = 256 * 1024;
constexpr int SP_NORMW = 0, SP_FNORMW = 8192, SP_WG = 9216, SP_BG = 25600, SP_WE = 25616, SP_BE = 156688, SP_DECAY = 156816, SP_SINK = 156832, SP_HGNW = 156840, SP_END = 157096;
static_assert(WS_SP + (size_t)SP_END * 4 <= CTL_ZERO_BYTES, "small parameters fit in the control MiB");
constexpr int CW_BAR = 4096;
constexpr int CW_CNT = 8192;

constexpr int RING_BYTES = 150528;
constexpr int LDSCTL_OFF = RING_BYTES, MISC_OFF = LDSCTL_OFF + 320;
constexpr int LDS_BYTES = RING_BYTES + 4096;
constexpr int NWAVES = 8;

typedef __bf16 bf16v2_t __attribute__((ext_vector_type(2)));
__device__ __forceinline__ unsigned pk2(float lo, float hi) { const f32x2 v = {lo, hi}; const bf16v2_t r = __builtin_convertvector(v, bf16v2_t); return __builtin_bit_cast(unsigned, r); }
__device__ __forceinline__ unsigned f2bf(float f) { return pk2(f, f) & 0xffffu; }
__device__ __forceinline__ float bf2f(unsigned h) { return __builtin_bit_cast(float, h << 16); }
__device__ __forceinline__ float bflo(unsigned w) { return __builtin_bit_cast(float, w << 16); }
__device__ __forceinline__ float bfhi(unsigned w) { return __builtin_bit_cast(float, w & 0xffff0000u); }
__device__ __forceinline__ float shx(float v, int o, int lane) { return __builtin_bit_cast(float, __builtin_amdgcn_ds_bpermute((lane ^ o) << 2, __builtin_bit_cast(int, v))); }
__device__ __forceinline__ int shup_i(int v, int o, int lane) { return __builtin_amdgcn_ds_bpermute((lane - o) << 2, v); }
__device__ __forceinline__ int shidx_i(int v, int src) { return __builtin_amdgcn_ds_bpermute(src << 2, v); }
__device__ __forceinline__ float wave_sum(float v, int lane) {
#pragma unroll
    for (int o = 1; o < 64; o <<= 1) v += shx(v, o, lane);
    return v;
}
__device__ __forceinline__ float wave_sum_dpp(float v) {
    v += __builtin_bit_cast(float, __builtin_amdgcn_update_dpp(0, __builtin_bit_cast(int, v), 0x111, 0xf, 0xf, true));
    v += __builtin_bit_cast(float, __builtin_amdgcn_update_dpp(0, __builtin_bit_cast(int, v), 0x112, 0xf, 0xf, true));
    v += __builtin_bit_cast(float, __builtin_amdgcn_update_dpp(0, __builtin_bit_cast(int, v), 0x114, 0xf, 0xf, true));
    v += __builtin_bit_cast(float, __builtin_amdgcn_update_dpp(0, __builtin_bit_cast(int, v), 0x118, 0xf, 0xf, true));
    v += __builtin_bit_cast(float, __builtin_amdgcn_update_dpp(0, __builtin_bit_cast(int, v), 0x142, 0xa, 0xf, false));
    v += __builtin_bit_cast(float, __builtin_amdgcn_update_dpp(0, __builtin_bit_cast(int, v), 0x143, 0xc, 0xf, false));
    return __builtin_bit_cast(float, __builtin_amdgcn_readlane(__builtin_bit_cast(int, v), 63));
}
__device__ __forceinline__ f32x4 bf4(u32x2 t) { return (f32x4){bflo(t.x), bfhi(t.x), bflo(t.y), bfhi(t.y)}; }
__device__ __forceinline__ u32x2 pk4(f32x4 v) { u32x2 q; q.x = pk2(v.x, v.y); q.y = pk2(v.z, v.w); return q; }
__device__ __forceinline__ float siluf(float x) { return x * __builtin_amdgcn_rcpf(1.0f + __expf(-x)); }
#define LDS_WAIT() asm volatile("s_waitcnt lgkmcnt(0)" ::: "memory")
#define VM_WAIT() asm volatile("s_waitcnt vmcnt(0)" ::: "memory")

namespace pg8 {
constexpr int BM = 256, BK = 64, HALF = 128, HTB = HALF * BK * 2, STAGE_BYTES = 8 * HTB, NXCD = 8, WGM = 8;
__host__ __device__ __forceinline__ int lds_byte(int r, int c) { const int st = (r >> 4) * 2 + (c >> 5), rr = r & 15, cc = c & 31, ob = rr * 64 + cc * 2; return st * 1024 + (ob ^ (((ob >> 9) & 1) << 5)); }
__host__ __device__ __forceinline__ void stage_rc(int b, int& R, int& C) { const int st = b / 1024, sb = b % 1024, swz = sb ^ (((sb >> 9) & 1) << 5); R = (st >> 1) * 16 + swz / 64; C = (st & 1) * 32 + (swz % 64) / 2; }
__host__ __device__ __forceinline__ int perm32(int rho) { const int n = rho >> 4, i = rho & 15; return 8 * (i >> 2) + 4 * n + (i & 3); }

struct Unit { int pm, pn, e, cnt, tile; };

__device__ __forceinline__ int xcd_remap(int L, int nwg) { const int q = nwg / NXCD, r = nwg % NXCD, xcd = L % NXCD, off = L / NXCD; return (xcd < r ? xcd * (q + 1) : r * (q + 1) + (xcd - r) * q) + off; }

struct StaticOrder {
    int nM, nN, nwg, G, c, skipctx;
    __device__ void init(int M, int N, int G_, int c_, int skip_ = 0) { skipctx = skip_; nM = skip_ ? 64 : M / BM; nN = N / BM; nwg = nM * nN; G = G_; c = c_; }
    __device__ bool next(int i, Unit& u) const {
        const long L = (long)i * G + c; if (L >= nwg) return false;
        const int wgid = xcd_remap((int)L, nwg);
        const int nig = WGM * nN, gid = wgid / nig, fm = gid * WGM, gsz = (nM - fm) < WGM ? (nM - fm) : WGM;
        u.pm = fm + ((wgid % nig) % gsz); u.pn = (wgid % nig) / gsz; u.e = 0; u.cnt = 0; u.tile = 0;
        if (skipctx) u.pm = u.pm + u.pm / 16 + 1;
        return true;
    }
};
struct MoeOrder {
    const LAS int* tstart; const LAS int* cnts; int ntiles, G, c;
    __device__ bool next(int i, Unit& u) const {
        const int nwg = ntiles * 4; const long L = (long)i * G + c; if (L >= nwg) return false;
        const int wgid = xcd_remap((int)L, nwg);
        const int tile = wgid >> 2; u.pn = wgid & 3; u.tile = tile;
        int e = 0;
        for (int k = 1; k < NEXP; ++k) e += (tstart[k] <= tile) ? 1 : 0;
        u.e = e; u.pm = tile - tstart[e]; u.cnt = cnts[e]; return true;
    }
};

struct PlainAddr {
    static constexpr bool GATHER = false;
    const bf16_t* A; const bf16_t* Bt; int K;
    __device__ __forceinline__ void base(const Unit& u, const char*& cA, const char*& cB) const { cA = (const char*)(A + (size_t)u.pm * BM * K); cB = (const char*)(Bt + (size_t)u.pn * BM * K); }
    __device__ __forceinline__ void rows(const Unit&, const int (&)[2], const int (&)[2], unsigned (&)[2], unsigned (&)[2]) const {}
};
struct MoeGatherAddr {
    static constexpr bool GATHER = true;
    const bf16_t* HB; const bf16_t* Wbase; const unsigned* list; int K;
    __device__ __forceinline__ void base(const Unit& u, const char*& cA, const char*& cB) const { cA = (const char*)HB; cB = (const char*)Wbase + (size_t)u.e * (3u << 20) + (size_t)u.pn * BM * K * 2; }
    __device__ __forceinline__ void rows(const Unit& u, const int (&R)[2], const int (&C)[2], unsigned (&v0)[2], unsigned (&v1)[2]) const {
        const unsigned* lp = list + (size_t)u.e * LIST_CAP;
#pragma unroll
        for (int i = 0; i < 2; ++i) {
            int i0 = u.pm * BM + R[i], i1 = i0 + HALF; const int mx = u.cnt - 1; i0 = i0 < mx ? i0 : mx; i1 = i1 < mx ? i1 : mx;
            const unsigned t0 = __hip_atomic_load(lp + i0, __ATOMIC_RELAXED, __HIP_MEMORY_SCOPE_AGENT), t1 = __hip_atomic_load(lp + i1, __ATOMIC_RELAXED, __HIP_MEMORY_SCOPE_AGENT);
            v0[i] = (t0 * (unsigned)K + (unsigned)C[i]) * 2u; v1[i] = (t1 * (unsigned)K + (unsigned)C[i]) * 2u;
        }
    }
};
struct MoeActAddr {
    static constexpr bool GATHER = false;
    const bf16_t* Act; const bf16_t* Wbase; int K;
    __device__ __forceinline__ void base(const Unit& u, const char*& cA, const char*& cB) const { cA = (const char*)(Act + (size_t)u.tile * BM * K); cB = (const char*)Wbase + (size_t)u.e * (3u << 20) + (size_t)u.pn * BM * K * 2; }
    __device__ __forceinline__ void rows(const Unit&, const int (&)[2], const int (&)[2], unsigned (&)[2], unsigned (&)[2]) const {}
};

__device__ __forceinline__ unsigned cvt_pk_bf16(float lo, float hi) { unsigned r; asm volatile("v_cvt_pk_bf16_f32 %0, %1, %2" : "=v"(r) : "v"(lo), "v"(hi)); return r; }

template <class Epi, class Sched, class Addr>
__device__ __forceinline__ void gemm_phase(LAS unsigned char* lds, const Addr& AD, const Sched& S, const Epi& E, const int K) {
    int tid = threadIdx.x; asm volatile("" : "+v"(tid));
    const int wid = __builtin_amdgcn_readfirstlane(tid >> 6), lane = tid & 63, wr = wid >> 2, wc = wid & 3, fr = lane & 15, fq = lane >> 4;
    const int nt = K / BK;
    int sR[2], sC[2]; unsigned voffA[2], voffB[2];
#pragma unroll
    for (int i = 0; i < 2; ++i) { int R, C; stage_rc(tid * 16 + i * 8192, R, C); sR[i] = R; sC[i] = C; const int Rb = Epi::PERM ? ((R & ~31) + perm32(R & 31)) : R; voffA[i] = (unsigned)(R * K + C) * 2u; voffB[i] = (unsigned)(Rb * K + C) * 2u; }
    const size_t kstep = (size_t)(BK * 2);
    const size_t hstep = (size_t)HALF * K * 2;
    const unsigned ldsw = (unsigned)wid * 1024u;
    const int aoff = lds_byte(wr * 64 + fr, fq * 8), boff = lds_byte(wc * 32 + fr, fq * 8);
#define PG8_SA(b, h) (((b) * 2 + (h)) * HTB)
#define PG8_SB(b, h) ((4 + (b) * 2 + (h)) * HTB)
#define PG8_STAGE(bufoff, gbase, voff) do { _Pragma("unroll") for (int _i = 0; _i < 2; ++_i) \
        __builtin_amdgcn_global_load_lds((const unsigned*)((const char*)(gbase) + (voff)[_i]), (LAS unsigned*)(lds + (bufoff) + ldsw + _i * 8192), 16, 0, 0); } while (0)
#define PG8_LDA(dst, b, h) do { _Pragma("unroll") for (int m = 0; m < 4; ++m) _Pragma("unroll") for (int k = 0; k < 2; ++k) dst[m][k] = *(const LAS bf16x8*)(lds + PG8_SA(b, h) + aoff + m * 2048 + k * 1024); } while (0)
#define PG8_LDB(dst, b, h) do { _Pragma("unroll") for (int n = 0; n < 2; ++n) _Pragma("unroll") for (int k = 0; k < 2; ++k) dst[n][k] = *(const LAS bf16x8*)(lds + PG8_SB(b, h) + boff + n * 2048 + k * 1024); } while (0)
#define PG8_MMA(ai, bj, At, Bt) do { __builtin_amdgcn_s_setprio(1); _Pragma("unroll") for (int m = 0; m < 4; ++m) _Pragma("unroll") for (int n = 0; n < 2; ++n) _Pragma("unroll") for (int k = 0; k < 2; ++k) \
        acc[ai][bj][m][n] = __builtin_amdgcn_mfma_f32_16x16x32_bf16(Bt[n][k], At[m][k], acc[ai][bj][m][n], 0, 0, 0); __builtin_amdgcn_s_setprio(0); } while (0)
#define PG8_WAIT_V(n) asm volatile("s_waitcnt vmcnt(" #n ")" ::: "memory")
#define PG8_WAIT_L(n) asm volatile("s_waitcnt lgkmcnt(" #n ")" ::: "memory")
#define PG8_BAR __builtin_amdgcn_s_barrier()
#define PG8_SCHED __builtin_amdgcn_sched_barrier(0)
    Unit cur, nxt; int ui = 0;
    if (!S.next(0, cur)) return;
    f32x4 acc[2][2][4][2];
#pragma unroll
    for (int a = 0; a < 2; ++a)
#pragma unroll
        for (int b = 0; b < 2; ++b)
#pragma unroll
            for (int m = 0; m < 4; ++m)
#pragma unroll
                for (int n = 0; n < 2; ++n) acc[a][b][m][n] = (f32x4){0.f, 0.f, 0.f, 0.f};
    bf16x8 At[4][2], B0[2][2], B1[2][2];
    const char* cA; const char* cB; unsigned cv0[2] = {voffA[0], voffA[1]}, cv1[2] = {voffA[0], voffA[1]};
    AD.base(cur, cA, cB); AD.rows(cur, sR, sC, cv0, cv1);
    const size_t ah = Addr::GATHER ? (size_t)0 : hstep;
    PG8_STAGE(PG8_SB(0, 0), cB, voffB); PG8_STAGE(PG8_SB(0, 1), cB + hstep, voffB); PG8_STAGE(PG8_SA(0, 0), cA, cv0); PG8_STAGE(PG8_SA(0, 1), cA + ah, cv1);
    if (wr == 1) PG8_BAR;
    PG8_WAIT_V(2); PG8_BAR;
    PG8_STAGE(PG8_SB(1, 0), cB + kstep, voffB); PG8_STAGE(PG8_SA(1, 0), cA + kstep, cv0); PG8_STAGE(PG8_SB(1, 1), cB + hstep + kstep, voffB);
    PG8_WAIT_V(6); PG8_BAR;
    for (;;) {
        const bool has_next = S.next(ui + 1, nxt);
        const char* nA = cA; const char* nB = cB; unsigned nv0[2] = {cv0[0], cv0[1]}, nv1[2] = {cv1[0], cv1[1]};
        if (has_next) { AD.base(nxt, nA, nB); AD.rows(nxt, sR, sC, nv0, nv1); }
#if REP_KLOOP
        for (int rep_ = 0; rep_ <= Epi::REPK; ++rep_) {
        if (rep_ > 0) {
#pragma unroll
            for (int a = 0; a < 2; ++a)
#pragma unroll
                for (int b = 0; b < 2; ++b)
#pragma unroll
                    for (int m = 0; m < 4; ++m)
#pragma unroll
                        for (int n = 0; n < 2; ++n) acc[a][b][m][n] = (f32x4){0.f, 0.f, 0.f, 0.f};
        }
        const bool lastrep = rep_ == Epi::REPK;
#else
        { const bool lastrep = true;
#endif
        for (int t = 0; t < nt; t += 2) {
            const bool last = (t == nt - 2);
            const char* a1 = cA + (size_t)(t + 1) * kstep;
            const char* a2 = last ? (lastrep ? nA : cA) : cA + (size_t)(t + 2) * kstep; const char* b2 = last ? (lastrep ? nB : cB) : cB + (size_t)(t + 2) * kstep;
            const char* a3 = a2 + kstep; const char* b3 = b2 + kstep;
            unsigned x0[2] = {cv0[0], cv0[1]}, x1[2] = {cv1[0], cv1[1]};
            if constexpr (Addr::GATHER) { if (last && lastrep) { x0[0] = nv0[0]; x0[1] = nv0[1]; x1[0] = nv1[0]; x1[1] = nv1[1]; } }
            PG8_LDB(B0, 0, 0); PG8_LDB(B1, 0, 1); PG8_SCHED; PG8_LDA(At, 0, 0); PG8_STAGE(PG8_SA(1, 1), a1 + ah, cv1);
            PG8_WAIT_V(8); PG8_WAIT_L(0); PG8_BAR; PG8_MMA(0, 0, At, B0); PG8_MMA(0, 1, At, B1); PG8_BAR; PG8_SCHED;
            PG8_LDA(At, 0, 1); PG8_STAGE(PG8_SB(0, 0), b2, voffB); PG8_STAGE(PG8_SB(0, 1), b2 + hstep, voffB); PG8_STAGE(PG8_SA(0, 0), a2, x0);
            PG8_WAIT_V(8); PG8_WAIT_L(0); PG8_BAR; PG8_MMA(1, 0, At, B0); PG8_MMA(1, 1, At, B1); PG8_BAR; PG8_SCHED;
            PG8_LDB(B0, 1, 0); PG8_LDB(B1, 1, 1); PG8_SCHED; PG8_LDA(At, 1, 0); PG8_STAGE(PG8_SA(0, 1), a2 + ah, x1);
            PG8_WAIT_V(8); PG8_WAIT_L(0); PG8_BAR; PG8_MMA(0, 0, At, B0); PG8_MMA(0, 1, At, B1); PG8_BAR; PG8_SCHED;
            PG8_LDA(At, 1, 1); PG8_STAGE(PG8_SB(1, 0), b3, voffB); PG8_STAGE(PG8_SB(1, 1), b3 + hstep, voffB); PG8_STAGE(PG8_SA(1, 0), a3, x0);
            PG8_WAIT_V(8); PG8_WAIT_L(0); PG8_BAR; PG8_MMA(1, 0, At, B0); PG8_MMA(1, 1, At, B1); PG8_BAR; PG8_SCHED;
        }
        }
        if (wr == 0) PG8_BAR;
#if REP_KLOOP
        if constexpr (Epi::REPE > 0) { int nrep_ = 1 + Epi::REPE; asm volatile("" : "+s"(nrep_));
#pragma nounroll
          for (int rep_ = 0; rep_ < nrep_; ++rep_) E(acc, cur, wr, wc, fr, fq); }
        else E(acc, cur, wr, wc, fr, fq);
#else
        E(acc, cur, wr, wc, fr, fq);
#endif
        if (!has_next) break;
#pragma unroll
        for (int a = 0; a < 2; ++a)
#pragma unroll
            for (int b = 0; b < 2; ++b)
#pragma unroll
                for (int m = 0; m < 4; ++m)
#pragma unroll
                    for (int n = 0; n < 2; ++n) acc[a][b][m][n] = (f32x4){0.f, 0.f, 0.f, 0.f};
        cur = nxt; cA = nA; cB = nB; cv0[0] = nv0[0]; cv0[1] = nv0[1]; cv1[0] = nv1[0]; cv1[1] = nv1[1]; ++ui;
        if (wr == 1) PG8_BAR;
    }
    PG8_WAIT_V(0);
    PG8_BAR;
#undef PG8_SA
#undef PG8_SB
#undef PG8_STAGE
#undef PG8_LDA
#undef PG8_LDB
#undef PG8_MMA
#undef PG8_WAIT_V
#undef PG8_WAIT_L
#undef PG8_BAR
#undef PG8_SCHED
}
}

#define XB_TMO      128
#define XB_XCNT(j)  (256  + 64 * (j))
#define XB_XSUB(j)  (1280 + 64 * (j))
#define XB_XGEN(j)  (2304 + 64 * (j))
#define XB_TOP      3328
#define XB_TOPGEN   3392
#define XCD_BAR_WORDS 3456
#define XB_SPIN_CAP (1u << 20)
__device__ __forceinline__ unsigned xb_ld(unsigned* p)              { return __hip_atomic_load((GAS unsigned*)p, __ATOMIC_RELAXED, __HIP_MEMORY_SCOPE_AGENT); }
__device__ __forceinline__ unsigned xb_add(unsigned* p, unsigned v) { return __hip_atomic_fetch_add((GAS unsigned*)p, v, __ATOMIC_RELAXED, __HIP_MEMORY_SCOPE_AGENT); }
__device__ __forceinline__ unsigned xb_xcc_id() { return (unsigned)__builtin_amdgcn_s_getreg((3 << 11) | 20) & 0xFu; }
#define XB_SPIN(cond, bar) do { unsigned _sp = 0; while (cond) { __builtin_amdgcn_s_sleep(1); \
    if ((++_sp & 255u) == 0u) { if (xb_ld(&(bar)[XB_TMO])) break; if (_sp > XB_SPIN_CAP) { xb_add(&(bar)[XB_TMO], 1u); break; } } } } while (0)
struct XcdBarrier { unsigned* bar; unsigned x; volatile LAS unsigned* st; };
__device__ __forceinline__ XcdBarrier xcd_barrier_post(unsigned* bar, volatile LAS unsigned* st) {
    XcdBarrier b; b.bar = bar; b.x = xb_xcc_id(); b.st = st;
    if (threadIdx.x == 0) st[2] = xb_add(&bar[XB_XCNT(b.x)], 1u);
    return b;
}
__device__ __forceinline__ void xcd_barrier_complete(unsigned* bar, unsigned x, unsigned& nloc, unsigned& nx) {
    const unsigned G = gridDim.x * gridDim.y * gridDim.z;
    unsigned sum, cnt, mine, sp = 0u;
    for (;;) {
        sum = 0u; cnt = 0u; mine = 0u;
#pragma unroll
        for (unsigned j = 0; j < 16; ++j) { const unsigned c = xb_ld(&bar[XB_XCNT(j)]); sum += c; cnt += (c > 0u) ? 1u : 0u; }
        mine = xb_ld(&bar[XB_XCNT(x)]);
        if (sum == G) break;
        __builtin_amdgcn_s_sleep(1);
        if ((++sp & 255u) == 0u) { if (xb_ld(&bar[XB_TMO])) break; if (sp > XB_SPIN_CAP) { xb_add(&bar[XB_TMO], 1u); break; } }
    }
    nloc = mine > 0u ? mine : 1u; nx = cnt > 0u ? cnt : 1u;
}
__device__ __forceinline__ void xcd_barrier(const XcdBarrier& b) {
    asm volatile("s_waitcnt vmcnt(0)" ::: "memory");
    __syncthreads();
    if (threadIdx.x == 0) {
        unsigned* bar = b.bar; asm volatile("" : "+s"(bar));
        __builtin_amdgcn_s_waitcnt(0);
        unsigned nloc = b.st[0], nx = b.st[1];
        if (nloc == 0u) { xcd_barrier_complete(bar, b.x, nloc, nx); b.st[0] = nloc; b.st[1] = nx; }
        const unsigned old = xb_add(&bar[XB_XSUB(b.x)], 1u);
        const unsigned gen = old / nloc;
        if (old + 1u == (gen + 1u) * nloc) {
            __builtin_amdgcn_fence(__ATOMIC_RELEASE, "agent");
            asm volatile("s_waitcnt vmcnt(0)" ::: "memory");
            const unsigned og = xb_add(&bar[XB_TOP], 1u);
            const unsigned tg = og / nx;
            if (og + 1u == (tg + 1u) * nx) xb_add(&bar[XB_TOPGEN], 1u);
            else XB_SPIN(xb_ld(&bar[XB_TOPGEN]) == tg, bar);
            __builtin_amdgcn_fence(__ATOMIC_ACQUIRE, "agent");
            xb_add(&bar[XB_XGEN(b.x)], 1u);
            asm volatile("s_waitcnt vmcnt(0)" ::: "memory");
        } else {
            XB_SPIN(xb_ld(&bar[XB_XGEN(b.x)]) == gen, bar);
            __builtin_amdgcn_fence(__ATOMIC_ACQUIRE, "agent");
            asm volatile("s_waitcnt vmcnt(0)" ::: "memory");
        }
    }
    __syncthreads();
}

__device__ __forceinline__ int ftid() { int t = (int)threadIdx.x; asm volatile("" : "+v"(t)); return t; }
__device__ __forceinline__ int flane() { return ftid() & 63; }
__device__ __forceinline__ int fbid() { int b = (int)blockIdx.x; asm volatile("" : "+s"(b)); return b; }
#define FCG(F) __builtin_amdgcn_readfirstlane((int)(F).MISC[12])
struct Args { const float* in[23]; float* out; unsigned char* ws; int ph_lo, ph_hi; };
struct Frame {
    LAS unsigned char* lds;
    volatile LAS unsigned* MISC;
    unsigned* ctl;
    unsigned char* ws;
    int wave, vcu, G;
};
enum { I_X = 0, I_C, I_CTX, I_CCTX, I_ADAW, I_ADAB, I_NORMW, I_FNORMW, I_EVWIN, I_EVWOUT, I_RETDECAY, I_SINK, I_ODWIN, I_ODWOUT, I_LBLOG, I_HGNW,
       I_WG, I_BG, I_WE, I_BE, I_W1, I_W3, I_W2 };

__device__ __forceinline__ void conv_item(const float* srcp, int src_ld, bf16_t* WT, int K, int n0, int k0, LAS float* scr, int lane) {
#pragma unroll 8
    for (int i = 0; i < 32; ++i) { const int kk = 2 * i + (lane >> 5); scr[kk * 33 + (lane & 31)] = srcp[(size_t)(k0 + kk) * src_ld]; }
    LDS_WAIT(); asm volatile("" ::: "memory");
    const int c = lane & 7;
#pragma unroll
    for (int j = 0; j < 4; ++j) { const int n = (lane >> 3) + 8 * j; const LAS float* s = scr + (8 * c) * 33 + n;
        u32x4 o; o.x = pk2(s[0 * 33], s[1 * 33]); o.y = pk2(s[2 * 33], s[3 * 33]); o.z = pk2(s[4 * 33], s[5 * 33]); o.w = pk2(s[6 * 33], s[7 * 33]);
        *(u32x4*)(WT + (size_t)(n0 + n) * K + k0 + 8 * c) = o; }
    LDS_WAIT(); asm volatile("" ::: "memory");
}
__device__ __forceinline__ int head_perm(int n) { const int hh = n >> 7, phi = n & 127, g = phi >> 3, u = phi & 7; return hh * 128 + 64 * (g >> 3) + 4 * (g & 7) + (u & 3) + 32 * (u >> 2); }

constexpr int NI_W13 = 16 * 32, NI_W2 = 8 * 32, NI_MOE1 = NI_W13 + NI_W2, MOE_NI = NEXP * NI_MOE1;
#ifndef CONV_TAIL_WAVES
#define CONV_TAIL_WAVES 4
#endif
#ifndef MOE_G1_EVEN
#define MOE_G1_EVEN 7168
#endif
#ifndef MOE_G1_ODD
#define MOE_G1_ODD 6144
#endif
#ifndef MOE_G2_EVEN
#define MOE_G2_EVEN 10240
#endif
#ifndef MOE_G2_ODD
#define MOE_G2_ODD 10240
#endif
__host__ __device__ constexpr int moe_g1_hi(int l) { return (l & 1) ? MOE_G1_ODD : MOE_G1_EVEN; }
__host__ __device__ constexpr int moe_g2_hi(int l) { return l == DEPTH - 1 ? moe_g1_hi(l) : moe_g1_hi(l) + ((l & 1) ? MOE_G2_ODD : MOE_G2_EVEN); }
#ifndef MOE_T_R3
#define MOE_T_R3 6144
#endif
#ifndef MOE_T_M1
#define MOE_T_M1 6144
#endif
#ifndef MOE_T_M2
#define MOE_T_M2 3072
#endif
__host__ __device__ constexpr int moe_min(int a, int b) { return a < b ? a : b; }
__host__ __device__ constexpr int moe_x_hi(int l) { return moe_min(MOE_NI, moe_g2_hi(l) + ((l == 0 || l == 3) ? MOE_T_R3 : MOE_T_M1)); }
__host__ __device__ constexpr int moe_y_hi(int l) { return moe_min(MOE_NI, moe_x_hi(l) + (l == 0 ? 0 : (l == 3 ? MOE_T_M1 : MOE_T_M2))); }
__host__ __device__ constexpr int moe_z_hi(int l) { return moe_min(MOE_NI, moe_y_hi(l) + (l == 3 ? MOE_T_M2 : 0)); }
__host__ __device__ constexpr int moe_p0_lo(int l) { return moe_z_hi(l); }
__host__ __device__ constexpr int moe_p0_cnt(int l) { return l == 3 ? 0 : MOE_NI - moe_p0_lo(l); }
__device__ __forceinline__ void conv_moe_item(Frame& F, const Args& args, int l, int r, LAS float* scr, int lane) {
    const int le = l * NEXP + r / NI_MOE1; r %= NI_MOE1;
    bf16_t* dst = (bf16_t*)(F.ws + WS_W_MOE + (size_t)le * 3 * MiB);
    if (r < NI_W13) { const int kb = r / 32, nb = r % 32; const int n = nb * 32 + (lane & 31);
        const int Gq = n >> 3, u = n & 7; const float* src = (u < 4 ? args.in[I_W1] : args.in[I_W3]) + (size_t)le * DM * FF + 4 * Gq + (u & 3);
        conv_item(src, FF, dst, DM, nb * 32, kb * 64, scr, lane); }
    else { r -= NI_W13; const int kb = r / 32, nb = r % 32; const int n = nb * 32 + (lane & 31);
        conv_item(args.in[I_W2] + (size_t)le * FF * DM + n, DM, dst + (size_t)DM * DM, FF, nb * 32, kb * 64, scr, lane); }
}
__device__ __forceinline__ void conv_moe_tail(Frame& F, const Args& args, int l, int lo, int hi, int nwg) {
    const int r = nwg % F.G, c = FCG(F);
    if (c >= r) {
        __syncthreads();
        LAS float* scr = (LAS float*)(F.lds + F.wave * 16384); const int lane = flane();
        const int nslot = (F.G - r) * CONV_TAIL_WAVES;
        if (F.wave < CONV_TAIL_WAVES)
        for (int it = lo + (c - r) * CONV_TAIL_WAVES + F.wave; it < hi; it += nslot) conv_moe_item(F, args, l, it, scr, lane);
    }
}

constexpr int NI_EVIN = 16 * (EV_N / 32), NI_ODIN = 16 * (OD_N / 32), NI_OUT = 16 * 32, NI_PROJ = 2 * NI_EVIN + 2 * NI_ODIN + 4 * NI_OUT;
__device__ __forceinline__ void conv_proj_item(Frame& F, const Args& args, int r, LAS float* scr, int lane) {
    if (r < 2 * NI_EVIN) { const int p = r / NI_EVIN; r %= NI_EVIN; const int nblk = EV_N / 32, kb = r / nblk, nb = r % nblk; const int n = nb * 32 + (lane & 31);
        conv_item(args.in[I_EVWIN] + (size_t)p * DM * EV_N + head_perm(n), EV_N, (bf16_t*)(F.ws + WS_W_EVIN + (size_t)p * 6 * MiB), DM, nb * 32, kb * 64, scr, lane); return; }
    r -= 2 * NI_EVIN;
    if (r < 2 * NI_ODIN) { const int p = r / NI_ODIN; r %= NI_ODIN; const int nblk = OD_N / 32, kb = r / nblk, nb = r % nblk; const int n = nb * 32 + (lane & 31);
        conv_item(args.in[I_ODWIN] + (size_t)p * DM * OD_N + head_perm(n), OD_N, (bf16_t*)(F.ws + WS_W_ODIN + (size_t)p * 10 * MiB), DM, nb * 32, kb * 64, scr, lane); return; }
    r -= 2 * NI_ODIN;
    { const int q = r / NI_OUT; r %= NI_OUT; const int kb = r / 32, nb = r % 32; const int n = nb * 32 + (lane & 31);
        const float* src = (q < 2 ? args.in[I_EVWOUT] + (size_t)q * DM * DM : args.in[I_ODWOUT] + (size_t)(q - 2) * DM * DM);
        bf16_t* dst = (bf16_t*)(F.ws + (q < 2 ? WS_W_EVOUT + (size_t)q * 2 * MiB : WS_W_ODOUT + (size_t)(q - 2) * 2 * MiB));
        conv_item(src + n, DM, dst, DM, nb * 32, kb * 64, scr, lane); }
}

__device__ __forceinline__ void p0_prologue(Frame& F, const Args& args) {
    LAS float* scr = (LAS float*)(F.lds + F.wave * 16384);
    const int gw = F.vcu * NWAVES + F.wave, NGW = F.G * NWAVES, lane = flane();
    constexpr int NP0 = NI_EVIN + NI_OUT;
    constexpr int NITEMS = NP0 + moe_p0_cnt(0) + moe_p0_cnt(1) + moe_p0_cnt(2) + moe_p0_cnt(3);
    for (int rep_ = 0; rep_ <= REP_CONV; ++rep_)
    for (int it = gw; it < NITEMS; it += NGW) {
        int r = it;
        if (r < NP0) { conv_proj_item(F, args, r < NI_EVIN ? r : (2 * NI_EVIN + 2 * NI_ODIN) + (r - NI_EVIN), scr, lane); continue; }
        r -= NP0;
        if (r < moe_p0_cnt(0)) { conv_moe_item(F, args, 0, moe_p0_lo(0) + r, scr, lane); continue; }
        r -= moe_p0_cnt(0);
        if (r < moe_p0_cnt(1)) { conv_moe_item(F, args, 1, moe_p0_lo(1) + r, scr, lane); continue; }
        r -= moe_p0_cnt(1);
        if (r < moe_p0_cnt(2)) { conv_moe_item(F, args, 2, moe_p0_lo(2) + r, scr, lane); continue; }
        r -= moe_p0_cnt(2);
        conv_moe_item(F, args, 3, moe_p0_lo(3) + r, scr, lane);
    }
    {
        u32x2* xr = (u32x2*)(F.ws + WS_XRES);
        const f32x4* xs = (const f32x4*)args.in[I_X]; const f32x4* cs = (const f32x4*)args.in[I_CTX];
        const size_t total = (size_t)MTOK * 256;
        for (size_t i = (size_t)fbid() * 512 + ftid(); i < total; i += (size_t)F.G * 512) {
            const int row = (int)(i >> 8), c4 = (int)(i & 255); const int b = row / SU, p = row % SU;
            xr[i] = pk4((p < NCTX) ? cs[((size_t)(b * NCTX + p) << 8) + c4] : xs[((size_t)(b * LSEQ + p - NCTX) << 8) + c4]);
        }
    }
    if (NAIVE_COPY) { float* xr2 = (float*)(F.ws + WS_XRES);
        for (size_t i = (size_t)fbid() * 512 + ftid(); i < (size_t)MTOK * DM; i += (size_t)F.G * 512) { const size_t row = i / DM; const int k = (int)(i % DM); const int b = (int)(row / SU), p = (int)(row % SU);
            xr2[i] = p < NCTX ? args.in[I_CTX][((size_t)b * NCTX + p) * DM + k] : args.in[I_X][((size_t)b * LSEQ + (p - NCTX)) * DM + k]; } }
    {
        float* sp = (float*)(F.ws + WS_SP);
        for (int i = fbid() * 512 + ftid(); i < SP_END; i += F.G * 512) {
            float v;
            if (i < SP_FNORMW) v = args.in[I_NORMW][i]; else if (i < SP_WG) v = args.in[I_FNORMW][i - SP_FNORMW]; else if (i < SP_BG) v = args.in[I_WG][i - SP_WG]; else if (i < SP_WE) v = args.in[I_BG][i - SP_BG];
            else if (i < SP_BE) v = args.in[I_WE][i - SP_WE]; else if (i < SP_DECAY) v = args.in[I_BE][i - SP_BE]; else if (i < SP_SINK) v = args.in[I_RETDECAY][i - SP_DECAY]; else if (i < SP_HGNW) v = args.in[I_SINK][i - SP_SINK]; else v = args.in[I_HGNW][i - SP_HGNW];
            sp[i] = v;
        }
    }
    if (blockIdx.x == 0) {
        float* lb = (float*)(F.ws + WS_LB); const float* lg = args.in[I_LBLOG];
        for (int c = ftid(); c < DM; c += 512) {
            const float a0 = lg[c], a1 = lg[DM + c], a2 = lg[2 * DM + c], a3 = lg[3 * DM + c];
            const float mx = fmaxf(fmaxf(a0, a1), fmaxf(a2, a3));
            const float e0 = expf(a0 - mx), e1 = expf(a1 - mx), e2 = expf(a2 - mx), e3 = expf(a3 - mx); const float inv = 1.0f / (e0 + e1 + e2 + e3);
            lb[c] = 0.f; lb[DM + c] = e1 * inv; lb[2 * DM + c] = (e1 + e2) * inv; lb[3 * DM + c] = (e1 + e2 + e3) * inv;
        }
    }
    if (blockIdx.x == 1) {
        float* rc = (float*)(F.ws + WS_ROPEC); float* rs = (float*)(F.ws + WS_ROPES);
        for (int i = ftid(); i < 64 * 32; i += 512) { const int pos = i >> 5, fi = i & 31;
            const float invf = powf(10000.0f, -(float)(2 * fi) / 64.0f); const float ang = (float)pos * invf;
            rc[i] = cosf(ang); rs[i] = sinf(ang); }
    }
    {
        __syncthreads();
        LAS float* sv = (LAS float*)F.lds;
        LAS float* part = (LAS float*)(F.lds + 20480);
        for (int i = ftid(); i < 5 * DM; i += 512) { const int r = i >> 10, k = i & 1023; const float v = (r < 4) ? args.in[I_C][r * DM + k] : args.in[I_CCTX][k]; sv[i] = siluf(v); }
        __syncthreads();
        float* mod = (float*)(F.ws + WS_MOD);
        for (int it = fbid(); it < DEPTH * 96; it += F.G) {
            const int l = it / 96, cg = it % 96; const int col = cg * 64 + lane;
            const float* w = args.in[I_ADAW] + (size_t)l * DM * 6144 + col;
            float a[5] = {0.f, 0.f, 0.f, 0.f, 0.f};
            const int k0 = F.wave * 128;
#pragma unroll 8
            for (int k = 0; k < 128; ++k) { const float wv = w[(size_t)(k0 + k) * 6144];
#pragma unroll
                for (int r = 0; r < 5; ++r) a[r] += sv[r * DM + k0 + k] * wv; }
#pragma unroll
            for (int r = 0; r < 5; ++r) part[(F.wave * 5 + r) * 64 + lane] = a[r];
            __syncthreads();
            if (ftid() < 320) { const int r = ftid() >> 6, c = ftid() & 63; float s = 0.f;
#pragma unroll
                for (int w8 = 0; w8 < 8; ++w8) s += part[(w8 * 5 + r) * 64 + c];
                mod[((size_t)l * 5 + r) * 6144 + cg * 64 + c] = s + args.in[I_ADAB][l * 6144 + cg * 64 + c]; }
            __syncthreads();
        }
    }
}

__device__ __forceinline__ int moe_tile_prefix(const unsigned* cnt, int lane, int& mycnt) {
    const int c = (lane < NEXP) ? (int)__hip_atomic_load(cnt + lane, __ATOMIC_RELAXED, __HIP_MEMORY_SCOPE_AGENT) : 0; mycnt = c;
    const int nt = (c + 255) >> 8; int incl = nt;
#pragma unroll
    for (int o = 1; o < 64; o <<= 1) { const int v = shup_i(incl, o, lane); if (lane >= o) incl += v; }
    return incl - nt;
}

template <bool FINAL>
__device__ __forceinline__ void n1_phase(Frame& F, const Args& args, int l) {
    const int gw = (MUT_A ? fbid() : F.vcu) * NWAVES + F.wave, NGW = F.G * NWAVES, lane = flane();
    float* xres = (float*)(F.ws + WS_XRES);
    const float* mod = (const float*)(F.ws + WS_MOD);
    int tprefix = 0, dummy;
    if (l > 0) tprefix = moe_tile_prefix(F.ctl + CW_CNT + (l - 1) * NEXP, lane, dummy);
    for (int rr_ = 0; rr_ < (MUT_D ? 64 : 9); ++rr_) {
        const int row = MUT_D ? (fbid() * 512 + F.wave * 64 + rr_) : (gw + rr_ * NGW); if (row >= MTOK) continue;
        const int b = row / SU, p = row % SU; const int mrow = (p < NCTX) ? 4 : b;
        if (FINAL && p < NCTX) continue;
        u32x2* xr = (u32x2*)((bf16_t*)(F.ws + WS_XRES) + (size_t)row * DM) + lane;
        f32x4 v[4];
#pragma unroll
        for (int j = 0; j < 4; ++j) v[j] = bf4(xr[64 * j]);
        if (l > 0 && CONTRIB_MOE) {
            {
                unsigned* tiw = (unsigned*)(F.ws + WS_TOKINFO) + (size_t)row * 8;
                u32x4 t0, t1;
                t0.x = __hip_atomic_load(tiw + 0, __ATOMIC_RELAXED, __HIP_MEMORY_SCOPE_AGENT); t0.y = __hip_atomic_load(tiw + 1, __ATOMIC_RELAXED, __HIP_MEMORY_SCOPE_AGENT);
                t0.z = __hip_atomic_load(tiw + 2, __ATOMIC_RELAXED, __HIP_MEMORY_SCOPE_AGENT); t0.w = __hip_atomic_load(tiw + 3, __ATOMIC_RELAXED, __HIP_MEMORY_SCOPE_AGENT);
                t1.x = __hip_atomic_load(tiw + 4, __ATOMIC_RELAXED, __HIP_MEMORY_SCOPE_AGENT); t1.y = __hip_atomic_load(tiw + 5, __ATOMIC_RELAXED, __HIP_MEMORY_SCOPE_AGENT); t1.z = 0u; t1.w = 0u;
                const int ts0 = shidx_i(tprefix, (int)t0.x), ts1 = shidx_i(tprefix, (int)t0.z);
                const size_t s0 = (size_t)ts0 * 256 + t0.y, s1 = (size_t)ts1 * 256 + t0.w;
                const unsigned gb0 = t1.x, gb1 = t1.y;
                const float g0 = __builtin_bit_cast(float, gb0), g1 = __builtin_bit_cast(float, gb1);
                const u32x2* y0 = (const u32x2*)(F.ws + WS_YB + s0 * (DM * 2)) + lane; const u32x2* y1 = (const u32x2*)(F.ws + WS_YB + s1 * (DM * 2)) + lane;
                const f32x4* gp = (const f32x4*)(mod + ((size_t)(l - 1) * 5 + mrow) * 6144 + 5 * DM) + lane;
                if (NAIVE_MOE) {
                    const f32x4* n0 = (const f32x4*)(F.ws + WS_YN + (size_t)row * 2 * DM * 4) + lane; const f32x4* n1 = n0 + 256;
#pragma unroll
                    for (int j = 0; j < 4; ++j) { const f32x4 g = gp[64 * j]; v[j] = v[j] + g * (n0[64 * j] * g0 + n1[64 * j] * g1); }
                } else {
                if (MUT_B) {
                    const bf16_t* yy0 = (const bf16_t*)(F.ws + WS_YB) + s0 * DM; const bf16_t* yy1 = (const bf16_t*)(F.ws + WS_YB) + s1 * DM;
                    const float* gate = mod + ((size_t)(l - 1) * 5 + mrow) * 6144 + 5 * DM;
#pragma unroll
                    for (int j = 0; j < 4; ++j) { const int k = 4 * lane + 256 * j;
                        v[j].x += gate[k] * (g0 * bf2f(yy0[k]) + g1 * bf2f(yy1[k])); v[j].y += gate[k + 1] * (g0 * bf2f(yy0[k + 1]) + g1 * bf2f(yy1[k + 1]));
                        v[j].z += gate[k + 2] * (g0 * bf2f(yy0[k + 2]) + g1 * bf2f(yy1[k + 2])); v[j].w += gate[k + 3] * (g0 * bf2f(yy0[k + 3]) + g1 * bf2f(yy1[k + 3])); }
                } else {
#pragma unroll
                for (int j = 0; j < 4; ++j) { const u32x2 a = y0[64 * j], c = y1[64 * j]; const f32x4 g = gp[64 * j];
                    v[j].x += g.x * (g0 * bflo(a.x) + g1 * bflo(c.x)); v[j].y += g.y * (g0 * bfhi(a.x) + g1 * bfhi(c.x));
                    v[j].z += g.z * (g0 * bflo(a.y) + g1 * bflo(c.y)); v[j].w += g.w * (g0 * bfhi(a.y) + g1 * bfhi(c.y)); }
                }
                }
                if (!FINAL) {
#pragma unroll
                    for (int j = 0; j < 4; ++j) xr[64 * j] = pk4(v[j]);
                }
            }
        }
        float s = 0.f;
#pragma unroll
        for (int j = 0; j < 4; ++j) s += (v[j].x * v[j].x + v[j].y * v[j].y) + (v[j].z * v[j].z + v[j].w * v[j].w);
        const float rstd = 1.0f / sqrtf(wave_sum(s, lane) * (1.0f / DM) + EPS);
        if (FINAL) {
            const f32x4* nw = (const f32x4*)((const float*)(F.ws + WS_SP) + SP_FNORMW) + lane;
            f32x4* o = (f32x4*)(args.out + ((size_t)b * LSEQ + (p - NCTX)) * DM) + lane;
#pragma unroll
            for (int j = 0; j < 4; ++j) { const f32x4 w = nw[64 * j]; o[64 * j] = v[j] * rstd * w; }
        } else {
            const f32x4* nw = (const f32x4*)(((const float*)(F.ws + WS_SP) + SP_NORMW) + (size_t)(l * 2 + 0) * DM) + lane;
            const f32x4* sh = (const f32x4*)(mod + ((size_t)l * 5 + mrow) * 6144 + 0 * DM) + lane;
            const f32x4* sc = (const f32x4*)(mod + ((size_t)l * 5 + mrow) * 6144 + 1 * DM) + lane;
            u32x2* o = (u32x2*)(F.ws + WS_HB + (size_t)row * (DM * 2)) + lane;
#pragma unroll
            for (int j = 0; j < 4; ++j) { const f32x4 w = nw[64 * j], a = sh[64 * j], c = sc[64 * j]; const f32x4 h = v[j] * rstd * w * (c + 1.0f) + a;
                u32x2 q; q.x = pk2(h.x, h.y); q.y = pk2(h.z, h.w); o[64 * j] = q; }
        }
    }
}

__device__ __forceinline__ void naive_n1(Frame& F, const Args& args, int l, bool final_) {
    float* xres = (float*)(F.ws + WS_XRES);
    const float* mod = (const float*)(F.ws + WS_MOD);
    for (int row = fbid() * 512 + ftid(); row < MTOK; row += F.G * 512) {
        const int b = row / SU, p = row % SU; const int mrow = (p < NCTX) ? 4 : b;
        if (final_ && p < NCTX) continue;
        float* xr = xres + (size_t)row * DM;
        if (l > 0) {
            const unsigned* cnt = F.ctl + CW_CNT + (l - 1) * NEXP;
            const unsigned* ti = (const unsigned*)(F.ws + WS_TOKINFO) + (size_t)row * 8;
            const unsigned e0 = ti[0], p0 = ti[1], e1 = ti[2], p1 = ti[3]; const float g0 = __builtin_bit_cast(float, ti[4]), g1 = __builtin_bit_cast(float, ti[5]);
            int ts0 = 0, ts1 = 0; for (unsigned e = 0; e < e0; ++e) ts0 += ((int)cnt[e] + 255) / 256; for (unsigned e = 0; e < e1; ++e) ts1 += ((int)cnt[e] + 255) / 256;
            const bf16_t* y0 = (const bf16_t*)(F.ws + WS_YB) + ((size_t)ts0 * 256 + p0) * DM; const bf16_t* y1 = (const bf16_t*)(F.ws + WS_YB) + ((size_t)ts1 * 256 + p1) * DM;
            const float* gate = mod + ((size_t)(l - 1) * 5 + mrow) * 6144 + 5 * DM;
            for (int k = 0; k < DM; ++k) xr[k] = xr[k] + gate[k] * (g0 * bf2f(y0[k]) + g1 * bf2f(y1[k]));
        }
        double ss = 0.0; for (int k = 0; k < DM; ++k) ss += (double)xr[k] * xr[k];
        const float rstd = 1.0f / sqrtf((float)(ss / DM) + EPS);
        if (final_) { float* o = args.out + ((size_t)b * LSEQ + (p - NCTX)) * DM; for (int k = 0; k < DM; ++k) o[k] = xr[k] * rstd * args.in[I_FNORMW][k]; }
        else { bf16_t* hb = (bf16_t*)(F.ws + WS_HB) + (size_t)row * DM; const float* nw = args.in[I_NORMW] + (size_t)(l * 2) * DM; const float* mr = mod + ((size_t)l * 5 + mrow) * 6144;
            for (int k = 0; k < DM; ++k) hb[k] = (bf16_t)f2bf(xr[k] * rstd * nw[k] * (1.0f + mr[DM + k]) + mr[k]); }
    }
}
__device__ __forceinline__ void wave_n1(Frame& F, const Args& args, int l, bool final_) {
    float* xres = (float*)(F.ws + WS_XRES);
    const float* mod = (const float*)(F.ws + WS_MOD);
    const int gw = F.vcu * NWAVES + F.wave, NGW = F.G * NWAVES, lane = flane();
    for (int row = gw; row < MTOK; row += NGW) {
        const int b = row / SU, p = row % SU; const int mrow = (p < NCTX) ? 4 : b;
        if (final_ && p < NCTX) continue;
        float* xr = xres + (size_t)row * DM;
        float xv[16];
#pragma unroll
        for (int i = 0; i < 16; ++i) xv[i] = xr[lane + 64 * i];
        if (l > 0) {
            const unsigned* cnt = F.ctl + CW_CNT + (l - 1) * NEXP;
            const unsigned* ti = (const unsigned*)(F.ws + WS_TOKINFO) + (size_t)row * 8;
            const unsigned e0 = ti[0], p0 = ti[1], e1 = ti[2], p1 = ti[3]; const float g0 = __builtin_bit_cast(float, ti[4]), g1 = __builtin_bit_cast(float, ti[5]);
            int ts0 = 0, ts1 = 0; for (unsigned e = 0; e < e0; ++e) ts0 += ((int)cnt[e] + 255) / 256; for (unsigned e = 0; e < e1; ++e) ts1 += ((int)cnt[e] + 255) / 256;
            const bf16_t* y0 = (const bf16_t*)(F.ws + WS_YB) + ((size_t)ts0 * 256 + p0) * DM; const bf16_t* y1 = (const bf16_t*)(F.ws + WS_YB) + ((size_t)ts1 * 256 + p1) * DM;
            const float* gate = mod + ((size_t)(l - 1) * 5 + mrow) * 6144 + 5 * DM;
#pragma unroll
            for (int i = 0; i < 16; ++i) { const int k = lane + 64 * i; xv[i] = xv[i] + gate[k] * (g0 * bf2f(y0[k]) + g1 * bf2f(y1[k])); if (!final_) xr[k] = xv[i]; }
        }
        float ss = 0.f;
#pragma unroll
        for (int i = 0; i < 16; ++i) ss += xv[i] * xv[i];
        const float rstd = 1.0f / sqrtf(wave_sum(ss, lane) * (1.0f / DM) + EPS);
        if (final_) { float* o = args.out + ((size_t)b * LSEQ + (p - NCTX)) * DM;
#pragma unroll
            for (int i = 0; i < 16; ++i) { const int k = lane + 64 * i; o[k] = xv[i] * rstd * args.in[I_FNORMW][k]; } }
        else { bf16_t* hb = (bf16_t*)(F.ws + WS_HB) + (size_t)row * DM; const float* nw = args.in[I_NORMW] + (size_t)(l * 2) * DM; const float* mr = mod + ((size_t)l * 5 + mrow) * 6144;
#pragma unroll
            for (int i = 0; i < 16; ++i) { const int k = lane + 64 * i; hb[k] = (bf16_t)f2bf(xv[i] * rstd * nw[k] * (1.0f + mr[DM + k]) + mr[k]); } }
    }
}
__device__ __forceinline__ void n2r_phase(Frame& F, const Args& args, int l) {
    const int gw = F.vcu * NWAVES + F.wave, NGW = F.G * NWAVES, lane = flane();
    const float* xres = (const float*)(F.ws + WS_XRES);
    const float* mod = (const float*)(F.ws + WS_MOD);
    unsigned* cnt = F.ctl + CW_CNT + l * NEXP;
    unsigned* list = (unsigned*)(F.ws + WS_LIST);
    const float* wg = ((const float*)(F.ws + WS_SP) + SP_WG) + (size_t)l * DM * 4; const float* bg = ((const float*)(F.ws + WS_SP) + SP_BG) + l * 4;
    const float* we = ((const float*)(F.ws + WS_SP) + SP_WE) + (size_t)l * 4 * DM * 8; const float* be = ((const float*)(F.ws + WS_SP) + SP_BE) + l * 32;
    LAS float* wgT = (LAS float*)F.lds; LAS float* weT = wgT + 4 * DM;
    LAS unsigned* hist = (LAS unsigned*)(F.lds + LDSCTL_OFF + 1024); LAS unsigned* baseL = hist + 32; LAS unsigned* rec = hist + 64 + F.wave * 36;
    __syncthreads();
    if (ftid() < 32) hist[ftid()] = 0u;
    {   const int t = ftid();
        for (int r = t; r < DM; r += 512) { const f32x4 a = *(const f32x4*)(wg + (size_t)r * 4); wgT[r] = a.x; wgT[DM + r] = a.y; wgT[2 * DM + r] = a.z; wgT[3 * DM + r] = a.w; }
        for (int r = t; r < 4 * DM; r += 512) { const int g = r >> 10, c = r & 1023; const f32x4 a = *(const f32x4*)(we + (size_t)r * 8), b2 = *(const f32x4*)(we + (size_t)r * 8 + 4);
            LAS float* d = weT + g * 8 * DM + c; d[0] = a.x; d[DM] = a.y; d[2 * DM] = a.z; d[3 * DM] = a.w; d[4 * DM] = b2.x; d[5 * DM] = b2.y; d[6 * DM] = b2.z; d[7 * DM] = b2.w; }
    }
    __syncthreads();
    for (int k_ = 0; k_ < 9; ++k_) {
        const int row = gw + k_ * NGW; if (row >= MTOK) break;
        const int b = row / SU, p = row % SU; const int mrow = (p < NCTX) ? 4 : b;
        if (l == DEPTH - 1 && p < NCTX) continue;
        const u32x2* xr = (const u32x2*)((const bf16_t*)(F.ws + WS_XRES) + (size_t)row * DM) + lane;
        f32x4 v[4]; f32x4 s4 = (f32x4){0.f, 0.f, 0.f, 0.f};
#pragma unroll
        for (int j = 0; j < 4; ++j) { v[j] = bf4(xr[64 * j]); s4 += v[j] * v[j]; }
        const float rstd = __builtin_amdgcn_rsqf(wave_sum_dpp((s4.x + s4.y) + (s4.z + s4.w)) * (1.0f / DM) + EPS);
        const f32x4* nw = (const f32x4*)(((const float*)(F.ws + WS_SP) + SP_NORMW) + (size_t)(l * 2 + 1) * DM) + lane;
        const f32x4* sh = (const f32x4*)(mod + ((size_t)l * 5 + mrow) * 6144 + 3 * DM) + lane;
        const f32x4* sc = (const f32x4*)(mod + ((size_t)l * 5 + mrow) * 6144 + 4 * DM) + lane;
        u32x2* o = (u32x2*)(F.ws + WS_HB + (size_t)row * (DM * 2)) + lane;
        f32x4 ga[4];
#pragma unroll
        for (int g = 0; g < 4; ++g) ga[g] = (f32x4){0.f, 0.f, 0.f, 0.f};
#pragma unroll
        for (int j = 0; j < 4; ++j) { const f32x4 w = nw[64 * j], a = sh[64 * j], c = sc[64 * j]; const f32x4 h = v[j] * rstd * w * (c + 1.0f) + a; v[j] = h;
            u32x2 q; q.x = pk2(h.x, h.y); q.y = pk2(h.z, h.w); o[64 * j] = q;
#pragma unroll
            for (int g = 0; g < 4; ++g) { const f32x4 wv = *(const LAS f32x4*)(wgT + g * DM + 4 * lane + 256 * j); ga[g] += h * wv; } }
        float gl[4];
#pragma unroll
        for (int g = 0; g < 4; ++g) gl[g] = wave_sum_dpp((ga[g].x + ga[g].y) + (ga[g].z + ga[g].w)) + bg[g];
        int gi = 0; float gm = gl[0];
#pragma unroll
        for (int g = 1; g < 4; ++g) if (gl[g] > gm) { gm = gl[g]; gi = g; }
        const float gp = 1.0f / (__expf(gl[0] - gm) + __expf(gl[1] - gm) + __expf(gl[2] - gm) + __expf(gl[3] - gm));
        const LAS float* weg = weT + gi * 8 * DM;
        f32x4 ea[8];
#pragma unroll
        for (int e = 0; e < 8; ++e) ea[e] = (f32x4){0.f, 0.f, 0.f, 0.f};
#pragma unroll
        for (int j = 0; j < 4; ++j) {
#pragma unroll
            for (int e = 0; e < 8; ++e) { const f32x4 wv = *(const LAS f32x4*)(weg + e * DM + 4 * lane + 256 * j); ea[e] += v[j] * wv; }
        }
        float el[8];
#pragma unroll
        for (int e = 0; e < 8; ++e) el[e] = wave_sum_dpp((ea[e].x + ea[e].y) + (ea[e].z + ea[e].w)) + be[gi * 8 + e];
        int i0 = 0; float v0 = el[0];
#pragma unroll
        for (int e = 1; e < 8; ++e) if (el[e] > v0) { v0 = el[e]; i0 = e; }
        int i1 = -1; float v1 = -3.0e38f;
#pragma unroll
        for (int e = 0; e < 8; ++e) if (e != i0 && el[e] > v1) { v1 = el[e]; i1 = e; }
        const float w0 = 1.0f / (1.0f + __expf(v1 - v0)), w1 = 1.0f - w0;
        if (lane == 0) {
            const unsigned e0 = (unsigned)(gi * 8 + i0), e1 = (unsigned)(gi * 8 + i1);
            const unsigned lp0 = __hip_atomic_fetch_add(hist + e0, 1u, __ATOMIC_RELAXED, __HIP_MEMORY_SCOPE_WORKGROUP), lp1 = __hip_atomic_fetch_add(hist + e1, 1u, __ATOMIC_RELAXED, __HIP_MEMORY_SCOPE_WORKGROUP);
            rec[k_ * 4 + 0] = e0; rec[k_ * 4 + 1] = lp0; rec[k_ * 4 + 2] = e1; rec[k_ * 4 + 3] = lp1;
            u32x4* ti = (u32x4*)(F.ws + WS_TOKINFO) + (size_t)row * 2;
            ti[1] = (u32x4){__builtin_bit_cast(unsigned, gp * w0), __builtin_bit_cast(unsigned, gp * w1), 0u, 0u};
        }
    }
    __syncthreads();
    if (ftid() < 32) { const unsigned hc = hist[ftid()]; baseL[ftid()] = hc ? atomicAdd(cnt + ftid(), hc) : 0u; }
    __syncthreads();
    if (lane == 0) {
        for (int k_ = 0; k_ < 9; ++k_) {
            const int row = gw + k_ * NGW; if (row >= MTOK) break;
            if (l == DEPTH - 1 && (row % SU) < NCTX) continue;
            const unsigned e0 = rec[k_ * 4 + 0], e1 = rec[k_ * 4 + 2]; const unsigned p0 = baseL[e0] + rec[k_ * 4 + 1], p1 = baseL[e1] + rec[k_ * 4 + 3];
            list[(size_t)e0 * LIST_CAP + p0] = (unsigned)row; list[(size_t)e1 * LIST_CAP + p1] = (unsigned)row;
            u32x4* ti = (u32x4*)(F.ws + WS_TOKINFO) + (size_t)row * 2;
            ti[0] = (u32x4){e0, p0, e1, p1};
        }
    }
    __syncthreads();
}

__device__ __forceinline__ void naive_n2r(Frame& F, const Args& args, int l) {
    const float* xres = (const float*)(F.ws + WS_XRES);
    const float* mod = (const float*)(F.ws + WS_MOD);
    unsigned* cnt = F.ctl + CW_CNT + l * NEXP;
    unsigned* list = (unsigned*)(F.ws + WS_LIST);
    const float* wg = args.in[I_WG] + (size_t)l * DM * 4; const float* bg = args.in[I_BG] + l * 4;
    const float* we = args.in[I_WE] + (size_t)l * 4 * DM * 8; const float* be = args.in[I_BE] + l * 32;
    for (int row = fbid() * 512 + ftid(); row < MTOK; row += F.G * 512) {
        const int b = row / SU, p = row % SU; const int mrow = (p < NCTX) ? 4 : b;
        if (l == DEPTH - 1 && p < NCTX) continue;
        const float* xr = xres + (size_t)row * DM; double ss = 0.0;
        for (int k = 0; k < DM; ++k) ss += (double)xr[k] * xr[k];
        const float rstd = 1.0f / sqrtf((float)(ss / DM) + EPS);
        const float* nw = args.in[I_NORMW] + (size_t)(l * 2 + 1) * DM; const float* mr = mod + ((size_t)l * 5 + mrow) * 6144;
        bf16_t* hb = (bf16_t*)(F.ws + WS_HB) + (size_t)row * DM;
        float gl[4] = {bg[0], bg[1], bg[2], bg[3]};
        for (int k = 0; k < DM; ++k) { const float h = xr[k] * rstd * nw[k] * (1.0f + mr[4 * DM + k]) + mr[3 * DM + k]; hb[k] = (bf16_t)f2bf(h);
            gl[0] += h * wg[k * 4 + 0]; gl[1] += h * wg[k * 4 + 1]; gl[2] += h * wg[k * 4 + 2]; gl[3] += h * wg[k * 4 + 3]; }
        int gi = 0; for (int g = 1; g < 4; ++g) if (gl[g] > gl[gi]) gi = g;
        float den = 0.f; for (int g = 0; g < 4; ++g) den += expf(gl[g] - gl[gi]);
        const float gp = 1.0f / den;
        float el[8]; for (int e = 0; e < 8; ++e) el[e] = be[gi * 8 + e];
        for (int k = 0; k < DM; ++k) { const float h = xr[k] * rstd * nw[k] * (1.0f + mr[4 * DM + k]) + mr[3 * DM + k]; const float* wr = we + ((size_t)gi * DM + k) * 8;
#pragma unroll
            for (int e = 0; e < 8; ++e) el[e] += h * wr[e]; }
        int i0 = 0; for (int e = 1; e < 8; ++e) if (el[e] > el[i0]) i0 = e;
        int i1 = (i0 == 0) ? 1 : 0; for (int e = 0; e < 8; ++e) if (e != i0 && el[e] > el[i1]) i1 = e;
        const float m2 = el[i0]; const float a0 = 1.0f, a1 = expf(el[i1] - m2); const float w0 = a0 / (a0 + a1), w1 = a1 / (a0 + a1);
        const unsigned e0 = (unsigned)(gi * 8 + i0), e1 = (unsigned)(gi * 8 + i1);
        const unsigned p0 = atomicAdd(cnt + e0, 1u), p1 = atomicAdd(cnt + e1, 1u);
        list[(size_t)e0 * LIST_CAP + p0] = (unsigned)row; list[(size_t)e1 * LIST_CAP + p1] = (unsigned)row;
        u32x4* ti = (u32x4*)(F.ws + WS_TOKINFO) + (size_t)row * 2;
        ti[0] = (u32x4){e0, p0, e1, p1}; ti[1] = (u32x4){__builtin_bit_cast(unsigned, gp * w0), __builtin_bit_cast(unsigned, gp * w1), 0u, 0u};
    }
}

struct EpiProj {
    static constexpr bool PERM = true; static constexpr int REPK = REPK_EPIPROJ, REPE = REPE_EPIPROJ;
    unsigned char* ws; const float* lb; int odd;
    __device__ __forceinline__ void operator()(const f32x4 (&acc)[2][2][4][2], const pg8::Unit& u, int wr, int wc, int fr, int fq) const {
        const int pmb = u.pm % 17; const bool isctx = (pmb == 0); const int tbase = (pmb - 1) * 256;
        const int g = 4 * wc + fq, half = g >> 3, f0 = 4 * (g & 7);
        const float* ropec = (const float*)(ws + WS_ROPEC); const float* ropes = (const float*)(ws + WS_ROPES);
#pragma unroll
        for (int bj = 0; bj < 2; ++bj) {
            const int hcol = 256 * u.pn + 128 * bj; const int lc0 = hcol + 64 * half + f0;
            if (!odd) {
                const bool rope = !isctx && (hcol < 1024 || (hcol >= 2048 && hcol < 2816));
                const float scale = (hcol >= 512 && hcol < 1024) ? 0.08838834764831845f : 1.0f;
                bf16_t* dst = (bf16_t*)(ws + WS_PE);
#pragma unroll
                for (int ai = 0; ai < 2; ++ai)
#pragma unroll
                    for (int m = 0; m < 4; ++m) {
                        const int rr = 128 * ai + 64 * wr + 16 * m + fr; const size_t row = (size_t)u.pm * 256 + rr;
                        f32x4 x1 = acc[ai][bj][m][0] * scale, x2 = acc[ai][bj][m][1] * scale;
                        if (rope) { const int t = tbase + rr; const int pos = half ? (t & 63) : (t >> 6);
                            const f32x4 c = *(const f32x4*)(ropec + pos * 32 + f0), s = *(const f32x4*)(ropes + pos * 32 + f0);
                            const f32x4 o1 = x1 * c - x2 * s, o2 = x2 * c + x1 * s; x1 = o1; x2 = o2; }
                        u32x2 q1, q2; q1.x = pk2(x1.x, x1.y); q1.y = pk2(x1.z, x1.w); q2.x = pk2(x2.x, x2.y); q2.y = pk2(x2.z, x2.w);
                        *(u32x2*)(dst + row * EV_N + lc0) = q1; *(u32x2*)(dst + row * EV_N + lc0 + 32) = q2;
                    }
            } else {
                const int seg = hcol >> 10, c0 = lc0 & 1023;
                if (seg == 1 || seg == 2) {
                    bf16_t* dst = (bf16_t*)(ws + (seg == 1 ? WS_FF : WS_FB));
                    const f32x4 l1 = *(const f32x4*)(lb + c0), l2 = *(const f32x4*)(lb + c0 + 32);
#pragma unroll
                    for (int ai = 0; ai < 2; ++ai)
#pragma unroll
                        for (int m = 0; m < 4; ++m) {
                            const size_t row = (size_t)u.pm * 256 + 128 * ai + 64 * wr + 16 * m + fr;
                            const f32x4 z1 = acc[ai][bj][m][0], z2 = acc[ai][bj][m][1]; f32x4 f1, f2;
                            f1.x = (1.f - l1.x) * __builtin_amdgcn_rcpf(1.f + __expf(z1.x)); f1.y = (1.f - l1.y) * __builtin_amdgcn_rcpf(1.f + __expf(z1.y)); f1.z = (1.f - l1.z) * __builtin_amdgcn_rcpf(1.f + __expf(z1.z)); f1.w = (1.f - l1.w) * __builtin_amdgcn_rcpf(1.f + __expf(z1.w));
                            f2.x = (1.f - l2.x) * __builtin_amdgcn_rcpf(1.f + __expf(z2.x)); f2.y = (1.f - l2.y) * __builtin_amdgcn_rcpf(1.f + __expf(z2.y)); f2.z = (1.f - l2.z) * __builtin_amdgcn_rcpf(1.f + __expf(z2.z)); f2.w = (1.f - l2.w) * __builtin_amdgcn_rcpf(1.f + __expf(z2.w));
                            u32x2 q1, q2; q1.x = pk2(f1.x, f1.y); q1.y = pk2(f1.z, f1.w); q2.x = pk2(f2.x, f2.y); q2.y = pk2(f2.z, f2.w);
                            *(u32x2*)(dst + row * DM + c0) = q1; *(u32x2*)(dst + row * DM + c0 + 32) = q2;
                        }
                } else {
                    bf16_t* dst = (bf16_t*)(ws + (seg == 0 ? WS_PQ : (seg == 3 ? WS_PI : WS_PG)));
#pragma unroll
                    for (int ai = 0; ai < 2; ++ai)
#pragma unroll
                        for (int m = 0; m < 4; ++m) {
                            const size_t row = (size_t)u.pm * 256 + 128 * ai + 64 * wr + 16 * m + fr;
                            const f32x4 x1 = acc[ai][bj][m][0], x2 = acc[ai][bj][m][1];
                            u32x2 q1, q2; q1.x = pk2(x1.x, x1.y); q1.y = pk2(x1.z, x1.w); q2.x = pk2(x2.x, x2.y); q2.y = pk2(x2.z, x2.w);
                            *(u32x2*)(dst + row * DM + c0) = q1; *(u32x2*)(dst + row * DM + c0 + 32) = q2;
                        }
                }
            }
        }
    }
};
struct EpiOut {
    static constexpr bool PERM = false; static constexpr int REPK = REPK_EPIOUT, REPE = REPE_EPIOUT;
    bf16_t* xres; const float* modl; int enable;
    __device__ __forceinline__ void operator()(const f32x4 (&acc)[2][2][4][2], const pg8::Unit& u, int wr, int wc, int fr, int fq) const {
        if (!enable) return;
        const int pmb = u.pm % 17; const int mrow = (pmb == 0) ? 4 : (u.pm / 17);
        const float* gate = modl + (size_t)mrow * 6144 + 2 * DM;
#pragma unroll
        for (int bj = 0; bj < 2; ++bj)
#pragma unroll
            for (int n = 0; n < 2; ++n) {
                const int c = 256 * u.pn + 128 * bj + 32 * wc + 16 * n + 4 * fq; const f32x4 gv = *(const f32x4*)(gate + c);
#pragma unroll
                for (int ai = 0; ai < 2; ++ai)
#pragma unroll
                    for (int m = 0; m < 4; ++m) { u32x2* p = (u32x2*)(xres + ((size_t)u.pm * 256 + 128 * ai + 64 * wr + 16 * m + fr) * DM + c); *p = pk4(bf4(*p) + gv * acc[ai][bj][m][n]); }
            }
    }
};
struct EpiAct {
    static constexpr bool PERM = true; static constexpr int REPK = REPK_EPIACT, REPE = REPE_EPIACT;
    bf16_t* Act;
    __device__ __forceinline__ void operator()(const f32x4 (&acc)[2][2][4][2], const pg8::Unit& u, int wr, int wc, int fr, int fq) const {
#pragma unroll
        for (int bj = 0; bj < 2; ++bj) { const int Gq = 32 * u.pn + 16 * bj + 4 * wc + fq;
#pragma unroll
            for (int ai = 0; ai < 2; ++ai)
#pragma unroll
                for (int m = 0; m < 4; ++m) { const size_t row = (size_t)u.tile * 256 + 128 * ai + 64 * wr + 16 * m + fr;
                    const f32x4 a = acc[ai][bj][m][0], b = acc[ai][bj][m][1];
                    u32x2 q; q.x = pk2(siluf(a.x) * b.x, siluf(a.y) * b.y); q.y = pk2(siluf(a.z) * b.z, siluf(a.w) * b.w);
                    *(u32x2*)(Act + row * FF + 4 * Gq) = q; } }
    }
};
struct EpiY {
    static constexpr bool PERM = true; static constexpr int REPK = REPK_EPIY, REPE = REPE_EPIY;
    bf16_t* YB;
    __device__ __forceinline__ void operator()(const f32x4 (&acc)[2][2][4][2], const pg8::Unit& u, int wr, int wc, int fr, int fq) const {
#pragma unroll
        for (int bj = 0; bj < 2; ++bj) { const int c = 256 * u.pn + 128 * bj + 32 * wc + 8 * fq;
#pragma unroll
            for (int ai = 0; ai < 2; ++ai)
#pragma unroll
                for (int m = 0; m < 4; ++m) { const size_t row = (size_t)u.tile * 256 + 128 * ai + 64 * wr + 16 * m + fr;
                    const f32x4 a = acc[ai][bj][m][0], b = acc[ai][bj][m][1];
                    u32x4 q; q.x = pk2(a.x, a.y); q.y = pk2(a.z, a.w); q.z = pk2(b.x, b.y); q.w = pk2(b.z, b.w);
                    *(u32x4*)(YB + row * DM + c) = q; } }
    }
};

__device__ __forceinline__ void naive_g1(Frame& F, const Args& args, int l) {
    const int odd = l & 1, p = l >> 1; const int N = odd ? OD_N : EV_N;
    const float* W = (odd ? args.in[I_ODWIN] : args.in[I_EVWIN]) + (size_t)p * DM * N;
    LAS float* sh = (LAS float*)F.lds;
    const float* lb = (const float*)(F.ws + WS_LB) + l * DM;
    const float* ropec = (const float*)(F.ws + WS_ROPEC); const float* ropes = (const float*)(F.ws + WS_ROPES);
    for (int rg = fbid(); rg < MTOK / 8; rg += F.G) {
        __syncthreads();
        if (NAIVE_G1 == 2) {
            const int row = rg * 8 + F.wave; const int bb = row / SU, pp = row % SU; const int mrow = pp < NCTX ? 4 : bb;
            const float* xr = (const float*)(F.ws + WS_XRES) + (size_t)row * DM; float ssq = 0.f;
            for (int k = flane(); k < DM; k += 64) ssq += xr[k] * xr[k];
            ssq = wave_sum(ssq, flane()); const float rs = 1.0f / sqrtf(ssq / (float)DM + EPS);
            const float* modr = (const float*)(F.ws + WS_MOD) + ((size_t)l * 5 + mrow) * 6144;
            for (int k = flane(); k < DM; k += 64) sh[F.wave * DM + k] = xr[k] * rs * args.in[I_NORMW][(size_t)(l * 2) * DM + k] * (1.0f + modr[DM + k]) + modr[k];
        } else
        for (int i = ftid(); i < 8 * DM; i += 512) sh[i] = bf2f(((const bf16_t*)(F.ws + WS_HB))[(size_t)rg * 8 * DM + i]);
        __syncthreads();
        for (int pi = ftid(); pi < N / 2; pi += 512) {
            const int hh = pi >> 6, rem = pi & 63, half = rem >> 5, d = rem & 31; const int cA = 128 * hh + 64 * half + d, cB = cA + 32;
            float a[8], bq[8];
#pragma unroll
            for (int r = 0; r < 8; ++r) { a[r] = 0.f; bq[r] = 0.f; }
            for (int k = 0; k < DM; ++k) { const float wa = W[(size_t)k * N + cA], wb = W[(size_t)k * N + cB];
#pragma unroll
                for (int r = 0; r < 8; ++r) { const float hv = sh[r * DM + k]; a[r] += hv * wa; bq[r] += hv * wb; } }
            const int hcol = 128 * hh;
#pragma unroll
            for (int r = 0; r < 8; ++r) {
                const int row = rg * 8 + r; const int pp = row % SU; const bool isctx = pp < NCTX; const int t = pp - NCTX;
                float x1 = a[r], x2 = bq[r];
                if (!odd) {
                    const bool rope = !isctx && (hcol < 1024 || (hcol >= 2048 && hcol < 2816));
                    if (hcol >= 512 && hcol < 1024) { x1 *= 0.08838834764831845f; x2 *= 0.08838834764831845f; }
                    if (rope) { const int pos = half ? (t & 63) : (t >> 6); float cc = ropec[pos * 32 + d], sn = ropes[pos * 32 + d];
                        if (NAIVE_G1 == 3) { const double ang = (double)((float)pos * powf(10000.0f, -(float)d / 32.0f)); cc = (float)cos(ang); sn = (float)sin(ang); }
                        const float o1 = x1 * cc - x2 * sn, o2 = x2 * cc + x1 * sn; x1 = o1; x2 = o2; }
                    bf16_t* dst = (bf16_t*)(F.ws + WS_PE) + (size_t)row * EV_N; dst[cA] = (bf16_t)f2bf(x1); dst[cB] = (bf16_t)f2bf(x2);
                } else {
                    const int seg = hcol >> 10, c0 = cA & 1023;
                    if (seg == 1 || seg == 2) { float* dst = (float*)(F.ws + (seg == 1 ? WS_FF : WS_FB)) + (size_t)row * DM;
                        float lba = lb[c0], lbb = lb[c0 + 32];
                        if (NAIVE_G1 == 3) { const float* lg = args.in[I_LBLOG]; float ea[4], eb[4], sa = 0.f, sb2 = 0.f; for (int q = 0; q < 4; ++q) { ea[q] = expf(lg[q * DM + c0]); eb[q] = expf(lg[q * DM + c0 + 32]); sa += ea[q]; sb2 += eb[q]; }
                            lba = 0.f; lbb = 0.f; for (int q = 1; q <= l; ++q) { lba += ea[q] / sa; lbb += eb[q] / sb2; } }
                        dst[c0] = lba + (1.f - lba) / (1.f + expf(-x1)); dst[c0 + 32] = lbb + (1.f - lbb) / (1.f + expf(-x2)); }
                    else { bf16_t* dst = (bf16_t*)(F.ws + (seg == 0 ? WS_PQ : (seg == 3 ? WS_PI : WS_PG))) + (size_t)row * DM; dst[c0] = (bf16_t)f2bf(x1); dst[c0 + 32] = (bf16_t)f2bf(x2); }
                }
            }
        }
    }
    __syncthreads();
}

__device__ __forceinline__ void naive_g2(Frame& F, const Args& args, int l) {
    const int odd = l & 1, p = l >> 1;
    const float* W = (odd ? args.in[I_ODWOUT] : args.in[I_EVWOUT]) + (size_t)p * DM * DM;
    LAS float* sh = (LAS float*)F.lds;
    const float* modl = (const float*)(F.ws + WS_MOD) + (size_t)l * 5 * 6144;
    float* xres = (float*)(F.ws + WS_XRES);
    for (int rg = fbid(); rg < MTOK / 8; rg += F.G) {
        __syncthreads();
        for (int i = ftid(); i < 8 * DM; i += 512) sh[i] = bf2f(((const bf16_t*)(F.ws + WS_YB16))[(size_t)rg * 8 * DM + i]);
        __syncthreads();
        for (int col = ftid(); col < DM; col += 512) {
            float a[8];
#pragma unroll
            for (int r = 0; r < 8; ++r) a[r] = 0.f;
            for (int k = 0; k < DM; ++k) { const float wa = W[(size_t)k * DM + col];
#pragma unroll
                for (int r = 0; r < 8; ++r) a[r] += sh[r * DM + k] * wa; }
#pragma unroll
            for (int r = 0; r < 8; ++r) { const int row = rg * 8 + r; const int b = row / SU, pp = row % SU; const int mrow = pp < NCTX ? 4 : b;
                xres[(size_t)row * DM + col] += modl[(size_t)mrow * 6144 + 2 * DM + col] * a[r]; }
        }
    }
    __syncthreads();
}
__device__ __forceinline__ void naive_mod(Frame& F, const Args& args) {
    float* mod = (float*)(F.ws + WS_MOD);
    for (int i = fbid() * 512 + ftid(); i < DEPTH * 5 * 6144; i += F.G * 512) {
        const int col = i % 6144, r = (i / 6144) % 5, l = i / (5 * 6144);
        const float* cv = r < 4 ? args.in[I_C] + r * DM : args.in[I_CCTX];
        const float* w = args.in[I_ADAW] + (size_t)l * DM * 6144 + col;
        float a = 0.f;
        for (int k = 0; k < DM; ++k) { const float v = cv[k]; a += (v / (1.0f + expf(-v))) * w[(size_t)k * 6144]; }
        mod[i] = a + args.in[I_ADAB][l * 6144 + col];
    }
}

__device__ __forceinline__ void naive_moe(Frame& F, const Args& args, int l) {
    LAS float* sh = (LAS float*)F.lds;
    LAS float* sa = sh + 8 * DM;
    LAS int* gstart = (LAS int*)(sa + 8 * FF);
    LAS int* stok = gstart + 40;
    const unsigned* cnt = F.ctl + CW_CNT + l * NEXP;
    const unsigned* list = (const unsigned*)(F.ws + WS_LIST);
    __syncthreads();
    if (ftid() == 0) { int acc = 0; for (int e = 0; e < NEXP; ++e) { gstart[e] = acc; acc += ((int)cnt[e] + 7) / 8; } gstart[NEXP] = acc; }
    __syncthreads();
    const int total = gstart[NEXP];
    float* YN = (float*)(F.ws + WS_YN);
    for (int gi = fbid(); gi < total; gi += F.G) {
        int e = 0; for (int k = 1; k < NEXP; ++k) e += (gstart[k] <= gi) ? 1 : 0;
        const int g = gi - gstart[e]; const int ce = (int)cnt[e];
        __syncthreads();
        if (ftid() < 8) { const int idx = 8 * g + ftid(); stok[ftid()] = idx < ce ? (int)list[(size_t)e * LIST_CAP + idx] : -1; }
        __syncthreads();
        for (int i = ftid(); i < 8 * DM; i += 512) { const int r = i >> 10, k = i & 1023; const int tk = stok[r]; sh[i] = tk >= 0 ? bf2f(((const bf16_t*)(F.ws + WS_HB))[(size_t)tk * DM + k]) : 0.f; }
        __syncthreads();
        const float* w1 = args.in[I_W1] + ((size_t)l * NEXP + e) * DM * FF; const float* w3 = args.in[I_W3] + ((size_t)l * NEXP + e) * DM * FF; const float* w2 = args.in[I_W2] + ((size_t)l * NEXP + e) * FF * DM;
        { const int col = ftid(); float a[8], b[8];
#pragma unroll
            for (int r = 0; r < 8; ++r) { a[r] = 0.f; b[r] = 0.f; }
            for (int k = 0; k < DM; ++k) { const float wa = w1[(size_t)k * FF + col], wb = w3[(size_t)k * FF + col];
#pragma unroll
                for (int r = 0; r < 8; ++r) { const float hv = sh[r * DM + k]; a[r] += hv * wa; b[r] += hv * wb; } }
#pragma unroll
            for (int r = 0; r < 8; ++r) sa[r * FF + col] = (a[r] / (1.0f + expf(-a[r]))) * b[r]; }
        __syncthreads();
        for (int col = ftid(); col < DM; col += 512) { float y[8];
#pragma unroll
            for (int r = 0; r < 8; ++r) y[r] = 0.f;
            for (int k = 0; k < FF; ++k) { const float wv = w2[(size_t)k * DM + col];
#pragma unroll
                for (int r = 0; r < 8; ++r) y[r] += sa[r * FF + k] * wv; }
#pragma unroll
            for (int r = 0; r < 8; ++r) { const int tk = stok[r]; if (tk >= 0) { const unsigned e0 = ((const unsigned*)(F.ws + WS_TOKINFO))[(size_t)tk * 8]; const int kk = (e0 == (unsigned)e) ? 0 : 1;
                YN[((size_t)tk * 2 + kk) * DM + col] = y[r]; } } }
    }
    __syncthreads();
}

constexpr int TLD = 136;
constexpr int TILE_BYTES = 128 * TLD * 2;
template <int NT, int KS>
__device__ __forceinline__ void wave_mma(f32x4 (&acc)[NT], const bf16x8 (&afr)[KS], const LAS bf16_t* Bt, int ldb, int lane) {
    const LAS bf16_t* bp = Bt + (lane & 15) * ldb + 8 * (lane >> 4);
#pragma unroll
    for (int nt = 0; nt < NT; ++nt)
#pragma unroll
        for (int ks = 0; ks < KS; ++ks) { const bf16x8 b = *(const LAS bf16x8*)(bp + nt * 16 * ldb + 32 * ks); acc[nt] = __builtin_amdgcn_mfma_f32_16x16x32_bf16(afr[ks], b, acc[nt], 0, 0, 0);
            if ((ks & 3) == 3 && (nt & 1) == 1) asm volatile("" ::: "memory"); }
}
template <int NT, int KS>
__device__ __forceinline__ void wave_mma2(f32x4 (&acc0)[NT], f32x4 (&acc1)[NT], const bf16x8 (&a0)[KS], const bf16x8 (&a1)[KS], const LAS bf16_t* Bt, int ldb, int lane) {
    const LAS bf16_t* bp = Bt + (lane & 15) * ldb + 8 * (lane >> 4);
#pragma unroll
    for (int nt = 0; nt < NT; ++nt) {
        bf16x8 b[KS];
#pragma unroll
        for (int ks = 0; ks < KS; ++ks) b[ks] = *(const LAS bf16x8*)(bp + nt * 16 * ldb + 32 * ks);
#pragma unroll
        for (int ks = 0; ks < KS; ++ks) { acc0[nt] = __builtin_amdgcn_mfma_f32_16x16x32_bf16(a0[ks], b[ks], acc0[nt], 0, 0, 0); acc1[nt] = __builtin_amdgcn_mfma_f32_16x16x32_bf16(a1[ks], b[ks], acc1[nt], 0, 0, 0); }
        if ((nt & 1) == 1) asm volatile("" ::: "memory");
    }
}
__device__ __forceinline__ void stage_rowmajor(LAS bf16_t* T, const bf16_t* src, size_t ld, int tid) {
#pragma unroll
    for (int i = 0; i < 4; ++i) { const int q = tid + 512 * i, r = q >> 4, cc = q & 15; const u32x4 v = *(const u32x4*)(src + (size_t)r * ld + 8 * cc); *(LAS u32x4*)(T + r * TLD + 8 * cc) = v; }
}
__device__ __forceinline__ void stage_transposed(LAS bf16_t* T, const bf16_t* src, size_t ld, int tid, bool scaled, float sa, float sb) {
#pragma unroll
    for (int i = 0; i < 2; ++i) { const int q = tid + 512 * i, rp = q & 63, cc = q >> 6;
        const u32x4 v0 = *(const u32x4*)(src + (size_t)(2 * rp) * ld + 8 * cc), v1 = *(const u32x4*)(src + (size_t)(2 * rp + 1) * ld + 8 * cc);
        const unsigned w0[4] = {v0.x, v0.y, v0.z, v0.w}, w1[4] = {v1.x, v1.y, v1.z, v1.w};
        LAS unsigned* tp = (LAS unsigned*)(T + (8 * cc) * TLD + 2 * rp);
        if (scaled) { const float s0 = exp2f(sa * (float)(2 * rp) + sb), s1 = exp2f(sa * (float)(2 * rp + 1) + sb);
#pragma unroll
            for (int k = 0; k < 4; ++k) { tp[(2 * k) * (TLD / 2)] = pk2(bflo(w0[k]) * s0, bflo(w1[k]) * s1); tp[(2 * k + 1) * (TLD / 2)] = pk2(bfhi(w0[k]) * s0, bfhi(w1[k]) * s1); }
        } else {
#pragma unroll
            for (int k = 0; k < 4; ++k) { tp[(2 * k) * (TLD / 2)] = (w0[k] & 0xffffu) | (w1[k] << 16); tp[(2 * k + 1) * (TLD / 2)] = (w0[k] >> 16) | (w1[k] & 0xffff0000u); }
        }
    }
}
__device__ __forceinline__ void stage_f32_rowmajor(LAS bf16_t* T, const float* src, int tid) {
#pragma unroll
    for (int i = 0; i < 8; ++i) { const int q = tid + 512 * i, r = q >> 5, cc = q & 31; const f32x4 v = *(const f32x4*)(src + (size_t)r * 128 + 4 * cc);
        u32x2 o; o.x = pk2(v.x, v.y); o.y = pk2(v.z, v.w); *(LAS u32x2*)(T + r * TLD + 4 * cc) = o; }
}
__device__ __forceinline__ float log2_gamma_f(const Frame& F, int p, int dir, int h) { return -expf(((const float*)(F.ws + WS_SP) + SP_DECAY)[(p * 2 + dir) * 4 + h]) * 1.4426950408889634f; }
#define log2_gamma(args, p, dir, h) log2_gamma_f(F, p, dir, h)

__device__ __forceinline__ void ret_state_item(Frame& F, const Args& args, int p, int item) {
    const int c = item % NCHUNK, h = (item / NCHUNK) & 3, b = item / (NCHUNK * 4);
    int tid = ftid(); asm volatile("" : "+v"(tid)); const int lane = tid & 63, w = F.wave;
    LAS bf16_t* T0 = (LAS bf16_t*)F.lds; LAS bf16_t* T1 = (LAS bf16_t*)(F.lds + TILE_BYTES); LAS bf16_t* T2 = (LAS bf16_t*)(F.lds + 2 * TILE_BYTES);
    const bf16_t* pe = (const bf16_t*)(F.ws + WS_PE) + ((size_t)b * SU + 128 * c) * EV_N;
    const float lgf = log2_gamma(args, p, 0, h), lgb = log2_gamma(args, p, 1, h);
    __syncthreads();
    stage_transposed(T0, pe + 512 + h * 128, EV_N, tid, false, 0.f, 0.f);
    stage_transposed(T1, pe + 1024 + h * 128, EV_N, tid, true, -lgf, 127.f * lgf);
    stage_transposed(T2, pe + 1024 + h * 128, EV_N, tid, true, lgb, 0.f);
    __syncthreads();
    bf16_t* st = (bf16_t*)(F.ws + WS_ST);
    {
        bf16x8 af[4], ab[4];
#pragma unroll
        for (int ks = 0; ks < 4; ++ks) { af[ks] = *(const LAS bf16x8*)(T1 + (16 * w + (lane & 15)) * TLD + 32 * ks + 8 * (lane >> 4)); ab[ks] = *(const LAS bf16x8*)(T2 + (16 * w + (lane & 15)) * TLD + 32 * ks + 8 * (lane >> 4)); }
        f32x4 accf[8], accb[8];
#pragma unroll
        for (int nt = 0; nt < 8; ++nt) { accf[nt] = (f32x4){0.f, 0.f, 0.f, 0.f}; accb[nt] = (f32x4){0.f, 0.f, 0.f, 0.f}; }
        wave_mma2<8, 4>(accf, accb, af, ab, T0, TLD, lane);
        bf16_t* dstf = st + ((((size_t)(b * 4 + h) * 2 + 0) * NCHUNK + c) * 128) * 128; bf16_t* dstb = st + ((((size_t)(b * 4 + h) * 2 + 1) * NCHUNK + c) * 128) * 128;
#pragma unroll
        for (int nt = 0; nt < 8; ++nt)
#pragma unroll
            for (int j = 0; j < 4; ++j) { const size_t o_ = (size_t)(16 * w + 4 * (lane >> 4) + j) * 128 + 16 * nt + (lane & 15); dstf[o_] = (bf16_t)f2bf(accf[nt][j]); dstb[o_] = (bf16_t)f2bf(accb[nt][j]); }
    }
}
__device__ __forceinline__ void ret_scan_phase(Frame& F, const Args& args, int p) {
    u32x2* st = (u32x2*)(F.ws + WS_ST);
    for (int i = fbid() * 512 + ftid(); i < 32 * 4096; i += F.G * 512) {
        const int bhd = i >> 12, el = i & 4095; const int dir = bhd & 1, h = (bhd >> 1) & 3;
        const float g128 = exp2f(128.f * log2_gamma(args, p, dir, h));
        u32x2* base = st + (size_t)bhd * NCHUNK * 4096 + el;
        f32x4 s = (f32x4){0.f, 0.f, 0.f, 0.f};
        for (int k = 0; k < NCHUNK; ++k) {
            const int c = dir == 0 ? k : (k < 2 ? 1 - k : NCHUNK + 1 - k);
            const u32x2 uw = base[(size_t)c * 4096]; u32x2 sw; sw.x = pk2(s.x, s.y); sw.y = pk2(s.z, s.w); base[(size_t)c * 4096] = sw;
            const f32x4 u = (f32x4){bflo(uw.x), bfhi(uw.x), bflo(uw.y), bfhi(uw.y)}; s = s * g128 + u;
        }
    }
}
__device__ __forceinline__ bf16x8 scale_frag(const bf16x8 a, float sc) {
    bf16x8 r;
#pragma unroll
    for (int k = 0; k < 8; ++k) r[k] = (short)f2bf(bf2f((unsigned)(unsigned short)a[k]) * sc);
    return r;
}
__device__ __forceinline__ void ret_out_item(Frame& F, const Args& args, int p, int item) {
    const int c = item % NCHUNK, h = (item / NCHUNK) & 3, b = item / (NCHUNK * 4);
    int tid = ftid(); asm volatile("" : "+v"(tid)); const int lane = tid & 63, w = F.wave, quad = lane >> 4, l15 = lane & 15;
    LAS bf16_t* T0 = (LAS bf16_t*)F.lds; LAS bf16_t* T1 = (LAS bf16_t*)(F.lds + TILE_BYTES); LAS bf16_t* T2 = (LAS bf16_t*)(F.lds + 2 * TILE_BYTES);
    const size_t row0 = (size_t)b * SU + 128 * c;
    const bf16_t* pe = (const bf16_t*)(F.ws + WS_PE) + row0 * EV_N;
    const float lgf = log2_gamma(args, p, 0, h), lgb = log2_gamma(args, p, 1, h);
    const bf16_t* stf = (const bf16_t*)(F.ws + WS_ST) + ((((size_t)(b * 4 + h) * 2 + 0) * NCHUNK + c) * 128) * 128;
    const bf16_t* stb = (const bf16_t*)(F.ws + WS_ST) + ((((size_t)(b * 4 + h) * 2 + 1) * NCHUNK + c) * 128) * 128;
    bf16x8 qf[4];
#pragma unroll
    for (int ks = 0; ks < 4; ++ks) qf[ks] = *(const bf16x8*)(pe + (size_t)(16 * w + l15) * EV_N + h * 128 + 32 * ks + 8 * quad);
    __syncthreads();
    stage_rowmajor(T0, pe + 512 + h * 128, EV_N, tid);
    stage_transposed(T1, pe + 1024 + h * 128, EV_N, tid, false, 0.f, 0.f);
    stage_rowmajor(T2, stf, 128, tid);
    __syncthreads();
    f32x4 ao[8];
#pragma unroll
    for (int nt = 0; nt < 8; ++nt) ao[nt] = (f32x4){0.f, 0.f, 0.f, 0.f};
    {
        const float cf = exp2f(lgf * (float)(16 * w + l15 + 1));
        bf16x8 qs[4];
#pragma unroll
        for (int ks = 0; ks < 4; ++ks) qs[ks] = scale_frag(qf[ks], cf);
        wave_mma<8, 4>(ao, qs, T2, TLD, lane);
    }
    {
        f32x4 aw[8];
#pragma unroll
        for (int nt = 0; nt < 8; ++nt) aw[nt] = (f32x4){0.f, 0.f, 0.f, 0.f};
        wave_mma<8, 4>(aw, qf, T0, TLD, lane);
        __syncthreads();
#pragma unroll
        for (int nt = 0; nt < 8; ++nt)
#pragma unroll
            for (int j = 0; j < 4; ++j) { const int i = 16 * w + 4 * quad + j, jj = 16 * nt + l15; const int d = i - jj;
                const float dec = d > 0 ? exp2f(lgf * (float)d) : (d < 0 ? exp2f(lgb * (float)(-d)) : 2.0f);
                T0[i * TLD + jj] = (bf16_t)f2bf(aw[nt][j] * dec); }
    }
    stage_rowmajor(T2, stb, 128, tid);
    __syncthreads();
    {
        bf16x8 pf[4];
#pragma unroll
        for (int ks = 0; ks < 4; ++ks) pf[ks] = *(const LAS bf16x8*)(T0 + (16 * w + l15) * TLD + 32 * ks + 8 * quad);
        wave_mma<8, 4>(ao, pf, T1, TLD, lane);
        const float cb = exp2f(lgb * (float)(128 - (16 * w + l15)));
#pragma unroll
        for (int ks = 0; ks < 4; ++ks) pf[ks] = scale_frag(qf[ks], cb);
        wave_mma<8, 4>(ao, pf, T2, TLD, lane);
    }
    bf16_t* yb = (bf16_t*)(F.ws + WS_YB16);
#pragma unroll
    for (int j = 0; j < 4; ++j) { const int i = 16 * w + 4 * quad + j;
        float ss = 0.f;
#pragma unroll
        for (int nt = 0; nt < 8; ++nt) ss += ao[nt][j] * ao[nt][j];
        ss += shx(ss, 1, lane); ss += shx(ss, 2, lane); ss += shx(ss, 4, lane); ss += shx(ss, 8, lane);
        const float rstd = 1.0f / sqrtf(ss * (1.0f / 128.f) + EPS);
        const bf16_t* gp = pe + (size_t)i * EV_N + 1536 + h * 128;
#pragma unroll
        for (int nt = 0; nt < 8; ++nt) { const float gt = bf2f(gp[16 * nt + l15]); yb[(row0 + i) * DM + h * 128 + 16 * nt + l15] = ABL_RET0 ? (bf16_t)0 : (bf16_t)f2bf(siluf(gt) * ao[nt][j] * rstd); }
    }
}
__device__ __forceinline__ void ret_direct_item(Frame& F, const Args& args, int p, int item) {
    const int c = item % NCHUNK, h = (item / NCHUNK) & 3, b = item / (NCHUNK * 4);
    int tid = ftid(); asm volatile("" : "+v"(tid)); const int lane = tid & 63, w = F.wave, quad = lane >> 4, l15 = lane & 15;
    LAS bf16_t* T0 = (LAS bf16_t*)F.lds; LAS bf16_t* T1 = (LAS bf16_t*)(F.lds + TILE_BYTES); LAS bf16_t* T2 = (LAS bf16_t*)(F.lds + 2 * TILE_BYTES);
    const size_t row0 = (size_t)b * SU + 128 * c;
    const bf16_t* peb = (const bf16_t*)(F.ws + WS_PE) + (size_t)b * SU * EV_N;
    const bf16_t* pe = peb + (size_t)128 * c * EV_N;
    const float lgf = log2_gamma(args, p, 0, h), lgb = log2_gamma(args, p, 1, h);
    bf16x8 qf[4];
#pragma unroll
    for (int ks = 0; ks < 4; ++ks) qf[ks] = *(const bf16x8*)(pe + (size_t)(16 * w + l15) * EV_N + h * 128 + 32 * ks + 8 * quad);
    f32x4 ao[8];
#pragma unroll
    for (int nt = 0; nt < 8; ++nt) ao[nt] = (f32x4){0.f, 0.f, 0.f, 0.f};
    for (int c2 = 0; c2 < NCHUNK; ++c2) {
        __syncthreads();
        stage_rowmajor(T0, peb + (size_t)128 * c2 * EV_N + 512 + h * 128, EV_N, tid);
        stage_transposed(T1, peb + (size_t)128 * c2 * EV_N + 1024 + h * 128, EV_N, tid, false, 0.f, 0.f);
        __syncthreads();
        f32x4 aw[8];
#pragma unroll
        for (int nt = 0; nt < 8; ++nt) aw[nt] = (f32x4){0.f, 0.f, 0.f, 0.f};
        wave_mma<8, 4>(aw, qf, T0, TLD, lane);
#pragma unroll
        for (int nt = 0; nt < 8; ++nt)
#pragma unroll
            for (int j = 0; j < 4; ++j) { const int i = 16 * w + 4 * quad + j, jj = 16 * nt + l15;
                const int px = 128 * c + i, py = 128 * c2 + jj;
                const int ubx = px < NCTX ? NCTX - 1 - px : SU + NCTX - 1 - px, uby = py < NCTX ? NCTX - 1 - py : SU + NCTX - 1 - py;
                float dec = 0.f;
                if (py <= px && !(px >= NCTX && false)) dec += exp2f(lgf * (float)(px - py));
                if (uby <= ubx) dec += exp2f(lgb * (float)(ubx - uby));
                if (px < NCTX && py >= NCTX) dec = 0.f;
                T2[i * TLD + jj] = (bf16_t)f2bf(aw[nt][j] * dec); }
        LDS_WAIT(); asm volatile("" ::: "memory");
        bf16x8 pf[4];
#pragma unroll
        for (int ks = 0; ks < 4; ++ks) pf[ks] = *(const LAS bf16x8*)(T2 + (16 * w + l15) * TLD + 32 * ks + 8 * quad);
        wave_mma<8, 4>(ao, pf, T1, TLD, lane);
    }
    bf16_t* yb = (bf16_t*)(F.ws + WS_YB16);
#pragma unroll
    for (int j = 0; j < 4; ++j) { const int i = 16 * w + 4 * quad + j;
        float ss = 0.f;
#pragma unroll
        for (int nt = 0; nt < 8; ++nt) ss += ao[nt][j] * ao[nt][j];
        ss += shx(ss, 1, lane); ss += shx(ss, 2, lane); ss += shx(ss, 4, lane); ss += shx(ss, 8, lane);
        const float rstd = 1.0f / sqrtf(ss * (1.0f / 128.f) + EPS);
        const bf16_t* gp = pe + (size_t)i * EV_N + 1536 + h * 128;
#pragma unroll
        for (int nt = 0; nt < 8; ++nt) { const float gt = bf2f(gp[16 * nt + l15]); yb[(row0 + i) * DM + h * 128 + 16 * nt + l15] = (bf16_t)f2bf(siluf(gt) * ao[nt][j] * rstd); }
    }
}
__device__ __forceinline__ void att_item(Frame& F, const Args& args, int p, int item) {
    const int qb = item % NCHUNK, hk = (item / NCHUNK) & 1, b = item / (NCHUNK * 2);
    int tid = ftid(); asm volatile("" : "+v"(tid)); const int lane = tid & 63, w = F.wave, quad = lane >> 4, l15 = lane & 15;
    const int g = w >> 2, hq = 2 * hk + g, qr0 = 32 * (w & 3);
    LAS bf16_t* T0 = (LAS bf16_t*)F.lds; LAS bf16_t* T1 = (LAS bf16_t*)(F.lds + TILE_BYTES);
    LAS bf16_t* Pw = (LAS bf16_t*)(F.lds + 2 * TILE_BYTES) + w * 32 * TLD;
    const bf16_t* peb = (const bf16_t*)(F.ws + WS_PE) + (size_t)b * SU * EV_N;
    const size_t qrow0 = (size_t)128 * qb + qr0;
    bf16x8 qf[2][4];
#pragma unroll
    for (int rt = 0; rt < 2; ++rt)
#pragma unroll
        for (int ks = 0; ks < 4; ++ks) qf[rt][ks] = *(const bf16x8*)(peb + (qrow0 + 16 * rt + l15) * EV_N + 2048 + hq * 128 + 32 * ks + 8 * quad);
    const float sink = ((const float*)(F.ws + WS_SP) + SP_SINK)[p * 4 + hq] * 1.4426950408889634f;
    const float scale = 0.08838834764831845f * 1.4426950408889634f;
    float mrow[2][4], lrow[2][4]; f32x4 ao[2][8];
#pragma unroll
    for (int rt = 0; rt < 2; ++rt) {
#pragma unroll
        for (int j = 0; j < 4; ++j) { mrow[rt][j] = sink; lrow[rt][j] = 1.0f; }
#pragma unroll
        for (int nt = 0; nt < 8; ++nt) ao[rt][nt] = (f32x4){0.f, 0.f, 0.f, 0.f};
    }
    const int ntile = (qb < 2) ? 2 : 5;
    for (int ti = 0; ti < ntile; ++ti) {
        int kt, mode = 0;
        if (ti < 2) kt = ti; else { kt = qb + (ti - 3); mode = (ti == 2) ? 1 : (ti == 4 ? 2 : 0); }
        if (ti >= 2 && (kt < 2 || kt >= NCHUNK)) continue;
        __syncthreads();
        stage_rowmajor(T0, peb + (size_t)128 * kt * EV_N + 2560 + hk * 128, EV_N, tid);
        stage_transposed(T1, peb + (size_t)128 * kt * EV_N + 2816 + hk * 128, EV_N, tid, false, 0.f, 0.f);
        __syncthreads();
        f32x4 s2[2][8];
#pragma unroll
        for (int nt = 0; nt < 8; ++nt) { s2[0][nt] = (f32x4){0.f, 0.f, 0.f, 0.f}; s2[1][nt] = (f32x4){0.f, 0.f, 0.f, 0.f}; }
        wave_mma2<8, 4>(s2[0], s2[1], qf[0], qf[1], T0, TLD, lane);
#pragma unroll
        for (int rt = 0; rt < 2; ++rt) {
            f32x4 (&s)[8] = s2[rt];
#pragma unroll
            for (int j = 0; j < 4; ++j) {
                const int qq = qr0 + 16 * rt + 4 * quad + j;
                float mx = -3.0e38f;
                if (mode == 0) {
#pragma unroll
                    for (int nt = 0; nt < 8; ++nt) { const float v = s[nt][j] * scale; s[nt][j] = v; mx = fmaxf(mx, v); }
                } else {
#pragma unroll
                    for (int nt = 0; nt < 8; ++nt) { const int kk = 16 * nt + l15; float v = s[nt][j] * scale;
                        const bool valid = (mode == 1 ? (kk >= qq) : (kk <= qq));
                        v = valid ? v : -3.0e38f; s[nt][j] = v; mx = fmaxf(mx, v); }
                }
                mx = fmaxf(mx, shx(mx, 1, lane)); mx = fmaxf(mx, shx(mx, 2, lane)); mx = fmaxf(mx, shx(mx, 4, lane)); mx = fmaxf(mx, shx(mx, 8, lane));
                const float mn = fmaxf(mrow[rt][j], mx); const float alpha = __builtin_amdgcn_exp2f(mrow[rt][j] - mn);
                float rs = 0.f;
#pragma unroll
                for (int nt = 0; nt < 8; ++nt) { const float pv = __builtin_amdgcn_exp2f(s[nt][j] - mn); rs += pv;     Pw[(16 * rt + 4 * quad + j) * TLD + 16 * nt + l15] = (bf16_t)f2bf(pv); }
                rs += shx(rs, 1, lane); rs += shx(rs, 2, lane); rs += shx(rs, 4, lane); rs += shx(rs, 8, lane);
                lrow[rt][j] = lrow[rt][j] * alpha + rs; mrow[rt][j] = mn;
#pragma unroll
                for (int nt = 0; nt < 8; ++nt) ao[rt][nt][j] *= alpha;
            }
        }
        LDS_WAIT(); asm volatile("" ::: "memory");
        {
            bf16x8 pf0[4], pf1[4];
#pragma unroll
            for (int ks = 0; ks < 4; ++ks) { pf0[ks] = *(const LAS bf16x8*)(Pw + (l15) * TLD + 32 * ks + 8 * quad); pf1[ks] = *(const LAS bf16x8*)(Pw + (16 + l15) * TLD + 32 * ks + 8 * quad); }
            wave_mma2<8, 4>(ao[0], ao[1], pf0, pf1, T1, TLD, lane);
        }
    }
    bf16_t* yb = (bf16_t*)(F.ws + WS_YB16) + ((size_t)b * SU + qrow0) * DM + 512 + hq * 128;
#pragma unroll
    for (int rt = 0; rt < 2; ++rt)
#pragma unroll
        for (int j = 0; j < 4; ++j) { const float inv = 1.0f / lrow[rt][j];
#pragma unroll
            for (int nt = 0; nt < 8; ++nt) yb[(size_t)(16 * rt + 4 * quad + j) * DM + 16 * nt + l15] = ABL_ATT0 ? (bf16_t)0 : (bf16_t)f2bf(ao[rt][nt][j] * inv); }
}
__device__ __forceinline__ void naive_att(Frame& F, const Args& args, int p) {
    const int gw = F.vcu * NWAVES + F.wave, NGW = F.G * NWAVES, lane = flane();
    LAS float* sq = (LAS float*)F.lds + F.wave * 1024;
    LAS float* sc = sq + 128;
    const bf16_t* pe = (const bf16_t*)(F.ws + WS_PE);
    for (int task = gw; task < MTOK * 4; task += NGW) {
        const int row = task >> 2, hq = task & 3, hk = hq >> 1; const int b = row / SU, pq = row % SU;
        const bf16_t* peb = pe + (size_t)b * SU * EV_N;
        sq[lane] = bf2f(peb[(size_t)pq * EV_N + 2048 + hq * 128 + lane]) * 0.08838834764831845f; sq[lane + 64] = bf2f(peb[(size_t)pq * EV_N + 2048 + hq * 128 + lane + 64]) * 0.08838834764831845f;
        LDS_WAIT(); asm volatile("" ::: "memory");
        int lo = 0, nloc = 0;
        if (pq >= NCTX) { const int t = pq - NCTX; lo = t - 128 < 0 ? 0 : t - 128; const int hi = t + 128 > LSEQ - 1 ? LSEQ - 1 : t + 128; nloc = hi - lo + 1; }
        const int nk = NCTX + nloc;
        const float sink = args.in[I_SINK][p * 4 + hq];
        float mx = sink;
        for (int ki = lane; ki < nk; ki += 64) { const int kp = ki < NCTX ? ki : NCTX + lo + (ki - NCTX);
            const bf16_t* kr = peb + (size_t)kp * EV_N + 2560 + hk * 128; float d = 0.f;
            for (int x = 0; x < 128; ++x) d += sq[x] * bf2f(kr[x]);
            sc[ki] = d; mx = fmaxf(mx, d); }
#pragma unroll
        for (int o = 1; o < 64; o <<= 1) mx = fmaxf(mx, shx(mx, o, lane));
        float sum = 0.f;
        for (int ki = lane; ki < nk; ki += 64) { const float e = expf(sc[ki] - mx); sc[ki] = e; sum += e; }
        sum = wave_sum(sum, lane) + expf(sink - mx);
        LDS_WAIT(); asm volatile("" ::: "memory");
        float o0 = 0.f, o1 = 0.f;
        for (int ki = 0; ki < nk; ++ki) { const int kp = ki < NCTX ? ki : NCTX + lo + (ki - NCTX); const bf16_t* vr = peb + (size_t)kp * EV_N + 2816 + hk * 128; const float pv = sc[ki];
            o0 += pv * bf2f(vr[lane]); o1 += pv * bf2f(vr[lane + 64]); }
        bf16_t* yb = (bf16_t*)(F.ws + WS_YB16) + (size_t)row * DM + 512 + hq * 128;
        yb[lane] = (bf16_t)f2bf(o0 / sum); yb[lane + 64] = (bf16_t)f2bf(o1 / sum);
        LDS_WAIT(); asm volatile("" ::: "memory");
    }
}
__device__ __forceinline__ void hg_scan_item_plain(Frame& F, int item) {
    const int es = item & 3, dir = (item >> 2) & 1, h = (item >> 3) & 7, b = item >> 6;
    const int tid = ftid(), e = tid & 31, dg = tid >> 5;
    LAS float* sP = (LAS float*)F.lds;
    LAS float* sIn = sP + 32 * 16 * 32;
    constexpr int INB = 32 * 128 * 2 + 32 * 32;
    const float* fsrc = (const float*)(F.ws + (dir ? WS_FB : WS_FF));
    const bf16_t* qsrc = (const bf16_t*)(F.ws + WS_PQ); const bf16_t* vsrc = (const bf16_t*)(F.ws + WS_PI);
    float* osrc = (float*)(F.ws + (dir ? WS_OB : WS_OF));
    float S[8];
#pragma unroll
    for (int k = 0; k < 8; ++k) S[k] = 0.f;
    const size_t rb = (size_t)b * SU;
    f32x4 rf0, rf1; u32x4 rq, rv;
    auto pos_of = [&](int s) { return dir ? (s < NCTX ? NCTX - 1 - s : SU + NCTX - 1 - s) : s; };
#define HG_ISSUE(s0_) do { const int pA = pos_of((s0_) + (tid >> 5)), pB = pos_of((s0_) + 16 + (tid >> 5)), pQ = pos_of((s0_) + (tid >> 4)); \
        rf0 = *(const f32x4*)(fsrc + (rb + pA) * DM + h * 128 + 4 * (tid & 31)); rf1 = *(const f32x4*)(fsrc + (rb + pB) * DM + h * 128 + 4 * (tid & 31)); \
        rq = *(const u32x4*)(qsrc + (rb + pQ) * DM + h * 128 + 8 * (tid & 15)); \
        if (tid < 128) { const int pV = pos_of((s0_) + (tid >> 2)); rv = *(const u32x4*)(vsrc + (rb + pV) * DM + h * 128 + 32 * es + 8 * (tid & 3)); } } while (0)
#define HG_WRITE(buf_) do { LAS float* bF = sIn + (buf_) * INB; LAS float* bQ = bF + 32 * 128; LAS float* bV = bQ + 32 * 128; \
        *(LAS f32x4*)(bF + (tid >> 5) * 128 + 4 * (tid & 31)) = rf0; *(LAS f32x4*)(bF + (16 + (tid >> 5)) * 128 + 4 * (tid & 31)) = rf1; \
        { LAS float* d = bQ + (tid >> 4) * 128 + 8 * (tid & 15); *(LAS f32x4*)d = (f32x4){bflo(rq.x), bfhi(rq.x), bflo(rq.y), bfhi(rq.y)}; *(LAS f32x4*)(d + 4) = (f32x4){bflo(rq.z), bfhi(rq.z), bflo(rq.w), bfhi(rq.w)}; } \
        if (tid < 128) { LAS float* d = bV + (tid >> 2) * 32 + 8 * (tid & 3); *(LAS f32x4*)d = (f32x4){bflo(rv.x), bfhi(rv.x), bflo(rv.y), bfhi(rv.y)}; *(LAS f32x4*)(d + 4) = (f32x4){bflo(rv.z), bfhi(rv.z), bflo(rv.w), bfhi(rv.w)}; } } while (0)
    __syncthreads();
    HG_ISSUE(0); HG_WRITE(0);
    __syncthreads();
    constexpr int NTB = SU / 32;
    for (int tb = 0; tb < NTB; ++tb) {
        const int s0 = 32 * tb, cur = tb & 1;
        if (tb + 1 < NTB) HG_ISSUE(s0 + 32);
        const LAS float* sF = sIn + cur * INB; const LAS float* sQ = sF + 32 * 128; const LAS float* sV = sQ + 32 * 128;
#pragma unroll 4
        for (int tt = 0; tt < 32; ++tt) {
            const f32x4 f0 = *(const LAS f32x4*)(sF + tt * 128 + 8 * dg), f1 = *(const LAS f32x4*)(sF + tt * 128 + 8 * dg + 4);
            const f32x4 q0 = *(const LAS f32x4*)(sQ + tt * 128 + 8 * dg), q1 = *(const LAS f32x4*)(sQ + tt * 128 + 8 * dg + 4);
            const float v = sV[tt * 32 + e];
            const float ff[8] = {f0.x, f0.y, f0.z, f0.w, f1.x, f1.y, f1.z, f1.w}; const float qq[8] = {q0.x, q0.y, q0.z, q0.w, q1.x, q1.y, q1.z, q1.w};
            float part = 0.f;
#pragma unroll
            for (int k = 0; k < 8; ++k) { S[k] = ff[k] * S[k] + (1.0f - ff[k]) * v; part += qq[k] * S[k]; }
            sP[(tt * 16 + dg) * 32 + e] = part;
        }
        __syncthreads();
#pragma unroll
        for (int i = 0; i < 2; ++i) { const int q = tid + 512 * i, tt = q >> 5, ee = q & 31; float o = 0.f;
#pragma unroll
            for (int k = 0; k < 16; ++k) o += sP[(tt * 16 + k) * 32 + ee];
            osrc[(rb + pos_of(s0 + tt)) * DM + h * 128 + 32 * es + ee] = o; }
        if (tb + 1 < NTB) HG_WRITE(cur ^ 1);
        __syncthreads();
    }
#undef HG_ISSUE
#undef HG_WRITE
}
__device__ __forceinline__ void hg_scan_item_c16(Frame& F, int item) {
    const int es = item & 3, dir = (item >> 2) & 1, h = (item >> 3) & 7, b = item >> 6;
    const int tid = ftid(), lane = tid & 63, w = F.wave, quad = lane >> 4, l15 = lane & 15;
    constexpr int INB = 32 * 128 * 2 + 32 * 32;
    LAS float* sIn = (LAS float*)F.lds;
    LAS bf16_t* QA = (LAS bf16_t*)(sIn + 2 * INB);
    LAS bf16_t* KB = QA + 2 * 16 * 136;
    LAS bf16_t* KC = KB + 2 * 16 * 136;
    LAS bf16_t* VT = KC + 2 * 128 * 40;
    LAS bf16_t* PP = VT + 2 * 32 * 40;
    LAS bf16_t* ST = PP + 2 * 16 * 40;
    LAS float* DEC = (LAS float*)(ST + 32 * 136);
    const float* fsrc = (const float*)(F.ws + (dir ? WS_FB : WS_FF));
    const bf16_t* qsrc = (const bf16_t*)(F.ws + WS_PQ); const bf16_t* vsrc = (const bf16_t*)(F.ws + WS_PI);
    float* osrc = (float*)(F.ws + (dir ? WS_OB : WS_OF));
    const size_t rb = (size_t)b * SU;
    f32x4 S[2] = {(f32x4){0.f, 0.f, 0.f, 0.f}, (f32x4){0.f, 0.f, 0.f, 0.f}};
    f32x4 rf0, rf1; u32x4 rq, rv;
    auto pos_of = [&](int s) { return dir ? (s < NCTX ? NCTX - 1 - s : SU + NCTX - 1 - s) : s; };
#define HG_ISSUE(s0_) do { const int pA = pos_of((s0_) + (tid >> 5)), pB = pos_of((s0_) + 16 + (tid >> 5)), pQ = pos_of((s0_) + (tid >> 4)); \
        rf0 = *(const f32x4*)(fsrc + (rb + pA) * DM + h * 128 + 4 * (tid & 31)); rf1 = *(const f32x4*)(fsrc + (rb + pB) * DM + h * 128 + 4 * (tid & 31)); \
        rq = *(const u32x4*)(qsrc + (rb + pQ) * DM + h * 128 + 8 * (tid & 15)); \
        if (tid < 128) { const int pV = pos_of((s0_) + (tid >> 2)); rv = *(const u32x4*)(vsrc + (rb + pV) * DM + h * 128 + 32 * es + 8 * (tid & 3)); } } while (0)
#define HG_WRITE(buf_) do { LAS float* bF = sIn + (buf_) * INB; LAS float* bQ = bF + 32 * 128; LAS float* bV = bQ + 32 * 128; \
        *(LAS f32x4*)(bF + (tid >> 5) * 128 + 4 * (tid & 31)) = rf0; *(LAS f32x4*)(bF + (16 + (tid >> 5)) * 128 + 4 * (tid & 31)) = rf1; \
        { LAS float* d = bQ + (tid >> 4) * 128 + 8 * (tid & 15); *(LAS f32x4*)d = (f32x4){bflo(rq.x), bfhi(rq.x), bflo(rq.y), bfhi(rq.y)}; *(LAS f32x4*)(d + 4) = (f32x4){bflo(rq.z), bfhi(rq.z), bflo(rq.w), bfhi(rq.w)}; } \
        if (tid < 128) { LAS float* d = bV + (tid >> 2) * 32 + 8 * (tid & 3); *(LAS f32x4*)d = (f32x4){bflo(rv.x), bfhi(rv.x), bflo(rv.y), bfhi(rv.y)}; *(LAS f32x4*)(d + 4) = (f32x4){bflo(rv.z), bfhi(rv.z), bflo(rv.w), bfhi(rv.w)}; } } while (0)
    __syncthreads();
    for (int i = tid; i < 2 * 128 * 40; i += 512) KC[i] = 0;
    for (int i = tid; i < 2 * 32 * 40; i += 512) VT[i] = 0;
    for (int i = tid; i < 2 * 16 * 40; i += 512) PP[i] = 0;
    for (int i = tid; i < 32 * 136; i += 512) ST[i] = 0;
    HG_ISSUE(0); HG_WRITE(0);
    __syncthreads();
    constexpr int NTB = SU / 32;
#define HG_BAR() do { asm volatile("s_waitcnt lgkmcnt(0)" ::: "memory"); __builtin_amdgcn_s_barrier(); asm volatile("" ::: "memory"); } while (0)
    for (int tb = 0; tb < NTB; ++tb) {
        const int s0 = 32 * tb, cur = tb & 1;
        if (tb + 1 < NTB) HG_ISSUE(s0 + 32);
        const LAS float* sF = sIn + cur * INB; const LAS float* sQ = sF + 32 * 128; const LAS float* sV = sQ + 32 * 128;
        if (tid < 256) {
            const int c = tid >> 7, d = tid & 127;
            float a = 0.f, kbv[16], fv[16], qv[16];
#pragma unroll
            for (int i = 0; i < 16; ++i) { fv[i] = sF[(16 * c + i) * 128 + d]; qv[i] = sQ[(16 * c + i) * 128 + d]; }
#pragma unroll
            for (int i = 0; i < 16; ++i) { const float f = fv[i], q = qv[i];
                a += __builtin_amdgcn_logf(f); const float ea = __builtin_amdgcn_exp2f(a);
                QA[(c * 16 + i) * 136 + d] = (bf16_t)f2bf(q * ea); kbv[i] = (1.0f - f) * __builtin_amdgcn_exp2f(-a); }
            const float al = __builtin_amdgcn_exp2f(a); DEC[c * 128 + d] = al;
            unsigned pk[8];
#pragma unroll
            for (int j = 0; j < 16; ++j) { KB[(c * 16 + j) * 136 + d] = (bf16_t)f2bf(kbv[j]); }
#pragma unroll
            for (int j = 0; j < 8; ++j) pk[j] = pk2(kbv[2 * j] * al, kbv[2 * j + 1] * al);
            LAS u32x4* kd = (LAS u32x4*)(KC + (c * 128 + d) * 40); kd[0] = (u32x4){pk[0], pk[1], pk[2], pk[3]}; kd[1] = (u32x4){pk[4], pk[5], pk[6], pk[7]};
        } else {
            const int idx = tid - 256, c = idx >> 7, e = (idx >> 2) & 31, jq = idx & 3;
            const float v0 = sV[(16 * c + 4 * jq + 0) * 32 + e], v1 = sV[(16 * c + 4 * jq + 1) * 32 + e], v2 = sV[(16 * c + 4 * jq + 2) * 32 + e], v3 = sV[(16 * c + 4 * jq + 3) * 32 + e];
            u32x2 o; o.x = pk2(v0, v1); o.y = pk2(v2, v3); *(LAS u32x2*)(VT + (c * 32 + e) * 40 + 4 * jq) = o;
        }
        HG_BAR();
        bf16x8 qa[4]; f32x4 oi[2] = {(f32x4){0.f, 0.f, 0.f, 0.f}, (f32x4){0.f, 0.f, 0.f, 0.f}};
        bf16x8 sb0[2][4];
        if (w < 2) {
            const int c = w;
            bf16x8 kbf[4], vbf[2];
#pragma unroll
            for (int ks = 0; ks < 4; ++ks) { qa[ks] = *(const LAS bf16x8*)(QA + (c * 16 + l15) * 136 + 32 * ks + 8 * quad); kbf[ks] = *(const LAS bf16x8*)(KB + (c * 16 + l15) * 136 + 32 * ks + 8 * quad); }
#pragma unroll
            for (int nt = 0; nt < 2; ++nt) vbf[nt] = *(const LAS bf16x8*)(VT + (c * 32 + 16 * nt + l15) * 40 + 8 * quad);
            if (c == 0) {
#pragma unroll
                for (int nt = 0; nt < 2; ++nt)
#pragma unroll
                    for (int ks = 0; ks < 4; ++ks) sb0[nt][ks] = *(const LAS bf16x8*)(ST + (16 * nt + l15) * 136 + 32 * ks + 8 * quad);
            }
            f32x4 sc = (f32x4){0.f, 0.f, 0.f, 0.f};
#pragma unroll
            for (int ks = 0; ks < 4; ++ks) sc = __builtin_amdgcn_mfma_f32_16x16x32_bf16(qa[ks], kbf[ks], sc, 0, 0, 0);
#pragma unroll
            for (int jj = 0; jj < 4; ++jj) { const int i = 4 * quad + jj; PP[(c * 16 + i) * 40 + l15] = (bf16_t)f2bf(l15 <= i ? sc[jj] : 0.f); }
            LDS_WAIT(); asm volatile("" ::: "memory");
            const bf16x8 pa = *(const LAS bf16x8*)(PP + (c * 16 + l15) * 40 + 8 * quad);
#pragma unroll
            for (int nt = 0; nt < 2; ++nt) oi[nt] = __builtin_amdgcn_mfma_f32_16x16x32_bf16(pa, vbf[nt], oi[nt], 0, 0, 0);
        }
#pragma unroll
        for (int c = 0; c < 2; ++c) {
            if (w == c) {
                if (c == 1) {
#pragma unroll
                    for (int nt = 0; nt < 2; ++nt)
#pragma unroll
                        for (int ks = 0; ks < 4; ++ks) sb0[nt][ks] = *(const LAS bf16x8*)(ST + (16 * nt + l15) * 136 + 32 * ks + 8 * quad);
                }
#pragma unroll
                for (int ks = 0; ks < 4; ++ks)
#pragma unroll
                    for (int nt = 0; nt < 2; ++nt) oi[nt] = __builtin_amdgcn_mfma_f32_16x16x32_bf16(qa[ks], sb0[nt][ks], oi[nt], 0, 0, 0);
#pragma unroll
                for (int jj = 0; jj < 4; ++jj) { const int pp = pos_of(s0 + 16 * c + 4 * quad + jj); float* op = osrc + (rb + pp) * DM + h * 128 + 32 * es + l15; op[0] = oi[0][jj]; op[16] = oi[1][jj]; }
            }
            {
                const f32x4 dc = *(const LAS f32x4*)(DEC + c * 128 + 16 * w + 4 * quad);
                const bf16x8 ka = *(const LAS bf16x8*)(KC + (c * 128 + 16 * w + l15) * 40 + 8 * quad);
#pragma unroll
                for (int nt = 0; nt < 2; ++nt) { const bf16x8 vb = *(const LAS bf16x8*)(VT + (c * 32 + 16 * nt + l15) * 40 + 8 * quad); S[nt] = S[nt] * dc; S[nt] = __builtin_amdgcn_mfma_f32_16x16x32_bf16(ka, vb, S[nt], 0, 0, 0); }
            }
            HG_BAR();
#pragma unroll
            for (int nt = 0; nt < 2; ++nt)
#pragma unroll
                for (int jj = 0; jj < 4; ++jj) ST[(16 * nt + l15) * 136 + 16 * w + 4 * quad + jj] = (bf16_t)f2bf(S[nt][jj]);
            if (c == 1 && tb + 1 < NTB) HG_WRITE(cur ^ 1);
            HG_BAR();
        }
    }
#undef HG_ISSUE
#undef HG_WRITE
#undef HG_BAR
}
__device__ __forceinline__ void hg_scan_item_c32(Frame& F, int item) {
    const int es = item & 3, dir = (item >> 2) & 1, h = (item >> 3) & 7, b = item >> 6;
    const int tid = ftid(), lane = tid & 63, w = F.wave, quad = lane >> 4, l15 = lane & 15;
    constexpr int INB = 32 * 128 * 2 + 32 * 32;
    LAS float* sIn = (LAS float*)F.lds;
    LAS bf16_t* QA = (LAS bf16_t*)(sIn + 2 * INB);
    LAS bf16_t* KB = QA + 32 * 136;
    LAS bf16_t* KC = KB + 32 * 136;
    LAS bf16_t* VT = KC + 128 * 40;
    LAS bf16_t* PP = VT + 32 * 40;
    LAS bf16_t* ST = PP + 32 * 40;
    LAS float* DEC = (LAS float*)(ST + 32 * 136);
    const float* fsrc = (const float*)(F.ws + (dir ? WS_FB : WS_FF));
    const bf16_t* qsrc = (const bf16_t*)(F.ws + WS_PQ); const bf16_t* vsrc = (const bf16_t*)(F.ws + WS_PI);
    float* osrc = (float*)(F.ws + (dir ? WS_OB : WS_OF));
    const size_t rb = (size_t)b * SU;
    f32x4 S[2] = {(f32x4){0.f, 0.f, 0.f, 0.f}, (f32x4){0.f, 0.f, 0.f, 0.f}};
    f32x4 rf0A, rf1A, rf0B, rf1B; u32x4 rqA, rvA, rqB, rvB;
    auto pos_of = [&](int s) { return dir ? (s < NCTX ? NCTX - 1 - s : SU + NCTX - 1 - s) : s; };
#define HG_ISSUE(rf0, rf1, rq, rv, s0_) do { const int pA = pos_of((s0_) + (tid >> 5)), pB = pos_of((s0_) + 16 + (tid >> 5)), pQ = pos_of((s0_) + (tid >> 4)); \
        rf0 = *(const f32x4*)(fsrc + (rb + pA) * DM + h * 128 + 4 * (tid & 31)); rf1 = *(const f32x4*)(fsrc + (rb + pB) * DM + h * 128 + 4 * (tid & 31)); \
        rq = *(const u32x4*)(qsrc + (rb + pQ) * DM + h * 128 + 8 * (tid & 15)); \
        if (tid < 128) { const int pV = pos_of((s0_) + (tid >> 2)); rv = *(const u32x4*)(vsrc + (rb + pV) * DM + h * 128 + 32 * es + 8 * (tid & 3)); } } while (0)
#define HG_WRITE(rf0, rf1, rq, rv, buf_) do { LAS float* bF = sIn + (buf_) * INB; LAS float* bQ = bF + 32 * 128; LAS float* bV = bQ + 32 * 128; \
        *(LAS f32x4*)(bF + (tid >> 5) * 128 + 4 * (tid & 31)) = rf0; *(LAS f32x4*)(bF + (16 + (tid >> 5)) * 128 + 4 * (tid & 31)) = rf1; \
        { LAS float* d = bQ + (tid >> 4) * 128 + 8 * (tid & 15); *(LAS f32x4*)d = (f32x4){bflo(rq.x), bfhi(rq.x), bflo(rq.y), bfhi(rq.y)}; *(LAS f32x4*)(d + 4) = (f32x4){bflo(rq.z), bfhi(rq.z), bflo(rq.w), bfhi(rq.w)}; } \
        if (tid < 128) { LAS float* d = bV + (tid >> 2) * 32 + 8 * (tid & 3); *(LAS f32x4*)d = (f32x4){bflo(rv.x), bfhi(rv.x), bflo(rv.y), bfhi(rv.y)}; *(LAS f32x4*)(d + 4) = (f32x4){bflo(rv.z), bfhi(rv.z), bflo(rv.w), bfhi(rv.w)}; } } while (0)
#define HG_BAR() do { asm volatile("s_waitcnt lgkmcnt(0)" ::: "memory"); __builtin_amdgcn_s_barrier(); asm volatile("" ::: "memory"); } while (0)
    __syncthreads();
    for (int i = tid; i < 32 * 136; i += 512) ST[i] = 0;
    HG_ISSUE(rf0A, rf1A, rqA, rvA, 0); HG_WRITE(rf0A, rf1A, rqA, rvA, 0);
    HG_ISSUE(rf0B, rf1B, rqB, rvB, 32);
    __syncthreads();
    constexpr int NTB = SU / 32;
    auto blk = [&](const int tb, const int cur) __attribute__((always_inline)) {
        const int s0 = 32 * tb;
        const LAS float* sF = sIn + cur * INB; const LAS float* sQ = sF + 32 * 128; const LAS float* sV = sQ + 32 * 128;
        if (tid < 256) {
            const int c = tid & 1, d = tid >> 1;
            float fv[16], qv[16], kbv[16];
#pragma unroll
            for (int i = 0; i < 16; ++i) { fv[i] = sF[(16 * c + i) * 128 + d]; qv[i] = sQ[(16 * c + i) * 128 + d]; }
            float tot = 1.f;
#pragma unroll
            for (int i = 0; i < 16; ++i) tot *= fv[i];
            const float oth = shx(tot, 1, lane);
            float ea = c ? oth : 1.f;
            float eia = __builtin_amdgcn_rcpf(ea);
            const float al = tot * oth;
#pragma unroll
            for (int i = 0; i < 16; ++i) { const float fo = fv[i]; ea *= fo; eia *= __builtin_amdgcn_rcpf(fo);
                QA[(16 * c + i) * 136 + d] = (bf16_t)f2bf(qv[i] * ea); kbv[i] = (1.0f - fo) * eia; }
            if (c == 0) DEC[d] = al;
            unsigned pk[8];
#pragma unroll
            for (int j = 0; j < 16; ++j) KB[(16 * c + j) * 136 + d] = (bf16_t)f2bf(kbv[j]);
#pragma unroll
            for (int j = 0; j < 8; ++j) pk[j] = pk2(kbv[2 * j] * al, kbv[2 * j + 1] * al);
            LAS u32x4* kd = (LAS u32x4*)(KC + d * 40 + 16 * c); kd[0] = (u32x4){pk[0], pk[1], pk[2], pk[3]}; kd[1] = (u32x4){pk[4], pk[5], pk[6], pk[7]};
        } else {
            const int idx = tid - 256, e = idx >> 3, jq = idx & 7;
            const float v0 = sV[(4 * jq + 0) * 32 + e], v1 = sV[(4 * jq + 1) * 32 + e], v2 = sV[(4 * jq + 2) * 32 + e], v3 = sV[(4 * jq + 3) * 32 + e];
            u32x2 o; o.x = pk2(v0, v1); o.y = pk2(v2, v3); *(LAS u32x2*)(VT + e * 40 + 4 * jq) = o;
        }
        HG_BAR();
        if (w < 2) {
            const int it = w;
            bf16x8 qa[4], kbf[2][4], vbf[2], sbf[2][4];
#pragma unroll
            for (int ks = 0; ks < 4; ++ks) { qa[ks] = *(const LAS bf16x8*)(QA + (16 * it + l15) * 136 + 32 * ks + 8 * quad);
                kbf[0][ks] = *(const LAS bf16x8*)(KB + (l15) * 136 + 32 * ks + 8 * quad); kbf[1][ks] = *(const LAS bf16x8*)(KB + (16 + l15) * 136 + 32 * ks + 8 * quad); }
#pragma unroll
            for (int nt = 0; nt < 2; ++nt) { vbf[nt] = *(const LAS bf16x8*)(VT + (16 * nt + l15) * 40 + 8 * quad);
#pragma unroll
                for (int ks = 0; ks < 4; ++ks) sbf[nt][ks] = *(const LAS bf16x8*)(ST + (16 * nt + l15) * 136 + 32 * ks + 8 * quad); }
            f32x4 sc0 = (f32x4){0.f, 0.f, 0.f, 0.f}, sc1 = (f32x4){0.f, 0.f, 0.f, 0.f};
#pragma unroll
            for (int ks = 0; ks < 4; ++ks) { sc0 = __builtin_amdgcn_mfma_f32_16x16x32_bf16(qa[ks], kbf[0][ks], sc0, 0, 0, 0); sc1 = __builtin_amdgcn_mfma_f32_16x16x32_bf16(qa[ks], kbf[1][ks], sc1, 0, 0, 0); }
#pragma unroll
            for (int jj = 0; jj < 4; ++jj) { const int i = 16 * it + 4 * quad + jj;
                PP[i * 40 + l15] = (bf16_t)f2bf(l15 <= i ? sc0[jj] : 0.f); PP[i * 40 + 16 + l15] = (bf16_t)f2bf(16 + l15 <= i ? sc1[jj] : 0.f); }
            LDS_WAIT(); asm volatile("" ::: "memory");
            const bf16x8 pa = *(const LAS bf16x8*)(PP + (16 * it + l15) * 40 + 8 * quad);
            f32x4 oi[2];
#pragma unroll
            for (int nt = 0; nt < 2; ++nt) { oi[nt] = __builtin_amdgcn_mfma_f32_16x16x32_bf16(pa, vbf[nt], (f32x4){0.f, 0.f, 0.f, 0.f}, 0, 0, 0);
#pragma unroll
                for (int ks = 0; ks < 4; ++ks) oi[nt] = __builtin_amdgcn_mfma_f32_16x16x32_bf16(qa[ks], sbf[nt][ks], oi[nt], 0, 0, 0); }
#pragma unroll
            for (int jj = 0; jj < 4; ++jj) { const int pp = pos_of(s0 + 16 * it + 4 * quad + jj); float* op = osrc + (rb + pp) * DM + h * 128 + 32 * es + l15; op[0] = oi[0][jj]; op[16] = oi[1][jj]; }
        }
        {
            const f32x4 dc = *(const LAS f32x4*)(DEC + 16 * w + 4 * quad);
            const bf16x8 ka = *(const LAS bf16x8*)(KC + (16 * w + l15) * 40 + 8 * quad);
#pragma unroll
            for (int nt = 0; nt < 2; ++nt) { const bf16x8 vb = *(const LAS bf16x8*)(VT + (16 * nt + l15) * 40 + 8 * quad); S[nt] = S[nt] * dc; S[nt] = __builtin_amdgcn_mfma_f32_16x16x32_bf16(ka, vb, S[nt], 0, 0, 0); }
        }
        HG_BAR();
#pragma unroll
        for (int nt = 0; nt < 2; ++nt)
#pragma unroll
            for (int jj = 0; jj < 4; ++jj) ST[(16 * nt + l15) * 136 + 16 * w + 4 * quad + jj] = (bf16_t)f2bf(S[nt][jj]);
    };
    for (int tb = 0; tb < NTB; tb += 2) {
        { const int nb = tb + 2 < NTB ? tb + 2 : NTB - 1; HG_ISSUE(rf0A, rf1A, rqA, rvA, 32 * nb); }
        blk(tb, 0);
        HG_WRITE(rf0B, rf1B, rqB, rvB, 1);
        HG_BAR();
        { const int nb = tb + 3 < NTB ? tb + 3 : NTB - 1; HG_ISSUE(rf0B, rf1B, rqB, rvB, 32 * nb); }
        blk(tb + 1, 1);
        HG_WRITE(rf0A, rf1A, rqA, rvA, 0);
        HG_BAR();
    }
#undef HG_ISSUE
#undef HG_WRITE
#undef HG_BAR
}
__device__ __forceinline__ void hg_scan_item(Frame& F, int item) {
    const int es = item & 3, dir = (item >> 2) & 1, h = (item >> 3) & 7, b = item >> 6;
    const int tid = ftid(), lane = tid & 63, w = F.wave, quad = lane >> 4, l15 = lane & 15;
    constexpr int INB = 32 * 128 * 2 + 32 * 32;
    LAS float* sIn = (LAS float*)F.lds;
    LAS bf16_t* QA = (LAS bf16_t*)(sIn + 2 * INB);
    LAS bf16_t* KB = QA + 2 * 32 * 136;
    LAS bf16_t* KC = KB + 32 * 136;
    LAS bf16_t* VT = KC + 2 * 128 * 40;
    LAS bf16_t* PP = VT + 2 * 32 * 40;
    LAS bf16_t* ST = PP + 2 * 32 * 40;
    LAS float* DEC = (LAS float*)(ST + 2 * 32 * 136);
    const bf16_t* ksrc = (const bf16_t*)(F.ws + (dir ? WS_FB : WS_FF));
    const bf16_t* qsrc = (const bf16_t*)(F.ws + WS_PQ); const bf16_t* vsrc = (const bf16_t*)(F.ws + WS_PI);
    bf16_t* osrc = (bf16_t*)(F.ws + (dir ? WS_OB : WS_OF));
    const size_t rb = (size_t)b * SU;
    auto pos_of = [&](int s) { return dir ? (s < NCTX ? NCTX - 1 - s : SU + NCTX - 1 - s) : s; };
    constexpr int NTB = SU / 32;
#define HG_BAR() do { asm volatile("s_waitcnt lgkmcnt(0)" ::: "memory"); __builtin_amdgcn_s_barrier(); asm volatile("" ::: "memory"); } while (0)
    u32x4 rk[2], rq[2], rv;
#define HG_ISSUE(s0_) do { \
        _Pragma("unroll") for (int r_ = 0; r_ < 2; ++r_) rk[r_] = *(const u32x4*)(ksrc + (rb + pos_of((s0_) + (tid >> 4) + 16 * r_)) * DM + h * 128 + 8 * (tid & 15)); \
        _Pragma("unroll") for (int r_ = 0; r_ < 2; ++r_) rq[r_] = *(const u32x4*)(qsrc + (rb + pos_of((s0_) + (tid >> 4) + 16 * r_)) * DM + h * 128 + 8 * (tid & 15)); \
        if (tid < 128) rv = *(const u32x4*)(vsrc + (rb + pos_of((s0_) + (tid >> 2))) * DM + h * 128 + 32 * es + 8 * (tid & 3)); } while (0)
#define HG_WRITE(buf_) do { LAS float* bF = sIn + (buf_) * INB; LAS float* bQ = bF + 32 * 128; LAS float* bV = bQ + 32 * 128; \
        _Pragma("unroll") for (int r_ = 0; r_ < 2; ++r_) { LAS float* d = bF + ((tid >> 4) + 16 * r_) * 128 + 8 * (tid & 15); *(LAS f32x4*)d = (f32x4){1.f - bflo(rk[r_].x), 1.f - bfhi(rk[r_].x), 1.f - bflo(rk[r_].y), 1.f - bfhi(rk[r_].y)}; *(LAS f32x4*)(d + 4) = (f32x4){1.f - bflo(rk[r_].z), 1.f - bfhi(rk[r_].z), 1.f - bflo(rk[r_].w), 1.f - bfhi(rk[r_].w)}; } \
        _Pragma("unroll") for (int r_ = 0; r_ < 2; ++r_) { LAS float* d = bQ + ((tid >> 4) + 16 * r_) * 128 + 8 * (tid & 15); *(LAS f32x4*)d = (f32x4){bflo(rq[r_].x), bfhi(rq[r_].x), bflo(rq[r_].y), bfhi(rq[r_].y)}; *(LAS f32x4*)(d + 4) = (f32x4){bflo(rq[r_].z), bfhi(rq[r_].z), bflo(rq[r_].w), bfhi(rq[r_].w)}; } \
        if (tid < 128) { LAS float* d = bV + (tid >> 2) * 32 + 8 * (tid & 3); *(LAS f32x4*)d = (f32x4){bflo(rv.x), bfhi(rv.x), bflo(rv.y), bfhi(rv.y)}; *(LAS f32x4*)(d + 4) = (f32x4){bflo(rv.z), bfhi(rv.z), bflo(rv.w), bfhi(rv.w)}; } } while (0)
    f32x4 S[2][2];
#pragma unroll
    for (int a = 0; a < 2; ++a)
#pragma unroll
        for (int c2 = 0; c2 < 2; ++c2) S[a][c2] = (f32x4){0.f, 0.f, 0.f, 0.f};
    __syncthreads();
    for (int i = tid; i < 2 * 32 * 136; i += 512) ST[i] = 0;
    if (w < 4) { HG_ISSUE(0); HG_WRITE(0); HG_ISSUE(32); }
    __syncthreads();
    for (int j = 0; j <= NTB; ++j) {
        const int sp = j & 1;
        const int t = j - 1, sc_ = t & 1;
        f32x4 oi = (f32x4){0.f, 0.f, 0.f, 0.f};
        f32x2 kbv[8], al; float v0, v1, v2, v3;
        if (w < 4) {
            if (j < NTB) {
                const LAS float* sF = sIn + sp * INB; const LAS float* sQ = sF + 32 * 128; const LAS float* sV = sQ + 32 * 128;
                const int cq = w, dp = lane;
                f32x2 fv[32], qv[8];
#pragma unroll
                for (int i = 0; i < 32; ++i) fv[i] = *(const LAS f32x2*)(sF + i * 128 + 2 * dp);
                f32x2 fq[8];
#pragma unroll
                for (int i = 0; i < 8; ++i) { qv[i] = *(const LAS f32x2*)(sQ + (8 * cq + i) * 128 + 2 * dp); fq[i] = *(const LAS f32x2*)(sF + (8 * cq + i) * 128 + 2 * dp); }
                const int e = tid >> 3, jq = tid & 7;
                v0 = sV[(4 * jq + 0) * 32 + e]; v1 = sV[(4 * jq + 1) * 32 + e]; v2 = sV[(4 * jq + 2) * 32 + e]; v3 = sV[(4 * jq + 3) * 32 + e];
                f32x2 qp[4];
#pragma unroll
                for (int c4 = 0; c4 < 4; ++c4) { f32x2 pr = fv[8 * c4];
#pragma unroll
                    for (int i = 1; i < 8; ++i) pr = pr * fv[8 * c4 + i]; qp[c4] = pr; }
                f32x2 ea = (f32x2){1.f, 1.f};
#pragma unroll
                for (int c4 = 0; c4 < 3; ++c4) { if (c4 < cq) ea = ea * qp[c4]; }
                al = (qp[0] * qp[1]) * (qp[2] * qp[3]);
                f32x2 eia; eia.x = __builtin_amdgcn_rcpf(ea.x); eia.y = __builtin_amdgcn_rcpf(ea.y);
                LAS bf16_t* qa_ = QA + sp * 32 * 136;
#pragma unroll
                for (int i = 0; i < 8; ++i) { const f32x2 fo = fq[i];
                    ea = ea * fo; f32x2 rf_; rf_.x = __builtin_amdgcn_rcpf(fo.x); rf_.y = __builtin_amdgcn_rcpf(fo.y); eia = eia * rf_;
                    const f32x2 qa2 = qv[i] * ea; kbv[i] = ((f32x2){1.f, 1.f} - fo) * eia;
                    *(LAS unsigned*)(qa_ + (8 * cq + i) * 136 + 2 * dp) = pk2(qa2.x, qa2.y);
                    *(LAS unsigned*)(KB + (8 * cq + i) * 136 + 2 * dp) = pk2(kbv[i].x, kbv[i].y); }
            }
        } else if (t >= 0) {
            const int k = w - 4, it = k >> 1, nt = k & 1;
            const bf16x8 pa = *(const LAS bf16x8*)(PP + (sc_ * 32 + 16 * it + l15) * 40 + 8 * quad);
            const bf16x8 vb = *(const LAS bf16x8*)(VT + (sc_ * 32 + 16 * nt + l15) * 40 + 8 * quad);
            bf16x8 qa[4], sb[4];
#pragma unroll
            for (int ks = 0; ks < 4; ++ks) { qa[ks] = *(const LAS bf16x8*)(QA + (sc_ * 32 + 16 * it + l15) * 136 + 32 * ks + 8 * quad); sb[ks] = *(const LAS bf16x8*)(ST + (sc_ * 32 + 16 * nt + l15) * 136 + 32 * ks + 8 * quad); }
            oi = __builtin_amdgcn_mfma_f32_16x16x32_bf16(pa, vb, oi, 0, 0, 0);
#pragma unroll
            for (int ks = 0; ks < 4; ++ks) oi = __builtin_amdgcn_mfma_f32_16x16x32_bf16(qa[ks], sb[ks], oi, 0, 0, 0);
#pragma unroll
            for (int jj = 0; jj < 4; ++jj) { const int pp = pos_of(32 * t + 16 * it + 4 * quad + jj); osrc[(rb + pp) * DM + h * 128 + 32 * es + 16 * nt + l15] = (bf16_t)f2bf(oi[jj]); }
        }
        HG_BAR();
        if (w >= 4) {
            if (t >= 0) {
            const int k = w - 4;
#pragma unroll
            for (int mt = 0; mt < 2; ++mt) {
                const f32x4 dc = *(const LAS f32x4*)(DEC + sc_ * 128 + 32 * k + 16 * mt + 4 * quad);
                const bf16x8 ka = *(const LAS bf16x8*)(KC + (sc_ * 128 + 32 * k + 16 * mt + l15) * 40 + 8 * quad);
#pragma unroll
                for (int n2 = 0; n2 < 2; ++n2) { const bf16x8 vb2 = *(const LAS bf16x8*)(VT + (sc_ * 32 + 16 * n2 + l15) * 40 + 8 * quad); S[mt][n2] = S[mt][n2] * dc; S[mt][n2] = __builtin_amdgcn_mfma_f32_16x16x32_bf16(ka, vb2, S[mt][n2], 0, 0, 0); }
            }
            LAS bf16_t* stn = ST + (sc_ ^ 1) * 32 * 136;
#pragma unroll
            for (int mt = 0; mt < 2; ++mt)
#pragma unroll
                for (int n2 = 0; n2 < 2; ++n2)
                    { u32x2 o2; o2.x = pk2(S[mt][n2][0], S[mt][n2][1]); o2.y = pk2(S[mt][n2][2], S[mt][n2][3]); *(LAS u32x2*)(stn + (16 * n2 + l15) * 136 + 32 * k + 16 * mt + 4 * quad) = o2; }
            }
            if (j < NTB) {
                const int k = w - 4, it = k >> 1, jt = k & 1;
                f32x4 sc0 = (f32x4){0.f, 0.f, 0.f, 0.f};
                if (k != 1) {
                    bf16x8 qa[4], kbf[4];
#pragma unroll
                    for (int ks = 0; ks < 4; ++ks) { qa[ks] = *(const LAS bf16x8*)(QA + (sp * 32 + 16 * it + l15) * 136 + 32 * ks + 8 * quad);
                        kbf[ks] = *(const LAS bf16x8*)(KB + (16 * jt + l15) * 136 + 32 * ks + 8 * quad); }
#pragma unroll
                    for (int ks = 0; ks < 4; ++ks) sc0 = __builtin_amdgcn_mfma_f32_16x16x32_bf16(qa[ks], kbf[ks], sc0, 0, 0, 0);
                }
#pragma unroll
                for (int jj = 0; jj < 4; ++jj) { const int i = 16 * it + 4 * quad + jj;
                    PP[(sp * 32 + i) * 40 + 16 * jt + l15] = (bf16_t)f2bf(16 * jt + l15 <= i ? sc0[jj] : 0.f); }
            }
        }
        if (w < 4 && j < NTB) {
            const int cq = w, dp = lane; const int e = tid >> 3, jq = tid & 7;
                if (cq == 0) *(LAS f32x2*)(DEC + sp * 128 + 2 * dp) = al;
                u32x4 k0, k1;
                k0.x = pk2(kbv[0].x * al.x, kbv[1].x * al.x); k0.y = pk2(kbv[2].x * al.x, kbv[3].x * al.x); k0.z = pk2(kbv[4].x * al.x, kbv[5].x * al.x); k0.w = pk2(kbv[6].x * al.x, kbv[7].x * al.x);
                k1.x = pk2(kbv[0].y * al.y, kbv[1].y * al.y); k1.y = pk2(kbv[2].y * al.y, kbv[3].y * al.y); k1.z = pk2(kbv[4].y * al.y, kbv[5].y * al.y); k1.w = pk2(kbv[6].y * al.y, kbv[7].y * al.y);
                *(LAS u32x4*)(KC + (sp * 128 + 2 * dp) * 40 + 8 * cq) = k0; *(LAS u32x4*)(KC + (sp * 128 + 2 * dp + 1) * 40 + 8 * cq) = k1;
                u32x2 o; o.x = pk2(v0, v1); o.y = pk2(v2, v3); *(LAS u32x2*)(VT + (sp * 32 + e) * 40 + 4 * jq) = o;
        }
        if (w < 4 && j + 1 < NTB) { HG_WRITE((j + 1) & 1); if (j + 2 < NTB) HG_ISSUE(32 * (j + 2)); }
        HG_BAR();
    }
#undef HG_ISSUE
#undef HG_WRITE
#undef HG_BAR
}
__device__ __forceinline__ void naive_hg_scan(Frame& F) {
    const int gt = fbid() * 512 + ftid();
    if (gt >= NB * 8 * 2 * 128) return;
    const int e = gt & 127, dir = (gt >> 7) & 1, h = (gt >> 8) & 7, b = gt >> 11;
    const float* fsrc = (const float*)(F.ws + (dir ? WS_FB : WS_FF));
    const bf16_t* qsrc = (const bf16_t*)(F.ws + WS_PQ); const bf16_t* vsrc = (const bf16_t*)(F.ws + WS_PI);
    float* osrc = (float*)(F.ws + (dir ? WS_OB : WS_OF));
    float S[128];
#pragma unroll
    for (int d = 0; d < 128; ++d) S[d] = 0.f;
    for (int s_ = 0; s_ < SU; ++s_) {
        const int pp = dir ? (s_ < NCTX ? NCTX - 1 - s_ : SU + NCTX - 1 - s_) : s_;
        const size_t row = (size_t)b * SU + pp;
        const float v = bf2f(vsrc[row * DM + h * 128 + e]);
        const float* fr = fsrc + row * DM + h * 128; const bf16_t* qr = qsrc + row * DM + h * 128;
        float o = 0.f;
#pragma unroll
        for (int d = 0; d < 128; ++d) { const float f = fr[d]; S[d] = f * S[d] + (1.0f - f) * v; o += bf2f(qr[d]) * S[d]; }
        osrc[row * DM + h * 128 + e] = o;
    }
}
__device__ __forceinline__ void naive_hg_readout(Frame& F, const Args& args, int p) {
    for (int i = fbid() * 512 + ftid(); i < MTOK * 8; i += F.G * 512) {
        const int row = i >> 3, h = i & 7;
        const float* a = (const float*)(F.ws + WS_OF) + (size_t)row * DM + h * 128; const float* c = (const float*)(F.ws + WS_OB) + (size_t)row * DM + h * 128;
        float ss = 0.f;
        for (int d = 0; d < 128; ++d) { const float o = a[d] + c[d]; ss += o * o; }
        const float rstd = 1.0f / sqrtf(ss / 128.f + EPS);
        const bf16_t* g = (const bf16_t*)(F.ws + WS_PG) + (size_t)row * DM + h * 128; bf16_t* y = (bf16_t*)(F.ws + WS_YB16) + (size_t)row * DM + h * 128;
        for (int d = 0; d < 128; ++d) { const float o = a[d] + c[d]; const float gv = bf2f(g[d]); y[d] = (bf16_t)f2bf(o * rstd * args.in[I_HGNW][p * 128 + d] * (gv / (1.0f + expf(-gv)))); }
    }
}
__device__ __forceinline__ void hg_readout_phase(Frame& F, const Args& args, int p) {
    const int gw = F.vcu * NWAVES + F.wave, NGW = F.G * NWAVES, lane = flane();
    const float* nw = ((const float*)(F.ws + WS_SP) + SP_HGNW) + p * 128 + 16 * (lane & 7);
    for (int row = gw; row < MTOK; row += NGW) {
        const u32x4* a = (const u32x4*)(F.ws + WS_OF + (size_t)row * DM * 2) + 2 * lane; const u32x4* c = (const u32x4*)(F.ws + WS_OB + (size_t)row * DM * 2) + 2 * lane;
        const u32x4 a0 = a[0], a1 = a[1], c0 = c[0], c1 = c[1];
        const unsigned aw[8] = {a0.x, a0.y, a0.z, a0.w, a1.x, a1.y, a1.z, a1.w}, cw[8] = {c0.x, c0.y, c0.z, c0.w, c1.x, c1.y, c1.z, c1.w};
        f32x4 o[4]; float ss = 0.f;
#pragma unroll
        for (int j = 0; j < 4; ++j) { o[j] = (f32x4){bflo(aw[2 * j]) + bflo(cw[2 * j]), bfhi(aw[2 * j]) + bfhi(cw[2 * j]), bflo(aw[2 * j + 1]) + bflo(cw[2 * j + 1]), bfhi(aw[2 * j + 1]) + bfhi(cw[2 * j + 1])};
            ss += (o[j].x * o[j].x + o[j].y * o[j].y) + (o[j].z * o[j].z + o[j].w * o[j].w); }
        ss += shx(ss, 1, lane); ss += shx(ss, 2, lane); ss += shx(ss, 4, lane);
        const float rstd = 1.0f / sqrtf(ss * (1.0f / 128.f) + EPS);
        const u32x4* gp = (const u32x4*)(F.ws + WS_PG + (size_t)row * DM * 2) + 2 * lane;
        const u32x4 g0 = gp[0], g1 = gp[1]; const unsigned gwv[8] = {g0.x, g0.y, g0.z, g0.w, g1.x, g1.y, g1.z, g1.w};
        unsigned outw[8];
#pragma unroll
        for (int j = 0; j < 4; ++j) { const f32x4 wv = *(const f32x4*)(nw + 4 * j);
            const float y0 = o[j].x * rstd * wv.x * siluf(bflo(gwv[2 * j])), y1 = o[j].y * rstd * wv.y * siluf(bfhi(gwv[2 * j]));
            const float y2 = o[j].z * rstd * wv.z * siluf(bflo(gwv[2 * j + 1])), y3 = o[j].w * rstd * wv.w * siluf(bfhi(gwv[2 * j + 1]));
            outw[2 * j] = pk2(y0, y1); outw[2 * j + 1] = pk2(y2, y3); }
        u32x4* op = (u32x4*)(F.ws + WS_YB16 + (size_t)row * DM * 2) + 2 * lane;
        op[0] = (u32x4){outw[0], outw[1], outw[2], outw[3]}; op[1] = (u32x4){outw[4], outw[5], outw[6], outw[7]};
    }
}

constexpr int NPHASE = 2 + 9 * DEPTH;
constexpr unsigned KM_ALL = 0x7ffu | (3u << 16);
template <unsigned KM>
__device__ __forceinline__ void mk_body(const Args& args, unsigned char* lds_raw) {
    Frame F;
    F.lds = (LAS unsigned char*)lds_raw;
    F.MISC = (volatile LAS unsigned*)(F.lds + MISC_OFF);
    F.wave = __builtin_amdgcn_readfirstlane(ftid() >> 6);
    F.G = gridDim.x; { const int bx = blockIdx.x; F.vcu = (F.G % 8 == 0) ? (bx % 8) * (F.G / 8) + bx / 8 : bx; }
    F.ws = args.ws; F.ctl = (unsigned*)(args.ws + WS_CTL);
    for (int u = ftid(); u < (LDS_BYTES - LDSCTL_OFF) / 4; u += NWAVES * 64) ((LAS unsigned*)(F.lds + LDSCTL_OFF))[u] = 0u;
    __syncthreads();
    XcdBarrier bar; bar.bar = F.ctl + CW_BAR; bar.x = 0; bar.st = nullptr;
    const int lo = args.ph_lo, hi = args.ph_hi;
    if (hi - lo > 1) bar = xcd_barrier_post(F.ctl + CW_BAR, F.MISC + 8);
#define HAS(kind) ((KM >> (kind)) & 1u)
    if constexpr (HAS(0)) { if (lo == 0) { p0_prologue(F, args); if (NAIVE_MOD) { __syncthreads(); naive_mod(F, args); } if (hi > 1) xcd_barrier(bar); } }
    float* const outp = args.out;
#pragma nounroll
    for (int ph = (lo == 0 ? 1 : lo); ph < hi; ++ph) {
        const Args* ap = &args;
        { unsigned char* w_ = args.ws; asm volatile("" : "+s"(w_)); F.ws = w_; F.ctl = (unsigned*)(w_ + WS_CTL); }
        { int wv_ = __builtin_amdgcn_readfirstlane(ftid() >> 6); F.wave = wv_; int g_ = (int)gridDim.x; asm volatile("" : "+s"(g_)); F.G = g_; const int bx = fbid(); F.vcu = (g_ % 8 == 0) ? (bx % 8) * (g_ / 8) + bx / 8 : bx; }
        const float* mod = (const float*)(F.ws + WS_MOD);
        const int kind = (ph == 0) ? 0 : (ph == NPHASE - 1 ? 10 : 1 + (ph - 1) % 9);
        const int l = (ph - 1) / 9; const int odd = l & 1, p = l >> 1;
        if (kind == 5 && odd) continue;
        switch (kind) {
        case 1: if constexpr (HAS(1)) { if (NAIVE_N1 == 1) naive_n1(F, *ap, l, false); else if (NAIVE_N1 == 2) wave_n1(F, *ap, l, false); else n1_phase<false>(F, *ap, l); } break;
        case 2: if constexpr (HAS(2)) {
            const int N = odd ? OD_N : EV_N;
            if (NAIVE_G1) { naive_g1(F, *ap, l); } else {
            pg8::PlainAddr AD{(const bf16_t*)(F.ws + WS_HB), (const bf16_t*)(F.ws + (odd ? WS_W_ODIN + (size_t)p * 10 * MiB : WS_W_EVIN + (size_t)p * 6 * MiB)), DM};
            pg8::StaticOrder S; S.init(MTOK, N, F.G, fbid());
            EpiProj E{F.ws, (const float*)(F.ws + WS_LB) + l * DM, odd};
            pg8::gemm_phase(F.lds, AD, S, E, DM);
            } } break;
        case 3: if constexpr (HAS(3)) {
            if (!odd) {
                if constexpr (HAS(16)) {
                    for (int it = fbid(); it < NB * 4 * NCHUNK + (NAIVE_ATT ? 0 : NB * 2 * NCHUNK); it += F.G) {
                        if (it < NB * 4 * NCHUNK) ret_state_item(F, *ap, p, it); else att_item(F, *ap, p, it - NB * 4 * NCHUNK);
                    }
                    if (NAIVE_ATT) { __syncthreads(); naive_att(F, *ap, p); }
                }
            } else {
                if constexpr (HAS(17)) { if (NAIVE_HG) naive_hg_scan(F); else for (int it = fbid(); it < NB * 8 * 2 * 4; it += F.G) hg_scan_item(F, it); }
            }
            __syncthreads(); } break;
        case 4: if constexpr (HAS(4)) {
            if (!odd) { if constexpr (HAS(16)) ret_scan_phase(F, *ap, p); } else { if constexpr (HAS(17)) { if (NAIVE_HG) naive_hg_readout(F, *ap, p); else hg_readout_phase(F, *ap, p); } } } break;
        case 5: if constexpr (HAS(5)) { for (int it = fbid(); it < NB * 4 * NCHUNK; it += F.G) { if (RET_DIRECT) ret_direct_item(F, *ap, p, it); else ret_out_item(F, *ap, p, it); } __syncthreads(); } break;
        case 6: if constexpr (HAS(6)) {
            if (NAIVE_G2) { if (odd ? CONTRIB_ODD : CONTRIB_EVEN) naive_g2(F, *ap, l); } else {
            pg8::PlainAddr AD{(const bf16_t*)(F.ws + WS_YB16), (const bf16_t*)(F.ws + (odd ? WS_W_ODOUT : WS_W_EVOUT) + (size_t)p * 2 * MiB), DM};
            pg8::StaticOrder S; S.init(MTOK, DM, F.G, fbid());
            EpiOut E{(bf16_t*)(F.ws + WS_XRES), mod + (size_t)l * 5 * 6144, odd ? CONTRIB_ODD : CONTRIB_EVEN};
            pg8::gemm_phase(F.lds, AD, S, E, DM);
            } } break;
        case 7: if constexpr (HAS(7)) { if (NAIVE_N2R) naive_n2r(F, *ap, l); else n2r_phase(F, *ap, l); } break;
        case 8: case 9: if constexpr (HAS(8) || HAS(9)) {
            LAS int* tstart = (LAS int*)(F.lds + LDSCTL_OFF + 512); LAS int* cnts = (LAS int*)(F.lds + LDSCTL_OFF + 768);
            __syncthreads();
            if (F.wave == 0) { int mycnt; const int pre = moe_tile_prefix(F.ctl + CW_CNT + l * NEXP, flane(), mycnt); if (flane() <= NEXP) tstart[flane()] = pre; if (flane() < NEXP) cnts[flane()] = mycnt; }
            __syncthreads();
            const int ntiles = tstart[NEXP];
            const bf16_t* wmoe = (const bf16_t*)(F.ws + WS_W_MOE + (size_t)l * NEXP * 3 * MiB);
            if (kind == 8) { if constexpr (HAS(8)) {
                if (NAIVE_MOE) naive_moe(F, *ap, l); else {
                pg8::MoeGatherAddr AD{(const bf16_t*)(F.ws + WS_HB), wmoe, (const unsigned*)(F.ws + WS_LIST), DM};
                pg8::MoeOrder S{tstart, cnts, ntiles, F.G, fbid()};
                EpiAct E{(bf16_t*)(F.ws + WS_ACT)};
                pg8::gemm_phase(F.lds, AD, S, E, DM); }
            } } else { if constexpr (HAS(9)) {
                pg8::MoeActAddr AD{(const bf16_t*)(F.ws + WS_ACT), wmoe + (size_t)DM * DM, FF};
                pg8::MoeOrder S{tstart, cnts, ntiles, F.G, fbid()};
                EpiY E{(bf16_t*)(F.ws + WS_YB)};
                pg8::gemm_phase(F.lds, AD, S, E, FF);
            } } } break;
        default: if constexpr (HAS(10)) { if (NAIVE_FINAL == 1) naive_n1(F, *ap, DEPTH, true); else if (NAIVE_FINAL == 2) wave_n1(F, *ap, DEPTH, true); else n1_phase<true>(F, *ap, DEPTH); } break;
        }
        if (ph + 1 < hi) xcd_barrier(bar);
    }
#undef HAS
}
template <int L>
__device__ __forceinline__ void layer_sl(Frame& F, const Args& args, const XcdBarrier& bar) {
    constexpr int l = L; constexpr int odd = L & 1, p = L >> 1;
    const float* mod = (const float*)(F.ws + WS_MOD);
    n1_phase<false>(F, args, l); xcd_barrier(bar);
    { pg8::PlainAddr AD{(const bf16_t*)(F.ws + WS_HB), (const bf16_t*)(F.ws + (odd ? WS_W_ODIN + (size_t)p * 10 * MiB : WS_W_EVIN + (size_t)p * 6 * MiB)), DM};
      pg8::StaticOrder S; S.init(MTOK, odd ? OD_N : EV_N, F.G, FCG(F));
      EpiProj E{F.ws, (const float*)(F.ws + WS_LB) + l * DM, odd};
      pg8::gemm_phase(F.lds, AD, S, E, DM); }
    conv_moe_tail(F, args, l, 0, moe_g1_hi(l), (MTOK / 256) * ((odd ? OD_N : EV_N) / 256));
    xcd_barrier(bar);
    if constexpr (!odd) {
        {
            const int bx = F.vcu;
            if (F.G == 256) {
                att_item(F, args, p, bx);
                if (bx < 16) att_item(F, args, p, 256 + bx);
                else { const int r0 = 2 * (bx - 16); ret_state_item(F, args, p, r0); ret_state_item(F, args, p, r0 + 1); if (bx - 16 < 64) ret_state_item(F, args, p, 480 + (bx - 16));
                    else if constexpr (l == 2) {
                        __syncthreads();
                        LAS float* scr = (LAS float*)(F.lds + F.wave * 16384); const int lane = flane();
                        for (int it = moe_p0_lo(3) + (bx - 80) * NWAVES + F.wave; it < MOE_NI; it += 176 * NWAVES) conv_moe_item(F, args, 3, it, scr, lane);
                    }
                    else if constexpr (l == 0) {
                        __syncthreads();
                        LAS float* scr = (LAS float*)(F.lds + F.wave * 16384); const int lane = flane();
                        constexpr int A0 = NI_EVIN, A1 = 2 * NI_EVIN + 2 * NI_ODIN, B0 = A1 + NI_OUT, B1 = A1 + 4 * NI_OUT, NA = A1 - A0, TOT = NA + (B1 - B0);
                        for (int it = (bx - 80) * NWAVES + F.wave; it < TOT; it += 176 * NWAVES) conv_proj_item(F, args, it < NA ? A0 + it : B0 + (it - NA), scr, lane);
                    } }
            } else {
                for (int it = bx; it < NB * 4 * NCHUNK + NB * 2 * NCHUNK; it += F.G) { if (it < NB * 2 * NCHUNK) att_item(F, args, p, it); else ret_state_item(F, args, p, it - NB * 2 * NCHUNK); }
            }
        }
        __syncthreads(); xcd_barrier(bar);
        ret_scan_phase(F, args, p); xcd_barrier(bar);
        for (int rep_ = 0; rep_ <= REP_MIXE; ++rep_) for (int it = FCG(F); it < NB * 4 * NCHUNK; it += F.G) ret_out_item(F, args, p, it);
        if constexpr (l == 0) conv_moe_tail(F, args, 0, moe_g2_hi(0), moe_x_hi(0), NB * 4 * NCHUNK);
        if constexpr (l == 2) conv_moe_tail(F, args, 3, moe_g2_hi(3), moe_x_hi(3), NB * 4 * NCHUNK);
        __syncthreads(); xcd_barrier(bar);
    } else {
        for (int rep_ = 0; rep_ <= REP_HG; ++rep_) for (int it = F.vcu; it < NB * 8 * 2 * 4; it += F.G) hg_scan_item(F, it);
        __syncthreads(); xcd_barrier(bar);
        hg_readout_phase(F, args, p); xcd_barrier(bar);
    }
    { pg8::PlainAddr AD{(const bf16_t*)(F.ws + WS_YB16), (const bf16_t*)(F.ws + (odd ? WS_W_ODOUT : WS_W_EVOUT) + (size_t)p * 2 * MiB), DM};
      pg8::StaticOrder S; S.init(MTOK, DM, F.G, FCG(F), l == DEPTH - 1 ? 1 : 0);
      EpiOut E{(bf16_t*)(F.ws + WS_XRES), mod + (size_t)l * 5 * 6144, 1};
      pg8::gemm_phase(F.lds, AD, S, E, DM); }
    if constexpr (l != DEPTH - 1) conv_moe_tail(F, args, l, moe_g1_hi(l), moe_g2_hi(l), (MTOK / 256) * (DM / 256));
    xcd_barrier(bar);
    n2r_phase(F, args, l); xcd_barrier(bar);
    {   LAS int* tstart = (LAS int*)(F.lds + LDSCTL_OFF + 512); LAS int* cnts = (LAS int*)(F.lds + LDSCTL_OFF + 768);
        __syncthreads();
        if (F.wave == 0) { int mycnt; const int ln = flane(); const int pre = moe_tile_prefix(F.ctl + CW_CNT + l * NEXP, ln, mycnt); if (ln <= NEXP) tstart[ln] = pre; if (ln < NEXP) cnts[ln] = mycnt; }
        __syncthreads();
        const int ntiles = tstart[NEXP];
        const bf16_t* wmoe = (const bf16_t*)(F.ws + WS_W_MOE + (size_t)l * NEXP * 3 * MiB);
        { pg8::MoeGatherAddr AD{(const bf16_t*)(F.ws + WS_HB), wmoe, (const unsigned*)(F.ws + WS_LIST), DM};
          pg8::MoeOrder S{tstart, cnts, ntiles, F.G, FCG(F)};
          EpiAct E{(bf16_t*)(F.ws + WS_ACT)};
          pg8::gemm_phase(F.lds, AD, S, E, DM); }
        if constexpr (l == 0) conv_moe_tail(F, args, 1, moe_g2_hi(1), moe_x_hi(1), ntiles * 4);
        if constexpr (l == 1) conv_moe_tail(F, args, 2, moe_g2_hi(2), moe_x_hi(2), ntiles * 4);
        if constexpr (l == 2) conv_moe_tail(F, args, 3, moe_x_hi(3), moe_y_hi(3), ntiles * 4);
        xcd_barrier(bar);
        { pg8::MoeActAddr AD{(const bf16_t*)(F.ws + WS_ACT), wmoe + (size_t)DM * DM, FF};
          pg8::MoeOrder S{tstart, cnts, ntiles, F.G, FCG(F)};
          EpiY E{(bf16_t*)(F.ws + WS_YB)};
          pg8::gemm_phase(F.lds, AD, S, E, FF); }
        if constexpr (l == 0) conv_moe_tail(F, args, 1, moe_x_hi(1), moe_y_hi(1), ntiles * 4);
        if constexpr (l == 1) conv_moe_tail(F, args, 2, moe_x_hi(2), moe_y_hi(2), ntiles * 4);
        if constexpr (l == 2) conv_moe_tail(F, args, 3, moe_y_hi(3), moe_z_hi(3), ntiles * 4);
        xcd_barrier(bar);
    }
}
__global__ void __launch_bounds__(NWAVES * 64, 2) mk_one(Args args) {
    extern __shared__ __attribute__((aligned(16))) unsigned char lds_raw[];
    Frame F;
    F.lds = (LAS unsigned char*)lds_raw;
    F.MISC = (volatile LAS unsigned*)(F.lds + MISC_OFF);
    F.wave = __builtin_amdgcn_readfirstlane(ftid() >> 6);
    F.G = gridDim.x; { const int bx = blockIdx.x; F.vcu = (F.G % 8 == 0) ? (bx % 8) * (F.G / 8) + bx / 8 : bx; }
    F.ws = args.ws; F.ctl = (unsigned*)(args.ws + WS_CTL);
    for (int u = ftid(); u < (LDS_BYTES - LDSCTL_OFF) / 4; u += NWAVES * 64) ((LAS unsigned*)(F.lds + LDSCTL_OFF))[u] = 0u;
    __syncthreads();
    const XcdBarrier bar = xcd_barrier_post(F.ctl + CW_BAR, F.MISC + 8);
    p0_prologue(F, args); xcd_barrier(bar);
    {
        if (ftid() == 0) {
            unsigned* bw = F.ctl + CW_BAR; const unsigned G = (unsigned)F.G, per = G / 8u; bool uni = (G % 8u) == 0u;
            for (unsigned j = 0; j < 8; ++j) uni = uni && (xb_ld(&bw[XB_XCNT(j)]) == per);
            const unsigned r = F.MISC[10], x = bar.x;
            F.MISC[12] = (uni && x < 8u && r < per) ? r * 8u + x : (unsigned)blockIdx.x;
            F.MISC[13] = (uni && x < 8u && r < per) ? x * per + r : (unsigned)F.vcu;
        }
        __syncthreads();
        F.vcu = __builtin_amdgcn_readfirstlane((int)F.MISC[13]);
    }
    layer_sl<0>(F, args, bar);
    layer_sl<1>(F, args, bar);
    layer_sl<2>(F, args, bar);
    layer_sl<3>(F, args, bar);
    n1_phase<true>(F, args, DEPTH);
}

template <unsigned KM>
__global__ void __launch_bounds__(NWAVES * 64, 2) mk_fwd(Args args) {
    extern __shared__ __attribute__((aligned(16))) unsigned char lds_raw[];
    mk_body<KM>(args, lds_raw);
}

template <unsigned KM> static bool prep_kernel() { return hipFuncSetAttribute((const void*)mk_fwd<KM>, hipFuncAttributeMaxDynamicSharedMemorySize, LDS_BYTES) == hipSuccess; }
template <unsigned KM> static void launch_kernel(int grid, hipStream_t stream, const Args& a) { hipLaunchKernelGGL(mk_fwd<KM>, dim3(grid), dim3(NWAVES * 64), LDS_BYTES, stream, a); }
#define KEV (1u << 16)
#define KOD (1u << 17)
extern "C" void kernel_launch(void* const* d_in, const int* in_sizes, int n_in, void* d_out, int out_size, void* d_ws, size_t ws_size, hipStream_t stream) {
    static int grid = 0;
    if (grid == 0) {
        const int exp_sizes[23] = {NB * LSEQ * DM, NB * DM, NB * NCTX * DM, DM, DEPTH * DM * 6 * DM, DEPTH * 6 * DM, DEPTH * 2 * DM, DM, 2 * DM * EV_N, 2 * DM * DM, 16, 8,
                                   2 * DM * OD_N, 2 * DM * DM, DEPTH * DM, 2 * 128, DEPTH * DM * 4, DEPTH * 4, DEPTH * 4 * DM * 8, DEPTH * 32, DEPTH * NEXP * DM * FF, DEPTH * NEXP * DM * FF, DEPTH * NEXP * FF * DM};
        bool sz_ok = (n_in == 23) && out_size == NB * LSEQ * DM;
        for (int i = 0; i < 23 && sz_ok; ++i) sz_ok = (in_sizes[i] == exp_sizes[i]);
        if (!sz_ok) { fprintf(stderr, "kernel_launch: unexpected input sizes\n"); grid = -1; return; }
        if (n_in != 23 || ws_size < WS_END) { fprintf(stderr, "kernel_launch: unexpected n_in %d / ws_size %zu\n", n_in, ws_size); grid = -1; return; }
        int dev = 0, cus = 0;
        if (hipGetDevice(&dev) != hipSuccess || hipDeviceGetAttribute(&cus, hipDeviceAttributeMultiprocessorCount, dev) != hipSuccess) { grid = -1; return; }
        bool ok = true;
#if MK_PER_PHASE
        ok = ok && prep_kernel<1u << 0>() && prep_kernel<1u << 1>() && prep_kernel<1u << 2>() && prep_kernel<(1u << 3) | KEV>() && prep_kernel<(1u << 3) | KOD>()
                && prep_kernel<(1u << 4) | KEV>() && prep_kernel<(1u << 4) | KOD>() && prep_kernel<(1u << 5) | KEV>() && prep_kernel<1u << 6>() && prep_kernel<1u << 7>()
                && prep_kernel<1u << 8>() && prep_kernel<1u << 9>() && prep_kernel<1u << 10>();
#else
        ok = ok && (hipFuncSetAttribute((const void*)mk_one, hipFuncAttributeMaxDynamicSharedMemorySize, LDS_BYTES) == hipSuccess);
#ifdef PROBE_MASKS
        ok = ok && prep_kernel<(1u<<3)|(3u<<16)>() && prep_kernel<(1u<<3)|(1u<<5)|(1u<<16)>() && prep_kernel<(1u<<0)|(1u<<1)|(1u<<7)|(1u<<10)>() && prep_kernel<(1u<<3)|(1u<<4)|(1u<<5)|(3u<<16)>() && prep_kernel<(1u<<0)|(1u<<3)|(1u<<16)>() && prep_kernel<(1u<<1)|(1u<<3)|(1u<<16)>();
#endif
#endif
        if (!ok) { fprintf(stderr, "kernel_launch: hipFuncSetAttribute failed\n"); grid = -1; return; }
        (void)hipGetLastError();
        int per_cu = 1;
#if !MK_PER_PHASE
        if (hipOccupancyMaxActiveBlocksPerMultiprocessor(&per_cu, mk_one, NWAVES * 64, LDS_BYTES) != hipSuccess || per_cu < 1) { fprintf(stderr, "kernel_launch: occupancy query failed\n"); grid = -1; return; }
#endif
        grid = cus * per_cu; if (grid > 256) grid = 256;
    }
    if (grid < 0) return;
    (void)hipMemsetAsync((char*)d_ws + WS_CTL, 0, CTL_ZERO_BYTES, stream);
    Args a{};
    for (int i = 0; i < 23; ++i) a.in[i] = (const float*)d_in[i];
    a.out = (float*)d_out; a.ws = (unsigned char*)d_ws;
#if MK_PER_PHASE
    for (int ph = 0; ph < NPHASE; ++ph) {
        { unsigned char* w_ = args.ws; asm volatile("" : "+s"(w_)); F.ws = w_; F.ctl = (unsigned*)(w_ + WS_CTL); }
        { int wv_ = __builtin_amdgcn_readfirstlane(ftid() >> 6); F.wave = wv_; int g_ = (int)gridDim.x; asm volatile("" : "+s"(g_)); F.G = g_; const int bx = fbid(); F.vcu = (g_ % 8 == 0) ? (bx % 8) * (g_ / 8) + bx / 8 : bx; }
        const float* mod = (const float*)(F.ws + WS_MOD);
        const int kind = (ph == 0) ? 0 : (ph == NPHASE - 1 ? 10 : 1 + (ph - 1) % 9); const int l = (ph - 1) / 9; const bool odd = (l & 1) != 0;
        if (kind == 5 && odd) continue;
        a.ph_lo = ph; a.ph_hi = ph + 1;
        switch (kind) {
            case 0: launch_kernel<1u << 0>(grid, stream, a); break;
            case 1: launch_kernel<1u << 1>(grid, stream, a); break;
            case 2: launch_kernel<1u << 2>(grid, stream, a); break;
            case 3: if (odd) launch_kernel<(1u << 3) | KOD>(grid, stream, a); else launch_kernel<(1u << 3) | KEV>(grid, stream, a); break;
            case 4: if (odd) launch_kernel<(1u << 4) | KOD>(grid, stream, a); else launch_kernel<(1u << 4) | KEV>(grid, stream, a); break;
            case 5: launch_kernel<(1u << 5) | KEV>(grid, stream, a); break;
            case 6: launch_kernel<1u << 6>(grid, stream, a); break;
            case 7: launch_kernel<1u << 7>(grid, stream, a); break;
            case 8: launch_kernel<1u << 8>(grid, stream, a); break;
            case 9: launch_kernel<1u << 9>(grid, stream, a); break;
            default: launch_kernel<1u << 10>(grid, stream, a); break;
        }
    }
#else
    a.ph_lo = 0; a.ph_hi = NPHASE;
    hipLaunchKernelGGL(mk_one, dim3(grid), dim3(NWAVES * 64), LDS_BYTES, stream, a);
#endif
}
```
